# Optimizing an MI355X kernel written in HIP

```python
import math
import jax, jax.numpy as jnp
from jax import lax
import numpy as np

D_MODEL = 1024
BATCH = 1
SEQ = 16384
DEPTH = 1

ATTN_HEADS = 8
HEAD_DIM = 128
ATTN_W = ATTN_HEADS * HEAD_DIM
MOBA_BLOCK = 256
MOBA_TOPK = 3
Q_CHUNK = 32
ROPE_DIM = HEAD_DIM // 4
ROPE_THETA = 500000.0
DN_HEADS = 8
DN_DK = 128
DN_DV = 128
DN_QK_W = DN_HEADS * DN_DK
DN_V_W = DN_HEADS * DN_DV
DN_CONV = 4
DN_CHUNK = 64
D_FF = int(math.ceil(8 * D_MODEL / 3 / 256) * 256)
EPS = 1e-6

IN_SIZES = [ATTN_W, ATTN_W, ATTN_W,
            DN_QK_W, DN_QK_W, DN_V_W,
            DN_V_W,
            DN_HEADS, DN_HEADS,
            D_MODEL, D_MODEL]
IN_TOTAL = int(sum(IN_SIZES))
IN_SPLITS = [int(s) for s in np.cumsum(IN_SIZES)[:-1]]

kernel_name = "hybrid_moba_gdn_gated_merge_block"


def rms_norm(x, w):
    xf = x.astype(jnp.float32)
    y = xf * lax.rsqrt(jnp.mean(xf * xf, axis=-1, keepdims=True) + EPS)
    return (y * w.astype(jnp.float32)).astype(x.dtype)


def l2_norm(x):
    return x * lax.rsqrt(jnp.sum(x * x, axis=-1, keepdims=True) + EPS)


def partial_rope(x, pos):
    half = ROPE_DIM // 2
    inv = ROPE_THETA ** (-jnp.arange(half, dtype=jnp.float32) * 2.0 / ROPE_DIM)
    ang = pos.astype(jnp.float32)[:, None] * inv[None, :]
    cos = jnp.cos(ang)[None, :, None, :]
    sin = jnp.sin(ang)[None, :, None, :]
    xr = x[..., :ROPE_DIM].astype(jnp.float32)
    x1, x2 = xr[..., :half], xr[..., half:]
    rot = jnp.concatenate([x1 * cos - x2 * sin, x2 * cos + x1 * sin], axis=-1)
    return jnp.concatenate([rot.astype(x.dtype), x[..., ROPE_DIM:]], axis=-1)


def moba_attention(q, k, v):
    B, S, H, D = q.shape
    nb = -(-S // MOBA_BLOCK)
    s_pad = nb * MOBA_BLOCK
    pad = [(0, 0), (0, s_pad - S), (0, 0), (0, 0)]
    q = jnp.pad(q, pad).transpose(0, 2, 1, 3)
    k = jnp.pad(k, pad).transpose(0, 2, 1, 3)
    v = jnp.pad(v, pad).transpose(0, 2, 1, 3)
    kb = k.reshape(B, H, nb, MOBA_BLOCK, D)
    vb = v.reshape(B, H, nb, MOBA_BLOCK, D)
    k_mean = jnp.mean(kb.astype(jnp.float32), axis=3)
    gate = jnp.einsum('bhsd,bhnd->bhsn', q.astype(jnp.float32), k_mean)
    pos = jnp.arange(s_pad)
    q_blk = pos // MOBA_BLOCK
    past = jnp.arange(nb)[None, :] < q_blk[:, None]
    gate = jnp.where(past[None, None], gate, -jnp.inf)
    k_eff = min(MOBA_TOPK, nb)
    _, top_idx = lax.top_k(gate, k_eff)
    top_valid = jnp.arange(k_eff)[None, :] < q_blk[:, None]
    own = jnp.broadcast_to(q_blk[None, None, :, None], (B, H, s_pad, 1))
    idx = jnp.concatenate([top_idx.astype(jnp.int32), own.astype(jnp.int32)], axis=-1)
    slot_valid = jnp.concatenate([top_valid, jnp.ones((s_pad, 1), bool)], axis=-1)
    ns = k_eff + 1
    nc = s_pad // Q_CHUNK
    qc = q.reshape(B, H, nc, Q_CHUNK, D).transpose(2, 0, 1, 3, 4)
    idxc = idx.reshape(B, H, nc, Q_CHUNK, ns).transpose(2, 0, 1, 3, 4)
    validc = slot_valid.reshape(nc, Q_CHUNK, ns)
    posc = pos.reshape(nc, Q_CHUNK)
    key_off = jnp.arange(MOBA_BLOCK)
    bi = jnp.arange(B)[:, None, None, None]
    hi = jnp.arange(H)[None, :, None, None]
    scale = 1.0 / math.sqrt(D)

    def chunk(args):
        qq, ii, vv, pp = args
        ks = kb[bi, hi, ii]
        vs = vb[bi, hi, ii]
        s = jnp.einsum('bhqd,bhqnkd->bhqnk', qq, ks,
                       preferred_element_type=jnp.float32) * scale
        kpos = ii[..., None] * MOBA_BLOCK + key_off
        mask = vv[None, None, :, :, None] & (kpos <= pp[None, None, :, None, None])
        s = jnp.where(mask, s, -jnp.inf)
        p = jax.nn.softmax(s, axis=(-2, -1))
        return jnp.einsum('bhqnk,bhqnkd->bhqd', p.astype(vs.dtype), vs)

    out = lax.map(chunk, (qc, idxc, validc, posc))
    out = out.transpose(1, 2, 0, 3, 4).reshape(B, H, s_pad, D)[:, :, :S]
    return out.transpose(0, 2, 1, 3)


def causal_depthwise_conv(x, w):
    K, C = w.shape
    return lax.conv_general_dilated(x, w[:, None, :].astype(x.dtype), window_strides=(1,),
                                    padding=[(K - 1, 0)],
                                    dimension_numbers=('NWC', 'WIO', 'NWC'),
                                    feature_group_count=C)


def chunk_gated_delta_rule(q, k, v, beta, g):
    B, S, H, dk = q.shape
    dv = v.shape[-1]
    C = DN_CHUNK
    N = S // C
    q = q * (dk ** -0.5)
    tr = lambda t: t.reshape(B, N, C, H, -1).transpose(0, 3, 1, 2, 4)
    q, k, v = tr(q), tr(k), tr(v)
    beta = beta.reshape(B, N, C, H).transpose(0, 3, 1, 2)
    g = jnp.cumsum(g.reshape(B, N, C, H).transpose(0, 3, 1, 2), axis=-1)
    tril = jnp.tril(jnp.ones((C, C), bool))
    strict = jnp.tril(jnp.ones((C, C), bool), -1)
    eye = jnp.eye(C, dtype=q.dtype)
    gdiff = g[..., :, None] - g[..., None, :]
    decay = jnp.where(tril, jnp.exp(jnp.where(tril, gdiff, 0.0)), 0.0)
    k_beta = k * beta[..., None]
    v_beta = v * beta[..., None]
    L = jnp.where(strict, jnp.einsum('bhncd,bhnjd->bhncj', k_beta, k) * decay, 0.0)
    A = L + eye
    T = lax.linalg.triangular_solve(A, jnp.broadcast_to(eye, A.shape), left_side=True,
                                    lower=True, unit_diagonal=True)
    u = jnp.einsum('bhncj,bhnjd->bhncd', T, v_beta)
    w = jnp.einsum('bhncj,bhnjd->bhncd', T, k_beta * jnp.exp(g)[..., None])
    attn = jnp.where(tril, jnp.einsum('bhncd,bhnjd->bhncj', q, k) * decay, 0.0)
    mv = lambda t: jnp.moveaxis(t, 2, 0)

    def step(state, xs):
        qn, kn, un, wn, gn, an = xs
        v_new = un - jnp.einsum('bhcd,bhde->bhce', wn, state)
        o = (jnp.einsum('bhcd,bhde->bhce', qn * jnp.exp(gn)[..., None], state)
             + jnp.einsum('bhcj,bhje->bhce', an, v_new))
        g_last = gn[..., -1]
        state = (state * jnp.exp(g_last)[..., None, None]
                 + jnp.einsum('bhcd,bhce->bhde', kn * jnp.exp(g_last[..., None] - gn)[..., None], v_new))
        return state, o

    s0 = jnp.zeros((B, H, dk, dv), q.dtype)
    _, o = lax.scan(step, s0, (mv(q), mv(k), mv(u), mv(w), mv(g), mv(attn)))
    return o.transpose(1, 0, 3, 2, 4).reshape(B, S, H, dv)


def gated_deltanet(q, k, v, z, b, a, conv_w, a_log, dt_bias, o_norm_w):
    B, S, _ = q.shape
    dt = q.dtype
    qkv = jax.nn.silu(causal_depthwise_conv(jnp.concatenate([q, k, v], axis=-1), conv_w))
    qkv = qkv.astype(jnp.float32)
    q, k, v = jnp.split(qkv, [DN_QK_W, 2 * DN_QK_W], axis=-1)
    q = l2_norm(q.reshape(B, S, DN_HEADS, DN_DK))
    k = l2_norm(k.reshape(B, S, DN_HEADS, DN_DK))
    v = v.reshape(B, S, DN_HEADS, DN_DV)
    beta = jax.nn.sigmoid(b.astype(jnp.float32))
    g = -jnp.exp(a_log.astype(jnp.float32)) * jax.nn.softplus(
        a.astype(jnp.float32) + dt_bias.astype(jnp.float32))
    o = chunk_gated_delta_rule(q, k, v, beta, g)
    o = rms_norm(o, o_norm_w) * jax.nn.silu(z.astype(jnp.float32).reshape(B, S, DN_HEADS, DN_DV))
    return o.reshape(B, S, DN_V_W).astype(dt)


def setup_inputs(seed: int = 0) -> dict:
    key = jax.random.key(seed)
    ks = jax.random.split(key, 20)
    f32 = jnp.float32
    nrm = lambda k_, shape, fan_in: jax.random.normal(k_, shape, f32) * (fan_in ** -0.5)
    gain = lambda k_, shape: 1.0 + 0.05 * jax.random.normal(k_, shape, f32)
    dt = jnp.exp(jax.random.uniform(ks[14], (DEPTH, DN_HEADS), f32, math.log(1e-3), math.log(1e-1)))
    return {
        "x": jax.random.normal(ks[0], (BATCH, SEQ, D_MODEL), f32),
        "norm_mix_pre": gain(ks[1], (DEPTH, D_MODEL)),
        "w_in": nrm(ks[2], (DEPTH, D_MODEL, IN_TOTAL), D_MODEL),
        "conv_w": nrm(ks[3], (DEPTH, DN_CONV, 2 * DN_QK_W + DN_V_W), DN_CONV),
        "a_log": jnp.log(jax.random.uniform(ks[4], (DEPTH, DN_HEADS), f32, 1.0, 16.0)),
        "dt_bias": jnp.log(jnp.expm1(dt)),
        "o_norm_w": gain(ks[5], (DEPTH, DN_DV)),
        "w_o_attn": nrm(ks[6], (DEPTH, ATTN_W, D_MODEL), ATTN_W),
        "w_o_delta": nrm(ks[7], (DEPTH, DN_V_W, D_MODEL), DN_V_W),
        "w_out": nrm(ks[8], (DEPTH, D_MODEL, D_MODEL), D_MODEL),
        "norm_mix_post": gain(ks[9], (DEPTH, D_MODEL)),
        "norm_ffn_pre": gain(ks[10], (DEPTH, D_MODEL)),
        "w_gate": nrm(ks[11], (DEPTH, D_MODEL, D_FF), D_MODEL),
        "w_up": nrm(ks[12], (DEPTH, D_MODEL, D_FF), D_MODEL),
        "w_down": nrm(ks[13], (DEPTH, D_FF, D_MODEL), D_FF),
        "norm_ffn_post": gain(ks[15], (DEPTH, D_MODEL)),
    }


def reference(x, norm_mix_pre, w_in, conv_w, a_log, dt_bias, o_norm_w, w_o_attn, w_o_delta,
              w_out, norm_mix_post, norm_ffn_pre, w_gate, w_up, w_down, norm_ffn_post):
    B, S, _ = x.shape
    pos = jnp.arange(S)
    for l in range(DEPTH):
        h = rms_norm(x, norm_mix_pre[l])
        proj = h @ w_in[l]
        qa, ka, va, qd, kd, vd, zd, bd, ad, ga, gd = jnp.split(proj, IN_SPLITS, axis=-1)
        qa = partial_rope(qa.reshape(B, S, ATTN_HEADS, HEAD_DIM), pos)
        ka = partial_rope(ka.reshape(B, S, ATTN_HEADS, HEAD_DIM), pos)
        va = va.reshape(B, S, ATTN_HEADS, HEAD_DIM)
        ya = moba_attention(qa, ka, va).reshape(B, S, ATTN_W)
        yd = gated_deltanet(qd, kd, vd, zd, bd, ad, conv_w[l], a_log[l], dt_bias[l], o_norm_w[l])
        merged = (jax.nn.sigmoid(ga) * (ya @ w_o_attn[l])
                  + jax.nn.sigmoid(gd) * (yd @ w_o_delta[l]))
        x = x + rms_norm(merged @ w_out[l], norm_mix_post[l])
        h = rms_norm(x, norm_ffn_pre[l])
        f = (jax.nn.silu(h @ w_gate[l]) * (h @ w_up[l])) @ w_down[l]
        x = x + rms_norm(f, norm_ffn_post[l])
    return x
```

```cpp
#include <hip/hip_runtime.h>
#include <cstdio>
#include <cstdint>
#include <cmath>
namespace pg8 {
#define PG8_LAS __attribute__((address_space(3)))
typedef unsigned short bf16_t;
typedef short bf16x8 __attribute__((ext_vector_type(8)));
typedef float f32x4 __attribute__((ext_vector_type(4)));
typedef unsigned u32x4 __attribute__((ext_vector_type(4)));
constexpr int BM = 256, BK = 64, HALF = 128, HTB = HALF * BK * 2  , STAGE_BYTES = 8 * HTB, NXCD = 8, WGM = 8;

__host__ __device__ __forceinline__ int lds_byte(int r, int c) { const int st = (r >> 4) * 2 + (c >> 5), rr = r & 15, cc = c & 31, ob = rr * 64 + cc * 2; return st * 1024 + (ob ^ (((ob >> 9) & 1) << 5)); }
__host__ __device__ __forceinline__ void stage_rc(int b, int& R, int& C) { const int st = b / 1024, sb = b % 1024, swz = sb ^ (((sb >> 9) & 1) << 5); R = (st >> 1) * 16 + swz / 64; C = (st & 1) * 32 + (swz % 64) / 2; }
__host__ __device__ __forceinline__ int perm32(int rho) { const int n = rho >> 4, i = rho & 15; return 8 * (i >> 2) + 4 * n + (i & 3); }

struct Unit { int pm, pn; };
struct Gemm { const bf16_t* A; const bf16_t* Bt; int M, N, K; };

struct StaticOrder {
    int nM, nN, nwg, G, c;
    __host__ __device__ void init(int M, int N, int G_, int c_) { nM = M / BM; nN = N / BM; nwg = nM * nN; G = G_; c = c_; }
    __host__ __device__ bool next(int i, Unit& u) const {
        const long L = (long)i * G + c; if (L >= nwg) return false;
        int wgid = (int)L; { const int q = nwg / NXCD, r = nwg % NXCD, xcd = wgid % NXCD, off = wgid / NXCD; wgid = (xcd < r ? xcd * (q + 1) : r * (q + 1) + (xcd - r) * q) + off; }
        const int nig = WGM * nN, gid = wgid / nig, fm = gid * WGM, gsz = (nM - fm) < WGM ? (nM - fm) : WGM;
        u.pm = fm + ((wgid % nig) % gsz); u.pn = (wgid % nig) / gsz; return true;
    }
    __device__ __forceinline__ void a_ready(const Unit&) const {}
    __device__ __forceinline__ void done(const Unit&) const {}
};

__device__ __forceinline__ unsigned cvt_pk_bf16(float lo, float hi) { unsigned r; asm volatile("v_cvt_pk_bf16_f32 %0, %1, %2" : "=v"(r) : "v"(lo), "v"(hi)); return r; }
template <class Epi, class Sched, bool ALIGN_EPI = false, bool SP2 = false>
__device__ __forceinline__ void gemm_phase(PG8_LAS unsigned char* lds, const Gemm g, const Sched& S, const Epi& E) {
    const int tid = threadIdx.x, wid = __builtin_amdgcn_readfirstlane(tid >> 6), lane = tid & 63, wr = wid >> 2, wc = wid & 3, fr = lane & 15, fq = lane >> 4;
    const int K = g.K, nt = K / BK;
    unsigned voffA[2], voffB[2];
#pragma unroll
    for (int i = 0; i < 2; ++i) { int R, C; stage_rc(tid * 16 + i * 8192, R, C); const int Rb = Epi::PERM ? ((R & ~31) + perm32(R & 31)) : R;
        voffA[i] = (unsigned)(R * K + C) * 2u; voffB[i] = (unsigned)(Rb * K + C) * 2u; }
    const size_t kstep = (size_t)(BK * 2);
    const size_t hstep = (size_t)HALF * K * 2;
    const size_t tstep = 2 * hstep;
    const unsigned ldsw = (unsigned)wid * 1024u;
    const int aoff = lds_byte(wr * 64 + fr, fq * 8), boff = lds_byte(wc * 32 + fr, fq * 8);
#define PG8_SA(b, h) (((b) * 2 + (h)) * HTB)
#define PG8_SB(b, h) ((4 + (b) * 2 + (h)) * HTB)
#define PG8_STAGE(bufoff, gbase, voff) do { _Pragma("unroll") for (int _i = 0; _i < 2; ++_i) \
        __builtin_amdgcn_global_load_lds((const unsigned*)((const char*)(gbase) + (voff)[_i]), (PG8_LAS unsigned*)(lds + (bufoff) + ldsw + _i * 8192), 16, 0, 0); } while (0)
#define PG8_LDA(dst, b, h) do { _Pragma("unroll") for (int m = 0; m < 4; ++m) _Pragma("unroll") for (int k = 0; k < 2; ++k) dst[m][k] = *(const PG8_LAS bf16x8*)(lds + PG8_SA(b, h) + aoff + m * 2048 + k * 1024); } while (0)
#define PG8_LDB(dst, b, h) do { _Pragma("unroll") for (int n = 0; n < 2; ++n) _Pragma("unroll") for (int k = 0; k < 2; ++k) dst[n][k] = *(const PG8_LAS bf16x8*)(lds + PG8_SB(b, h) + boff + n * 2048 + k * 1024); } while (0)
#define PG8_MMA(ai, bj, At, Bt) do { __builtin_amdgcn_s_setprio(1); _Pragma("unroll") for (int m = 0; m < 4; ++m) _Pragma("unroll") for (int n = 0; n < 2; ++n) _Pragma("unroll") for (int k = 0; k < 2; ++k) \
        acc[ai][bj][m][n] = __builtin_amdgcn_mfma_f32_16x16x32_bf16(Bt[n][k], At[m][k], acc[ai][bj][m][n], 0, 0, 0); __builtin_amdgcn_s_setprio(0); } while (0)
#define PG8_WAIT_V(n) asm volatile("s_waitcnt vmcnt(" #n ")" ::: "memory")
#define PG8_WAIT_L(n) asm volatile("s_waitcnt lgkmcnt(" #n ")" ::: "memory")
#define PG8_BAR __builtin_amdgcn_s_barrier()
#define PG8_SCHED __builtin_amdgcn_sched_barrier(0)
    Unit cur, nxt; int ui = 0;
    if (!S.next(0, cur)) return;
    f32x4 acc[2][2][4][2];
#pragma unroll
    for (int a = 0; a < 2; ++a)
#pragma unroll
        for (int b = 0; b < 2; ++b)
#pragma unroll
            for (int m = 0; m < 4; ++m)
#pragma unroll
                for (int n = 0; n < 2; ++n) acc[a][b][m][n] = (f32x4){0.f, 0.f, 0.f, 0.f};
    bf16x8 At[4][2], B0[2][2], B1[2][2];
    const char* cA = (const char*)g.A + (size_t)cur.pm * tstep; const char* cB = (const char*)g.Bt + (size_t)cur.pn * tstep;
    S.a_ready(cur);
    if constexpr (SP2) {
        PG8_STAGE(PG8_SB(0, 0), cB, voffB); PG8_STAGE(PG8_SB(0, 1), cB + hstep, voffB); PG8_STAGE(PG8_SA(0, 0), cA, voffA); PG8_STAGE(PG8_SA(0, 1), cA + hstep, voffA);
        if (wr == 1) PG8_BAR;
        PG8_WAIT_V(2); PG8_BAR;
        PG8_STAGE(PG8_SB(1, 0), cB + kstep, voffB); PG8_STAGE(PG8_SA(1, 0), cA + kstep, voffA); PG8_STAGE(PG8_SB(1, 1), cB + hstep + kstep, voffB);
        PG8_WAIT_V(6); PG8_BAR;
    } else {
        PG8_STAGE(PG8_SB(0, 0), cB, voffB); PG8_STAGE(PG8_SA(0, 0), cA, voffA); PG8_STAGE(PG8_SB(0, 1), cB + hstep, voffB); PG8_STAGE(PG8_SA(0, 1), cA + hstep, voffA);
        if (wr == 1) PG8_BAR;
        PG8_WAIT_V(4); PG8_BAR;
        PG8_STAGE(PG8_SB(1, 0), cB + kstep, voffB); PG8_STAGE(PG8_SA(1, 0), cA + kstep, voffA); PG8_STAGE(PG8_SB(1, 1), cB + hstep + kstep, voffB);
        PG8_WAIT_V(6); PG8_BAR;
    }
    for (;;) {
        const bool has_next = S.next(ui + 1, nxt);
        const char* nA = has_next ? (const char*)g.A + (size_t)nxt.pm * tstep : cA; const char* nB = has_next ? (const char*)g.Bt + (size_t)nxt.pn * tstep : cB;
        for (int t = 0; t < nt; t += 2) {
            const bool last = (t == nt - 2);
            const char* a1 = cA + (size_t)(t + 1) * kstep;
            const char* a2 = last ? nA : cA + (size_t)(t + 2) * kstep; const char* b2 = last ? nB : cB + (size_t)(t + 2) * kstep;
            const char* a3 = a2 + kstep; const char* b3 = b2 + kstep;
            if (last && has_next) S.a_ready(nxt);
            if constexpr (SP2) {
            PG8_LDB(B0, 0, 0); PG8_LDB(B1, 0, 1); PG8_SCHED; PG8_LDA(At, 0, 0); PG8_STAGE(PG8_SA(1, 1), a1 + hstep, voffA);
            PG8_WAIT_V(8); PG8_WAIT_L(0); PG8_BAR; PG8_MMA(0, 0, At, B0); PG8_MMA(0, 1, At, B1); PG8_BAR; PG8_SCHED;
            PG8_LDA(At, 0, 1); PG8_STAGE(PG8_SB(0, 0), b2, voffB); PG8_STAGE(PG8_SB(0, 1), b2 + hstep, voffB); PG8_STAGE(PG8_SA(0, 0), a2, voffA);
            PG8_WAIT_V(8); PG8_WAIT_L(0); PG8_BAR; PG8_MMA(1, 0, At, B0); PG8_MMA(1, 1, At, B1); PG8_BAR; PG8_SCHED;
            PG8_LDB(B0, 1, 0); PG8_LDB(B1, 1, 1); PG8_SCHED; PG8_LDA(At, 1, 0); PG8_STAGE(PG8_SA(0, 1), a2 + hstep, voffA);
            PG8_WAIT_V(8); PG8_WAIT_L(0); PG8_BAR; PG8_MMA(0, 0, At, B0); PG8_MMA(0, 1, At, B1); PG8_BAR; PG8_SCHED;
            PG8_LDA(At, 1, 1); PG8_STAGE(PG8_SB(1, 0), b3, voffB); PG8_STAGE(PG8_SB(1, 1), b3 + hstep, voffB); PG8_STAGE(PG8_SA(1, 0), a3, voffA);
            PG8_WAIT_V(8); PG8_WAIT_L(0); PG8_BAR; PG8_MMA(1, 0, At, B0); PG8_MMA(1, 1, At, B1); PG8_BAR; PG8_SCHED;
            } else {
            PG8_LDB(B0, 0, 0); PG8_SCHED; PG8_LDA(At, 0, 0); PG8_STAGE(PG8_SA(1, 1), a1 + hstep, voffA);
            PG8_WAIT_L(8); PG8_BAR; PG8_WAIT_L(0); PG8_MMA(0, 0, At, B0); PG8_BAR; PG8_SCHED;
            PG8_LDB(B1, 0, 1); PG8_STAGE(PG8_SB(0, 0), b2, voffB);
            PG8_BAR; PG8_WAIT_L(0); PG8_MMA(0, 1, At, B1); PG8_BAR;
            PG8_LDA(At, 0, 1); PG8_STAGE(PG8_SA(0, 0), a2, voffA);
            PG8_BAR; PG8_WAIT_L(0); PG8_MMA(1, 0, At, B0); PG8_BAR; PG8_SCHED;
            PG8_STAGE(PG8_SB(0, 1), b2 + hstep, voffB);
            PG8_WAIT_V(6); PG8_BAR; PG8_MMA(1, 1, At, B1); PG8_BAR;
            PG8_LDB(B0, 1, 0); PG8_SCHED; PG8_LDA(At, 1, 0); PG8_STAGE(PG8_SA(0, 1), a2 + hstep, voffA);
            PG8_WAIT_L(8); PG8_BAR; PG8_WAIT_L(0); PG8_MMA(0, 0, At, B0); PG8_BAR; PG8_SCHED;
            PG8_LDB(B1, 1, 1); PG8_STAGE(PG8_SB(1, 0), b3, voffB);
            PG8_BAR; PG8_WAIT_L(0); PG8_MMA(0, 1, At, B1); PG8_BAR;
            PG8_LDA(At, 1, 1); PG8_STAGE(PG8_SA(1, 0), a3, voffA);
            PG8_BAR; PG8_WAIT_L(0); PG8_MMA(1, 0, At, B0); PG8_BAR; PG8_SCHED;
            PG8_STAGE(PG8_SB(1, 1), b3 + hstep, voffB);
            PG8_WAIT_V(6); PG8_BAR; PG8_MMA(1, 1, At, B1); PG8_BAR;
            }
        }
        if constexpr (ALIGN_EPI) { if (wr == 0) PG8_BAR; }
        if constexpr (!Epi::AFTER_DRAIN) { E(acc, cur, wr, wc, fr, fq); S.done(cur); }
        if (!has_next) break;
#pragma unroll
        for (int a = 0; a < 2; ++a)
#pragma unroll
            for (int b = 0; b < 2; ++b)
#pragma unroll
                for (int m = 0; m < 4; ++m)
#pragma unroll
                    for (int n = 0; n < 2; ++n) acc[a][b][m][n] = (f32x4){0.f, 0.f, 0.f, 0.f};
        cur = nxt; cA = nA; cB = nB; ++ui;
        if constexpr (ALIGN_EPI) { if (wr == 1) PG8_BAR; }
    }
    PG8_WAIT_V(0);
    if constexpr (!ALIGN_EPI) { if (wr == 0) PG8_BAR; }
    PG8_BAR;
    if constexpr (Epi::AFTER_DRAIN) { E.fused(acc, cur, wr, wc, fr, fq, lds, wid, lane); S.done(cur); }
#undef PG8_SA
#undef PG8_SB
#undef PG8_STAGE
#undef PG8_LDA
#undef PG8_LDB
#undef PG8_MMA
#undef PG8_WAIT_V
#undef PG8_WAIT_L
#undef PG8_BAR
#undef PG8_SCHED
}
}
#define GAS __attribute__((address_space(1)))
#define LAS __attribute__((address_space(3)))
typedef unsigned short bf16;
typedef unsigned v4u __attribute__((ext_vector_type(4)));
typedef float f32x4 __attribute__((ext_vector_type(4)));
typedef short bf16x8 __attribute__((ext_vector_type(8)));
typedef GAS unsigned gu32;
typedef GAS unsigned long long gu64;
#define RLX_AGENT __ATOMIC_RELAXED, __HIP_MEMORY_SCOPE_AGENT
#define LDS_WAIT() asm volatile("s_waitcnt lgkmcnt(0)" ::: "memory")
#define VM_WAIT() asm volatile("s_waitcnt vmcnt(0)" ::: "memory")
__device__ __forceinline__ unsigned long long rt() { return __builtin_amdgcn_s_memrealtime(); }
__device__ __forceinline__ unsigned f2bf(float f) { unsigned u = __builtin_bit_cast(unsigned, f); return (u + 0x7fffu + ((u >> 16) & 1u)) >> 16; }
__device__ __forceinline__ unsigned pk2(float lo, float hi) { return f2bf(lo) | (f2bf(hi) << 16); }

#define XB_TMO      128
#define XB_XCNT(j)  (256  + 64 * (j))
#define XB_XSUB(j)  (1280 + 64 * (j))
#define XB_XGEN(j)  (2304 + 64 * (j))
#define XB_TOP      3328
#define XB_TOPGEN   3392
#define XCD_BAR_WORDS 3456
#define XB_SPIN_CAP (1u << 18)

__device__ __forceinline__ unsigned xb_ld(unsigned* p)              { return __hip_atomic_load(p, __ATOMIC_RELAXED, __HIP_MEMORY_SCOPE_AGENT); }
__device__ __forceinline__ unsigned xb_add(unsigned* p, unsigned v) { return __hip_atomic_fetch_add(p, v, __ATOMIC_RELAXED, __HIP_MEMORY_SCOPE_AGENT); }
__device__ __forceinline__ unsigned xb_xcc_id() { return (unsigned)__builtin_amdgcn_s_getreg((3 << 11) | 20) & 0xFu; }
#define XB_SPIN(cond, bar) do { unsigned _sp = 0; while (cond) { __builtin_amdgcn_s_sleep(1); \
    if ((++_sp & 255u) == 0u) { if (xb_ld(&(bar)[XB_TMO])) break; if (_sp > XB_SPIN_CAP) { atomicAdd(&(bar)[XB_TMO], 1u); break; } } } } while (0)

struct XcdBarrier {
    unsigned* bar; unsigned x;
    volatile LAS unsigned* st;
};

__device__ __forceinline__ XcdBarrier xcd_barrier_post(unsigned* bar, volatile LAS unsigned* st) {
    XcdBarrier b; b.bar = bar; b.x = xb_xcc_id(); b.st = st;
    if (threadIdx.x == 0) (void)xb_add(&bar[XB_XCNT(b.x)], 1u);
    return b;
}
__device__ __forceinline__ void xcd_barrier_complete(unsigned* bar, unsigned x, unsigned& nloc, unsigned& nx) {
    const unsigned G = gridDim.x * gridDim.y * gridDim.z;
    unsigned sum, cnt, mine, sp = 0u;
    for (;;) {
        sum = 0u; cnt = 0u; mine = 0u;
#pragma unroll
        for (unsigned j = 0; j < 16; ++j) { const unsigned c = xb_ld(&bar[XB_XCNT(j)]); sum += c; cnt += (c > 0u) ? 1u : 0u; mine = (j == x) ? c : mine; }
        if (sum == G) break;
        __builtin_amdgcn_s_sleep(1);
        if ((++sp & 255u) == 0u) { if (xb_ld(&bar[XB_TMO])) break; if (sp > XB_SPIN_CAP) { atomicAdd(&bar[XB_TMO], 1u); break; } }
    }
    nloc = mine > 0u ? mine : 1u; nx = cnt > 0u ? cnt : 1u;
}

__device__ __forceinline__ void xcd_barrier(const XcdBarrier& b) {
    asm volatile("s_waitcnt vmcnt(0)" ::: "memory");
    __syncthreads();
    if (threadIdx.x == 0) {
        unsigned* bar = b.bar;
        __builtin_amdgcn_s_waitcnt(0);
        unsigned nloc = b.st[0], nx = b.st[1];
        if (nloc == 0u) { xcd_barrier_complete(bar, b.x, nloc, nx); b.st[0] = nloc; b.st[1] = nx; }
        const unsigned old = xb_add(&bar[XB_XSUB(b.x)], 1u);
        const unsigned gen = old / nloc;
        if (old + 1u == (gen + 1u) * nloc) {
            __builtin_amdgcn_fence(__ATOMIC_RELEASE, "agent");
            asm volatile("s_waitcnt vmcnt(0)" ::: "memory");
            const unsigned og = xb_add(&bar[XB_TOP], 1u);
            const unsigned tg = og / nx;
            if (og + 1u == (tg + 1u) * nx) xb_add(&bar[XB_TOPGEN], 1u);
            else XB_SPIN(xb_ld(&bar[XB_TOPGEN]) == tg, bar);
            __builtin_amdgcn_fence(__ATOMIC_ACQUIRE, "agent");
            xb_add(&bar[XB_XGEN(b.x)], 1u);
            asm volatile("s_waitcnt vmcnt(0)" ::: "memory");
        } else {
            XB_SPIN(xb_ld(&bar[XB_XGEN(b.x)]) == gen, bar);
            __builtin_amdgcn_fence(__ATOMIC_ACQUIRE, "agent");
            asm volatile("s_waitcnt vmcnt(0)" ::: "memory");
        }
    }
    __syncthreads();
}

constexpr int S = 16384, DM = 1024, NH = 8, HD = 128, MBLK = 256, NBLK = S / MBLK, DFF = 2816, INTOT = 9232;
constexpr int CH = 64, NCH = S / CH;
constexpr float EPS = 1e-6f;
constexpr int NWAVES = 8;

constexpr size_t MiB = 1u << 20;
constexpr size_t WS_CTL = 0, CTL_ZERO_BYTES = 1 * MiB;
constexpr size_t WS_COS = 1 * MiB, WS_SIN = 2 * MiB;
constexpr size_t WS_BA = 3 * MiB;
constexpr size_t WS_KMEAN = 4 * MiB;
constexpr size_t WS_TOPI = 5 * MiB;
constexpr size_t WS_BETA = 6 * MiB + 512 * 1024, WS_G = 7 * MiB, WS_GC = 7 * MiB + 512 * 1024;
constexpr size_t WS_WTA = 8 * MiB, WS_WTB = 14 * MiB, WS_WTG = 22 * MiB, WS_WTOA = 26 * MiB, WS_WTOD = 28 * MiB, WS_WTOUT = 30 * MiB, WS_WTGU = 32 * MiB, WS_WTDN = 43 * MiB;
constexpr size_t WS_H = 49 * MiB;
constexpr size_t WS_R1 = 81 * MiB;
constexpr size_t WS_Z = 177 * MiB, WS_YA = 209 * MiB, WS_END = 256 * MiB;
constexpr size_t ACT_BYTES = (size_t)S * DFF * 2;
constexpr size_t T32 = (size_t)S * DM * 2;
static_assert(WS_WTDN + (size_t)DM * DFF * 2 <= WS_H && WS_YA + T32 <= WS_END && WS_R1 + 3 * T32 == WS_Z, "ws map");
constexpr size_t WS_VN = WS_H;
constexpr size_t WS_W = WS_R1, WS_ATT = WS_R1 + T32, WS_O = WS_R1 + T32 + 16 * MiB, WS_YD = WS_R1;
constexpr size_t WS_T = 113 * MiB, WS_H2 = WS_H, WS_ACT = 81 * MiB, WS_F = 169 * MiB;
static_assert(WS_ACT + ACT_BYTES <= WS_F && WS_F + 2 * T32 <= WS_END && WS_O + T32 <= WS_Z && WS_T + 2 * T32 <= WS_Z, "overlay map");
constexpr int CW_BAR = 4096;

constexpr int RING_OFF = 0, RING_BYTES = 131072;
constexpr int LDSCTL_OFF = RING_BYTES, MISC_OFF = LDSCTL_OFF + 320;
constexpr int LDS_BYTES = 147456;

typedef unsigned u32x4 __attribute__((ext_vector_type(4)));
typedef unsigned u32x2 __attribute__((ext_vector_type(2)));

__device__ __forceinline__ float bflo(unsigned u) { return __builtin_bit_cast(float, u << 16); }
__device__ __forceinline__ float bfhi(unsigned u) { return __builtin_bit_cast(float, u & 0xffff0000u); }
__device__ __forceinline__ float bf2f(bf16 b) { return __builtin_bit_cast(float, ((unsigned)b) << 16); }
__device__ __forceinline__ float wave_sum(float v) {
#pragma unroll
    for (int o = 1; o < 64; o <<= 1) v += __shfl_xor(v, o);
    return v;
}
__device__ __forceinline__ float wave_max(float v) {
#pragma unroll
    for (int o = 1; o < 64; o <<= 1) v = fmaxf(v, __shfl_xor(v, o));
    return v;
}
__device__ __forceinline__ float sigmoidf_(float x) { return 1.f / (1.f + __expf(-x)); }
__device__ __forceinline__ float siluf_(float x) { return x / (1.f + __expf(-x)); }

namespace pg8 {
struct EpiRope {
    static constexpr bool PERM = false, AFTER_DRAIN = false;
    bf16_t* base; const float* cosT; const float* sinT;
    __device__ __forceinline__ void operator()(const f32x4 (&acc)[2][2][4][2], const Unit& u, int wr, int wc, int fr, int fq) const {
        const int t = u.pn >> 2, pnl = u.pn & 3;
        bf16_t* ob = base + (size_t)t * ((size_t)S * DM);
        const bool rope = (t < 2) && (wc == 0);
#pragma unroll
        for (int ai = 0; ai < 2; ++ai)
#pragma unroll
            for (int m = 0; m < 4; ++m) {
                const int row = u.pm * BM + ai * HALF + wr * 64 + m * 16 + fr;
                f32x4 cv = (f32x4){1.f, 1.f, 1.f, 1.f}, sv = (f32x4){0.f, 0.f, 0.f, 0.f};
                if (rope) { cv = *(const f32x4*)(cosT + (size_t)row * 16 + 4 * fq); sv = *(const f32x4*)(sinT + (size_t)row * 16 + 4 * fq); }
#pragma unroll
                for (int bj = 0; bj < 2; ++bj) {
                    f32x4 v0 = acc[ai][bj][m][0], v1 = acc[ai][bj][m][1];
                    if (rope) { const f32x4 n0 = v0 * cv - v1 * sv, n1 = v1 * cv + v0 * sv; v0 = n0; v1 = n1; }
                    bf16_t* p = ob + (size_t)row * DM + pnl * 256 + bj * HALF + wc * 32 + 4 * fq;
                    u32x2 w0, w1; w0.x = cvt_pk_bf16(v0[0], v0[1]); w0.y = cvt_pk_bf16(v0[2], v0[3]); w1.x = cvt_pk_bf16(v1[0], v1[1]); w1.y = cvt_pk_bf16(v1[2], v1[3]);
                    *(u32x2*)p = w0; *(u32x2*)(p + 16) = w1;
                }
            }
    }
};
template <int MODE> struct EpiGen {
    static constexpr bool PERM = true, AFTER_DRAIN = false;
    bf16_t* O; int ldc; int split_cols; size_t split_stride; const bf16_t* G2;
    __device__ __forceinline__ static void unpack8(const u32x4 w, float (&f)[8]) {
        f[0] = bflo(w.x); f[1] = bfhi(w.x); f[2] = bflo(w.y); f[3] = bfhi(w.y); f[4] = bflo(w.z); f[5] = bfhi(w.z); f[6] = bflo(w.w); f[7] = bfhi(w.w);
    }
    __device__ __forceinline__ void operator()(const f32x4 (&acc)[2][2][4][2], const Unit& u, int wr, int wc, int fr, int fq) const {
        const int row0 = u.pm * BM + wr * 64 + fr; int colt = u.pn * BM; bf16_t* base = O; const bf16_t* g2 = G2;
        if (split_cols) { const int t = colt / split_cols; base += (size_t)t * split_stride; colt -= t * split_cols; }
#pragma unroll
        for (int ai = 0; ai < 2; ++ai)
#pragma unroll
            for (int m = 0; m < 4; ++m) {
                const int row = row0 + ai * HALF + m * 16;
                if constexpr (MODE == 4) {
                    const f32x4 g0 = acc[ai][0][m][0], g1 = acc[ai][0][m][1], u0 = acc[ai][1][m][0], u1 = acc[ai][1][m][1];
                    float r[8];
#pragma unroll
                    for (int e = 0; e < 4; ++e) { r[e] = siluf_(g0[e]) * u0[e]; r[4 + e] = siluf_(g1[e]) * u1[e]; }
                    u32x4 w; w.x = cvt_pk_bf16(r[0], r[1]); w.y = cvt_pk_bf16(r[2], r[3]); w.z = cvt_pk_bf16(r[4], r[5]); w.w = cvt_pk_bf16(r[6], r[7]);
                    *(u32x4*)(base + (size_t)row * ldc + u.pn * HALF + wc * 32 + 8 * fq) = w;
                } else {
#pragma unroll
                    for (int bj = 0; bj < 2; ++bj) {
                        const f32x4 v0 = acc[ai][bj][m][0], v1 = acc[ai][bj][m][1];
                        float r[8] = {v0[0], v0[1], v0[2], v0[3], v1[0], v1[1], v1[2], v1[3]};
                        bf16_t* p = base + (size_t)row * ldc + colt + bj * HALF + wc * 32 + 8 * fq;
                        if constexpr (MODE == 1) {
#pragma unroll
                            for (int e = 0; e < 8; ++e) r[e] = sigmoidf_(r[e]);
                        }
                        if constexpr (MODE == 2) { float g[8]; unpack8(*(const u32x4*)p, g);
#pragma unroll
                            for (int e = 0; e < 8; ++e) r[e] = r[e] * g[e]; }
                        if constexpr (MODE == 3) { float g[8], o[8]; unpack8(*(const u32x4*)(g2 + (size_t)row * ldc + colt + bj * HALF + wc * 32 + 8 * fq), g); unpack8(*(const u32x4*)p, o);
#pragma unroll
                            for (int e = 0; e < 8; ++e) r[e] = o[e] + r[e] * g[e]; }
                        u32x4 w; w.x = cvt_pk_bf16(r[0], r[1]); w.y = cvt_pk_bf16(r[2], r[3]); w.z = cvt_pk_bf16(r[4], r[5]); w.w = cvt_pk_bf16(r[6], r[7]);
                        *(u32x4*)p = w;
                    }
                }
            }
    }
};
struct EpiF32 {
    static constexpr bool PERM = false, AFTER_DRAIN = false;
    float* C; int ldc;
    __device__ __forceinline__ void operator()(const f32x4 (&acc)[2][2][4][2], const Unit& u, int wr, int wc, int fr, int fq) const {
        const int row0 = u.pm * BM + wr * 64 + fr, col0 = u.pn * BM + wc * 32 + 4 * fq;
#pragma unroll
        for (int ai = 0; ai < 2; ++ai)
#pragma unroll
            for (int m = 0; m < 4; ++m) { float* rowp = C + (size_t)(row0 + ai * HALF + m * 16) * ldc + col0;
#pragma unroll
                for (int bj = 0; bj < 2; ++bj)
#pragma unroll
                    for (int n = 0; n < 2; ++n) *(f32x4*)(rowp + bj * HALF + n * 16) = acc[ai][bj][m][n]; }
    }
};
}

struct Args { const float* in[16]; float* out; unsigned char* ws; int ph_lo, ph_hi; };
struct Frame {
    LAS unsigned char* lds;
    volatile LAS unsigned* MISC;
    int tid, lane, wave, G, gw, NGW;
    float* out; unsigned char* ws;
};
#define WSP(T, off) ((T*)(F.ws + (off)))

__device__ __forceinline__ void tr_item(const float* W, int ldw, int scol0, int k0, bf16* WT, int K, int drow0, LAS float* scr, int lane) {
#pragma unroll 8
    for (int i = 0; i < 32; ++i) { const int kk = 2 * i + (lane >> 5); scr[kk * 33 + (lane & 31)] = W[(size_t)(k0 + kk) * ldw + scol0 + (lane & 31)]; }
    LDS_WAIT(); asm volatile("" ::: "memory");
    const int c = lane & 7;
#pragma unroll
    for (int j = 0; j < 4; ++j) { const int n = (lane >> 3) + 8 * j; const LAS float* s = scr + (8 * c) * 33 + n;
        v4u o; o.x = pk2(s[0 * 33], s[1 * 33]); o.y = pk2(s[2 * 33], s[3 * 33]); o.z = pk2(s[4 * 33], s[5 * 33]); o.w = pk2(s[6 * 33], s[7 * 33]);
        *(GAS v4u*)(WT + (size_t)(drow0 + n) * K + k0 + 8 * c) = o; }
    LDS_WAIT(); asm volatile("" ::: "memory");
}
__device__ __forceinline__ void rms_row_bf16(const float* xrow, const float* w, bf16* orow, int lane, f32x4 (&hv)[4]) {
    const f32x4* xr = (const f32x4*)xrow + lane; const f32x4* wr = (const f32x4*)w + lane;
    float ss = 0.f;
#pragma unroll
    for (int j = 0; j < 4; ++j) { hv[j] = xr[64 * j]; ss += (hv[j].x * hv[j].x + hv[j].y * hv[j].y) + (hv[j].z * hv[j].z + hv[j].w * hv[j].w); }
    const float rs = 1.f / sqrtf(wave_sum(ss) * (1.f / DM) + EPS);
    unsigned long long* o8 = (unsigned long long*)orow + lane;
#pragma unroll
    for (int j = 0; j < 4; ++j) { const f32x4 wv = wr[64 * j]; hv[j] = hv[j] * rs * wv;
        o8[64 * j] = (unsigned long long)pk2(hv[j].x, hv[j].y) | ((unsigned long long)pk2(hv[j].z, hv[j].w) << 32); }
}
__device__ __forceinline__ void p_prologue(Frame& F, const Args& A) {
    LAS float* scr = (LAS float*)(F.lds + RING_OFF + F.wave * 16384);
    const float* w_in = A.in[2];
    constexpr int I_A = 16 * 96, I_B = 16 * 128, I_G = 16 * 64, I_O = 16 * 32, I_GU = 16 * 88, I_DN = 44 * 32;
    constexpr int NITEMS = I_A + I_B + I_G + 3 * I_O + 2 * I_GU + I_DN;
    for (int it = F.gw; it < NITEMS; it += F.NGW) {
        int r = it; const float* W; int ldw, scol, nbn, K = DM, dmode = 0; size_t dst;
        if (r < I_A) { W = w_in; ldw = INTOT; scol = 0; nbn = 96; dst = WS_WTA; }
        else if ((r -= I_A) < I_B) { W = w_in; ldw = INTOT; scol = 3072; nbn = 128; dst = WS_WTB; }
        else if ((r -= I_B) < I_G) { W = w_in; ldw = INTOT; scol = 7184; nbn = 64; dst = WS_WTG; }
        else if ((r -= I_G) < I_O) { W = A.in[7]; ldw = DM; scol = 0; nbn = 32; dst = WS_WTOA; }
        else if ((r -= I_O) < I_O) { W = A.in[8]; ldw = DM; scol = 0; nbn = 32; dst = WS_WTOD; }
        else if ((r -= I_O) < I_O) { W = A.in[9]; ldw = DM; scol = 0; nbn = 32; dst = WS_WTOUT; }
        else if ((r -= I_O) < I_GU) { W = A.in[12]; ldw = DFF; scol = 0; nbn = 88; dst = WS_WTGU; dmode = 1; }
        else if ((r -= I_GU) < I_GU) { W = A.in[13]; ldw = DFF; scol = 0; nbn = 88; dst = WS_WTGU; dmode = 2; }
        else { r -= I_GU; W = A.in[14]; ldw = DM; scol = 0; nbn = 32; dst = WS_WTDN; K = DFF; }
        const int kb = r / nbn, nb = r % nbn, n0 = 32 * nb;
        const int drow0 = (dmode == 0) ? n0 : 256 * (n0 / 128) + (n0 % 128) + (dmode == 2 ? 128 : 0);
        tr_item(W, ldw, scol + n0, 64 * kb, WSP(bf16, dst), K, drow0, scr, F.lane);
    }
    { float* cosT = WSP(float, WS_COS); float* sinT = WSP(float, WS_SIN);
      for (int i = F.gw * 64 + F.lane; i < S * 16; i += F.NGW * 64) { const int pos = i >> 4, k = i & 15;
          const float inv = (float)pow(500000.0, -(double)k / 16.0); const float ang = (float)pos * inv;
          cosT[i] = cosf(ang); sinT[i] = sinf(ang); } }
    { const float* x = A.in[0]; bf16* H = WSP(bf16, WS_H); float* BA = WSP(float, WS_BA);
      LAS float* wl = (LAS float*)F.lds; LAS float* hl = (LAS float*)(F.lds + 67584) + F.wave * 1024;
      __syncthreads();
      for (int i = F.tid; i < 4096; i += NWAVES * 64) { const int k = i >> 2, q = i & 3; const f32x4 v = *(const f32x4*)(w_in + (size_t)k * INTOT + 7168 + 4 * q);
          *(LAS f32x4*)(wl + (k >> 8) * 4112 + (k & 255) * 16 + 4 * q) = v; }
      __syncthreads();
      const int c = F.lane & 15, kq = F.lane >> 4; const LAS float* wq = wl + kq * 4112 + c; const LAS float* hq = hl + kq * 256;
      for (int m = F.gw; m < S; m += F.NGW) {
          f32x4 hv[4]; rms_row_bf16(x + (size_t)m * DM, A.in[1], H + (size_t)m * DM, F.lane, hv);
#pragma unroll
          for (int j = 0; j < 4; ++j) *(LAS f32x4*)(hl + 4 * (F.lane + 64 * j)) = hv[j];
          asm volatile("s_waitcnt lgkmcnt(0)" ::: "memory");
          float acc = 0.f;
#pragma unroll 8
          for (int kk = 0; kk < 256; ++kk) acc += hq[kk] * wq[kk * 16];
          acc += __shfl_xor(acc, 16); acc += __shfl_xor(acc, 32);
          if (F.lane < 16) BA[(size_t)m * 16 + F.lane] = acc;
          asm volatile("s_waitcnt lgkmcnt(0)" ::: "memory");
      }
      __syncthreads(); }
}
__device__ __forceinline__ void p_hrecompute(Frame& F, const Args& A) {
    const float* x = A.in[0]; bf16* H = WSP(bf16, WS_H);
    for (int m = F.gw; m < S; m += F.NGW) { f32x4 hv[4]; rms_row_bf16(x + (size_t)m * DM, A.in[1], H + (size_t)m * DM, F.lane, hv); }
}

__device__ __forceinline__ void p_kmean(Frame& F, const Args& A) {
    const bf16* KA = WSP(bf16, WS_R1 + T32); float* KM = WSP(float, WS_KMEAN);
    for (int it = F.gw; it < NBLK * NH; it += F.NGW) { const int blk = it >> 3, h = it & 7;
        float s0 = 0.f, s1 = 0.f; const bf16* p = KA + (size_t)(blk * MBLK) * DM + h * HD + 2 * F.lane;
        for (int r = 0; r < MBLK; ++r) { const unsigned v = *(const unsigned*)(p + (size_t)r * DM); s0 += bflo(v); s1 += bfhi(v); }
        KM[(size_t)it * HD + 2 * F.lane] = s0 * (1.f / MBLK); KM[(size_t)it * HD + 2 * F.lane + 1] = s1 * (1.f / MBLK); }
}
__device__ __forceinline__ void p_topk(Frame& F, const Args& A) {
    const bf16* QA = WSP(bf16, WS_R1); const float* KM = WSP(float, WS_KMEAN); int* TOPI = WSP(int, WS_TOPI);
    for (int it = F.gw; it < S * NH; it += F.NGW) { const int q = it >> 3, h = it & 7, qblk = q >> 8;
        float g = -INFINITY;
        if (F.lane < qblk) { const bf16* qp = QA + (size_t)q * DM + h * HD; const float* kp = KM + ((size_t)F.lane * NH + h) * HD; float a = 0.f;
#pragma unroll
            for (int c = 0; c < 16; ++c) { const u32x4 qv = *(const u32x4*)(qp + 8 * c); const f32x4 k0 = *(const f32x4*)(kp + 8 * c), k1 = *(const f32x4*)(kp + 8 * c + 4);
                a += bflo(qv.x) * k0.x + bfhi(qv.x) * k0.y + bflo(qv.y) * k0.z + bfhi(qv.y) * k0.w + bflo(qv.z) * k1.x + bfhi(qv.z) * k1.y + bflo(qv.w) * k1.z + bfhi(qv.w) * k1.w; }
            g = a; }
        int res = -1;
#pragma unroll
        for (int r = 0; r < 3; ++r) { float v = g; int i = F.lane;
#pragma unroll
            for (int o = 1; o < 64; o <<= 1) { const float ov = __shfl_xor(v, o); const int oi = __shfl_xor(i, o); if (ov > v || (ov == v && oi < i)) { v = ov; i = oi; } }
            if (F.lane == r) res = (r < qblk) ? i : -1;
            if (F.lane == i) g = -INFINITY; }
        if (F.lane < 3) TOPI[(size_t)it * 3 + F.lane] = res; }
}
__device__ __forceinline__ void p_attn_naive(Frame& F, const Args& A) {
    const bf16* QA = WSP(bf16, WS_R1); const bf16* KA = WSP(bf16, WS_R1 + T32); const bf16* VA = WSP(bf16, WS_R1 + 2 * T32); const int* TOPI = WSP(int, WS_TOPI); bf16* YA = WSP(bf16, WS_YA);
    for (int it = F.gw; it < S * NH; it += F.NGW) { const int q = it >> 3, h = it & 7, qblk = q >> 8;
        const bf16* qp = QA + (size_t)q * DM + h * HD;
        float m = -INFINITY, l = 0.f, o0 = 0.f, o1 = 0.f;
        for (int slot = 0; slot < 4; ++slot) {
            int kb = qblk; if (slot < 3) { kb = TOPI[(size_t)it * 3 + slot]; if (kb < 0) continue; }
            const bf16* kp = KA + (size_t)(kb * MBLK) * DM + h * HD; const bf16* vp = VA + (size_t)(kb * MBLK) * DM + h * HD;
            float s[4] = {0.f, 0.f, 0.f, 0.f};
#pragma unroll 4
            for (int c = 0; c < 16; ++c) { const u32x4 qv = *(const u32x4*)(qp + 8 * c);
                const float q0 = bflo(qv.x), q1 = bfhi(qv.x), q2 = bflo(qv.y), q3 = bfhi(qv.y), q4 = bflo(qv.z), q5 = bfhi(qv.z), q6 = bflo(qv.w), q7 = bfhi(qv.w);
#pragma unroll
                for (int jj = 0; jj < 4; ++jj) { const u32x4 kv = *(const u32x4*)(kp + (size_t)(F.lane + 64 * jj) * DM + 8 * c);
                    s[jj] += q0 * bflo(kv.x) + q1 * bfhi(kv.x) + q2 * bflo(kv.y) + q3 * bfhi(kv.y) + q4 * bflo(kv.z) + q5 * bfhi(kv.z) + q6 * bflo(kv.w) + q7 * bfhi(kv.w); } }
            float mx = -INFINITY;
#pragma unroll
            for (int jj = 0; jj < 4; ++jj) { s[jj] *= 0.08838834764831845f; if (slot == 3 && (kb * MBLK + F.lane + 64 * jj) > q) s[jj] = -INFINITY; mx = fmaxf(mx, s[jj]); }
            mx = wave_max(mx);
            const float mn = fmaxf(m, mx), sc = __expf(m - mn);
            float p[4], ps = 0.f;
#pragma unroll
            for (int jj = 0; jj < 4; ++jj) { p[jj] = __expf(s[jj] - mn); ps += p[jj]; }
            l = l * sc + wave_sum(ps); o0 *= sc; o1 *= sc; m = mn;
#pragma unroll
            for (int jj = 0; jj < 4; ++jj)
                for (int ln = 0; ln < 64; ++ln) { const float pj = __shfl(p[jj], ln); const unsigned vv = *(const unsigned*)(vp + (size_t)(ln + 64 * jj) * DM + 2 * F.lane); o0 += pj * bflo(vv); o1 += pj * bfhi(vv); }
        }
        const float il = 1.f / l;
        *(unsigned*)(YA + (size_t)q * DM + h * HD + 2 * F.lane) = pk2(o0 * il, o1 * il); }
}

__device__ __forceinline__ void p_dn_conv(Frame& F, const Args& A) {
    const bf16* QB = WSP(bf16, WS_R1); const bf16* KB = WSP(bf16, WS_R1 + T32); const bf16* VB = WSP(bf16, WS_R1 + 2 * T32);
    bf16* QN = (bf16*)F.out; bf16* KN = (bf16*)F.out + (size_t)S * DM; bf16* VN = WSP(bf16, WS_VN);
    const float* cw = A.in[3]; const float* BA = WSP(const float, WS_BA); float* BETA = WSP(float, WS_BETA); float* G = WSP(float, WS_G);
    for (int it = F.gw; it < S * NH; it += F.NGW) { const int t = it >> 3, h = it & 7, c = h * HD + 2 * F.lane;
        float aq0 = 0.f, aq1 = 0.f, ak0 = 0.f, ak1 = 0.f, av0 = 0.f, av1 = 0.f;
#pragma unroll
        for (int j = 0; j < 4; ++j) { const int tt = t + j - 3; if (tt < 0) continue;
            const unsigned xq = *(const unsigned*)(QB + (size_t)tt * DM + c), xk = *(const unsigned*)(KB + (size_t)tt * DM + c), xv = *(const unsigned*)(VB + (size_t)tt * DM + c);
            const float* w = cw + (size_t)j * 3072;
            aq0 += w[c] * bflo(xq); aq1 += w[c + 1] * bfhi(xq); ak0 += w[1024 + c] * bflo(xk); ak1 += w[1024 + c + 1] * bfhi(xk); av0 += w[2048 + c] * bflo(xv); av1 += w[2048 + c + 1] * bfhi(xv); }
        aq0 = siluf_(aq0); aq1 = siluf_(aq1); ak0 = siluf_(ak0); ak1 = siluf_(ak1); av0 = siluf_(av0); av1 = siluf_(av1);
        const float rq = 1.f / sqrtf(wave_sum(aq0 * aq0 + aq1 * aq1) + EPS) * 0.08838834764831845f, rk = 1.f / sqrtf(wave_sum(ak0 * ak0 + ak1 * ak1) + EPS);
        *(unsigned*)(QN + (size_t)t * DM + c) = pk2(aq0 * rq, aq1 * rq); *(unsigned*)(KN + (size_t)t * DM + c) = pk2(ak0 * rk, ak1 * rk); *(unsigned*)(VN + (size_t)t * DM + c) = pk2(av0, av1);
        if (F.lane == 0) { const float b = BA[(size_t)t * 16 + h], a = BA[(size_t)t * 16 + 8 + h] + A.in[5][h];
            const float sp = (a > 20.f) ? a : log1pf(expf(a));
            BETA[(size_t)t * 8 + h] = 1.f / (1.f + expf(-b)); G[(size_t)t * 8 + h] = -expf(A.in[4][h]) * sp; } }
}
__device__ __forceinline__ void p_dn_chunk(Frame& F, const Args& A) {
    const bf16* QN = (const bf16*)F.out; const bf16* KN = (const bf16*)F.out + (size_t)S * DM; bf16* VU = WSP(bf16, WS_VN); bf16* Wb = WSP(bf16, WS_W); bf16* ATT = WSP(bf16, WS_ATT);
    const float* BETA = WSP(const float, WS_BETA); const float* G = WSP(const float, WS_G); float* GC = WSP(float, WS_GC);
    LAS float* Kc = (LAS float*)(F.lds); LAS float* Qc = Kc + 64 * 132; LAS float* Lm = Qc + 64 * 132; LAS float* Tm = Lm + 64 * 65; LAS float* gcs = Tm + 64 * 65; LAS float* bes = gcs + 64; LAS float* bge = bes + 64;
    const int tid = F.tid;
    for (int item = blockIdx.x; item < NCH * NH; item += F.G) { const int n = item >> 3, h = item & 7, t0 = n * CH;
        __syncthreads();
        if (tid < 64) { gcs[tid] = G[(size_t)(t0 + tid) * 8 + h]; bes[tid] = BETA[(size_t)(t0 + tid) * 8 + h]; }
        __syncthreads();
        if (tid == 0) { float a = 0.f; for (int i = 0; i < 64; ++i) { a += gcs[i]; gcs[i] = a; } }
#pragma unroll
        for (int r = 0; r < 2; ++r) { const int idx = tid + 512 * r, row = idx >> 4, c8 = idx & 15;
            const u32x4 kv = *(const u32x4*)(KN + (size_t)(t0 + row) * DM + h * HD + 8 * c8), qv = *(const u32x4*)(QN + (size_t)(t0 + row) * DM + h * HD + 8 * c8);
            LAS float* kd = Kc + row * 132 + 8 * c8; LAS float* qd = Qc + row * 132 + 8 * c8;
            kd[0] = bflo(kv.x); kd[1] = bfhi(kv.x); kd[2] = bflo(kv.y); kd[3] = bfhi(kv.y); kd[4] = bflo(kv.z); kd[5] = bfhi(kv.z); kd[6] = bflo(kv.w); kd[7] = bfhi(kv.w);
            qd[0] = bflo(qv.x); qd[1] = bfhi(qv.x); qd[2] = bflo(qv.y); qd[3] = bfhi(qv.y); qd[4] = bflo(qv.z); qd[5] = bfhi(qv.z); qd[6] = bflo(qv.w); qd[7] = bfhi(qv.w); }
        __syncthreads();
        if (tid < 64) { GC[(size_t)(t0 + tid) * 8 + h] = gcs[tid]; bge[tid] = bes[tid] * expf(gcs[tid]); }
        for (int r = 0; r < 8; ++r) { const int p = tid + 512 * r, i = p >> 6, j = p & 63;
            float dk = 0.f, dq = 0.f;
            if (j <= i) { const LAS float* ki = Kc + i * 132; const LAS float* kj = Kc + j * 132; const LAS float* qi = Qc + i * 132;
                for (int d = 0; d < HD; ++d) { dk += ki[d] * kj[d]; dq += qi[d] * kj[d]; } }
            const float dec = (j <= i) ? expf(gcs[i] - gcs[j]) : 0.f;
            Lm[i * 65 + j] = (j < i) ? bes[i] * dk * dec : 0.f;
            ATT[((size_t)(h * NCH + n) * 64 + i) * 64 + j] = (bf16)f2bf((j <= i) ? dq * dec : 0.f); }
        __syncthreads();
        if (tid < 64) { const int c = tid;
            for (int i = 0; i < 64; ++i) { float acc = (i == c) ? 1.f : 0.f; for (int j = 0; j < i; ++j) acc -= Lm[i * 65 + j] * Tm[j * 65 + c]; Tm[i * 65 + c] = acc; } }
        __syncthreads();
#pragma unroll
        for (int r = 0; r < 2; ++r) { const int idx = tid + 512 * r, row = idx >> 4, c8 = idx & 15;
            const u32x4 vv = *(const u32x4*)(VU + (size_t)(t0 + row) * DM + h * HD + 8 * c8); LAS float* vd = Qc + row * 132 + 8 * c8;
            vd[0] = bflo(vv.x); vd[1] = bfhi(vv.x); vd[2] = bflo(vv.y); vd[3] = bfhi(vv.y); vd[4] = bflo(vv.z); vd[5] = bfhi(vv.z); vd[6] = bflo(vv.w); vd[7] = bfhi(vv.w); }
        __syncthreads();
        { const int d = tid & 127, ig = tid >> 7;
          for (int ii = 0; ii < 16; ++ii) { const int i = ig * 16 + ii; float au = 0.f, aw = 0.f;
              for (int j = 0; j <= i; ++j) { const float t = Tm[i * 65 + j]; au += t * bes[j] * Qc[j * 132 + d]; aw += t * bge[j] * Kc[j * 132 + d]; }
              VU[(size_t)(t0 + i) * DM + h * HD + d] = (bf16)f2bf(au); Wb[(size_t)(t0 + i) * DM + h * HD + d] = (bf16)f2bf(aw); } }
    }
    __syncthreads();
}
__device__ __forceinline__ void p_dn_scan_naive(Frame& F, const Args& A) {
    if (blockIdx.x < 4) {
    const bf16* QN = (const bf16*)F.out; const bf16* KN = (const bf16*)F.out + (size_t)S * DM; const bf16* U = WSP(const bf16, WS_VN); const bf16* Wb = WSP(const bf16, WS_W); const bf16* ATT = WSP(const bf16, WS_ATT);
    const float* GC = WSP(const float, WS_GC); bf16* O = WSP(bf16, WS_O);
    LAS float* vn = (LAS float*)F.lds;
    const int tid = F.tid, wv = tid >> 6, h = blockIdx.x * 2 + (wv >> 2), e = (wv & 3) * 32 + (F.lane & 31), half = F.lane >> 5;
    float s[64];
#pragma unroll
    for (int d = 0; d < 64; ++d) s[d] = 0.f;
    for (int n = 0; n < NCH; ++n) { const int t0 = n * CH; const float gl = GC[(size_t)(t0 + 63) * 8 + h];
        for (int c = 0; c < 64; ++c) { const size_t ro = (size_t)(t0 + c) * DM + h * HD; const bf16* wp = Wb + ro + 64 * half; float a = 0.f;
#pragma unroll
            for (int d8 = 0; d8 < 8; ++d8) { if ((d8 & 1) == 0) asm volatile("" ::: "memory"); const u32x4 wv4 = *(const u32x4*)(wp + 8 * d8);
                a += bflo(wv4.x) * s[8 * d8] + bfhi(wv4.x) * s[8 * d8 + 1] + bflo(wv4.y) * s[8 * d8 + 2] + bfhi(wv4.y) * s[8 * d8 + 3] + bflo(wv4.z) * s[8 * d8 + 4] + bfhi(wv4.z) * s[8 * d8 + 5] + bflo(wv4.w) * s[8 * d8 + 6] + bfhi(wv4.w) * s[8 * d8 + 7]; }
            a += __shfl_xor(a, 32);
            vn[c * 512 + tid] = bf2f(U[ro + e]) - a; }
        for (int c = 0; c < 64; ++c) { const size_t ro = (size_t)(t0 + c) * DM + h * HD; const bf16* qp = QN + ro + 64 * half; float a = 0.f;
#pragma unroll
            for (int d8 = 0; d8 < 8; ++d8) { if ((d8 & 1) == 0) asm volatile("" ::: "memory"); const u32x4 wv4 = *(const u32x4*)(qp + 8 * d8);
                a += bflo(wv4.x) * s[8 * d8] + bfhi(wv4.x) * s[8 * d8 + 1] + bflo(wv4.y) * s[8 * d8 + 2] + bfhi(wv4.y) * s[8 * d8 + 3] + bflo(wv4.z) * s[8 * d8 + 4] + bfhi(wv4.z) * s[8 * d8 + 5] + bflo(wv4.w) * s[8 * d8 + 6] + bfhi(wv4.w) * s[8 * d8 + 7]; }
            a += __shfl_xor(a, 32);
            a *= expf(GC[(size_t)(t0 + c) * 8 + h]);
            const bf16* ap = ATT + ((size_t)(h * NCH + n) * 64 + c) * 64; float b = 0.f;
            for (int j = 0; j <= c; ++j) b += bf2f(ap[j]) * vn[j * 512 + tid];
            if (half == 0) O[ro + e] = (bf16)f2bf(a + b); }
        const float egl = expf(gl);
#pragma unroll
        for (int d = 0; d < 64; ++d) s[d] *= egl;
        for (int c = 0; c < 64; ++c) { const size_t ro = (size_t)(t0 + c) * DM + h * HD; const bf16* kp = KN + ro + 64 * half; const float f = vn[c * 512 + tid] * expf(gl - GC[(size_t)(t0 + c) * 8 + h]);
#pragma unroll
            for (int d8 = 0; d8 < 8; ++d8) { if ((d8 & 1) == 0) asm volatile("" ::: "memory"); const u32x4 wv4 = *(const u32x4*)(kp + 8 * d8);
                s[8 * d8] += f * bflo(wv4.x); s[8 * d8 + 1] += f * bfhi(wv4.x); s[8 * d8 + 2] += f * bflo(wv4.y); s[8 * d8 + 3] += f * bfhi(wv4.y); s[8 * d8 + 4] += f * bflo(wv4.z); s[8 * d8 + 5] += f * bfhi(wv4.z); s[8 * d8 + 6] += f * bflo(wv4.w); s[8 * d8 + 7] += f * bfhi(wv4.w); } }
    }
    }
}
__device__ __forceinline__ void p_dn_out(Frame& F, const Args& A) {
    const bf16* O = WSP(const bf16, WS_O); const bf16* Z = WSP(const bf16, WS_Z); bf16* YD = WSP(bf16, WS_YD); const float* ow = A.in[6];
    for (int it = F.gw; it < S * NH; it += F.NGW) { const int t = it >> 3, h = it & 7; const size_t off = (size_t)t * DM + h * HD + 2 * F.lane;
        const unsigned ov = *(const unsigned*)(O + off), zv = *(const unsigned*)(Z + off); const float o0 = bflo(ov), o1 = bfhi(ov);
        const float rs = 1.f / sqrtf(wave_sum(o0 * o0 + o1 * o1) * (1.f / HD) + EPS);
        *(unsigned*)(YD + off) = pk2(o0 * rs * ow[2 * F.lane] * siluf_(bflo(zv)), o1 * rs * ow[2 * F.lane + 1] * siluf_(bfhi(zv))); }
}

__device__ __forceinline__ void p_post_mix(Frame& F, const Args& A) {
    const float* x = A.in[0]; const float* T = WSP(const float, WS_T); bf16* H2 = WSP(bf16, WS_H2);
    for (int m = F.gw; m < S; m += F.NGW) {
        const f32x4* tr = (const f32x4*)(T + (size_t)m * DM) + F.lane; const f32x4* xr = (const f32x4*)(x + (size_t)m * DM) + F.lane; f32x4* orow = (f32x4*)(F.out + (size_t)m * DM) + F.lane;
        const f32x4* w1 = (const f32x4*)A.in[10] + F.lane; const f32x4* w2 = (const f32x4*)A.in[11] + F.lane;
        f32x4 tv[4]; float ss = 0.f;
#pragma unroll
        for (int j = 0; j < 4; ++j) { tv[j] = tr[64 * j]; ss += (tv[j].x * tv[j].x + tv[j].y * tv[j].y) + (tv[j].z * tv[j].z + tv[j].w * tv[j].w); }
        const float rs = 1.f / sqrtf(wave_sum(ss) * (1.f / DM) + EPS); float s2 = 0.f;
#pragma unroll
        for (int j = 0; j < 4; ++j) { tv[j] = xr[64 * j] + tv[j] * rs * w1[64 * j]; orow[64 * j] = tv[j]; s2 += (tv[j].x * tv[j].x + tv[j].y * tv[j].y) + (tv[j].z * tv[j].z + tv[j].w * tv[j].w); }
        const float r2 = 1.f / sqrtf(wave_sum(s2) * (1.f / DM) + EPS);
        unsigned long long* o8 = (unsigned long long*)(H2 + (size_t)m * DM) + F.lane;
#pragma unroll
        for (int j = 0; j < 4; ++j) { const f32x4 hv = tv[j] * r2 * w2[64 * j]; o8[64 * j] = (unsigned long long)pk2(hv.x, hv.y) | ((unsigned long long)pk2(hv.z, hv.w) << 32); }
    }
}
__device__ __forceinline__ void p_final(Frame& F, const Args& A) {
    const float* Fd = WSP(const float, WS_F);
    for (int m = F.gw; m < S; m += F.NGW) {
        const f32x4* fr = (const f32x4*)(Fd + (size_t)m * DM) + F.lane; f32x4* orow = (f32x4*)(F.out + (size_t)m * DM) + F.lane; const f32x4* w = (const f32x4*)A.in[15] + F.lane;
        f32x4 fv[4]; float ss = 0.f;
#pragma unroll
        for (int j = 0; j < 4; ++j) { fv[j] = fr[64 * j]; ss += (fv[j].x * fv[j].x + fv[j].y * fv[j].y) + (fv[j].z * fv[j].z + fv[j].w * fv[j].w); }
        const float rs = 1.f / sqrtf(wave_sum(ss) * (1.f / DM) + EPS);
#pragma unroll
        for (int j = 0; j < 4; ++j) orow[64 * j] = orow[64 * j] + fv[j] * rs * w[64 * j];
    }
}

constexpr int NPHASE = 18;
#ifndef MK_N_LAUNCHES
#define MK_N_LAUNCHES NPHASE
#endif
constexpr int N_LAUNCHES = MK_N_LAUNCHES;
__global__ void __launch_bounds__(NWAVES * 64, 2) fwd(Args args) {
    extern __shared__ __attribute__((aligned(16))) unsigned char lds[];
    Frame F;
    F.lds = (LAS unsigned char*)lds; F.MISC = (volatile LAS unsigned*)(F.lds + MISC_OFF);
    F.tid = threadIdx.x; F.lane = F.tid & 63; F.wave = __builtin_amdgcn_readfirstlane(F.tid >> 6);
    F.G = gridDim.x; F.gw = blockIdx.x * NWAVES + F.wave; F.NGW = F.G * NWAVES;
    F.out = args.out; F.ws = args.ws;
    for (int u = F.tid; u < (LDS_BYTES - LDSCTL_OFF) / 4; u += NWAVES * 64) ((LAS unsigned*)(F.lds + LDSCTL_OFF))[u] = 0u;
    __syncthreads();
    XcdBarrier bar; bar.bar = (unsigned*)(F.ws + WS_CTL) + CW_BAR; bar.x = 0; bar.st = nullptr;
    if (N_LAUNCHES == 1) bar = xcd_barrier_post((unsigned*)(F.ws + WS_CTL) + CW_BAR, F.MISC + 8);
#define GRID_BAR() do { if (N_LAUNCHES == 1) xcd_barrier(bar); } while (0)
    const int lo = args.ph_lo, hi = args.ph_hi;
#if defined(ONLY_PH)
#define PH_EN(k) ((k) == ONLY_PH)
#elif defined(PH_MASK)
#define PH_EN(k) (((PH_MASK) >> (k)) & 1)
#else
#define PH_EN(k) true
#endif
#define IN(k) (PH_EN(k) && lo <= (k) && (k) < hi)
#define BOTH(k) (IN(k) && IN((k) + 1))
#define GEMM(EPI, Aoff, Boff, N_, K_, ...) do { pg8::Gemm g{(const pg8::bf16_t*)(F.ws + (Aoff)), (const pg8::bf16_t*)(F.ws + (Boff)), S, (N_), (K_)}; pg8::StaticOrder So; So.init(S, (N_), F.G, (int)blockIdx.x); \
        EPI E{__VA_ARGS__}; pg8::gemm_phase<EPI, pg8::StaticOrder, true, true>(F.lds + RING_OFF, g, So, E); } while (0)

    if (IN(0)) { p_prologue(F, args); if (BOTH(0)) GRID_BAR(); }
    if (IN(1)) { GEMM(pg8::EpiRope, WS_H, WS_WTA, 3072, DM, WSP(pg8::bf16_t, WS_R1), WSP(const float, WS_COS), WSP(const float, WS_SIN)); if (BOTH(1)) GRID_BAR(); }
    if (IN(2)) { p_kmean(F, args); if (BOTH(2)) GRID_BAR(); }
    if (IN(3)) { p_topk(F, args); if (BOTH(3)) GRID_BAR(); }
    if (IN(4)) { p_attn_naive(F, args); if (BOTH(4)) GRID_BAR(); }
    if (IN(5)) { GEMM(pg8::EpiGen<0>, WS_H, WS_WTB, 4096, DM, WSP(pg8::bf16_t, WS_R1), DM, 1024, (size_t)S * DM, nullptr); if (BOTH(5)) GRID_BAR(); }
    if (IN(6)) { p_dn_conv(F, args); if (BOTH(6)) GRID_BAR(); }
    if (IN(7)) { p_dn_chunk(F, args); if (BOTH(7)) GRID_BAR(); }
    if (IN(8)) { p_dn_scan_naive(F, args); if (BOTH(8)) GRID_BAR(); }
    if (IN(9)) { p_dn_out(F, args); p_hrecompute(F, args); if (BOTH(9)) GRID_BAR(); }
    if (IN(10)) { GEMM(pg8::EpiGen<1>, WS_H, WS_WTG, 2048, DM, (pg8::bf16_t*)F.out, DM, 1024, (size_t)S * DM, nullptr); if (BOTH(10)) GRID_BAR(); }
    if (IN(11)) { GEMM(pg8::EpiGen<2>, WS_YA, WS_WTOA, 1024, DM, (pg8::bf16_t*)F.out, DM, 0, 0, nullptr); if (BOTH(11)) GRID_BAR(); }
    if (IN(12)) { GEMM(pg8::EpiGen<3>, WS_YD, WS_WTOD, 1024, DM, (pg8::bf16_t*)F.out, DM, 0, 0, (const pg8::bf16_t*)F.out + (size_t)S * DM); if (BOTH(12)) GRID_BAR(); }
    if (IN(13)) { pg8::Gemm g{(const pg8::bf16_t*)F.out, WSP(const pg8::bf16_t, WS_WTOUT), S, DM, DM}; pg8::StaticOrder So; So.init(S, DM, F.G, (int)blockIdx.x);
        pg8::EpiF32 E{WSP(float, WS_T), DM}; pg8::gemm_phase<pg8::EpiF32, pg8::StaticOrder, true, true>(F.lds + RING_OFF, g, So, E); if (BOTH(13)) GRID_BAR(); }
    if (IN(14)) { p_post_mix(F, args); if (BOTH(14)) GRID_BAR(); }
    if (IN(15)) { GEMM(pg8::EpiGen<4>, WS_H2, WS_WTGU, 2 * DFF, DM, WSP(pg8::bf16_t, WS_ACT), DFF, 0, 0, nullptr); if (BOTH(15)) GRID_BAR(); }
    if (IN(16)) { pg8::Gemm g{WSP(const pg8::bf16_t, WS_ACT), WSP(const pg8::bf16_t, WS_WTDN), S, DM, DFF}; pg8::StaticOrder So; So.init(S, DM, F.G, (int)blockIdx.x);
        pg8::EpiF32 E{WSP(float, WS_F), DM}; pg8::gemm_phase<pg8::EpiF32, pg8::StaticOrder, true, true>(F.lds + RING_OFF, g, So, E); if (BOTH(16)) GRID_BAR(); }
    if (IN(17)) { p_final(F, args); }
#undef IN
#undef BOTH
}

extern "C" void kernel_launch(void* const* d_in, const int* in_sizes, int n_in, void* d_out, int out_size, void* d_ws, size_t ws_size, hipStream_t stream) {
    static int grid = 0;
    if (grid == 0) {
        if (n_in != 16 || in_sizes[0] != S * DM || out_size != S * DM || ws_size < WS_END) { fprintf(stderr, "kernel_launch: unexpected shapes (n_in %d, in0 %d, out %d, ws %zu); nothing launched\n", n_in, n_in > 0 ? in_sizes[0] : -1, out_size, ws_size); grid = -1; return; }
        int dev = 0, cus = 0, per_cu = 0;
        if (hipGetDevice(&dev) != hipSuccess || hipDeviceGetAttribute(&cus, hipDeviceAttributeMultiprocessorCount, dev) != hipSuccess) { grid = -1; return; }
        if (hipFuncSetAttribute((const void*)fwd, hipFuncAttributeMaxDynamicSharedMemorySize, LDS_BYTES) != hipSuccess) { fprintf(stderr, "kernel_launch: hipFuncSetAttribute failed\n"); grid = -1; return; }
        if (hipOccupancyMaxActiveBlocksPerMultiprocessor(&per_cu, (const void*)fwd, NWAVES * 64, LDS_BYTES) != hipSuccess || per_cu < 1) fprintf(stderr, "kernel_launch: occupancy query says %d\n", per_cu);
        (void)hipGetLastError();
        grid = cus;
    }
    if (grid < 0) return;
    if (hipMemsetAsync((char*)d_ws + WS_CTL, 0, CTL_ZERO_BYTES, stream) != hipSuccess) return;
    Args a{};
    for (int i = 0; i < 16; ++i) a.in[i] = (const float*)d_in[i];
    a.out = (float*)d_out; a.ws = (unsigned char*)d_ws;
    for (int li = 0; li < N_LAUNCHES; ++li) {
        a.ph_lo = (N_LAUNCHES == 1) ? 0 : li; a.ph_hi = (N_LAUNCHES == 1) ? NPHASE : li + 1;
        hipLaunchKernelGGL(fwd, dim3(grid), dim3(NWAVES * 64), LDS_BYTES, stream, a);
        if (hipPeekAtLastError() != hipSuccess) { fprintf(stderr, "kernel_launch: launch %d failed\n", li); break; }
    }
}
```

```cpp
#include <hip/hip_runtime.h>
#include <cstdio>
#include <cstdint>
#include <cmath>
namespace pg8 {
#define PG8_LAS __attribute__((address_space(3)))
typedef unsigned short bf16_t;
typedef short bf16x8 __attribute__((ext_vector_type(8)));
typedef float f32x4 __attribute__((ext_vector_type(4)));
typedef unsigned u32x4 __attribute__((ext_vector_type(4)));
constexpr int BM = 256, BK = 64, HALF = 128, HTB = HALF * BK * 2  , STAGE_BYTES = 8 * HTB, NXCD = 8, WGM = 8;

__host__ __device__ __forceinline__ int lds_byte(int r, int c) { const int st = (r >> 4) * 2 + (c >> 5), rr = r & 15, cc = c & 31, ob = rr * 64 + cc * 2; return st * 1024 + (ob ^ (((ob >> 9) & 1) << 5)); }
__host__ __device__ __forceinline__ void stage_rc(int b, int& R, int& C) { const int st = b / 1024, sb = b % 1024, swz = sb ^ (((sb >> 9) & 1) << 5); R = (st >> 1) * 16 + swz / 64; C = (st & 1) * 32 + (swz % 64) / 2; }
__host__ __device__ __forceinline__ int perm32(int rho) { const int n = rho >> 4, i = rho & 15; return 8 * (i >> 2) + 4 * n + (i & 3); }

struct Unit { int pm, pn; };
struct Gemm { const bf16_t* A; const bf16_t* Bt; int M, N, K; };

struct StaticOrder {
    int nM, nN, nwg, G, c;
    __host__ __device__ void init(int M, int N, int G_, int c_) { nM = M / BM; nN = N / BM; nwg = nM * nN; G = G_; c = c_; }
    __host__ __device__ bool next(int i, Unit& u) const {
        const long L = (long)i * G + c; if (L >= nwg) return false;
        int wgid = (int)L; { const int q = nwg / NXCD, r = nwg % NXCD, xcd = wgid % NXCD, off = wgid / NXCD; wgid = (xcd < r ? xcd * (q + 1) : r * (q + 1) + (xcd - r) * q) + off; }
        const int nig = WGM * nN, gid = wgid / nig, fm = gid * WGM, gsz = (nM - fm) < WGM ? (nM - fm) : WGM;
        u.pm = fm + ((wgid % nig) % gsz); u.pn = (wgid % nig) / gsz; return true;
    }
    __device__ __forceinline__ void a_ready(const Unit&) const {}
    __device__ __forceinline__ void done(const Unit&) const {}
};

__device__ __forceinline__ unsigned cvt_pk_bf16(float lo, float hi) { typedef __bf16 b2 __attribute__((ext_vector_type(2))); typedef float f2 __attribute__((ext_vector_type(2))); const f2 v = {lo, hi}; return __builtin_bit_cast(unsigned, __builtin_convertvector(v, b2)); }
template <class Epi, class Sched, bool ALIGN_EPI = false, bool SP2 = false>
__device__ __forceinline__ void gemm_phase(PG8_LAS unsigned char* lds, const Gemm g, const Sched& S, const Epi& E) {
    const int tid = threadIdx.x, wid = __builtin_amdgcn_readfirstlane(tid >> 6), lane = tid & 63, wr = wid >> 2, wc = wid & 3, fr = lane & 15, fq = lane >> 4;
    const int K = g.K, nt = K / BK;
    unsigned voffA[2], voffB[2];
#pragma unroll
    for (int i = 0; i < 2; ++i) { int R, C; stage_rc(tid * 16 + i * 8192, R, C); const int Rb = Epi::PERM ? ((R & ~31) + perm32(R & 31)) : R;
        voffA[i] = (unsigned)(R * K + C) * 2u; voffB[i] = (unsigned)(Rb * K + C) * 2u; }
    const size_t kstep = (size_t)(BK * 2);
    const size_t hstep = (size_t)HALF * K * 2;
    const size_t tstep = 2 * hstep;
    const unsigned ldsw = (unsigned)wid * 1024u;
    const int aoff = lds_byte(wr * 64 + fr, fq * 8), boff = lds_byte(wc * 32 + fr, fq * 8);
#define PG8_SA(b, h) (((b) * 2 + (h)) * HTB)
#define PG8_SB(b, h) ((4 + (b) * 2 + (h)) * HTB)
#define PG8_STAGE(bufoff, gbase, voff) do { _Pragma("unroll") for (int _i = 0; _i < 2; ++_i) \
        __builtin_amdgcn_global_load_lds((const unsigned*)((const char*)(gbase) + (voff)[_i]), (PG8_LAS unsigned*)(lds + (bufoff) + ldsw + _i * 8192), 16, 0, 0); } while (0)
#define PG8_LDA(dst, b, h) do { _Pragma("unroll") for (int m = 0; m < 4; ++m) _Pragma("unroll") for (int k = 0; k < 2; ++k) dst[m][k] = *(const PG8_LAS bf16x8*)(lds + PG8_SA(b, h) + aoff + m * 2048 + k * 1024); } while (0)
#define PG8_LDB(dst, b, h) do { _Pragma("unroll") for (int n = 0; n < 2; ++n) _Pragma("unroll") for (int k = 0; k < 2; ++k) dst[n][k] = *(const PG8_LAS bf16x8*)(lds + PG8_SB(b, h) + boff + n * 2048 + k * 1024); } while (0)
#define PG8_MMA(ai, bj, At, Bt) do { __builtin_amdgcn_s_setprio(1); _Pragma("unroll") for (int m = 0; m < 4; ++m) _Pragma("unroll") for (int n = 0; n < 2; ++n) _Pragma("unroll") for (int k = 0; k < 2; ++k) \
        acc[ai][bj][m][n] = __builtin_amdgcn_mfma_f32_16x16x32_bf16(Bt[n][k], At[m][k], acc[ai][bj][m][n], 0, 0, 0); __builtin_amdgcn_s_setprio(0); } while (0)
#define PG8_WAIT_V(n) asm volatile("s_waitcnt vmcnt(" #n ")" ::: "memory")
#define PG8_WAIT_L(n) asm volatile("s_waitcnt lgkmcnt(" #n ")" ::: "memory")
#define PG8_BAR __builtin_amdgcn_s_barrier()
#define PG8_SCHED __builtin_amdgcn_sched_barrier(0)
    Unit cur, nxt; int ui = 0;
    if (!S.next(0, cur)) return;
    f32x4 acc[2][2][4][2];
#pragma unroll
    for (int a = 0; a < 2; ++a)
#pragma unroll
        for (int b = 0; b < 2; ++b)
#pragma unroll
            for (int m = 0; m < 4; ++m)
#pragma unroll
                for (int n = 0; n < 2; ++n) acc[a][b][m][n] = (f32x4){0.f, 0.f, 0.f, 0.f};
    bf16x8 At[4][2], B0[2][2], B1[2][2];
    const char* cA = (const char*)g.A + (size_t)cur.pm * tstep; const char* cB = (const char*)g.Bt + (size_t)cur.pn * tstep;
    S.a_ready(cur);
    if constexpr (SP2) {
        PG8_STAGE(PG8_SB(0, 0), cB, voffB); PG8_STAGE(PG8_SB(0, 1), cB + hstep, voffB); PG8_STAGE(PG8_SA(0, 0), cA, voffA); PG8_STAGE(PG8_SA(0, 1), cA + hstep, voffA);
        if (wr == 1) PG8_BAR;
        PG8_WAIT_V(2); PG8_BAR;
        PG8_STAGE(PG8_SB(1, 0), cB + kstep, voffB); PG8_STAGE(PG8_SA(1, 0), cA + kstep, voffA); PG8_STAGE(PG8_SB(1, 1), cB + hstep + kstep, voffB);
        PG8_WAIT_V(6); PG8_BAR;
    } else {
        PG8_STAGE(PG8_SB(0, 0), cB, voffB); PG8_STAGE(PG8_SA(0, 0), cA, voffA); PG8_STAGE(PG8_SB(0, 1), cB + hstep, voffB); PG8_STAGE(PG8_SA(0, 1), cA + hstep, voffA);
        if (wr == 1) PG8_BAR;
        PG8_WAIT_V(4); PG8_BAR;
        PG8_STAGE(PG8_SB(1, 0), cB + kstep, voffB); PG8_STAGE(PG8_SA(1, 0), cA + kstep, voffA); PG8_STAGE(PG8_SB(1, 1), cB + hstep + kstep, voffB);
        PG8_WAIT_V(6); PG8_BAR;
    }
    for (;;) {
        const bool has_next = S.next(ui + 1, nxt);
        const char* nA = has_next ? (const char*)g.A + (size_t)nxt.pm * tstep : cA; const char* nB = has_next ? (const char*)g.Bt + (size_t)nxt.pn * tstep : cB;
        for (int t = 0; t < nt; t += 2) {
            const bool last = (t == nt - 2);
            const char* a1 = cA + (size_t)(t + 1) * kstep;
            const char* a2 = last ? nA : cA + (size_t)(t + 2) * kstep; const char* b2 = last ? nB : cB + (size_t)(t + 2) * kstep;
            const char* a3 = a2 + kstep; const char* b3 = b2 + kstep;
            if (last && has_next) S.a_ready(nxt);
            if constexpr (SP2) {
            PG8_LDB(B0, 0, 0); PG8_LDB(B1, 0, 1); PG8_SCHED; PG8_LDA(At, 0, 0); PG8_STAGE(PG8_SA(1, 1), a1 + hstep, voffA);
            PG8_WAIT_V(8); PG8_WAIT_L(0); PG8_BAR; PG8_MMA(0, 0, At, B0); PG8_MMA(0, 1, At, B1); PG8_BAR; PG8_SCHED;
            PG8_LDA(At, 0, 1); PG8_STAGE(PG8_SB(0, 0), b2, voffB); PG8_STAGE(PG8_SB(0, 1), b2 + hstep, voffB); PG8_STAGE(PG8_SA(0, 0), a2, voffA);
            PG8_WAIT_V(8); PG8_WAIT_L(0); PG8_BAR; PG8_MMA(1, 0, At, B0); PG8_MMA(1, 1, At, B1); PG8_BAR; PG8_SCHED;
            PG8_LDB(B0, 1, 0); PG8_LDB(B1, 1, 1); PG8_SCHED; PG8_LDA(At, 1, 0); PG8_STAGE(PG8_SA(0, 1), a2 + hstep, voffA);
            PG8_WAIT_V(8); PG8_WAIT_L(0); PG8_BAR; PG8_MMA(0, 0, At, B0); PG8_MMA(0, 1, At, B1); PG8_BAR; PG8_SCHED;
            PG8_LDA(At, 1, 1); PG8_STAGE(PG8_SB(1, 0), b3, voffB); PG8_STAGE(PG8_SB(1, 1), b3 + hstep, voffB); PG8_STAGE(PG8_SA(1, 0), a3, voffA);
            PG8_WAIT_V(8); PG8_WAIT_L(0); PG8_BAR; PG8_MMA(1, 0, At, B0); PG8_MMA(1, 1, At, B1); PG8_BAR; PG8_SCHED;
            } else {
            PG8_LDB(B0, 0, 0); PG8_SCHED; PG8_LDA(At, 0, 0); PG8_STAGE(PG8_SA(1, 1), a1 + hstep, voffA);
            PG8_WAIT_L(8); PG8_BAR; PG8_WAIT_L(0); PG8_MMA(0, 0, At, B0); PG8_BAR; PG8_SCHED;
            PG8_LDB(B1, 0, 1); PG8_STAGE(PG8_SB(0, 0), b2, voffB);
            PG8_BAR; PG8_WAIT_L(0); PG8_MMA(0, 1, At, B1); PG8_BAR;
            PG8_LDA(At, 0, 1); PG8_STAGE(PG8_SA(0, 0), a2, voffA);
            PG8_BAR; PG8_WAIT_L(0); PG8_MMA(1, 0, At, B0); PG8_BAR; PG8_SCHED;
            PG8_STAGE(PG8_SB(0, 1), b2 + hstep, voffB);
            PG8_WAIT_V(6); PG8_BAR; PG8_MMA(1, 1, At, B1); PG8_BAR;
            PG8_LDB(B0, 1, 0); PG8_SCHED; PG8_LDA(At, 1, 0); PG8_STAGE(PG8_SA(0, 1), a2 + hstep, voffA);
            PG8_WAIT_L(8); PG8_BAR; PG8_WAIT_L(0); PG8_MMA(0, 0, At, B0); PG8_BAR; PG8_SCHED;
            PG8_LDB(B1, 1, 1); PG8_STAGE(PG8_SB(1, 0), b3, voffB);
            PG8_BAR; PG8_WAIT_L(0); PG8_MMA(0, 1, At, B1); PG8_BAR;
            PG8_LDA(At, 1, 1); PG8_STAGE(PG8_SA(1, 0), a3, voffA);
            PG8_BAR; PG8_WAIT_L(0); PG8_MMA(1, 0, At, B0); PG8_BAR; PG8_SCHED;
            PG8_STAGE(PG8_SB(1, 1), b3 + hstep, voffB);
            PG8_WAIT_V(6); PG8_BAR; PG8_MMA(1, 1, At, B1); PG8_BAR;
            }
        }
        if constexpr (ALIGN_EPI) { if (wr == 0) PG8_BAR; }
        if constexpr (!Epi::AFTER_DRAIN) { E(acc, cur, wr, wc, fr, fq); S.done(cur); }
        if (!has_next) break;
#pragma unroll
        for (int a = 0; a < 2; ++a)
#pragma unroll
            for (int b = 0; b < 2; ++b)
#pragma unroll
                for (int m = 0; m < 4; ++m)
#pragma unroll
                    for (int n = 0; n < 2; ++n) acc[a][b][m][n] = (f32x4){0.f, 0.f, 0.f, 0.f};
        cur = nxt; cA = nA; cB = nB; ++ui;
        if constexpr (ALIGN_EPI) { if (wr == 1) PG8_BAR; }
    }
    PG8_WAIT_V(0);
    if constexpr (!ALIGN_EPI) { if (wr == 0) PG8_BAR; }
    PG8_BAR;
    if constexpr (Epi::AFTER_DRAIN) { E.fused(acc, cur, wr, wc, fr, fq, lds, wid, lane); S.done(cur); }
#undef PG8_SA
#undef PG8_SB
#undef PG8_STAGE
#undef PG8_LDA
#undef PG8_LDB
#undef PG8_MMA
#undef PG8_WAIT_V
#undef PG8_WAIT_L
#undef PG8_BAR
#undef PG8_SCHED
}
}
#define GAS __attribute__((address_space(1)))
#define LAS __attribute__((address_space(3)))
typedef unsigned short bf16;
typedef unsigned v4u __attribute__((ext_vector_type(4)));
typedef float f32x4 __attribute__((ext_vector_type(4)));
typedef short bf16x8 __attribute__((ext_vector_type(8)));
typedef GAS unsigned gu32;
typedef GAS unsigned long long gu64;
#define RLX_AGENT __ATOMIC_RELAXED, __HIP_MEMORY_SCOPE_AGENT
#define LDS_WAIT() asm volatile("s_waitcnt lgkmcnt(0)" ::: "memory")
#define VM_WAIT() asm volatile("s_waitcnt vmcnt(0)" ::: "memory")
__device__ __forceinline__ unsigned long long rt() { return __builtin_amdgcn_s_memrealtime(); }
typedef __bf16 hbf2_t __attribute__((ext_vector_type(2)));
typedef float hf2_t __attribute__((ext_vector_type(2)));
__device__ __forceinline__ unsigned pk2(float lo, float hi) { const hf2_t v = {lo, hi}; return __builtin_bit_cast(unsigned, __builtin_convertvector(v, hbf2_t)); }
__device__ __forceinline__ unsigned f2bf(float f) { return pk2(f, 0.f) & 0xffffu; }

#define XB_TMO      128
#define XB_XCNT(j)  (256  + 64 * (j))
#define XB_XSUB(j)  (1280 + 64 * (j))
#define XB_XGEN(j)  (2304 + 64 * (j))
#define XB_TOP      3328
#define XB_TOPGEN   3392
#define XCD_BAR_WORDS 3456
#define XB_SPIN_CAP (1u << 22)

__device__ __forceinline__ unsigned xb_ld(unsigned* p)              { return __hip_atomic_load(p, __ATOMIC_RELAXED, __HIP_MEMORY_SCOPE_AGENT); }
__device__ __forceinline__ unsigned xb_add(unsigned* p, unsigned v) { return __hip_atomic_fetch_add(p, v, __ATOMIC_RELAXED, __HIP_MEMORY_SCOPE_AGENT); }
__device__ __forceinline__ unsigned xb_xcc_id() { return (unsigned)__builtin_amdgcn_s_getreg((3 << 11) | 20) & 0xFu; }
#define XB_SPIN(cond, bar) do { unsigned _sp = 0; while (cond) { __builtin_amdgcn_s_sleep(1); \
    if ((++_sp & 255u) == 0u) { if (xb_ld(&(bar)[XB_TMO])) break; if (_sp > XB_SPIN_CAP) { atomicAdd(&(bar)[XB_TMO], 1u); break; } } } } while (0)

struct XcdBarrier {
    unsigned* bar; unsigned x;
    volatile LAS unsigned* st;
};

__device__ __forceinline__ XcdBarrier xcd_barrier_post(unsigned* bar, volatile LAS unsigned* st) {
    XcdBarrier b; b.bar = bar; b.x = xb_xcc_id(); b.st = st;
    if (threadIdx.x == 0) (void)xb_add(&bar[XB_XCNT(b.x)], 1u);
    return b;
}
__device__ __forceinline__ void xcd_barrier_complete(unsigned* bar, unsigned x, unsigned& nloc, unsigned& nx) {
    const unsigned G = gridDim.x * gridDim.y * gridDim.z;
    unsigned sum, cnt, mine, sp = 0u;
    for (;;) {
        sum = 0u; cnt = 0u; mine = 0u;
#pragma unroll
        for (unsigned j = 0; j < 16; ++j) { const unsigned c = xb_ld(&bar[XB_XCNT(j)]); sum += c; cnt += (c > 0u) ? 1u : 0u; mine = (j == x) ? c : mine; }
        if (sum == G) break;
        __builtin_amdgcn_s_sleep(1);
        if ((++sp & 255u) == 0u) { if (xb_ld(&bar[XB_TMO])) break; if (sp > XB_SPIN_CAP) { atomicAdd(&bar[XB_TMO], 1u); break; } }
    }
    nloc = mine > 0u ? mine : 1u; nx = cnt > 0u ? cnt : 1u;
}

__device__ __forceinline__ void xcd_barrier(const XcdBarrier& b) {
    asm volatile("s_waitcnt vmcnt(0)" ::: "memory");
    __syncthreads();
    if (threadIdx.x == 0) {
        unsigned* bar = b.bar;
        __builtin_amdgcn_s_waitcnt(0);
        unsigned nloc = b.st[0], nx = b.st[1];
        if (nloc == 0u) { xcd_barrier_complete(bar, b.x, nloc, nx); b.st[0] = nloc; b.st[1] = nx; }
        const unsigned old = xb_add(&bar[XB_XSUB(b.x)], 1u);
        const unsigned gen = old / nloc;
        if (old + 1u == (gen + 1u) * nloc) {
            __builtin_amdgcn_fence(__ATOMIC_RELEASE, "agent");
            asm volatile("s_waitcnt vmcnt(0)" ::: "memory");
            const unsigned og = xb_add(&bar[XB_TOP], 1u);
            const unsigned tg = og / nx;
            if (og + 1u == (tg + 1u) * nx) xb_add(&bar[XB_TOPGEN], 1u);
            else XB_SPIN(xb_ld(&bar[XB_TOPGEN]) == tg, bar);
            __builtin_amdgcn_fence(__ATOMIC_ACQUIRE, "agent");
            xb_add(&bar[XB_XGEN(b.x)], 1u);
            asm volatile("s_waitcnt vmcnt(0)" ::: "memory");
        } else {
            XB_SPIN(xb_ld(&bar[XB_XGEN(b.x)]) == gen, bar);
            __builtin_amdgcn_fence(__ATOMIC_ACQUIRE, "agent");
            asm volatile("s_waitcnt vmcnt(0)" ::: "memory");
        }
    }
    __syncthreads();
}

constexpr int S = 16384, DM = 1024, NH = 8, HD = 128, MBLK = 256, NBLK = S / MBLK, DFF = 2816, INTOT = 9232;
constexpr int CH = 64, NCH = S / CH;
constexpr float EPS = 1e-6f;
constexpr int NWAVES = 8;
#ifndef DN2_LATE_WT
#define DN2_LATE_WT 1
#endif

constexpr size_t MiB = 1u << 20;
constexpr size_t WS_CTL = 0, CTL_ZERO_BYTES = 1 * MiB;
constexpr size_t WS_COS = 1 * MiB, WS_SIN = 2 * MiB;
constexpr size_t WS_BA = 3 * MiB;
constexpr size_t WS_KMEAN = 4 * MiB;
constexpr size_t WS_TOPI = 5 * MiB;
constexpr size_t WS_BETA = 6 * MiB + 512 * 1024, WS_G = 7 * MiB, WS_GC = 7 * MiB + 512 * 1024;
constexpr size_t WS_WTA = 8 * MiB, WS_WTB = 14 * MiB, WS_WTG = 22 * MiB, WS_WTOA = 26 * MiB, WS_WTOD = 28 * MiB, WS_WTOUT = 30 * MiB, WS_WTGU = 32 * MiB, WS_WTDN = 43 * MiB;
constexpr size_t WS_H = 49 * MiB;
constexpr size_t WS_R1 = 81 * MiB;
constexpr size_t WS_Z = 177 * MiB, WS_YA = 209 * MiB, WS_END = 256 * MiB;
constexpr size_t ACT_BYTES = (size_t)S * DFF * 2;
constexpr size_t T32 = (size_t)S * DM * 2;
static_assert(WS_WTDN + (size_t)DM * DFF * 2 <= WS_H && WS_YA + T32 <= WS_END && WS_R1 + 3 * T32 == WS_Z, "ws map");
constexpr size_t WS_VN = WS_H;
constexpr size_t WS_W = WS_R1, WS_ATT = WS_R1 + T32, WS_O = WS_R1 + T32 + 16 * MiB, WS_YD = WS_R1;
constexpr size_t WS_T = 113 * MiB, WS_H2 = WS_H, WS_ACT = 81 * MiB, WS_F = 169 * MiB;
static_assert(WS_ACT + ACT_BYTES <= WS_F && WS_F + 2 * T32 <= WS_END && WS_O + T32 <= WS_Z && WS_T + 2 * T32 <= WS_Z, "overlay map");
constexpr int CW_BAR = 4096;

constexpr int RING_OFF = 0, RING_BYTES = 131072;
constexpr int LDS_BYTES = 163840;
constexpr int LDSCTL_OFF = LDS_BYTES - 4096, MISC_OFF = LDSCTL_OFF + 320;

typedef unsigned u32x4 __attribute__((ext_vector_type(4)));
typedef unsigned u32x2 __attribute__((ext_vector_type(2)));

__device__ __forceinline__ float bflo(unsigned u) { return __builtin_bit_cast(float, u << 16); }
__device__ __forceinline__ float bfhi(unsigned u) { return __builtin_bit_cast(float, u & 0xffff0000u); }
__device__ __forceinline__ float bf2f(bf16 b) { return __builtin_bit_cast(float, ((unsigned)b) << 16); }
__device__ __forceinline__ float wave_sum(float v) {
#define WS_DPP(ctrl) v += __builtin_bit_cast(float, __builtin_amdgcn_update_dpp(0, __builtin_bit_cast(int, v), (ctrl), 0xF, 0xF, true))
    WS_DPP(0xB1); WS_DPP(0x4E); WS_DPP(0x141); WS_DPP(0x140);
#undef WS_DPP
    const float s0 = __builtin_bit_cast(float, __builtin_amdgcn_readlane(__builtin_bit_cast(int, v), 0)), s1 = __builtin_bit_cast(float, __builtin_amdgcn_readlane(__builtin_bit_cast(int, v), 16));
    const float s2 = __builtin_bit_cast(float, __builtin_amdgcn_readlane(__builtin_bit_cast(int, v), 32)), s3 = __builtin_bit_cast(float, __builtin_amdgcn_readlane(__builtin_bit_cast(int, v), 48));
    return (s0 + s1) + (s2 + s3);
}
__device__ __forceinline__ float wave_max(float v) {
#pragma unroll
    for (int o = 1; o < 64; o <<= 1) v = fmaxf(v, __shfl_xor(v, o));
    return v;
}
__device__ __forceinline__ float rcp_(float x) { return __builtin_amdgcn_rcpf(x); }
__device__ __forceinline__ float rsq_(float x) { return __builtin_amdgcn_rsqf(x); }
__device__ __forceinline__ float sigmoidf_(float x) { return rcp_(1.f + __expf(-x)); }
__device__ __forceinline__ float siluf_(float x) { return x * rcp_(1.f + __expf(-x)); }
__device__ __forceinline__ float sigmoidf_e(float x) { return sigmoidf_(x); }
__device__ __forceinline__ float siluf_e(float x) { return siluf_(x); }

namespace pg8 {
struct EpiRope {
    static constexpr bool PERM = false, AFTER_DRAIN = false;
    bf16_t* base; const float* cosT; const float* sinT; float* kpart;
    __device__ __forceinline__ void operator()(const f32x4 (&acc)[2][2][4][2], const Unit& u, int wr, int wc, int fr, int fq) const {
        const int t = u.pn >> 2, pnl = u.pn & 3;
        bf16_t* ob = base + (size_t)t * ((size_t)S * DM);
        const bool rope = (t < 2) && (wc == 0);
        f32x4 cs[2][2];
#pragma unroll
        for (int bj = 0; bj < 2; ++bj)
#pragma unroll
            for (int n = 0; n < 2; ++n) cs[bj][n] = (f32x4){0.f, 0.f, 0.f, 0.f};
#pragma unroll
        for (int ai = 0; ai < 2; ++ai)
#pragma unroll
            for (int m = 0; m < 4; ++m) {
                const int row = u.pm * BM + ai * HALF + wr * 64 + m * 16 + fr;
                f32x4 cv = (f32x4){1.f, 1.f, 1.f, 1.f}, sv = (f32x4){0.f, 0.f, 0.f, 0.f};
                if (rope) { cv = *(const f32x4*)(cosT + (size_t)row * 16 + 4 * fq); sv = *(const f32x4*)(sinT + (size_t)row * 16 + 4 * fq); }
#pragma unroll
                for (int bj = 0; bj < 2; ++bj) {
                    f32x4 v0 = acc[ai][bj][m][0], v1 = acc[ai][bj][m][1];
                    if (rope) { const f32x4 n0 = v0 * cv - v1 * sv, n1 = v1 * cv + v0 * sv; v0 = n0; v1 = n1; }
                    cs[bj][0] = cs[bj][0] + v0; cs[bj][1] = cs[bj][1] + v1;
                    bf16_t* p = ob + (size_t)row * DM + pnl * 256 + bj * HALF + wc * 32 + 4 * fq;
                    u32x2 w0, w1; w0.x = cvt_pk_bf16(v0[0], v0[1]); w0.y = cvt_pk_bf16(v0[2], v0[3]); w1.x = cvt_pk_bf16(v1[0], v1[1]); w1.y = cvt_pk_bf16(v1[2], v1[3]);
                    *(u32x2*)p = w0; *(u32x2*)(p + 16) = w1;
                }
            }
        if (t == 1) {
#pragma unroll
            for (int bj = 0; bj < 2; ++bj)
#pragma unroll
                for (int n = 0; n < 2; ++n) { f32x4 s = cs[bj][n];
#pragma unroll
                    for (int o = 1; o < 16; o <<= 1) { s.x += __shfl_xor(s.x, o); s.y += __shfl_xor(s.y, o); s.z += __shfl_xor(s.z, o); s.w += __shfl_xor(s.w, o); }
                    if (fr == 0) *(f32x4*)(kpart + ((size_t)(u.pm * 2 + wr) * NH + 2 * pnl + bj) * HD + wc * 32 + 16 * n + 4 * fq) = s; } }
    }
};
template <int MODE> struct EpiGen {
    static constexpr bool PERM = true, AFTER_DRAIN = false;
    bf16_t* O; int ldc; int split_cols; size_t split_stride; const bf16_t* G2;
    __device__ __forceinline__ static void unpack8(const u32x4 w, float (&f)[8]) {
        f[0] = bflo(w.x); f[1] = bfhi(w.x); f[2] = bflo(w.y); f[3] = bfhi(w.y); f[4] = bflo(w.z); f[5] = bfhi(w.z); f[6] = bflo(w.w); f[7] = bfhi(w.w);
    }
    __device__ __forceinline__ void operator()(const f32x4 (&acc)[2][2][4][2], const Unit& u, int wr, int wc, int fr, int fq) const {
        const int row0 = u.pm * BM + wr * 64 + fr; int colt = u.pn * BM; bf16_t* base = O; const bf16_t* g2 = G2;
        if (split_cols) { const int t = colt / split_cols; base += (size_t)t * split_stride; colt -= t * split_cols; }
#pragma unroll
        for (int ai = 0; ai < 2; ++ai)
#pragma unroll
            for (int m = 0; m < 4; ++m) {
                const int row = row0 + ai * HALF + m * 16;
                if constexpr (MODE == 4) {
                    const f32x4 g0 = acc[ai][0][m][0], g1 = acc[ai][0][m][1], u0 = acc[ai][1][m][0], u1 = acc[ai][1][m][1];
                    float r[8];
#pragma unroll
                    for (int e = 0; e < 4; ++e) { r[e] = siluf_e(g0[e]) * u0[e]; r[4 + e] = siluf_e(g1[e]) * u1[e]; }
                    u32x4 w; w.x = cvt_pk_bf16(r[0], r[1]); w.y = cvt_pk_bf16(r[2], r[3]); w.z = cvt_pk_bf16(r[4], r[5]); w.w = cvt_pk_bf16(r[6], r[7]);
                    *(u32x4*)(base + (size_t)row * ldc + u.pn * HALF + wc * 32 + 8 * fq) = w;
                } else {
#pragma unroll
                    for (int bj = 0; bj < 2; ++bj) {
                        const f32x4 v0 = acc[ai][bj][m][0], v1 = acc[ai][bj][m][1];
                        float r[8] = {v0[0], v0[1], v0[2], v0[3], v1[0], v1[1], v1[2], v1[3]};
                        bf16_t* p = base + (size_t)row * ldc + colt + bj * HALF + wc * 32 + 8 * fq;
                        if constexpr (MODE == 1) {
#pragma unroll
                            for (int e = 0; e < 8; ++e) r[e] = sigmoidf_e(r[e]);
                        }
                        if constexpr (MODE == 2) { float g[8]; unpack8(*(const u32x4*)p, g);
#pragma unroll
                            for (int e = 0; e < 8; ++e) r[e] = r[e] * g[e]; }
                        if constexpr (MODE == 3) { float g[8], o[8]; unpack8(*(const u32x4*)(g2 + (size_t)row * ldc + colt + bj * HALF + wc * 32 + 8 * fq), g); unpack8(*(const u32x4*)p, o);
#pragma unroll
                            for (int e = 0; e < 8; ++e) r[e] = o[e] + r[e] * g[e]; }
                        u32x4 w; w.x = cvt_pk_bf16(r[0], r[1]); w.y = cvt_pk_bf16(r[2], r[3]); w.z = cvt_pk_bf16(r[4], r[5]); w.w = cvt_pk_bf16(r[6], r[7]);
                        *(u32x4*)p = w;
                    }
                }
            }
    }
};
struct EpiF32 {
    static constexpr bool PERM = false, AFTER_DRAIN = false;
    float* C; int ldc;
    __device__ __forceinline__ void operator()(const f32x4 (&acc)[2][2][4][2], const Unit& u, int wr, int wc, int fr, int fq) const {
        const int row0 = u.pm * BM + wr * 64 + fr, col0 = u.pn * BM + wc * 32 + 4 * fq;
#pragma unroll
        for (int ai = 0; ai < 2; ++ai)
#pragma unroll
            for (int m = 0; m < 4; ++m) { float* rowp = C + (size_t)(row0 + ai * HALF + m * 16) * ldc + col0;
#pragma unroll
                for (int bj = 0; bj < 2; ++bj)
#pragma unroll
                    for (int n = 0; n < 2; ++n) *(f32x4*)(rowp + bj * HALF + n * 16) = acc[ai][bj][m][n]; }
    }
};
}

struct Args { const float* in[16]; float* out; unsigned char* ws; int ph_lo, ph_hi, pass, pad; };
struct Frame {
    LAS unsigned char* lds;
    volatile LAS unsigned* MISC;
    int tid, lane, wave, G, gw, NGW;
    float* out; unsigned char* ws;
};
#define WSP(T, off) ((T*)(F.ws + (off)))
#define WSPF(T, off) ((T*)(Fp.ws + (off)))

struct WtItem { const float* src; bf16* dst; int ldw, K; };
__device__ __forceinline__ void tr_load(const WtItem& I, int lane, f32x4 (&v)[8]) {
#pragma unroll
    for (int i = 0; i < 8; ++i) v[i] = *(const f32x4*)(I.src + (size_t)((lane >> 3) + 8 * i) * I.ldw + 4 * (lane & 7));
}
__device__ __forceinline__ void tr_put(const f32x4 (&v)[8], LAS float* scr, int lane) {
#pragma unroll
    for (int i = 0; i < 8; ++i) { LAS float* s = scr + ((lane >> 3) + 8 * i) * 33 + 4 * (lane & 7); s[0] = v[i].x; s[1] = v[i].y; s[2] = v[i].z; s[3] = v[i].w; }
    LDS_WAIT(); asm volatile("" ::: "memory");
}
__device__ __forceinline__ void tr_out(const WtItem& I, const LAS float* scr, int lane) {
    const int c = lane & 7;
#pragma unroll
    for (int j = 0; j < 4; ++j) { const int n = (lane >> 3) + 8 * j; const LAS float* s = scr + (8 * c) * 33 + n;
        v4u o; o.x = pk2(s[0 * 33], s[1 * 33]); o.y = pk2(s[2 * 33], s[3 * 33]); o.z = pk2(s[4 * 33], s[5 * 33]); o.w = pk2(s[6 * 33], s[7 * 33]);
        *(GAS v4u*)(I.dst + (size_t)n * I.K + 8 * c) = o; }
    LDS_WAIT(); asm volatile("" ::: "memory");
}
__device__ __forceinline__ void rms_row_bf16(const float* xrow, const float* w, bf16* orow, int lane, f32x4 (&hv)[4]) {
    const f32x4* xr = (const f32x4*)xrow + lane; const f32x4* wr = (const f32x4*)w + lane;
    float ss = 0.f;
#pragma unroll
    for (int j = 0; j < 4; ++j) { hv[j] = xr[64 * j]; ss += (hv[j].x * hv[j].x + hv[j].y * hv[j].y) + (hv[j].z * hv[j].z + hv[j].w * hv[j].w); }
    const float rs = rsq_(wave_sum(ss) * (1.f / DM) + EPS);
    unsigned long long* o8 = (unsigned long long*)orow + lane;
#pragma unroll
    for (int j = 0; j < 4; ++j) { const f32x4 wv = wr[64 * j]; hv[j] = hv[j] * rs * wv;
        o8[64 * j] = (unsigned long long)pk2(hv[j].x, hv[j].y) | ((unsigned long long)pk2(hv[j].z, hv[j].w) << 32); }
}
__device__ __forceinline__ WtItem wt_decode(const Args& A, unsigned char* ws, int it) {
    constexpr int I_A = 16 * 96, I_B = 16 * 128, I_G = 16 * 64, I_O = 16 * 32, I_GU = 16 * 88;
    const float* w_in = A.in[2];
    int r = it; const float* W; int ldw, scol, nbn, K = DM, dmode = 0; size_t dst;
    if (r < I_A) { W = w_in; ldw = INTOT; scol = 0; nbn = 96; dst = WS_WTA; }
    else if ((r -= I_A) < I_B) { W = w_in; ldw = INTOT; scol = 3072; nbn = 128; dst = WS_WTB; }
    else if ((r -= I_B) < I_G) { W = w_in; ldw = INTOT; scol = 7184; nbn = 64; dst = WS_WTG; }
    else if ((r -= I_G) < I_O) { W = A.in[7]; ldw = DM; scol = 0; nbn = 32; dst = WS_WTOA; }
    else if ((r -= I_O) < I_O) { W = A.in[8]; ldw = DM; scol = 0; nbn = 32; dst = WS_WTOD; }
    else if ((r -= I_O) < I_O) { W = A.in[9]; ldw = DM; scol = 0; nbn = 32; dst = WS_WTOUT; }
    else if ((r -= I_O) < I_GU) { W = A.in[12]; ldw = DFF; scol = 0; nbn = 88; dst = WS_WTGU; dmode = 1; }
    else if ((r -= I_GU) < I_GU) { W = A.in[13]; ldw = DFF; scol = 0; nbn = 88; dst = WS_WTGU; dmode = 2; }
    else { r -= I_GU; W = A.in[14]; ldw = DM; scol = 0; nbn = 32; dst = WS_WTDN; K = DFF; }
    const int kb = r / nbn, nb = r % nbn, n0 = 32 * nb;
    const int drow0 = (dmode == 0) ? n0 : 256 * (n0 / 128) + (n0 % 128) + (dmode == 2 ? 128 : 0);
    WtItem I; I.src = W + (size_t)(64 * kb) * ldw + scol + n0; I.dst = (bf16*)(ws + dst) + (size_t)drow0 * K + 64 * kb; I.ldw = ldw; I.K = K; return I;
}
__device__ __forceinline__ void p_wtrans(Frame& F, const Args& A, int it0, int it1, int gw0, int ngw) {
    LAS float* scr = (LAS float*)(F.lds + RING_OFF + F.wave * 16384);
    int it = it0 + gw0; if (it >= it1) return;
    WtItem cur = wt_decode(A, F.ws, it); f32x4 v[8]; tr_load(cur, F.lane, v);
    for (;;) {
        const int itn = it + ngw; const bool more = itn < it1;
        tr_put(v, scr, F.lane);
        WtItem nxt = cur; if (more) { nxt = wt_decode(A, F.ws, itn); tr_load(nxt, F.lane, v); }
        tr_out(cur, scr, F.lane);
        if (!more) break;
        cur = nxt; it = itn;
    }
}
constexpr int WT_A_ITEMS = 2560;
constexpr int WT_ITEMS_EARLY = 16 * 96 + 16 * 128, WT_ITEMS_ALL = 16 * 96 + 16 * 128 + 16 * 64 + 3 * 16 * 32 + 2 * 16 * 88 + 44 * 32;
__device__ __forceinline__ void p_prologue(Frame& F, const Args& A) {
    const float* w_in = A.in[2];
#if DN2_LATE_WT
    p_wtrans(F, A, 0, WT_ITEMS_EARLY, F.gw, F.NGW);
#else
    p_wtrans(F, A, 0, WT_ITEMS_ALL, F.gw, F.NGW);
#endif
    { float* cosT = WSP(float, WS_COS); float* sinT = WSP(float, WS_SIN);
      for (int i = F.gw * 64 + F.lane; i < S * 16; i += F.NGW * 64) { const int pos = i >> 4, k = i & 15;
          const float inv = (float)pow(500000.0, -(double)k / 16.0); const float ang = (float)pos * inv;
          cosT[i] = cosf(ang); sinT[i] = sinf(ang); } }
    { const float* x = A.in[0]; bf16* H = WSP(bf16, WS_H); float* BA = WSP(float, WS_BA);
      LAS float* wl = (LAS float*)F.lds; LAS float* hl = (LAS float*)(F.lds + 67584) + F.wave * 1024;
      __syncthreads();
      for (int i = F.tid; i < 4096; i += NWAVES * 64) { const int k = i >> 2, q = i & 3; const f32x4 v = *(const f32x4*)(w_in + (size_t)k * INTOT + 7168 + 4 * q);
          *(LAS f32x4*)(wl + (k >> 8) * 4112 + (k & 255) * 16 + 4 * q) = v; }
      __syncthreads();
      const int c = F.lane & 15, kq = F.lane >> 4; const LAS float* wq = wl + kq * 4112 + c; const LAS float* hq = hl + kq * 256;
      for (int m = F.gw; m < S; m += F.NGW) {
          f32x4 hv[4]; rms_row_bf16(x + (size_t)m * DM, A.in[1], H + (size_t)m * DM, F.lane, hv);
#pragma unroll
          for (int j = 0; j < 4; ++j) *(LAS f32x4*)(hl + 4 * (F.lane + 64 * j)) = hv[j];
          asm volatile("s_waitcnt lgkmcnt(0)" ::: "memory");
          float acc = 0.f;
#pragma unroll 8
          for (int kk = 0; kk < 256; ++kk) acc += hq[kk] * wq[kk * 16];
          acc += __shfl_xor(acc, 16); acc += __shfl_xor(acc, 32);
          if (F.lane < 16) BA[(size_t)m * 16 + F.lane] = acc;
          asm volatile("s_waitcnt lgkmcnt(0)" ::: "memory");
      }
      __syncthreads(); }
}
__device__ __forceinline__ void p_hrecompute_sub(Frame& F, const Args& A, bf16* H, int gw0, int ngw) {
    const float* x = A.in[0];
    for (int m = gw0; m < S; m += ngw) { f32x4 hv[4]; rms_row_bf16(x + (size_t)m * DM, A.in[1], H + (size_t)m * DM, F.lane, hv); }
}
__device__ __forceinline__ void p_hrecompute(Frame& F, const Args& A) {
    const float* x = A.in[0]; bf16* H = WSP(bf16, WS_H);
    for (int m = F.gw; m < S; m += F.NGW) { f32x4 hv[4]; rms_row_bf16(x + (size_t)m * DM, A.in[1], H + (size_t)m * DM, F.lane, hv); }
}

__device__ __forceinline__ void p_kmean(Frame& F, const Args& A) {
    const bf16* KA = WSP(bf16, WS_R1 + T32); float* KM = WSP(float, WS_KMEAN);
    for (int it = F.gw; it < NBLK * NH; it += F.NGW) { const int blk = it >> 3, h = it & 7;
        float s0 = 0.f, s1 = 0.f; const bf16* p = KA + (size_t)(blk * MBLK) * DM + h * HD + 2 * F.lane;
#pragma unroll 32
        for (int r = 0; r < MBLK; ++r) { const unsigned v = *(const unsigned*)(p + (size_t)r * DM); s0 += bflo(v); s1 += bfhi(v); }
        KM[(size_t)it * HD + 2 * F.lane] = s0 * (1.f / MBLK); KM[(size_t)it * HD + 2 * F.lane + 1] = s1 * (1.f / MBLK); }
}
__device__ __forceinline__ void p_topk(Frame& F, const Args& A) {
    const bf16* QA = WSP(bf16, WS_R1); const float* KM = WSP(float, WS_KMEAN); int* TOPI = WSP(int, WS_TOPI);
    for (int it = F.gw; it < S * NH; it += F.NGW) { const int q = it >> 3, h = it & 7, qblk = q >> 8;
        float g = -INFINITY;
        if (F.lane < qblk) { const bf16* qp = QA + (size_t)q * DM + h * HD; const float* kp = KM + ((size_t)F.lane * NH + h) * HD; float a = 0.f;
#pragma unroll
            for (int c = 0; c < 16; ++c) { const u32x4 qv = *(const u32x4*)(qp + 8 * c); const f32x4 k0 = *(const f32x4*)(kp + 8 * c), k1 = *(const f32x4*)(kp + 8 * c + 4);
                a += bflo(qv.x) * k0.x + bfhi(qv.x) * k0.y + bflo(qv.y) * k0.z + bfhi(qv.y) * k0.w + bflo(qv.z) * k1.x + bfhi(qv.z) * k1.y + bflo(qv.w) * k1.z + bfhi(qv.w) * k1.w; }
            g = a; }
        int res = -1;
#pragma unroll
        for (int r = 0; r < 3; ++r) { float v = g; int i = F.lane;
#pragma unroll
            for (int o = 1; o < 64; o <<= 1) { const float ov = __shfl_xor(v, o); const int oi = __shfl_xor(i, o); if (ov > v || (ov == v && oi < i)) { v = ov; i = oi; } }
            if (F.lane == r) res = (r < qblk) ? i : -1;
            if (F.lane == i) g = -INFINITY; }
        if (F.lane < 3) TOPI[(size_t)it * 3 + F.lane] = res; }
}
__device__ __forceinline__ void p_attn_naive(Frame& F, const Args& A) {
    const bf16* QA = WSP(bf16, WS_R1); const bf16* KA = WSP(bf16, WS_R1 + T32); const bf16* VA = WSP(bf16, WS_R1 + 2 * T32); const int* TOPI = WSP(int, WS_TOPI);
#ifdef DBG_ATTN
    bf16* YA = (bf16*)F.out;
#else
    bf16* YA = WSP(bf16, WS_YA);
#endif
    for (int it = F.gw; it < S * NH; it += F.NGW) { const int q = it >> 3, h = it & 7, qblk = q >> 8;
        const bf16* qp = QA + (size_t)q * DM + h * HD;
        float m = -INFINITY, l = 0.f, o0 = 0.f, o1 = 0.f;
        for (int slot = 0; slot < 4; ++slot) {
            int kb = qblk; if (slot < 3) { kb = TOPI[(size_t)it * 3 + slot]; if (kb < 0) continue; }
            const bf16* kp = KA + (size_t)(kb * MBLK) * DM + h * HD; const bf16* vp = VA + (size_t)(kb * MBLK) * DM + h * HD;
            float s[4] = {0.f, 0.f, 0.f, 0.f};
#pragma unroll 4
            for (int c = 0; c < 16; ++c) { const u32x4 qv = *(const u32x4*)(qp + 8 * c);
                const float q0 = bflo(qv.x), q1 = bfhi(qv.x), q2 = bflo(qv.y), q3 = bfhi(qv.y), q4 = bflo(qv.z), q5 = bfhi(qv.z), q6 = bflo(qv.w), q7 = bfhi(qv.w);
#pragma unroll
                for (int jj = 0; jj < 4; ++jj) { const u32x4 kv = *(const u32x4*)(kp + (size_t)(F.lane + 64 * jj) * DM + 8 * c);
                    s[jj] += q0 * bflo(kv.x) + q1 * bfhi(kv.x) + q2 * bflo(kv.y) + q3 * bfhi(kv.y) + q4 * bflo(kv.z) + q5 * bfhi(kv.z) + q6 * bflo(kv.w) + q7 * bfhi(kv.w); } }
            float mx = -INFINITY;
#pragma unroll
            for (int jj = 0; jj < 4; ++jj) { s[jj] *= 0.08838834764831845f; if (slot == 3 && (kb * MBLK + F.lane + 64 * jj) > q) s[jj] = -INFINITY; mx = fmaxf(mx, s[jj]); }
            mx = wave_max(mx);
            const float mn = fmaxf(m, mx), sc = __expf(m - mn);
            float p[4], ps = 0.f;
#pragma unroll
            for (int jj = 0; jj < 4; ++jj) { p[jj] = __expf(s[jj] - mn); ps += p[jj]; }
            l = l * sc + wave_sum(ps); o0 *= sc; o1 *= sc; m = mn;
#pragma unroll
            for (int jj = 0; jj < 4; ++jj)
                for (int ln = 0; ln < 64; ++ln) { const float pj = __shfl(p[jj], ln); const unsigned vv = *(const unsigned*)(vp + (size_t)(ln + 64 * jj) * DM + 2 * F.lane); o0 += pj * bflo(vv); o1 += pj * bfhi(vv); }
        }
        const float il = 1.f / l;
        *(unsigned*)(YA + (size_t)q * DM + h * HD + 2 * F.lane) = pk2(o0 * il, o1 * il); }
}


typedef float f32x16 __attribute__((ext_vector_type(16)));
typedef short s16x4 __attribute__((ext_vector_type(4)));
typedef float f32x2_t __attribute__((ext_vector_type(2)));
typedef __bf16 bf16x2_t __attribute__((ext_vector_type(2)));
constexpr size_t WS_BUCKET = 241 * MiB, WS_ML = 249 * MiB, WS_OP2 = WS_Z;
constexpr int BUCKET_PER_HEAD = 256 * 2016;
constexpr int CW_CNT = 16384;
static_assert(WS_BUCKET + (size_t)NH * BUCKET_PER_HEAD * 2 <= WS_ML && WS_ML + (size_t)3 * S * NH * 8 <= WS_END, "bucket map");
constexpr float SM_C = 0.08838834764831845f * 1.4426950408889634f;

__device__ __forceinline__ int bucket_off(int kb) { return 256 * (63 * kb - (kb * (kb - 1)) / 2); }
__device__ __forceinline__ unsigned attn_off(unsigned row, unsigned ch) { return 256u * row + 16u * (ch ^ (((row & 3u) << 2) | ((row >> 2) & 3u))); }
__device__ __forceinline__ unsigned cvtpk(float lo, float hi) { f32x2_t v = {lo, hi}; bf16x2_t b = __builtin_convertvector(v, bf16x2_t); return __builtin_bit_cast(unsigned, b); }
__device__ __forceinline__ s16x4 vtr16(const LAS unsigned char* p) { typedef short v4i16_t __attribute__((ext_vector_type(4))); return __builtin_bit_cast(s16x4, __builtin_amdgcn_ds_read_tr16_b64_v4i16((LAS v4i16_t*)p)); }

__device__ __forceinline__ void unpack8f(const bf16x8 v, float (&f)[8]) { const u32x4 w = __builtin_bit_cast(u32x4, v);
    f[0] = bflo(w.x); f[1] = bfhi(w.x); f[2] = bflo(w.y); f[3] = bfhi(w.y); f[4] = bflo(w.z); f[5] = bfhi(w.z); f[6] = bflo(w.w); f[7] = bfhi(w.w); }
__device__ __forceinline__ bf16x8 pack8f(const float (&f)[8]) { u32x4 w; w.x = cvtpk(f[0], f[1]); w.y = cvtpk(f[2], f[3]); w.z = cvtpk(f[4], f[5]); w.w = cvtpk(f[6], f[7]); return __builtin_bit_cast(bf16x8, w); }

__device__ __forceinline__ void attn_stage(const bf16* src, LAS unsigned char* img, int tid) {
#pragma unroll
    for (int i = 0; i < 8; ++i) { const int n = tid + 512 * i, row = n >> 4, ch = n & 15;
        const u32x4 v = *(const u32x4*)(src + (size_t)row * DM + 8 * ch); *(LAS u32x4*)(img + attn_off(row, ch)) = v; }
}
struct AttnState { float m, l; f32x16 o[4]; };
__device__ __forceinline__ float half_max(float v) { const auto t = __builtin_amdgcn_permlane32_swap(__builtin_bit_cast(unsigned, v), __builtin_bit_cast(unsigned, v), false, false); return fmaxf(__builtin_bit_cast(float, t[0]), __builtin_bit_cast(float, t[1])); }
__device__ __forceinline__ float half_sum(float v) { const auto t = __builtin_amdgcn_permlane32_swap(__builtin_bit_cast(unsigned, v), __builtin_bit_cast(unsigned, v), false, false); return __builtin_bit_cast(float, t[0]) + __builtin_bit_cast(float, t[1]); }
template <int NT> __device__ __forceinline__ void attn_wave(const bf16x8 (&qf)[8], const LAS unsigned char* Kimg, const LAS unsigned char* Vimg, int nt, int diag, int lane, AttnState& st) {
    const int r = lane & 31, hh = lane >> 5, blk = (lane >> 4) & 1, q4 = (lane & 15) >> 2, p4 = lane & 3;
    const LAS unsigned char* kad[8];
#pragma unroll
    for (int ks = 0; ks < 8; ++ks) kad[ks] = Kimg + attn_off(r, 2 * ks + hh);
    const LAS unsigned char* vad[4][4];
#pragma unroll
    for (int i = 0; i < 4; ++i) { const unsigned rl = 16u * (i >> 1) + 8u * (i & 1) + 4u * hh + q4, x = ((rl & 3u) << 2) | ((rl >> 2) & 3u), cb = 2u * blk + (p4 >> 1);
#pragma unroll
        for (int c = 0; c < 4; ++c) vad[i][c] = Vimg + 256u * rl + 16u * (cb ^ (x & 3u)) + 8u * (p4 & 1) + 64u * ((unsigned)c ^ (x >> 2)); }
    st.m = -INFINITY; st.l = 0.f;
#pragma unroll
    for (int c = 0; c < 4; ++c)
#pragma unroll
        for (int i = 0; i < 16; ++i) st.o[c][i] = 0.f;
    auto tile = [&](const int kt) __attribute__((always_inline)) {
        f32x16 s;
#pragma unroll
        for (int i = 0; i < 16; ++i) s[i] = 0.f;
#pragma unroll
        for (int ks = 0; ks < 8; ++ks) { const bf16x8 kf = *(const LAS bf16x8*)(kad[ks] + kt * 8192); s = __builtin_amdgcn_mfma_f32_32x32x16_bf16(kf, qf[ks], s, 0, 0, 0); }
        float tmax = -INFINITY;
#pragma unroll
        for (int i = 0; i < 16; ++i) { if (kt == diag && ((i & 3) + 8 * (i >> 2) + 4 * hh) > r) s[i] = -INFINITY; tmax = fmaxf(tmax, s[i]); }
        tmax = fmaxf(tmax, __shfl_xor(tmax, 32)) * SM_C;
        if (!(tmax - st.m <= 8.f)) { const float mn = fmaxf(st.m, tmax), alpha = __builtin_amdgcn_exp2f(st.m - mn); st.l *= alpha; st.m = mn;
#pragma unroll
            for (int c = 0; c < 4; ++c)
#pragma unroll
                for (int i = 0; i < 16; ++i) st.o[c][i] *= alpha; }
        float rs = 0.f; const float nm = -st.m;
#pragma unroll
        for (int i = 0; i < 16; ++i) { s[i] = __builtin_amdgcn_exp2f(__builtin_fmaf(s[i], SM_C, nm)); rs += s[i]; }
        st.l += rs + __shfl_xor(rs, 32);
#pragma unroll
        for (int sp = 0; sp < 2; ++sp) {
            u32x4 pw; pw.x = cvtpk(s[8 * sp], s[8 * sp + 1]); pw.y = cvtpk(s[8 * sp + 2], s[8 * sp + 3]); pw.z = cvtpk(s[8 * sp + 4], s[8 * sp + 5]); pw.w = cvtpk(s[8 * sp + 6], s[8 * sp + 7]);
            const bf16x8 pf = __builtin_bit_cast(bf16x8, pw);
#pragma unroll
            for (int c = 0; c < 4; ++c) {
                const s16x4 lo = vtr16(vad[2 * sp][c] + kt * 8192);
                const s16x4 hi = vtr16(vad[2 * sp + 1][c] + kt * 8192);
                const bf16x8 vf = __builtin_shufflevector(lo, hi, 0, 1, 2, 3, 4, 5, 6, 7);
                st.o[c] = __builtin_amdgcn_mfma_f32_32x32x16_bf16(vf, pf, st.o[c], 0, 0, 0);
            }
        }
    };
    if constexpr (NT > 0) {
#pragma unroll
        for (int kt = 0; kt < NT; ++kt) tile(kt);
    } else { for (int kt = 0; kt < nt; ++kt) tile(kt); }
}
__device__ __forceinline__ void p_topk_bucket(Frame& F, const Args& A) {
    const bf16* QA = WSP(bf16, WS_R1); const float* KM = WSP(float, WS_KMEAN); int* TOPI = WSP(int, WS_TOPI);
    unsigned* CNT = WSP(unsigned, WS_CTL) + CW_CNT; unsigned short* BUCKET = WSP(unsigned short, WS_BUCKET); f32x2_t* ML = WSP(f32x2_t, WS_ML);
    for (int it = F.gw; it < S * NH; it += F.NGW) { const int q = it >> 3, h = it & 7, qblk = q >> 8;
        float g = -INFINITY;
        if (F.lane < qblk) { const bf16* qp = QA + (size_t)q * DM + h * HD; const float* kp = KM + ((size_t)F.lane * NH + h) * HD; float a = 0.f;
#pragma unroll
            for (int c = 0; c < 16; ++c) { const u32x4 qv = *(const u32x4*)(qp + 8 * c); const f32x4 k0 = *(const f32x4*)(kp + 8 * c), k1 = *(const f32x4*)(kp + 8 * c + 4);
                a += bflo(qv.x) * k0.x + bfhi(qv.x) * k0.y + bflo(qv.y) * k0.z + bfhi(qv.y) * k0.w + bflo(qv.z) * k1.x + bfhi(qv.z) * k1.y + bflo(qv.w) * k1.z + bfhi(qv.w) * k1.w; }
            g = a; }
        int res = -1;
#pragma unroll
        for (int r = 0; r < 3; ++r) { float v = g; int i = F.lane;
#pragma unroll
            for (int o = 1; o < 64; o <<= 1) { const float ov = __shfl_xor(v, o); const int oi = __shfl_xor(i, o); if (ov > v || (ov == v && oi < i)) { v = ov; i = oi; } }
            if (F.lane == r) res = (r < qblk) ? i : -1;
            if (F.lane == i) g = -INFINITY; }
        if (F.lane < 3) { TOPI[(size_t)it * 3 + F.lane] = res;
            if (res >= 0) { const unsigned pos = __hip_atomic_fetch_add(CNT + h * NBLK + res, 1u, __ATOMIC_RELAXED, __HIP_MEMORY_SCOPE_AGENT);
                BUCKET[(size_t)h * BUCKET_PER_HEAD + bucket_off(res) + pos] = (unsigned short)((q << 2) | F.lane); }
            else ML[((size_t)F.lane * S + q) * NH + h] = (f32x2_t){-INFINITY, 0.f}; } }
}

__device__ __forceinline__ void p_topk2(Frame& F, const Args& A) {
    const bf16* QA = WSP(bf16, WS_R1); const float* KP = WSP(const float, WS_KMEAN);
    unsigned* CNT = WSP(unsigned, WS_CTL) + CW_CNT; unsigned short* BUCKET = WSP(unsigned short, WS_BUCKET); f32x2_t* ML = WSP(f32x2_t, WS_ML);
    LAS unsigned char* Kimg = F.lds;
    LAS int* lcnt = (LAS int*)(F.lds + 16384); LAS int* lbase = lcnt + 64;
    const int lane = F.lane, r = lane & 31, hh = lane >> 5;
    for (int u = blockIdx.x; u < NBLK * NH; u += F.G) { const int qblk = u >> 3, h = u & 7, q = qblk * MBLK + 32 * F.wave + r;
        __syncthreads();
        { const int n = F.tid >> 3, c = F.tid & 7; const float* p0 = KP + ((size_t)(n * 2) * NH + h) * HD + 16 * c; const float* p1 = p0 + (size_t)NH * HD;
#pragma unroll
          for (int half = 0; half < 2; ++half) { const f32x4 a0 = *(const f32x4*)(p0 + 8 * half), a1 = *(const f32x4*)(p0 + 8 * half + 4), c0 = *(const f32x4*)(p1 + 8 * half), c1 = *(const f32x4*)(p1 + 8 * half + 4);
              float f[8] = {(a0.x + c0.x) * (1.f / MBLK), (a0.y + c0.y) * (1.f / MBLK), (a0.z + c0.z) * (1.f / MBLK), (a0.w + c0.w) * (1.f / MBLK), (a1.x + c1.x) * (1.f / MBLK), (a1.y + c1.y) * (1.f / MBLK), (a1.z + c1.z) * (1.f / MBLK), (a1.w + c1.w) * (1.f / MBLK)};
              *(LAS bf16x8*)(Kimg + attn_off(n, 2 * c + half)) = pack8f(f); } }
        if (F.tid < 64) lcnt[F.tid] = 0;
        __syncthreads();
        float bv[3] = {-INFINITY, -INFINITY, -INFINITY}; int bi[3] = {0, 0, 0};
        if (qblk > 0) {
            bf16x8 qf[8];
#pragma unroll
            for (int ks = 0; ks < 8; ++ks) qf[ks] = *(const bf16x8*)(QA + (size_t)q * DM + h * HD + 16 * ks + 8 * hh);
            const int nt = (qblk > 32) ? 2 : 1;
            for (int tn = 0; tn < nt; ++tn) {
                f32x16 acc;
#pragma unroll
                for (int i = 0; i < 16; ++i) acc[i] = 0.f;
#pragma unroll
                for (int ks = 0; ks < 8; ++ks) { const bf16x8 kf = *(const LAS bf16x8*)(Kimg + attn_off(32 * tn + r, 2 * ks + hh)); acc = __builtin_amdgcn_mfma_f32_32x32x16_bf16(kf, qf[ks], acc, 0, 0, 0); }
#pragma unroll
                for (int i = 0; i < 16; ++i) { const int n = 32 * tn + (i & 3) + 8 * (i >> 2) + 4 * hh; const float v = (n < qblk) ? acc[i] : -INFINITY;
                    const bool g0 = v > bv[0], g1 = v > bv[1], g2 = v > bv[2];
                    bv[2] = g1 ? bv[1] : (g2 ? v : bv[2]); bi[2] = g1 ? bi[1] : (g2 ? n : bi[2]);
                    bv[1] = g0 ? bv[0] : (g1 ? v : bv[1]); bi[1] = g0 ? bi[0] : (g1 ? n : bi[1]);
                    bv[0] = g0 ? v : bv[0]; bi[0] = g0 ? n : bi[0]; }
            }
            float ov[3]; int oi[3];
#pragma unroll
            for (int k = 0; k < 3; ++k) { ov[k] = __shfl_xor(bv[k], 32); oi[k] = __shfl_xor(bi[k], 32); }
#pragma unroll
            for (int k = 0; k < 3; ++k) { const float v = ov[k]; const int n = oi[k];
#define TK_GT(v_, n_, w_, m_) ((v_) > (w_) || ((v_) == (w_) && (n_) < (m_)))
                const bool ok = v > -INFINITY, g0 = ok && TK_GT(v, n, bv[0], bi[0]), g1 = ok && TK_GT(v, n, bv[1], bi[1]), g2 = ok && TK_GT(v, n, bv[2], bi[2]);
                bv[2] = g1 ? bv[1] : (g2 ? v : bv[2]); bi[2] = g1 ? bi[1] : (g2 ? n : bi[2]);
                bv[1] = g0 ? bv[0] : (g1 ? v : bv[1]); bi[1] = g0 ? bi[0] : (g1 ? n : bi[1]);
                bv[0] = g0 ? v : bv[0]; bi[0] = g0 ? n : bi[0]; }
        }
        int rank[3] = {0, 0, 0}; bool valid[3];
#pragma unroll
        for (int k = 0; k < 3; ++k) { valid[k] = (hh == 0) && (k < qblk) && (bv[k] > -INFINITY);
            if (valid[k]) rank[k] = __hip_atomic_fetch_add(lcnt + bi[k], 1, __ATOMIC_RELAXED, __HIP_MEMORY_SCOPE_WORKGROUP);
            else if (hh == 0) ML[((size_t)k * S + q) * NH + h] = (f32x2_t){-INFINITY, 0.f}; }
        __syncthreads();
        if (F.tid < 64) { const int c = lcnt[F.tid]; if (c > 0) lbase[F.tid] = (int)__hip_atomic_fetch_add(CNT + h * NBLK + F.tid, (unsigned)c, __ATOMIC_RELAXED, __HIP_MEMORY_SCOPE_AGENT); }
        __syncthreads();
#pragma unroll
        for (int k = 0; k < 3; ++k) if (valid[k]) BUCKET[(size_t)h * BUCKET_PER_HEAD + bucket_off(bi[k]) + lbase[bi[k]] + rank[k]] = (unsigned short)((q << 2) | k);
    }
    __syncthreads();
}
__device__ __forceinline__ bf16* op_slot(Frame& F, int r) { return r < 2 ? (bf16*)F.out + (size_t)r * S * DM : WSP(bf16, WS_OP2); }
__device__ __forceinline__ void p_attn_sel(Frame& F, const Args& A) {
    const bf16* QA = WSP(bf16, WS_R1); const bf16* KA = WSP(bf16, WS_R1 + T32); const bf16* VA = WSP(bf16, WS_R1 + 2 * T32);
    const unsigned* CNT = WSP(const unsigned, WS_CTL) + CW_CNT; const unsigned short* BUCKET = WSP(const unsigned short, WS_BUCKET); f32x2_t* ML = WSP(f32x2_t, WS_ML);
    LAS unsigned char* Kimg = F.lds; LAS unsigned char* Vimg = F.lds + 65536; LAS int* pre = (LAS int*)(F.lds + LDSCTL_OFF + 1024);
    __syncthreads();
    { const int nb = (int)((CNT[F.tid] + 255u) >> 8);
      int inc = nb;
#pragma unroll
      for (int o = 1; o < 64; o <<= 1) { const int v = __shfl_up(inc, o); if (F.lane >= o) inc += v; }
      LAS int* wtot = pre + 520;
      if (F.lane == 63) wtot[F.wave] = inc;
      __syncthreads();
      int base = 0;
#pragma unroll
      for (int w = 0; w < NWAVES; ++w) base += (w < F.wave) ? wtot[w] : 0;
      pre[F.tid] = base + inc - nb;
      if (F.tid == NWAVES * 64 - 1) pre[NH * NBLK] = base + inc; }
    __syncthreads();
    const int total = pre[NH * NBLK];
#define AS_DECODE(u_, h_, kb_, b_, cnt_) do { int lo_ = 0, hi_ = NH * NBLK - 1; while (lo_ < hi_) { const int mid_ = (lo_ + hi_ + 1) >> 1; if (pre[mid_] <= (u_)) lo_ = mid_; else hi_ = mid_ - 1; } \
        h_ = lo_ >> 6; kb_ = lo_ & 63; b_ = (u_) - pre[lo_]; cnt_ = (int)CNT[lo_]; } while (0)
#define AS_LOADKV(h_, kb_) do { const bf16* ks_ = KA + (size_t)((kb_) * MBLK) * DM + (h_) * HD; const bf16* vs_ = VA + (size_t)((kb_) * MBLK) * DM + (h_) * HD; \
        _Pragma("unroll") for (int i = 0; i < 8; ++i) { const int n_ = F.tid + 512 * i, row_ = n_ >> 4, ch_ = n_ & 15; kr[i] = *(const u32x4*)(ks_ + (size_t)row_ * DM + 8 * ch_); vr[i] = *(const u32x4*)(vs_ + (size_t)row_ * DM + 8 * ch_); } } while (0)
    const int hh = F.lane >> 5;
    bf16x8 qf[8];
    const int u1 = (int)(((long long)(blockIdx.x + 1) * total) / F.G); int hs = -1, kbs = -1;
    int u = (int)(((long long)blockIdx.x * total) / F.G), h = 0, kb = 0, b = 0, cnt = 0, q = 0, r = 0; bool valid = false;
    if (u < u1) { AS_DECODE(u, h, kb, b, cnt);
        const int e = 256 * b + 32 * F.wave + (F.lane & 31); valid = e < cnt;
        const unsigned ent = BUCKET[(size_t)h * BUCKET_PER_HEAD + bucket_off(kb) + (valid ? e : 256 * b)]; q = (int)(ent >> 2); r = (int)(ent & 3u);
#pragma unroll
        for (int ks = 0; ks < 8; ++ks) qf[ks] = *(const bf16x8*)(QA + (size_t)q * DM + h * HD + 16 * ks + 8 * hh); }
    while (u < u1) {
        if (h != hs || kb != kbs) {
            __syncthreads();
            attn_stage(KA + (size_t)(kb * MBLK) * DM + h * HD, Kimg, F.tid); attn_stage(VA + (size_t)(kb * MBLK) * DM + h * HD, Vimg, F.tid);
            __syncthreads(); hs = h; kbs = kb; }
        const int un = u + 1; int hn = 0, kbn = 0, bn = 0, cntn = 0; unsigned entn = 0u; bool validn = false;
        if (un < u1) { AS_DECODE(un, hn, kbn, bn, cntn);
            const int e = 256 * bn + 32 * F.wave + (F.lane & 31); validn = e < cntn;
            entn = BUCKET[(size_t)hn * BUCKET_PER_HEAD + bucket_off(kbn) + (validn ? e : 256 * bn)]; }
        AttnState st; attn_wave<8>(qf, Kimg, Vimg, 8, -1, F.lane, st);
        const int qc = q, rc = r, hc = h; const bool vc = valid;
        if (un < u1) { q = (int)(entn >> 2); r = (int)(entn & 3u); h = hn; kb = kbn; valid = validn;
#pragma unroll
            for (int ks = 0; ks < 8; ++ks) qf[ks] = *(const bf16x8*)(QA + (size_t)q * DM + h * HD + 16 * ks + 8 * hh); }
        if (vc) {
            bf16* op = op_slot(F, rc) + (size_t)qc * DM + hc * HD + 64 * hh;
#pragma unroll
            for (int c = 0; c < 4; ++c)
#pragma unroll
                for (int g2 = 0; g2 < 2; ++g2) { u32x4 w; w.x = cvtpk(st.o[c][8 * g2], st.o[c][8 * g2 + 1]); w.y = cvtpk(st.o[c][8 * g2 + 2], st.o[c][8 * g2 + 3]); w.z = cvtpk(st.o[c][8 * g2 + 4], st.o[c][8 * g2 + 5]); w.w = cvtpk(st.o[c][8 * g2 + 6], st.o[c][8 * g2 + 7]);
                    *(u32x4*)(op + 16 * c + 8 * g2) = w; }
            if (hh == 0) ML[((size_t)rc * S + qc) * NH + hc] = (f32x2_t){st.m, st.l}; }
        u = un;
    }
    __syncthreads();
}
__device__ __forceinline__ void p_attn_own(Frame& F, const Args& A) {
    const bf16* QA = WSP(bf16, WS_R1); const bf16* KA = WSP(bf16, WS_R1 + T32); const bf16* VA = WSP(bf16, WS_R1 + 2 * T32); const f32x2_t* ML = WSP(const f32x2_t, WS_ML); bf16* YA = WSP(bf16, WS_YA);
    LAS unsigned char* Kimg = F.lds; LAS unsigned char* Vimg = F.lds + 65536;
    for (int u = blockIdx.x; u < NH * NBLK; u += F.G) { const int h = u & 7, qb = u >> 3;
        __syncthreads();
        attn_stage(KA + (size_t)(qb * MBLK) * DM + h * HD, Kimg, F.tid); attn_stage(VA + (size_t)(qb * MBLK) * DM + h * HD, Vimg, F.tid);
        __syncthreads();
        const int q = qb * MBLK + 32 * F.wave + (F.lane & 31), hh = F.lane >> 5;
        bf16x8 qf[8];
#pragma unroll
        for (int ks = 0; ks < 8; ++ks) qf[ks] = *(const bf16x8*)(QA + (size_t)q * DM + h * HD + 16 * ks + 8 * hh);
        AttnState st; attn_wave<0>(qf, Kimg, Vimg, F.wave + 1, F.wave, F.lane, st);
        float mr[3], lr[3], M = st.m;
#pragma unroll
        for (int r = 0; r < 3; ++r) { const f32x2_t ml = ML[((size_t)r * S + q) * NH + h]; mr[r] = ml.x; lr[r] = ml.y; M = fmaxf(M, ml.x); }
        const float w0 = __builtin_amdgcn_exp2f(st.m - M); float L = st.l * w0; float wr[3];
#pragma unroll
        for (int r = 0; r < 3; ++r) { wr[r] = (lr[r] > 0.f) ? __builtin_amdgcn_exp2f(mr[r] - M) : 0.f; L += lr[r] * wr[r]; }
        const float iL = rcp_(L);
        const size_t pbase = (size_t)q * DM + h * HD + 64 * hh;
        const bf16* ps0 = op_slot(F, 0) + pbase; const bf16* ps1 = op_slot(F, 1) + pbase; const bf16* ps2 = op_slot(F, 2) + pbase;
#pragma unroll
        for (int half = 0; half < 2; ++half) {
            bf16x8 pl[4][3];
#pragma unroll
            for (int k = 0; k < 4; ++k) { pl[k][0] = *(const bf16x8*)(ps0 + 32 * half + 8 * k); pl[k][1] = *(const bf16x8*)(ps1 + 32 * half + 8 * k); pl[k][2] = *(const bf16x8*)(ps2 + 32 * half + 8 * k); }
            __builtin_amdgcn_sched_barrier(0);
#pragma unroll
            for (int k = 0; k < 4; ++k) { const int c = 2 * half + (k >> 1), g2 = k & 1;
                float v[8];
#pragma unroll
                for (int e = 0; e < 8; ++e) v[e] = st.o[c][8 * g2 + e] * w0;
#pragma unroll
                for (int r = 0; r < 3; ++r) { float pf[8]; unpack8f(pl[k][r], pf); const bool on = wr[r] != 0.f;
#pragma unroll
                    for (int e = 0; e < 8; ++e) v[e] += on ? wr[r] * pf[e] : 0.f; }
                u32x2 wa, wb; wa.x = cvtpk(v[0] * iL, v[1] * iL); wa.y = cvtpk(v[2] * iL, v[3] * iL); wb.x = cvtpk(v[4] * iL, v[5] * iL); wb.y = cvtpk(v[6] * iL, v[7] * iL);
                bf16* yp = YA + (size_t)q * DM + h * HD + 32 * c + 16 * g2 + 4 * hh; *(u32x2*)yp = wa; *(u32x2*)(yp + 8) = wb; }
        }
    }
    __syncthreads();
}
__device__ __forceinline__ void p_dn_conv(Frame& F, const Args& A) {
    const bf16* QB = WSP(bf16, WS_R1); const bf16* KB = WSP(bf16, WS_R1 + T32); const bf16* VB = WSP(bf16, WS_R1 + 2 * T32);
    bf16* QN = (bf16*)F.out; bf16* KN = (bf16*)F.out + (size_t)S * DM; bf16* VN = WSP(bf16, WS_VN);
    const float* cw = A.in[3]; const float* BA = WSP(const float, WS_BA); float* BETA = WSP(float, WS_BETA); float* G = WSP(float, WS_G);
    for (int it = F.gw; it < S * NH; it += F.NGW) { const int t = it >> 3, h = it & 7, c = h * HD + 2 * F.lane;
        float aq0 = 0.f, aq1 = 0.f, ak0 = 0.f, ak1 = 0.f, av0 = 0.f, av1 = 0.f;
#pragma unroll
        for (int j = 0; j < 4; ++j) { const int tt = t + j - 3; if (tt < 0) continue;
            const unsigned xq = *(const unsigned*)(QB + (size_t)tt * DM + c), xk = *(const unsigned*)(KB + (size_t)tt * DM + c), xv = *(const unsigned*)(VB + (size_t)tt * DM + c);
            const float* w = cw + (size_t)j * 3072;
            aq0 += w[c] * bflo(xq); aq1 += w[c + 1] * bfhi(xq); ak0 += w[1024 + c] * bflo(xk); ak1 += w[1024 + c + 1] * bfhi(xk); av0 += w[2048 + c] * bflo(xv); av1 += w[2048 + c + 1] * bfhi(xv); }
        aq0 = siluf_(aq0); aq1 = siluf_(aq1); ak0 = siluf_(ak0); ak1 = siluf_(ak1); av0 = siluf_(av0); av1 = siluf_(av1);
        const float rq = rsq_(wave_sum(aq0 * aq0 + aq1 * aq1) + EPS) * 0.08838834764831845f, rk = rsq_(wave_sum(ak0 * ak0 + ak1 * ak1) + EPS);
        *(unsigned*)(QN + (size_t)t * DM + c) = pk2(aq0 * rq, aq1 * rq); *(unsigned*)(KN + (size_t)t * DM + c) = pk2(ak0 * rk, ak1 * rk); *(unsigned*)(VN + (size_t)t * DM + c) = pk2(av0, av1);
        if (F.lane == 0) { const float b = BA[(size_t)t * 16 + h], a = BA[(size_t)t * 16 + 8 + h] + A.in[5][h];
            const float sp = (a > 20.f) ? a : log1pf(expf(a));
            BETA[(size_t)t * 8 + h] = 1.f / (1.f + expf(-b)); G[(size_t)t * 8 + h] = -expf(A.in[4][h]) * sp; } }
}
__device__ __forceinline__ void p_dn_chunk(Frame& F, const Args& A) {
    const bf16* QN = (const bf16*)F.out; const bf16* KN = (const bf16*)F.out + (size_t)S * DM; bf16* VU = WSP(bf16, WS_VN); bf16* Wb = WSP(bf16, WS_W); bf16* ATT = WSP(bf16, WS_ATT);
    const float* BETA = WSP(const float, WS_BETA); const float* G = WSP(const float, WS_G); float* GC = WSP(float, WS_GC);
    LAS float* Kc = (LAS float*)(F.lds); LAS float* Qc = Kc + 64 * 132; LAS float* Lm = Qc + 64 * 132; LAS float* Tm = Lm + 64 * 65; LAS float* gcs = Tm + 64 * 65; LAS float* bes = gcs + 64; LAS float* bge = bes + 64;
    const int tid = F.tid;
    for (int item = blockIdx.x; item < NCH * NH; item += F.G) { const int n = item >> 3, h = item & 7, t0 = n * CH;
        __syncthreads();
        if (tid < 64) { gcs[tid] = G[(size_t)(t0 + tid) * 8 + h]; bes[tid] = BETA[(size_t)(t0 + tid) * 8 + h]; }
        __syncthreads();
        if (tid == 0) { float a = 0.f; for (int i = 0; i < 64; ++i) { a += gcs[i]; gcs[i] = a; } }
#pragma unroll
        for (int r = 0; r < 2; ++r) { const int idx = tid + 512 * r, row = idx >> 4, c8 = idx & 15;
            const u32x4 kv = *(const u32x4*)(KN + (size_t)(t0 + row) * DM + h * HD + 8 * c8), qv = *(const u32x4*)(QN + (size_t)(t0 + row) * DM + h * HD + 8 * c8);
            LAS float* kd = Kc + row * 132 + 8 * c8; LAS float* qd = Qc + row * 132 + 8 * c8;
            kd[0] = bflo(kv.x); kd[1] = bfhi(kv.x); kd[2] = bflo(kv.y); kd[3] = bfhi(kv.y); kd[4] = bflo(kv.z); kd[5] = bfhi(kv.z); kd[6] = bflo(kv.w); kd[7] = bfhi(kv.w);
            qd[0] = bflo(qv.x); qd[1] = bfhi(qv.x); qd[2] = bflo(qv.y); qd[3] = bfhi(qv.y); qd[4] = bflo(qv.z); qd[5] = bfhi(qv.z); qd[6] = bflo(qv.w); qd[7] = bfhi(qv.w); }
        __syncthreads();
        if (tid < 64) { GC[(size_t)(t0 + tid) * 8 + h] = gcs[tid]; bge[tid] = bes[tid] * expf(gcs[tid]); }
        for (int r = 0; r < 8; ++r) { const int p = tid + 512 * r, i = p >> 6, j = p & 63;
            float dk = 0.f, dq = 0.f;
            if (j <= i) { const LAS float* ki = Kc + i * 132; const LAS float* kj = Kc + j * 132; const LAS float* qi = Qc + i * 132;
                for (int d = 0; d < HD; ++d) { dk += ki[d] * kj[d]; dq += qi[d] * kj[d]; } }
            const float dec = (j <= i) ? expf(gcs[i] - gcs[j]) : 0.f;
            Lm[i * 65 + j] = (j < i) ? bes[i] * dk * dec : 0.f;
            ATT[((size_t)(h * NCH + n) * 64 + i) * 64 + j] = (bf16)f2bf((j <= i) ? dq * dec : 0.f); }
        __syncthreads();
        if (tid < 64) { const int c = tid;
            for (int i = 0; i < 64; ++i) { float acc = (i == c) ? 1.f : 0.f; for (int j = 0; j < i; ++j) acc -= Lm[i * 65 + j] * Tm[j * 65 + c]; Tm[i * 65 + c] = acc; } }
        __syncthreads();
#pragma unroll
        for (int r = 0; r < 2; ++r) { const int idx = tid + 512 * r, row = idx >> 4, c8 = idx & 15;
            const u32x4 vv = *(const u32x4*)(VU + (size_t)(t0 + row) * DM + h * HD + 8 * c8); LAS float* vd = Qc + row * 132 + 8 * c8;
            vd[0] = bflo(vv.x); vd[1] = bfhi(vv.x); vd[2] = bflo(vv.y); vd[3] = bfhi(vv.y); vd[4] = bflo(vv.z); vd[5] = bfhi(vv.z); vd[6] = bflo(vv.w); vd[7] = bfhi(vv.w); }
        __syncthreads();
        { const int d = tid & 127, ig = tid >> 7;
          for (int ii = 0; ii < 16; ++ii) { const int i = ig * 16 + ii; float au = 0.f, aw = 0.f;
              for (int j = 0; j <= i; ++j) { const float t = Tm[i * 65 + j]; au += t * bes[j] * Qc[j * 132 + d]; aw += t * bge[j] * Kc[j * 132 + d]; }
              VU[(size_t)(t0 + i) * DM + h * HD + d] = (bf16)f2bf(au); Wb[(size_t)(t0 + i) * DM + h * HD + d] = (bf16)f2bf(aw); } }
    }
    __syncthreads();
}
__device__ __forceinline__ void p_dn_scan_naive(Frame& F, const Args& A) {
    if (blockIdx.x < 4) {
    const bf16* QN = (const bf16*)F.out; const bf16* KN = (const bf16*)F.out + (size_t)S * DM; const bf16* U = WSP(const bf16, WS_VN); const bf16* Wb = WSP(const bf16, WS_W); const bf16* ATT = WSP(const bf16, WS_ATT);
    const float* GC = WSP(const float, WS_GC); bf16* O = WSP(bf16, WS_O);
    LAS float* vn = (LAS float*)F.lds;
    const int tid = F.tid, wv = tid >> 6, h = blockIdx.x * 2 + (wv >> 2), e = (wv & 3) * 32 + (F.lane & 31), half = F.lane >> 5;
    float s[64];
#pragma unroll
    for (int d = 0; d < 64; ++d) s[d] = 0.f;
    for (int n = 0; n < NCH; ++n) { const int t0 = n * CH; const float gl = GC[(size_t)(t0 + 63) * 8 + h];
        for (int c = 0; c < 64; ++c) { const size_t ro = (size_t)(t0 + c) * DM + h * HD; const bf16* wp = Wb + ro + 64 * half; float a = 0.f;
#pragma unroll
            for (int d8 = 0; d8 < 8; ++d8) { if ((d8 & 1) == 0) asm volatile("" ::: "memory"); const u32x4 wv4 = *(const u32x4*)(wp + 8 * d8);
                a += bflo(wv4.x) * s[8 * d8] + bfhi(wv4.x) * s[8 * d8 + 1] + bflo(wv4.y) * s[8 * d8 + 2] + bfhi(wv4.y) * s[8 * d8 + 3] + bflo(wv4.z) * s[8 * d8 + 4] + bfhi(wv4.z) * s[8 * d8 + 5] + bflo(wv4.w) * s[8 * d8 + 6] + bfhi(wv4.w) * s[8 * d8 + 7]; }
            a += __shfl_xor(a, 32);
            vn[c * 512 + tid] = bf2f(U[ro + e]) - a; }
        for (int c = 0; c < 64; ++c) { const size_t ro = (size_t)(t0 + c) * DM + h * HD; const bf16* qp = QN + ro + 64 * half; float a = 0.f;
#pragma unroll
            for (int d8 = 0; d8 < 8; ++d8) { if ((d8 & 1) == 0) asm volatile("" ::: "memory"); const u32x4 wv4 = *(const u32x4*)(qp + 8 * d8);
                a += bflo(wv4.x) * s[8 * d8] + bfhi(wv4.x) * s[8 * d8 + 1] + bflo(wv4.y) * s[8 * d8 + 2] + bfhi(wv4.y) * s[8 * d8 + 3] + bflo(wv4.z) * s[8 * d8 + 4] + bfhi(wv4.z) * s[8 * d8 + 5] + bflo(wv4.w) * s[8 * d8 + 6] + bfhi(wv4.w) * s[8 * d8 + 7]; }
            a += __shfl_xor(a, 32);
            a *= expf(GC[(size_t)(t0 + c) * 8 + h]);
            const bf16* ap = ATT + ((size_t)(h * NCH + n) * 64 + c) * 64; float b = 0.f;
            for (int j = 0; j <= c; ++j) b += bf2f(ap[j]) * vn[j * 512 + tid];
            if (half == 0) O[ro + e] = (bf16)f2bf(a + b); }
        const float egl = expf(gl);
#pragma unroll
        for (int d = 0; d < 64; ++d) s[d] *= egl;
        for (int c = 0; c < 64; ++c) { const size_t ro = (size_t)(t0 + c) * DM + h * HD; const bf16* kp = KN + ro + 64 * half; const float f = vn[c * 512 + tid] * expf(gl - GC[(size_t)(t0 + c) * 8 + h]);
#pragma unroll
            for (int d8 = 0; d8 < 8; ++d8) { if ((d8 & 1) == 0) asm volatile("" ::: "memory"); const u32x4 wv4 = *(const u32x4*)(kp + 8 * d8);
                s[8 * d8] += f * bflo(wv4.x); s[8 * d8 + 1] += f * bfhi(wv4.x); s[8 * d8 + 2] += f * bflo(wv4.y); s[8 * d8 + 3] += f * bfhi(wv4.y); s[8 * d8 + 4] += f * bflo(wv4.z); s[8 * d8 + 5] += f * bfhi(wv4.z); s[8 * d8 + 6] += f * bflo(wv4.w); s[8 * d8 + 7] += f * bfhi(wv4.w); } }
    }
    }
}
__device__ __forceinline__ void p_dn_out(Frame& F, const Args& A) {
    const bf16* O = WSP(const bf16, WS_O); const bf16* Z = WSP(const bf16, WS_Z); bf16* YD = WSP(bf16, WS_YD); const float* ow = A.in[6];
    for (int it = F.gw; it < S * NH; it += F.NGW) { const int t = it >> 3, h = it & 7; const size_t off = (size_t)t * DM + h * HD + 2 * F.lane;
        const unsigned ov = *(const unsigned*)(O + off), zv = *(const unsigned*)(Z + off); const float o0 = bflo(ov), o1 = bfhi(ov);
        const float rs = rsq_(wave_sum(o0 * o0 + o1 * o1) * (1.f / HD) + EPS);
        *(unsigned*)(YD + off) = pk2(o0 * rs * ow[2 * F.lane] * siluf_(bflo(zv)), o1 * rs * ow[2 * F.lane + 1] * siluf_(bfhi(zv))); }
}


constexpr size_t WS_UT = WS_O;
constexpr size_t WS_KT = WS_VN;
constexpr size_t WS_EGL = WS_KMEAN;
typedef float f32x4_t __attribute__((ext_vector_type(4)));

__device__ __forceinline__ void p_dn_relayout1(Frame& F, const Args& A) {
    bf16* QN = (bf16*)F.out; bf16* Wb = WSP(bf16, WS_W); const bf16* U = WSP(const bf16, WS_VN); bf16* UT = WSP(bf16, WS_UT); const float* GC = WSP(const float, WS_GC); float* EGL = WSP(float, WS_EGL);
    LAS unsigned short* tile = (LAS unsigned short*)(F.lds + F.wave * 16640);
    for (int it = F.gw; it < NCH * NH; it += F.NGW) { const int n = it >> 3, h = it & 7, t0 = n * CH;
        if (F.lane == 0) EGL[h * NCH + n] = expf(GC[(size_t)(t0 + 63) * 8 + h]);
        for (int c = 0; c < 64; ++c) { const size_t off = (size_t)(t0 + c) * DM + h * HD + 2 * F.lane; const float eg = expf(GC[(size_t)(t0 + c) * 8 + h]);
            const unsigned qv = *(const unsigned*)(QN + off); *(unsigned*)(QN + off) = pk2(bflo(qv) * eg, bfhi(qv) * eg);
            const unsigned wv = *(const unsigned*)(Wb + off); *(unsigned*)(Wb + off) = wv ^ 0x80008000u;
            const unsigned uv = *(const unsigned*)(U + off); *(LAS unsigned*)(tile + c * 130 + 2 * F.lane) = uv; }
        asm volatile("s_waitcnt lgkmcnt(0)" ::: "memory");
        bf16* ut = UT + (size_t)(h * NCH + n) * (HD * CH);
        for (int e = 0; e < HD; ++e) ut[e * CH + F.lane] = tile[F.lane * 130 + e];
        asm volatile("s_waitcnt lgkmcnt(0)" ::: "memory");
    }
}
__device__ __forceinline__ void p_dn_relayout2(Frame& F, const Args& A) {
    const bf16* KN = (const bf16*)F.out + (size_t)S * DM; bf16* KT = WSP(bf16, WS_KT); const float* GC = WSP(const float, WS_GC);
    LAS unsigned short* tile = (LAS unsigned short*)(F.lds + F.wave * 16640);
    for (int it = F.gw; it < NCH * NH; it += F.NGW) { const int n = it >> 3, h = it & 7, t0 = n * CH;
        for (int c = 0; c < 64; ++c) { const size_t off = (size_t)(t0 + c) * DM + h * HD + 2 * F.lane; *(LAS unsigned*)(tile + c * 130 + 2 * F.lane) = *(const unsigned*)(KN + off); }
        asm volatile("s_waitcnt lgkmcnt(0)" ::: "memory");
        const float f = expf(GC[(size_t)(t0 + 63) * 8 + h] - GC[(size_t)(t0 + F.lane) * 8 + h]);
        bf16* kt = KT + (size_t)(h * NCH + n) * (HD * CH);
        for (int d = 0; d < HD; ++d) kt[d * CH + F.lane] = (bf16)f2bf(bf2f(tile[F.lane * 130 + d]) * f);
        asm volatile("s_waitcnt lgkmcnt(0)" ::: "memory");
    }
}

constexpr size_t WS2_QN = WS_R1, WS2_KN = WS_R1 + T32, WS2_WNEG = WS_R1 + 2 * T32, WS2_ATT = WS_H, WS2_YD = WS_R1 + 2 * T32, WS2_HALT = WS_R1 + T32;
__device__ __forceinline__ bf16* ws2_kt(Frame& F) { return (bf16*)F.out; }
__device__ __forceinline__ bf16* ws2_ut(Frame& F) { return (bf16*)F.out + (size_t)S * DM; }

struct ConvHalo { unsigned q[3], k[3], v[3]; };
__device__ __forceinline__ void p_dn_conv2_halo(Frame& F, ConvHalo& H) {
    const bf16* QB = WSP(bf16, WS_R1); const bf16* KB = WSP(bf16, WS_R1 + T32); const bf16* VB = WSP(bf16, WS_R1 + 2 * T32);
    const int n = F.gw >> 3, h = F.gw & 7, t0 = n * CH, col = h * HD + 2 * F.lane;
#pragma unroll
    for (int j = 0; j < 3; ++j) { const int tt = t0 - 3 + j; H.q[j] = H.k[j] = H.v[j] = 0u;
        if (tt >= 0 && F.gw < NCH * NH) { H.q[j] = *(const unsigned*)(QB + (size_t)tt * DM + col); H.k[j] = *(const unsigned*)(KB + (size_t)tt * DM + col); H.v[j] = *(const unsigned*)(VB + (size_t)tt * DM + col); } }
}
struct ConvW { float w0[4], w1[4]; };
__device__ __forceinline__ void conv_w(const float* cw, int col, ConvW& W) {
#pragma unroll
    for (int j = 0; j < 4; ++j) { W.w0[j] = cw[(size_t)j * 3072 + col]; W.w1[j] = cw[(size_t)j * 3072 + col + 1]; }
}
__device__ __forceinline__ __amdgpu_buffer_rsrc_t mk_rsrc(const void* p) { return __builtin_amdgcn_make_buffer_rsrc((void*)p, 0, 0x7fffffff, 0x00020000); }
__device__ __forceinline__ void conv_load(const bf16* src, int t0, int col, unsigned (&xall)[CH]) {
    const __amdgpu_buffer_rsrc_t r = mk_rsrc(src + (size_t)t0 * DM);
#pragma unroll
    for (int c = 0; c < CH; ++c) xall[c] = __builtin_amdgcn_raw_buffer_load_b32(r, 2 * col, c * (DM * 2), 0);
}
template <bool NORM, bool DST, bool TILE> __device__ __forceinline__ void conv_pass(const unsigned (&xall)[CH], bf16* dst, LAS unsigned short* tile, const ConvW& W, const unsigned (&halo)[3], int t0, int col, int lane, float scale) {
    float a0 = bflo(halo[0]), a1 = bfhi(halo[0]), b0 = bflo(halo[1]), b1 = bfhi(halo[1]), c0 = bflo(halo[2]), c1 = bfhi(halo[2]);
    const __amdgpu_buffer_rsrc_t rd = mk_rsrc(DST ? dst + (size_t)t0 * DM : nullptr);
#pragma unroll
    for (int c = 0; c < CH; ++c) { const unsigned xv = xall[c]; const float d0 = bflo(xv), d1 = bfhi(xv);
        float y0 = siluf_(W.w0[0] * a0 + W.w0[1] * b0 + W.w0[2] * c0 + W.w0[3] * d0), y1 = siluf_(W.w1[0] * a1 + W.w1[1] * b1 + W.w1[2] * c1 + W.w1[3] * d1);
        if (NORM) { const float rs = scale * rsq_(wave_sum(y0 * y0 + y1 * y1) + EPS); y0 *= rs; y1 *= rs; }
        const unsigned o = pk2(y0, y1);
        if (DST) __builtin_amdgcn_raw_buffer_store_b32(o, rd, 2 * col, c * (DM * 2), 0);
        if (TILE) *(LAS unsigned*)(tile + c * 130 + 2 * lane) = o;
        a0 = b0; a1 = b1; b0 = c0; b1 = c1; c0 = d0; c1 = d1; }
}
__device__ __forceinline__ void conv_tile_out(const LAS unsigned short* tile, bf16* dstT, int lane) {
#pragma unroll 4
    for (int i = 0; i < 16; ++i) { const int d = 8 * i + (lane >> 3), ch = lane & 7; const LAS unsigned short* tp = tile + (8 * ch) * 130 + d;
        u32x4 w; w.x = (unsigned)tp[0] | ((unsigned)tp[130] << 16); w.y = (unsigned)tp[260] | ((unsigned)tp[390] << 16); w.z = (unsigned)tp[520] | ((unsigned)tp[650] << 16); w.w = (unsigned)tp[780] | ((unsigned)tp[910] << 16);
        *(u32x4*)(dstT + (size_t)d * CH + 8 * ch) = w; }
}
__device__ __forceinline__ void p_dn_conv2(Frame& F, const Args& A, const ConvHalo& H) {
    if (F.gw >= NCH * NH) return;
    bf16* QB = WSP(bf16, WS_R1); bf16* KB = WSP(bf16, WS_R1 + T32); const bf16* VB = WSP(bf16, WS_R1 + 2 * T32); const float* cw = A.in[3];
    LAS unsigned short* tile = (LAS unsigned short*)(F.lds + F.wave * 16640);
    const int n = F.gw >> 3, h = F.gw & 7, t0 = n * CH, col = h * HD + 2 * F.lane;
    bf16* ktr = ws2_kt(F) + (size_t)(h * NCH + n) * (HD * CH); bf16* vt = ws2_ut(F) + (size_t)(h * NCH + n) * (HD * CH);
    unsigned xa[CH]; ConvW W;
    conv_load(KB, t0, col, xa); conv_w(cw + 1024, col, W);
    conv_pass<true, true, true>(xa, KB, tile, W, H.k, t0, col, F.lane, 1.f);
    asm volatile("s_waitcnt lgkmcnt(0)" ::: "memory");
    conv_load(VB, t0, col, xa); conv_w(cw + 2048, col, W);
    __builtin_amdgcn_sched_barrier(0);
    conv_tile_out(tile, ktr, F.lane);
    asm volatile("s_waitcnt lgkmcnt(0)" ::: "memory");
    conv_pass<false, false, true>(xa, nullptr, tile, W, H.v, t0, col, F.lane, 1.f);
    asm volatile("s_waitcnt lgkmcnt(0)" ::: "memory");
    conv_load(QB, t0, col, xa); conv_w(cw, col, W);
    __builtin_amdgcn_sched_barrier(0);
    conv_tile_out(tile, vt, F.lane);
    asm volatile("s_waitcnt lgkmcnt(0)" ::: "memory");
    conv_pass<true, true, false>(xa, QB, tile, W, H.q, t0, col, F.lane, 0.08838834764831845f);
}

constexpr int CK_WAVE_LDS = 19200;
__device__ __forceinline__ void p_dn_chunk2(Frame& F, const Args& A) {
    if (F.gw >= NCH * NH) return;
    const int n = F.gw >> 3, h = F.gw & 7, t0 = n * CH, lane = F.lane, r = lane & 31, hh = lane >> 5;
    bf16* QN = WSP(bf16, WS2_QN); const bf16* KN = WSP(const bf16, WS2_KN); bf16* Wn = WSP(bf16, WS2_WNEG); bf16* ATT = WSP(bf16, WS2_ATT) + (size_t)(h * NCH + n) * (CH * CH);
    bf16* KT = ws2_kt(F) + (size_t)(h * NCH + n) * (HD * CH); bf16* UT = ws2_ut(F) + (size_t)(h * NCH + n) * (HD * CH);
    const float* BA = WSP(const float, WS_BA); float* EGL = WSP(float, WS_EGL);
    LAS unsigned char* wl = F.lds + F.wave * CK_WAVE_LDS; LAS float* Lw = (LAS float*)wl; LAS float* gcs = (LAS float*)(wl + 18432); LAS float* bes = gcs + 64; LAS float* fcs = bes + 64;
    float beta, gc, gl;
    { const int t = t0 + lane; const float b = BA[(size_t)t * 16 + h], a = BA[(size_t)t * 16 + 8 + h] + A.in[5][h];
      const float sp = (a > 20.f) ? a : log1pf(expf(a)); gc = -expf(A.in[4][h]) * sp; beta = 1.f / (1.f + expf(-b));
#pragma unroll
      for (int o = 1; o < 64; o <<= 1) { const float v = __shfl_up(gc, o); if (lane >= o) gc += v; }
      gl = __shfl(gc, 63);
      gcs[lane] = gc; bes[lane] = beta; fcs[lane] = expf(gl - gc);
      if (lane == 0) EGL[h * NCH + n] = expf(gl); }
    asm volatile("s_waitcnt lgkmcnt(0)" ::: "memory");
    {
        bf16x8 kf[2][8];
#pragma unroll
        for (int ti = 0; ti < 2; ++ti)
#pragma unroll
            for (int ks = 0; ks < 8; ++ks) kf[ti][ks] = *(const bf16x8*)(KN + (size_t)(t0 + 32 * ti + r) * DM + h * HD + 16 * ks + 8 * hh);
#pragma unroll
        for (int tt = 0; tt < 3; ++tt) { const int ti = (tt == 0) ? 0 : 1, tj = (tt == 2) ? 1 : 0;
            f32x16 acc;
#pragma unroll
            for (int i = 0; i < 16; ++i) acc[i] = 0.f;
#pragma unroll
            for (int ks = 0; ks < 8; ++ks) acc = __builtin_amdgcn_mfma_f32_32x32x16_bf16(kf[ti][ks], kf[tj][ks], acc, 0, 0, 0);
            const int j = 32 * tj + r; const float gcj = gcs[j];
#pragma unroll
            for (int g4 = 0; g4 < 4; ++g4) { const int i0 = 32 * ti + 8 * g4 + 4 * hh; const f32x4 gi = *(const LAS f32x4*)(gcs + i0), bi = *(const LAS f32x4*)(bes + i0);
#pragma unroll
                for (int e = 0; e < 4; ++e) { const int i = i0 + e; Lw[i * 68 + j] = (j < i) ? bi[e] * acc[4 * g4 + e] * __expf(gi[e] - gcj) : 0.f; } } }
        bf16x8 qf[2][8];
#pragma unroll
        for (int ti = 0; ti < 2; ++ti)
#pragma unroll
            for (int ks = 0; ks < 8; ++ks) qf[ti][ks] = *(const bf16x8*)(QN + (size_t)(t0 + 32 * ti + r) * DM + h * HD + 16 * ks + 8 * hh);
#pragma unroll
        for (int tt = 0; tt < 3; ++tt) { const int tj = (tt == 2) ? 1 : 0, ti = (tt == 0) ? 0 : 1;
            f32x16 acc;
#pragma unroll
            for (int i = 0; i < 16; ++i) acc[i] = 0.f;
#pragma unroll
            for (int ks = 0; ks < 8; ++ks) acc = __builtin_amdgcn_mfma_f32_32x32x16_bf16(kf[tj][ks], qf[ti][ks], acc, 0, 0, 0);
            const int i = 32 * ti + r; const float gci = gcs[i];
#pragma unroll
            for (int g4 = 0; g4 < 4; ++g4) { const int j0 = 32 * tj + 8 * g4 + 4 * hh; const f32x4 gj = *(const LAS f32x4*)(gcs + j0); float v[4];
#pragma unroll
                for (int e = 0; e < 4; ++e) v[e] = (j0 + e <= i) ? acc[4 * g4 + e] * __expf(gci - gj[e]) : 0.f;
                u32x2 w; w.x = cvtpk(v[0], v[1]); w.y = cvtpk(v[2], v[3]); *(u32x2*)(ATT + (size_t)i * CH + 32 * tj + 16 * (g4 & 1) + 8 * hh + 4 * (g4 >> 1)) = w; } }
        { const u32x4 z4 = {0u, 0u, 0u, 0u}; const int zi = lane >> 1, zj = 32 + 16 * (lane & 1); *(u32x4*)(ATT + (size_t)zi * CH + zj) = z4; *(u32x4*)(ATT + (size_t)zi * CH + zj + 8) = z4; }
#pragma unroll
        for (int ti = 0; ti < 2; ++ti) { const float eg = __expf(gcs[32 * ti + r]);
#pragma unroll
            for (int ks = 0; ks < 8; ++ks) { float f[8]; unpack8f(qf[ti][ks], f);
#pragma unroll
                for (int e = 0; e < 8; ++e) f[e] *= eg;
                const u32x4 pw = __builtin_bit_cast(u32x4, pack8f(f)); bf16* qd = QN + (size_t)(t0 + 32 * ti + r) * DM + h * HD + 32 * (ks >> 1) + 16 * hh + 4 * (ks & 1);
                u32x2 p0, p1; p0.x = pw.x; p0.y = pw.y; p1.x = pw.z; p1.y = pw.w; *(u32x2*)qd = p0; *(u32x2*)(qd + 8) = p1; } }
    }
    asm volatile("s_waitcnt lgkmcnt(0)" ::: "memory");
    float T[64];
#pragma unroll
    for (int i = 0; i < 64; ++i) { float acc = (lane == i) ? 1.f : 0.f;
#pragma unroll
        for (int j = 0; j < i; ++j) acc -= Lw[i * 68 + j] * T[j];
        T[i] = acc; }
    LAS unsigned short* Tb = (LAS unsigned short*)wl; LAS unsigned short* Tbg = Tb + 64 * 72;
    { const float eg = __expf(gc);
      asm volatile("s_waitcnt lgkmcnt(0)" ::: "memory");
#pragma unroll
      for (int i = 0; i < 64; ++i) { const float v = T[i] * beta; Tb[i * 72 + lane] = (unsigned short)f2bf(v); Tbg[i * 72 + lane] = (unsigned short)f2bf(v * eg); } }
    asm volatile("s_waitcnt lgkmcnt(0)" ::: "memory");
#ifdef DBG_CHK
    if (n < 128) { bf16* dump = WSP(bf16, 241 * MiB) + (size_t)(h * 128 + n) * 4096; for (int i = 0; i < 64; ++i) dump[i * 64 + lane] = Tbg[i * 72 + lane]; }
#endif
#ifdef DBG_CHK
    if (n < 32) { bf16* dk = WSP(bf16, 249 * MiB) + (size_t)(h * 32 + n) * 8192; for (int x = 0; x < 128; ++x) dk[x * 64 + lane] = KT[(size_t)x * CH + lane]; }
#endif
#ifdef DN2_VALU_UW
    for (int e = 0; e < HD; ++e) { float a = 0.f; for (int j2 = 0; j2 < 64; ++j2) a += bf2f(Tb[lane * 72 + j2]) * bf2f(UT[(size_t)e * CH + j2]); asm volatile("s_waitcnt vmcnt(0)" ::: "memory"); UT[(size_t)e * CH + lane] = (bf16)f2bf(a); asm volatile("s_waitcnt vmcnt(0)" ::: "memory"); }
    for (int d2 = 0; d2 < HD; ++d2) { float a = 0.f; for (int j2 = 0; j2 < 64; ++j2) a += bf2f(Tbg[lane * 72 + j2]) * bf2f(KT[(size_t)d2 * CH + j2]); Wn[(size_t)(t0 + lane) * DM + h * HD + d2] = (bf16)f2bf(-a); }
#else
#pragma unroll
    for (int te = 0; te < 4; ++te) { bf16x8 vfr[4];
#pragma unroll
        for (int ks2 = 0; ks2 < 4; ++ks2) vfr[ks2] = *(const bf16x8*)(UT + (size_t)(32 * te + r) * CH + 16 * ks2 + 8 * hh);
#pragma unroll
        for (int ti = 0; ti < 2; ++ti) { f32x16 acc;
#pragma unroll
            for (int i = 0; i < 16; ++i) acc[i] = 0.f;
#pragma unroll
            for (int ks2 = 0; ks2 < 4; ++ks2) if (ti == 1 || ks2 < 2) { const bf16x8 tb = *(const LAS bf16x8*)(Tb + (32 * ti + r) * 72 + 16 * ks2 + 8 * hh); acc = __builtin_amdgcn_mfma_f32_32x32x16_bf16(tb, vfr[ks2], acc, 0, 0, 0); }
#pragma unroll
            for (int g4 = 0; g4 < 4; ++g4) { u32x2 w; w.x = cvtpk(acc[4 * g4], acc[4 * g4 + 1]); w.y = cvtpk(acc[4 * g4 + 2], acc[4 * g4 + 3]); *(u32x2*)(UT + (size_t)(32 * te + r) * CH + 32 * ti + 8 * g4 + 4 * hh) = w; } } }
#pragma unroll
    for (int td = 0; td < 4; ++td) { bf16x8 kfr[4];
#pragma unroll
        for (int ks2 = 0; ks2 < 4; ++ks2) kfr[ks2] = *(const bf16x8*)(KT + (size_t)(32 * td + r) * CH + 16 * ks2 + 8 * hh);
#pragma unroll
        for (int tc = 0; tc < 2; ++tc) { f32x16 acc;
#pragma unroll
            for (int i = 0; i < 16; ++i) acc[i] = 0.f;
#pragma unroll
            for (int ks2 = 0; ks2 < 4; ++ks2) if (tc == 1 || ks2 < 2) { const bf16x8 tg = *(const LAS bf16x8*)(Tbg + (32 * tc + r) * 72 + 16 * ks2 + 8 * hh); acc = __builtin_amdgcn_mfma_f32_32x32x16_bf16(kfr[ks2], tg, acc, 0, 0, 0); }
#pragma unroll
            for (int g4 = 0; g4 < 4; ++g4) { u32x2 w; w.x = cvtpk(-acc[4 * g4], -acc[4 * g4 + 1]); w.y = cvtpk(-acc[4 * g4 + 2], -acc[4 * g4 + 3]);
                *(u32x2*)(Wn + (size_t)(t0 + 32 * tc + r) * DM + h * HD + 32 * td + 16 * (g4 & 1) + 8 * hh + 4 * (g4 >> 1)) = w; } } }
#endif
#pragma unroll 4
    for (int p = 0; p < 16; ++p) { const int idx = lane + 64 * p, d = idx >> 3, ch = idx & 7; bf16x8* ptr = (bf16x8*)(KT + (size_t)d * CH + 8 * ch);
        float f[8]; unpack8f(*ptr, f); const f32x4 f0 = *(const LAS f32x4*)(fcs + 8 * ch), f1 = *(const LAS f32x4*)(fcs + 8 * ch + 4);
        f[0] *= f0[0]; f[1] *= f0[1]; f[2] *= f0[2]; f[3] *= f0[3]; f[4] *= f1[0]; f[5] *= f1[1]; f[6] *= f1[2]; f[7] *= f1[3];
        const u32x4 pw = __builtin_bit_cast(u32x4, pack8f(f)); bf16* kd = KT + (size_t)d * CH + 32 * (ch >> 2) + 16 * (ch & 1) + 4 * ((ch >> 1) & 1);
        u32x2 p0, p1; p0.x = pw.x; p0.y = pw.y; p1.x = pw.z; p1.y = pw.w; *(u32x2*)kd = p0; *(u32x2*)(kd + 8) = p1; }
}

#ifndef DN2
#define DN2 1
#endif
#if DN2
#define SCAN_WNEG WS2_WNEG
#define SCAN_QP WSP(const bf16, WS2_QN)
#define SCAN_KT ws2_kt(F)
#define SCAN_UT ws2_ut(F)
#define SCAN_ATT WS2_ATT
#define SCAN_YD WS2_YD
#else
#define SCAN_WNEG WS_W
#define SCAN_QP ((const bf16*)F.out)
#define SCAN_KT WSP(bf16, WS_KT)
#define SCAN_UT WSP(bf16, WS_UT)
#define SCAN_ATT WS_ATT
#define SCAN_YD WS_YD
#endif
constexpr int SC_RW = 288, SC_RK = 160;
constexpr int SC_W = 0, SC_Q = 64 * SC_RW, SC_K = 2 * 64 * SC_RW, SC_A = SC_K + 128 * SC_RK, SC_BUF = SC_A + 64 * SC_RK;
__device__ __forceinline__ bf16x8 frag2(const LAS unsigned char* p) {
    const u32x2 a = *(const LAS u32x2*)p, b = *(const LAS u32x2*)(p + 32); u32x4 w; w.x = a.x; w.y = a.y; w.z = b.x; w.w = b.y; return __builtin_bit_cast(bf16x8, w);
}
__device__ __forceinline__ bf16x8 packb(const f32x4_t a, const f32x4_t b) { u32x4 w; w.x = cvtpk(a[0], a[1]); w.y = cvtpk(a[2], a[3]); w.z = cvtpk(b[0], b[1]); w.w = cvtpk(b[2], b[3]); return __builtin_bit_cast(bf16x8, w); }
constexpr int SCAN_WGS = 16;
__device__ __forceinline__ void p_dn_scan_fast(Frame& F, const Args& A) {
    if (blockIdx.x < SCAN_WGS) {
    const int h = blockIdx.x >> 1, hf = blockIdx.x & 1;
    const bf16* Wb = WSP(const bf16, SCAN_WNEG); const bf16* QP = SCAN_QP; const bf16* KT = SCAN_KT; const bf16* ATT = WSP(const bf16, SCAN_ATT); bf16* UT = SCAN_UT; const float* EGL = WSP(const float, WS_EGL);
    if (F.wave >= 4) {
        const int lt = F.tid - 256;
#if defined(SCAN_PROBE) && SCAN_PROBE == 2
        unsigned long long lp_sum = 0ull, lp_t0 = 0ull;
#define SCP_T0() (lp_t0 = __builtin_amdgcn_s_memrealtime())
#define SCP_T1() (lp_sum += __builtin_amdgcn_s_memrealtime() - lp_t0)
#else
#define SCP_T0() ((void)0)
#define SCP_T1() ((void)0)
#endif
        u32x4 rwA[4], rqA[4], rkA[4], raA[2], rwB[4], rqB[4], rkB[4], raB[2], rwC[4], rqC[4], rkC[4], raC[2];
#define SC_GLD(dst, voff, sbase) asm volatile("global_load_dwordx4 %0, %1, %2" : "=v"(dst) : "v"(voff), "s"(sbase) : "memory")
        const unsigned vo_w = (unsigned)((lt >> 4) * (DM * 2) + (lt & 15) * 16), vo_t = (unsigned)lt * 16u;
#define SC_ISSUE(n_, X) do { const bf16* bw_ = Wb + (size_t)((n_) * CH) * DM + h * HD; const bf16* bq_ = QP + (size_t)((n_) * CH) * DM + h * HD; \
            const bf16* bk_ = KT + (size_t)(h * NCH + (n_)) * (HD * CH); const bf16* ba_ = ATT + (size_t)(h * NCH + (n_)) * (CH * CH); \
            _Pragma("unroll") for (int i = 0; i < 4; ++i) { SC_GLD(rw##X[i], vo_w + (unsigned)i * (16u * DM * 2u), bw_); SC_GLD(rq##X[i], vo_w + (unsigned)i * (16u * DM * 2u), bq_); } \
            _Pragma("unroll") for (int i = 0; i < 4; ++i) { SC_GLD(rk##X[i], vo_t + (unsigned)i * 4096u, bk_); } \
            _Pragma("unroll") for (int i = 0; i < 2; ++i) { SC_GLD(ra##X[i], vo_t + (unsigned)i * 4096u, ba_); } } while (0)
#define SC_WAIT(N, X) asm volatile("s_waitcnt vmcnt(" #N ")" : "+v"(rw##X[0]), "+v"(rw##X[1]), "+v"(rw##X[2]), "+v"(rw##X[3]), "+v"(rq##X[0]), "+v"(rq##X[1]), "+v"(rq##X[2]), "+v"(rq##X[3]), \
            "+v"(rk##X[0]), "+v"(rk##X[1]), "+v"(rk##X[2]), "+v"(rk##X[3]), "+v"(ra##X[0]), "+v"(ra##X[1]) :: "memory")
#define SC_PUT(buf_, X) do { LAS unsigned char* b_ = F.lds + (buf_) * SC_BUF; \
            _Pragma("unroll") for (int i = 0; i < 4; ++i) { const int idx = lt + 256 * i, row = idx >> 4, ch = idx & 15; *(LAS u32x4*)(b_ + SC_W + row * SC_RW + 16 * ch) = rw##X[i]; *(LAS u32x4*)(b_ + SC_Q + row * SC_RW + 16 * ch) = rq##X[i]; } \
            _Pragma("unroll") for (int i = 0; i < 4; ++i) { const int idx = lt + 256 * i, row = idx >> 3, ch = idx & 7; *(LAS u32x4*)(b_ + SC_K + row * SC_RK + 16 * ch) = rk##X[i]; } \
            _Pragma("unroll") for (int i = 0; i < 2; ++i) { const int idx = lt + 256 * i, row = idx >> 3, ch = idx & 7; *(LAS u32x4*)(b_ + SC_A + row * SC_RK + 16 * ch) = ra##X[i]; } } while (0)
#define SC_STEP(n_, X) do { SCP_T0(); if ((n_) + 1 < NCH) { if ((n_) + 3 < NCH) SC_WAIT(28, X); else if ((n_) + 2 < NCH) SC_WAIT(14, X); else SC_WAIT(0, X); \
                SC_PUT(((n_) + 1) & 1, X); if ((n_) + 4 < NCH) SC_ISSUE((n_) + 4, X); } \
            asm volatile("s_waitcnt lgkmcnt(0)" ::: "memory"); SCP_T1(); __builtin_amdgcn_s_barrier(); } while (0)
        SC_ISSUE(0, A); SC_WAIT(0, A); SC_PUT(0, A);
        asm volatile("s_waitcnt lgkmcnt(0)" ::: "memory");
        __builtin_amdgcn_s_barrier();
        SC_ISSUE(1, A); SC_ISSUE(2, B); SC_ISSUE(3, C);
        for (int n = 0; n < NCH; n += 3) {
            SC_STEP(n, A);
            if (n + 1 < NCH) SC_STEP(n + 1, B);
            if (n + 2 < NCH) SC_STEP(n + 2, C);
        }
#if defined(SCAN_PROBE) && SCAN_PROBE == 2
        if (blockIdx.x == 0 && F.tid == 256) F.MISC[16] = (unsigned)lp_sum;
#endif
    } else {
        const int r = F.lane & 15, g = F.lane >> 4, e0 = (hf * 4 + F.wave) * 16;
        f32x4_t sacc[8];
#pragma unroll
        for (int i = 0; i < 8; ++i) sacc[i] = (f32x4_t){0.f, 0.f, 0.f, 0.f};
        bf16* utp = UT + (size_t)h * NCH * (HD * CH) + (size_t)(e0 + r) * CH + 4 * g;
        u32x2 un[4];
#pragma unroll
        for (int ct = 0; ct < 4; ++ct) un[ct] = *(const u32x2*)(utp + 16 * ct);
        float egl = EGL[h * NCH];
        __builtin_amdgcn_s_barrier();
#ifdef SCAN_PROBE
        unsigned long long sp_sum = 0ull;
#endif
        for (int n = 0; n < NCH; ++n) {
#ifdef SCAN_PROBE
            const unsigned long long sp_t0 = __builtin_amdgcn_s_memrealtime();
#endif
            const LAS unsigned char* b = F.lds + (n & 1) * SC_BUF; const LAS unsigned char* lw = b + SC_W + r * SC_RW + 16 * g; const LAS unsigned char* lq = b + SC_Q + r * SC_RW + 16 * g;
            const LAS unsigned char* lk = b + SC_K + r * SC_RK + 16 * g; const LAS unsigned char* la = b + SC_A + r * SC_RK + 16 * g;
            f32x4_t vacc[4], oacc[4]; bf16x8 sb[4], fa[16], fb[16];
#pragma unroll
            for (int ct = 0; ct < 4; ++ct)
#pragma unroll
                for (int kk = 0; kk < 4; ++kk) fa[4 * ct + kk] = *(const LAS bf16x8*)(lw + ct * 16 * SC_RW + kk * 64);
#pragma unroll
            for (int ct = 0; ct < 4; ++ct)
#pragma unroll
                for (int kk = 0; kk < 4; ++kk) fb[4 * ct + kk] = *(const LAS bf16x8*)(lq + ct * 16 * SC_RW + kk * 64);
            __builtin_amdgcn_sched_barrier(0);
#pragma unroll
            for (int kk = 0; kk < 4; ++kk) sb[kk] = packb(sacc[2 * kk], sacc[2 * kk + 1]);
#pragma unroll
            for (int ct = 0; ct < 4; ++ct) { vacc[ct] = (f32x4_t){bflo(un[ct].x), bfhi(un[ct].x), bflo(un[ct].y), bfhi(un[ct].y)}; oacc[ct] = (f32x4_t){0.f, 0.f, 0.f, 0.f}; }
            bf16* utc = utp + (size_t)n * (HD * CH);
            u32x2 unn[4]; float egln = 0.f;
            if (n + 1 < NCH) {
#pragma unroll
                for (int ct = 0; ct < 4; ++ct) unn[ct] = *(const u32x2*)(utc + HD * CH + 16 * ct);
                egln = EGL[h * NCH + n + 1]; }
#pragma unroll
            for (int kk = 0; kk < 4; ++kk)
#pragma unroll
                for (int ct = 0; ct < 4; ++ct) vacc[ct] = __builtin_amdgcn_mfma_f32_16x16x32_bf16(fa[4 * ct + kk], sb[kk], vacc[ct], 0, 0, 0);
            __builtin_amdgcn_sched_barrier(0);
#pragma unroll
            for (int mt = 0; mt < 8; ++mt)
#pragma unroll
                for (int k2 = 0; k2 < 2; ++k2) fa[2 * mt + k2] = *(const LAS bf16x8*)(lk + mt * 16 * SC_RK + k2 * 64);
            __builtin_amdgcn_sched_barrier(0);
#pragma unroll
            for (int kk = 0; kk < 4; ++kk)
#pragma unroll
                for (int ct = 0; ct < 4; ++ct) oacc[ct] = __builtin_amdgcn_mfma_f32_16x16x32_bf16(fb[4 * ct + kk], sb[kk], oacc[ct], 0, 0, 0);
            __builtin_amdgcn_sched_barrier(0);
#pragma unroll
            for (int ct = 0; ct < 4; ++ct)
#pragma unroll
                for (int k2 = 0; k2 < 2; ++k2) if (!(k2 == 1 && ct < 2)) fb[2 * ct + k2] = *(const LAS bf16x8*)(la + ct * 16 * SC_RK + k2 * 64);
            __builtin_amdgcn_sched_barrier(0);
            bf16x8 vb[2];
#pragma unroll
            for (int k2 = 0; k2 < 2; ++k2) vb[k2] = packb(vacc[2 * k2], vacc[2 * k2 + 1]);
#pragma unroll
            for (int mt = 0; mt < 8; ++mt) sacc[mt] = sacc[mt] * egl;
#pragma unroll
            for (int k2 = 0; k2 < 2; ++k2)
#pragma unroll
                for (int mt = 0; mt < 8; ++mt) sacc[mt] = __builtin_amdgcn_mfma_f32_16x16x32_bf16(fa[2 * mt + k2], vb[k2], sacc[mt], 0, 0, 0);
#pragma unroll
            for (int k2 = 0; k2 < 2; ++k2)
#pragma unroll
                for (int ct = 0; ct < 4; ++ct) if (!(k2 == 1 && ct < 2)) oacc[ct] = __builtin_amdgcn_mfma_f32_16x16x32_bf16(fb[2 * ct + k2], vb[k2], oacc[ct], 0, 0, 0);
#pragma unroll
            for (int ct = 0; ct < 4; ++ct) { u32x2 w; w.x = cvtpk(oacc[ct][0], oacc[ct][1]); w.y = cvtpk(oacc[ct][2], oacc[ct][3]); *(u32x2*)(utc + 16 * ct) = w; }
#pragma unroll
            for (int ct = 0; ct < 4; ++ct) un[ct] = unn[ct];
            egl = egln;
            asm volatile("s_waitcnt lgkmcnt(0)" ::: "memory");
#if defined(SCAN_PROBE) && SCAN_PROBE == 1
            asm volatile("s_waitcnt vmcnt(0)" ::: "memory"); sp_sum += __builtin_amdgcn_s_memrealtime() - sp_t0;
#endif
            __builtin_amdgcn_s_barrier();
        }
#if defined(SCAN_PROBE) && SCAN_PROBE == 1
        if (blockIdx.x == 0 && F.tid == 0) F.MISC[16] = (unsigned)sp_sum;
#endif
    }
    }
}

constexpr int SEG_G = 8, SEG_N = NCH / SEG_G;
constexpr size_t WS_SST = 241 * MiB;
constexpr size_t WS_MBB = 245 * MiB;
constexpr size_t WS_MBM = 249 * MiB;
static_assert(WS_MBM + (size_t)NH * (SEG_G - 1) * 128 * 128 * 4 <= WS_END, "segment scan buffers");

template <bool FINAL> __device__ __forceinline__ void scan_job(Frame& F, const Args& A, int h, int sg, int sub) {
    const bf16* Wb = WSP(const bf16, SCAN_WNEG); const bf16* QP = SCAN_QP; const bf16* KT = SCAN_KT; const bf16* ATT = WSP(const bf16, SCAN_ATT); bf16* UT = SCAN_UT; const float* EGL = WSP(const float, WS_EGL);
    const int n0 = sg * SEG_N, n1 = n0 + SEG_N;
    constexpr int NLD = FINAL ? 14 : 8;
    if (F.wave >= 4) {
        const int lt = F.tid - 256;
        u32x4 rwA[4], rqA[4], rkA[4], raA[2], rwB[4], rqB[4], rkB[4], raB[2], rwC[4], rqC[4], rkC[4], raC[2];
#define S2_GLD(dst, voff, sbase) asm volatile("global_load_dwordx4 %0, %1, %2" : "=v"(dst) : "v"(voff), "s"(sbase) : "memory")
        const unsigned vo_w = (unsigned)((lt >> 4) * (DM * 2) + (lt & 15) * 16), vo_t = (unsigned)lt * 16u;
#define S2_ISSUE(n_, X) do { const bf16* bw_ = Wb + (size_t)((n_) * CH) * DM + h * HD; const bf16* bk_ = KT + (size_t)(h * NCH + (n_)) * (HD * CH); \
            _Pragma("unroll") for (int i = 0; i < 4; ++i) { S2_GLD(rw##X[i], vo_w + (unsigned)i * (16u * DM * 2u), bw_); } \
            _Pragma("unroll") for (int i = 0; i < 4; ++i) { S2_GLD(rk##X[i], vo_t + (unsigned)i * 4096u, bk_); } \
            if constexpr (FINAL) { const bf16* bq_ = QP + (size_t)((n_) * CH) * DM + h * HD; const bf16* ba_ = ATT + (size_t)(h * NCH + (n_)) * (CH * CH); \
                _Pragma("unroll") for (int i = 0; i < 4; ++i) { S2_GLD(rq##X[i], vo_w + (unsigned)i * (16u * DM * 2u), bq_); } \
                _Pragma("unroll") for (int i = 0; i < 2; ++i) { S2_GLD(ra##X[i], vo_t + (unsigned)i * 4096u, ba_); } } } while (0)
#define S2_TIEF(X) "+v"(rw##X[0]), "+v"(rw##X[1]), "+v"(rw##X[2]), "+v"(rw##X[3]), "+v"(rq##X[0]), "+v"(rq##X[1]), "+v"(rq##X[2]), "+v"(rq##X[3]), "+v"(rk##X[0]), "+v"(rk##X[1]), "+v"(rk##X[2]), "+v"(rk##X[3]), "+v"(ra##X[0]), "+v"(ra##X[1])
#define S2_TIEA(X) "+v"(rw##X[0]), "+v"(rw##X[1]), "+v"(rw##X[2]), "+v"(rw##X[3]), "+v"(rk##X[0]), "+v"(rk##X[1]), "+v"(rk##X[2]), "+v"(rk##X[3])
#define S2_WAIT2(X) do { if constexpr (FINAL) asm volatile("s_waitcnt vmcnt(28)" : S2_TIEF(X) :: "memory"); else asm volatile("s_waitcnt vmcnt(16)" : S2_TIEA(X) :: "memory"); } while (0)
#define S2_WAIT0(X) do { if constexpr (FINAL) asm volatile("s_waitcnt vmcnt(0)" : S2_TIEF(X) :: "memory"); else asm volatile("s_waitcnt vmcnt(0)" : S2_TIEA(X) :: "memory"); } while (0)
#define S2_PUT(buf_, X) do { LAS unsigned char* b_ = F.lds + (buf_) * SC_BUF; \
            _Pragma("unroll") for (int i = 0; i < 4; ++i) { const int idx = lt + 256 * i, row = idx >> 4, ch = idx & 15; *(LAS u32x4*)(b_ + SC_W + row * SC_RW + 16 * ch) = rw##X[i]; \
                if constexpr (FINAL) *(LAS u32x4*)(b_ + SC_Q + row * SC_RW + 16 * ch) = rq##X[i]; } \
            _Pragma("unroll") for (int i = 0; i < 4; ++i) { const int idx = lt + 256 * i, row = idx >> 3, ch = idx & 7; *(LAS u32x4*)(b_ + SC_K + row * SC_RK + 16 * ch) = rk##X[i]; } \
            if constexpr (FINAL) { _Pragma("unroll") for (int i = 0; i < 2; ++i) { const int idx = lt + 256 * i, row = idx >> 3, ch = idx & 7; *(LAS u32x4*)(b_ + SC_A + row * SC_RK + 16 * ch) = ra##X[i]; } } } while (0)
#define S2_STEP(n_, X) do { S2_WAIT2(X); S2_PUT(((n_) + 1 - n0) & 1, X); { const int nn_ = ((n_) + 4 < n1) ? (n_) + 4 : n1 - 1; S2_ISSUE(nn_, X); } \
            asm volatile("s_waitcnt lgkmcnt(0)" ::: "memory"); __builtin_amdgcn_s_barrier(); } while (0)
        static_assert(SEG_N % 3 == 2, "loader tail below is written for SEG_N = 3k + 2");
        S2_ISSUE(n0, A); S2_WAIT0(A); S2_PUT(0, A);
        asm volatile("s_waitcnt lgkmcnt(0)" ::: "memory");
        __builtin_amdgcn_s_barrier();
        S2_ISSUE(n0 + 1, A); S2_ISSUE(n0 + 2, B); S2_ISSUE(n0 + 3, C);
        int n = n0;
        for (; n + 2 < n1; n += 3) { S2_STEP(n, A); S2_STEP(n + 1, B); S2_STEP(n + 2, C); }
        S2_STEP(n, A); S2_STEP(n + 1, B);
        asm volatile("s_waitcnt vmcnt(0)" ::: "memory");
    } else {
        const int r = F.lane & 15, g = F.lane >> 4;
        const int col = FINAL ? (sub * 4 + F.wave) * 16 + r : 64 * sub + 16 * F.wave + r;
        const bool real = FINAL || (col < 128);
        f32x4_t sacc[8];
        if constexpr (FINAL) { const float* sp = WSP(const float, WS_SST) + ((size_t)(h * SEG_G + sg) * 128 + col) * 128 + 4 * g;
#pragma unroll
            for (int mt = 0; mt < 8; ++mt) sacc[mt] = *(const f32x4_t*)(sp + 16 * mt); }
        else {
#pragma unroll
            for (int mt = 0; mt < 8; ++mt)
#pragma unroll
                for (int e = 0; e < 4; ++e) sacc[mt][e] = (!real && (16 * mt + 4 * g + e) == (col - 128)) ? 1.f : 0.f; }
        bf16* utp = UT + (size_t)h * NCH * (HD * CH) + (size_t)((FINAL ? col : (col & 127))) * CH + 4 * g;
        u32x2 un[4];
#pragma unroll
        for (int ct = 0; ct < 4; ++ct) { un[ct] = (u32x2){0u, 0u}; if (real) un[ct] = *(const u32x2*)(utp + (size_t)n0 * (HD * CH) + 16 * ct); }
        float egl = EGL[h * NCH + n0];
        __builtin_amdgcn_s_barrier();
        for (int n = n0; n < n1; ++n) {
            const LAS unsigned char* b = F.lds + ((n - n0) & 1) * SC_BUF; const LAS unsigned char* lw = b + SC_W + r * SC_RW + 16 * g; const LAS unsigned char* lq = b + SC_Q + r * SC_RW + 16 * g;
            const LAS unsigned char* lk = b + SC_K + r * SC_RK + 16 * g; const LAS unsigned char* la = b + SC_A + r * SC_RK + 16 * g;
            f32x4_t vacc[4], oacc[4]; bf16x8 sb[4], fa[16], fb[16];
#pragma unroll
            for (int ct = 0; ct < 4; ++ct)
#pragma unroll
                for (int kk = 0; kk < 4; ++kk) fa[4 * ct + kk] = *(const LAS bf16x8*)(lw + ct * 16 * SC_RW + kk * 64);
            if constexpr (FINAL) {
#pragma unroll
                for (int ct = 0; ct < 4; ++ct)
#pragma unroll
                    for (int kk = 0; kk < 4; ++kk) fb[4 * ct + kk] = *(const LAS bf16x8*)(lq + ct * 16 * SC_RW + kk * 64); }
            __builtin_amdgcn_sched_barrier(0);
#pragma unroll
            for (int kk = 0; kk < 4; ++kk) sb[kk] = packb(sacc[2 * kk], sacc[2 * kk + 1]);
#pragma unroll
            for (int ct = 0; ct < 4; ++ct) { vacc[ct] = (f32x4_t){bflo(un[ct].x), bfhi(un[ct].x), bflo(un[ct].y), bfhi(un[ct].y)}; oacc[ct] = (f32x4_t){0.f, 0.f, 0.f, 0.f}; }
            bf16* utc = utp + (size_t)n * (HD * CH);
            u32x2 unn[4]; float egln = 0.f;
#pragma unroll
            for (int ct = 0; ct < 4; ++ct) unn[ct] = (u32x2){0u, 0u};
            if (n + 1 < n1) { if (real) {
#pragma unroll
                    for (int ct = 0; ct < 4; ++ct) unn[ct] = *(const u32x2*)(utc + HD * CH + 16 * ct); }
                egln = EGL[h * NCH + n + 1]; }
#pragma unroll
            for (int kk = 0; kk < 4; ++kk)
#pragma unroll
                for (int ct = 0; ct < 4; ++ct) vacc[ct] = __builtin_amdgcn_mfma_f32_16x16x32_bf16(fa[4 * ct + kk], sb[kk], vacc[ct], 0, 0, 0);
            __builtin_amdgcn_sched_barrier(0);
#pragma unroll
            for (int mt = 0; mt < 8; ++mt)
#pragma unroll
                for (int k2 = 0; k2 < 2; ++k2) fa[2 * mt + k2] = *(const LAS bf16x8*)(lk + mt * 16 * SC_RK + k2 * 64);
            __builtin_amdgcn_sched_barrier(0);
            if constexpr (FINAL) {
#pragma unroll
                for (int kk = 0; kk < 4; ++kk)
#pragma unroll
                    for (int ct = 0; ct < 4; ++ct) oacc[ct] = __builtin_amdgcn_mfma_f32_16x16x32_bf16(fb[4 * ct + kk], sb[kk], oacc[ct], 0, 0, 0);
                __builtin_amdgcn_sched_barrier(0);
#pragma unroll
                for (int ct = 0; ct < 4; ++ct)
#pragma unroll
                    for (int k2 = 0; k2 < 2; ++k2) if (!(k2 == 1 && ct < 2)) fb[2 * ct + k2] = *(const LAS bf16x8*)(la + ct * 16 * SC_RK + k2 * 64);
                __builtin_amdgcn_sched_barrier(0); }
            bf16x8 vb[2];
#pragma unroll
            for (int k2 = 0; k2 < 2; ++k2) vb[k2] = packb(vacc[2 * k2], vacc[2 * k2 + 1]);
#pragma unroll
            for (int mt = 0; mt < 8; ++mt) sacc[mt] = sacc[mt] * egl;
#pragma unroll
            for (int k2 = 0; k2 < 2; ++k2)
#pragma unroll
                for (int mt = 0; mt < 8; ++mt) sacc[mt] = __builtin_amdgcn_mfma_f32_16x16x32_bf16(fa[2 * mt + k2], vb[k2], sacc[mt], 0, 0, 0);
            if constexpr (FINAL) {
#pragma unroll
                for (int k2 = 0; k2 < 2; ++k2)
#pragma unroll
                    for (int ct = 0; ct < 4; ++ct) if (!(k2 == 1 && ct < 2)) oacc[ct] = __builtin_amdgcn_mfma_f32_16x16x32_bf16(fb[2 * ct + k2], vb[k2], oacc[ct], 0, 0, 0);
#pragma unroll
                for (int ct = 0; ct < 4; ++ct) { u32x2 w; w.x = cvtpk(oacc[ct][0], oacc[ct][1]); w.y = cvtpk(oacc[ct][2], oacc[ct][3]); *(u32x2*)(utc + 16 * ct) = w; } }
#pragma unroll
            for (int ct = 0; ct < 4; ++ct) un[ct] = unn[ct];
            egl = egln;
            asm volatile("s_waitcnt lgkmcnt(0)" ::: "memory");
            __builtin_amdgcn_s_barrier();
        }
        if constexpr (!FINAL) {
            if (real) { float* bp = WSP(float, WS_MBB) + ((size_t)(h * (SEG_G - 1) + sg) * 128 + col) * 128 + 4 * g;
#pragma unroll
                for (int mt = 0; mt < 8; ++mt) *(f32x4_t*)(bp + 16 * mt) = sacc[mt]; }
            else { float* mp = WSP(float, WS_MBM) + (size_t)(h * (SEG_G - 1) + sg) * (128 * 128) + (col - 128);
#pragma unroll
                for (int mt = 0; mt < 8; ++mt)
#pragma unroll
                    for (int e = 0; e < 4; ++e) mp[(size_t)(16 * mt + 4 * g + e) * 128] = sacc[mt][e]; } }
    }
}
__device__ __forceinline__ void scan_mid(Frame& F, const Args& A, int h) {
    LAS float* Sl = (LAS float*)F.lds; LAS unsigned char* Mimg = F.lds + 128 * 132 * 4;
    float* SST = WSP(float, WS_SST) + (size_t)h * SEG_G * (128 * 128);
    const float* MBB = WSP(const float, WS_MBB) + (size_t)h * (SEG_G - 1) * (128 * 128); const float* MBM = WSP(const float, WS_MBM) + (size_t)h * (SEG_G - 1) * (128 * 128);
    const int r = F.lane & 15, g = F.lane >> 4, et = F.wave;
    for (int i = F.tid; i < 128 * 128; i += NWAVES * 64) { Sl[(i >> 7) * 132 + (i & 127)] = 0.f; SST[i] = 0.f; }
    f32x4 mreg[8];
#pragma unroll
    for (int i = 0; i < 8; ++i) mreg[i] = *(const f32x4*)(MBM + (size_t)(F.tid + 512 * i) * 4);
    for (int sg = 0; sg < SEG_G - 1; ++sg) {
        __syncthreads();
#pragma unroll
        for (int i = 0; i < 8; ++i) { const int idx = F.tid + 512 * i, row = idx >> 5, c4 = idx & 31; u32x2 w; w.x = cvtpk(mreg[i].x, mreg[i].y); w.y = cvtpk(mreg[i].z, mreg[i].w); *(LAS u32x2*)(Mimg + row * 272 + 8 * c4) = w; }
        if (sg + 1 < SEG_G - 1) {
#pragma unroll
            for (int i = 0; i < 8; ++i) mreg[i] = *(const f32x4*)(MBM + (size_t)(sg + 1) * (128 * 128) + (size_t)(F.tid + 512 * i) * 4); }
        f32x4_t acc[8];
        const float* bp = MBB + ((size_t)sg * 128 + 16 * et + r) * 128 + 4 * g;
#pragma unroll
        for (int mt = 0; mt < 8; ++mt) acc[mt] = *(const f32x4_t*)(bp + 16 * mt);
        __syncthreads();
#pragma unroll
        for (int kk = 0; kk < 4; ++kk) {
            const LAS float* sp = Sl + (16 * et + r) * 132 + 32 * kk + 8 * g; const f32x4 s0 = *(const LAS f32x4*)sp, s1 = *(const LAS f32x4*)(sp + 4);
            float sf[8] = {s0.x, s0.y, s0.z, s0.w, s1.x, s1.y, s1.z, s1.w}; const bf16x8 bfr = pack8f(sf);
#pragma unroll
            for (int mt = 0; mt < 8; ++mt) { const bf16x8 afr = *(const LAS bf16x8*)(Mimg + (16 * mt + r) * 272 + 64 * kk + 16 * g); acc[mt] = __builtin_amdgcn_mfma_f32_16x16x32_bf16(afr, bfr, acc[mt], 0, 0, 0); } }
        float* so = SST + (size_t)(sg + 1) * (128 * 128) + (size_t)(16 * et + r) * 128 + 4 * g;
#pragma unroll
        for (int mt = 0; mt < 8; ++mt) { *(f32x4_t*)(so + 16 * mt) = acc[mt]; *(LAS f32x4_t*)(Sl + (16 * et + r) * 132 + 16 * mt + 4 * g) = acc[mt]; }
    }
    __syncthreads();
}
__device__ __forceinline__ void p_dn_scan2_A(Frame& F, const Args& A) { const int b = blockIdx.x; if (b < NH * (SEG_G - 1) * 4) { const int gid = 8 * (b >> 5) + (b & 7), sub = (b >> 3) & 3; scan_job<false>(F, A, gid / (SEG_G - 1), gid % (SEG_G - 1), sub); } }
__device__ __forceinline__ void p_dn_scan2_B(Frame& F, const Args& A) { if (blockIdx.x < NH) scan_mid(F, A, blockIdx.x); }
__device__ __forceinline__ void p_dn_scan2_C(Frame& F, const Args& A) { const int b = blockIdx.x; if (b < NH * SEG_G * 2) { const int gid = 8 * (b >> 4) + (b & 7), sub = (b >> 3) & 1; scan_job<true>(F, A, gid / SEG_G, gid % SEG_G, sub); } }
__device__ __forceinline__ void p_dn_out_fast(Frame& F, const Args& A) {
    const bf16* OT = SCAN_UT; const bf16* Z = WSP(const bf16, WS_Z); bf16* YD = WSP(bf16, SCAN_YD); const float* ow = A.in[6];
    LAS unsigned short* tile = (LAS unsigned short*)(F.lds + F.wave * 16640);
    for (int it = F.gw; it < NCH * NH; it += F.NGW) { const int n = it >> 3, h = it & 7, t0 = n * CH;
        const bf16* ot = OT + (size_t)(h * NCH + n) * (HD * CH);
        u32x4 ov[16]; unsigned zall[CH];
#pragma unroll
        for (int i = 0; i < 16; ++i) { const int e = 8 * i + (F.lane >> 3), ch = F.lane & 7; ov[i] = *(const u32x4*)(ot + (size_t)e * CH + 8 * ch); }
#pragma unroll
        for (int c = 0; c < CH; ++c) zall[c] = *(const unsigned*)(Z + (size_t)(t0 + c) * DM + h * HD + 2 * F.lane);
        const float w0 = ow[2 * F.lane], w1 = ow[2 * F.lane + 1];
#pragma unroll
        for (int i = 0; i < 16; ++i) { const int e = 8 * i + (F.lane >> 3), ch = F.lane & 7; const u32x4 v = ov[i]; LAS unsigned short* tp = tile + e * 65 + 8 * ch;
            tp[0] = (unsigned short)v.x; tp[1] = (unsigned short)(v.x >> 16); tp[2] = (unsigned short)v.y; tp[3] = (unsigned short)(v.y >> 16); tp[4] = (unsigned short)v.z; tp[5] = (unsigned short)(v.z >> 16); tp[6] = (unsigned short)v.w; tp[7] = (unsigned short)(v.w >> 16); }
        asm volatile("s_waitcnt lgkmcnt(0)" ::: "memory");
#pragma unroll
        for (int c = 0; c < CH; ++c) { const float o0 = bf2f(tile[(2 * F.lane) * 65 + c]), o1 = bf2f(tile[(2 * F.lane + 1) * 65 + c]);
            const float rs = rsq_(wave_sum(o0 * o0 + o1 * o1) * (1.f / HD) + EPS);
            const size_t off = (size_t)(t0 + c) * DM + h * HD + 2 * F.lane; const unsigned zv = zall[c];
            *(unsigned*)(YD + off) = pk2(o0 * rs * w0 * siluf_(bflo(zv)), o1 * rs * w1 * siluf_(bfhi(zv))); }
        asm volatile("s_waitcnt lgkmcnt(0)" ::: "memory");
    }
}
#ifdef DBG_ATTN
constexpr int CW_DBG = 20000;
__device__ __forceinline__ void dbg_compare(Frame& F, const bf16* a, const bf16* b, size_t n) {
    float* acc = (float*)(WSP(unsigned, WS_CTL) + CW_DBG); float d2 = 0.f, r2 = 0.f;
    for (size_t i = (size_t)F.gw * 64 + F.lane; i < n; i += (size_t)F.NGW * 64) { const float x = bf2f(a[i]), y = bf2f(b[i]); d2 += (x - y) * (x - y); r2 += y * y; }
    d2 = wave_sum(d2); r2 = wave_sum(r2);
    if (F.lane == 0) { atomicAdd(acc, d2); atomicAdd(acc + 1, r2); }
}
#endif

#if defined(DBG_DET) || defined(DBG_L2L)
constexpr int CW_CS = 24000;
__device__ __forceinline__ void dbg_cksum(Frame& F, const void* p, size_t bytes, int slot) {
    const unsigned* w = (const unsigned*)p; unsigned acc = 0u; const size_t nw = bytes / 4;
#ifdef DBG_NANCNT
    for (size_t i = (size_t)F.gw * 64 + F.lane; i < nw; i += (size_t)F.NGW * 64) { const unsigned v = w[i]; acc += ((v & 0x7F80u) >= (141u << 7)) + ((v & 0x7F800000u) >= (141u << 23)); }
#else
    for (size_t i = (size_t)F.gw * 64 + F.lane; i < nw; i += (size_t)F.NGW * 64) { const unsigned v = w[i]; acc += v * 2654435761u + (unsigned)(i * 40503u) * (v >> 7); }
#endif
#pragma unroll
    for (int o = 1; o < 64; o <<= 1) acc += __shfl_xor(acc, o);
    if (F.lane == 0) atomicAdd(WSP(unsigned, WS_CTL) + CW_CS + slot, acc);
}
#endif

#ifdef DBG_SIG
constexpr int CW_SIG = 26000;
__device__ __forceinline__ void dbg_sig(Frame& F, const bf16* p, size_t n, int slot) {
    double acc = 0.0, acc2 = 0.0;
    for (size_t i = (size_t)F.gw * 64 + F.lane; i < n; i += (size_t)F.NGW * 64) { unsigned hsh = (unsigned)i * 2654435761u; hsh ^= hsh >> 15; hsh *= 2246822519u; hsh ^= hsh >> 13;
        const float wgt = (float)(hsh & 0xFFFFu) * (1.f / 32768.f) - 1.f; const float x = bf2f(p[i]); acc += (double)(x * wgt); acc2 += (double)(x * x); }
    long long q1 = (long long)(acc * 65536.0), q2 = (long long)(acc2 * 65536.0);
#pragma unroll
    for (int o = 1; o < 64; o <<= 1) { q1 += __shfl_xor(q1, o); q2 += __shfl_xor(q2, o); }
    if (F.lane == 0) { unsigned long long* a = (unsigned long long*)(WSP(unsigned, WS_CTL) + CW_SIG); atomicAdd(a + 2 * slot, (unsigned long long)q1); atomicAdd(a + 2 * slot + 1, (unsigned long long)q2); }
}
#endif

#ifdef DBG_CHK
constexpr int CW_CHK = 28000;
__device__ __forceinline__ float dbg_g(const float* BA, const Args& A, int t, int h) { const float a = BA[(size_t)t * 16 + 8 + h] + A.in[5][h]; const float sp = (a > 20.f) ? a : log1pf(expf(a)); return -expf(A.in[4][h]) * sp; }
__device__ __forceinline__ void dbg_chk_acc(Frame& F, int k, float err, float ref) {
    long long q1 = (long long)((double)err * (double)err * 1048576.0), q2 = (long long)((double)ref * (double)ref * 1048576.0);
    unsigned long long* a = (unsigned long long*)(WSP(unsigned, WS_CTL) + CW_CHK); atomicAdd(a + 2 * k, (unsigned long long)q1); atomicAdd(a + 2 * k + 1, (unsigned long long)q2);
}
__device__ __forceinline__ void dbg_chunk2_check(Frame& F, const Args& A) {
    const float* BA = WSP(const float, WS_BA); const bf16* KN = WSP(const bf16, WS2_KN); const bf16* QP = WSP(const bf16, WS2_QN); const bf16* Wn = WSP(const bf16, WS2_WNEG);
    const bf16* ATT = WSP(const bf16, WS2_ATT); const bf16* KT = ws2_kt(F); const float* EGL = WSP(const float, WS_EGL);
    const int s = F.gw * 64 + F.lane; if (s >= 8192) return;
    unsigned hsh = (unsigned)s * 2654435761u; hsh ^= hsh >> 15; hsh *= 2246822519u; hsh ^= hsh >> 13;
    const int n = hsh & 255, h = (hsh >> 8) & 7, i = (hsh >> 11) & 63, d = (hsh >> 17) & 127, t0 = n * CH;
    float gci = 0.f, gl = 0.f; { float a = 0.f; for (int j = 0; j < 64; ++j) { a += dbg_g(BA, A, t0 + j, h); if (j == i) gci = a; } gl = a; }
    const float beta_i = 1.f / (1.f + expf(-BA[(size_t)(t0 + i) * 16 + h]));
    const bf16* ki = KN + (size_t)(t0 + i) * DM + h * HD;
    dbg_chk_acc(F, 0, EGL[h * NCH + n] - expf(gl), expf(gl));
    { const float ref = bf2f(ki[d]) * expf(gl - gci); dbg_chk_acc(F, 1, bf2f(KT[(size_t)(h * NCH + n) * (HD * CH) + (size_t)d * CH + i]) - ref, ref); }
    { const float kt = bf2f(KT[(size_t)(h * NCH + n) * (HD * CH) + (size_t)d * CH + i]); dbg_chk_acc(F, 4, kt - bf2f(ki[d]), bf2f(ki[d])); }
    if (n < 128) { const int c = d & 63; const bf16* tg = WSP(const bf16, 241 * MiB) + (size_t)(h * 128 + n) * 4096; float lhs = bf2f(tg[i * 64 + c]); float gcj = 0.f, gcc = 0.f;
      for (int j = 0; j < 64; ++j) { gcj += dbg_g(BA, A, t0 + j, h); if (j == c) gcc = gcj;
          if (j < i) { const bf16* kj = KN + (size_t)(t0 + j) * DM + h * HD; float dot = 0.f; for (int x = 0; x < HD; ++x) dot += bf2f(ki[x]) * bf2f(kj[x]); lhs += beta_i * dot * expf(gci - gcj) * bf2f(tg[j * 64 + c]); } }
      const float beta_c = 1.f / (1.f + expf(-BA[(size_t)(t0 + c) * 16 + h])); const float ref = (i == c) ? beta_c * expf(gcc) : 0.f; dbg_chk_acc(F, 5, lhs - ref, (i == c) ? ref : 0.05f * beta_c * expf(gcc)); }
    if (n < 128) { const bf16* tg = WSP(const bf16, 241 * MiB) + (size_t)(h * 128 + n) * 4096; float ref = 0.f, mag = 0.f;
      for (int j = 0; j < 64; ++j) { const float t = bf2f(tg[i * 64 + j]) * bf2f(KN[(size_t)(t0 + j) * DM + h * HD + d]); ref += t; mag += fabsf(t); }
      dbg_chk_acc(F, 6, -bf2f(Wn[(size_t)(t0 + i) * DM + h * HD + d]) - ref, mag); }
    if (n < 128) { const bf16* tg = WSP(const bf16, 241 * MiB) + (size_t)(h * 128 + n) * 4096; float r7 = 0.f, r8 = 0.f, mag = 0.f, gcj = 0.f;
      for (int j = 0; j < 64; ++j) { gcj += dbg_g(BA, A, t0 + j, h); const float kk = bf2f(KN[(size_t)(t0 + j) * DM + h * HD + d]); const float t = bf2f(tg[i * 64 + j]) * kk;
          r7 += t * expf(gl - gcj); r8 += bf2f(tg[j * 64 + i]) * kk; mag += fabsf(t); }
      const float wv = -bf2f(Wn[(size_t)(t0 + i) * DM + h * HD + d]); dbg_chk_acc(F, 7, wv - r7, mag); dbg_chk_acc(F, 8, wv - r8, mag); }
    if (n < 32) { const bf16* dk = WSP(const bf16, 249 * MiB) + (size_t)(h * 32 + n) * 8192; dbg_chk_acc(F, 9, bf2f(dk[d * 64 + i]) - bf2f(ki[d]), bf2f(ki[d])); }
    if (n < 32) { const float ref = bf2f(ki[d]) * expf(gl - gci); dbg_chk_acc(F, 10, bf2f(KT[(size_t)(h * NCH + n) * (HD * CH) + (size_t)d * CH + i]) - ref, ref); }
    if (n < 128) { const bf16* tg = WSP(const bf16, 241 * MiB) + (size_t)(h * 128 + n) * 4096; float ref = 0.f, mag = 0.f;
      for (int j = 0; j < 64; ++j) { const float t = bf2f(tg[i * 64 + j]) * bf2f(KN[(size_t)(t0 + j) * DM + h * HD + d]); ref += t; mag += fabsf(t); }
      dbg_chk_acc(F, n >= 32 ? 11 : 12, -bf2f(Wn[(size_t)(t0 + i) * DM + h * HD + d]) - ref, mag); }
    { float lhs = -bf2f(Wn[(size_t)(t0 + i) * DM + h * HD + d]); float gcj = 0.f;
      for (int j = 0; j < i; ++j) { gcj += dbg_g(BA, A, t0 + j, h); const bf16* kj = KN + (size_t)(t0 + j) * DM + h * HD; float dot = 0.f; for (int x = 0; x < HD; ++x) dot += bf2f(ki[x]) * bf2f(kj[x]);
          lhs += beta_i * dot * expf(gci - gcj) * (-bf2f(Wn[(size_t)(t0 + j) * DM + h * HD + d])); }
      const float ref = beta_i * expf(gci) * bf2f(ki[d]); dbg_chk_acc(F, 2, lhs - ref, ref); }
    { const int j = d & 63; if (j <= i && gci > -20.f) { float gcj = 0.f; for (int x = 0; x <= j; ++x) gcj += dbg_g(BA, A, t0 + x, h);
          const bf16* kj = KN + (size_t)(t0 + j) * DM + h * HD; const bf16* qi = QP + (size_t)(t0 + i) * DM + h * HD; float dot = 0.f; for (int x = 0; x < HD; ++x) dot += bf2f(qi[x]) * bf2f(kj[x]);
          const float ref = dot * expf(-gcj); dbg_chk_acc(F, 3, bf2f(ATT[(size_t)(h * NCH + n) * (CH * CH) + (size_t)i * CH + j]) - ref, ref); }
      else if (j > i) dbg_chk_acc(F, 3, bf2f(ATT[(size_t)(h * NCH + n) * (CH * CH) + (size_t)i * CH + j]), 0.f); }
}
#endif

#ifdef DBG_TILE
constexpr int CW_TILE = 30000;
__device__ __forceinline__ void dbg_tile_check(Frame& F, const Args& A) {
    if (F.gw >= NCH * NH) return;
    const int n = F.gw >> 3, h = F.gw & 7, t0 = n * CH, lane = F.lane;
    const float* BA = WSP(const float, WS_BA); const bf16* KN = WSP(const bf16, WS2_KN); const bf16* KT = ws2_kt(F) + (size_t)(h * NCH + n) * (HD * CH);
    float gc = 0.f, gl = 0.f; { float a = 0.f; for (int j = 0; j < 64; ++j) { a += dbg_g(BA, A, t0 + j, h); if (j == lane) gc = a; } gl = a; }
    const float f = expf(gl - gc); int bad = 0;
    for (int d = 0; d < HD; ++d) { const float ref = bf2f(KN[(size_t)(t0 + lane) * DM + h * HD + d]) * f; const float got = bf2f(KT[(size_t)d * CH + lane]); if (!(fabsf(got - ref) <= 0.02f * fabsf(ref) + 1e-3f)) ++bad; }
    bad = (int)wave_sum((float)bad);
    if (lane == 0 && bad > 0) { unsigned* w = WSP(unsigned, WS_CTL) + CW_TILE; atomicAdd(w, 1u); atomicMin(w + 1, (unsigned)n); atomicOr(w + 2 + n, 1u << h); atomicAdd(w + 300, (unsigned)bad); atomicOr(w + 301, 1u << h); if (bad > 4096) atomicOr(w + 302, 1u << h); }
}
#endif
template <int R> __device__ __forceinline__ void post_rows(Frame& F, const Args& A, int m0, int stride) {
    const float* x = A.in[0]; const bf16* T = WSP(const bf16, WS_T); bf16* H2 = WSP(bf16, WS_H2);
    const f32x4* w1 = (const f32x4*)A.in[10] + F.lane; const f32x4* w2 = (const f32x4*)A.in[11] + F.lane;
    unsigned long long t8[R][4]; f32x4 xv[R][4];
#pragma unroll
    for (int k = 0; k < R; ++k) { const int m = m0 + k * stride; const unsigned long long* tr = (const unsigned long long*)(T + (size_t)m * DM) + F.lane; const f32x4* xr = (const f32x4*)(x + (size_t)m * DM) + F.lane;
#pragma unroll
        for (int j = 0; j < 4; ++j) { t8[k][j] = tr[64 * j]; xv[k][j] = xr[64 * j]; } }
#pragma unroll
    for (int k = 0; k < R; ++k) { const int m = m0 + k * stride; f32x4* orow = (f32x4*)(F.out + (size_t)m * DM) + F.lane;
        f32x4 tv[4]; float ss = 0.f;
#pragma unroll
        for (int j = 0; j < 4; ++j) { const unsigned long long w8 = t8[k][j]; const unsigned lo = (unsigned)w8, hi = (unsigned)(w8 >> 32); tv[j] = (f32x4){bflo(lo), bfhi(lo), bflo(hi), bfhi(hi)}; ss += (tv[j].x * tv[j].x + tv[j].y * tv[j].y) + (tv[j].z * tv[j].z + tv[j].w * tv[j].w); }
        const float rs = rsq_(wave_sum(ss) * (1.f / DM) + EPS); float s2 = 0.f;
#pragma unroll
        for (int j = 0; j < 4; ++j) { tv[j] = xv[k][j] + tv[j] * rs * w1[64 * j]; orow[64 * j] = tv[j]; s2 += (tv[j].x * tv[j].x + tv[j].y * tv[j].y) + (tv[j].z * tv[j].z + tv[j].w * tv[j].w); }
        const float r2 = rsq_(wave_sum(s2) * (1.f / DM) + EPS);
        unsigned long long* o8 = (unsigned long long*)(H2 + (size_t)m * DM) + F.lane;
#pragma unroll
        for (int j = 0; j < 4; ++j) { const f32x4 hv = tv[j] * r2 * w2[64 * j]; o8[64 * j] = (unsigned long long)pk2(hv.x, hv.y) | ((unsigned long long)pk2(hv.z, hv.w) << 32); } }
}
__device__ __forceinline__ void p_post_mix(Frame& F, const Args& A) {
    int m = F.gw;
    for (; m + F.NGW < S; m += 2 * F.NGW) post_rows<2>(F, A, m, F.NGW);
    if (m < S) post_rows<1>(F, A, m, F.NGW);
}
#if !defined(DBG_NAN) && !defined(DBG_DET) && !defined(DBG_ATTN)
template <int R> __device__ __forceinline__ void final_rows(Frame& F, const Args& A, int m0, int stride) {
    const bf16* Fd = WSP(const bf16, WS_F); const f32x4* w = (const f32x4*)A.in[15] + F.lane;
    unsigned long long f8[R][4]; f32x4 xv[R][4];
#pragma unroll
    for (int k = 0; k < R; ++k) { const int m = m0 + k * stride; const unsigned long long* fr = (const unsigned long long*)(Fd + (size_t)m * DM) + F.lane; const f32x4* orow = (const f32x4*)(F.out + (size_t)m * DM) + F.lane;
#pragma unroll
        for (int j = 0; j < 4; ++j) { f8[k][j] = fr[64 * j]; xv[k][j] = orow[64 * j]; } }
#pragma unroll
    for (int k = 0; k < R; ++k) { const int m = m0 + k * stride; f32x4* orow = (f32x4*)(F.out + (size_t)m * DM) + F.lane;
        f32x4 fv[4]; float ss = 0.f;
#pragma unroll
        for (int j = 0; j < 4; ++j) { const unsigned long long w8 = f8[k][j]; const unsigned lo = (unsigned)w8, hi = (unsigned)(w8 >> 32); fv[j] = (f32x4){bflo(lo), bfhi(lo), bflo(hi), bfhi(hi)}; ss += (fv[j].x * fv[j].x + fv[j].y * fv[j].y) + (fv[j].z * fv[j].z + fv[j].w * fv[j].w); }
        const float rs = rsq_(wave_sum(ss) * (1.f / DM) + EPS);
#pragma unroll
        for (int j = 0; j < 4; ++j) orow[64 * j] = xv[k][j] + fv[j] * rs * w[64 * j]; }
}
__device__ __forceinline__ void p_final(Frame& F, const Args& A) {
    int m = F.gw;
    for (; m + F.NGW < S; m += 2 * F.NGW) final_rows<2>(F, A, m, F.NGW);
    if (m < S) final_rows<1>(F, A, m, F.NGW);
}
#else
__device__ __forceinline__ void p_final(Frame& F, const Args& A) {
    const bf16* Fd = WSP(const bf16, WS_F);
    for (int m = F.gw; m < S; m += F.NGW) {
        const unsigned long long* fr = (const unsigned long long*)(Fd + (size_t)m * DM) + F.lane; f32x4* orow = (f32x4*)(F.out + (size_t)m * DM) + F.lane; const f32x4* w = (const f32x4*)A.in[15] + F.lane;
        f32x4 fv[4]; float ss = 0.f;
#pragma unroll
        for (int j = 0; j < 4; ++j) { const unsigned long long w8 = fr[64 * j]; const unsigned lo = (unsigned)w8, hi = (unsigned)(w8 >> 32); fv[j] = (f32x4){bflo(lo), bfhi(lo), bflo(hi), bfhi(hi)}; ss += (fv[j].x * fv[j].x + fv[j].y * fv[j].y) + (fv[j].z * fv[j].z + fv[j].w * fv[j].w); }
        const float rs = rsq_(wave_sum(ss) * (1.f / DM) + EPS);
#pragma unroll
        for (int j = 0; j < 4; ++j) { f32x4 ov = orow[64 * j] + fv[j] * rs * w[64 * j];
#ifdef DBG_NAN
#pragma unroll
            for (int e = 0; e < 4; ++e) if (!(fabsf(ov[e]) < 1e30f)) ov[e] = 12345.f;
#endif
            orow[64 * j] = ov; }
#ifdef DBG_DET
        { const unsigned* cs = WSP(const unsigned, WS_CTL) + CW_CS; float pz = 0.f;
          for (int k = 12; k >= 0; --k) if (cs[k] != cs[16 + k]) pz = __builtin_ldexpf(1.f, 40 - 2 * k);
#pragma unroll
          for (int j = 0; j < 4; ++j) orow[64 * j] = orow[64 * j] + pz; }
#endif
#ifdef DBG_ATTN
        { const float* acc = (const float*)(WSP(unsigned, WS_CTL) + CW_DBG); const float rv = acc[0] / acc[1]; const float pz = !(rv < DBG_TOL) ? 1000.f : 0.f;
#pragma unroll
          for (int j = 0; j < 4; ++j) orow[64 * j] = orow[64 * j] + pz; }
#endif
    }
}

#endif
constexpr int NPHASE = 18;
#ifndef MK_N_LAUNCHES
#define MK_N_LAUNCHES 1
#endif
constexpr int N_LAUNCHES = MK_N_LAUNCHES;
__global__ void __launch_bounds__(NWAVES * 64, 2) fwd(Args args) {
    extern __shared__ __attribute__((aligned(16))) unsigned char lds[];
    Frame F;
    F.lds = (LAS unsigned char*)lds; F.MISC = (volatile LAS unsigned*)(F.lds + MISC_OFF);
    F.tid = threadIdx.x; F.lane = F.tid & 63; F.wave = __builtin_amdgcn_readfirstlane(F.tid >> 6);
    F.G = gridDim.x; F.gw = blockIdx.x * NWAVES + F.wave; F.NGW = F.G * NWAVES;
    F.out = args.out; F.ws = args.ws;
    for (int u = F.tid; u < (LDS_BYTES - LDSCTL_OFF) / 4; u += NWAVES * 64) ((LAS unsigned*)(F.lds + LDSCTL_OFF))[u] = 0u;
    __syncthreads();
    XcdBarrier bar; bar.bar = (unsigned*)(F.ws + WS_CTL) + CW_BAR; bar.x = 0; bar.st = nullptr;
    if (N_LAUNCHES == 1) bar = xcd_barrier_post((unsigned*)(F.ws + WS_CTL) + CW_BAR, F.MISC + 8);
#define GRID_BAR() do { if (N_LAUNCHES == 1) xcd_barrier(bar); } while (0)
    const int lo = args.ph_lo, hi = args.ph_hi;
#ifdef PROBE_LO
    unsigned long long pr_t0 = 0ull, pr_dt = 0ull;
#define PROBE_AT(k) do { if (blockIdx.x == 0 && F.tid == 0) { if ((k) == PROBE_LO) pr_t0 = __builtin_amdgcn_s_memrealtime(); if ((k) == PROBE_HI + 1) pr_dt = __builtin_amdgcn_s_memrealtime() - pr_t0; } } while (0)
#else
#define PROBE_AT(k) do {} while (0)
#endif
#ifdef DBG_L2L
#define CK(k, p, n) dbg_cksum(F, (p), (n), (k))
#define CKB() GRID_BAR()
#else
#define CK(k, p, n) do {} while (0)
#define CKB() do {} while (0)
#endif
#if defined(ONLY_PH)
#define PH_EN(k) ((k) == ONLY_PH)
#elif defined(PH_MASK)
#define PH_EN(k) (((PH_MASK) >> (k)) & 1)
#else
#define PH_EN(k) true
#endif
#define IN(k) (PH_EN(k) && lo <= (k) && (k) < hi)
#define BOTH(k) (IN(k) && IN((k) + 1))
#define GEMM(EPI, Aoff, Boff, N_, K_, ...) do { pg8::Gemm g{(const pg8::bf16_t*)(F.ws + (Aoff)), (const pg8::bf16_t*)(F.ws + (Boff)), S, (N_), (K_)}; pg8::StaticOrder So; So.init(S, (N_), F.G, (int)blockIdx.x); \
        EPI E{__VA_ARGS__}; pg8::gemm_phase<EPI, pg8::StaticOrder, true, true>(F.lds + RING_OFF, g, So, E); } while (0)

    PROBE_AT(0);
    if (IN(0)) { p_prologue(F, args); if (BOTH(0)) GRID_BAR(); }
    CK(0, F.ws + WS_H, T32); CK(0, F.ws + WS_BA, 1 * MiB); CK(0, F.ws + WS_WTA, 41 * MiB - 512 * 1024); CKB();
    PROBE_AT(1);
    if (IN(1)) { GEMM(pg8::EpiRope, WS_H, WS_WTA, 3072, DM, WSP(pg8::bf16_t, WS_R1), WSP(const float, WS_COS), WSP(const float, WS_SIN), WSP(float, WS_KMEAN)); if (BOTH(1)) GRID_BAR(); }
    CK(1, F.ws + WS_R1, 3 * T32); CKB();
    PROBE_AT(2);
#ifndef TOPK2
#define TOPK2 1
#endif
#if !TOPK2
    if (IN(2)) { p_kmean(F, args); if (BOTH(2)) GRID_BAR(); }
#endif
    CK(2, F.ws + WS_KMEAN, 256 * 1024); CKB();
#ifndef ATTN_FAST
#define ATTN_FAST 1
#endif
#if ATTN_FAST
    PROBE_AT(3);
#if TOPK2
    if (IN(3)) { p_topk2(F, args); if (BOTH(3)) GRID_BAR(); }
#else
    if (IN(3)) { p_topk_bucket(F, args); if (BOTH(3)) GRID_BAR(); }
#endif
    CK(3, F.ws + WS_TOPI, (size_t)S * NH * 12); CKB();
    PROBE_AT(4);
    if (IN(4)) { PROBE_AT(40); p_attn_sel(F, args); GRID_BAR(); PROBE_AT(41); p_attn_own(F, args); PROBE_AT(42);
#ifdef DBG_ATTN
        GRID_BAR(); p_attn_naive(F, args); GRID_BAR(); dbg_compare(F, WSP(const bf16, WS_YA), (const bf16*)F.out, (size_t)S * DM);
#endif
        if (BOTH(4)) GRID_BAR(); }
    CK(4, F.ws + WS_YA, T32); CKB();
#else
    PROBE_AT(3);
    if (IN(3)) { p_topk(F, args); if (BOTH(3)) GRID_BAR(); }
    PROBE_AT(4);
    if (IN(4)) { p_attn_naive(F, args); if (BOTH(4)) GRID_BAR(); }
#endif
#ifdef DBG_CHK
    {   GEMM(pg8::EpiGen<0>, WS_H, WS_WTB, 4096, DM, WSP(pg8::bf16_t, WS_R1), DM, 1024, (size_t)S * DM, nullptr); GRID_BAR();
        { ConvHalo hl; p_dn_conv2_halo(F, hl); GRID_BAR(); p_dn_conv2(F, args, hl); GRID_BAR(); }
        p_dn_chunk2(F, args); GRID_BAR();
        dbg_chunk2_check(F, args); GRID_BAR();
#ifdef DBG_TILE
        if (blockIdx.x == 0 && F.tid == 0) WSP(unsigned, WS_CTL)[CW_TILE + 1] = 0xFFFFu; GRID_BAR(); dbg_tile_check(F, args); GRID_BAR();
#endif
        }
#elif defined(DBG_SIG)
    {
      { Frame Fp = F; asm volatile("" : "+s"(Fp.ws), "+s"(Fp.out), "+v"(Fp.lane), "+v"(Fp.tid));
        GEMM(pg8::EpiGen<0>, WS_H, WS_WTB, 4096, DM, WSP(pg8::bf16_t, WS_R1), DM, 1024, (size_t)S * DM, nullptr); GRID_BAR();
        p_dn_conv(Fp, args); GRID_BAR(); p_dn_chunk(Fp, args); GRID_BAR(); p_dn_relayout1(Fp, args); GRID_BAR(); p_dn_relayout2(Fp, args); GRID_BAR();
        dbg_sig(Fp, (const bf16*)Fp.out, (size_t)S * DM, 0); dbg_sig(Fp, WSPF(const bf16, WS_W), (size_t)S * DM, 1); dbg_sig(Fp, WSPF(const bf16, WS_KT), (size_t)S * DM, 2);
        dbg_sig(Fp, WSPF(const bf16, WS_UT), (size_t)S * DM, 3); dbg_sig(Fp, WSPF(const bf16, WS_ATT), (size_t)S * DM / 2, 4); GRID_BAR();
      }
      { Frame Fp = F; asm volatile("" : "+s"(Fp.ws), "+s"(Fp.out), "+v"(Fp.lane), "+v"(Fp.tid));
        p_hrecompute(Fp, args); GRID_BAR();
        GEMM(pg8::EpiGen<0>, WS_H, WS_WTB, 4096, DM, WSP(pg8::bf16_t, WS_R1), DM, 1024, (size_t)S * DM, nullptr); GRID_BAR();
        { ConvHalo hl; p_dn_conv2_halo(Fp, hl); GRID_BAR(); p_dn_conv2(Fp, args, hl); GRID_BAR(); }
        p_dn_chunk2(Fp, args); GRID_BAR();
        dbg_sig(Fp, WSPF(const bf16, WS2_QN), (size_t)S * DM, 8); dbg_sig(Fp, WSPF(const bf16, WS2_WNEG), (size_t)S * DM, 9); dbg_sig(Fp, ws2_kt(Fp), (size_t)S * DM, 10);
        dbg_sig(Fp, ws2_ut(Fp), (size_t)S * DM, 11); dbg_sig(Fp, WSPF(const bf16, WS2_ATT), (size_t)S * DM / 2, 12); GRID_BAR();
      }
    }
#elif defined(DBG_DET)
#define DET_PASS(P) { Frame Fp = F; asm volatile("" : "+s"(Fp.ws), "+s"(Fp.out), "+v"(Fp.lane), "+v"(Fp.tid)); \
    p_hrecompute(Fp, args); GRID_BAR(); \
    GEMM(pg8::EpiGen<0>, WS_H, WS_WTB, 4096, DM, WSP(pg8::bf16_t, WS_R1), DM, 1024, (size_t)S * DM, nullptr); GRID_BAR(); \
    dbg_cksum(Fp, Fp.ws + WS_R1, 4 * T32, (P) * 16 + 0); GRID_BAR(); \
    { ConvHalo hl; p_dn_conv2_halo(Fp, hl); GRID_BAR(); p_dn_conv2(Fp, args, hl); GRID_BAR(); } \
    dbg_cksum(Fp, Fp.ws + WS2_QN, T32, (P) * 16 + 1); dbg_cksum(Fp, Fp.ws + WS2_KN, T32, (P) * 16 + 2); dbg_cksum(Fp, ws2_kt(Fp), T32, (P) * 16 + 3); dbg_cksum(Fp, ws2_ut(Fp), T32, (P) * 16 + 4); GRID_BAR(); \
    p_dn_chunk2(Fp, args); GRID_BAR(); \
    dbg_cksum(Fp, Fp.ws + WS2_ATT, T32 / 2, (P) * 16 + 5); dbg_cksum(Fp, Fp.ws + WS2_QN, T32, (P) * 16 + 6); dbg_cksum(Fp, ws2_ut(Fp), T32, (P) * 16 + 7); dbg_cksum(Fp, Fp.ws + WS2_WNEG, T32, (P) * 16 + 8); \
    dbg_cksum(Fp, ws2_kt(Fp), T32, (P) * 16 + 9);  GRID_BAR(); \
    p_dn_scan_fast(Fp, args); GRID_BAR(); \
    dbg_cksum(Fp, ws2_ut(Fp), T32, (P) * 16 + 11); GRID_BAR(); \
    p_dn_out_fast(Fp, args); GRID_BAR(); \
    dbg_cksum(Fp, Fp.ws + WS2_YD, T32, (P) * 16 + 12); GRID_BAR(); }
    { DET_PASS(0) }
    { DET_PASS(1) }
    p_hrecompute(F, args); GRID_BAR();
#else
    PROBE_AT(5);
    if (IN(5)) { GEMM(pg8::EpiGen<0>, WS_H, WS_WTB, 4096, DM, WSP(pg8::bf16_t, WS_R1), DM, 1024, (size_t)S * DM, nullptr); if (BOTH(5)) GRID_BAR(); }
    CK(5, F.ws + WS_R1, 4 * T32); CKB();
#if DN2
    PROBE_AT(6);
    if (IN(6)) { ConvHalo hl; p_dn_conv2_halo(F, hl); GRID_BAR(); p_dn_conv2(F, args, hl); if (BOTH(6)) GRID_BAR(); }
    CK(6, F.ws + WS2_QN, 2 * T32); CK(6, F.out, 2 * T32); CKB();
    PROBE_AT(7);
    if (IN(7)) { p_dn_chunk2(F, args); if (BOTH(7)) GRID_BAR(); }
    CK(7, F.ws + WS2_ATT, T32 / 2); CK(7, F.ws + WS2_QN, T32); CK(7, F.out, 2 * T32); CK(7, F.ws + WS2_WNEG, T32); CK(7, F.ws + WS_EGL, 8192); CKB();
#else
    PROBE_AT(6);
    if (IN(6)) { p_dn_conv(F, args); if (BOTH(6)) GRID_BAR(); }
    PROBE_AT(7);
    if (IN(7)) { p_dn_chunk(F, args); if (BOTH(7)) GRID_BAR(); }
#endif
#ifndef DN_FAST
#define DN_FAST 1
#endif
#if DN_FAST
#if DN2
    PROBE_AT(8);
#ifndef SCAN2
#define SCAN2 1
#endif
#if SCAN2
    if (IN(8)) { PROBE_AT(80); p_dn_scan2_A(F, args); GRID_BAR(); PROBE_AT(81); p_dn_scan2_B(F, args); GRID_BAR(); PROBE_AT(82); if (blockIdx.x < 128) p_dn_scan2_C(F, args); else { p_hrecompute_sub(F, args, WSP(bf16, WS2_HALT), ((int)blockIdx.x - 128) * NWAVES + F.wave, 128 * NWAVES);
#if DN2_LATE_WT
            p_wtrans(F, args, WT_ITEMS_EARLY, WT_ITEMS_ALL, ((int)blockIdx.x - 128) * NWAVES + F.wave, 128 * NWAVES);
#endif
        } if (BOTH(8)) GRID_BAR(); PROBE_AT(83); }
#else
    if (IN(8)) { p_dn_scan_fast(F, args); if (BOTH(8)) GRID_BAR(); }
#endif
    CK(8, ws2_ut(F), T32); CKB();
#else
    PROBE_AT(8);
    if (IN(8)) { p_dn_relayout1(F, args); GRID_BAR(); p_dn_relayout2(F, args); GRID_BAR(); p_dn_scan_fast(F, args); if (BOTH(8)) GRID_BAR(); }
#endif
    PROBE_AT(9);
#if DN2 && SCAN2
    if (IN(9)) { p_dn_out_fast(F, args); if (BOTH(9)) GRID_BAR(); }
#else
    if (IN(9)) { p_dn_out_fast(F, args); p_hrecompute(F, args); if (BOTH(9)) GRID_BAR(); }
#endif
    CK(9, F.ws + WS2_YD, T32); CK(9, F.ws + WS_H, T32); CKB();
#else
    PROBE_AT(8);
    if (IN(8)) { p_dn_scan_naive(F, args); if (BOTH(8)) GRID_BAR(); }
    PROBE_AT(9);
    if (IN(9)) { p_dn_out(F, args); p_hrecompute(F, args); if (BOTH(9)) GRID_BAR(); }
#endif
#endif
    PROBE_AT(10);
    if (IN(10)) { GEMM(pg8::EpiGen<1>, WS2_HALT, WS_WTG, 2048, DM, (pg8::bf16_t*)F.out, DM, 1024, (size_t)S * DM, nullptr); if (BOTH(10)) GRID_BAR(); }
    CK(10, F.out, 2 * T32); CKB();
    PROBE_AT(11);
    if (IN(11)) { GEMM(pg8::EpiGen<2>, WS_YA, WS_WTOA, 1024, DM, (pg8::bf16_t*)F.out, DM, 0, 0, nullptr); if (BOTH(11)) GRID_BAR(); }
    CK(11, F.out, T32); CKB();
    PROBE_AT(12);
    if (IN(12)) { GEMM(pg8::EpiGen<3>, SCAN_YD, WS_WTOD, 1024, DM, (pg8::bf16_t*)F.out, DM, 0, 0, (const pg8::bf16_t*)F.out + (size_t)S * DM); if (BOTH(12)) GRID_BAR(); }
    CK(12, F.out, T32); CKB();
    PROBE_AT(13);
    if (IN(13)) { pg8::Gemm g{(const pg8::bf16_t*)F.out, WSP(const pg8::bf16_t, WS_WTOUT), S, DM, DM}; pg8::StaticOrder So; So.init(S, DM, F.G, (int)blockIdx.x);
        pg8::EpiGen<0> E{WSP(pg8::bf16_t, WS_T), DM, 0, 0, nullptr}; pg8::gemm_phase<pg8::EpiGen<0>, pg8::StaticOrder, true, true>(F.lds + RING_OFF, g, So, E); if (BOTH(13)) GRID_BAR(); }
    CK(13, F.ws + WS_T, 2 * T32); CKB();
    PROBE_AT(14);
    if (IN(14)) { p_post_mix(F, args); if (BOTH(14)) GRID_BAR(); }
    CK(14, F.out, 2 * T32); CK(14, F.ws + WS_H2, T32); CKB();
    PROBE_AT(15);
    if (IN(15)) { GEMM(pg8::EpiGen<4>, WS_H2, WS_WTGU, 2 * DFF, DM, WSP(pg8::bf16_t, WS_ACT), DFF, 0, 0, nullptr); if (BOTH(15)) GRID_BAR(); }
    CK(15, F.ws + WS_ACT, ACT_BYTES); CKB();
    PROBE_AT(16);
    if (IN(16)) { pg8::Gemm g{WSP(const pg8::bf16_t, WS_ACT), WSP(const pg8::bf16_t, WS_WTDN), S, DM, DFF}; pg8::StaticOrder So; So.init(S, DM, F.G, (int)blockIdx.x);
        pg8::EpiGen<0> E{WSP(pg8::bf16_t, WS_F), DM, 0, 0, nullptr}; pg8::gemm_phase<pg8::EpiGen<0>, pg8::StaticOrder, true, true>(F.lds + RING_OFF, g, So, E); if (BOTH(16)) GRID_BAR(); }
    CK(16, F.ws + WS_F, 2 * T32); CKB();
#ifdef DBG_TILE
    PROBE_AT(17);
    if (IN(17)) { const unsigned* w = WSP(const unsigned, WS_CTL) + CW_TILE; const unsigned cnt = w[0], mn = w[1]; const unsigned hm = (mn < 256u) ? w[2 + mn] : 0u;
        const int sel = DBG_TILE; const unsigned val = (sel == 1) ? (cnt > 120u ? 120u : cnt) : (sel == 2) ? (mn > 255u ? 127u : (mn >> 1)) : (sel == 3 ? (mn & 1u) * 8u + 0u + (hm & 0xFu) * 0u + (hm & 0xFFu) / 4u : (hm & 3u));
        float pz = __builtin_ldexpf(1.f, (int)val + 4); if (sel == 6) pz = __builtin_ldexpf(1.f, (int)(w[301] & 15u) + 4); if (sel == 7) pz = __builtin_ldexpf(1.f, (int)(w[301] >> 4) + 4); if (sel == 8) pz = __builtin_ldexpf(1.f, (int)(w[302] & 15u) + 4); if (sel == 9) pz = __builtin_ldexpf(1.f, (int)(w[302] >> 4) + 4);
        if (sel == 5) { unsigned be = w[300], lg = 0; while (be > 1u) { be >>= 1; ++lg; } pz = __builtin_ldexpf(1.f, (int)lg + 4); }
        for (size_t i = (size_t)F.gw * 64 + F.lane; i < (size_t)S * DM; i += (size_t)F.NGW * 64) F.out[i] = args.in[0][i] + pz; }
#elif defined(DBG_CHK)
    PROBE_AT(17);
    if (IN(17)) { const long long* sg = (const long long*)(WSP(unsigned, WS_CTL) + CW_CHK); float pz = 0.f;
        for (int k = 12; k >= 9; --k) { const double e2 = (double)sg[2 * k], r2 = (double)sg[2 * k + 1]; if (!(e2 <= 1e-3 * r2 + 16.0)) pz += 1024.f * (float)(1 << (2 * (k - 9))); }
        for (size_t i = (size_t)F.gw * 64 + F.lane; i < (size_t)S * DM; i += (size_t)F.NGW * 64) F.out[i] = args.in[0][i] + pz; }
#elif defined(DBG_SIG)
    PROBE_AT(17);
    if (IN(17)) { const long long* sg = (const long long*)(WSP(unsigned, WS_CTL) + CW_SIG); float pz = 0.f;
        for (int k = 4; k >= 0; --k) { const float a0 = (float)((double)sg[2 * k] / 65536.0), a1 = (float)((double)sg[2 * (8 + k)] / 65536.0), n0 = (float)((double)sg[2 * k + 1] / 65536.0), n1 = (float)((double)sg[2 * (8 + k) + 1] / 65536.0);
            const bool bad = !(fabsf(a0 - a1) <= 0.02f * sqrtf(n0) + 1e-3f) || !(fabsf(n0 - n1) <= 0.02f * (n0 + n1)); if (bad) pz = __builtin_ldexpf(1.f, 40 - 2 * k); }
        for (size_t i = (size_t)F.gw * 64 + F.lane; i < (size_t)S * DM; i += (size_t)F.NGW * 64) F.out[i] = args.in[0][i] + pz; }
#elif defined(DBG_DET)
    PROBE_AT(17);
    if (IN(17)) { const unsigned* cs = WSP(const unsigned, WS_CTL) + CW_CS; float pz = 0.f;
#ifdef DBG_NANCNT
        for (int k = 12; k >= 0; --k) if (cs[k] != 0u) pz = __builtin_ldexpf(1.f, 40 - 2 * k);
#else
        for (int k = 12; k >= 0; --k) if (cs[k] != cs[16 + k]) pz = __builtin_ldexpf(1.f, 40 - 2 * k);
#endif
        for (size_t i = (size_t)F.gw * 64 + F.lane; i < (size_t)S * DM; i += (size_t)F.NGW * 64) F.out[i] = args.in[0][i] + pz; }
#else
    PROBE_AT(17);
    if (IN(17)) { p_final(F, args); }
#endif
#ifdef SCAN_PROBE
    __syncthreads();
    if (blockIdx.x == 0 && F.tid == 0) { const unsigned long long ts = __builtin_amdgcn_s_memrealtime(); const unsigned long long dd = 8ull * (unsigned long long)F.MISC[16]; while (__builtin_amdgcn_s_memrealtime() - ts < dd) __builtin_amdgcn_s_sleep(8); }
#endif
#ifdef PROBE_LO
    PROBE_AT(18);
    if (blockIdx.x == 0 && F.tid == 0) { const unsigned long long ts = __builtin_amdgcn_s_memrealtime(); while (__builtin_amdgcn_s_memrealtime() - ts < 8ull * pr_dt) __builtin_amdgcn_s_sleep(8); }
#endif
#ifdef DBG_L2L
    GRID_BAR(); CK(17, F.out, 2 * T32); GRID_BAR();
    { unsigned* cs = WSP(unsigned, WS_CTL) + CW_CS; unsigned* save = WSP(unsigned, 253 * MiB);
      if (args.pass == 0) { if (blockIdx.x == 0 && F.tid < 32) save[F.tid] = cs[F.tid]; }
      else { float pz = 0.f; for (int k = 17; k >= 0; --k) if (cs[k] != save[k]) pz = __builtin_ldexpf(1.f, 44 - 2 * k);
          if (pz != 0.f) for (size_t i = (size_t)F.gw * 64 + F.lane; i < (size_t)S * DM; i += (size_t)F.NGW * 64) F.out[i] += pz; } }
#endif
#undef IN
#undef BOTH
}

extern "C" void kernel_launch(void* const* d_in, const int* in_sizes, int n_in, void* d_out, int out_size, void* d_ws, size_t ws_size, hipStream_t stream) {
    static int grid = 0;
    if (grid == 0) {
        if (n_in != 16 || in_sizes[0] != S * DM || out_size != S * DM || ws_size < WS_END) { fprintf(stderr, "kernel_launch: unexpected shapes (n_in %d, in0 %d, out %d, ws %zu); nothing launched\n", n_in, n_in > 0 ? in_sizes[0] : -1, out_size, ws_size); grid = -1; return; }
        int dev = 0, cus = 0, per_cu = 0;
        if (hipGetDevice(&dev) != hipSuccess || hipDeviceGetAttribute(&cus, hipDeviceAttributeMultiprocessorCount, dev) != hipSuccess) { grid = -1; return; }
        if (hipFuncSetAttribute((const void*)fwd, hipFuncAttributeMaxDynamicSharedMemorySize, LDS_BYTES) != hipSuccess) { fprintf(stderr, "kernel_launch: hipFuncSetAttribute failed\n"); grid = -1; return; }
        if (hipOccupancyMaxActiveBlocksPerMultiprocessor(&per_cu, (const void*)fwd, NWAVES * 64, LDS_BYTES) != hipSuccess || per_cu < 1) fprintf(stderr, "kernel_launch: occupancy query says %d\n", per_cu);
        (void)hipGetLastError();
        grid = cus;
    }
    if (grid < 0) return;
    if (hipMemsetAsync((char*)d_ws + WS_CTL, 0, CTL_ZERO_BYTES, stream) != hipSuccess) return;
    Args a{};
    for (int i = 0; i < 16; ++i) a.in[i] = (const float*)d_in[i];
    a.out = (float*)d_out; a.ws = (unsigned char*)d_ws;
#ifdef DBG_L2L
    hipMemsetAsync((char*)d_ws + CTL_ZERO_BYTES, 0xA5, WS_END - CTL_ZERO_BYTES, stream); hipMemsetAsync(d_out, 0xA5, (size_t)S * DM * 4, stream);
    for (int li = 0; li < 2; ++li) {
        if (li == 1) hipMemsetAsync((char*)d_ws + WS_CTL, 0, CTL_ZERO_BYTES, stream);
        a.ph_lo = 0; a.ph_hi = NPHASE; a.pass = li;
#else
    for (int li = 0; li < N_LAUNCHES; ++li) {
        a.ph_lo = (N_LAUNCHES == 1) ? 0 : li; a.ph_hi = (N_LAUNCHES == 1) ? NPHASE : li + 1;
#endif
        hipLaunchKernelGGL(fwd, dim3(grid), dim3(NWAVES * 64), LDS_BYTES, stream, a);
        if (hipPeekAtLastError() != hipSuccess) { fprintf(stderr, "kernel_launch: launch %d failed\n", li); break; }
    }
}
```

```cpp
#include <hip/hip_runtime.h>
#include <cstdio>
#include <cstdint>
#include <cmath>
namespace pg8 {
#define PG8_LAS __attribute__((address_space(3)))
typedef unsigned short bf16_t;
typedef short bf16x8 __attribute__((ext_vector_type(8)));
typedef float f32x4 __attribute__((ext_vector_type(4)));
typedef unsigned u32x4 __attribute__((ext_vector_type(4)));
constexpr int BM = 256, BK = 64, HALF = 128, HTB = HALF * BK * 2  , STAGE_BYTES = 8 * HTB, NXCD = 8, WGM = 8;

__host__ __device__ __forceinline__ int lds_byte(int r, int c) { const int st = (r >> 4) * 2 + (c >> 5), rr = r & 15, cc = c & 31, ob = rr * 64 + cc * 2; return st * 1024 + (ob ^ (((ob >> 9) & 1) << 5)); }
__host__ __device__ __forceinline__ void stage_rc(int b, int& R, int& C) { const int st = b / 1024, sb = b % 1024, swz = sb ^ (((sb >> 9) & 1) << 5); R = (st >> 1) * 16 + swz / 64; C = (st & 1) * 32 + (swz % 64) / 2; }
__host__ __device__ __forceinline__ int perm32(int rho) { const int n = rho >> 4, i = rho & 15; return 8 * (i >> 2) + 4 * n + (i & 3); }

struct Unit { int pm, pn; };
struct Gemm { const bf16_t* A; const bf16_t* Bt; int M, N, K; };

struct StaticOrder {
    int nM, nN, nwg, G, c;
    __host__ __device__ void init(int M, int N, int G_, int c_) { nM = M / BM; nN = N / BM; nwg = nM * nN; G = G_; c = c_; }
    __host__ __device__ bool next(int i, Unit& u) const {
        const long L = (long)i * G + c; if (L >= nwg) return false;
        int wgid = (int)L; { const int q = nwg / NXCD, r = nwg % NXCD, xcd = wgid % NXCD, off = wgid / NXCD; wgid = (xcd < r ? xcd * (q + 1) : r * (q + 1) + (xcd - r) * q) + off; }
        const int nig = WGM * nN, gid = wgid / nig, fm = gid * WGM, gsz = (nM - fm) < WGM ? (nM - fm) : WGM;
        u.pm = fm + ((wgid % nig) % gsz); u.pn = (wgid % nig) / gsz; return true;
    }
    __device__ __forceinline__ void a_ready(const Unit&) const {}
    __device__ __forceinline__ void done(const Unit&) const {}
};

__device__ __forceinline__ unsigned cvt_pk_bf16(float lo, float hi) { typedef __bf16 b2 __attribute__((ext_vector_type(2))); typedef float f2 __attribute__((ext_vector_type(2))); const f2 v = {lo, hi}; return __builtin_bit_cast(unsigned, __builtin_convertvector(v, b2)); }
template <class Epi, class Sched, bool ALIGN_EPI = false, bool SP2 = false>
__device__ __forceinline__ void gemm_phase(PG8_LAS unsigned char* lds, const Gemm g, const Sched& S, const Epi& E) {
    const int tid = threadIdx.x, wid = __builtin_amdgcn_readfirstlane(tid >> 6), lane = tid & 63, wr = wid >> 2, wc = wid & 3, fr = lane & 15, fq = lane >> 4;
    const int K = g.K, nt = K / BK;
    unsigned voffA[2], voffB[2];
#pragma unroll
    for (int i = 0; i < 2; ++i) { int R, C; stage_rc(tid * 16 + i * 8192, R, C); const int Rb = Epi::PERM ? ((R & ~31) + perm32(R & 31)) : R;
        voffA[i] = (unsigned)(R * K + C) * 2u; voffB[i] = (unsigned)(Rb * K + C) * 2u; }
    const size_t kstep = (size_t)(BK * 2);
    const size_t hstep = (size_t)HALF * K * 2;
    const size_t tstep = 2 * hstep;
    const unsigned ldsw = (unsigned)wid * 1024u;
    const int aoff = lds_byte(wr * 64 + fr, fq * 8), boff = lds_byte(wc * 32 + fr, fq * 8);
#define PG8_SA(b, h) (((b) * 2 + (h)) * HTB)
#define PG8_SB(b, h) ((4 + (b) * 2 + (h)) * HTB)
#define PG8_STAGE(bufoff, gbase, voff) do { _Pragma("unroll") for (int _i = 0; _i < 2; ++_i) \
        __builtin_amdgcn_global_load_lds((const unsigned*)((const char*)(gbase) + (voff)[_i]), (PG8_LAS unsigned*)(lds + (bufoff) + ldsw + _i * 8192), 16, 0, 0); } while (0)
#define PG8_LDA(dst, b, h) do { _Pragma("unroll") for (int m = 0; m < 4; ++m) _Pragma("unroll") for (int k = 0; k < 2; ++k) dst[m][k] = *(const PG8_LAS bf16x8*)(lds + PG8_SA(b, h) + aoff + m * 2048 + k * 1024); } while (0)
#define PG8_LDB(dst, b, h) do { _Pragma("unroll") for (int n = 0; n < 2; ++n) _Pragma("unroll") for (int k = 0; k < 2; ++k) dst[n][k] = *(const PG8_LAS bf16x8*)(lds + PG8_SB(b, h) + boff + n * 2048 + k * 1024); } while (0)
#define PG8_MMA(ai, bj, At, Bt) do { __builtin_amdgcn_s_setprio(1); _Pragma("unroll") for (int m = 0; m < 4; ++m) _Pragma("unroll") for (int n = 0; n < 2; ++n) _Pragma("unroll") for (int k = 0; k < 2; ++k) \
        acc[ai][bj][m][n] = __builtin_amdgcn_mfma_f32_16x16x32_bf16(Bt[n][k], At[m][k], acc[ai][bj][m][n], 0, 0, 0); __builtin_amdgcn_s_setprio(0); } while (0)
#define PG8_WAIT_V(n) asm volatile("s_waitcnt vmcnt(" #n ")" ::: "memory")
#define PG8_WAIT_L(n) asm volatile("s_waitcnt lgkmcnt(" #n ")" ::: "memory")
#define PG8_BAR __builtin_amdgcn_s_barrier()
#define PG8_SCHED __builtin_amdgcn_sched_barrier(0)
    Unit cur, nxt; int ui = 0;
    if (!S.next(0, cur)) return;
    f32x4 acc[2][2][4][2];
#pragma unroll
    for (int a = 0; a < 2; ++a)
#pragma unroll
        for (int b = 0; b < 2; ++b)
#pragma unroll
            for (int m = 0; m < 4; ++m)
#pragma unroll
                for (int n = 0; n < 2; ++n) acc[a][b][m][n] = (f32x4){0.f, 0.f, 0.f, 0.f};
    bf16x8 At[4][2], B0[2][2], B1[2][2];
    const char* cA = (const char*)g.A + (size_t)cur.pm * tstep; const char* cB = (const char*)g.Bt + (size_t)cur.pn * tstep;
    S.a_ready(cur);
    if constexpr (SP2) {
        PG8_STAGE(PG8_SB(0, 0), cB, voffB); PG8_STAGE(PG8_SB(0, 1), cB + hstep, voffB); PG8_STAGE(PG8_SA(0, 0), cA, voffA); PG8_STAGE(PG8_SA(0, 1), cA + hstep, voffA);
        if (wr == 1) PG8_BAR;
        PG8_WAIT_V(2); PG8_BAR;
        PG8_STAGE(PG8_SB(1, 0), cB + kstep, voffB); PG8_STAGE(PG8_SA(1, 0), cA + kstep, voffA); PG8_STAGE(PG8_SB(1, 1), cB + hstep + kstep, voffB);
        PG8_WAIT_V(6); PG8_BAR;
    } else {
        PG8_STAGE(PG8_SB(0, 0), cB, voffB); PG8_STAGE(PG8_SA(0, 0), cA, voffA); PG8_STAGE(PG8_SB(0, 1), cB + hstep, voffB); PG8_STAGE(PG8_SA(0, 1), cA + hstep, voffA);
        if (wr == 1) PG8_BAR;
        PG8_WAIT_V(4); PG8_BAR;
        PG8_STAGE(PG8_SB(1, 0), cB + kstep, voffB); PG8_STAGE(PG8_SA(1, 0), cA + kstep, voffA); PG8_STAGE(PG8_SB(1, 1), cB + hstep + kstep, voffB);
        PG8_WAIT_V(6); PG8_BAR;
    }
    for (;;) {
        const bool has_next = S.next(ui + 1, nxt);
        const char* nA = has_next ? (const char*)g.A + (size_t)nxt.pm * tstep : cA; const char* nB = has_next ? (const char*)g.Bt + (size_t)nxt.pn * tstep : cB;
        for (int t = 0; t < nt; t += 2) {
            const bool last = (t == nt - 2);
            const char* a1 = cA + (size_t)(t + 1) * kstep;
            const char* a2 = last ? nA : cA + (size_t)(t + 2) * kstep; const char* b2 = last ? nB : cB + (size_t)(t + 2) * kstep;
            const char* a3 = a2 + kstep; const char* b3 = b2 + kstep;
            if (last && has_next) S.a_ready(nxt);
            if constexpr (SP2) {
            PG8_LDB(B0, 0, 0); PG8_LDB(B1, 0, 1); PG8_SCHED; PG8_LDA(At, 0, 0); PG8_STAGE(PG8_SA(1, 1), a1 + hstep, voffA);
            PG8_WAIT_V(8); PG8_WAIT_L(0); PG8_BAR; PG8_MMA(0, 0, At, B0); PG8_MMA(0, 1, At, B1); PG8_BAR; PG8_SCHED;
            PG8_LDA(At, 0, 1); PG8_STAGE(PG8_SB(0, 0), b2, voffB); PG8_STAGE(PG8_SB(0, 1), b2 + hstep, voffB); PG8_STAGE(PG8_SA(0, 0), a2, voffA);
            PG8_WAIT_V(8); PG8_WAIT_L(0); PG8_BAR; PG8_MMA(1, 0, At, B0); PG8_MMA(1, 1, At, B1); PG8_BAR; PG8_SCHED;
            PG8_LDB(B0, 1, 0); PG8_LDB(B1, 1, 1); PG8_SCHED; PG8_LDA(At, 1, 0); PG8_STAGE(PG8_SA(0, 1), a2 + hstep, voffA);
            PG8_WAIT_V(8); PG8_WAIT_L(0); PG8_BAR; PG8_MMA(0, 0, At, B0); PG8_MMA(0, 1, At, B1); PG8_BAR; PG8_SCHED;
            PG8_LDA(At, 1, 1); PG8_STAGE(PG8_SB(1, 0), b3, voffB); PG8_STAGE(PG8_SB(1, 1), b3 + hstep, voffB); PG8_STAGE(PG8_SA(1, 0), a3, voffA);
            PG8_WAIT_V(8); PG8_WAIT_L(0); PG8_BAR; PG8_MMA(1, 0, At, B0); PG8_MMA(1, 1, At, B1); PG8_BAR; PG8_SCHED;
            } else {
            PG8_LDB(B0, 0, 0); PG8_SCHED; PG8_LDA(At, 0, 0); PG8_STAGE(PG8_SA(1, 1), a1 + hstep, voffA);
            PG8_WAIT_L(8); PG8_BAR; PG8_WAIT_L(0); PG8_MMA(0, 0, At, B0); PG8_BAR; PG8_SCHED;
            PG8_LDB(B1, 0, 1); PG8_STAGE(PG8_SB(0, 0), b2, voffB);
            PG8_BAR; PG8_WAIT_L(0); PG8_MMA(0, 1, At, B1); PG8_BAR;
            PG8_LDA(At, 0, 1); PG8_STAGE(PG8_SA(0, 0), a2, voffA);
            PG8_BAR; PG8_WAIT_L(0); PG8_MMA(1, 0, At, B0); PG8_BAR; PG8_SCHED;
            PG8_STAGE(PG8_SB(0, 1), b2 + hstep, voffB);
            PG8_WAIT_V(6); PG8_BAR; PG8_MMA(1, 1, At, B1); PG8_BAR;
            PG8_LDB(B0, 1, 0); PG8_SCHED; PG8_LDA(At, 1, 0); PG8_STAGE(PG8_SA(0, 1), a2 + hstep, voffA);
            PG8_WAIT_L(8); PG8_BAR; PG8_WAIT_L(0); PG8_MMA(0, 0, At, B0); PG8_BAR; PG8_SCHED;
            PG8_LDB(B1, 1, 1); PG8_STAGE(PG8_SB(1, 0), b3, voffB);
            PG8_BAR; PG8_WAIT_L(0); PG8_MMA(0, 1, At, B1); PG8_BAR;
            PG8_LDA(At, 1, 1); PG8_STAGE(PG8_SA(1, 0), a3, voffA);
            PG8_BAR; PG8_WAIT_L(0); PG8_MMA(1, 0, At, B0); PG8_BAR; PG8_SCHED;
            PG8_STAGE(PG8_SB(1, 1), b3 + hstep, voffB);
            PG8_WAIT_V(6); PG8_BAR; PG8_MMA(1, 1, At, B1); PG8_BAR;
            }
        }
        if constexpr (ALIGN_EPI) { if (wr == 0) PG8_BAR; }
        if constexpr (!Epi::AFTER_DRAIN) { E(acc, cur, wr, wc, fr, fq); S.done(cur); }
        if (!has_next) break;
#pragma unroll
        for (int a = 0; a < 2; ++a)
#pragma unroll
            for (int b = 0; b < 2; ++b)
#pragma unroll
                for (int m = 0; m < 4; ++m)
#pragma unroll
                    for (int n = 0; n < 2; ++n) acc[a][b][m][n] = (f32x4){0.f, 0.f, 0.f, 0.f};
        cur = nxt; cA = nA; cB = nB; ++ui;
        if constexpr (ALIGN_EPI) { if (wr == 1) PG8_BAR; }
    }
    PG8_WAIT_V(0);
    if constexpr (!ALIGN_EPI) { if (wr == 0) PG8_BAR; }
    PG8_BAR;
    if constexpr (Epi::AFTER_DRAIN) { E.fused(acc, cur, wr, wc, fr, fq, lds, wid, lane); S.done(cur); }
#undef PG8_SA
#undef PG8_SB
#undef PG8_STAGE
#undef PG8_LDA
#undef PG8_LDB
#undef PG8_MMA
#undef PG8_WAIT_V
#undef PG8_WAIT_L
#undef PG8_BAR
#undef PG8_SCHED
}
}
#define GAS __attribute__((address_space(1)))
#define LAS __attribute__((address_space(3)))
typedef unsigned short bf16;
typedef unsigned v4u __attribute__((ext_vector_type(4)));
typedef float f32x4 __attribute__((ext_vector_type(4)));
typedef short bf16x8 __attribute__((ext_vector_type(8)));
typedef GAS unsigned gu32;
typedef GAS unsigned long long gu64;
#define RLX_AGENT __ATOMIC_RELAXED, __HIP_MEMORY_SCOPE_AGENT
#define LDS_WAIT() asm volatile("s_waitcnt lgkmcnt(0)" ::: "memory")
#define VM_WAIT() asm volatile("s_waitcnt vmcnt(0)" ::: "memory")
__device__ __forceinline__ unsigned long long rt() { return __builtin_amdgcn_s_memrealtime(); }
typedef __bf16 hbf2_t __attribute__((ext_vector_type(2)));
typedef float hf2_t __attribute__((ext_vector_type(2)));
__device__ __forceinline__ unsigned pk2(float lo, float hi) { const hf2_t v = {lo, hi}; return __builtin_bit_cast(unsigned, __builtin_convertvector(v, hbf2_t)); }
__device__ __forceinline__ unsigned f2bf(float f) { return pk2(f, 0.f) & 0xffffu; }

#define XB_TMO      128
#define XB_XCNT(j)  (256  + 64 * (j))
#define XB_XSUB(j)  (1280 + 64 * (j))
#define XB_XGEN(j)  (2304 + 64 * (j))
#define XB_TOP      3328
#define XB_TOPGEN   3392
#define XCD_BAR_WORDS 3456
#define XB_SPIN_CAP (1u << 22)

__device__ __forceinline__ unsigned xb_ld(unsigned* p)              { return __hip_atomic_load(p, __ATOMIC_RELAXED, __HIP_MEMORY_SCOPE_AGENT); }
__device__ __forceinline__ unsigned xb_add(unsigned* p, unsigned v) { return __hip_atomic_fetch_add(p, v, __ATOMIC_RELAXED, __HIP_MEMORY_SCOPE_AGENT); }
__device__ __forceinline__ unsigned xb_xcc_id() { return (unsigned)__builtin_amdgcn_s_getreg((3 << 11) | 20) & 0xFu; }
#define XB_SPIN(cond, bar) do { unsigned _sp = 0; while (cond) { __builtin_amdgcn_s_sleep(1); \
    if ((++_sp & 255u) == 0u) { if (xb_ld(&(bar)[XB_TMO])) break; if (_sp > XB_SPIN_CAP) { atomicAdd(&(bar)[XB_TMO], 1u); break; } } } } while (0)

struct XcdBarrier {
    unsigned* bar; unsigned x;
    volatile LAS unsigned* st;
};

__device__ __forceinline__ XcdBarrier xcd_barrier_post(unsigned* bar, volatile LAS unsigned* st) {
    XcdBarrier b; b.bar = bar; b.x = xb_xcc_id(); b.st = st;
    if (threadIdx.x == 0) (void)xb_add(&bar[XB_XCNT(b.x)], 1u);
    return b;
}
__device__ __forceinline__ void xcd_barrier_complete(unsigned* bar, unsigned x, unsigned& nloc, unsigned& nx) {
    const unsigned G = gridDim.x * gridDim.y * gridDim.z;
    unsigned sum, cnt, mine, sp = 0u;
    for (;;) {
        sum = 0u; cnt = 0u; mine = 0u;
#pragma unroll
        for (unsigned j = 0; j < 16; ++j) { const unsigned c = xb_ld(&bar[XB_XCNT(j)]); sum += c; cnt += (c > 0u) ? 1u : 0u; mine = (j == x) ? c : mine; }
        if (sum == G) break;
        __builtin_amdgcn_s_sleep(1);
        if ((++sp & 255u) == 0u) { if (xb_ld(&bar[XB_TMO])) break; if (sp > XB_SPIN_CAP) { atomicAdd(&bar[XB_TMO], 1u); break; } }
    }
    nloc = mine > 0u ? mine : 1u; nx = cnt > 0u ? cnt : 1u;
}

__device__ __forceinline__ void xcd_barrier(const XcdBarrier& b) {
    asm volatile("s_waitcnt vmcnt(0)" ::: "memory");
    __syncthreads();
    if (threadIdx.x == 0) {
        unsigned* bar = b.bar;
        __builtin_amdgcn_s_waitcnt(0);
        unsigned nloc = b.st[0], nx = b.st[1];
        if (nloc == 0u) { xcd_barrier_complete(bar, b.x, nloc, nx); b.st[0] = nloc; b.st[1] = nx; }
        const unsigned old = xb_add(&bar[XB_XSUB(b.x)], 1u);
        const unsigned gen = old / nloc;
        if (old + 1u == (gen + 1u) * nloc) {
            __builtin_amdgcn_fence(__ATOMIC_RELEASE, "agent");
            asm volatile("s_waitcnt vmcnt(0)" ::: "memory");
            const unsigned og = xb_add(&bar[XB_TOP], 1u);
            const unsigned tg = og / nx;
            if (og + 1u == (tg + 1u) * nx) xb_add(&bar[XB_TOPGEN], 1u);
            else XB_SPIN(xb_ld(&bar[XB_TOPGEN]) == tg, bar);
            __builtin_amdgcn_fence(__ATOMIC_ACQUIRE, "agent");
            xb_add(&bar[XB_XGEN(b.x)], 1u);
            asm volatile("s_waitcnt vmcnt(0)" ::: "memory");
        } else {
            XB_SPIN(xb_ld(&bar[XB_XGEN(b.x)]) == gen, bar);
            __builtin_amdgcn_fence(__ATOMIC_ACQUIRE, "agent");
            asm volatile("s_waitcnt vmcnt(0)" ::: "memory");
        }
    }
    __syncthreads();
}

constexpr int S = 16384, DM = 1024, NH = 8, HD = 128, MBLK = 256, NBLK = S / MBLK, DFF = 2816, INTOT = 9232;
constexpr int CH = 64, NCH = S / CH;
constexpr float EPS = 1e-6f;
constexpr int NWAVES = 8;
#ifndef DN2_LATE_WT
#define DN2_LATE_WT 1
#endif

constexpr size_t MiB = 1u << 20;
constexpr size_t WS_CTL = 0, CTL_ZERO_BYTES = 1 * MiB;
constexpr size_t WS_COS = 1 * MiB, WS_SIN = 2 * MiB;
constexpr size_t WS_BA = 3 * MiB;
constexpr size_t WS_KMEAN = 4 * MiB;
constexpr size_t WS_TOPI = 5 * MiB;
constexpr size_t WS_BETA = 6 * MiB + 512 * 1024, WS_G = 7 * MiB, WS_GC = 7 * MiB + 512 * 1024;
constexpr size_t WS_WTA = 8 * MiB, WS_WTB = 14 * MiB, WS_WTG = 22 * MiB, WS_WTOA = 26 * MiB, WS_WTOD = 28 * MiB, WS_WTOUT = 30 * MiB, WS_WTGU = 32 * MiB, WS_WTDN = 43 * MiB;
constexpr size_t WS_H = 49 * MiB;
constexpr size_t WS_R1 = 81 * MiB;
constexpr size_t WS_Z = 177 * MiB, WS_YA = 209 * MiB, WS_END = 256 * MiB;
constexpr size_t ACT_BYTES = (size_t)S * DFF * 2;
constexpr size_t T32 = (size_t)S * DM * 2;
static_assert(WS_WTDN + (size_t)DM * DFF * 2 <= WS_H && WS_YA + T32 <= WS_END && WS_R1 + 3 * T32 == WS_Z, "ws map");
constexpr size_t WS_VN = WS_H;
constexpr size_t WS_W = WS_R1, WS_ATT = WS_R1 + T32, WS_O = WS_R1 + T32 + 16 * MiB, WS_YD = WS_R1;
constexpr size_t WS_T = 113 * MiB, WS_H2 = WS_H, WS_ACT = 81 * MiB, WS_F = 169 * MiB;
static_assert(WS_ACT + ACT_BYTES <= WS_F && WS_F + 2 * T32 <= WS_END && WS_O + T32 <= WS_Z && WS_T + 2 * T32 <= WS_Z, "overlay map");
constexpr int CW_BAR = 4096;

constexpr int RING_OFF = 0, RING_BYTES = 131072;
constexpr int LDS_BYTES = 163840;
constexpr int LDSCTL_OFF = LDS_BYTES - 4096, MISC_OFF = LDSCTL_OFF + 320;

typedef unsigned u32x4 __attribute__((ext_vector_type(4)));
typedef unsigned u32x2 __attribute__((ext_vector_type(2)));

__device__ __forceinline__ float bflo(unsigned u) { return __builtin_bit_cast(float, u << 16); }
__device__ __forceinline__ float bfhi(unsigned u) { return __builtin_bit_cast(float, u & 0xffff0000u); }
__device__ __forceinline__ float bf2f(bf16 b) { return __builtin_bit_cast(float, ((unsigned)b) << 16); }
__device__ __forceinline__ float wave_sum(float v) {
#define WS_DPP(ctrl) v += __builtin_bit_cast(float, __builtin_amdgcn_update_dpp(0, __builtin_bit_cast(int, v), (ctrl), 0xF, 0xF, true))
    WS_DPP(0xB1); WS_DPP(0x4E); WS_DPP(0x141); WS_DPP(0x140);
#undef WS_DPP
    const float s0 = __builtin_bit_cast(float, __builtin_amdgcn_readlane(__builtin_bit_cast(int, v), 0)), s1 = __builtin_bit_cast(float, __builtin_amdgcn_readlane(__builtin_bit_cast(int, v), 16));
    const float s2 = __builtin_bit_cast(float, __builtin_amdgcn_readlane(__builtin_bit_cast(int, v), 32)), s3 = __builtin_bit_cast(float, __builtin_amdgcn_readlane(__builtin_bit_cast(int, v), 48));
    return (s0 + s1) + (s2 + s3);
}
__device__ __forceinline__ float wave_max(float v) {
#pragma unroll
    for (int o = 1; o < 64; o <<= 1) v = fmaxf(v, __shfl_xor(v, o));
    return v;
}
__device__ __forceinline__ float rcp_(float x) { return __builtin_amdgcn_rcpf(x); }
__device__ __forceinline__ float rsq_(float x) { return __builtin_amdgcn_rsqf(x); }
__device__ __forceinline__ float sigmoidf_(float x) { return rcp_(1.f + __expf(-x)); }
__device__ __forceinline__ float siluf_(float x) { return x * rcp_(1.f + __expf(-x)); }
__device__ __forceinline__ float sigmoidf_e(float x) { return sigmoidf_(x); }
__device__ __forceinline__ float siluf_e(float x) { return siluf_(x); }

namespace pg8 {
struct EpiRope {
    static constexpr bool PERM = false, AFTER_DRAIN = false;
    bf16_t* base; const float* cosT; const float* sinT; float* kpart;
    __device__ __forceinline__ void operator()(const f32x4 (&acc)[2][2][4][2], const Unit& u, int wr, int wc, int fr, int fq) const {
        const int t = u.pn >> 2, pnl = u.pn & 3;
        bf16_t* ob = base + (size_t)t * ((size_t)S * DM);
        const bool rope = (t < 2) && (wc == 0);
        f32x4 cs[2][2];
#pragma unroll
        for (int bj = 0; bj < 2; ++bj)
#pragma unroll
            for (int n = 0; n < 2; ++n) cs[bj][n] = (f32x4){0.f, 0.f, 0.f, 0.f};
#pragma unroll
        for (int ai = 0; ai < 2; ++ai)
#pragma unroll
            for (int m = 0; m < 4; ++m) {
                const int row = u.pm * BM + ai * HALF + wr * 64 + m * 16 + fr;
                f32x4 cv = (f32x4){1.f, 1.f, 1.f, 1.f}, sv = (f32x4){0.f, 0.f, 0.f, 0.f};
                if (rope) { cv = *(const f32x4*)(cosT + (size_t)row * 16 + 4 * fq); sv = *(const f32x4*)(sinT + (size_t)row * 16 + 4 * fq); }
#pragma unroll
                for (int bj = 0; bj < 2; ++bj) {
                    f32x4 v0 = acc[ai][bj][m][0], v1 = acc[ai][bj][m][1];
                    if (rope) { const f32x4 n0 = v0 * cv - v1 * sv, n1 = v1 * cv + v0 * sv; v0 = n0; v1 = n1; }
                    cs[bj][0] = cs[bj][0] + v0; cs[bj][1] = cs[bj][1] + v1;
                    bf16_t* p = ob + (size_t)row * DM + pnl * 256 + bj * HALF + wc * 32 + 4 * fq;
                    u32x2 w0, w1; w0.x = cvt_pk_bf16(v0[0], v0[1]); w0.y = cvt_pk_bf16(v0[2], v0[3]); w1.x = cvt_pk_bf16(v1[0], v1[1]); w1.y = cvt_pk_bf16(v1[2], v1[3]);
                    *(u32x2*)p = w0; *(u32x2*)(p + 16) = w1;
                }
            }
        if (t == 1) {
#pragma unroll
            for (int bj = 0; bj < 2; ++bj)
#pragma unroll
                for (int n = 0; n < 2; ++n) { f32x4 s = cs[bj][n];
#pragma unroll
                    for (int o = 1; o < 16; o <<= 1) { s.x += __shfl_xor(s.x, o); s.y += __shfl_xor(s.y, o); s.z += __shfl_xor(s.z, o); s.w += __shfl_xor(s.w, o); }
                    if (fr == 0) *(f32x4*)(kpart + ((size_t)(u.pm * 2 + wr) * NH + 2 * pnl + bj) * HD + wc * 32 + 16 * n + 4 * fq) = s; } }
    }
};
template <int MODE> struct EpiGen {
    static constexpr bool PERM = true, AFTER_DRAIN = false;
    bf16_t* O; int ldc; int split_cols; size_t split_stride; const bf16_t* G2;
    __device__ __forceinline__ static void unpack8(const u32x4 w, float (&f)[8]) {
        f[0] = bflo(w.x); f[1] = bfhi(w.x); f[2] = bflo(w.y); f[3] = bfhi(w.y); f[4] = bflo(w.z); f[5] = bfhi(w.z); f[6] = bflo(w.w); f[7] = bfhi(w.w);
    }
    __device__ __forceinline__ void operator()(const f32x4 (&acc)[2][2][4][2], const Unit& u, int wr, int wc, int fr, int fq) const {
        const int row0 = u.pm * BM + wr * 64 + fr; int colt = u.pn * BM; bf16_t* base = O; const bf16_t* g2 = G2;
        if (split_cols) { const int t = colt / split_cols; base += (size_t)t * split_stride; colt -= t * split_cols; }
#pragma unroll
        for (int ai = 0; ai < 2; ++ai)
#pragma unroll
            for (int m = 0; m < 4; ++m) {
                const int row = row0 + ai * HALF + m * 16;
                if constexpr (MODE == 4) {
                    const f32x4 g0 = acc[ai][0][m][0], g1 = acc[ai][0][m][1], u0 = acc[ai][1][m][0], u1 = acc[ai][1][m][1];
                    float r[8];
#pragma unroll
                    for (int e = 0; e < 4; ++e) { r[e] = siluf_e(g0[e]) * u0[e]; r[4 + e] = siluf_e(g1[e]) * u1[e]; }
                    u32x4 w; w.x = cvt_pk_bf16(r[0], r[1]); w.y = cvt_pk_bf16(r[2], r[3]); w.z = cvt_pk_bf16(r[4], r[5]); w.w = cvt_pk_bf16(r[6], r[7]);
                    *(u32x4*)(base + (size_t)row * ldc + u.pn * HALF + wc * 32 + 8 * fq) = w;
                } else {
#pragma unroll
                    for (int bj = 0; bj < 2; ++bj) {
                        const f32x4 v0 = acc[ai][bj][m][0], v1 = acc[ai][bj][m][1];
                        float r[8] = {v0[0], v0[1], v0[2], v0[3], v1[0], v1[1], v1[2], v1[3]};
                        bf16_t* p = base + (size_t)row * ldc + colt + bj * HALF + wc * 32 + 8 * fq;
                        if constexpr (MODE == 1) {
#pragma unroll
                            for (int e = 0; e < 8; ++e) r[e] = sigmoidf_e(r[e]);
                        }
                        if constexpr (MODE == 2) { float g[8]; unpack8(*(const u32x4*)p, g);
#pragma unroll
                            for (int e = 0; e < 8; ++e) r[e] = r[e] * g[e]; }
                        if constexpr (MODE == 3) { float g[8], o[8]; unpack8(*(const u32x4*)(g2 + (size_t)row * ldc + colt + bj * HALF + wc * 32 + 8 * fq), g); unpack8(*(const u32x4*)p, o);
#pragma unroll
                            for (int e = 0; e < 8; ++e) r[e] = o[e] + r[e] * g[e]; }
                        u32x4 w; w.x = cvt_pk_bf16(r[0], r[1]); w.y = cvt_pk_bf16(r[2], r[3]); w.z = cvt_pk_bf16(r[4], r[5]); w.w = cvt_pk_bf16(r[6], r[7]);
                        *(u32x4*)p = w;
                    }
                }
            }
    }
};
struct EpiF32 {
    static constexpr bool PERM = false, AFTER_DRAIN = false;
    float* C; int ldc;
    __device__ __forceinline__ void operator()(const f32x4 (&acc)[2][2][4][2], const Unit& u, int wr, int wc, int fr, int fq) const {
        const int row0 = u.pm * BM + wr * 64 + fr, col0 = u.pn * BM + wc * 32 + 4 * fq;
#pragma unroll
        for (int ai = 0; ai < 2; ++ai)
#pragma unroll
            for (int m = 0; m < 4; ++m) { float* rowp = C + (size_t)(row0 + ai * HALF + m * 16) * ldc + col0;
#pragma unroll
                for (int bj = 0; bj < 2; ++bj)
#pragma unroll
                    for (int n = 0; n < 2; ++n) *(f32x4*)(rowp + bj * HALF + n * 16) = acc[ai][bj][m][n]; }
    }
};
}

struct Args { const float* in[16]; float* out; unsigned char* ws; int ph_lo, ph_hi, pass, pad; };
struct Frame {
    LAS unsigned char* lds;
    volatile LAS unsigned* MISC;
    int tid, lane, wave, G, gw, NGW;
    float* out; unsigned char* ws;
};
#define WSP(T, off) ((T*)(F.ws + (off)))
#define WSPF(T, off) ((T*)(Fp.ws + (off)))

struct WtItem { const float* src; bf16* dst; int ldw, K; };
__device__ __forceinline__ void tr_load(const WtItem& I, int lane, f32x4 (&v)[8]) {
#pragma unroll
    for (int i = 0; i < 8; ++i) v[i] = *(const f32x4*)(I.src + (size_t)((lane >> 3) + 8 * i) * I.ldw + 4 * (lane & 7));
}
__device__ __forceinline__ void tr_put(const f32x4 (&v)[8], LAS float* scr, int lane) {
#pragma unroll
    for (int i = 0; i < 8; ++i) { LAS float* s = scr + ((lane >> 3) + 8 * i) * 33 + 4 * (lane & 7); s[0] = v[i].x; s[1] = v[i].y; s[2] = v[i].z; s[3] = v[i].w; }
    LDS_WAIT(); asm volatile("" ::: "memory");
}
__device__ __forceinline__ void tr_out(const WtItem& I, const LAS float* scr, int lane) {
    const int c = lane & 7;
#pragma unroll
    for (int j = 0; j < 4; ++j) { const int n = (lane >> 3) + 8 * j; const LAS float* s = scr + (8 * c) * 33 + n;
        v4u o; o.x = pk2(s[0 * 33], s[1 * 33]); o.y = pk2(s[2 * 33], s[3 * 33]); o.z = pk2(s[4 * 33], s[5 * 33]); o.w = pk2(s[6 * 33], s[7 * 33]);
        *(GAS v4u*)(I.dst + (size_t)n * I.K + 8 * c) = o; }
    LDS_WAIT(); asm volatile("" ::: "memory");
}
__device__ __forceinline__ void rms_row_bf16(const float* xrow, const float* w, bf16* orow, int lane, f32x4 (&hv)[4]) {
    const f32x4* xr = (const f32x4*)xrow + lane; const f32x4* wr = (const f32x4*)w + lane;
    float ss = 0.f;
#pragma unroll
    for (int j = 0; j < 4; ++j) { hv[j] = xr[64 * j]; ss += (hv[j].x * hv[j].x + hv[j].y * hv[j].y) + (hv[j].z * hv[j].z + hv[j].w * hv[j].w); }
    const float rs = rsq_(wave_sum(ss) * (1.f / DM) + EPS);
    unsigned long long* o8 = (unsigned long long*)orow + lane;
#pragma unroll
    for (int j = 0; j < 4; ++j) { const f32x4 wv = wr[64 * j]; hv[j] = hv[j] * rs * wv;
        o8[64 * j] = (unsigned long long)pk2(hv[j].x, hv[j].y) | ((unsigned long long)pk2(hv[j].z, hv[j].w) << 32); }
}
__device__ __forceinline__ WtItem wt_decode(const Args& A, unsigned char* ws, int it) {
    constexpr int I_A = 16 * 96, I_B = 16 * 128, I_G = 16 * 64, I_O = 16 * 32, I_GU = 16 * 88;
    const float* w_in = A.in[2];
    int r = it; const float* W; int ldw, scol, nbn, K = DM, dmode = 0; size_t dst;
    if (r < I_A) { W = w_in; ldw = INTOT; scol = 0; nbn = 96; dst = WS_WTA; }
    else if ((r -= I_A) < I_B) { W = w_in; ldw = INTOT; scol = 3072; nbn = 128; dst = WS_WTB; }
    else if ((r -= I_B) < I_G) { W = w_in; ldw = INTOT; scol = 7184; nbn = 64; dst = WS_WTG; }
    else if ((r -= I_G) < I_O) { W = A.in[7]; ldw = DM; scol = 0; nbn = 32; dst = WS_WTOA; }
    else if ((r -= I_O) < I_O) { W = A.in[8]; ldw = DM; scol = 0; nbn = 32; dst = WS_WTOD; }
    else if ((r -= I_O) < I_O) { W = A.in[9]; ldw = DM; scol = 0; nbn = 32; dst = WS_WTOUT; }
    else if ((r -= I_O) < I_GU) { W = A.in[12]; ldw = DFF; scol = 0; nbn = 88; dst = WS_WTGU; dmode = 1; }
    else if ((r -= I_GU) < I_GU) { W = A.in[13]; ldw = DFF; scol = 0; nbn = 88; dst = WS_WTGU; dmode = 2; }
    else { r -= I_GU; W = A.in[14]; ldw = DM; scol = 0; nbn = 32; dst = WS_WTDN; K = DFF; }
    const int kb = r / nbn, nb = r % nbn, n0 = 32 * nb;
    const int drow0 = (dmode == 0) ? n0 : 256 * (n0 / 128) + (n0 % 128) + (dmode == 2 ? 128 : 0);
    WtItem I; I.src = W + (size_t)(64 * kb) * ldw + scol + n0; I.dst = (bf16*)(ws + dst) + (size_t)drow0 * K + 64 * kb; I.ldw = ldw; I.K = K; return I;
}
__device__ __forceinline__ void p_wtrans(Frame& F, const Args& A, int it0, int it1, int gw0, int ngw) {
    LAS float* scr = (LAS float*)(F.lds + RING_OFF + F.wave * 16384);
    int it = it0 + gw0; if (it >= it1) return;
    WtItem cur = wt_decode(A, F.ws, it); f32x4 v[8]; tr_load(cur, F.lane, v);
    for (;;) {
        const int itn = it + ngw; const bool more = itn < it1;
        tr_put(v, scr, F.lane);
        WtItem nxt = cur; if (more) { nxt = wt_decode(A, F.ws, itn); tr_load(nxt, F.lane, v); }
        tr_out(cur, scr, F.lane);
        if (!more) break;
        cur = nxt; it = itn;
    }
}
constexpr int WT_A_ITEMS = 2560;
constexpr int WT_ITEMS_EARLY = 16 * 96 + 16 * 128, WT_ITEMS_ALL = 16 * 96 + 16 * 128 + 16 * 64 + 3 * 16 * 32 + 2 * 16 * 88 + 44 * 32;
__device__ __forceinline__ void p_prologue(Frame& F, const Args& A) {
    const float* w_in = A.in[2];
#if DN2_LATE_WT
    p_wtrans(F, A, 0, WT_ITEMS_EARLY, F.gw, F.NGW);
#else
    p_wtrans(F, A, 0, WT_ITEMS_ALL, F.gw, F.NGW);
#endif
    { float* cosT = WSP(float, WS_COS); float* sinT = WSP(float, WS_SIN);
      for (int i = F.gw * 64 + F.lane; i < S * 16; i += F.NGW * 64) { const int pos = i >> 4, k = i & 15;
          const float inv = (float)pow(500000.0, -(double)k / 16.0); const float ang = (float)pos * inv;
          cosT[i] = cosf(ang); sinT[i] = sinf(ang); } }
    { const float* x = A.in[0]; bf16* H = WSP(bf16, WS_H); float* BA = WSP(float, WS_BA);
      constexpr int WP = 2064;
      LAS unsigned char* wimg = F.lds; LAS unsigned char* hl = F.lds + 36864 + F.wave * (4 * WP + 192);
      __syncthreads();
      { const int k8 = F.tid >> 2, c4 = 4 * (F.tid & 3); f32x4 wv[8];
#pragma unroll
        for (int i = 0; i < 8; ++i) wv[i] = *(const f32x4*)(w_in + (size_t)(8 * k8 + i) * INTOT + 7168 + c4);
#pragma unroll
        for (int c = 0; c < 4; ++c) { u32x4 o; o.x = pk2(wv[0][c], wv[1][c]); o.y = pk2(wv[2][c], wv[3][c]); o.z = pk2(wv[4][c], wv[5][c]); o.w = pk2(wv[6][c], wv[7][c]);
            *(LAS u32x4*)(wimg + (c4 + c) * WP + 16 * k8) = o; } }
      __syncthreads();
      const int r16 = F.lane & 15, g = F.lane >> 4;
      const LAS unsigned char* wrd = wimg + r16 * WP + 16 * g; const LAS unsigned char* hrd = hl + (r16 & 3) * WP + 16 * g;
      f32x4 nw[4];
#pragma unroll
      for (int j = 0; j < 4; ++j) nw[j] = ((const f32x4*)A.in[1])[F.lane + 64 * j];
      for (int m0 = F.gw; m0 < S; m0 += 4 * F.NGW) {
          f32x4 xv[4][4];
#pragma unroll
          for (int k = 0; k < 4; ++k) { const int m = m0 + k * F.NGW; const f32x4* xr = (const f32x4*)(x + (size_t)(m < S ? m : m0) * DM) + F.lane;
#pragma unroll
              for (int j = 0; j < 4; ++j) xv[k][j] = xr[64 * j]; }
#pragma unroll
          for (int k = 0; k < 4; ++k) { const int m = m0 + k * F.NGW; float ss = 0.f;
#pragma unroll
              for (int j = 0; j < 4; ++j) ss += (xv[k][j].x * xv[k][j].x + xv[k][j].y * xv[k][j].y) + (xv[k][j].z * xv[k][j].z + xv[k][j].w * xv[k][j].w);
              const float rs = rsq_(wave_sum(ss) * (1.f / DM) + EPS);
              unsigned long long* o8 = (unsigned long long*)(H + (size_t)m * DM) + F.lane;
#pragma unroll
              for (int j = 0; j < 4; ++j) { const f32x4 hv = xv[k][j] * rs * nw[j]; u32x2 p; p.x = pk2(hv.x, hv.y); p.y = pk2(hv.z, hv.w);
                  if (m < S) o8[64 * j] = (unsigned long long)p.x | ((unsigned long long)p.y << 32);
                  *(LAS u32x2*)(hl + k * WP + 8 * (F.lane + 64 * j)) = p; } }
          asm volatile("s_waitcnt lgkmcnt(0)" ::: "memory");
          f32x4 acc = {0.f, 0.f, 0.f, 0.f};
#pragma unroll 8
          for (int s = 0; s < 32; ++s) { const bf16x8 wf = *(const LAS bf16x8*)(wrd + 64 * s), hf = *(const LAS bf16x8*)(hrd + 64 * s);
              acc = __builtin_amdgcn_mfma_f32_16x16x32_bf16(wf, hf, acc, 0, 0, 0); }
          { const int m = m0 + r16 * F.NGW; if (r16 < 4 && m < S) *(f32x4*)(BA + (size_t)m * 16 + 4 * g) = acc; }
          asm volatile("s_waitcnt lgkmcnt(0)" ::: "memory");
      }
      __syncthreads(); }
}
__device__ __forceinline__ void p_hrecompute_sub(Frame& F, const Args& A, bf16* H, int gw0, int ngw) {
    const float* x = A.in[0];
    for (int m = gw0; m < S; m += ngw) { f32x4 hv[4]; rms_row_bf16(x + (size_t)m * DM, A.in[1], H + (size_t)m * DM, F.lane, hv); }
}
__device__ __forceinline__ void p_hrecompute(Frame& F, const Args& A) {
    const float* x = A.in[0]; bf16* H = WSP(bf16, WS_H);
    for (int m = F.gw; m < S; m += F.NGW) { f32x4 hv[4]; rms_row_bf16(x + (size_t)m * DM, A.in[1], H + (size_t)m * DM, F.lane, hv); }
}

__device__ __forceinline__ void p_kmean(Frame& F, const Args& A) {
    const bf16* KA = WSP(bf16, WS_R1 + T32); float* KM = WSP(float, WS_KMEAN);
    for (int it = F.gw; it < NBLK * NH; it += F.NGW) { const int blk = it >> 3, h = it & 7;
        float s0 = 0.f, s1 = 0.f; const bf16* p = KA + (size_t)(blk * MBLK) * DM + h * HD + 2 * F.lane;
#pragma unroll 32
        for (int r = 0; r < MBLK; ++r) { const unsigned v = *(const unsigned*)(p + (size_t)r * DM); s0 += bflo(v); s1 += bfhi(v); }
        KM[(size_t)it * HD + 2 * F.lane] = s0 * (1.f / MBLK); KM[(size_t)it * HD + 2 * F.lane + 1] = s1 * (1.f / MBLK); }
}
__device__ __forceinline__ void p_topk(Frame& F, const Args& A) {
    const bf16* QA = WSP(bf16, WS_R1); const float* KM = WSP(float, WS_KMEAN); int* TOPI = WSP(int, WS_TOPI);
    for (int it = F.gw; it < S * NH; it += F.NGW) { const int q = it >> 3, h = it & 7, qblk = q >> 8;
        float g = -INFINITY;
        if (F.lane < qblk) { const bf16* qp = QA + (size_t)q * DM + h * HD; const float* kp = KM + ((size_t)F.lane * NH + h) * HD; float a = 0.f;
#pragma unroll
            for (int c = 0; c < 16; ++c) { const u32x4 qv = *(const u32x4*)(qp + 8 * c); const f32x4 k0 = *(const f32x4*)(kp + 8 * c), k1 = *(const f32x4*)(kp + 8 * c + 4);
                a += bflo(qv.x) * k0.x + bfhi(qv.x) * k0.y + bflo(qv.y) * k0.z + bfhi(qv.y) * k0.w + bflo(qv.z) * k1.x + bfhi(qv.z) * k1.y + bflo(qv.w) * k1.z + bfhi(qv.w) * k1.w; }
            g = a; }
        int res = -1;
#pragma unroll
        for (int r = 0; r < 3; ++r) { float v = g; int i = F.lane;
#pragma unroll
            for (int o = 1; o < 64; o <<= 1) { const float ov = __shfl_xor(v, o); const int oi = __shfl_xor(i, o); if (ov > v || (ov == v && oi < i)) { v = ov; i = oi; } }
            if (F.lane == r) res = (r < qblk) ? i : -1;
            if (F.lane == i) g = -INFINITY; }
        if (F.lane < 3) TOPI[(size_t)it * 3 + F.lane] = res; }
}
__device__ __forceinline__ void p_attn_naive(Frame& F, const Args& A) {
    const bf16* QA = WSP(bf16, WS_R1); const bf16* KA = WSP(bf16, WS_R1 + T32); const bf16* VA = WSP(bf16, WS_R1 + 2 * T32); const int* TOPI = WSP(int, WS_TOPI);
#ifdef DBG_ATTN
    bf16* YA = (bf16*)F.out;
#else
    bf16* YA = WSP(bf16, WS_YA);
#endif
    for (int it = F.gw; it < S * NH; it += F.NGW) { const int q = it >> 3, h = it & 7, qblk = q >> 8;
        const bf16* qp = QA + (size_t)q * DM + h * HD;
        float m = -INFINITY, l = 0.f, o0 = 0.f, o1 = 0.f;
        for (int slot = 0; slot < 4; ++slot) {
            int kb = qblk; if (slot < 3) { kb = TOPI[(size_t)it * 3 + slot]; if (kb < 0) continue; }
            const bf16* kp = KA + (size_t)(kb * MBLK) * DM + h * HD; const bf16* vp = VA + (size_t)(kb * MBLK) * DM + h * HD;
            float s[4] = {0.f, 0.f, 0.f, 0.f};
#pragma unroll 4
            for (int c = 0; c < 16; ++c) { const u32x4 qv = *(const u32x4*)(qp + 8 * c);
                const float q0 = bflo(qv.x), q1 = bfhi(qv.x), q2 = bflo(qv.y), q3 = bfhi(qv.y), q4 = bflo(qv.z), q5 = bfhi(qv.z), q6 = bflo(qv.w), q7 = bfhi(qv.w);
#pragma unroll
                for (int jj = 0; jj < 4; ++jj) { const u32x4 kv = *(const u32x4*)(kp + (size_t)(F.lane + 64 * jj) * DM + 8 * c);
                    s[jj] += q0 * bflo(kv.x) + q1 * bfhi(kv.x) + q2 * bflo(kv.y) + q3 * bfhi(kv.y) + q4 * bflo(kv.z) + q5 * bfhi(kv.z) + q6 * bflo(kv.w) + q7 * bfhi(kv.w); } }
            float mx = -INFINITY;
#pragma unroll
            for (int jj = 0; jj < 4; ++jj) { s[jj] *= 0.08838834764831845f; if (slot == 3 && (kb * MBLK + F.lane + 64 * jj) > q) s[jj] = -INFINITY; mx = fmaxf(mx, s[jj]); }
            mx = wave_max(mx);
            const float mn = fmaxf(m, mx), sc = __expf(m - mn);
            float p[4], ps = 0.f;
#pragma unroll
            for (int jj = 0; jj < 4; ++jj) { p[jj] = __expf(s[jj] - mn); ps += p[jj]; }
            l = l * sc + wave_sum(ps); o0 *= sc; o1 *= sc; m = mn;
#pragma unroll
            for (int jj = 0; jj < 4; ++jj)
                for (int ln = 0; ln < 64; ++ln) { const float pj = __shfl(p[jj], ln); const unsigned vv = *(const unsigned*)(vp + (size_t)(ln + 64 * jj) * DM + 2 * F.lane); o0 += pj * bflo(vv); o1 += pj * bfhi(vv); }
        }
        const float il = 1.f / l;
        *(unsigned*)(YA + (size_t)q * DM + h * HD + 2 * F.lane) = pk2(o0 * il, o1 * il); }
}


typedef float f32x16 __attribute__((ext_vector_type(16)));
typedef short s16x4 __attribute__((ext_vector_type(4)));
typedef float f32x2_t __attribute__((ext_vector_type(2)));
typedef __bf16 bf16x2_t __attribute__((ext_vector_type(2)));
constexpr size_t WS_BUCKET = 241 * MiB, WS_ML = 249 * MiB, WS_OP2 = WS_Z;
constexpr int BUCKET_PER_HEAD = 256 * 2016;
constexpr int CW_CNT = 16384;
static_assert(WS_BUCKET + (size_t)NH * BUCKET_PER_HEAD * 2 <= WS_ML && WS_ML + (size_t)3 * S * NH * 8 <= WS_END, "bucket map");
constexpr float SM_C = 0.08838834764831845f * 1.4426950408889634f;

__device__ __forceinline__ int bucket_off(int kb) { return 256 * (63 * kb - (kb * (kb - 1)) / 2); }
__device__ __forceinline__ unsigned attn_off(unsigned row, unsigned ch) { return 256u * row + 16u * (ch ^ (((row & 3u) << 2) | ((row >> 2) & 3u))); }
__device__ __forceinline__ unsigned cvtpk(float lo, float hi) { f32x2_t v = {lo, hi}; bf16x2_t b = __builtin_convertvector(v, bf16x2_t); return __builtin_bit_cast(unsigned, b); }
__device__ __forceinline__ s16x4 vtr16(const LAS unsigned char* p) { typedef short v4i16_t __attribute__((ext_vector_type(4))); return __builtin_bit_cast(s16x4, __builtin_amdgcn_ds_read_tr16_b64_v4i16((LAS v4i16_t*)p)); }

__device__ __forceinline__ void unpack8f(const bf16x8 v, float (&f)[8]) { const u32x4 w = __builtin_bit_cast(u32x4, v);
    f[0] = bflo(w.x); f[1] = bfhi(w.x); f[2] = bflo(w.y); f[3] = bfhi(w.y); f[4] = bflo(w.z); f[5] = bfhi(w.z); f[6] = bflo(w.w); f[7] = bfhi(w.w); }
__device__ __forceinline__ bf16x8 pack8f(const float (&f)[8]) { u32x4 w; w.x = cvtpk(f[0], f[1]); w.y = cvtpk(f[2], f[3]); w.z = cvtpk(f[4], f[5]); w.w = cvtpk(f[6], f[7]); return __builtin_bit_cast(bf16x8, w); }

__device__ __forceinline__ void attn_stage(const bf16* src, LAS unsigned char* img, int tid) {
#pragma unroll
    for (int i = 0; i < 8; ++i) { const int n = tid + 512 * i, row = n >> 4, ch = n & 15;
        const u32x4 v = *(const u32x4*)(src + (size_t)row * DM + 8 * ch); *(LAS u32x4*)(img + attn_off(row, ch)) = v; }
}
struct AttnState { float m, l; f32x16 o[4]; };
__device__ __forceinline__ float half_max(float v) { const auto t = __builtin_amdgcn_permlane32_swap(__builtin_bit_cast(unsigned, v), __builtin_bit_cast(unsigned, v), false, false); return fmaxf(__builtin_bit_cast(float, t[0]), __builtin_bit_cast(float, t[1])); }
__device__ __forceinline__ float half_sum(float v) { const auto t = __builtin_amdgcn_permlane32_swap(__builtin_bit_cast(unsigned, v), __builtin_bit_cast(unsigned, v), false, false); return __builtin_bit_cast(float, t[0]) + __builtin_bit_cast(float, t[1]); }
template <int NT> __device__ __forceinline__ void attn_wave(const bf16x8 (&qf)[8], const LAS unsigned char* Kimg, const LAS unsigned char* Vimg, int nt, int diag, int lane, AttnState& st) {
    const int r = lane & 31, hh = lane >> 5, blk = (lane >> 4) & 1, q4 = (lane & 15) >> 2, p4 = lane & 3;
    const LAS unsigned char* kad[8];
#pragma unroll
    for (int ks = 0; ks < 8; ++ks) kad[ks] = Kimg + attn_off(r, 2 * ks + hh);
    const LAS unsigned char* vad[4][4];
#pragma unroll
    for (int i = 0; i < 4; ++i) { const unsigned rl = 16u * (i >> 1) + 8u * (i & 1) + 4u * hh + q4, x = ((rl & 3u) << 2) | ((rl >> 2) & 3u), cb = 2u * blk + (p4 >> 1);
#pragma unroll
        for (int c = 0; c < 4; ++c) vad[i][c] = Vimg + 256u * rl + 16u * (cb ^ (x & 3u)) + 8u * (p4 & 1) + 64u * ((unsigned)c ^ (x >> 2)); }
    st.m = -INFINITY; st.l = 0.f;
#pragma unroll
    for (int c = 0; c < 4; ++c)
#pragma unroll
        for (int i = 0; i < 16; ++i) st.o[c][i] = 0.f;
    auto tile = [&](const int kt) __attribute__((always_inline)) {
        f32x16 s;
#pragma unroll
        for (int i = 0; i < 16; ++i) s[i] = 0.f;
#pragma unroll
        for (int ks = 0; ks < 8; ++ks) { const bf16x8 kf = *(const LAS bf16x8*)(kad[ks] + kt * 8192); s = __builtin_amdgcn_mfma_f32_32x32x16_bf16(kf, qf[ks], s, 0, 0, 0); }
        float tmax = -INFINITY;
#pragma unroll
        for (int i = 0; i < 16; ++i) { if (kt == diag && ((i & 3) + 8 * (i >> 2) + 4 * hh) > r) s[i] = -INFINITY; tmax = fmaxf(tmax, s[i]); }
        tmax = fmaxf(tmax, __shfl_xor(tmax, 32)) * SM_C;
        if (!(tmax - st.m <= 8.f)) { const float mn = fmaxf(st.m, tmax), alpha = __builtin_amdgcn_exp2f(st.m - mn); st.l *= alpha; st.m = mn;
#pragma unroll
            for (int c = 0; c < 4; ++c)
#pragma unroll
                for (int i = 0; i < 16; ++i) st.o[c][i] *= alpha; }
        float rs = 0.f; const float nm = -st.m;
#pragma unroll
        for (int i = 0; i < 16; ++i) { s[i] = __builtin_amdgcn_exp2f(__builtin_fmaf(s[i], SM_C, nm)); rs += s[i]; }
        st.l += rs + __shfl_xor(rs, 32);
#pragma unroll
        for (int sp = 0; sp < 2; ++sp) {
            u32x4 pw; pw.x = cvtpk(s[8 * sp], s[8 * sp + 1]); pw.y = cvtpk(s[8 * sp + 2], s[8 * sp + 3]); pw.z = cvtpk(s[8 * sp + 4], s[8 * sp + 5]); pw.w = cvtpk(s[8 * sp + 6], s[8 * sp + 7]);
            const bf16x8 pf = __builtin_bit_cast(bf16x8, pw);
#pragma unroll
            for (int c = 0; c < 4; ++c) {
                const s16x4 lo = vtr16(vad[2 * sp][c] + kt * 8192);
                const s16x4 hi = vtr16(vad[2 * sp + 1][c] + kt * 8192);
                const bf16x8 vf = __builtin_shufflevector(lo, hi, 0, 1, 2, 3, 4, 5, 6, 7);
                st.o[c] = __builtin_amdgcn_mfma_f32_32x32x16_bf16(vf, pf, st.o[c], 0, 0, 0);
            }
        }
    };
    if constexpr (NT > 0) {
#pragma unroll
        for (int kt = 0; kt < NT; ++kt) tile(kt);
    } else { for (int kt = 0; kt < nt; ++kt) tile(kt); }
}
__device__ __forceinline__ void p_topk_bucket(Frame& F, const Args& A) {
    const bf16* QA = WSP(bf16, WS_R1); const float* KM = WSP(float, WS_KMEAN); int* TOPI = WSP(int, WS_TOPI);
    unsigned* CNT = WSP(unsigned, WS_CTL) + CW_CNT; unsigned short* BUCKET = WSP(unsigned short, WS_BUCKET); f32x2_t* ML = WSP(f32x2_t, WS_ML);
    for (int it = F.gw; it < S * NH; it += F.NGW) { const int q = it >> 3, h = it & 7, qblk = q >> 8;
        float g = -INFINITY;
        if (F.lane < qblk) { const bf16* qp = QA + (size_t)q * DM + h * HD; const float* kp = KM + ((size_t)F.lane * NH + h) * HD; float a = 0.f;
#pragma unroll
            for (int c = 0; c < 16; ++c) { const u32x4 qv = *(const u32x4*)(qp + 8 * c); const f32x4 k0 = *(const f32x4*)(kp + 8 * c), k1 = *(const f32x4*)(kp + 8 * c + 4);
                a += bflo(qv.x) * k0.x + bfhi(qv.x) * k0.y + bflo(qv.y) * k0.z + bfhi(qv.y) * k0.w + bflo(qv.z) * k1.x + bfhi(qv.z) * k1.y + bflo(qv.w) * k1.z + bfhi(qv.w) * k1.w; }
            g = a; }
        int res = -1;
#pragma unroll
        for (int r = 0; r < 3; ++r) { float v = g; int i = F.lane;
#pragma unroll
            for (int o = 1; o < 64; o <<= 1) { const float ov = __shfl_xor(v, o); const int oi = __shfl_xor(i, o); if (ov > v || (ov == v && oi < i)) { v = ov; i = oi; } }
            if (F.lane == r) res = (r < qblk) ? i : -1;
            if (F.lane == i) g = -INFINITY; }
        if (F.lane < 3) { TOPI[(size_t)it * 3 + F.lane] = res;
            if (res >= 0) { const unsigned pos = __hip_atomic_fetch_add(CNT + h * NBLK + res, 1u, __ATOMIC_RELAXED, __HIP_MEMORY_SCOPE_AGENT);
                BUCKET[(size_t)h * BUCKET_PER_HEAD + bucket_off(res) + pos] = (unsigned short)((q << 2) | F.lane); }
            else ML[((size_t)F.lane * S + q) * NH + h] = (f32x2_t){-INFINITY, 0.f}; } }
}

__device__ __forceinline__ void p_topk2(Frame& F, const Args& A) {
    const bf16* QA = WSP(bf16, WS_R1); const float* KP = WSP(const float, WS_KMEAN);
    unsigned* CNT = WSP(unsigned, WS_CTL) + CW_CNT; unsigned short* BUCKET = WSP(unsigned short, WS_BUCKET); f32x2_t* ML = WSP(f32x2_t, WS_ML);
    LAS unsigned char* Kimg = F.lds;
    LAS int* lcnt = (LAS int*)(F.lds + 16384); LAS int* lbase = lcnt + 64;
    const int lane = F.lane, r = lane & 31, hh = lane >> 5;
    for (int u = blockIdx.x; u < NBLK * NH; u += F.G) { const int qblk = u >> 3, h = u & 7, q = qblk * MBLK + 32 * F.wave + r;
        __syncthreads();
        { const int n = F.tid >> 3, c = F.tid & 7; const float* p0 = KP + ((size_t)(n * 2) * NH + h) * HD + 16 * c; const float* p1 = p0 + (size_t)NH * HD;
#pragma unroll
          for (int half = 0; half < 2; ++half) { const f32x4 a0 = *(const f32x4*)(p0 + 8 * half), a1 = *(const f32x4*)(p0 + 8 * half + 4), c0 = *(const f32x4*)(p1 + 8 * half), c1 = *(const f32x4*)(p1 + 8 * half + 4);
              float f[8] = {(a0.x + c0.x) * (1.f / MBLK), (a0.y + c0.y) * (1.f / MBLK), (a0.z + c0.z) * (1.f / MBLK), (a0.w + c0.w) * (1.f / MBLK), (a1.x + c1.x) * (1.f / MBLK), (a1.y + c1.y) * (1.f / MBLK), (a1.z + c1.z) * (1.f / MBLK), (a1.w + c1.w) * (1.f / MBLK)};
              *(LAS bf16x8*)(Kimg + attn_off(n, 2 * c + half)) = pack8f(f); } }
        if (F.tid < 64) lcnt[F.tid] = 0;
        __syncthreads();
        float bv[3] = {-INFINITY, -INFINITY, -INFINITY}; int bi[3] = {0, 0, 0};
        if (qblk > 0) {
            bf16x8 qf[8];
#pragma unroll
            for (int ks = 0; ks < 8; ++ks) qf[ks] = *(const bf16x8*)(QA + (size_t)q * DM + h * HD + 16 * ks + 8 * hh);
            const int nt = (qblk > 32) ? 2 : 1;
            for (int tn = 0; tn < nt; ++tn) {
                f32x16 acc;
#pragma unroll
                for (int i = 0; i < 16; ++i) acc[i] = 0.f;
#pragma unroll
                for (int ks = 0; ks < 8; ++ks) { const bf16x8 kf = *(const LAS bf16x8*)(Kimg + attn_off(32 * tn + r, 2 * ks + hh)); acc = __builtin_amdgcn_mfma_f32_32x32x16_bf16(kf, qf[ks], acc, 0, 0, 0); }
#pragma unroll
                for (int i = 0; i < 16; ++i) { const int n = 32 * tn + (i & 3) + 8 * (i >> 2) + 4 * hh; const float v = (n < qblk) ? acc[i] : -INFINITY;
                    const bool g0 = v > bv[0], g1 = v > bv[1], g2 = v > bv[2];
                    bv[2] = g1 ? bv[1] : (g2 ? v : bv[2]); bi[2] = g1 ? bi[1] : (g2 ? n : bi[2]);
                    bv[1] = g0 ? bv[0] : (g1 ? v : bv[1]); bi[1] = g0 ? bi[0] : (g1 ? n : bi[1]);
                    bv[0] = g0 ? v : bv[0]; bi[0] = g0 ? n : bi[0]; }
            }
            float ov[3]; int oi[3];
#pragma unroll
            for (int k = 0; k < 3; ++k) { ov[k] = __shfl_xor(bv[k], 32); oi[k] = __shfl_xor(bi[k], 32); }
#pragma unroll
            for (int k = 0; k < 3; ++k) { const float v = ov[k]; const int n = oi[k];
#define TK_GT(v_, n_, w_, m_) ((v_) > (w_) || ((v_) == (w_) && (n_) < (m_)))
                const bool ok = v > -INFINITY, g0 = ok && TK_GT(v, n, bv[0], bi[0]), g1 = ok && TK_GT(v, n, bv[1], bi[1]), g2 = ok && TK_GT(v, n, bv[2], bi[2]);
                bv[2] = g1 ? bv[1] : (g2 ? v : bv[2]); bi[2] = g1 ? bi[1] : (g2 ? n : bi[2]);
                bv[1] = g0 ? bv[0] : (g1 ? v : bv[1]); bi[1] = g0 ? bi[0] : (g1 ? n : bi[1]);
                bv[0] = g0 ? v : bv[0]; bi[0] = g0 ? n : bi[0]; }
        }
        int rank[3] = {0, 0, 0}; bool valid[3];
#pragma unroll
        for (int k = 0; k < 3; ++k) { valid[k] = (hh == 0) && (k < qblk) && (bv[k] > -INFINITY);
            if (valid[k]) rank[k] = __hip_atomic_fetch_add(lcnt + bi[k], 1, __ATOMIC_RELAXED, __HIP_MEMORY_SCOPE_WORKGROUP);
            else if (hh == 0) ML[((size_t)k * S + q) * NH + h] = (f32x2_t){-INFINITY, 0.f}; }
        __syncthreads();
        if (F.tid < 64) { const int c = lcnt[F.tid]; if (c > 0) lbase[F.tid] = (int)__hip_atomic_fetch_add(CNT + h * NBLK + F.tid, (unsigned)c, __ATOMIC_RELAXED, __HIP_MEMORY_SCOPE_AGENT); }
        __syncthreads();
#pragma unroll
        for (int k = 0; k < 3; ++k) if (valid[k]) BUCKET[(size_t)h * BUCKET_PER_HEAD + bucket_off(bi[k]) + lbase[bi[k]] + rank[k]] = (unsigned short)((q << 2) | k);
    }
    __syncthreads();
}
__device__ __forceinline__ bf16* op_slot(Frame& F, int r) { return r < 2 ? (bf16*)F.out + (size_t)r * S * DM : WSP(bf16, WS_OP2); }
__device__ __forceinline__ void p_attn_sel(Frame& F, const Args& A) {
    const bf16* QA = WSP(bf16, WS_R1); const bf16* KA = WSP(bf16, WS_R1 + T32); const bf16* VA = WSP(bf16, WS_R1 + 2 * T32);
    const unsigned* CNT = WSP(const unsigned, WS_CTL) + CW_CNT; const unsigned short* BUCKET = WSP(const unsigned short, WS_BUCKET); f32x2_t* ML = WSP(f32x2_t, WS_ML);
    LAS unsigned char* Kimg = F.lds; LAS unsigned char* Vimg = F.lds + 65536; LAS int* pre = (LAS int*)(F.lds + LDSCTL_OFF + 1024);
    constexpr int AS_UW = 4, AS_SW = 3;
    LAS int* prew = (LAS int*)(F.lds + 131072);
    __syncthreads();
    { const int nb = (int)((CNT[F.tid] + 255u) >> 8), wb = nb ? AS_SW + AS_UW * nb : 0;
      int inc = nb, incw = wb;
#pragma unroll
      for (int o = 1; o < 64; o <<= 1) { const int v = __shfl_up(inc, o), vw = __shfl_up(incw, o); if (F.lane >= o) { inc += v; incw += vw; } }
      LAS int* wtot = pre + 520;
      if (F.lane == 63) { wtot[F.wave] = inc; wtot[8 + F.wave] = incw; }
      __syncthreads();
      int base = 0, basew = 0;
#pragma unroll
      for (int w = 0; w < NWAVES; ++w) { base += (w < F.wave) ? wtot[w] : 0; basew += (w < F.wave) ? wtot[8 + w] : 0; }
      pre[F.tid] = base + inc - nb; prew[F.tid] = basew + incw - wb;
      if (F.tid == NWAVES * 64 - 1) { pre[NH * NBLK] = base + inc; prew[NH * NBLK] = basew + incw; } }
    __syncthreads();
    const int totalw = prew[NH * NBLK];
    auto first_unit = [&](const int x) __attribute__((always_inline)) -> int {
        int lo = 0, hi = NH * NBLK - 1; while (lo < hi) { const int mid = (lo + hi + 1) >> 1; if (prew[mid] <= x) lo = mid; else hi = mid - 1; }
        const int nbl = pre[lo + 1] - pre[lo], d = x - prew[lo];
        int j = 0; if (d > 0) { j = (d - AS_SW + AS_UW - 1) / AS_UW; j = j < 1 ? 1 : j; j = j > nbl ? nbl : j; }
        return pre[lo] + j; };
#define AS_DECODE(u_, h_, kb_, b_, cnt_) do { int lo_ = 0, hi_ = NH * NBLK - 1; while (lo_ < hi_) { const int mid_ = (lo_ + hi_ + 1) >> 1; if (pre[mid_] <= (u_)) lo_ = mid_; else hi_ = mid_ - 1; } \
        h_ = lo_ >> 6; kb_ = lo_ & 63; b_ = (u_) - pre[lo_]; cnt_ = (int)CNT[lo_]; } while (0)
    const int hh = F.lane >> 5;
    bf16x8 qf[8];
    const int u1 = first_unit((int)(((long long)(blockIdx.x + 1) * totalw) / F.G)); int hs = -1, kbs = -1;
    int u = first_unit((int)(((long long)blockIdx.x * totalw) / F.G)), h = 0, kb = 0, b = 0, cnt = 0, q = 0, r = 0; bool valid = false;
    if (u < u1) { AS_DECODE(u, h, kb, b, cnt);
        const int e = 256 * b + 32 * F.wave + (F.lane & 31); valid = e < cnt;
        const unsigned ent = BUCKET[(size_t)h * BUCKET_PER_HEAD + bucket_off(kb) + (valid ? e : 256 * b)]; q = (int)(ent >> 2); r = (int)(ent & 3u);
#pragma unroll
        for (int ks = 0; ks < 8; ++ks) qf[ks] = *(const bf16x8*)(QA + (size_t)q * DM + h * HD + 16 * ks + 8 * hh); }
    while (u < u1) {
        if (h != hs || kb != kbs) {
            __syncthreads();
            attn_stage(KA + (size_t)(kb * MBLK) * DM + h * HD, Kimg, F.tid); attn_stage(VA + (size_t)(kb * MBLK) * DM + h * HD, Vimg, F.tid);
            __syncthreads(); hs = h; kbs = kb; }
        const int un = u + 1; int hn = 0, kbn = 0, bn = 0, cntn = 0; unsigned entn = 0u; bool validn = false;
        if (un < u1) { AS_DECODE(un, hn, kbn, bn, cntn);
            const int e = 256 * bn + 32 * F.wave + (F.lane & 31); validn = e < cntn;
            entn = BUCKET[(size_t)hn * BUCKET_PER_HEAD + bucket_off(kbn) + (validn ? e : 256 * bn)]; }
        AttnState st; if (__ballot(valid) != 0ull) attn_wave<8>(qf, Kimg, Vimg, 8, -1, F.lane, st);
        const int qc = q, rc = r, hc = h; const bool vc = valid;
        if (un < u1) { q = (int)(entn >> 2); r = (int)(entn & 3u); h = hn; kb = kbn; valid = validn;
#pragma unroll
            for (int ks = 0; ks < 8; ++ks) qf[ks] = *(const bf16x8*)(QA + (size_t)q * DM + h * HD + 16 * ks + 8 * hh); }
        if (vc) {
            bf16* op = op_slot(F, rc) + (size_t)qc * DM + hc * HD + 64 * hh;
#pragma unroll
            for (int c = 0; c < 4; ++c)
#pragma unroll
                for (int g2 = 0; g2 < 2; ++g2) { u32x4 w; w.x = cvtpk(st.o[c][8 * g2], st.o[c][8 * g2 + 1]); w.y = cvtpk(st.o[c][8 * g2 + 2], st.o[c][8 * g2 + 3]); w.z = cvtpk(st.o[c][8 * g2 + 4], st.o[c][8 * g2 + 5]); w.w = cvtpk(st.o[c][8 * g2 + 6], st.o[c][8 * g2 + 7]);
                    *(u32x4*)(op + 16 * c + 8 * g2) = w; }
            if (hh == 0) ML[((size_t)rc * S + qc) * NH + hc] = (f32x2_t){st.m, st.l}; }
        u = un;
    }
    __syncthreads();
}
__device__ __forceinline__ void p_attn_own(Frame& F, const Args& A) {
    const bf16* QA = WSP(bf16, WS_R1); const bf16* KA = WSP(bf16, WS_R1 + T32); const bf16* VA = WSP(bf16, WS_R1 + 2 * T32); const f32x2_t* ML = WSP(const f32x2_t, WS_ML); bf16* YA = WSP(bf16, WS_YA);
    LAS unsigned char* Kimg = F.lds; LAS unsigned char* Vimg = F.lds + 65536;
    for (int u = blockIdx.x; u < NH * NBLK; u += F.G) { const int h = u & 7, qb = u >> 3;
        __syncthreads();
        attn_stage(KA + (size_t)(qb * MBLK) * DM + h * HD, Kimg, F.tid); attn_stage(VA + (size_t)(qb * MBLK) * DM + h * HD, Vimg, F.tid);
        __syncthreads();
        const int q = qb * MBLK + 32 * F.wave + (F.lane & 31), hh = F.lane >> 5;
        bf16x8 qf[8];
#pragma unroll
        for (int ks = 0; ks < 8; ++ks) qf[ks] = *(const bf16x8*)(QA + (size_t)q * DM + h * HD + 16 * ks + 8 * hh);
        AttnState st; attn_wave<0>(qf, Kimg, Vimg, F.wave + 1, F.wave, F.lane, st);
        float mr[3], lr[3], M = st.m;
#pragma unroll
        for (int r = 0; r < 3; ++r) { const f32x2_t ml = ML[((size_t)r * S + q) * NH + h]; mr[r] = ml.x; lr[r] = ml.y; M = fmaxf(M, ml.x); }
        const float w0 = __builtin_amdgcn_exp2f(st.m - M); float L = st.l * w0; float wr[3];
#pragma unroll
        for (int r = 0; r < 3; ++r) { wr[r] = (lr[r] > 0.f) ? __builtin_amdgcn_exp2f(mr[r] - M) : 0.f; L += lr[r] * wr[r]; }
        const float iL = rcp_(L);
        const size_t pbase = (size_t)q * DM + h * HD + 64 * hh;
        const bf16* ps0 = op_slot(F, 0) + pbase; const bf16* ps1 = op_slot(F, 1) + pbase; const bf16* ps2 = op_slot(F, 2) + pbase;
#pragma unroll
        for (int half = 0; half < 2; ++half) {
            bf16x8 pl[4][3];
#pragma unroll
            for (int k = 0; k < 4; ++k) { pl[k][0] = *(const bf16x8*)(ps0 + 32 * half + 8 * k); pl[k][1] = *(const bf16x8*)(ps1 + 32 * half + 8 * k); pl[k][2] = *(const bf16x8*)(ps2 + 32 * half + 8 * k); }
            __builtin_amdgcn_sched_barrier(0);
#pragma unroll
            for (int k = 0; k < 4; ++k) { const int c = 2 * half + (k >> 1), g2 = k & 1;
                float v[8];
#pragma unroll
                for (int e = 0; e < 8; ++e) v[e] = st.o[c][8 * g2 + e] * w0;
#pragma unroll
                for (int r = 0; r < 3; ++r) { float pf[8]; unpack8f(pl[k][r], pf); const bool on = wr[r] != 0.f;
#pragma unroll
                    for (int e = 0; e < 8; ++e) v[e] += on ? wr[r] * pf[e] : 0.f; }
                u32x2 wa, wb; wa.x = cvtpk(v[0] * iL, v[1] * iL); wa.y = cvtpk(v[2] * iL, v[3] * iL); wb.x = cvtpk(v[4] * iL, v[5] * iL); wb.y = cvtpk(v[6] * iL, v[7] * iL);
                bf16* yp = YA + (size_t)q * DM + h * HD + 32 * c + 16 * g2 + 4 * hh; *(u32x2*)yp = wa; *(u32x2*)(yp + 8) = wb; }
        }
    }
    __syncthreads();
}
__device__ __forceinline__ void p_dn_conv(Frame& F, const Args& A) {
    const bf16* QB = WSP(bf16, WS_R1); const bf16* KB = WSP(bf16, WS_R1 + T32); const bf16* VB = WSP(bf16, WS_R1 + 2 * T32);
    bf16* QN = (bf16*)F.out; bf16* KN = (bf16*)F.out + (size_t)S * DM; bf16* VN = WSP(bf16, WS_VN);
    const float* cw = A.in[3]; const float* BA = WSP(const float, WS_BA); float* BETA = WSP(float, WS_BETA); float* G = WSP(float, WS_G);
    for (int it = F.gw; it < S * NH; it += F.NGW) { const int t = it >> 3, h = it & 7, c = h * HD + 2 * F.lane;
        float aq0 = 0.f, aq1 = 0.f, ak0 = 0.f, ak1 = 0.f, av0 = 0.f, av1 = 0.f;
#pragma unroll
        for (int j = 0; j < 4; ++j) { const int tt = t + j - 3; if (tt < 0) continue;
            const unsigned xq = *(const unsigned*)(QB + (size_t)tt * DM + c), xk = *(const unsigned*)(KB + (size_t)tt * DM + c), xv = *(const unsigned*)(VB + (size_t)tt * DM + c);
            const float* w = cw + (size_t)j * 3072;
            aq0 += w[c] * bflo(xq); aq1 += w[c + 1] * bfhi(xq); ak0 += w[1024 + c] * bflo(xk); ak1 += w[1024 + c + 1] * bfhi(xk); av0 += w[2048 + c] * bflo(xv); av1 += w[2048 + c + 1] * bfhi(xv); }
        aq0 = siluf_(aq0); aq1 = siluf_(aq1); ak0 = siluf_(ak0); ak1 = siluf_(ak1); av0 = siluf_(av0); av1 = siluf_(av1);
        const float rq = rsq_(wave_sum(aq0 * aq0 + aq1 * aq1) + EPS) * 0.08838834764831845f, rk = rsq_(wave_sum(ak0 * ak0 + ak1 * ak1) + EPS);
        *(unsigned*)(QN + (size_t)t * DM + c) = pk2(aq0 * rq, aq1 * rq); *(unsigned*)(KN + (size_t)t * DM + c) = pk2(ak0 * rk, ak1 * rk); *(unsigned*)(VN + (size_t)t * DM + c) = pk2(av0, av1);
        if (F.lane == 0) { const float b = BA[(size_t)t * 16 + h], a = BA[(size_t)t * 16 + 8 + h] + A.in[5][h];
            const float sp = (a > 20.f) ? a : log1pf(expf(a));
            BETA[(size_t)t * 8 + h] = 1.f / (1.f + expf(-b)); G[(size_t)t * 8 + h] = -expf(A.in[4][h]) * sp; } }
}
__device__ __forceinline__ void p_dn_chunk(Frame& F, const Args& A) {
    const bf16* QN = (const bf16*)F.out; const bf16* KN = (const bf16*)F.out + (size_t)S * DM; bf16* VU = WSP(bf16, WS_VN); bf16* Wb = WSP(bf16, WS_W); bf16* ATT = WSP(bf16, WS_ATT);
    const float* BETA = WSP(const float, WS_BETA); const float* G = WSP(const float, WS_G); float* GC = WSP(float, WS_GC);
    LAS float* Kc = (LAS float*)(F.lds); LAS float* Qc = Kc + 64 * 132; LAS float* Lm = Qc + 64 * 132; LAS float* Tm = Lm + 64 * 65; LAS float* gcs = Tm + 64 * 65; LAS float* bes = gcs + 64; LAS float* bge = bes + 64;
    const int tid = F.tid;
    for (int item = blockIdx.x; item < NCH * NH; item += F.G) { const int n = item >> 3, h = item & 7, t0 = n * CH;
        __syncthreads();
        if (tid < 64) { gcs[tid] = G[(size_t)(t0 + tid) * 8 + h]; bes[tid] = BETA[(size_t)(t0 + tid) * 8 + h]; }
        __syncthreads();
        if (tid == 0) { float a = 0.f; for (int i = 0; i < 64; ++i) { a += gcs[i]; gcs[i] = a; } }
#pragma unroll
        for (int r = 0; r < 2; ++r) { const int idx = tid + 512 * r, row = idx >> 4, c8 = idx & 15;
            const u32x4 kv = *(const u32x4*)(KN + (size_t)(t0 + row) * DM + h * HD + 8 * c8), qv = *(const u32x4*)(QN + (size_t)(t0 + row) * DM + h * HD + 8 * c8);
            LAS float* kd = Kc + row * 132 + 8 * c8; LAS float* qd = Qc + row * 132 + 8 * c8;
            kd[0] = bflo(kv.x); kd[1] = bfhi(kv.x); kd[2] = bflo(kv.y); kd[3] = bfhi(kv.y); kd[4] = bflo(kv.z); kd[5] = bfhi(kv.z); kd[6] = bflo(kv.w); kd[7] = bfhi(kv.w);
            qd[0] = bflo(qv.x); qd[1] = bfhi(qv.x); qd[2] = bflo(qv.y); qd[3] = bfhi(qv.y); qd[4] = bflo(qv.z); qd[5] = bfhi(qv.z); qd[6] = bflo(qv.w); qd[7] = bfhi(qv.w); }
        __syncthreads();
        if (tid < 64) { GC[(size_t)(t0 + tid) * 8 + h] = gcs[tid]; bge[tid] = bes[tid] * expf(gcs[tid]); }
        for (int r = 0; r < 8; ++r) { const int p = tid + 512 * r, i = p >> 6, j = p & 63;
            float dk = 0.f, dq = 0.f;
            if (j <= i) { const LAS float* ki = Kc + i * 132; const LAS float* kj = Kc + j * 132; const LAS float* qi = Qc + i * 132;
                for (int d = 0; d < HD; ++d) { dk += ki[d] * kj[d]; dq += qi[d] * kj[d]; } }
            const float dec = (j <= i) ? expf(gcs[i] - gcs[j]) : 0.f;
            Lm[i * 65 + j] = (j < i) ? bes[i] * dk * dec : 0.f;
            ATT[((size_t)(h * NCH + n) * 64 + i) * 64 + j] = (bf16)f2bf((j <= i) ? dq * dec : 0.f); }
        __syncthreads();
        if (tid < 64) { const int c = tid;
            for (int i = 0; i < 64; ++i) { float acc = (i == c) ? 1.f : 0.f; for (int j = 0; j < i; ++j) acc -= Lm[i * 65 + j] * Tm[j * 65 + c]; Tm[i * 65 + c] = acc; } }
        __syncthreads();
#pragma unroll
        for (int r = 0; r < 2; ++r) { const int idx = tid + 512 * r, row = idx >> 4, c8 = idx & 15;
            const u32x4 vv = *(const u32x4*)(VU + (size_t)(t0 + row) * DM + h * HD + 8 * c8); LAS float* vd = Qc + row * 132 + 8 * c8;
            vd[0] = bflo(vv.x); vd[1] = bfhi(vv.x); vd[2] = bflo(vv.y); vd[3] = bfhi(vv.y); vd[4] = bflo(vv.z); vd[5] = bfhi(vv.z); vd[6] = bflo(vv.w); vd[7] = bfhi(vv.w); }
        __syncthreads();
        { const int d = tid & 127, ig = tid >> 7;
          for (int ii = 0; ii < 16; ++ii) { const int i = ig * 16 + ii; float au = 0.f, aw = 0.f;
              for (int j = 0; j <= i; ++j) { const float t = Tm[i * 65 + j]; au += t * bes[j] * Qc[j * 132 + d]; aw += t * bge[j] * Kc[j * 132 + d]; }
              VU[(size_t)(t0 + i) * DM + h * HD + d] = (bf16)f2bf(au); Wb[(size_t)(t0 + i) * DM + h * HD + d] = (bf16)f2bf(aw); } }
    }
    __syncthreads();
}
__device__ __forceinline__ void p_dn_scan_naive(Frame& F, const Args& A) {
    if (blockIdx.x < 4) {
    const bf16* QN = (const bf16*)F.out; const bf16* KN = (const bf16*)F.out + (size_t)S * DM; const bf16* U = WSP(const bf16, WS_VN); const bf16* Wb = WSP(const bf16, WS_W); const bf16* ATT = WSP(const bf16, WS_ATT);
    const float* GC = WSP(const float, WS_GC); bf16* O = WSP(bf16, WS_O);
    LAS float* vn = (LAS float*)F.lds;
    const int tid = F.tid, wv = tid >> 6, h = blockIdx.x * 2 + (wv >> 2), e = (wv & 3) * 32 + (F.lane & 31), half = F.lane >> 5;
    float s[64];
#pragma unroll
    for (int d = 0; d < 64; ++d) s[d] = 0.f;
    for (int n = 0; n < NCH; ++n) { const int t0 = n * CH; const float gl = GC[(size_t)(t0 + 63) * 8 + h];
        for (int c = 0; c < 64; ++c) { const size_t ro = (size_t)(t0 + c) * DM + h * HD; const bf16* wp = Wb + ro + 64 * half; float a = 0.f;
#pragma unroll
            for (int d8 = 0; d8 < 8; ++d8) { if ((d8 & 1) == 0) asm volatile("" ::: "memory"); const u32x4 wv4 = *(const u32x4*)(wp + 8 * d8);
                a += bflo(wv4.x) * s[8 * d8] + bfhi(wv4.x) * s[8 * d8 + 1] + bflo(wv4.y) * s[8 * d8 + 2] + bfhi(wv4.y) * s[8 * d8 + 3] + bflo(wv4.z) * s[8 * d8 + 4] + bfhi(wv4.z) * s[8 * d8 + 5] + bflo(wv4.w) * s[8 * d8 + 6] + bfhi(wv4.w) * s[8 * d8 + 7]; }
            a += __shfl_xor(a, 32);
            vn[c * 512 + tid] = bf2f(U[ro + e]) - a; }
        for (int c = 0; c < 64; ++c) { const size_t ro = (size_t)(t0 + c) * DM + h * HD; const bf16* qp = QN + ro + 64 * half; float a = 0.f;
#pragma unroll
            for (int d8 = 0; d8 < 8; ++d8) { if ((d8 & 1) == 0) asm volatile("" ::: "memory"); const u32x4 wv4 = *(const u32x4*)(qp + 8 * d8);
                a += bflo(wv4.x) * s[8 * d8] + bfhi(wv4.x) * s[8 * d8 + 1] + bflo(wv4.y) * s[8 * d8 + 2] + bfhi(wv4.y) * s[8 * d8 + 3] + bflo(wv4.z) * s[8 * d8 + 4] + bfhi(wv4.z) * s[8 * d8 + 5] + bflo(wv4.w) * s[8 * d8 + 6] + bfhi(wv4.w) * s[8 * d8 + 7]; }
            a += __shfl_xor(a, 32);
            a *= expf(GC[(size_t)(t0 + c) * 8 + h]);
            const bf16* ap = ATT + ((size_t)(h * NCH + n) * 64 + c) * 64; float b = 0.f;
            for (int j = 0; j <= c; ++j) b += bf2f(ap[j]) * vn[j * 512 + tid];
            if (half == 0) O[ro + e] = (bf16)f2bf(a + b); }
        const float egl = expf(gl);
#pragma unroll
        for (int d = 0; d < 64; ++d) s[d] *= egl;
        for (int c = 0; c < 64; ++c) { const size_t ro = (size_t)(t0 + c) * DM + h * HD; const bf16* kp = KN + ro + 64 * half; const float f = vn[c * 512 + tid] * expf(gl - GC[(size_t)(t0 + c) * 8 + h]);
#pragma unroll
            for (int d8 = 0; d8 < 8; ++d8) { if ((d8 & 1) == 0) asm volatile("" ::: "memory"); const u32x4 wv4 = *(const u32x4*)(kp + 8 * d8);
                s[8 * d8] += f * bflo(wv4.x); s[8 * d8 + 1] += f * bfhi(wv4.x); s[8 * d8 + 2] += f * bflo(wv4.y); s[8 * d8 + 3] += f * bfhi(wv4.y); s[8 * d8 + 4] += f * bflo(wv4.z); s[8 * d8 + 5] += f * bfhi(wv4.z); s[8 * d8 + 6] += f * bflo(wv4.w); s[8 * d8 + 7] += f * bfhi(wv4.w); } }
    }
    }
}
__device__ __forceinline__ void p_dn_out(Frame& F, const Args& A) {
    const bf16* O = WSP(const bf16, WS_O); const bf16* Z = WSP(const bf16, WS_Z); bf16* YD = WSP(bf16, WS_YD); const float* ow = A.in[6];
    for (int it = F.gw; it < S * NH; it += F.NGW) { const int t = it >> 3, h = it & 7; const size_t off = (size_t)t * DM + h * HD + 2 * F.lane;
        const unsigned ov = *(const unsigned*)(O + off), zv = *(const unsigned*)(Z + off); const float o0 = bflo(ov), o1 = bfhi(ov);
        const float rs = rsq_(wave_sum(o0 * o0 + o1 * o1) * (1.f / HD) + EPS);
        *(unsigned*)(YD + off) = pk2(o0 * rs * ow[2 * F.lane] * siluf_(bflo(zv)), o1 * rs * ow[2 * F.lane + 1] * siluf_(bfhi(zv))); }
}


constexpr size_t WS_UT = WS_O;
constexpr size_t WS_KT = WS_VN;
constexpr size_t WS_EGL = WS_KMEAN;
typedef float f32x4_t __attribute__((ext_vector_type(4)));

__device__ __forceinline__ void p_dn_relayout1(Frame& F, const Args& A) {
    bf16* QN = (bf16*)F.out; bf16* Wb = WSP(bf16, WS_W); const bf16* U = WSP(const bf16, WS_VN); bf16* UT = WSP(bf16, WS_UT); const float* GC = WSP(const float, WS_GC); float* EGL = WSP(float, WS_EGL);
    LAS unsigned short* tile = (LAS unsigned short*)(F.lds + F.wave * 16640);
    for (int it = F.gw; it < NCH * NH; it += F.NGW) { const int n = it >> 3, h = it & 7, t0 = n * CH;
        if (F.lane == 0) EGL[h * NCH + n] = expf(GC[(size_t)(t0 + 63) * 8 + h]);
        for (int c = 0; c < 64; ++c) { const size_t off = (size_t)(t0 + c) * DM + h * HD + 2 * F.lane; const float eg = expf(GC[(size_t)(t0 + c) * 8 + h]);
            const unsigned qv = *(const unsigned*)(QN + off); *(unsigned*)(QN + off) = pk2(bflo(qv) * eg, bfhi(qv) * eg);
            const unsigned wv = *(const unsigned*)(Wb + off); *(unsigned*)(Wb + off) = wv ^ 0x80008000u;
            const unsigned uv = *(const unsigned*)(U + off); *(LAS unsigned*)(tile + c * 130 + 2 * F.lane) = uv; }
        asm volatile("s_waitcnt lgkmcnt(0)" ::: "memory");
        bf16* ut = UT + (size_t)(h * NCH + n) * (HD * CH);
        for (int e = 0; e < HD; ++e) ut[e * CH + F.lane] = tile[F.lane * 130 + e];
        asm volatile("s_waitcnt lgkmcnt(0)" ::: "memory");
    }
}
__device__ __forceinline__ void p_dn_relayout2(Frame& F, const Args& A) {
    const bf16* KN = (const bf16*)F.out + (size_t)S * DM; bf16* KT = WSP(bf16, WS_KT); const float* GC = WSP(const float, WS_GC);
    LAS unsigned short* tile = (LAS unsigned short*)(F.lds + F.wave * 16640);
    for (int it = F.gw; it < NCH * NH; it += F.NGW) { const int n = it >> 3, h = it & 7, t0 = n * CH;
        for (int c = 0; c < 64; ++c) { const size_t off = (size_t)(t0 + c) * DM + h * HD + 2 * F.lane; *(LAS unsigned*)(tile + c * 130 + 2 * F.lane) = *(const unsigned*)(KN + off); }
        asm volatile("s_waitcnt lgkmcnt(0)" ::: "memory");
        const float f = expf(GC[(size_t)(t0 + 63) * 8 + h] - GC[(size_t)(t0 + F.lane) * 8 + h]);
        bf16* kt = KT + (size_t)(h * NCH + n) * (HD * CH);
        for (int d = 0; d < HD; ++d) kt[d * CH + F.lane] = (bf16)f2bf(bf2f(tile[F.lane * 130 + d]) * f);
        asm volatile("s_waitcnt lgkmcnt(0)" ::: "memory");
    }
}

constexpr size_t WS2_QN = WS_R1, WS2_KN = WS_R1 + T32, WS2_WNEG = WS_R1 + 2 * T32, WS2_ATT = WS_H, WS2_YD = WS_R1 + 2 * T32, WS2_HALT = WS_R1 + T32;
__device__ __forceinline__ bf16* ws2_kt(Frame& F) { return (bf16*)F.out; }
__device__ __forceinline__ bf16* ws2_ut(Frame& F) { return (bf16*)F.out + (size_t)S * DM; }

struct ConvHalo { unsigned q[3], k[3], v[3]; };
__device__ __forceinline__ void p_dn_conv2_halo(Frame& F, ConvHalo& H) {
    const bf16* QB = WSP(bf16, WS_R1); const bf16* KB = WSP(bf16, WS_R1 + T32); const bf16* VB = WSP(bf16, WS_R1 + 2 * T32);
    const int n = F.gw >> 3, h = F.gw & 7, t0 = n * CH, col = h * HD + 2 * F.lane;
#pragma unroll
    for (int j = 0; j < 3; ++j) { const int tt = t0 - 3 + j; H.q[j] = H.k[j] = H.v[j] = 0u;
        if (tt >= 0 && F.gw < NCH * NH) { H.q[j] = *(const unsigned*)(QB + (size_t)tt * DM + col); H.k[j] = *(const unsigned*)(KB + (size_t)tt * DM + col); H.v[j] = *(const unsigned*)(VB + (size_t)tt * DM + col); } }
}
struct ConvW { float w0[4], w1[4]; };
__device__ __forceinline__ void conv_w(const float* cw, int col, ConvW& W) {
#pragma unroll
    for (int j = 0; j < 4; ++j) { W.w0[j] = cw[(size_t)j * 3072 + col]; W.w1[j] = cw[(size_t)j * 3072 + col + 1]; }
}
__device__ __forceinline__ __amdgpu_buffer_rsrc_t mk_rsrc(const void* p) { return __builtin_amdgcn_make_buffer_rsrc((void*)p, 0, 0x7fffffff, 0x00020000); }
__device__ __forceinline__ void conv_load(const bf16* src, int t0, int col, unsigned (&xall)[CH]) {
    const __amdgpu_buffer_rsrc_t r = mk_rsrc(src + (size_t)t0 * DM);
#pragma unroll
    for (int c = 0; c < CH; ++c) xall[c] = __builtin_amdgcn_raw_buffer_load_b32(r, 2 * col, c * (DM * 2), 0);
}
template <bool NORM, bool DST, bool TILE> __device__ __forceinline__ void conv_pass(const unsigned (&xall)[CH], bf16* dst, LAS unsigned short* tile, const ConvW& W, const unsigned (&halo)[3], int t0, int col, int lane, float scale) {
    float a0 = bflo(halo[0]), a1 = bfhi(halo[0]), b0 = bflo(halo[1]), b1 = bfhi(halo[1]), c0 = bflo(halo[2]), c1 = bfhi(halo[2]);
    const __amdgpu_buffer_rsrc_t rd = mk_rsrc(DST ? dst + (size_t)t0 * DM : nullptr);
#pragma unroll
    for (int c = 0; c < CH; ++c) { const unsigned xv = xall[c]; const float d0 = bflo(xv), d1 = bfhi(xv);
        float y0 = siluf_(W.w0[0] * a0 + W.w0[1] * b0 + W.w0[2] * c0 + W.w0[3] * d0), y1 = siluf_(W.w1[0] * a1 + W.w1[1] * b1 + W.w1[2] * c1 + W.w1[3] * d1);
        if (NORM) { const float rs = scale * rsq_(wave_sum(y0 * y0 + y1 * y1) + EPS); y0 *= rs; y1 *= rs; }
        const unsigned o = pk2(y0, y1);
        if (DST) __builtin_amdgcn_raw_buffer_store_b32(o, rd, 2 * col, c * (DM * 2), 0);
        if (TILE) *(LAS unsigned*)(tile + c * 130 + 2 * lane) = o;
        a0 = b0; a1 = b1; b0 = c0; b1 = c1; c0 = d0; c1 = d1; }
}
__device__ __forceinline__ void conv_tile_out(const LAS unsigned short* tile, bf16* dstT, int lane) {
#pragma unroll 4
    for (int i = 0; i < 16; ++i) { const int d = 8 * i + (lane >> 3), ch = lane & 7; const LAS unsigned short* tp = tile + (8 * ch) * 130 + d;
        u32x4 w; w.x = (unsigned)tp[0] | ((unsigned)tp[130] << 16); w.y = (unsigned)tp[260] | ((unsigned)tp[390] << 16); w.z = (unsigned)tp[520] | ((unsigned)tp[650] << 16); w.w = (unsigned)tp[780] | ((unsigned)tp[910] << 16);
        *(u32x4*)(dstT + (size_t)d * CH + 8 * ch) = w; }
}
__device__ __forceinline__ void p_dn_conv2(Frame& F, const Args& A, const ConvHalo& H) {
    if (F.gw >= NCH * NH) return;
    bf16* QB = WSP(bf16, WS_R1); bf16* KB = WSP(bf16, WS_R1 + T32); const bf16* VB = WSP(bf16, WS_R1 + 2 * T32); const float* cw = A.in[3];
    LAS unsigned short* tile = (LAS unsigned short*)(F.lds + F.wave * 16640);
    const int n = F.gw >> 3, h = F.gw & 7, t0 = n * CH, col = h * HD + 2 * F.lane;
    bf16* ktr = ws2_kt(F) + (size_t)(h * NCH + n) * (HD * CH); bf16* vt = ws2_ut(F) + (size_t)(h * NCH + n) * (HD * CH);
    unsigned xa[CH]; ConvW W;
    conv_load(KB, t0, col, xa); conv_w(cw + 1024, col, W);
    conv_pass<true, true, true>(xa, KB, tile, W, H.k, t0, col, F.lane, 1.f);
    asm volatile("s_waitcnt lgkmcnt(0)" ::: "memory");
    conv_load(VB, t0, col, xa); conv_w(cw + 2048, col, W);
    __builtin_amdgcn_sched_barrier(0);
    conv_tile_out(tile, ktr, F.lane);
    asm volatile("s_waitcnt lgkmcnt(0)" ::: "memory");
    conv_pass<false, false, true>(xa, nullptr, tile, W, H.v, t0, col, F.lane, 1.f);
    asm volatile("s_waitcnt lgkmcnt(0)" ::: "memory");
    conv_load(QB, t0, col, xa); conv_w(cw, col, W);
    __builtin_amdgcn_sched_barrier(0);
    conv_tile_out(tile, vt, F.lane);
    asm volatile("s_waitcnt lgkmcnt(0)" ::: "memory");
    conv_pass<true, true, false>(xa, QB, tile, W, H.q, t0, col, F.lane, 0.08838834764831845f);
}

constexpr int CK_WAVE_LDS = 19200;
__device__ __forceinline__ void p_dn_chunk2(Frame& F, const Args& A) {
    if (F.gw >= NCH * NH) return;
    const int n = F.gw >> 3, h = F.gw & 7, t0 = n * CH, lane = F.lane, r = lane & 31, hh = lane >> 5;
    bf16* QN = WSP(bf16, WS2_QN); const bf16* KN = WSP(const bf16, WS2_KN); bf16* Wn = WSP(bf16, WS2_WNEG); bf16* ATT = WSP(bf16, WS2_ATT) + (size_t)(h * NCH + n) * (CH * CH);
    bf16* KT = ws2_kt(F) + (size_t)(h * NCH + n) * (HD * CH); bf16* UT = ws2_ut(F) + (size_t)(h * NCH + n) * (HD * CH);
    const float* BA = WSP(const float, WS_BA); float* EGL = WSP(float, WS_EGL);
    LAS unsigned char* wl = F.lds + F.wave * CK_WAVE_LDS; LAS float* Lw = (LAS float*)wl; LAS float* gcs = (LAS float*)(wl + 18432); LAS float* bes = gcs + 64; LAS float* fcs = bes + 64;
    float beta, gc, gl;
    { const int t = t0 + lane; const float b = BA[(size_t)t * 16 + h], a = BA[(size_t)t * 16 + 8 + h] + A.in[5][h];
      const float sp = (a > 20.f) ? a : log1pf(expf(a)); gc = -expf(A.in[4][h]) * sp; beta = 1.f / (1.f + expf(-b));
#pragma unroll
      for (int o = 1; o < 64; o <<= 1) { const float v = __shfl_up(gc, o); if (lane >= o) gc += v; }
      gl = __shfl(gc, 63);
      gcs[lane] = gc; bes[lane] = beta; fcs[lane] = expf(gl - gc);
      if (lane == 0) EGL[h * NCH + n] = expf(gl); }
    asm volatile("s_waitcnt lgkmcnt(0)" ::: "memory");
    {
        bf16x8 kf[2][8];
#pragma unroll
        for (int ti = 0; ti < 2; ++ti)
#pragma unroll
            for (int ks = 0; ks < 8; ++ks) kf[ti][ks] = *(const bf16x8*)(KN + (size_t)(t0 + 32 * ti + r) * DM + h * HD + 16 * ks + 8 * hh);
#pragma unroll
        for (int tt = 0; tt < 3; ++tt) { const int ti = (tt == 0) ? 0 : 1, tj = (tt == 2) ? 1 : 0;
            f32x16 acc;
#pragma unroll
            for (int i = 0; i < 16; ++i) acc[i] = 0.f;
#pragma unroll
            for (int ks = 0; ks < 8; ++ks) acc = __builtin_amdgcn_mfma_f32_32x32x16_bf16(kf[ti][ks], kf[tj][ks], acc, 0, 0, 0);
            const int j = 32 * tj + r; const float gcj = gcs[j];
#pragma unroll
            for (int g4 = 0; g4 < 4; ++g4) { const int i0 = 32 * ti + 8 * g4 + 4 * hh; const f32x4 gi = *(const LAS f32x4*)(gcs + i0), bi = *(const LAS f32x4*)(bes + i0);
#pragma unroll
                for (int e = 0; e < 4; ++e) { const int i = i0 + e; Lw[i * 68 + j] = (j < i) ? bi[e] * acc[4 * g4 + e] * __expf(gi[e] - gcj) : 0.f; } } }
        bf16x8 qf[2][8];
#pragma unroll
        for (int ti = 0; ti < 2; ++ti)
#pragma unroll
            for (int ks = 0; ks < 8; ++ks) qf[ti][ks] = *(const bf16x8*)(QN + (size_t)(t0 + 32 * ti + r) * DM + h * HD + 16 * ks + 8 * hh);
#pragma unroll
        for (int tt = 0; tt < 3; ++tt) { const int tj = (tt == 2) ? 1 : 0, ti = (tt == 0) ? 0 : 1;
            f32x16 acc;
#pragma unroll
            for (int i = 0; i < 16; ++i) acc[i] = 0.f;
#pragma unroll
            for (int ks = 0; ks < 8; ++ks) acc = __builtin_amdgcn_mfma_f32_32x32x16_bf16(kf[tj][ks], qf[ti][ks], acc, 0, 0, 0);
            const int i = 32 * ti + r; const float gci = gcs[i];
#pragma unroll
            for (int g4 = 0; g4 < 4; ++g4) { const int j0 = 32 * tj + 8 * g4 + 4 * hh; const f32x4 gj = *(const LAS f32x4*)(gcs + j0); float v[4];
#pragma unroll
                for (int e = 0; e < 4; ++e) v[e] = (j0 + e <= i) ? acc[4 * g4 + e] * __expf(gci - gj[e]) : 0.f;
                u32x2 w; w.x = cvtpk(v[0], v[1]); w.y = cvtpk(v[2], v[3]); *(u32x2*)(ATT + (size_t)i * CH + 32 * tj + 16 * (g4 & 1) + 8 * hh + 4 * (g4 >> 1)) = w; } }
        { const u32x4 z4 = {0u, 0u, 0u, 0u}; const int zi = lane >> 1, zj = 32 + 16 * (lane & 1); *(u32x4*)(ATT + (size_t)zi * CH + zj) = z4; *(u32x4*)(ATT + (size_t)zi * CH + zj + 8) = z4; }
#pragma unroll
        for (int ti = 0; ti < 2; ++ti) { const float eg = __expf(gcs[32 * ti + r]);
#pragma unroll
            for (int ks = 0; ks < 8; ++ks) { float f[8]; unpack8f(qf[ti][ks], f);
#pragma unroll
                for (int e = 0; e < 8; ++e) f[e] *= eg;
                const u32x4 pw = __builtin_bit_cast(u32x4, pack8f(f)); bf16* qd = QN + (size_t)(t0 + 32 * ti + r) * DM + h * HD + 32 * (ks >> 1) + 16 * hh + 4 * (ks & 1);
                u32x2 p0, p1; p0.x = pw.x; p0.y = pw.y; p1.x = pw.z; p1.y = pw.w; *(u32x2*)qd = p0; *(u32x2*)(qd + 8) = p1; } }
    }
    asm volatile("s_waitcnt lgkmcnt(0)" ::: "memory");
    float T[64];
#pragma unroll
    for (int i = 0; i < 64; ++i) { float acc = (lane == i) ? 1.f : 0.f;
#pragma unroll
        for (int j = 0; j < i; ++j) acc -= Lw[i * 68 + j] * T[j];
        T[i] = acc; }
    LAS unsigned short* Tb = (LAS unsigned short*)wl; LAS unsigned short* Tbg = Tb + 64 * 72;
    { const float eg = __expf(gc);
      asm volatile("s_waitcnt lgkmcnt(0)" ::: "memory");
#pragma unroll
      for (int i = 0; i < 64; ++i) { const float v = T[i] * beta; Tb[i * 72 + lane] = (unsigned short)f2bf(v); Tbg[i * 72 + lane] = (unsigned short)f2bf(v * eg); } }
    asm volatile("s_waitcnt lgkmcnt(0)" ::: "memory");
#ifdef DBG_CHK
    if (n < 128) { bf16* dump = WSP(bf16, 241 * MiB) + (size_t)(h * 128 + n) * 4096; for (int i = 0; i < 64; ++i) dump[i * 64 + lane] = Tbg[i * 72 + lane]; }
#endif
#ifdef DBG_CHK
    if (n < 32) { bf16* dk = WSP(bf16, 249 * MiB) + (size_t)(h * 32 + n) * 8192; for (int x = 0; x < 128; ++x) dk[x * 64 + lane] = KT[(size_t)x * CH + lane]; }
#endif
#ifdef DN2_VALU_UW
    for (int e = 0; e < HD; ++e) { float a = 0.f; for (int j2 = 0; j2 < 64; ++j2) a += bf2f(Tb[lane * 72 + j2]) * bf2f(UT[(size_t)e * CH + j2]); asm volatile("s_waitcnt vmcnt(0)" ::: "memory"); UT[(size_t)e * CH + lane] = (bf16)f2bf(a); asm volatile("s_waitcnt vmcnt(0)" ::: "memory"); }
    for (int d2 = 0; d2 < HD; ++d2) { float a = 0.f; for (int j2 = 0; j2 < 64; ++j2) a += bf2f(Tbg[lane * 72 + j2]) * bf2f(KT[(size_t)d2 * CH + j2]); Wn[(size_t)(t0 + lane) * DM + h * HD + d2] = (bf16)f2bf(-a); }
#else
#pragma unroll
    for (int te = 0; te < 4; ++te) { bf16x8 vfr[4];
#pragma unroll
        for (int ks2 = 0; ks2 < 4; ++ks2) vfr[ks2] = *(const bf16x8*)(UT + (size_t)(32 * te + r) * CH + 16 * ks2 + 8 * hh);
#pragma unroll
        for (int ti = 0; ti < 2; ++ti) { f32x16 acc;
#pragma unroll
            for (int i = 0; i < 16; ++i) acc[i] = 0.f;
#pragma unroll
            for (int ks2 = 0; ks2 < 4; ++ks2) if (ti == 1 || ks2 < 2) { const bf16x8 tb = *(const LAS bf16x8*)(Tb + (32 * ti + r) * 72 + 16 * ks2 + 8 * hh); acc = __builtin_amdgcn_mfma_f32_32x32x16_bf16(tb, vfr[ks2], acc, 0, 0, 0); }
#pragma unroll
            for (int g4 = 0; g4 < 4; ++g4) { u32x2 w; w.x = cvtpk(acc[4 * g4], acc[4 * g4 + 1]); w.y = cvtpk(acc[4 * g4 + 2], acc[4 * g4 + 3]); *(u32x2*)(UT + (size_t)(32 * te + r) * CH + 32 * ti + 8 * g4 + 4 * hh) = w; } } }
#pragma unroll
    for (int td = 0; td < 4; ++td) { bf16x8 kfr[4];
#pragma unroll
        for (int ks2 = 0; ks2 < 4; ++ks2) kfr[ks2] = *(const bf16x8*)(KT + (size_t)(32 * td + r) * CH + 16 * ks2 + 8 * hh);
#pragma unroll
        for (int tc = 0; tc < 2; ++tc) { f32x16 acc;
#pragma unroll
            for (int i = 0; i < 16; ++i) acc[i] = 0.f;
#pragma unroll
            for (int ks2 = 0; ks2 < 4; ++ks2) if (tc == 1 || ks2 < 2) { const bf16x8 tg = *(const LAS bf16x8*)(Tbg + (32 * tc + r) * 72 + 16 * ks2 + 8 * hh); acc = __builtin_amdgcn_mfma_f32_32x32x16_bf16(kfr[ks2], tg, acc, 0, 0, 0); }
#pragma unroll
            for (int g4 = 0; g4 < 4; ++g4) { u32x2 w; w.x = cvtpk(-acc[4 * g4], -acc[4 * g4 + 1]); w.y = cvtpk(-acc[4 * g4 + 2], -acc[4 * g4 + 3]);
                *(u32x2*)(Wn + (size_t)(t0 + 32 * tc + r) * DM + h * HD + 32 * td + 16 * (g4 & 1) + 8 * hh + 4 * (g4 >> 1)) = w; } } }
#endif
#pragma unroll 4
    for (int p = 0; p < 16; ++p) { const int idx = lane + 64 * p, d = idx >> 3, ch = idx & 7; bf16x8* ptr = (bf16x8*)(KT + (size_t)d * CH + 8 * ch);
        float f[8]; unpack8f(*ptr, f); const f32x4 f0 = *(const LAS f32x4*)(fcs + 8 * ch), f1 = *(const LAS f32x4*)(fcs + 8 * ch + 4);
        f[0] *= f0[0]; f[1] *= f0[1]; f[2] *= f0[2]; f[3] *= f0[3]; f[4] *= f1[0]; f[5] *= f1[1]; f[6] *= f1[2]; f[7] *= f1[3];
        const u32x4 pw = __builtin_bit_cast(u32x4, pack8f(f)); bf16* kd = KT + (size_t)d * CH + 32 * (ch >> 2) + 16 * (ch & 1) + 4 * ((ch >> 1) & 1);
        u32x2 p0, p1; p0.x = pw.x; p0.y = pw.y; p1.x = pw.z; p1.y = pw.w; *(u32x2*)kd = p0; *(u32x2*)(kd + 8) = p1; }
}

#ifndef DN2
#define DN2 1
#endif
#if DN2
#define SCAN_WNEG WS2_WNEG
#define SCAN_QP WSP(const bf16, WS2_QN)
#define SCAN_KT ws2_kt(F)
#define SCAN_UT ws2_ut(F)
#define SCAN_ATT WS2_ATT
#define SCAN_YD WS2_YD
#else
#define SCAN_WNEG WS_W
#define SCAN_QP ((const bf16*)F.out)
#define SCAN_KT WSP(bf16, WS_KT)
#define SCAN_UT WSP(bf16, WS_UT)
#define SCAN_ATT WS_ATT
#define SCAN_YD WS_YD
#endif
constexpr int SC_RW = 288, SC_RK = 160;
constexpr int SC_W = 0, SC_Q = 64 * SC_RW, SC_K = 2 * 64 * SC_RW, SC_A = SC_K + 128 * SC_RK, SC_BUF = SC_A + 64 * SC_RK;
__device__ __forceinline__ bf16x8 frag2(const LAS unsigned char* p) {
    const u32x2 a = *(const LAS u32x2*)p, b = *(const LAS u32x2*)(p + 32); u32x4 w; w.x = a.x; w.y = a.y; w.z = b.x; w.w = b.y; return __builtin_bit_cast(bf16x8, w);
}
__device__ __forceinline__ bf16x8 packb(const f32x4_t a, const f32x4_t b) { u32x4 w; w.x = cvtpk(a[0], a[1]); w.y = cvtpk(a[2], a[3]); w.z = cvtpk(b[0], b[1]); w.w = cvtpk(b[2], b[3]); return __builtin_bit_cast(bf16x8, w); }
constexpr int SCAN_WGS = 16;
__device__ __forceinline__ void p_dn_scan_fast(Frame& F, const Args& A) {
    if (blockIdx.x < SCAN_WGS) {
    const int h = blockIdx.x >> 1, hf = blockIdx.x & 1;
    const bf16* Wb = WSP(const bf16, SCAN_WNEG); const bf16* QP = SCAN_QP; const bf16* KT = SCAN_KT; const bf16* ATT = WSP(const bf16, SCAN_ATT); bf16* UT = SCAN_UT; const float* EGL = WSP(const float, WS_EGL);
    if (F.wave >= 4) {
        const int lt = F.tid - 256;
#if defined(SCAN_PROBE) && SCAN_PROBE == 2
        unsigned long long lp_sum = 0ull, lp_t0 = 0ull;
#define SCP_T0() (lp_t0 = __builtin_amdgcn_s_memrealtime())
#define SCP_T1() (lp_sum += __builtin_amdgcn_s_memrealtime() - lp_t0)
#else
#define SCP_T0() ((void)0)
#define SCP_T1() ((void)0)
#endif
        u32x4 rwA[4], rqA[4], rkA[4], raA[2], rwB[4], rqB[4], rkB[4], raB[2], rwC[4], rqC[4], rkC[4], raC[2];
#define SC_GLD(dst, voff, sbase) asm volatile("global_load_dwordx4 %0, %1, %2" : "=v"(dst) : "v"(voff), "s"(sbase) : "memory")
        const unsigned vo_w = (unsigned)((lt >> 4) * (DM * 2) + (lt & 15) * 16), vo_t = (unsigned)lt * 16u;
#define SC_ISSUE(n_, X) do { const bf16* bw_ = Wb + (size_t)((n_) * CH) * DM + h * HD; const bf16* bq_ = QP + (size_t)((n_) * CH) * DM + h * HD; \
            const bf16* bk_ = KT + (size_t)(h * NCH + (n_)) * (HD * CH); const bf16* ba_ = ATT + (size_t)(h * NCH + (n_)) * (CH * CH); \
            _Pragma("unroll") for (int i = 0; i < 4; ++i) { SC_GLD(rw##X[i], vo_w + (unsigned)i * (16u * DM * 2u), bw_); SC_GLD(rq##X[i], vo_w + (unsigned)i * (16u * DM * 2u), bq_); } \
            _Pragma("unroll") for (int i = 0; i < 4; ++i) { SC_GLD(rk##X[i], vo_t + (unsigned)i * 4096u, bk_); } \
            _Pragma("unroll") for (int i = 0; i < 2; ++i) { SC_GLD(ra##X[i], vo_t + (unsigned)i * 4096u, ba_); } } while (0)
#define SC_WAIT(N, X) asm volatile("s_waitcnt vmcnt(" #N ")" : "+v"(rw##X[0]), "+v"(rw##X[1]), "+v"(rw##X[2]), "+v"(rw##X[3]), "+v"(rq##X[0]), "+v"(rq##X[1]), "+v"(rq##X[2]), "+v"(rq##X[3]), \
            "+v"(rk##X[0]), "+v"(rk##X[1]), "+v"(rk##X[2]), "+v"(rk##X[3]), "+v"(ra##X[0]), "+v"(ra##X[1]) :: "memory")
#define SC_PUT(buf_, X) do { LAS unsigned char* b_ = F.lds + (buf_) * SC_BUF; \
            _Pragma("unroll") for (int i = 0; i < 4; ++i) { const int idx = lt + 256 * i, row = idx >> 4, ch = idx & 15; *(LAS u32x4*)(b_ + SC_W + row * SC_RW + 16 * ch) = rw##X[i]; *(LAS u32x4*)(b_ + SC_Q + row * SC_RW + 16 * ch) = rq##X[i]; } \
            _Pragma("unroll") for (int i = 0; i < 4; ++i) { const int idx = lt + 256 * i, row = idx >> 3, ch = idx & 7; *(LAS u32x4*)(b_ + SC_K + row * SC_RK + 16 * ch) = rk##X[i]; } \
            _Pragma("unroll") for (int i = 0; i < 2; ++i) { const int idx = lt + 256 * i, row = idx >> 3, ch = idx & 7; *(LAS u32x4*)(b_ + SC_A + row * SC_RK + 16 * ch) = ra##X[i]; } } while (0)
#define SC_STEP(n_, X) do { SCP_T0(); if ((n_) + 1 < NCH) { if ((n_) + 3 < NCH) SC_WAIT(28, X); else if ((n_) + 2 < NCH) SC_WAIT(14, X); else SC_WAIT(0, X); \
                SC_PUT(((n_) + 1) & 1, X); if ((n_) + 4 < NCH) SC_ISSUE((n_) + 4, X); } \
            asm volatile("s_waitcnt lgkmcnt(0)" ::: "memory"); SCP_T1(); __builtin_amdgcn_s_barrier(); } while (0)
        SC_ISSUE(0, A); SC_WAIT(0, A); SC_PUT(0, A);
        asm volatile("s_waitcnt lgkmcnt(0)" ::: "memory");
        __builtin_amdgcn_s_barrier();
        SC_ISSUE(1, A); SC_ISSUE(2, B); SC_ISSUE(3, C);
        for (int n = 0; n < NCH; n += 3) {
            SC_STEP(n, A);
            if (n + 1 < NCH) SC_STEP(n + 1, B);
            if (n + 2 < NCH) SC_STEP(n + 2, C);
        }
#if defined(SCAN_PROBE) && SCAN_PROBE == 2
        if (blockIdx.x == 0 && F.tid == 256) F.MISC[16] = (unsigned)lp_sum;
#endif
    } else {
        const int r = F.lane & 15, g = F.lane >> 4, e0 = (hf * 4 + F.wave) * 16;
        f32x4_t sacc[8];
#pragma unroll
        for (int i = 0; i < 8; ++i) sacc[i] = (f32x4_t){0.f, 0.f, 0.f, 0.f};
        bf16* utp = UT + (size_t)h * NCH * (HD * CH) + (size_t)(e0 + r) * CH + 4 * g;
        u32x2 un[4];
#pragma unroll
        for (int ct = 0; ct < 4; ++ct) un[ct] = *(const u32x2*)(utp + 16 * ct);
        float egl = EGL[h * NCH];
        __builtin_amdgcn_s_barrier();
#ifdef SCAN_PROBE
        unsigned long long sp_sum = 0ull;
#endif
        for (int n = 0; n < NCH; ++n) {
#ifdef SCAN_PROBE
            const unsigned long long sp_t0 = __builtin_amdgcn_s_memrealtime();
#endif
            const LAS unsigned char* b = F.lds + (n & 1) * SC_BUF; const LAS unsigned char* lw = b + SC_W + r * SC_RW + 16 * g; const LAS unsigned char* lq = b + SC_Q + r * SC_RW + 16 * g;
            const LAS unsigned char* lk = b + SC_K + r * SC_RK + 16 * g; const LAS unsigned char* la = b + SC_A + r * SC_RK + 16 * g;
            f32x4_t vacc[4], oacc[4]; bf16x8 sb[4], fa[16], fb[16];
#pragma unroll
            for (int ct = 0; ct < 4; ++ct)
#pragma unroll
                for (int kk = 0; kk < 4; ++kk) fa[4 * ct + kk] = *(const LAS bf16x8*)(lw + ct * 16 * SC_RW + kk * 64);
#pragma unroll
            for (int ct = 0; ct < 4; ++ct)
#pragma unroll
                for (int kk = 0; kk < 4; ++kk) fb[4 * ct + kk] = *(const LAS bf16x8*)(lq + ct * 16 * SC_RW + kk * 64);
            __builtin_amdgcn_sched_barrier(0);
#pragma unroll
            for (int kk = 0; kk < 4; ++kk) sb[kk] = packb(sacc[2 * kk], sacc[2 * kk + 1]);
#pragma unroll
            for (int ct = 0; ct < 4; ++ct) { vacc[ct] = (f32x4_t){bflo(un[ct].x), bfhi(un[ct].x), bflo(un[ct].y), bfhi(un[ct].y)}; oacc[ct] = (f32x4_t){0.f, 0.f, 0.f, 0.f}; }
            bf16* utc = utp + (size_t)n * (HD * CH);
            u32x2 unn[4]; float egln = 0.f;
            if (n + 1 < NCH) {
#pragma unroll
                for (int ct = 0; ct < 4; ++ct) unn[ct] = *(const u32x2*)(utc + HD * CH + 16 * ct);
                egln = EGL[h * NCH + n + 1]; }
#pragma unroll
            for (int kk = 0; kk < 4; ++kk)
#pragma unroll
                for (int ct = 0; ct < 4; ++ct) vacc[ct] = __builtin_amdgcn_mfma_f32_16x16x32_bf16(fa[4 * ct + kk], sb[kk], vacc[ct], 0, 0, 0);
            __builtin_amdgcn_sched_barrier(0);
#pragma unroll
            for (int mt = 0; mt < 8; ++mt)
#pragma unroll
                for (int k2 = 0; k2 < 2; ++k2) fa[2 * mt + k2] = *(const LAS bf16x8*)(lk + mt * 16 * SC_RK + k2 * 64);
            __builtin_amdgcn_sched_barrier(0);
#pragma unroll
            for (int kk = 0; kk < 4; ++kk)
#pragma unroll
                for (int ct = 0; ct < 4; ++ct) oacc[ct] = __builtin_amdgcn_mfma_f32_16x16x32_bf16(fb[4 * ct + kk], sb[kk], oacc[ct], 0, 0, 0);
            __builtin_amdgcn_sched_barrier(0);
#pragma unroll
            for (int ct = 0; ct < 4; ++ct)
#pragma unroll
                for (int k2 = 0; k2 < 2; ++k2) if (!(k2 == 1 && ct < 2)) fb[2 * ct + k2] = *(const LAS bf16x8*)(la + ct * 16 * SC_RK + k2 * 64);
            __builtin_amdgcn_sched_barrier(0);
            bf16x8 vb[2];
#pragma unroll
            for (int k2 = 0; k2 < 2; ++k2) vb[k2] = packb(vacc[2 * k2], vacc[2 * k2 + 1]);
#pragma unroll
            for (int mt = 0; mt < 8; ++mt) sacc[mt] = sacc[mt] * egl;
#pragma unroll
            for (int k2 = 0; k2 < 2; ++k2)
#pragma unroll
                for (int mt = 0; mt < 8; ++mt) sacc[mt] = __builtin_amdgcn_mfma_f32_16x16x32_bf16(fa[2 * mt + k2], vb[k2], sacc[mt], 0, 0, 0);
#pragma unroll
            for (int k2 = 0; k2 < 2; ++k2)
#pragma unroll
                for (int ct = 0; ct < 4; ++ct) if (!(k2 == 1 && ct < 2)) oacc[ct] = __builtin_amdgcn_mfma_f32_16x16x32_bf16(fb[2 * ct + k2], vb[k2], oacc[ct], 0, 0, 0);
#pragma unroll
            for (int ct = 0; ct < 4; ++ct) { u32x2 w; w.x = cvtpk(oacc[ct][0], oacc[ct][1]); w.y = cvtpk(oacc[ct][2], oacc[ct][3]); *(u32x2*)(utc + 16 * ct) = w; }
#pragma unroll
            for (int ct = 0; ct < 4; ++ct) un[ct] = unn[ct];
            egl = egln;
            asm volatile("s_waitcnt lgkmcnt(0)" ::: "memory");
#if defined(SCAN_PROBE) && SCAN_PROBE == 1
            asm volatile("s_waitcnt vmcnt(0)" ::: "memory"); sp_sum += __builtin_amdgcn_s_memrealtime() - sp_t0;
#endif
            __builtin_amdgcn_s_barrier();
        }
#if defined(SCAN_PROBE) && SCAN_PROBE == 1
        if (blockIdx.x == 0 && F.tid == 0) F.MISC[16] = (unsigned)sp_sum;
#endif
    }
    }
}

constexpr int SEG_G = 8, SEG_N = NCH / SEG_G;
constexpr size_t WS_SST = 241 * MiB;
constexpr size_t WS_MBB = 245 * MiB;
constexpr size_t WS_MBM = 249 * MiB;
static_assert(WS_MBM + (size_t)NH * (SEG_G - 1) * 128 * 128 * 4 <= WS_END, "segment scan buffers");

template <bool FINAL> __device__ __forceinline__ void scan_job(Frame& F, const Args& A, int h, int sg, int sub) {
    const bf16* Wb = WSP(const bf16, SCAN_WNEG); const bf16* QP = SCAN_QP; const bf16* KT = SCAN_KT; const bf16* ATT = WSP(const bf16, SCAN_ATT); bf16* UT = SCAN_UT; const float* EGL = WSP(const float, WS_EGL);
    const int n0 = sg * SEG_N, n1 = n0 + SEG_N;
    constexpr int NLD = FINAL ? 14 : 8;
    if (F.wave >= 4) {
        const int lt = F.tid - 256;
        u32x4 rwA[4], rqA[4], rkA[4], raA[2], rwB[4], rqB[4], rkB[4], raB[2], rwC[4], rqC[4], rkC[4], raC[2];
#define S2_GLD(dst, voff, sbase) asm volatile("global_load_dwordx4 %0, %1, %2" : "=v"(dst) : "v"(voff), "s"(sbase) : "memory")
        const unsigned vo_w = (unsigned)((lt >> 4) * (DM * 2) + (lt & 15) * 16), vo_t = (unsigned)lt * 16u;
#define S2_ISSUE(n_, X) do { const bf16* bw_ = Wb + (size_t)((n_) * CH) * DM + h * HD; const bf16* bk_ = KT + (size_t)(h * NCH + (n_)) * (HD * CH); \
            _Pragma("unroll") for (int i = 0; i < 4; ++i) { S2_GLD(rw##X[i], vo_w + (unsigned)i * (16u * DM * 2u), bw_); } \
            _Pragma("unroll") for (int i = 0; i < 4; ++i) { S2_GLD(rk##X[i], vo_t + (unsigned)i * 4096u, bk_); } \
            if constexpr (FINAL) { const bf16* bq_ = QP + (size_t)((n_) * CH) * DM + h * HD; const bf16* ba_ = ATT + (size_t)(h * NCH + (n_)) * (CH * CH); \
                _Pragma("unroll") for (int i = 0; i < 4; ++i) { S2_GLD(rq##X[i], vo_w + (unsigned)i * (16u * DM * 2u), bq_); } \
                _Pragma("unroll") for (int i = 0; i < 2; ++i) { S2_GLD(ra##X[i], vo_t + (unsigned)i * 4096u, ba_); } } } while (0)
#define S2_TIEF(X) "+v"(rw##X[0]), "+v"(rw##X[1]), "+v"(rw##X[2]), "+v"(rw##X[3]), "+v"(rq##X[0]), "+v"(rq##X[1]), "+v"(rq##X[2]), "+v"(rq##X[3]), "+v"(rk##X[0]), "+v"(rk##X[1]), "+v"(rk##X[2]), "+v"(rk##X[3]), "+v"(ra##X[0]), "+v"(ra##X[1])
#define S2_TIEA(X) "+v"(rw##X[0]), "+v"(rw##X[1]), "+v"(rw##X[2]), "+v"(rw##X[3]), "+v"(rk##X[0]), "+v"(rk##X[1]), "+v"(rk##X[2]), "+v"(rk##X[3])
#define S2_WAIT2(X) do { if constexpr (FINAL) asm volatile("s_waitcnt vmcnt(28)" : S2_TIEF(X) :: "memory"); else asm volatile("s_waitcnt vmcnt(16)" : S2_TIEA(X) :: "memory"); } while (0)
#define S2_WAIT0(X) do { if constexpr (FINAL) asm volatile("s_waitcnt vmcnt(0)" : S2_TIEF(X) :: "memory"); else asm volatile("s_waitcnt vmcnt(0)" : S2_TIEA(X) :: "memory"); } while (0)
#define S2_PUT(buf_, X) do { LAS unsigned char* b_ = F.lds + (buf_) * SC_BUF; \
            _Pragma("unroll") for (int i = 0; i < 4; ++i) { const int idx = lt + 256 * i, row = idx >> 4, ch = idx & 15; *(LAS u32x4*)(b_ + SC_W + row * SC_RW + 16 * ch) = rw##X[i]; \
                if constexpr (FINAL) *(LAS u32x4*)(b_ + SC_Q + row * SC_RW + 16 * ch) = rq##X[i]; } \
            _Pragma("unroll") for (int i = 0; i < 4; ++i) { const int idx = lt + 256 * i, row = idx >> 3, ch = idx & 7; *(LAS u32x4*)(b_ + SC_K + row * SC_RK + 16 * ch) = rk##X[i]; } \
            if constexpr (FINAL) { _Pragma("unroll") for (int i = 0; i < 2; ++i) { const int idx = lt + 256 * i, row = idx >> 3, ch = idx & 7; *(LAS u32x4*)(b_ + SC_A + row * SC_RK + 16 * ch) = ra##X[i]; } } } while (0)
#define S2_STEP(n_, X) do { S2_WAIT2(X); S2_PUT(((n_) + 1 - n0) & 1, X); { const int nn_ = ((n_) + 4 < n1) ? (n_) + 4 : n1 - 1; S2_ISSUE(nn_, X); } \
            asm volatile("s_waitcnt lgkmcnt(0)" ::: "memory"); __builtin_amdgcn_s_barrier(); } while (0)
        static_assert(SEG_N % 3 == 2, "loader tail below is written for SEG_N = 3k + 2");
        S2_ISSUE(n0, A); S2_WAIT0(A); S2_PUT(0, A);
        asm volatile("s_waitcnt lgkmcnt(0)" ::: "memory");
        __builtin_amdgcn_s_barrier();
        S2_ISSUE(n0 + 1, A); S2_ISSUE(n0 + 2, B); S2_ISSUE(n0 + 3, C);
        int n = n0;
        for (; n + 2 < n1; n += 3) { S2_STEP(n, A); S2_STEP(n + 1, B); S2_STEP(n + 2, C); }
        S2_STEP(n, A); S2_STEP(n + 1, B);
        asm volatile("s_waitcnt vmcnt(0)" ::: "memory");
    } else {
        const int r = F.lane & 15, g = F.lane >> 4;
        const int col = FINAL ? (sub * 4 + F.wave) * 16 + r : 64 * sub + 16 * F.wave + r;
        const bool real = FINAL || (col < 128);
        f32x4_t sacc[8];
        if constexpr (FINAL) { const float* sp = WSP(const float, WS_SST) + ((size_t)(h * SEG_G + sg) * 128 + col) * 128 + 4 * g;
#pragma unroll
            for (int mt = 0; mt < 8; ++mt) sacc[mt] = *(const f32x4_t*)(sp + 16 * mt); }
        else {
#pragma unroll
            for (int mt = 0; mt < 8; ++mt)
#pragma unroll
                for (int e = 0; e < 4; ++e) sacc[mt][e] = (!real && (16 * mt + 4 * g + e) == (col - 128)) ? 1.f : 0.f; }
        bf16* utp = UT + (size_t)h * NCH * (HD * CH) + (size_t)((FINAL ? col : (col & 127))) * CH + 4 * g;
        u32x2 un[4];
#pragma unroll
        for (int ct = 0; ct < 4; ++ct) { un[ct] = (u32x2){0u, 0u}; if (real) un[ct] = *(const u32x2*)(utp + (size_t)n0 * (HD * CH) + 16 * ct); }
        float egl = EGL[h * NCH + n0];
        __builtin_amdgcn_s_barrier();
        for (int n = n0; n < n1; ++n) {
            const LAS unsigned char* b = F.lds + ((n - n0) & 1) * SC_BUF; const LAS unsigned char* lw = b + SC_W + r * SC_RW + 16 * g; const LAS unsigned char* lq = b + SC_Q + r * SC_RW + 16 * g;
            const LAS unsigned char* lk = b + SC_K + r * SC_RK + 16 * g; const LAS unsigned char* la = b + SC_A + r * SC_RK + 16 * g;
            f32x4_t vacc[4], oacc[4]; bf16x8 sb[4], fa[16], fb[16];
#pragma unroll
            for (int ct = 0; ct < 4; ++ct)
#pragma unroll
                for (int kk = 0; kk < 4; ++kk) fa[4 * ct + kk] = *(const LAS bf16x8*)(lw + ct * 16 * SC_RW + kk * 64);
            if constexpr (FINAL) {
#pragma unroll
                for (int ct = 0; ct < 4; ++ct)
#pragma unroll
                    for (int kk = 0; kk < 4; ++kk) fb[4 * ct + kk] = *(const LAS bf16x8*)(lq + ct * 16 * SC_RW + kk * 64); }
            __builtin_amdgcn_sched_barrier(0);
#pragma unroll
            for (int kk = 0; kk < 4; ++kk) sb[kk] = packb(sacc[2 * kk], sacc[2 * kk + 1]);
#pragma unroll
            for (int ct = 0; ct < 4; ++ct) { vacc[ct] = (f32x4_t){bflo(un[ct].x), bfhi(un[ct].x), bflo(un[ct].y), bfhi(un[ct].y)}; oacc[ct] = (f32x4_t){0.f, 0.f, 0.f, 0.f}; }
            bf16* utc = utp + (size_t)n * (HD * CH);
            u32x2 unn[4]; float egln = 0.f;
#pragma unroll
            for (int ct = 0; ct < 4; ++ct) unn[ct] = (u32x2){0u, 0u};
            if (n + 1 < n1) { if (real) {
#pragma unroll
                    for (int ct = 0; ct < 4; ++ct) unn[ct] = *(const u32x2*)(utc + HD * CH + 16 * ct); }
                egln = EGL[h * NCH + n + 1]; }
#pragma unroll
            for (int kk = 0; kk < 4; ++kk)
#pragma unroll
                for (int ct = 0; ct < 4; ++ct) vacc[ct] = __builtin_amdgcn_mfma_f32_16x16x32_bf16(fa[4 * ct + kk], sb[kk], vacc[ct], 0, 0, 0);
            __builtin_amdgcn_sched_barrier(0);
#pragma unroll
            for (int mt = 0; mt < 8; ++mt)
#pragma unroll
                for (int k2 = 0; k2 < 2; ++k2) fa[2 * mt + k2] = *(const LAS bf16x8*)(lk + mt * 16 * SC_RK + k2 * 64);
            __builtin_amdgcn_sched_barrier(0);
            if constexpr (FINAL) {
#pragma unroll
                for (int kk = 0; kk < 4; ++kk)
#pragma unroll
                    for (int ct = 0; ct < 4; ++ct) oacc[ct] = __builtin_amdgcn_mfma_f32_16x16x32_bf16(fb[4 * ct + kk], sb[kk], oacc[ct], 0, 0, 0);
                __builtin_amdgcn_sched_barrier(0);
#pragma unroll
                for (int ct = 0; ct < 4; ++ct)
#pragma unroll
                    for (int k2 = 0; k2 < 2; ++k2) if (!(k2 == 1 && ct < 2)) fb[2 * ct + k2] = *(const LAS bf16x8*)(la + ct * 16 * SC_RK + k2 * 64);
                __builtin_amdgcn_sched_barrier(0); }
            bf16x8 vb[2];
#pragma unroll
            for (int k2 = 0; k2 < 2; ++k2) vb[k2] = packb(vacc[2 * k2], vacc[2 * k2 + 1]);
#pragma unroll
            for (int mt = 0; mt < 8; ++mt) sacc[mt] = sacc[mt] * egl;
#pragma unroll
            for (int k2 = 0; k2 < 2; ++k2)
#pragma unroll
                for (int mt = 0; mt < 8; ++mt) sacc[mt] = __builtin_amdgcn_mfma_f32_16x16x32_bf16(fa[2 * mt + k2], vb[k2], sacc[mt], 0, 0, 0);
            if constexpr (FINAL) {
#pragma unroll
                for (int k2 = 0; k2 < 2; ++k2)
#pragma unroll
                    for (int ct = 0; ct < 4; ++ct) if (!(k2 == 1 && ct < 2)) oacc[ct] = __builtin_amdgcn_mfma_f32_16x16x32_bf16(fb[2 * ct + k2], vb[k2], oacc[ct], 0, 0, 0);
#pragma unroll
                for (int ct = 0; ct < 4; ++ct) { u32x2 w; w.x = cvtpk(oacc[ct][0], oacc[ct][1]); w.y = cvtpk(oacc[ct][2], oacc[ct][3]); *(u32x2*)(utc + 16 * ct) = w; } }
#pragma unroll
            for (int ct = 0; ct < 4; ++ct) un[ct] = unn[ct];
            egl = egln;
            asm volatile("s_waitcnt lgkmcnt(0)" ::: "memory");
            __builtin_amdgcn_s_barrier();
        }
        if constexpr (!FINAL) {
            if (real) { float* bp = WSP(float, WS_MBB) + ((size_t)(h * (SEG_G - 1) + sg) * 128 + col) * 128 + 4 * g;
#pragma unroll
                for (int mt = 0; mt < 8; ++mt) *(f32x4_t*)(bp + 16 * mt) = sacc[mt]; }
            else { float* mp = WSP(float, WS_MBM) + (size_t)(h * (SEG_G - 1) + sg) * (128 * 128) + (col - 128);
#pragma unroll
                for (int mt = 0; mt < 8; ++mt)
#pragma unroll
                    for (int e = 0; e < 4; ++e) mp[(size_t)(16 * mt + 4 * g + e) * 128] = sacc[mt][e]; } }
    }
}
__device__ __forceinline__ void scan_mid(Frame& F, const Args& A, int h) {
    LAS float* Sl = (LAS float*)F.lds; LAS unsigned char* Mimg = F.lds + 128 * 132 * 4;
    float* SST = WSP(float, WS_SST) + (size_t)h * SEG_G * (128 * 128);
    const float* MBB = WSP(const float, WS_MBB) + (size_t)h * (SEG_G - 1) * (128 * 128); const float* MBM = WSP(const float, WS_MBM) + (size_t)h * (SEG_G - 1) * (128 * 128);
    const int r = F.lane & 15, g = F.lane >> 4, et = F.wave;
    for (int i = F.tid; i < 128 * 128; i += NWAVES * 64) { Sl[(i >> 7) * 132 + (i & 127)] = 0.f; SST[i] = 0.f; }
    f32x4 mreg[8];
#pragma unroll
    for (int i = 0; i < 8; ++i) mreg[i] = *(const f32x4*)(MBM + (size_t)(F.tid + 512 * i) * 4);
    for (int sg = 0; sg < SEG_G - 1; ++sg) {
        __syncthreads();
#pragma unroll
        for (int i = 0; i < 8; ++i) { const int idx = F.tid + 512 * i, row = idx >> 5, c4 = idx & 31; u32x2 w; w.x = cvtpk(mreg[i].x, mreg[i].y); w.y = cvtpk(mreg[i].z, mreg[i].w); *(LAS u32x2*)(Mimg + row * 272 + 8 * c4) = w; }
        if (sg + 1 < SEG_G - 1) {
#pragma unroll
            for (int i = 0; i < 8; ++i) mreg[i] = *(const f32x4*)(MBM + (size_t)(sg + 1) * (128 * 128) + (size_t)(F.tid + 512 * i) * 4); }
        f32x4_t acc[8];
        const float* bp = MBB + ((size_t)sg * 128 + 16 * et + r) * 128 + 4 * g;
#pragma unroll
        for (int mt = 0; mt < 8; ++mt) acc[mt] = *(const f32x4_t*)(bp + 16 * mt);
        __syncthreads();
#pragma unroll
        for (int kk = 0; kk < 4; ++kk) {
            const LAS float* sp = Sl + (16 * et + r) * 132 + 32 * kk + 8 * g; const f32x4 s0 = *(const LAS f32x4*)sp, s1 = *(const LAS f32x4*)(sp + 4);
            float sf[8] = {s0.x, s0.y, s0.z, s0.w, s1.x, s1.y, s1.z, s1.w}; const bf16x8 bfr = pack8f(sf);
#pragma unroll
            for (int mt = 0; mt < 8; ++mt) { const bf16x8 afr = *(const LAS bf16x8*)(Mimg + (16 * mt + r) * 272 + 64 * kk + 16 * g); acc[mt] = __builtin_amdgcn_mfma_f32_16x16x32_bf16(afr, bfr, acc[mt], 0, 0, 0); } }
        float* so = SST + (size_t)(sg + 1) * (128 * 128) + (size_t)(16 * et + r) * 128 + 4 * g;
#pragma unroll
        for (int mt = 0; mt < 8; ++mt) { *(f32x4_t*)(so + 16 * mt) = acc[mt]; *(LAS f32x4_t*)(Sl + (16 * et + r) * 132 + 16 * mt + 4 * g) = acc[mt]; }
    }
    __syncthreads();
}
__device__ __forceinline__ void p_dn_scan2_A(Frame& F, const Args& A) { const int b = blockIdx.x; if (b < NH * (SEG_G - 1) * 4) { const int gid = 8 * (b >> 5) + (b & 7), sub = (b >> 3) & 3; scan_job<false>(F, A, gid / (SEG_G - 1), gid % (SEG_G - 1), sub); } }
__device__ __forceinline__ void p_dn_scan2_B(Frame& F, const Args& A) { if (blockIdx.x < NH) scan_mid(F, A, blockIdx.x); }
__device__ __forceinline__ void p_dn_scan2_C(Frame& F, const Args& A) { const int b = blockIdx.x; if (b < NH * SEG_G * 2) { const int gid = 8 * (b >> 4) + (b & 7), sub = (b >> 3) & 1; scan_job<true>(F, A, gid / SEG_G, gid % SEG_G, sub); } }
__device__ __forceinline__ void p_dn_out_fast(Frame& F, const Args& A) {
    const bf16* OT = SCAN_UT; const bf16* Z = WSP(const bf16, WS_Z); bf16* YD = WSP(bf16, SCAN_YD); const float* ow = A.in[6];
    LAS unsigned short* tile = (LAS unsigned short*)(F.lds + F.wave * 16640);
    for (int it = F.gw; it < NCH * NH; it += F.NGW) { const int n = it >> 3, h = it & 7, t0 = n * CH;
        const bf16* ot = OT + (size_t)(h * NCH + n) * (HD * CH);
        u32x4 ov[16]; unsigned zall[CH];
#pragma unroll
        for (int i = 0; i < 16; ++i) { const int e = 8 * i + (F.lane >> 3), ch = F.lane & 7; ov[i] = *(const u32x4*)(ot + (size_t)e * CH + 8 * ch); }
#pragma unroll
        for (int c = 0; c < CH; ++c) zall[c] = *(const unsigned*)(Z + (size_t)(t0 + c) * DM + h * HD + 2 * F.lane);
        const float w0 = ow[2 * F.lane], w1 = ow[2 * F.lane + 1];
#pragma unroll
        for (int i = 0; i < 16; ++i) { const int e = 8 * i + (F.lane >> 3), ch = F.lane & 7; const u32x4 v = ov[i]; LAS unsigned short* tp = tile + e * 65 + 8 * ch;
            tp[0] = (unsigned short)v.x; tp[1] = (unsigned short)(v.x >> 16); tp[2] = (unsigned short)v.y; tp[3] = (unsigned short)(v.y >> 16); tp[4] = (unsigned short)v.z; tp[5] = (unsigned short)(v.z >> 16); tp[6] = (unsigned short)v.w; tp[7] = (unsigned short)(v.w >> 16); }
        asm volatile("s_waitcnt lgkmcnt(0)" ::: "memory");
#pragma unroll
        for (int c = 0; c < CH; ++c) { const float o0 = bf2f(tile[(2 * F.lane) * 65 + c]), o1 = bf2f(tile[(2 * F.lane + 1) * 65 + c]);
            const float rs = rsq_(wave_sum(o0 * o0 + o1 * o1) * (1.f / HD) + EPS);
            const size_t off = (size_t)(t0 + c) * DM + h * HD + 2 * F.lane; const unsigned zv = zall[c];
            *(unsigned*)(YD + off) = pk2(o0 * rs * w0 * siluf_(bflo(zv)), o1 * rs * w1 * siluf_(bfhi(zv))); }
        asm volatile("s_waitcnt lgkmcnt(0)" ::: "memory");
    }
}
#ifdef DBG_ATTN
constexpr int CW_DBG = 20000;
__device__ __forceinline__ void dbg_compare(Frame& F, const bf16* a, const bf16* b, size_t n) {
    float* acc = (float*)(WSP(unsigned, WS_CTL) + CW_DBG); float d2 = 0.f, r2 = 0.f;
    for (size_t i = (size_t)F.gw * 64 + F.lane; i < n; i += (size_t)F.NGW * 64) { const float x = bf2f(a[i]), y = bf2f(b[i]); d2 += (x - y) * (x - y); r2 += y * y; }
    d2 = wave_sum(d2); r2 = wave_sum(r2);
    if (F.lane == 0) { atomicAdd(acc, d2); atomicAdd(acc + 1, r2); }
}
#endif

#if defined(DBG_DET) || defined(DBG_L2L)
constexpr int CW_CS = 24000;
__device__ __forceinline__ void dbg_cksum(Frame& F, const void* p, size_t bytes, int slot) {
    const unsigned* w = (const unsigned*)p; unsigned acc = 0u; const size_t nw = bytes / 4;
#ifdef DBG_NANCNT
    for (size_t i = (size_t)F.gw * 64 + F.lane; i < nw; i += (size_t)F.NGW * 64) { const unsigned v = w[i]; acc += ((v & 0x7F80u) >= (141u << 7)) + ((v & 0x7F800000u) >= (141u << 23)); }
#else
    for (size_t i = (size_t)F.gw * 64 + F.lane; i < nw; i += (size_t)F.NGW * 64) { const unsigned v = w[i]; acc += v * 2654435761u + (unsigned)(i * 40503u) * (v >> 7); }
#endif
#pragma unroll
    for (int o = 1; o < 64; o <<= 1) acc += __shfl_xor(acc, o);
    if (F.lane == 0) atomicAdd(WSP(unsigned, WS_CTL) + CW_CS + slot, acc);
}
#endif

#ifdef DBG_SIG
constexpr int CW_SIG = 26000;
__device__ __forceinline__ void dbg_sig(Frame& F, const bf16* p, size_t n, int slot) {
    double acc = 0.0, acc2 = 0.0;
    for (size_t i = (size_t)F.gw * 64 + F.lane; i < n; i += (size_t)F.NGW * 64) { unsigned hsh = (unsigned)i * 2654435761u; hsh ^= hsh >> 15; hsh *= 2246822519u; hsh ^= hsh >> 13;
        const float wgt = (float)(hsh & 0xFFFFu) * (1.f / 32768.f) - 1.f; const float x = bf2f(p[i]); acc += (double)(x * wgt); acc2 += (double)(x * x); }
    long long q1 = (long long)(acc * 65536.0), q2 = (long long)(acc2 * 65536.0);
#pragma unroll
    for (int o = 1; o < 64; o <<= 1) { q1 += __shfl_xor(q1, o); q2 += __shfl_xor(q2, o); }
    if (F.lane == 0) { unsigned long long* a = (unsigned long long*)(WSP(unsigned, WS_CTL) + CW_SIG); atomicAdd(a + 2 * slot, (unsigned long long)q1); atomicAdd(a + 2 * slot + 1, (unsigned long long)q2); }
}
#endif

#ifdef DBG_CHK
constexpr int CW_CHK = 28000;
__device__ __forceinline__ float dbg_g(const float* BA, const Args& A, int t, int h) { const float a = BA[(size_t)t * 16 + 8 + h] + A.in[5][h]; const float sp = (a > 20.f) ? a : log1pf(expf(a)); return -expf(A.in[4][h]) * sp; }
__device__ __forceinline__ void dbg_chk_acc(Frame& F, int k, float err, float ref) {
    long long q1 = (long long)((double)err * (double)err * 1048576.0), q2 = (long long)((double)ref * (double)ref * 1048576.0);
    unsigned long long* a = (unsigned long long*)(WSP(unsigned, WS_CTL) + CW_CHK); atomicAdd(a + 2 * k, (unsigned long long)q1); atomicAdd(a + 2 * k + 1, (unsigned long long)q2);
}
__device__ __forceinline__ void dbg_chunk2_check(Frame& F, const Args& A) {
    const float* BA = WSP(const float, WS_BA); const bf16* KN = WSP(const bf16, WS2_KN); const bf16* QP = WSP(const bf16, WS2_QN); const bf16* Wn = WSP(const bf16, WS2_WNEG);
    const bf16* ATT = WSP(const bf16, WS2_ATT); const bf16* KT = ws2_kt(F); const float* EGL = WSP(const float, WS_EGL);
    const int s = F.gw * 64 + F.lane; if (s >= 8192) return;
    unsigned hsh = (unsigned)s * 2654435761u; hsh ^= hsh >> 15; hsh *= 2246822519u; hsh ^= hsh >> 13;
    const int n = hsh & 255, h = (hsh >> 8) & 7, i = (hsh >> 11) & 63, d = (hsh >> 17) & 127, t0 = n * CH;
    float gci = 0.f, gl = 0.f; { float a = 0.f; for (int j = 0; j < 64; ++j) { a += dbg_g(BA, A, t0 + j, h); if (j == i) gci = a; } gl = a; }
    const float beta_i = 1.f / (1.f + expf(-BA[(size_t)(t0 + i) * 16 + h]));
    const bf16* ki = KN + (size_t)(t0 + i) * DM + h * HD;
    dbg_chk_acc(F, 0, EGL[h * NCH + n] - expf(gl), expf(gl));
    { const float ref = bf2f(ki[d]) * expf(gl - gci); dbg_chk_acc(F, 1, bf2f(KT[(size_t)(h * NCH + n) * (HD * CH) + (size_t)d * CH + i]) - ref, ref); }
    { const float kt = bf2f(KT[(size_t)(h * NCH + n) * (HD * CH) + (size_t)d * CH + i]); dbg_chk_acc(F, 4, kt - bf2f(ki[d]), bf2f(ki[d])); }
    if (n < 128) { const int c = d & 63; const bf16* tg = WSP(const bf16, 241 * MiB) + (size_t)(h * 128 + n) * 4096; float lhs = bf2f(tg[i * 64 + c]); float gcj = 0.f, gcc = 0.f;
      for (int j = 0; j < 64; ++j) { gcj += dbg_g(BA, A, t0 + j, h); if (j == c) gcc = gcj;
          if (j < i) { const bf16* kj = KN + (size_t)(t0 + j) * DM + h * HD; float dot = 0.f; for (int x = 0; x < HD; ++x) dot += bf2f(ki[x]) * bf2f(kj[x]); lhs += beta_i * dot * expf(gci - gcj) * bf2f(tg[j * 64 + c]); } }
      const float beta_c = 1.f / (1.f + expf(-BA[(size_t)(t0 + c) * 16 + h])); const float ref = (i == c) ? beta_c * expf(gcc) : 0.f; dbg_chk_acc(F, 5, lhs - ref, (i == c) ? ref : 0.05f * beta_c * expf(gcc)); }
    if (n < 128) { const bf16* tg = WSP(const bf16, 241 * MiB) + (size_t)(h * 128 + n) * 4096; float ref = 0.f, mag = 0.f;
      for (int j = 0; j < 64; ++j) { const float t = bf2f(tg[i * 64 + j]) * bf2f(KN[(size_t)(t0 + j) * DM + h * HD + d]); ref += t; mag += fabsf(t); }
      dbg_chk_acc(F, 6, -bf2f(Wn[(size_t)(t0 + i) * DM + h * HD + d]) - ref, mag); }
    if (n < 128) { const bf16* tg = WSP(const bf16, 241 * MiB) + (size_t)(h * 128 + n) * 4096; float r7 = 0.f, r8 = 0.f, mag = 0.f, gcj = 0.f;
      for (int j = 0; j < 64; ++j) { gcj += dbg_g(BA, A, t0 + j, h); const float kk = bf2f(KN[(size_t)(t0 + j) * DM + h * HD + d]); const float t = bf2f(tg[i * 64 + j]) * kk;
          r7 += t * expf(gl - gcj); r8 += bf2f(tg[j * 64 + i]) * kk; mag += fabsf(t); }
      const float wv = -bf2f(Wn[(size_t)(t0 + i) * DM + h * HD + d]); dbg_chk_acc(F, 7, wv - r7, mag); dbg_chk_acc(F, 8, wv - r8, mag); }
    if (n < 32) { const bf16* dk = WSP(const bf16, 249 * MiB) + (size_t)(h * 32 + n) * 8192; dbg_chk_acc(F, 9, bf2f(dk[d * 64 + i]) - bf2f(ki[d]), bf2f(ki[d])); }
    if (n < 32) { const float ref = bf2f(ki[d]) * expf(gl - gci); dbg_chk_acc(F, 10, bf2f(KT[(size_t)(h * NCH + n) * (HD * CH) + (size_t)d * CH + i]) - ref, ref); }
    if (n < 128) { const bf16* tg = WSP(const bf16, 241 * MiB) + (size_t)(h * 128 + n) * 4096; float ref = 0.f, mag = 0.f;
      for (int j = 0; j < 64; ++j) { const float t = bf2f(tg[i * 64 + j]) * bf2f(KN[(size_t)(t0 + j) * DM + h * HD + d]); ref += t; mag += fabsf(t); }
      dbg_chk_acc(F, n >= 32 ? 11 : 12, -bf2f(Wn[(size_t)(t0 + i) * DM + h * HD + d]) - ref, mag); }
    { float lhs = -bf2f(Wn[(size_t)(t0 + i) * DM + h * HD + d]); float gcj = 0.f;
      for (int j = 0; j < i; ++j) { gcj += dbg_g(BA, A, t0 + j, h); const bf16* kj = KN + (size_t)(t0 + j) * DM + h * HD; float dot = 0.f; for (int x = 0; x < HD; ++x) dot += bf2f(ki[x]) * bf2f(kj[x]);
          lhs += beta_i * dot * expf(gci - gcj) * (-bf2f(Wn[(size_t)(t0 + j) * DM + h * HD + d])); }
      const float ref = beta_i * expf(gci) * bf2f(ki[d]); dbg_chk_acc(F, 2, lhs - ref, ref); }
    { const int j = d & 63; if (j <= i && gci > -20.f) { float gcj = 0.f; for (int x = 0; x <= j; ++x) gcj += dbg_g(BA, A, t0 + x, h);
          const bf16* kj = KN + (size_t)(t0 + j) * DM + h * HD; const bf16* qi = QP + (size_t)(t0 + i) * DM + h * HD; float dot = 0.f; for (int x = 0; x < HD; ++x) dot += bf2f(qi[x]) * bf2f(kj[x]);
          const float ref = dot * expf(-gcj); dbg_chk_acc(F, 3, bf2f(ATT[(size_t)(h * NCH + n) * (CH * CH) + (size_t)i * CH + j]) - ref, ref); }
      else if (j > i) dbg_chk_acc(F, 3, bf2f(ATT[(size_t)(h * NCH + n) * (CH * CH) + (size_t)i * CH + j]), 0.f); }
}
#endif

#ifdef DBG_TILE
constexpr int CW_TILE = 30000;
__device__ __forceinline__ void dbg_tile_check(Frame& F, const Args& A) {
    if (F.gw >= NCH * NH) return;
    const int n = F.gw >> 3, h = F.gw & 7, t0 = n * CH, lane = F.lane;
    const float* BA = WSP(const float, WS_BA); const bf16* KN = WSP(const bf16, WS2_KN); const bf16* KT = ws2_kt(F) + (size_t)(h * NCH + n) * (HD * CH);
    float gc = 0.f, gl = 0.f; { float a = 0.f; for (int j = 0; j < 64; ++j) { a += dbg_g(BA, A, t0 + j, h); if (j == lane) gc = a; } gl = a; }
    const float f = expf(gl - gc); int bad = 0;
    for (int d = 0; d < HD; ++d) { const float ref = bf2f(KN[(size_t)(t0 + lane) * DM + h * HD + d]) * f; const float got = bf2f(KT[(size_t)d * CH + lane]); if (!(fabsf(got - ref) <= 0.02f * fabsf(ref) + 1e-3f)) ++bad; }
    bad = (int)wave_sum((float)bad);
    if (lane == 0 && bad > 0) { unsigned* w = WSP(unsigned, WS_CTL) + CW_TILE; atomicAdd(w, 1u); atomicMin(w + 1, (unsigned)n); atomicOr(w + 2 + n, 1u << h); atomicAdd(w + 300, (unsigned)bad); atomicOr(w + 301, 1u << h); if (bad > 4096) atomicOr(w + 302, 1u << h); }
}
#endif
template <int R> __device__ __forceinline__ void post_rows(Frame& F, const Args& A, int m0, int stride) {
    const float* x = A.in[0]; const bf16* T = WSP(const bf16, WS_T); bf16* H2 = WSP(bf16, WS_H2);
    const f32x4* w1 = (const f32x4*)A.in[10] + F.lane; const f32x4* w2 = (const f32x4*)A.in[11] + F.lane;
    unsigned long long t8[R][4]; f32x4 xv[R][4];
#pragma unroll
    for (int k = 0; k < R; ++k) { const int m = m0 + k * stride; const unsigned long long* tr = (const unsigned long long*)(T + (size_t)m * DM) + F.lane; const f32x4* xr = (const f32x4*)(x + (size_t)m * DM) + F.lane;
#pragma unroll
        for (int j = 0; j < 4; ++j) { t8[k][j] = tr[64 * j]; xv[k][j] = xr[64 * j]; } }
#pragma unroll
    for (int k = 0; k < R; ++k) { const int m = m0 + k * stride; f32x4* orow = (f32x4*)(F.out + (size_t)m * DM) + F.lane;
        f32x4 tv[4]; float ss = 0.f;
#pragma unroll
        for (int j = 0; j < 4; ++j) { const unsigned long long w8 = t8[k][j]; const unsigned lo = (unsigned)w8, hi = (unsigned)(w8 >> 32); tv[j] = (f32x4){bflo(lo), bfhi(lo), bflo(hi), bfhi(hi)}; ss += (tv[j].x * tv[j].x + tv[j].y * tv[j].y) + (tv[j].z * tv[j].z + tv[j].w * tv[j].w); }
        const float rs = rsq_(wave_sum(ss) * (1.f / DM) + EPS); float s2 = 0.f;
#pragma unroll
        for (int j = 0; j < 4; ++j) { tv[j] = xv[k][j] + tv[j] * rs * w1[64 * j]; orow[64 * j] = tv[j]; s2 += (tv[j].x * tv[j].x + tv[j].y * tv[j].y) + (tv[j].z * tv[j].z + tv[j].w * tv[j].w); }
        const float r2 = rsq_(wave_sum(s2) * (1.f / DM) + EPS);
        unsigned long long* o8 = (unsigned long long*)(H2 + (size_t)m * DM) + F.lane;
#pragma unroll
        for (int j = 0; j < 4; ++j) { const f32x4 hv = tv[j] * r2 * w2[64 * j]; o8[64 * j] = (unsigned long long)pk2(hv.x, hv.y) | ((unsigned long long)pk2(hv.z, hv.w) << 32); } }
}
__device__ __forceinline__ void p_post_mix(Frame& F, const Args& A) {
    int m = F.gw;
    for (; m + F.NGW < S; m += 2 * F.NGW) post_rows<2>(F, A, m, F.NGW);
    if (m < S) post_rows<1>(F, A, m, F.NGW);
}
#if !defined(DBG_NAN) && !defined(DBG_DET) && !defined(DBG_ATTN)
template <int R> __device__ __forceinline__ void final_rows(Frame& F, const Args& A, int m0, int stride) {
    const bf16* Fd = WSP(const bf16, WS_F); const f32x4* w = (const f32x4*)A.in[15] + F.lane;
    unsigned long long f8[R][4]; f32x4 xv[R][4];
#pragma unroll
    for (int k = 0; k < R; ++k) { const int m = m0 + k * stride; const unsigned long long* fr = (const unsigned long long*)(Fd + (size_t)m * DM) + F.lane; const f32x4* orow = (const f32x4*)(F.out + (size_t)m * DM) + F.lane;
#pragma unroll
        for (int j = 0; j < 4; ++j) { f8[k][j] = fr[64 * j]; xv[k][j] = orow[64 * j]; } }
#pragma unroll
    for (int k = 0; k < R; ++k) { const int m = m0 + k * stride; f32x4* orow = (f32x4*)(F.out + (size_t)m * DM) + F.lane;
        f32x4 fv[4]; float ss = 0.f;
#pragma unroll
        for (int j = 0; j < 4; ++j) { const unsigned long long w8 = f8[k][j]; const unsigned lo = (unsigned)w8, hi = (unsigned)(w8 >> 32); fv[j] = (f32x4){bflo(lo), bfhi(lo), bflo(hi), bfhi(hi)}; ss += (fv[j].x * fv[j].x + fv[j].y * fv[j].y) + (fv[j].z * fv[j].z + fv[j].w * fv[j].w); }
        const float rs = rsq_(wave_sum(ss) * (1.f / DM) + EPS);
#pragma unroll
        for (int j = 0; j < 4; ++j) orow[64 * j] = xv[k][j] + fv[j] * rs * w[64 * j]; }
}
__device__ __forceinline__ void p_final(Frame& F, const Args& A) {
    int m = F.gw;
    for (; m + F.NGW < S; m += 2 * F.NGW) final_rows<2>(F, A, m, F.NGW);
    if (m < S) final_rows<1>(F, A, m, F.NGW);
}
#else
__device__ __forceinline__ void p_final(Frame& F, const Args& A) {
    const bf16* Fd = WSP(const bf16, WS_F);
    for (int m = F.gw; m < S; m += F.NGW) {
        const unsigned long long* fr = (const unsigned long long*)(Fd + (size_t)m * DM) + F.lane; f32x4* orow = (f32x4*)(F.out + (size_t)m * DM) + F.lane; const f32x4* w = (const f32x4*)A.in[15] + F.lane;
        f32x4 fv[4]; float ss = 0.f;
#pragma unroll
        for (int j = 0; j < 4; ++j) { const unsigned long long w8 = fr[64 * j]; const unsigned lo = (unsigned)w8, hi = (unsigned)(w8 >> 32); fv[j] = (f32x4){bflo(lo), bfhi(lo), bflo(hi), bfhi(hi)}; ss += (fv[j].x * fv[j].x + fv[j].y * fv[j].y) + (fv[j].z * fv[j].z + fv[j].w * fv[j].w); }
        const float rs = rsq_(wave_sum(ss) * (1.f / DM) + EPS);
#pragma unroll
        for (int j = 0; j < 4; ++j) { f32x4 ov = orow[64 * j] + fv[j] * rs * w[64 * j];
#ifdef DBG_NAN
#pragma unroll
            for (int e = 0; e < 4; ++e) if (!(fabsf(ov[e]) < 1e30f)) ov[e] = 12345.f;
#endif
            orow[64 * j] = ov; }
#ifdef DBG_DET
        { const unsigned* cs = WSP(const unsigned, WS_CTL) + CW_CS; float pz = 0.f;
          for (int k = 12; k >= 0; --k) if (cs[k] != cs[16 + k]) pz = __builtin_ldexpf(1.f, 40 - 2 * k);
#pragma unroll
          for (int j = 0; j < 4; ++j) orow[64 * j] = orow[64 * j] + pz; }
#endif
#ifdef DBG_ATTN
        { const float* acc = (const float*)(WSP(unsigned, WS_CTL) + CW_DBG); const float rv = acc[0] / acc[1]; const float pz = !(rv < DBG_TOL) ? 1000.f : 0.f;
#pragma unroll
          for (int j = 0; j < 4; ++j) orow[64 * j] = orow[64 * j] + pz; }
#endif
    }
}

#endif
constexpr int NPHASE = 18;
#ifndef MK_N_LAUNCHES
#define MK_N_LAUNCHES 1
#endif
constexpr int N_LAUNCHES = MK_N_LAUNCHES;
__global__ void __launch_bounds__(NWAVES * 64, 2) fwd(Args args) {
    extern __shared__ __attribute__((aligned(16))) unsigned char lds[];
    Frame F;
    F.lds = (LAS unsigned char*)lds; F.MISC = (volatile LAS unsigned*)(F.lds + MISC_OFF);
    F.tid = threadIdx.x; F.lane = F.tid & 63; F.wave = __builtin_amdgcn_readfirstlane(F.tid >> 6);
    F.G = gridDim.x; F.gw = blockIdx.x * NWAVES + F.wave; F.NGW = F.G * NWAVES;
    F.out = args.out; F.ws = args.ws;
    for (int u = F.tid; u < (LDS_BYTES - LDSCTL_OFF) / 4; u += NWAVES * 64) ((LAS unsigned*)(F.lds + LDSCTL_OFF))[u] = 0u;
    __syncthreads();
    XcdBarrier bar; bar.bar = (unsigned*)(F.ws + WS_CTL) + CW_BAR; bar.x = 0; bar.st = nullptr;
    if (N_LAUNCHES == 1) bar = xcd_barrier_post((unsigned*)(F.ws + WS_CTL) + CW_BAR, F.MISC + 8);
#define GRID_BAR() do { if (N_LAUNCHES == 1) xcd_barrier(bar); } while (0)
    const int lo = args.ph_lo, hi = args.ph_hi;
#ifdef PROBE_LO
    unsigned long long pr_t0 = 0ull, pr_dt = 0ull;
#define PROBE_AT(k) do { if (blockIdx.x == 0 && F.tid == 0) { if ((k) == PROBE_LO) pr_t0 = __builtin_amdgcn_s_memrealtime(); if ((k) == PROBE_HI + 1) pr_dt = __builtin_amdgcn_s_memrealtime() - pr_t0; } } while (0)
#else
#define PROBE_AT(k) do {} while (0)
#endif
#ifdef DBG_L2L
#define CK(k, p, n) dbg_cksum(F, (p), (n), (k))
#define CKB() GRID_BAR()
#else
#define CK(k, p, n) do {} while (0)
#define CKB() do {} while (0)
#endif
#if defined(ONLY_PH)
#define PH_EN(k) ((k) == ONLY_PH)
#elif defined(PH_MASK)
#define PH_EN(k) (((PH_MASK) >> (k)) & 1)
#else
#define PH_EN(k) true
#endif
#define IN(k) (PH_EN(k) && lo <= (k) && (k) < hi)
#define BOTH(k) (IN(k) && IN((k) + 1))
#define GEMM(EPI, Aoff, Boff, N_, K_, ...) do { pg8::Gemm g{(const pg8::bf16_t*)(F.ws + (Aoff)), (const pg8::bf16_t*)(F.ws + (Boff)), S, (N_), (K_)}; pg8::StaticOrder So; So.init(S, (N_), F.G, (int)blockIdx.x); \
        EPI E{__VA_ARGS__}; pg8::gemm_phase<EPI, pg8::StaticOrder, true, true>(F.lds + RING_OFF, g, So, E); } while (0)

    PROBE_AT(0);
    if (IN(0)) { p_prologue(F, args); if (BOTH(0)) GRID_BAR(); }
    CK(0, F.ws + WS_H, T32); CK(0, F.ws + WS_BA, 1 * MiB); CK(0, F.ws + WS_WTA, 41 * MiB - 512 * 1024); CKB();
    PROBE_AT(1);
    if (IN(1)) { GEMM(pg8::EpiRope, WS_H, WS_WTA, 3072, DM, WSP(pg8::bf16_t, WS_R1), WSP(const float, WS_COS), WSP(const float, WS_SIN), WSP(float, WS_KMEAN)); if (BOTH(1)) GRID_BAR(); }
    CK(1, F.ws + WS_R1, 3 * T32); CKB();
    PROBE_AT(2);
#ifndef TOPK2
#define TOPK2 1
#endif
#if !TOPK2
    if (IN(2)) { p_kmean(F, args); if (BOTH(2)) GRID_BAR(); }
#endif
    CK(2, F.ws + WS_KMEAN, 256 * 1024); CKB();
#ifndef ATTN_FAST
#define ATTN_FAST 1
#endif
#if ATTN_FAST
    PROBE_AT(3);
#if TOPK2
    if (IN(3)) { p_topk2(F, args); if (BOTH(3)) GRID_BAR(); }
#else
    if (IN(3)) { p_topk_bucket(F, args); if (BOTH(3)) GRID_BAR(); }
#endif
    CK(3, F.ws + WS_TOPI, (size_t)S * NH * 12); CKB();
    PROBE_AT(4);
#ifdef WGSTAT
#define WGSTAT_RUN(k, call) do { const unsigned long long t0_ = __builtin_amdgcn_s_memrealtime(); call; if (WGSTAT_PH == (k)) { __syncthreads(); if (F.tid == 0) { const unsigned dt_ = (unsigned)(__builtin_amdgcn_s_memrealtime() - t0_); \
        unsigned* w_ = WSP(unsigned, WS_CTL) + 30000; atomicMax(w_, dt_); atomicAdd(w_ + 1, dt_); atomicMin(w_ + 2, 0xFFFFFFFFu - dt_); } } } while (0)
#else
#define WGSTAT_RUN(k, call) call
#endif
    if (IN(4)) { PROBE_AT(40); WGSTAT_RUN(40, p_attn_sel(F, args)); GRID_BAR(); PROBE_AT(41); WGSTAT_RUN(41, p_attn_own(F, args)); PROBE_AT(42);
#ifdef DBG_ATTN
        GRID_BAR(); p_attn_naive(F, args); GRID_BAR(); dbg_compare(F, WSP(const bf16, WS_YA), (const bf16*)F.out, (size_t)S * DM);
#endif
        if (BOTH(4)) GRID_BAR(); }
    CK(4, F.ws + WS_YA, T32); CKB();
#else
    PROBE_AT(3);
    if (IN(3)) { p_topk(F, args); if (BOTH(3)) GRID_BAR(); }
    PROBE_AT(4);
    if (IN(4)) { p_attn_naive(F, args); if (BOTH(4)) GRID_BAR(); }
#endif
#ifdef DBG_CHK
    {   GEMM(pg8::EpiGen<0>, WS_H, WS_WTB, 4096, DM, WSP(pg8::bf16_t, WS_R1), DM, 1024, (size_t)S * DM, nullptr); GRID_BAR();
        { ConvHalo hl; p_dn_conv2_halo(F, hl); GRID_BAR(); p_dn_conv2(F, args, hl); GRID_BAR(); }
        p_dn_chunk2(F, args); GRID_BAR();
        dbg_chunk2_check(F, args); GRID_BAR();
#ifdef DBG_TILE
        if (blockIdx.x == 0 && F.tid == 0) WSP(unsigned, WS_CTL)[CW_TILE + 1] = 0xFFFFu; GRID_BAR(); dbg_tile_check(F, args); GRID_BAR();
#endif
        }
#elif defined(DBG_SIG)
    {
      { Frame Fp = F; asm volatile("" : "+s"(Fp.ws), "+s"(Fp.out), "+v"(Fp.lane), "+v"(Fp.tid));
        GEMM(pg8::EpiGen<0>, WS_H, WS_WTB, 4096, DM, WSP(pg8::bf16_t, WS_R1), DM, 1024, (size_t)S * DM, nullptr); GRID_BAR();
        p_dn_conv(Fp, args); GRID_BAR(); p_dn_chunk(Fp, args); GRID_BAR(); p_dn_relayout1(Fp, args); GRID_BAR(); p_dn_relayout2(Fp, args); GRID_BAR();
        dbg_sig(Fp, (const bf16*)Fp.out, (size_t)S * DM, 0); dbg_sig(Fp, WSPF(const bf16, WS_W), (size_t)S * DM, 1); dbg_sig(Fp, WSPF(const bf16, WS_KT), (size_t)S * DM, 2);
        dbg_sig(Fp, WSPF(const bf16, WS_UT), (size_t)S * DM, 3); dbg_sig(Fp, WSPF(const bf16, WS_ATT), (size_t)S * DM / 2, 4); GRID_BAR();
      }
      { Frame Fp = F; asm volatile("" : "+s"(Fp.ws), "+s"(Fp.out), "+v"(Fp.lane), "+v"(Fp.tid));
        p_hrecompute(Fp, args); GRID_BAR();
        GEMM(pg8::EpiGen<0>, WS_H, WS_WTB, 4096, DM, WSP(pg8::bf16_t, WS_R1), DM, 1024, (size_t)S * DM, nullptr); GRID_BAR();
        { ConvHalo hl; p_dn_conv2_halo(Fp, hl); GRID_BAR(); p_dn_conv2(Fp, args, hl); GRID_BAR(); }
        p_dn_chunk2(Fp, args); GRID_BAR();
        dbg_sig(Fp, WSPF(const bf16, WS2_QN), (size_t)S * DM, 8); dbg_sig(Fp, WSPF(const bf16, WS2_WNEG), (size_t)S * DM, 9); dbg_sig(Fp, ws2_kt(Fp), (size_t)S * DM, 10);
        dbg_sig(Fp, ws2_ut(Fp), (size_t)S * DM, 11); dbg_sig(Fp, WSPF(const bf16, WS2_ATT), (size_t)S * DM / 2, 12); GRID_BAR();
      }
    }
#elif defined(DBG_DET)
#define DET_PASS(P) { Frame Fp = F; asm volatile("" : "+s"(Fp.ws), "+s"(Fp.out), "+v"(Fp.lane), "+v"(Fp.tid)); \
    p_hrecompute(Fp, args); GRID_BAR(); \
    GEMM(pg8::EpiGen<0>, WS_H, WS_WTB, 4096, DM, WSP(pg8::bf16_t, WS_R1), DM, 1024, (size_t)S * DM, nullptr); GRID_BAR(); \
    dbg_cksum(Fp, Fp.ws + WS_R1, 4 * T32, (P) * 16 + 0); GRID_BAR(); \
    { ConvHalo hl; p_dn_conv2_halo(Fp, hl); GRID_BAR(); p_dn_conv2(Fp, args, hl); GRID_BAR(); } \
    dbg_cksum(Fp, Fp.ws + WS2_QN, T32, (P) * 16 + 1); dbg_cksum(Fp, Fp.ws + WS2_KN, T32, (P) * 16 + 2); dbg_cksum(Fp, ws2_kt(Fp), T32, (P) * 16 + 3); dbg_cksum(Fp, ws2_ut(Fp), T32, (P) * 16 + 4); GRID_BAR(); \
    p_dn_chunk2(Fp, args); GRID_BAR(); \
    dbg_cksum(Fp, Fp.ws + WS2_ATT, T32 / 2, (P) * 16 + 5); dbg_cksum(Fp, Fp.ws + WS2_QN, T32, (P) * 16 + 6); dbg_cksum(Fp, ws2_ut(Fp), T32, (P) * 16 + 7); dbg_cksum(Fp, Fp.ws + WS2_WNEG, T32, (P) * 16 + 8); \
    dbg_cksum(Fp, ws2_kt(Fp), T32, (P) * 16 + 9);  GRID_BAR(); \
    p_dn_scan_fast(Fp, args); GRID_BAR(); \
    dbg_cksum(Fp, ws2_ut(Fp), T32, (P) * 16 + 11); GRID_BAR(); \
    p_dn_out_fast(Fp, args); GRID_BAR(); \
    dbg_cksum(Fp, Fp.ws + WS2_YD, T32, (P) * 16 + 12); GRID_BAR(); }
    { DET_PASS(0) }
    { DET_PASS(1) }
    p_hrecompute(F, args); GRID_BAR();
#else
    PROBE_AT(5);
    if (IN(5)) { GEMM(pg8::EpiGen<0>, WS_H, WS_WTB, 4096, DM, WSP(pg8::bf16_t, WS_R1), DM, 1024, (size_t)S * DM, nullptr); if (BOTH(5)) GRID_BAR(); }
    CK(5, F.ws + WS_R1, 4 * T32); CKB();
#if DN2
    PROBE_AT(6);
    if (IN(6)) { ConvHalo hl; p_dn_conv2_halo(F, hl); GRID_BAR(); p_dn_conv2(F, args, hl); if (BOTH(6)) GRID_BAR(); }
    CK(6, F.ws + WS2_QN, 2 * T32); CK(6, F.out, 2 * T32); CKB();
    PROBE_AT(7);
    if (IN(7)) { p_dn_chunk2(F, args); if (BOTH(7)) GRID_BAR(); }
    CK(7, F.ws + WS2_ATT, T32 / 2); CK(7, F.ws + WS2_QN, T32); CK(7, F.out, 2 * T32); CK(7, F.ws + WS2_WNEG, T32); CK(7, F.ws + WS_EGL, 8192); CKB();
#else
    PROBE_AT(6);
    if (IN(6)) { p_dn_conv(F, args); if (BOTH(6)) GRID_BAR(); }
    PROBE_AT(7);
    if (IN(7)) { p_dn_chunk(F, args); if (BOTH(7)) GRID_BAR(); }
#endif
#ifndef DN_FAST
#define DN_FAST 1
#endif
#if DN_FAST
#if DN2
    PROBE_AT(8);
#ifndef SCAN2
#define SCAN2 1
#endif
#if SCAN2
    if (IN(8)) { PROBE_AT(80); p_dn_scan2_A(F, args); GRID_BAR(); PROBE_AT(81); p_dn_scan2_B(F, args); GRID_BAR(); PROBE_AT(82); if (blockIdx.x < 128) p_dn_scan2_C(F, args); else { p_hrecompute_sub(F, args, WSP(bf16, WS2_HALT), ((int)blockIdx.x - 128) * NWAVES + F.wave, 128 * NWAVES);
#if DN2_LATE_WT
            p_wtrans(F, args, WT_ITEMS_EARLY, WT_ITEMS_ALL, ((int)blockIdx.x - 128) * NWAVES + F.wave, 128 * NWAVES);
#endif
        } if (BOTH(8)) GRID_BAR(); PROBE_AT(83); }
#else
    if (IN(8)) { p_dn_scan_fast(F, args); if (BOTH(8)) GRID_BAR(); }
#endif
    CK(8, ws2_ut(F), T32); CKB();
#else
    PROBE_AT(8);
    if (IN(8)) { p_dn_relayout1(F, args); GRID_BAR(); p_dn_relayout2(F, args); GRID_BAR(); p_dn_scan_fast(F, args); if (BOTH(8)) GRID_BAR(); }
#endif
    PROBE_AT(9);
#if DN2 && SCAN2
    if (IN(9)) { p_dn_out_fast(F, args); if (BOTH(9)) GRID_BAR(); }
#else
    if (IN(9)) { p_dn_out_fast(F, args); p_hrecompute(F, args); if (BOTH(9)) GRID_BAR(); }
#endif
    CK(9, F.ws + WS2_YD, T32); CK(9, F.ws + WS_H, T32); CKB();
#else
    PROBE_AT(8);
    if (IN(8)) { p_dn_scan_naive(F, args); if (BOTH(8)) GRID_BAR(); }
    PROBE_AT(9);
    if (IN(9)) { p_dn_out(F, args); p_hrecompute(F, args); if (BOTH(9)) GRID_BAR(); }
#endif
#endif
    PROBE_AT(10);
    if (IN(10)) { GEMM(pg8::EpiGen<1>, WS2_HALT, WS_WTG, 2048, DM, (pg8::bf16_t*)F.out, DM, 1024, (size_t)S * DM, nullptr); if (BOTH(10)) GRID_BAR(); }
    CK(10, F.out, 2 * T32); CKB();
    PROBE_AT(11);
    if (IN(11)) { GEMM(pg8::EpiGen<2>, WS_YA, WS_WTOA, 1024, DM, (pg8::bf16_t*)F.out, DM, 0, 0, nullptr); if (BOTH(11)) GRID_BAR(); }
    CK(11, F.out, T32); CKB();
    PROBE_AT(12);
    if (IN(12)) { GEMM(pg8::EpiGen<3>, SCAN_YD, WS_WTOD, 1024, DM, (pg8::bf16_t*)F.out, DM, 0, 0, (const pg8::bf16_t*)F.out + (size_t)S * DM); if (BOTH(12)) GRID_BAR(); }
    CK(12, F.out, T32); CKB();
    PROBE_AT(13);
    if (IN(13)) { pg8::Gemm g{(const pg8::bf16_t*)F.out, WSP(const pg8::bf16_t, WS_WTOUT), S, DM, DM}; pg8::StaticOrder So; So.init(S, DM, F.G, (int)blockIdx.x);
        pg8::EpiGen<0> E{WSP(pg8::bf16_t, WS_T), DM, 0, 0, nullptr}; pg8::gemm_phase<pg8::EpiGen<0>, pg8::StaticOrder, true, true>(F.lds + RING_OFF, g, So, E); if (BOTH(13)) GRID_BAR(); }
    CK(13, F.ws + WS_T, 2 * T32); CKB();
    PROBE_AT(14);
    if (IN(14)) { p_post_mix(F, args); if (BOTH(14)) GRID_BAR(); }
    CK(14, F.out, 2 * T32); CK(14, F.ws + WS_H2, T32); CKB();
    PROBE_AT(15);
    if (IN(15)) { GEMM(pg8::EpiGen<4>, WS_H2, WS_WTGU, 2 * DFF, DM, WSP(pg8::bf16_t, WS_ACT), DFF, 0, 0, nullptr); if (BOTH(15)) GRID_BAR(); }
    CK(15, F.ws + WS_ACT, ACT_BYTES); CKB();
    PROBE_AT(16);
    if (IN(16)) { pg8::Gemm g{WSP(const pg8::bf16_t, WS_ACT), WSP(const pg8::bf16_t, WS_WTDN), S, DM, DFF}; pg8::StaticOrder So; So.init(S, DM, F.G, (int)blockIdx.x);
        pg8::EpiGen<0> E{WSP(pg8::bf16_t, WS_F), DM, 0, 0, nullptr}; pg8::gemm_phase<pg8::EpiGen<0>, pg8::StaticOrder, true, true>(F.lds + RING_OFF, g, So, E); if (BOTH(16)) GRID_BAR(); }
    CK(16, F.ws + WS_F, 2 * T32); CKB();
#ifdef DBG_TILE
    PROBE_AT(17);
    if (IN(17)) { const unsigned* w = WSP(const unsigned, WS_CTL) + CW_TILE; const unsigned cnt = w[0], mn = w[1]; const unsigned hm = (mn < 256u) ? w[2 + mn] : 0u;
        const int sel = DBG_TILE; const unsigned val = (sel == 1) ? (cnt > 120u ? 120u : cnt) : (sel == 2) ? (mn > 255u ? 127u : (mn >> 1)) : (sel == 3 ? (mn & 1u) * 8u + 0u + (hm & 0xFu) * 0u + (hm & 0xFFu) / 4u : (hm & 3u));
        float pz = __builtin_ldexpf(1.f, (int)val + 4); if (sel == 6) pz = __builtin_ldexpf(1.f, (int)(w[301] & 15u) + 4); if (sel == 7) pz = __builtin_ldexpf(1.f, (int)(w[301] >> 4) + 4); if (sel == 8) pz = __builtin_ldexpf(1.f, (int)(w[302] & 15u) + 4); if (sel == 9) pz = __builtin_ldexpf(1.f, (int)(w[302] >> 4) + 4);
        if (sel == 5) { unsigned be = w[300], lg = 0; while (be > 1u) { be >>= 1; ++lg; } pz = __builtin_ldexpf(1.f, (int)lg + 4); }
        for (size_t i = (size_t)F.gw * 64 + F.lane; i < (size_t)S * DM; i += (size_t)F.NGW * 64) F.out[i] = args.in[0][i] + pz; }
#elif defined(DBG_CHK)
    PROBE_AT(17);
    if (IN(17)) { const long long* sg = (const long long*)(WSP(unsigned, WS_CTL) + CW_CHK); float pz = 0.f;
        for (int k = 12; k >= 9; --k) { const double e2 = (double)sg[2 * k], r2 = (double)sg[2 * k + 1]; if (!(e2 <= 1e-3 * r2 + 16.0)) pz += 1024.f * (float)(1 << (2 * (k - 9))); }
        for (size_t i = (size_t)F.gw * 64 + F.lane; i < (size_t)S * DM; i += (size_t)F.NGW * 64) F.out[i] = args.in[0][i] + pz; }
#elif defined(DBG_SIG)
    PROBE_AT(17);
    if (IN(17)) { const long long* sg = (const long long*)(WSP(unsigned, WS_CTL) + CW_SIG); float pz = 0.f;
        for (int k = 4; k >= 0; --k) { const float a0 = (float)((double)sg[2 * k] / 65536.0), a1 = (float)((double)sg[2 * (8 + k)] / 65536.0), n0 = (float)((double)sg[2 * k + 1] / 65536.0), n1 = (float)((double)sg[2 * (8 + k) + 1] / 65536.0);
            const bool bad = !(fabsf(a0 - a1) <= 0.02f * sqrtf(n0) + 1e-3f) || !(fabsf(n0 - n1) <= 0.02f * (n0 + n1)); if (bad) pz = __builtin_ldexpf(1.f, 40 - 2 * k); }
        for (size_t i = (size_t)F.gw * 64 + F.lane; i < (size_t)S * DM; i += (size_t)F.NGW * 64) F.out[i] = args.in[0][i] + pz; }
#elif defined(DBG_DET)
    PROBE_AT(17);
    if (IN(17)) { const unsigned* cs = WSP(const unsigned, WS_CTL) + CW_CS; float pz = 0.f;
#ifdef DBG_NANCNT
        for (int k = 12; k >= 0; --k) if (cs[k] != 0u) pz = __builtin_ldexpf(1.f, 40 - 2 * k);
#else
        for (int k = 12; k >= 0; --k) if (cs[k] != cs[16 + k]) pz = __builtin_ldexpf(1.f, 40 - 2 * k);
#endif
        for (size_t i = (size_t)F.gw * 64 + F.lane; i < (size_t)S * DM; i += (size_t)F.NGW * 64) F.out[i] = args.in[0][i] + pz; }
#else
    PROBE_AT(17);
    if (IN(17)) { p_final(F, args); }
#endif
#ifdef WGSTAT
    if (blockIdx.x == 0 && F.tid == 0) { const unsigned* w_ = WSP(const unsigned, WS_CTL) + 30000; const unsigned v0 = __hip_atomic_load(w_, __ATOMIC_RELAXED, __HIP_MEMORY_SCOPE_AGENT), v1 = __hip_atomic_load(w_ + 1, __ATOMIC_RELAXED, __HIP_MEMORY_SCOPE_AGENT), v2 = __hip_atomic_load(w_ + 2, __ATOMIC_RELAXED, __HIP_MEMORY_SCOPE_AGENT);
        const unsigned long long dd = 8ull * (unsigned long long)(WGSTAT == 1 ? v0 : (WGSTAT == 2 ? v1 / (unsigned)F.G : 0xFFFFFFFFu - v2));
        const unsigned long long ts = __builtin_amdgcn_s_memrealtime(); while (__builtin_amdgcn_s_memrealtime() - ts < dd) __builtin_amdgcn_s_sleep(8); }
#endif
#ifdef SCAN_PROBE
    __syncthreads();
    if (blockIdx.x == 0 && F.tid == 0) { const unsigned long long ts = __builtin_amdgcn_s_memrealtime(); const unsigned long long dd = 8ull * (unsigned long long)F.MISC[16]; while (__builtin_amdgcn_s_memrealtime() - ts < dd) __builtin_amdgcn_s_sleep(8); }
#endif
#ifdef PROBE_LO
    PROBE_AT(18);
    if (blockIdx.x == 0 && F.tid == 0) { const unsigned long long ts = __builtin_amdgcn_s_memrealtime(); while (__builtin_amdgcn_s_memrealtime() - ts < 8ull * pr_dt) __builtin_amdgcn_s_sleep(8); }
#endif
#ifdef DBG_L2L
    GRID_BAR(); CK(17, F.out, 2 * T32); GRID_BAR();
    { unsigned* cs = WSP(unsigned, WS_CTL) + CW_CS; unsigned* save = WSP(unsigned, 253 * MiB);
      if (args.pass == 0) { if (blockIdx.x == 0 && F.tid < 32) save[F.tid] = cs[F.tid]; }
      else { float pz = 0.f; for (int k = 17; k >= 0; --k) if (cs[k] != save[k]) pz = __builtin_ldexpf(1.f, 44 - 2 * k);
          if (pz != 0.f) for (size_t i = (size_t)F.gw * 64 + F.lane; i < (size_t)S * DM; i += (size_t)F.NGW * 64) F.out[i] += pz; } }
#endif
#undef IN
#undef BOTH
}

extern "C" void kernel_launch(void* const* d_in, const int* in_sizes, int n_in, void* d_out, int out_size, void* d_ws, size_t ws_size, hipStream_t stream) {
    static int grid = 0;
    if (grid == 0) {
        if (n_in != 16 || in_sizes[0] != S * DM || out_size != S * DM || ws_size < WS_END) { fprintf(stderr, "kernel_launch: unexpected shapes (n_in %d, in0 %d, out %d, ws %zu); nothing launched\n", n_in, n_in > 0 ? in_sizes[0] : -1, out_size, ws_size); grid = -1; return; }
        int dev = 0, cus = 0, per_cu = 0;
        if (hipGetDevice(&dev) != hipSuccess || hipDeviceGetAttribute(&cus, hipDeviceAttributeMultiprocessorCount, dev) != hipSuccess) { grid = -1; return; }
        if (hipFuncSetAttribute((const void*)fwd, hipFuncAttributeMaxDynamicSharedMemorySize, LDS_BYTES) != hipSuccess) { fprintf(stderr, "kernel_launch: hipFuncSetAttribute failed\n"); grid = -1; return; }
        if (hipOccupancyMaxActiveBlocksPerMultiprocessor(&per_cu, (const void*)fwd, NWAVES * 64, LDS_BYTES) != hipSuccess || per_cu < 1) fprintf(stderr, "kernel_launch: occupancy query says %d\n", per_cu);
        (void)hipGetLastError();
        grid = cus;
    }
    if (grid < 0) return;
    if (hipMemsetAsync((char*)d_ws + WS_CTL, 0, CTL_ZERO_BYTES, stream) != hipSuccess) return;
    Args a{};
    for (int i = 0; i < 16; ++i) a.in[i] = (const float*)d_in[i];
    a.out = (float*)d_out; a.ws = (unsigned char*)d_ws;
#ifdef DBG_L2L
    hipMemsetAsync((char*)d_ws + CTL_ZERO_BYTES, 0xA5, WS_END - CTL_ZERO_BYTES, stream); hipMemsetAsync(d_out, 0xA5, (size_t)S * DM * 4, stream);
    for (int li = 0; li < 2; ++li) {
        if (li == 1) hipMemsetAsync((char*)d_ws + WS_CTL, 0, CTL_ZERO_BYTES, stream);
        a.ph_lo = 0; a.ph_hi = NPHASE; a.pass = li;
#else
    for (int li = 0; li < N_LAUNCHES; ++li) {
        a.ph_lo = (N_LAUNCHES == 1) ? 0 : li; a.ph_hi = (N_LAUNCHES == 1) ? NPHASE : li + 1;
#endif
        hipLaunchKernelGGL(fwd, dim3(grid), dim3(NWAVES * 64), LDS_BYTES, stream, a);
        if (hipPeekAtLastError() != hipSuccess) { fprintf(stderr, "kernel_launch: launch %d failed\n", li); break; }
    }
}
```

```cpp
#include <hip/hip_runtime.h>
#include <cstdio>
#include <cstdint>
#include <cmath>
namespace pg8 {
#define PG8_LAS __attribute__((address_space(3)))
typedef unsigned short bf16_t;
typedef short bf16x8 __attribute__((ext_vector_type(8)));
typedef float f32x4 __attribute__((ext_vector_type(4)));
typedef unsigned u32x4 __attribute__((ext_vector_type(4)));
constexpr int BM = 256, BK = 64, HALF = 128, HTB = HALF * BK * 2  , STAGE_BYTES = 8 * HTB, NXCD = 8, WGM = 8;

__host__ __device__ __forceinline__ int lds_byte(int r, int c) { const int st = (r >> 4) * 2 + (c >> 5), rr = r & 15, cc = c & 31, ob = rr * 64 + cc * 2; return st * 1024 + (ob ^ (((ob >> 9) & 1) << 5)); }
__host__ __device__ __forceinline__ void stage_rc(int b, int& R, int& C) { const int st = b / 1024, sb = b % 1024, swz = sb ^ (((sb >> 9) & 1) << 5); R = (st >> 1) * 16 + swz / 64; C = (st & 1) * 32 + (swz % 64) / 2; }
__host__ __device__ __forceinline__ int perm32(int rho) { const int n = rho >> 4, i = rho & 15; return 8 * (i >> 2) + 4 * n + (i & 3); }

struct Unit { int pm, pn; };
struct Gemm { const bf16_t* A; const bf16_t* Bt; int M, N, K; };

struct StaticOrder {
    int nM, nN, nwg, G, c;
    __host__ __device__ void init(int M, int N, int G_, int c_) { nM = M / BM; nN = N / BM; nwg = nM * nN; G = G_; c = c_; }
    __host__ __device__ bool next(int i, Unit& u) const {
        const long L = (long)i * G + c; if (L >= nwg) return false;
        int wgid = (int)L; { const int q = nwg / NXCD, r = nwg % NXCD, xcd = wgid % NXCD, off = wgid / NXCD; wgid = (xcd < r ? xcd * (q + 1) : r * (q + 1) + (xcd - r) * q) + off; }
        const int nig = WGM * nN, gid = wgid / nig, fm = gid * WGM, gsz = (nM - fm) < WGM ? (nM - fm) : WGM;
        u.pm = fm + ((wgid % nig) % gsz); u.pn = (wgid % nig) / gsz; return true;
    }
    __device__ __forceinline__ void a_ready(const Unit&) const {}
    __device__ __forceinline__ void done(const Unit&) const {}
};

__device__ __forceinline__ unsigned cvt_pk_bf16(float lo, float hi) { typedef __bf16 b2 __attribute__((ext_vector_type(2))); typedef float f2 __attribute__((ext_vector_type(2))); const f2 v = {lo, hi}; return __builtin_bit_cast(unsigned, __builtin_convertvector(v, b2)); }
template <class Epi, class Sched, bool ALIGN_EPI = false, bool SP2 = false>
__device__ __forceinline__ void gemm_phase(PG8_LAS unsigned char* lds, const Gemm g, const Sched& S, const Epi& E) {
    const int tid = threadIdx.x, wid = __builtin_amdgcn_readfirstlane(tid >> 6), lane = tid & 63, wr = wid >> 2, wc = wid & 3, fr = lane & 15, fq = lane >> 4;
    const int K = g.K, nt = K / BK;
    unsigned voffA[2], voffB[2];
#pragma unroll
    for (int i = 0; i < 2; ++i) { int R, C; stage_rc(tid * 16 + i * 8192, R, C); const int Rb = Epi::PERM ? ((R & ~31) + perm32(R & 31)) : R;
        voffA[i] = (unsigned)(R * K + C) * 2u; voffB[i] = (unsigned)(Rb * K + C) * 2u; }
    const size_t kstep = (size_t)(BK * 2);
    const size_t hstep = (size_t)HALF * K * 2;
    const size_t tstep = 2 * hstep;
    const unsigned ldsw = (unsigned)wid * 1024u;
    const int aoff = lds_byte(wr * 64 + fr, fq * 8), boff = lds_byte(wc * 32 + fr, fq * 8);
#define PG8_SA(b, h) (((b) * 2 + (h)) * HTB)
#define PG8_SB(b, h) ((4 + (b) * 2 + (h)) * HTB)
#define PG8_STAGE(bufoff, gbase, voff) do { _Pragma("unroll") for (int _i = 0; _i < 2; ++_i) \
        __builtin_amdgcn_global_load_lds((const unsigned*)((const char*)(gbase) + (voff)[_i]), (PG8_LAS unsigned*)(lds + (bufoff) + ldsw + _i * 8192), 16, 0, 0); } while (0)
#define PG8_LDA(dst, b, h) do { _Pragma("unroll") for (int m = 0; m < 4; ++m) _Pragma("unroll") for (int k = 0; k < 2; ++k) dst[m][k] = *(const PG8_LAS bf16x8*)(lds + PG8_SA(b, h) + aoff + m * 2048 + k * 1024); } while (0)
#define PG8_LDB(dst, b, h) do { _Pragma("unroll") for (int n = 0; n < 2; ++n) _Pragma("unroll") for (int k = 0; k < 2; ++k) dst[n][k] = *(const PG8_LAS bf16x8*)(lds + PG8_SB(b, h) + boff + n * 2048 + k * 1024); } while (0)
#define PG8_MMA(ai, bj, At, Bt) do { __builtin_amdgcn_s_setprio(1); _Pragma("unroll") for (int m = 0; m < 4; ++m) _Pragma("unroll") for (int n = 0; n < 2; ++n) _Pragma("unroll") for (int k = 0; k < 2; ++k) \
        acc[ai][bj][m][n] = __builtin_amdgcn_mfma_f32_16x16x32_bf16(Bt[n][k], At[m][k], acc[ai][bj][m][n], 0, 0, 0); __builtin_amdgcn_s_setprio(0); } while (0)
#define PG8_WAIT_V(n) asm volatile("s_waitcnt vmcnt(" #n ")" ::: "memory")
#define PG8_WAIT_L(n) asm volatile("s_waitcnt lgkmcnt(" #n ")" ::: "memory")
#define PG8_BAR __builtin_amdgcn_s_barrier()
#define PG8_SCHED __builtin_amdgcn_sched_barrier(0)
    Unit cur, nxt; int ui = 0;
    if (!S.next(0, cur)) return;
    f32x4 acc[2][2][4][2];
#pragma unroll
    for (int a = 0; a < 2; ++a)
#pragma unroll
        for (int b = 0; b < 2; ++b)
#pragma unroll
            for (int m = 0; m < 4; ++m)
#pragma unroll
                for (int n = 0; n < 2; ++n) acc[a][b][m][n] = (f32x4){0.f, 0.f, 0.f, 0.f};
    bf16x8 At[4][2], B0[2][2], B1[2][2];
    const char* cA = (const char*)g.A + (size_t)cur.pm * tstep; const char* cB = (const char*)g.Bt + (size_t)cur.pn * tstep;
    S.a_ready(cur);
    if constexpr (SP2) {
        PG8_STAGE(PG8_SB(0, 0), cB, voffB); PG8_STAGE(PG8_SB(0, 1), cB + hstep, voffB); PG8_STAGE(PG8_SA(0, 0), cA, voffA); PG8_STAGE(PG8_SA(0, 1), cA + hstep, voffA);
        if (wr == 1) PG8_BAR;
        PG8_WAIT_V(2); PG8_BAR;
        PG8_STAGE(PG8_SB(1, 0), cB + kstep, voffB); PG8_STAGE(PG8_SA(1, 0), cA + kstep, voffA); PG8_STAGE(PG8_SB(1, 1), cB + hstep + kstep, voffB);
        PG8_WAIT_V(6); PG8_BAR;
    } else {
        PG8_STAGE(PG8_SB(0, 0), cB, voffB); PG8_STAGE(PG8_SA(0, 0), cA, voffA); PG8_STAGE(PG8_SB(0, 1), cB + hstep, voffB); PG8_STAGE(PG8_SA(0, 1), cA + hstep, voffA);
        if (wr == 1) PG8_BAR;
        PG8_WAIT_V(4); PG8_BAR;
        PG8_STAGE(PG8_SB(1, 0), cB + kstep, voffB); PG8_STAGE(PG8_SA(1, 0), cA + kstep, voffA); PG8_STAGE(PG8_SB(1, 1), cB + hstep + kstep, voffB);
        PG8_WAIT_V(6); PG8_BAR;
    }
    for (;;) {
        const bool has_next = S.next(ui + 1, nxt);
        const char* nA = has_next ? (const char*)g.A + (size_t)nxt.pm * tstep : cA; const char* nB = has_next ? (const char*)g.Bt + (size_t)nxt.pn * tstep : cB;
        for (int t = 0; t < nt; t += 2) {
            const bool last = (t == nt - 2);
            const char* a1 = cA + (size_t)(t + 1) * kstep;
            const char* a2 = last ? nA : cA + (size_t)(t + 2) * kstep; const char* b2 = last ? nB : cB + (size_t)(t + 2) * kstep;
            const char* a3 = a2 + kstep; const char* b3 = b2 + kstep;
            if (last && has_next) S.a_ready(nxt);
            if constexpr (SP2) {
            PG8_LDB(B0, 0, 0); PG8_LDB(B1, 0, 1); PG8_SCHED; PG8_LDA(At, 0, 0); PG8_STAGE(PG8_SA(1, 1), a1 + hstep, voffA);
            PG8_WAIT_V(8); PG8_WAIT_L(0); PG8_BAR; PG8_MMA(0, 0, At, B0); PG8_MMA(0, 1, At, B1); PG8_BAR; PG8_SCHED;
            PG8_LDA(At, 0, 1); PG8_STAGE(PG8_SB(0, 0), b2, voffB); PG8_STAGE(PG8_SB(0, 1), b2 + hstep, voffB); PG8_STAGE(PG8_SA(0, 0), a2, voffA);
            PG8_WAIT_V(8); PG8_WAIT_L(0); PG8_BAR; PG8_MMA(1, 0, At, B0); PG8_MMA(1, 1, At, B1); PG8_BAR; PG8_SCHED;
            PG8_LDB(B0, 1, 0); PG8_LDB(B1, 1, 1); PG8_SCHED; PG8_LDA(At, 1, 0); PG8_STAGE(PG8_SA(0, 1), a2 + hstep, voffA);
            PG8_WAIT_V(8); PG8_WAIT_L(0); PG8_BAR; PG8_MMA(0, 0, At, B0); PG8_MMA(0, 1, At, B1); PG8_BAR; PG8_SCHED;
            PG8_LDA(At, 1, 1); PG8_STAGE(PG8_SB(1, 0), b3, voffB); PG8_STAGE(PG8_SB(1, 1), b3 + hstep, voffB); PG8_STAGE(PG8_SA(1, 0), a3, voffA);
            PG8_WAIT_V(8); PG8_WAIT_L(0); PG8_BAR; PG8_MMA(1, 0, At, B0); PG8_MMA(1, 1, At, B1); PG8_BAR; PG8_SCHED;
            } else {
            PG8_LDB(B0, 0, 0); PG8_SCHED; PG8_LDA(At, 0, 0); PG8_STAGE(PG8_SA(1, 1), a1 + hstep, voffA);
            PG8_WAIT_L(8); PG8_BAR; PG8_WAIT_L(0); PG8_MMA(0, 0, At, B0); PG8_BAR; PG8_SCHED;
            PG8_LDB(B1, 0, 1); PG8_STAGE(PG8_SB(0, 0), b2, voffB);
            PG8_BAR; PG8_WAIT_L(0); PG8_MMA(0, 1, At, B1); PG8_BAR;
            PG8_LDA(At, 0, 1); PG8_STAGE(PG8_SA(0, 0), a2, voffA);
            PG8_BAR; PG8_WAIT_L(0); PG8_MMA(1, 0, At, B0); PG8_BAR; PG8_SCHED;
            PG8_STAGE(PG8_SB(0, 1), b2 + hstep, voffB);
            PG8_WAIT_V(6); PG8_BAR; PG8_MMA(1, 1, At, B1); PG8_BAR;
            PG8_LDB(B0, 1, 0); PG8_SCHED; PG8_LDA(At, 1, 0); PG8_STAGE(PG8_SA(0, 1), a2 + hstep, voffA);
            PG8_WAIT_L(8); PG8_BAR; PG8_WAIT_L(0); PG8_MMA(0, 0, At, B0); PG8_BAR; PG8_SCHED;
            PG8_LDB(B1, 1, 1); PG8_STAGE(PG8_SB(1, 0), b3, voffB);
            PG8_BAR; PG8_WAIT_L(0); PG8_MMA(0, 1, At, B1); PG8_BAR;
            PG8_LDA(At, 1, 1); PG8_STAGE(PG8_SA(1, 0), a3, voffA);
            PG8_BAR; PG8_WAIT_L(0); PG8_MMA(1, 0, At, B0); PG8_BAR; PG8_SCHED;
            PG8_STAGE(PG8_SB(1, 1), b3 + hstep, voffB);
            PG8_WAIT_V(6); PG8_BAR; PG8_MMA(1, 1, At, B1); PG8_BAR;
            }
        }
        if constexpr (ALIGN_EPI) { if (wr == 0) PG8_BAR; }
        if constexpr (!Epi::AFTER_DRAIN) { E(acc, cur, wr, wc, fr, fq); S.done(cur); }
        if (!has_next) break;
#pragma unroll
        for (int a = 0; a < 2; ++a)
#pragma unroll
            for (int b = 0; b < 2; ++b)
#pragma unroll
                for (int m = 0; m < 4; ++m)
#pragma unroll
                    for (int n = 0; n < 2; ++n) acc[a][b][m][n] = (f32x4){0.f, 0.f, 0.f, 0.f};
        cur = nxt; cA = nA; cB = nB; ++ui;
        if constexpr (ALIGN_EPI) { if (wr == 1) PG8_BAR; }
    }
    PG8_WAIT_V(0);
    if constexpr (!ALIGN_EPI) { if (wr == 0) PG8_BAR; }
    PG8_BAR;
    if constexpr (Epi::AFTER_DRAIN) { E.fused(acc, cur, wr, wc, fr, fq, lds, wid, lane); S.done(cur); }
#undef PG8_SA
#undef PG8_SB
#undef PG8_STAGE
#undef PG8_LDA
#undef PG8_LDB
#undef PG8_MMA
#undef PG8_WAIT_V
#undef PG8_WAIT_L
#undef PG8_BAR
#undef PG8_SCHED
}
}
#define GAS __attribute__((address_space(1)))
#define LAS __attribute__((address_space(3)))
typedef unsigned short bf16;
typedef unsigned v4u __attribute__((ext_vector_type(4)));
typedef float f32x4 __attribute__((ext_vector_type(4)));
typedef short bf16x8 __attribute__((ext_vector_type(8)));
typedef GAS unsigned gu32;
typedef GAS unsigned long long gu64;
#define RLX_AGENT __ATOMIC_RELAXED, __HIP_MEMORY_SCOPE_AGENT
#define LDS_WAIT() asm volatile("s_waitcnt lgkmcnt(0)" ::: "memory")
#define VM_WAIT() asm volatile("s_waitcnt vmcnt(0)" ::: "memory")
__device__ __forceinline__ unsigned long long rt() { return __builtin_amdgcn_s_memrealtime(); }
typedef __bf16 hbf2_t __attribute__((ext_vector_type(2)));
typedef float hf2_t __attribute__((ext_vector_type(2)));
__device__ __forceinline__ unsigned pk2(float lo, float hi) { const hf2_t v = {lo, hi}; return __builtin_bit_cast(unsigned, __builtin_convertvector(v, hbf2_t)); }
__device__ __forceinline__ unsigned f2bf(float f) { return pk2(f, 0.f) & 0xffffu; }

#define XB_TMO      128
#define XB_XCNT(j)  (256  + 64 * (j))
#define XB_XSUB(j)  (1280 + 64 * (j))
#define XB_XGEN(j)  (2304 + 64 * (j))
#define XB_TOP      3328
#define XB_TOPGEN   3392
#define XCD_BAR_WORDS 3456
#define XB_SPIN_CAP (1u << 22)

__device__ __forceinline__ unsigned xb_ld(unsigned* p)              { return __hip_atomic_load(p, __ATOMIC_RELAXED, __HIP_MEMORY_SCOPE_AGENT); }
__device__ __forceinline__ unsigned xb_add(unsigned* p, unsigned v) { return __hip_atomic_fetch_add(p, v, __ATOMIC_RELAXED, __HIP_MEMORY_SCOPE_AGENT); }
__device__ __forceinline__ unsigned xb_xcc_id() { return (unsigned)__builtin_amdgcn_s_getreg((3 << 11) | 20) & 0xFu; }
#define XB_SPIN(cond, bar) do { unsigned _sp = 0; while (cond) { __builtin_amdgcn_s_sleep(1); \
    if ((++_sp & 255u) == 0u) { if (xb_ld(&(bar)[XB_TMO])) break; if (_sp > XB_SPIN_CAP) { atomicAdd(&(bar)[XB_TMO], 1u); break; } } } } while (0)

struct XcdBarrier {
    unsigned* bar; unsigned x;
    volatile LAS unsigned* st;
};

__device__ __forceinline__ XcdBarrier xcd_barrier_post(unsigned* bar, volatile LAS unsigned* st) {
    XcdBarrier b; b.bar = bar; b.x = xb_xcc_id(); b.st = st;
    if (threadIdx.x == 0) (void)xb_add(&bar[XB_XCNT(b.x)], 1u);
    return b;
}
__device__ __forceinline__ void xcd_barrier_complete(unsigned* bar, unsigned x, unsigned& nloc, unsigned& nx) {
    const unsigned G = gridDim.x * gridDim.y * gridDim.z;
    unsigned sum, cnt, mine, sp = 0u;
    for (;;) {
        sum = 0u; cnt = 0u; mine = 0u;
#pragma unroll
        for (unsigned j = 0; j < 16; ++j) { const unsigned c = xb_ld(&bar[XB_XCNT(j)]); sum += c; cnt += (c > 0u) ? 1u : 0u; mine = (j == x) ? c : mine; }
        if (sum == G) break;
        __builtin_amdgcn_s_sleep(1);
        if ((++sp & 255u) == 0u) { if (xb_ld(&bar[XB_TMO])) break; if (sp > XB_SPIN_CAP) { atomicAdd(&bar[XB_TMO], 1u); break; } }
    }
    nloc = mine > 0u ? mine : 1u; nx = cnt > 0u ? cnt : 1u;
}

__device__ __forceinline__ void xcd_barrier(const XcdBarrier& b) {
    asm volatile("s_waitcnt vmcnt(0)" ::: "memory");
    __syncthreads();
    if (threadIdx.x == 0) {
        unsigned* bar = b.bar;
        __builtin_amdgcn_s_waitcnt(0);
        unsigned nloc = b.st[0], nx = b.st[1];
        if (nloc == 0u) { xcd_barrier_complete(bar, b.x, nloc, nx); b.st[0] = nloc; b.st[1] = nx; }
        const unsigned old = xb_add(&bar[XB_XSUB(b.x)], 1u);
        const unsigned gen = old / nloc;
        if (old + 1u == (gen + 1u) * nloc) {
            __builtin_amdgcn_fence(__ATOMIC_RELEASE, "agent");
            asm volatile("s_waitcnt vmcnt(0)" ::: "memory");
            const unsigned og = xb_add(&bar[XB_TOP], 1u);
            const unsigned tg = og / nx;
            if (og + 1u == (tg + 1u) * nx) xb_add(&bar[XB_TOPGEN], 1u);
            else XB_SPIN(xb_ld(&bar[XB_TOPGEN]) == tg, bar);
            __builtin_amdgcn_fence(__ATOMIC_ACQUIRE, "agent");
            xb_add(&bar[XB_XGEN(b.x)], 1u);
            asm volatile("s_waitcnt vmcnt(0)" ::: "memory");
        } else {
            XB_SPIN(xb_ld(&bar[XB_XGEN(b.x)]) == gen, bar);
            __builtin_amdgcn_fence(__ATOMIC_ACQUIRE, "agent");
            asm volatile("s_waitcnt vmcnt(0)" ::: "memory");
        }
    }
    __syncthreads();
}

constexpr int S = 16384, DM = 1024, NH = 8, HD = 128, MBLK = 256, NBLK = S / MBLK, DFF = 2816, INTOT = 9232;
constexpr int CH = 64, NCH = S / CH;
constexpr float EPS = 1e-6f;
constexpr int NWAVES = 8;
#ifndef DN2_LATE_WT
#define DN2_LATE_WT 1
#endif

constexpr size_t MiB = 1u << 20;
constexpr size_t WS_CTL = 0, CTL_ZERO_BYTES = 1 * MiB;
constexpr size_t WS_COS = 1 * MiB, WS_SIN = 2 * MiB;
constexpr size_t WS_BA = 3 * MiB;
constexpr size_t WS_KMEAN = 4 * MiB;
constexpr size_t WS_TOPI = 5 * MiB;
constexpr size_t WS_BETA = 6 * MiB + 512 * 1024, WS_G = 7 * MiB, WS_GC = 7 * MiB + 512 * 1024;
constexpr size_t WS_WTA = 8 * MiB, WS_WTB = 14 * MiB, WS_WTG = 22 * MiB, WS_WTOA = 26 * MiB, WS_WTOD = 28 * MiB, WS_WTOUT = 30 * MiB, WS_WTGU = 32 * MiB, WS_WTDN = 43 * MiB;
constexpr size_t WS_H = 49 * MiB;
constexpr size_t WS_R1 = 81 * MiB;
constexpr size_t WS_Z = 177 * MiB, WS_YA = 209 * MiB, WS_END = 256 * MiB;
constexpr size_t ACT_BYTES = (size_t)S * DFF * 2;
constexpr size_t T32 = (size_t)S * DM * 2;
static_assert(WS_WTDN + (size_t)DM * DFF * 2 <= WS_H && WS_YA + T32 <= WS_END && WS_R1 + 3 * T32 == WS_Z, "ws map");
constexpr size_t WS_VN = WS_H;
constexpr size_t WS_W = WS_R1, WS_ATT = WS_R1 + T32, WS_O = WS_R1 + T32 + 16 * MiB, WS_YD = WS_R1;
constexpr size_t WS_T = 113 * MiB, WS_H2 = WS_H, WS_ACT = 81 * MiB, WS_F = 169 * MiB;
static_assert(WS_ACT + ACT_BYTES <= WS_F && WS_F + 2 * T32 <= WS_END && WS_O + T32 <= WS_Z && WS_T + 2 * T32 <= WS_Z, "overlay map");
constexpr int CW_BAR = 4096;

constexpr int RING_OFF = 0, RING_BYTES = 131072;
constexpr int LDS_BYTES = 163840;
constexpr int LDSCTL_OFF = LDS_BYTES - 4096, MISC_OFF = LDSCTL_OFF + 320;

typedef unsigned u32x4 __attribute__((ext_vector_type(4)));
typedef unsigned u32x2 __attribute__((ext_vector_type(2)));

__device__ __forceinline__ float bflo(unsigned u) { return __builtin_bit_cast(float, u << 16); }
__device__ __forceinline__ float bfhi(unsigned u) { return __builtin_bit_cast(float, u & 0xffff0000u); }
__device__ __forceinline__ float bf2f(bf16 b) { return __builtin_bit_cast(float, ((unsigned)b) << 16); }
__device__ __forceinline__ float wave_sum(float v) {
#define WS_DPP(ctrl) v += __builtin_bit_cast(float, __builtin_amdgcn_update_dpp(0, __builtin_bit_cast(int, v), (ctrl), 0xF, 0xF, true))
    WS_DPP(0xB1); WS_DPP(0x4E); WS_DPP(0x141); WS_DPP(0x140);
#undef WS_DPP
    const float s0 = __builtin_bit_cast(float, __builtin_amdgcn_readlane(__builtin_bit_cast(int, v), 0)), s1 = __builtin_bit_cast(float, __builtin_amdgcn_readlane(__builtin_bit_cast(int, v), 16));
    const float s2 = __builtin_bit_cast(float, __builtin_amdgcn_readlane(__builtin_bit_cast(int, v), 32)), s3 = __builtin_bit_cast(float, __builtin_amdgcn_readlane(__builtin_bit_cast(int, v), 48));
    return (s0 + s1) + (s2 + s3);
}
__device__ __forceinline__ float wave_max(float v) {
#pragma unroll
    for (int o = 1; o < 64; o <<= 1) v = fmaxf(v, __shfl_xor(v, o));
    return v;
}
__device__ __forceinline__ float rcp_(float x) { return __builtin_amdgcn_rcpf(x); }
__device__ __forceinline__ float rsq_(float x) { return __builtin_amdgcn_rsqf(x); }
__device__ __forceinline__ float sigmoidf_(float x) { return rcp_(1.f + __expf(-x)); }
__device__ __forceinline__ float siluf_(float x) { return x * rcp_(1.f + __expf(-x)); }
__device__ __forceinline__ float sigmoidf_e(float x) { return sigmoidf_(x); }
__device__ __forceinline__ float siluf_e(float x) { return siluf_(x); }

namespace pg8 {
struct EpiRope {
    static constexpr bool PERM = false, AFTER_DRAIN = false;
    bf16_t* base; const float* cosT; const float* sinT; float* kpart;
    __device__ __forceinline__ void operator()(const f32x4 (&acc)[2][2][4][2], const Unit& u, int wr, int wc, int fr, int fq) const {
        const int t = u.pn >> 2, pnl = u.pn & 3;
        bf16_t* ob = base + (size_t)t * ((size_t)S * DM);
        const bool rope = (t < 2) && (wc == 0);
        f32x4 cs[2][2];
#pragma unroll
        for (int bj = 0; bj < 2; ++bj)
#pragma unroll
            for (int n = 0; n < 2; ++n) cs[bj][n] = (f32x4){0.f, 0.f, 0.f, 0.f};
#pragma unroll
        for (int ai = 0; ai < 2; ++ai)
#pragma unroll
            for (int m = 0; m < 4; ++m) {
                const int row = u.pm * BM + ai * HALF + wr * 64 + m * 16 + fr;
                f32x4 cv = (f32x4){1.f, 1.f, 1.f, 1.f}, sv = (f32x4){0.f, 0.f, 0.f, 0.f};
                if (rope) { cv = *(const f32x4*)(cosT + (size_t)row * 16 + 4 * fq); sv = *(const f32x4*)(sinT + (size_t)row * 16 + 4 * fq); }
#pragma unroll
                for (int bj = 0; bj < 2; ++bj) {
                    f32x4 v0 = acc[ai][bj][m][0], v1 = acc[ai][bj][m][1];
                    if (rope) { const f32x4 n0 = v0 * cv - v1 * sv, n1 = v1 * cv + v0 * sv; v0 = n0; v1 = n1; }
                    cs[bj][0] = cs[bj][0] + v0; cs[bj][1] = cs[bj][1] + v1;
                    bf16_t* p = ob + (size_t)row * DM + pnl * 256 + bj * HALF + wc * 32 + 4 * fq;
                    u32x2 w0, w1; w0.x = cvt_pk_bf16(v0[0], v0[1]); w0.y = cvt_pk_bf16(v0[2], v0[3]); w1.x = cvt_pk_bf16(v1[0], v1[1]); w1.y = cvt_pk_bf16(v1[2], v1[3]);
                    *(u32x2*)p = w0; *(u32x2*)(p + 16) = w1;
                }
            }
        if (t == 1) {
#pragma unroll
            for (int bj = 0; bj < 2; ++bj)
#pragma unroll
                for (int n = 0; n < 2; ++n) { f32x4 s = cs[bj][n];
#pragma unroll
                    for (int o = 1; o < 16; o <<= 1) { s.x += __shfl_xor(s.x, o); s.y += __shfl_xor(s.y, o); s.z += __shfl_xor(s.z, o); s.w += __shfl_xor(s.w, o); }
                    if (fr == 0) *(f32x4*)(kpart + ((size_t)(u.pm * 2 + wr) * NH + 2 * pnl + bj) * HD + wc * 32 + 16 * n + 4 * fq) = s; } }
    }
};
template <int MODE> struct EpiGen {
    static constexpr bool PERM = true, AFTER_DRAIN = false;
    bf16_t* O; int ldc; int split_cols; size_t split_stride; const bf16_t* G2;
    __device__ __forceinline__ static void unpack8(const u32x4 w, float (&f)[8]) {
        f[0] = bflo(w.x); f[1] = bfhi(w.x); f[2] = bflo(w.y); f[3] = bfhi(w.y); f[4] = bflo(w.z); f[5] = bfhi(w.z); f[6] = bflo(w.w); f[7] = bfhi(w.w);
    }
    __device__ __forceinline__ void operator()(const f32x4 (&acc)[2][2][4][2], const Unit& u, int wr, int wc, int fr, int fq) const {
        const int row0 = u.pm * BM + wr * 64 + fr; int colt = u.pn * BM; bf16_t* base = O; const bf16_t* g2 = G2;
        if (split_cols) { const int t = colt / split_cols; base += (size_t)t * split_stride; colt -= t * split_cols; }
#pragma unroll
        for (int ai = 0; ai < 2; ++ai)
#pragma unroll
            for (int m = 0; m < 4; ++m) {
                const int row = row0 + ai * HALF + m * 16;
                if constexpr (MODE == 4) {
                    const f32x4 g0 = acc[ai][0][m][0], g1 = acc[ai][0][m][1], u0 = acc[ai][1][m][0], u1 = acc[ai][1][m][1];
                    float r[8];
#pragma unroll
                    for (int e = 0; e < 4; ++e) { r[e] = siluf_e(g0[e]) * u0[e]; r[4 + e] = siluf_e(g1[e]) * u1[e]; }
                    u32x4 w; w.x = cvt_pk_bf16(r[0], r[1]); w.y = cvt_pk_bf16(r[2], r[3]); w.z = cvt_pk_bf16(r[4], r[5]); w.w = cvt_pk_bf16(r[6], r[7]);
                    *(u32x4*)(base + (size_t)row * ldc + u.pn * HALF + wc * 32 + 8 * fq) = w;
                } else {
#pragma unroll
                    for (int bj = 0; bj < 2; ++bj) {
                        const f32x4 v0 = acc[ai][bj][m][0], v1 = acc[ai][bj][m][1];
                        float r[8] = {v0[0], v0[1], v0[2], v0[3], v1[0], v1[1], v1[2], v1[3]};
                        bf16_t* p = base + (size_t)row * ldc + colt + bj * HALF + wc * 32 + 8 * fq;
                        if constexpr (MODE == 1) {
#pragma unroll
                            for (int e = 0; e < 8; ++e) r[e] = sigmoidf_e(r[e]);
                        }
                        if constexpr (MODE == 2) { float g[8]; unpack8(*(const u32x4*)p, g);
#pragma unroll
                            for (int e = 0; e < 8; ++e) r[e] = r[e] * g[e]; }
                        if constexpr (MODE == 3) { float g[8], o[8]; unpack8(*(const u32x4*)(g2 + (size_t)row * ldc + colt + bj * HALF + wc * 32 + 8 * fq), g); unpack8(*(const u32x4*)p, o);
#pragma unroll
                            for (int e = 0; e < 8; ++e) r[e] = o[e] + r[e] * g[e]; }
                        u32x4 w; w.x = cvt_pk_bf16(r[0], r[1]); w.y = cvt_pk_bf16(r[2], r[3]); w.z = cvt_pk_bf16(r[4], r[5]); w.w = cvt_pk_bf16(r[6], r[7]);
                        *(u32x4*)p = w;
                    }
                }
            }
    }
};
struct EpiF32 {
    static constexpr bool PERM = false, AFTER_DRAIN = false;
    float* C; int ldc;
    __device__ __forceinline__ void operator()(const f32x4 (&acc)[2][2][4][2], const Unit& u, int wr, int wc, int fr, int fq) const {
        const int row0 = u.pm * BM + wr * 64 + fr, col0 = u.pn * BM + wc * 32 + 4 * fq;
#pragma unroll
        for (int ai = 0; ai < 2; ++ai)
#pragma unroll
            for (int m = 0; m < 4; ++m) { float* rowp = C + (size_t)(row0 + ai * HALF + m * 16) * ldc + col0;
#pragma unroll
                for (int bj = 0; bj < 2; ++bj)
#pragma unroll
                    for (int n = 0; n < 2; ++n) *(f32x4*)(rowp + bj * HALF + n * 16) = acc[ai][bj][m][n]; }
    }
};
}

struct Args { const float* in[16]; float* out; unsigned char* ws; int ph_lo, ph_hi, pass, pad; };
struct Frame {
    LAS unsigned char* lds;
    volatile LAS unsigned* MISC;
    int tid, lane, wave, G, gw, NGW;
    float* out; unsigned char* ws;
};
#define WSP(T, off) ((T*)(F.ws + (off)))
#define WSPF(T, off) ((T*)(Fp.ws + (off)))

struct WtItem { const float* src; bf16* dst; int ldw, K; };
__device__ __forceinline__ void tr_load(const WtItem& I, int lane, f32x4 (&v)[8]) {
#pragma unroll
    for (int i = 0; i < 8; ++i) v[i] = *(const f32x4*)(I.src + (size_t)((lane >> 3) + 8 * i) * I.ldw + 4 * (lane & 7));
}
__device__ __forceinline__ void tr_put(const f32x4 (&v)[8], LAS float* scr, int lane) {
#pragma unroll
    for (int i = 0; i < 8; ++i) { LAS float* s = scr + ((lane >> 3) + 8 * i) * 33 + 4 * (lane & 7); s[0] = v[i].x; s[1] = v[i].y; s[2] = v[i].z; s[3] = v[i].w; }
    LDS_WAIT(); asm volatile("" ::: "memory");
}
__device__ __forceinline__ void tr_out(const WtItem& I, const LAS float* scr, int lane) {
    const int c = lane & 7;
#pragma unroll
    for (int j = 0; j < 4; ++j) { const int n = (lane >> 3) + 8 * j; const LAS float* s = scr + (8 * c) * 33 + n;
        v4u o; o.x = pk2(s[0 * 33], s[1 * 33]); o.y = pk2(s[2 * 33], s[3 * 33]); o.z = pk2(s[4 * 33], s[5 * 33]); o.w = pk2(s[6 * 33], s[7 * 33]);
        *(GAS v4u*)(I.dst + (size_t)n * I.K + 8 * c) = o; }
    LDS_WAIT(); asm volatile("" ::: "memory");
}
__device__ __forceinline__ void rms_row_bf16(const float* xrow, const float* w, bf16* orow, int lane, f32x4 (&hv)[4]) {
    const f32x4* xr = (const f32x4*)xrow + lane; const f32x4* wr = (const f32x4*)w + lane;
    float ss = 0.f;
#pragma unroll
    for (int j = 0; j < 4; ++j) { hv[j] = xr[64 * j]; ss += (hv[j].x * hv[j].x + hv[j].y * hv[j].y) + (hv[j].z * hv[j].z + hv[j].w * hv[j].w); }
    const float rs = rsq_(wave_sum(ss) * (1.f / DM) + EPS);
    unsigned long long* o8 = (unsigned long long*)orow + lane;
#pragma unroll
    for (int j = 0; j < 4; ++j) { const f32x4 wv = wr[64 * j]; hv[j] = hv[j] * rs * wv;
        o8[64 * j] = (unsigned long long)pk2(hv[j].x, hv[j].y) | ((unsigned long long)pk2(hv[j].z, hv[j].w) << 32); }
}
__device__ __forceinline__ WtItem wt_decode(const Args& A, unsigned char* ws, int it) {
    constexpr int I_A = 16 * 96, I_B = 16 * 128, I_G = 16 * 64, I_O = 16 * 32, I_GU = 16 * 88;
    const float* w_in = A.in[2];
    int r = it; const float* W; int ldw, scol, nbn, K = DM, dmode = 0; size_t dst;
    if (r < I_A) { W = w_in; ldw = INTOT; scol = 0; nbn = 96; dst = WS_WTA; }
    else if ((r -= I_A) < I_B) { W = w_in; ldw = INTOT; scol = 3072; nbn = 128; dst = WS_WTB; }
    else if ((r -= I_B) < I_G) { W = w_in; ldw = INTOT; scol = 7184; nbn = 64; dst = WS_WTG; }
    else if ((r -= I_G) < I_O) { W = A.in[7]; ldw = DM; scol = 0; nbn = 32; dst = WS_WTOA; }
    else if ((r -= I_O) < I_O) { W = A.in[8]; ldw = DM; scol = 0; nbn = 32; dst = WS_WTOD; }
    else if ((r -= I_O) < I_O) { W = A.in[9]; ldw = DM; scol = 0; nbn = 32; dst = WS_WTOUT; }
    else if ((r -= I_O) < I_GU) { W = A.in[12]; ldw = DFF; scol = 0; nbn = 88; dst = WS_WTGU; dmode = 1; }
    else if ((r -= I_GU) < I_GU) { W = A.in[13]; ldw = DFF; scol = 0; nbn = 88; dst = WS_WTGU; dmode = 2; }
    else { r -= I_GU; W = A.in[14]; ldw = DM; scol = 0; nbn = 32; dst = WS_WTDN; K = DFF; }
    const int kb = r / nbn, nb = r % nbn, n0 = 32 * nb;
    const int drow0 = (dmode == 0) ? n0 : 256 * (n0 / 128) + (n0 % 128) + (dmode == 2 ? 128 : 0);
    WtItem I; I.src = W + (size_t)(64 * kb) * ldw + scol + n0; I.dst = (bf16*)(ws + dst) + (size_t)drow0 * K + 64 * kb; I.ldw = ldw; I.K = K; return I;
}
__device__ __forceinline__ void p_wtrans(Frame& F, const Args& A, int it0, int it1, int gw0, int ngw) {
    LAS float* scr = (LAS float*)(F.lds + RING_OFF + F.wave * 16384);
    int it = it0 + gw0; if (it >= it1) return;
    WtItem cur = wt_decode(A, F.ws, it); f32x4 v[8]; tr_load(cur, F.lane, v);
    for (;;) {
        const int itn = it + ngw; const bool more = itn < it1;
        tr_put(v, scr, F.lane);
        WtItem nxt = cur; if (more) { nxt = wt_decode(A, F.ws, itn); tr_load(nxt, F.lane, v); }
        tr_out(cur, scr, F.lane);
        if (!more) break;
        cur = nxt; it = itn;
    }
}
constexpr int WT_A_ITEMS = 2560;
constexpr int WT_ITEMS_EARLY = 16 * 96 + 16 * 128, WT_ITEMS_ALL = 16 * 96 + 16 * 128 + 16 * 64 + 3 * 16 * 32 + 2 * 16 * 88 + 44 * 32;
__device__ __forceinline__ void p_prologue(Frame& F, const Args& A) {
    const float* w_in = A.in[2];
#if DN2_LATE_WT
    p_wtrans(F, A, 0, WT_ITEMS_EARLY, F.gw, F.NGW);
#else
    p_wtrans(F, A, 0, WT_ITEMS_ALL, F.gw, F.NGW);
#endif
    { float* cosT = WSP(float, WS_COS); float* sinT = WSP(float, WS_SIN);
      for (int i = F.gw * 64 + F.lane; i < S * 16; i += F.NGW * 64) { const int pos = i >> 4, k = i & 15;
          const float inv = (float)pow(500000.0, -(double)k / 16.0); const float ang = (float)pos * inv;
          cosT[i] = cosf(ang); sinT[i] = sinf(ang); } }
    { const float* x = A.in[0]; bf16* H = WSP(bf16, WS_H); float* BA = WSP(float, WS_BA);
      constexpr int WP = 2064;
      LAS unsigned char* wimg = F.lds; LAS unsigned char* hl = F.lds + 36864 + F.wave * (4 * WP + 192);
      __syncthreads();
      { const int k8 = F.tid >> 2, c4 = 4 * (F.tid & 3); f32x4 wv[8];
#pragma unroll
        for (int i = 0; i < 8; ++i) wv[i] = *(const f32x4*)(w_in + (size_t)(8 * k8 + i) * INTOT + 7168 + c4);
#pragma unroll
        for (int c = 0; c < 4; ++c) { u32x4 o; o.x = pk2(wv[0][c], wv[1][c]); o.y = pk2(wv[2][c], wv[3][c]); o.z = pk2(wv[4][c], wv[5][c]); o.w = pk2(wv[6][c], wv[7][c]);
            *(LAS u32x4*)(wimg + (c4 + c) * WP + 16 * k8) = o; } }
      __syncthreads();
      const int r16 = F.lane & 15, g = F.lane >> 4;
      const LAS unsigned char* wrd = wimg + r16 * WP + 16 * g; const LAS unsigned char* hrd = hl + (r16 & 3) * WP + 16 * g;
      f32x4 nw[4];
#pragma unroll
      for (int j = 0; j < 4; ++j) nw[j] = ((const f32x4*)A.in[1])[F.lane + 64 * j];
      for (int m0 = F.gw; m0 < S; m0 += 4 * F.NGW) {
          f32x4 xv[4][4];
#pragma unroll
          for (int k = 0; k < 4; ++k) { const int m = m0 + k * F.NGW; const f32x4* xr = (const f32x4*)(x + (size_t)(m < S ? m : m0) * DM) + F.lane;
#pragma unroll
              for (int j = 0; j < 4; ++j) xv[k][j] = xr[64 * j]; }
#pragma unroll
          for (int k = 0; k < 4; ++k) { const int m = m0 + k * F.NGW; float ss = 0.f;
#pragma unroll
              for (int j = 0; j < 4; ++j) ss += (xv[k][j].x * xv[k][j].x + xv[k][j].y * xv[k][j].y) + (xv[k][j].z * xv[k][j].z + xv[k][j].w * xv[k][j].w);
              const float rs = rsq_(wave_sum(ss) * (1.f / DM) + EPS);
              unsigned long long* o8 = (unsigned long long*)(H + (size_t)m * DM) + F.lane;
#pragma unroll
              for (int j = 0; j < 4; ++j) { const f32x4 hv = xv[k][j] * rs * nw[j]; u32x2 p; p.x = pk2(hv.x, hv.y); p.y = pk2(hv.z, hv.w);
                  if (m < S) o8[64 * j] = (unsigned long long)p.x | ((unsigned long long)p.y << 32);
                  *(LAS u32x2*)(hl + k * WP + 8 * (F.lane + 64 * j)) = p; } }
          asm volatile("s_waitcnt lgkmcnt(0)" ::: "memory");
          f32x4 acc = {0.f, 0.f, 0.f, 0.f};
#pragma unroll 8
          for (int s = 0; s < 32; ++s) { const bf16x8 wf = *(const LAS bf16x8*)(wrd + 64 * s), hf = *(const LAS bf16x8*)(hrd + 64 * s);
              acc = __builtin_amdgcn_mfma_f32_16x16x32_bf16(wf, hf, acc, 0, 0, 0); }
          { const int m = m0 + r16 * F.NGW; if (r16 < 4 && m < S) *(f32x4*)(BA + (size_t)m * 16 + 4 * g) = acc; }
          asm volatile("s_waitcnt lgkmcnt(0)" ::: "memory");
      }
      __syncthreads(); }
}
__device__ __forceinline__ void p_hrecompute_sub(Frame& F, const Args& A, bf16* H, int gw0, int ngw) {
    const float* x = A.in[0];
    for (int m = gw0; m < S; m += ngw) { f32x4 hv[4]; rms_row_bf16(x + (size_t)m * DM, A.in[1], H + (size_t)m * DM, F.lane, hv); }
}
__device__ __forceinline__ void p_hrecompute(Frame& F, const Args& A) {
    const float* x = A.in[0]; bf16* H = WSP(bf16, WS_H);
    for (int m = F.gw; m < S; m += F.NGW) { f32x4 hv[4]; rms_row_bf16(x + (size_t)m * DM, A.in[1], H + (size_t)m * DM, F.lane, hv); }
}

__device__ __forceinline__ void p_kmean(Frame& F, const Args& A) {
    const bf16* KA = WSP(bf16, WS_R1 + T32); float* KM = WSP(float, WS_KMEAN);
    for (int it = F.gw; it < NBLK * NH; it += F.NGW) { const int blk = it >> 3, h = it & 7;
        float s0 = 0.f, s1 = 0.f; const bf16* p = KA + (size_t)(blk * MBLK) * DM + h * HD + 2 * F.lane;
#pragma unroll 32
        for (int r = 0; r < MBLK; ++r) { const unsigned v = *(const unsigned*)(p + (size_t)r * DM); s0 += bflo(v); s1 += bfhi(v); }
        KM[(size_t)it * HD + 2 * F.lane] = s0 * (1.f / MBLK); KM[(size_t)it * HD + 2 * F.lane + 1] = s1 * (1.f / MBLK); }
}
__device__ __forceinline__ void p_topk(Frame& F, const Args& A) {
    const bf16* QA = WSP(bf16, WS_R1); const float* KM = WSP(float, WS_KMEAN); int* TOPI = WSP(int, WS_TOPI);
    for (int it = F.gw; it < S * NH; it += F.NGW) { const int q = it >> 3, h = it & 7, qblk = q >> 8;
        float g = -INFINITY;
        if (F.lane < qblk) { const bf16* qp = QA + (size_t)q * DM + h * HD; const float* kp = KM + ((size_t)F.lane * NH + h) * HD; float a = 0.f;
#pragma unroll
            for (int c = 0; c < 16; ++c) { const u32x4 qv = *(const u32x4*)(qp + 8 * c); const f32x4 k0 = *(const f32x4*)(kp + 8 * c), k1 = *(const f32x4*)(kp + 8 * c + 4);
                a += bflo(qv.x) * k0.x + bfhi(qv.x) * k0.y + bflo(qv.y) * k0.z + bfhi(qv.y) * k0.w + bflo(qv.z) * k1.x + bfhi(qv.z) * k1.y + bflo(qv.w) * k1.z + bfhi(qv.w) * k1.w; }
            g = a; }
        int res = -1;
#pragma unroll
        for (int r = 0; r < 3; ++r) { float v = g; int i = F.lane;
#pragma unroll
            for (int o = 1; o < 64; o <<= 1) { const float ov = __shfl_xor(v, o); const int oi = __shfl_xor(i, o); if (ov > v || (ov == v && oi < i)) { v = ov; i = oi; } }
            if (F.lane == r) res = (r < qblk) ? i : -1;
            if (F.lane == i) g = -INFINITY; }
        if (F.lane < 3) TOPI[(size_t)it * 3 + F.lane] = res; }
}
__device__ __forceinline__ void p_attn_naive(Frame& F, const Args& A) {
    const bf16* QA = WSP(bf16, WS_R1); const bf16* KA = WSP(bf16, WS_R1 + T32); const bf16* VA = WSP(bf16, WS_R1 + 2 * T32); const int* TOPI = WSP(int, WS_TOPI);
#ifdef DBG_ATTN
    bf16* YA = (bf16*)F.out;
#else
    bf16* YA = WSP(bf16, WS_YA);
#endif
    for (int it = F.gw; it < S * NH; it += F.NGW) { const int q = it >> 3, h = it & 7, qblk = q >> 8;
        const bf16* qp = QA + (size_t)q * DM + h * HD;
        float m = -INFINITY, l = 0.f, o0 = 0.f, o1 = 0.f;
        for (int slot = 0; slot < 4; ++slot) {
            int kb = qblk; if (slot < 3) { kb = TOPI[(size_t)it * 3 + slot]; if (kb < 0) continue; }
            const bf16* kp = KA + (size_t)(kb * MBLK) * DM + h * HD; const bf16* vp = VA + (size_t)(kb * MBLK) * DM + h * HD;
            float s[4] = {0.f, 0.f, 0.f, 0.f};
#pragma unroll 4
            for (int c = 0; c < 16; ++c) { const u32x4 qv = *(const u32x4*)(qp + 8 * c);
                const float q0 = bflo(qv.x), q1 = bfhi(qv.x), q2 = bflo(qv.y), q3 = bfhi(qv.y), q4 = bflo(qv.z), q5 = bfhi(qv.z), q6 = bflo(qv.w), q7 = bfhi(qv.w);
#pragma unroll
                for (int jj = 0; jj < 4; ++jj) { const u32x4 kv = *(const u32x4*)(kp + (size_t)(F.lane + 64 * jj) * DM + 8 * c);
                    s[jj] += q0 * bflo(kv.x) + q1 * bfhi(kv.x) + q2 * bflo(kv.y) + q3 * bfhi(kv.y) + q4 * bflo(kv.z) + q5 * bfhi(kv.z) + q6 * bflo(kv.w) + q7 * bfhi(kv.w); } }
            float mx = -INFINITY;
#pragma unroll
            for (int jj = 0; jj < 4; ++jj) { s[jj] *= 0.08838834764831845f; if (slot == 3 && (kb * MBLK + F.lane + 64 * jj) > q) s[jj] = -INFINITY; mx = fmaxf(mx, s[jj]); }
            mx = wave_max(mx);
            const float mn = fmaxf(m, mx), sc = __expf(m - mn);
            float p[4], ps = 0.f;
#pragma unroll
            for (int jj = 0; jj < 4; ++jj) { p[jj] = __expf(s[jj] - mn); ps += p[jj]; }
            l = l * sc + wave_sum(ps); o0 *= sc; o1 *= sc; m = mn;
#pragma unroll
            for (int jj = 0; jj < 4; ++jj)
                for (int ln = 0; ln < 64; ++ln) { const float pj = __shfl(p[jj], ln); const unsigned vv = *(const unsigned*)(vp + (size_t)(ln + 64 * jj) * DM + 2 * F.lane); o0 += pj * bflo(vv); o1 += pj * bfhi(vv); }
        }
        const float il = 1.f / l;
        *(unsigned*)(YA + (size_t)q * DM + h * HD + 2 * F.lane) = pk2(o0 * il, o1 * il); }
}


typedef float f32x16 __attribute__((ext_vector_type(16)));
typedef short s16x4 __attribute__((ext_vector_type(4)));
typedef float f32x2_t __attribute__((ext_vector_type(2)));
typedef __bf16 bf16x2_t __attribute__((ext_vector_type(2)));
constexpr size_t WS_BUCKET = 241 * MiB, WS_ML = 249 * MiB, WS_OP2 = WS_Z;
constexpr int BUCKET_PER_HEAD = 256 * 2016;
constexpr int CW_CNT = 16384;
static_assert(WS_BUCKET + (size_t)NH * BUCKET_PER_HEAD * 2 <= WS_ML && WS_ML + (size_t)3 * S * NH * 8 <= WS_END, "bucket map");
constexpr float SM_C = 0.08838834764831845f * 1.4426950408889634f;

__device__ __forceinline__ int bucket_off(int kb) { return 256 * (63 * kb - (kb * (kb - 1)) / 2); }
__device__ __forceinline__ unsigned attn_off(unsigned row, unsigned ch) { return 256u * row + 16u * (ch ^ (((row & 3u) << 2) | ((row >> 2) & 3u))); }
__device__ __forceinline__ unsigned cvtpk(float lo, float hi) { f32x2_t v = {lo, hi}; bf16x2_t b = __builtin_convertvector(v, bf16x2_t); return __builtin_bit_cast(unsigned, b); }
__device__ __forceinline__ s16x4 vtr16(const LAS unsigned char* p) { typedef short v4i16_t __attribute__((ext_vector_type(4))); return __builtin_bit_cast(s16x4, __builtin_amdgcn_ds_read_tr16_b64_v4i16((LAS v4i16_t*)p)); }

__device__ __forceinline__ void unpack8f(const bf16x8 v, float (&f)[8]) { const u32x4 w = __builtin_bit_cast(u32x4, v);
    f[0] = bflo(w.x); f[1] = bfhi(w.x); f[2] = bflo(w.y); f[3] = bfhi(w.y); f[4] = bflo(w.z); f[5] = bfhi(w.z); f[6] = bflo(w.w); f[7] = bfhi(w.w); }
__device__ __forceinline__ bf16x8 pack8f(const float (&f)[8]) { u32x4 w; w.x = cvtpk(f[0], f[1]); w.y = cvtpk(f[2], f[3]); w.z = cvtpk(f[4], f[5]); w.w = cvtpk(f[6], f[7]); return __builtin_bit_cast(bf16x8, w); }

__device__ __forceinline__ void attn_stage(const bf16* src, LAS unsigned char* img, int tid) {
#pragma unroll
    for (int i = 0; i < 8; ++i) { const int n = tid + 512 * i, row = n >> 4, ch = n & 15;
        const u32x4 v = *(const u32x4*)(src + (size_t)row * DM + 8 * ch); *(LAS u32x4*)(img + attn_off(row, ch)) = v; }
}
struct AttnState { float m, l; f32x16 o[4]; };
__device__ __forceinline__ float half_max(float v) { const auto t = __builtin_amdgcn_permlane32_swap(__builtin_bit_cast(unsigned, v), __builtin_bit_cast(unsigned, v), false, false); return fmaxf(__builtin_bit_cast(float, t[0]), __builtin_bit_cast(float, t[1])); }
__device__ __forceinline__ float half_sum(float v) { const auto t = __builtin_amdgcn_permlane32_swap(__builtin_bit_cast(unsigned, v), __builtin_bit_cast(unsigned, v), false, false); return __builtin_bit_cast(float, t[0]) + __builtin_bit_cast(float, t[1]); }
template <int NT> __device__ __forceinline__ void attn_wave(const bf16x8 (&qf)[8], const LAS unsigned char* Kimg, const LAS unsigned char* Vimg, int nt, int diag, int lane, AttnState& st) {
    const int r = lane & 31, hh = lane >> 5, blk = (lane >> 4) & 1, q4 = (lane & 15) >> 2, p4 = lane & 3;
    const LAS unsigned char* kad[8];
#pragma unroll
    for (int ks = 0; ks < 8; ++ks) kad[ks] = Kimg + attn_off(r, 2 * ks + hh);
    const LAS unsigned char* vad[4][4];
#pragma unroll
    for (int i = 0; i < 4; ++i) { const unsigned rl = 16u * (i >> 1) + 8u * (i & 1) + 4u * hh + q4, x = ((rl & 3u) << 2) | ((rl >> 2) & 3u), cb = 2u * blk + (p4 >> 1);
#pragma unroll
        for (int c = 0; c < 4; ++c) vad[i][c] = Vimg + 256u * rl + 16u * (cb ^ (x & 3u)) + 8u * (p4 & 1) + 64u * ((unsigned)c ^ (x >> 2)); }
    st.m = -INFINITY; st.l = 0.f;
#pragma unroll
    for (int c = 0; c < 4; ++c)
#pragma unroll
        for (int i = 0; i < 16; ++i) st.o[c][i] = 0.f;
    auto tile = [&](const int kt) __attribute__((always_inline)) {
        f32x16 s;
#pragma unroll
        for (int i = 0; i < 16; ++i) s[i] = 0.f;
#pragma unroll
        for (int ks = 0; ks < 8; ++ks) { const bf16x8 kf = *(const LAS bf16x8*)(kad[ks] + kt * 8192); s = __builtin_amdgcn_mfma_f32_32x32x16_bf16(kf, qf[ks], s, 0, 0, 0); }
        float tmax = -INFINITY;
#pragma unroll
        for (int i = 0; i < 16; ++i) { if (kt == diag && ((i & 3) + 8 * (i >> 2) + 4 * hh) > r) s[i] = -INFINITY; tmax = fmaxf(tmax, s[i]); }
        tmax = fmaxf(tmax, __shfl_xor(tmax, 32)) * SM_C;
        if (!(tmax - st.m <= 8.f)) { const float mn = fmaxf(st.m, tmax), alpha = __builtin_amdgcn_exp2f(st.m - mn); st.l *= alpha; st.m = mn;
#pragma unroll
            for (int c = 0; c < 4; ++c)
#pragma unroll
                for (int i = 0; i < 16; ++i) st.o[c][i] *= alpha; }
        float rs = 0.f; const float nm = -st.m;
#pragma unroll
        for (int i = 0; i < 16; ++i) { s[i] = __builtin_amdgcn_exp2f(__builtin_fmaf(s[i], SM_C, nm)); rs += s[i]; }
        st.l += rs + __shfl_xor(rs, 32);
#pragma unroll
        for (int sp = 0; sp < 2; ++sp) {
            u32x4 pw; pw.x = cvtpk(s[8 * sp], s[8 * sp + 1]); pw.y = cvtpk(s[8 * sp + 2], s[8 * sp + 3]); pw.z = cvtpk(s[8 * sp + 4], s[8 * sp + 5]); pw.w = cvtpk(s[8 * sp + 6], s[8 * sp + 7]);
            const bf16x8 pf = __builtin_bit_cast(bf16x8, pw);
#pragma unroll
            for (int c = 0; c < 4; ++c) {
                const s16x4 lo = vtr16(vad[2 * sp][c] + kt * 8192);
                const s16x4 hi = vtr16(vad[2 * sp + 1][c] + kt * 8192);
                const bf16x8 vf = __builtin_shufflevector(lo, hi, 0, 1, 2, 3, 4, 5, 6, 7);
                st.o[c] = __builtin_amdgcn_mfma_f32_32x32x16_bf16(vf, pf, st.o[c], 0, 0, 0);
            }
        }
    };
    if constexpr (NT > 0) {
#pragma unroll
        for (int kt = 0; kt < NT; ++kt) tile(kt);
    } else { for (int kt = 0; kt < nt; ++kt) tile(kt); }
}
__device__ __forceinline__ void p_topk_bucket(Frame& F, const Args& A) {
    const bf16* QA = WSP(bf16, WS_R1); const float* KM = WSP(float, WS_KMEAN); int* TOPI = WSP(int, WS_TOPI);
    unsigned* CNT = WSP(unsigned, WS_CTL) + CW_CNT; unsigned short* BUCKET = WSP(unsigned short, WS_BUCKET); f32x2_t* ML = WSP(f32x2_t, WS_ML);
    for (int it = F.gw; it < S * NH; it += F.NGW) { const int q = it >> 3, h = it & 7, qblk = q >> 8;
        float g = -INFINITY;
        if (F.lane < qblk) { const bf16* qp = QA + (size_t)q * DM + h * HD; const float* kp = KM + ((size_t)F.lane * NH + h) * HD; float a = 0.f;
#pragma unroll
            for (int c = 0; c < 16; ++c) { const u32x4 qv = *(const u32x4*)(qp + 8 * c); const f32x4 k0 = *(const f32x4*)(kp + 8 * c), k1 = *(const f32x4*)(kp + 8 * c + 4);
                a += bflo(qv.x) * k0.x + bfhi(qv.x) * k0.y + bflo(qv.y) * k0.z + bfhi(qv.y) * k0.w + bflo(qv.z) * k1.x + bfhi(qv.z) * k1.y + bflo(qv.w) * k1.z + bfhi(qv.w) * k1.w; }
            g = a; }
        int res = -1;
#pragma unroll
        for (int r = 0; r < 3; ++r) { float v = g; int i = F.lane;
#pragma unroll
            for (int o = 1; o < 64; o <<= 1) { const float ov = __shfl_xor(v, o); const int oi = __shfl_xor(i, o); if (ov > v || (ov == v && oi < i)) { v = ov; i = oi; } }
            if (F.lane == r) res = (r < qblk) ? i : -1;
            if (F.lane == i) g = -INFINITY; }
        if (F.lane < 3) { TOPI[(size_t)it * 3 + F.lane] = res;
            if (res >= 0) { const unsigned pos = __hip_atomic_fetch_add(CNT + h * NBLK + res, 1u, __ATOMIC_RELAXED, __HIP_MEMORY_SCOPE_AGENT);
                BUCKET[(size_t)h * BUCKET_PER_HEAD + bucket_off(res) + pos] = (unsigned short)((q << 2) | F.lane); }
            else ML[((size_t)F.lane * S + q) * NH + h] = (f32x2_t){-INFINITY, 0.f}; } }
}

__device__ __forceinline__ void p_topk2(Frame& F, const Args& A) {
    const bf16* QA = WSP(bf16, WS_R1); const float* KP = WSP(const float, WS_KMEAN);
    unsigned* CNT = WSP(unsigned, WS_CTL) + CW_CNT; unsigned short* BUCKET = WSP(unsigned short, WS_BUCKET); f32x2_t* ML = WSP(f32x2_t, WS_ML);
    LAS unsigned char* Kimg = F.lds;
    LAS int* lcnt = (LAS int*)(F.lds + 16384); LAS int* lbase = lcnt + 64;
    const int lane = F.lane, r = lane & 31, hh = lane >> 5;
    for (int u = blockIdx.x; u < NBLK * NH; u += F.G) { const int qblk = u >> 3, h = u & 7, q = qblk * MBLK + 32 * F.wave + r;
        __syncthreads();
        { const int n = F.tid >> 3, c = F.tid & 7; const float* p0 = KP + ((size_t)(n * 2) * NH + h) * HD + 16 * c; const float* p1 = p0 + (size_t)NH * HD;
#pragma unroll
          for (int half = 0; half < 2; ++half) { const f32x4 a0 = *(const f32x4*)(p0 + 8 * half), a1 = *(const f32x4*)(p0 + 8 * half + 4), c0 = *(const f32x4*)(p1 + 8 * half), c1 = *(const f32x4*)(p1 + 8 * half + 4);
              float f[8] = {(a0.x + c0.x) * (1.f / MBLK), (a0.y + c0.y) * (1.f / MBLK), (a0.z + c0.z) * (1.f / MBLK), (a0.w + c0.w) * (1.f / MBLK), (a1.x + c1.x) * (1.f / MBLK), (a1.y + c1.y) * (1.f / MBLK), (a1.z + c1.z) * (1.f / MBLK), (a1.w + c1.w) * (1.f / MBLK)};
              *(LAS bf16x8*)(Kimg + attn_off(n, 2 * c + half)) = pack8f(f); } }
        if (F.tid < 64) lcnt[F.tid] = 0;
        __syncthreads();
        float bv[3] = {-INFINITY, -INFINITY, -INFINITY}; int bi[3] = {0, 0, 0};
        if (qblk > 0) {
            bf16x8 qf[8];
#pragma unroll
            for (int ks = 0; ks < 8; ++ks) qf[ks] = *(const bf16x8*)(QA + (size_t)q * DM + h * HD + 16 * ks + 8 * hh);
            const int nt = (qblk > 32) ? 2 : 1;
            for (int tn = 0; tn < nt; ++tn) {
                f32x16 acc;
#pragma unroll
                for (int i = 0; i < 16; ++i) acc[i] = 0.f;
#pragma unroll
                for (int ks = 0; ks < 8; ++ks) { const bf16x8 kf = *(const LAS bf16x8*)(Kimg + attn_off(32 * tn + r, 2 * ks + hh)); acc = __builtin_amdgcn_mfma_f32_32x32x16_bf16(kf, qf[ks], acc, 0, 0, 0); }
#pragma unroll
                for (int i = 0; i < 16; ++i) { const int n = 32 * tn + (i & 3) + 8 * (i >> 2) + 4 * hh; const float v = (n < qblk) ? acc[i] : -INFINITY;
                    const bool g0 = v > bv[0], g1 = v > bv[1], g2 = v > bv[2];
                    bv[2] = g1 ? bv[1] : (g2 ? v : bv[2]); bi[2] = g1 ? bi[1] : (g2 ? n : bi[2]);
                    bv[1] = g0 ? bv[0] : (g1 ? v : bv[1]); bi[1] = g0 ? bi[0] : (g1 ? n : bi[1]);
                    bv[0] = g0 ? v : bv[0]; bi[0] = g0 ? n : bi[0]; }
            }
            float ov[3]; int oi[3];
#pragma unroll
            for (int k = 0; k < 3; ++k) { ov[k] = __shfl_xor(bv[k], 32); oi[k] = __shfl_xor(bi[k], 32); }
#pragma unroll
            for (int k = 0; k < 3; ++k) { const float v = ov[k]; const int n = oi[k];
#define TK_GT(v_, n_, w_, m_) ((v_) > (w_) || ((v_) == (w_) && (n_) < (m_)))
                const bool ok = v > -INFINITY, g0 = ok && TK_GT(v, n, bv[0], bi[0]), g1 = ok && TK_GT(v, n, bv[1], bi[1]), g2 = ok && TK_GT(v, n, bv[2], bi[2]);
                bv[2] = g1 ? bv[1] : (g2 ? v : bv[2]); bi[2] = g1 ? bi[1] : (g2 ? n : bi[2]);
                bv[1] = g0 ? bv[0] : (g1 ? v : bv[1]); bi[1] = g0 ? bi[0] : (g1 ? n : bi[1]);
                bv[0] = g0 ? v : bv[0]; bi[0] = g0 ? n : bi[0]; }
        }
        int rank[3] = {0, 0, 0}; bool valid[3];
#pragma unroll
        for (int k = 0; k < 3; ++k) { valid[k] = (hh == 0) && (k < qblk) && (bv[k] > -INFINITY);
            if (valid[k]) rank[k] = __hip_atomic_fetch_add(lcnt + bi[k], 1, __ATOMIC_RELAXED, __HIP_MEMORY_SCOPE_WORKGROUP);
            else if (hh == 0) ML[((size_t)k * S + q) * NH + h] = (f32x2_t){-INFINITY, 0.f}; }
        __syncthreads();
        if (F.tid < 64) { const int c = lcnt[F.tid]; if (c > 0) lbase[F.tid] = (int)__hip_atomic_fetch_add(CNT + h * NBLK + F.tid, (unsigned)c, __ATOMIC_RELAXED, __HIP_MEMORY_SCOPE_AGENT); }
        __syncthreads();
#pragma unroll
        for (int k = 0; k < 3; ++k) if (valid[k]) BUCKET[(size_t)h * BUCKET_PER_HEAD + bucket_off(bi[k]) + lbase[bi[k]] + rank[k]] = (unsigned short)((q << 2) | k);
    }
    __syncthreads();
}
__device__ __forceinline__ bf16* op_slot(Frame& F, int r) { return r < 2 ? (bf16*)F.out + (size_t)r * S * DM : WSP(bf16, WS_OP2); }
__device__ __forceinline__ void p_attn_sel(Frame& F, const Args& A) {
    const bf16* QA = WSP(bf16, WS_R1); const bf16* KA = WSP(bf16, WS_R1 + T32); const bf16* VA = WSP(bf16, WS_R1 + 2 * T32);
    const unsigned* CNT = WSP(const unsigned, WS_CTL) + CW_CNT; const unsigned short* BUCKET = WSP(const unsigned short, WS_BUCKET); f32x2_t* ML = WSP(f32x2_t, WS_ML);
    LAS unsigned char* Kimg = F.lds; LAS unsigned char* Vimg = F.lds + 65536; LAS int* pre = (LAS int*)(F.lds + LDSCTL_OFF + 1024);
    constexpr int AS_UW = 4, AS_SW = 3;
    LAS int* prew = (LAS int*)(F.lds + 131072);
    __syncthreads();
    { const int nb = (int)((CNT[F.tid] + 255u) >> 8), wb = nb ? AS_SW + AS_UW * nb : 0;
      int inc = nb, incw = wb;
#pragma unroll
      for (int o = 1; o < 64; o <<= 1) { const int v = __shfl_up(inc, o), vw = __shfl_up(incw, o); if (F.lane >= o) { inc += v; incw += vw; } }
      LAS int* wtot = pre + 520;
      if (F.lane == 63) { wtot[F.wave] = inc; wtot[8 + F.wave] = incw; }
      __syncthreads();
      int base = 0, basew = 0;
#pragma unroll
      for (int w = 0; w < NWAVES; ++w) { base += (w < F.wave) ? wtot[w] : 0; basew += (w < F.wave) ? wtot[8 + w] : 0; }
      pre[F.tid] = base + inc - nb; prew[F.tid] = basew + incw - wb;
      if (F.tid == NWAVES * 64 - 1) { pre[NH * NBLK] = base + inc; prew[NH * NBLK] = basew + incw; } }
    __syncthreads();
    const int totalw = prew[NH * NBLK];
    auto first_unit = [&](const int x) __attribute__((always_inline)) -> int {
        int lo = 0, hi = NH * NBLK - 1; while (lo < hi) { const int mid = (lo + hi + 1) >> 1; if (prew[mid] <= x) lo = mid; else hi = mid - 1; }
        const int nbl = pre[lo + 1] - pre[lo], d = x - prew[lo];
        int j = 0; if (d > 0) { j = (d - AS_SW + AS_UW - 1) / AS_UW; j = j < 1 ? 1 : j; j = j > nbl ? nbl : j; }
        return pre[lo] + j; };
#define AS_DECODE(u_, h_, kb_, b_, cnt_) do { int lo_ = 0, hi_ = NH * NBLK - 1; while (lo_ < hi_) { const int mid_ = (lo_ + hi_ + 1) >> 1; if (pre[mid_] <= (u_)) lo_ = mid_; else hi_ = mid_ - 1; } \
        h_ = lo_ >> 6; kb_ = lo_ & 63; b_ = (u_) - pre[lo_]; cnt_ = (int)CNT[lo_]; } while (0)
    const int hh = F.lane >> 5;
    bf16x8 qf[8];
    const int u1 = first_unit((int)(((long long)(blockIdx.x + 1) * totalw) / F.G)); int hs = -1, kbs = -1;
    int u = first_unit((int)(((long long)blockIdx.x * totalw) / F.G)), h = 0, kb = 0, b = 0, cnt = 0, q = 0, r = 0; bool valid = false;
    if (u < u1) { AS_DECODE(u, h, kb, b, cnt);
        const int e = 256 * b + 32 * F.wave + (F.lane & 31); valid = e < cnt;
        const unsigned ent = BUCKET[(size_t)h * BUCKET_PER_HEAD + bucket_off(kb) + (valid ? e : 256 * b)]; q = (int)(ent >> 2); r = (int)(ent & 3u);
#pragma unroll
        for (int ks = 0; ks < 8; ++ks) qf[ks] = *(const bf16x8*)(QA + (size_t)q * DM + h * HD + 16 * ks + 8 * hh); }
    while (u < u1) {
        if (h != hs || kb != kbs) {
            __syncthreads();
            attn_stage(KA + (size_t)(kb * MBLK) * DM + h * HD, Kimg, F.tid); attn_stage(VA + (size_t)(kb * MBLK) * DM + h * HD, Vimg, F.tid);
            __syncthreads(); hs = h; kbs = kb; }
        const int un = u + 1; int hn = 0, kbn = 0, bn = 0, cntn = 0; unsigned entn = 0u; bool validn = false;
        if (un < u1) { AS_DECODE(un, hn, kbn, bn, cntn);
            const int e = 256 * bn + 32 * F.wave + (F.lane & 31); validn = e < cntn;
            entn = BUCKET[(size_t)hn * BUCKET_PER_HEAD + bucket_off(kbn) + (validn ? e : 256 * bn)]; }
        AttnState st; if (__ballot(valid) != 0ull) attn_wave<8>(qf, Kimg, Vimg, 8, -1, F.lane, st);
        const int qc = q, rc = r, hc = h; const bool vc = valid;
        if (un < u1) { q = (int)(entn >> 2); r = (int)(entn & 3u); h = hn; kb = kbn; valid = validn;
#pragma unroll
            for (int ks = 0; ks < 8; ++ks) qf[ks] = *(const bf16x8*)(QA + (size_t)q * DM + h * HD + 16 * ks + 8 * hh); }
        if (vc) {
            bf16* op = op_slot(F, rc) + (size_t)qc * DM + hc * HD + 64 * hh;
#pragma unroll
            for (int c = 0; c < 4; ++c)
#pragma unroll
                for (int g2 = 0; g2 < 2; ++g2) { u32x4 w; w.x = cvtpk(st.o[c][8 * g2], st.o[c][8 * g2 + 1]); w.y = cvtpk(st.o[c][8 * g2 + 2], st.o[c][8 * g2 + 3]); w.z = cvtpk(st.o[c][8 * g2 + 4], st.o[c][8 * g2 + 5]); w.w = cvtpk(st.o[c][8 * g2 + 6], st.o[c][8 * g2 + 7]);
                    *(u32x4*)(op + 16 * c + 8 * g2) = w; }
            if (hh == 0) ML[((size_t)rc * S + qc) * NH + hc] = (f32x2_t){st.m, st.l}; }
        u = un;
    }
    __syncthreads();
}
__device__ __forceinline__ void p_attn_own(Frame& F, const Args& A) {
    const bf16* QA = WSP(bf16, WS_R1); const bf16* KA = WSP(bf16, WS_R1 + T32); const bf16* VA = WSP(bf16, WS_R1 + 2 * T32); const f32x2_t* ML = WSP(const f32x2_t, WS_ML); bf16* YA = WSP(bf16, WS_YA);
    LAS unsigned char* Kimg = F.lds; LAS unsigned char* Vimg = F.lds + 65536;
    for (int u = blockIdx.x; u < NH * NBLK; u += F.G) { const int h = u & 7, qb = u >> 3;
        __syncthreads();
        attn_stage(KA + (size_t)(qb * MBLK) * DM + h * HD, Kimg, F.tid); attn_stage(VA + (size_t)(qb * MBLK) * DM + h * HD, Vimg, F.tid);
        __syncthreads();
        const int q = qb * MBLK + 32 * F.wave + (F.lane & 31), hh = F.lane >> 5;
        bf16x8 qf[8];
#pragma unroll
        for (int ks = 0; ks < 8; ++ks) qf[ks] = *(const bf16x8*)(QA + (size_t)q * DM + h * HD + 16 * ks + 8 * hh);
        AttnState st; attn_wave<0>(qf, Kimg, Vimg, F.wave + 1, F.wave, F.lane, st);
        float mr[3], lr[3], M = st.m;
#pragma unroll
        for (int r = 0; r < 3; ++r) { const f32x2_t ml = ML[((size_t)r * S + q) * NH + h]; mr[r] = ml.x; lr[r] = ml.y; M = fmaxf(M, ml.x); }
        const float w0 = __builtin_amdgcn_exp2f(st.m - M); float L = st.l * w0; float wr[3];
#pragma unroll
        for (int r = 0; r < 3; ++r) { wr[r] = (lr[r] > 0.f) ? __builtin_amdgcn_exp2f(mr[r] - M) : 0.f; L += lr[r] * wr[r]; }
        const float iL = rcp_(L);
        const size_t pbase = (size_t)q * DM + h * HD + 64 * hh;
        const bf16* ps0 = op_slot(F, 0) + pbase; const bf16* ps1 = op_slot(F, 1) + pbase; const bf16* ps2 = op_slot(F, 2) + pbase;
#pragma unroll
        for (int half = 0; half < 2; ++half) {
            bf16x8 pl[4][3];
#pragma unroll
            for (int k = 0; k < 4; ++k) { pl[k][0] = *(const bf16x8*)(ps0 + 32 * half + 8 * k); pl[k][1] = *(const bf16x8*)(ps1 + 32 * half + 8 * k); pl[k][2] = *(const bf16x8*)(ps2 + 32 * half + 8 * k); }
            __builtin_amdgcn_sched_barrier(0);
#pragma unroll
            for (int k = 0; k < 4; ++k) { const int c = 2 * half + (k >> 1), g2 = k & 1;
                float v[8];
#pragma unroll
                for (int e = 0; e < 8; ++e) v[e] = st.o[c][8 * g2 + e] * w0;
#pragma unroll
                for (int r = 0; r < 3; ++r) { float pf[8]; unpack8f(pl[k][r], pf); const bool on = wr[r] != 0.f;
#pragma unroll
                    for (int e = 0; e < 8; ++e) v[e] += on ? wr[r] * pf[e] : 0.f; }
                u32x2 wa, wb; wa.x = cvtpk(v[0] * iL, v[1] * iL); wa.y = cvtpk(v[2] * iL, v[3] * iL); wb.x = cvtpk(v[4] * iL, v[5] * iL); wb.y = cvtpk(v[6] * iL, v[7] * iL);
                bf16* yp = YA + (size_t)q * DM + h * HD + 32 * c + 16 * g2 + 4 * hh; *(u32x2*)yp = wa; *(u32x2*)(yp + 8) = wb; }
        }
    }
    __syncthreads();
}
__device__ __forceinline__ void p_dn_conv(Frame& F, const Args& A) {
    const bf16* QB = WSP(bf16, WS_R1); const bf16* KB = WSP(bf16, WS_R1 + T32); const bf16* VB = WSP(bf16, WS_R1 + 2 * T32);
    bf16* QN = (bf16*)F.out; bf16* KN = (bf16*)F.out + (size_t)S * DM; bf16* VN = WSP(bf16, WS_VN);
    const float* cw = A.in[3]; const float* BA = WSP(const float, WS_BA); float* BETA = WSP(float, WS_BETA); float* G = WSP(float, WS_G);
    for (int it = F.gw; it < S * NH; it += F.NGW) { const int t = it >> 3, h = it & 7, c = h * HD + 2 * F.lane;
        float aq0 = 0.f, aq1 = 0.f, ak0 = 0.f, ak1 = 0.f, av0 = 0.f, av1 = 0.f;
#pragma unroll
        for (int j = 0; j < 4; ++j) { const int tt = t + j - 3; if (tt < 0) continue;
            const unsigned xq = *(const unsigned*)(QB + (size_t)tt * DM + c), xk = *(const unsigned*)(KB + (size_t)tt * DM + c), xv = *(const unsigned*)(VB + (size_t)tt * DM + c);
            const float* w = cw + (size_t)j * 3072;
            aq0 += w[c] * bflo(xq); aq1 += w[c + 1] * bfhi(xq); ak0 += w[1024 + c] * bflo(xk); ak1 += w[1024 + c + 1] * bfhi(xk); av0 += w[2048 + c] * bflo(xv); av1 += w[2048 + c + 1] * bfhi(xv); }
        aq0 = siluf_(aq0); aq1 = siluf_(aq1); ak0 = siluf_(ak0); ak1 = siluf_(ak1); av0 = siluf_(av0); av1 = siluf_(av1);
        const float rq = rsq_(wave_sum(aq0 * aq0 + aq1 * aq1) + EPS) * 0.08838834764831845f, rk = rsq_(wave_sum(ak0 * ak0 + ak1 * ak1) + EPS);
        *(unsigned*)(QN + (size_t)t * DM + c) = pk2(aq0 * rq, aq1 * rq); *(unsigned*)(KN + (size_t)t * DM + c) = pk2(ak0 * rk, ak1 * rk); *(unsigned*)(VN + (size_t)t * DM + c) = pk2(av0, av1);
        if (F.lane == 0) { const float b = BA[(size_t)t * 16 + h], a = BA[(size_t)t * 16 + 8 + h] + A.in[5][h];
            const float sp = (a > 20.f) ? a : log1pf(expf(a));
            BETA[(size_t)t * 8 + h] = 1.f / (1.f + expf(-b)); G[(size_t)t * 8 + h] = -expf(A.in[4][h]) * sp; } }
}
__device__ __forceinline__ void p_dn_chunk(Frame& F, const Args& A) {
    const bf16* QN = (const bf16*)F.out; const bf16* KN = (const bf16*)F.out + (size_t)S * DM; bf16* VU = WSP(bf16, WS_VN); bf16* Wb = WSP(bf16, WS_W); bf16* ATT = WSP(bf16, WS_ATT);
    const float* BETA = WSP(const float, WS_BETA); const float* G = WSP(const float, WS_G); float* GC = WSP(float, WS_GC);
    LAS float* Kc = (LAS float*)(F.lds); LAS float* Qc = Kc + 64 * 132; LAS float* Lm = Qc + 64 * 132; LAS float* Tm = Lm + 64 * 65; LAS float* gcs = Tm + 64 * 65; LAS float* bes = gcs + 64; LAS float* bge = bes + 64;
    const int tid = F.tid;
    for (int item = blockIdx.x; item < NCH * NH; item += F.G) { const int n = item >> 3, h = item & 7, t0 = n * CH;
        __syncthreads();
        if (tid < 64) { gcs[tid] = G[(size_t)(t0 + tid) * 8 + h]; bes[tid] = BETA[(size_t)(t0 + tid) * 8 + h]; }
        __syncthreads();
        if (tid == 0) { float a = 0.f; for (int i = 0; i < 64; ++i) { a += gcs[i]; gcs[i] = a; } }
#pragma unroll
        for (int r = 0; r < 2; ++r) { const int idx = tid + 512 * r, row = idx >> 4, c8 = idx & 15;
            const u32x4 kv = *(const u32x4*)(KN + (size_t)(t0 + row) * DM + h * HD + 8 * c8), qv = *(const u32x4*)(QN + (size_t)(t0 + row) * DM + h * HD + 8 * c8);
            LAS float* kd = Kc + row * 132 + 8 * c8; LAS float* qd = Qc + row * 132 + 8 * c8;
            kd[0] = bflo(kv.x); kd[1] = bfhi(kv.x); kd[2] = bflo(kv.y); kd[3] = bfhi(kv.y); kd[4] = bflo(kv.z); kd[5] = bfhi(kv.z); kd[6] = bflo(kv.w); kd[7] = bfhi(kv.w);
            qd[0] = bflo(qv.x); qd[1] = bfhi(qv.x); qd[2] = bflo(qv.y); qd[3] = bfhi(qv.y); qd[4] = bflo(qv.z); qd[5] = bfhi(qv.z); qd[6] = bflo(qv.w); qd[7] = bfhi(qv.w); }
        __syncthreads();
        if (tid < 64) { GC[(size_t)(t0 + tid) * 8 + h] = gcs[tid]; bge[tid] = bes[tid] * expf(gcs[tid]); }
        for (int r = 0; r < 8; ++r) { const int p = tid + 512 * r, i = p >> 6, j = p & 63;
            float dk = 0.f, dq = 0.f;
            if (j <= i) { const LAS float* ki = Kc + i * 132; const LAS float* kj = Kc + j * 132; const LAS float* qi = Qc + i * 132;
                for (int d = 0; d < HD; ++d) { dk += ki[d] * kj[d]; dq += qi[d] * kj[d]; } }
            const float dec = (j <= i) ? expf(gcs[i] - gcs[j]) : 0.f;
            Lm[i * 65 + j] = (j < i) ? bes[i] * dk * dec : 0.f;
            ATT[((size_t)(h * NCH + n) * 64 + i) * 64 + j] = (bf16)f2bf((j <= i) ? dq * dec : 0.f); }
        __syncthreads();
        if (tid < 64) { const int c = tid;
            for (int i = 0; i < 64; ++i) { float acc = (i == c) ? 1.f : 0.f; for (int j = 0; j < i; ++j) acc -= Lm[i * 65 + j] * Tm[j * 65 + c]; Tm[i * 65 + c] = acc; } }
        __syncthreads();
#pragma unroll
        for (int r = 0; r < 2; ++r) { const int idx = tid + 512 * r, row = idx >> 4, c8 = idx & 15;
            const u32x4 vv = *(const u32x4*)(VU + (size_t)(t0 + row) * DM + h * HD + 8 * c8); LAS float* vd = Qc + row * 132 + 8 * c8;
            vd[0] = bflo(vv.x); vd[1] = bfhi(vv.x); vd[2] = bflo(vv.y); vd[3] = bfhi(vv.y); vd[4] = bflo(vv.z); vd[5] = bfhi(vv.z); vd[6] = bflo(vv.w); vd[7] = bfhi(vv.w); }
        __syncthreads();
        { const int d = tid & 127, ig = tid >> 7;
          for (int ii = 0; ii < 16; ++ii) { const int i = ig * 16 + ii; float au = 0.f, aw = 0.f;
              for (int j = 0; j <= i; ++j) { const float t = Tm[i * 65 + j]; au += t * bes[j] * Qc[j * 132 + d]; aw += t * bge[j] * Kc[j * 132 + d]; }
              VU[(size_t)(t0 + i) * DM + h * HD + d] = (bf16)f2bf(au); Wb[(size_t)(t0 + i) * DM + h * HD + d] = (bf16)f2bf(aw); } }
    }
    __syncthreads();
}
__device__ __forceinline__ void p_dn_scan_naive(Frame& F, const Args& A) {
    if (blockIdx.x < 4) {
    const bf16* QN = (const bf16*)F.out; const bf16* KN = (const bf16*)F.out + (size_t)S * DM; const bf16* U = WSP(const bf16, WS_VN); const bf16* Wb = WSP(const bf16, WS_W); const bf16* ATT = WSP(const bf16, WS_ATT);
    const float* GC = WSP(const float, WS_GC); bf16* O = WSP(bf16, WS_O);
    LAS float* vn = (LAS float*)F.lds;
    const int tid = F.tid, wv = tid >> 6, h = blockIdx.x * 2 + (wv >> 2), e = (wv & 3) * 32 + (F.lane & 31), half = F.lane >> 5;
    float s[64];
#pragma unroll
    for (int d = 0; d < 64; ++d) s[d] = 0.f;
    for (int n = 0; n < NCH; ++n) { const int t0 = n * CH; const float gl = GC[(size_t)(t0 + 63) * 8 + h];
        for (int c = 0; c < 64; ++c) { const size_t ro = (size_t)(t0 + c) * DM + h * HD; const bf16* wp = Wb + ro + 64 * half; float a = 0.f;
#pragma unroll
            for (int d8 = 0; d8 < 8; ++d8) { if ((d8 & 1) == 0) asm volatile("" ::: "memory"); const u32x4 wv4 = *(const u32x4*)(wp + 8 * d8);
                a += bflo(wv4.x) * s[8 * d8] + bfhi(wv4.x) * s[8 * d8 + 1] + bflo(wv4.y) * s[8 * d8 + 2] + bfhi(wv4.y) * s[8 * d8 + 3] + bflo(wv4.z) * s[8 * d8 + 4] + bfhi(wv4.z) * s[8 * d8 + 5] + bflo(wv4.w) * s[8 * d8 + 6] + bfhi(wv4.w) * s[8 * d8 + 7]; }
            a += __shfl_xor(a, 32);
            vn[c * 512 + tid] = bf2f(U[ro + e]) - a; }
        for (int c = 0; c < 64; ++c) { const size_t ro = (size_t)(t0 + c) * DM + h * HD; const bf16* qp = QN + ro + 64 * half; float a = 0.f;
#pragma unroll
            for (int d8 = 0; d8 < 8; ++d8) { if ((d8 & 1) == 0) asm volatile("" ::: "memory"); const u32x4 wv4 = *(const u32x4*)(qp + 8 * d8);
                a += bflo(wv4.x) * s[8 * d8] + bfhi(wv4.x) * s[8 * d8 + 1] + bflo(wv4.y) * s[8 * d8 + 2] + bfhi(wv4.y) * s[8 * d8 + 3] + bflo(wv4.z) * s[8 * d8 + 4] + bfhi(wv4.z) * s[8 * d8 + 5] + bflo(wv4.w) * s[8 * d8 + 6] + bfhi(wv4.w) * s[8 * d8 + 7]; }
            a += __shfl_xor(a, 32);
            a *= expf(GC[(size_t)(t0 + c) * 8 + h]);
            const bf16* ap = ATT + ((size_t)(h * NCH + n) * 64 + c) * 64; float b = 0.f;
            for (int j = 0; j <= c; ++j) b += bf2f(ap[j]) * vn[j * 512 + tid];
            if (half == 0) O[ro + e] = (bf16)f2bf(a + b); }
        const float egl = expf(gl);
#pragma unroll
        for (int d = 0; d < 64; ++d) s[d] *= egl;
        for (int c = 0; c < 64; ++c) { const size_t ro = (size_t)(t0 + c) * DM + h * HD; const bf16* kp = KN + ro + 64 * half; const float f = vn[c * 512 + tid] * expf(gl - GC[(size_t)(t0 + c) * 8 + h]);
#pragma unroll
            for (int d8 = 0; d8 < 8; ++d8) { if ((d8 & 1) == 0) asm volatile("" ::: "memory"); const u32x4 wv4 = *(const u32x4*)(kp + 8 * d8);
                s[8 * d8] += f * bflo(wv4.x); s[8 * d8 + 1] += f * bfhi(wv4.x); s[8 * d8 + 2] += f * bflo(wv4.y); s[8 * d8 + 3] += f * bfhi(wv4.y); s[8 * d8 + 4] += f * bflo(wv4.z); s[8 * d8 + 5] += f * bfhi(wv4.z); s[8 * d8 + 6] += f * bflo(wv4.w); s[8 * d8 + 7] += f * bfhi(wv4.w); } }
    }
    }
}
__device__ __forceinline__ void p_dn_out(Frame& F, const Args& A) {
    const bf16* O = WSP(const bf16, WS_O); const bf16* Z = WSP(const bf16, WS_Z); bf16* YD = WSP(bf16, WS_YD); const float* ow = A.in[6];
    for (int it = F.gw; it < S * NH; it += F.NGW) { const int t = it >> 3, h = it & 7; const size_t off = (size_t)t * DM + h * HD + 2 * F.lane;
        const unsigned ov = *(const unsigned*)(O + off), zv = *(const unsigned*)(Z + off); const float o0 = bflo(ov), o1 = bfhi(ov);
        const float rs = rsq_(wave_sum(o0 * o0 + o1 * o1) * (1.f / HD) + EPS);
        *(unsigned*)(YD + off) = pk2(o0 * rs * ow[2 * F.lane] * siluf_(bflo(zv)), o1 * rs * ow[2 * F.lane + 1] * siluf_(bfhi(zv))); }
}


constexpr size_t WS_UT = WS_O;
constexpr size_t WS_KT = WS_VN;
constexpr size_t WS_EGL = WS_KMEAN;
typedef float f32x4_t __attribute__((ext_vector_type(4)));

__device__ __forceinline__ void p_dn_relayout1(Frame& F, const Args& A) {
    bf16* QN = (bf16*)F.out; bf16* Wb = WSP(bf16, WS_W); const bf16* U = WSP(const bf16, WS_VN); bf16* UT = WSP(bf16, WS_UT); const float* GC = WSP(const float, WS_GC); float* EGL = WSP(float, WS_EGL);
    LAS unsigned short* tile = (LAS unsigned short*)(F.lds + F.wave * 16640);
    for (int it = F.gw; it < NCH * NH; it += F.NGW) { const int n = it >> 3, h = it & 7, t0 = n * CH;
        if (F.lane == 0) EGL[h * NCH + n] = expf(GC[(size_t)(t0 + 63) * 8 + h]);
        for (int c = 0; c < 64; ++c) { const size_t off = (size_t)(t0 + c) * DM + h * HD + 2 * F.lane; const float eg = expf(GC[(size_t)(t0 + c) * 8 + h]);
            const unsigned qv = *(const unsigned*)(QN + off); *(unsigned*)(QN + off) = pk2(bflo(qv) * eg, bfhi(qv) * eg);
            const unsigned wv = *(const unsigned*)(Wb + off); *(unsigned*)(Wb + off) = wv ^ 0x80008000u;
            const unsigned uv = *(const unsigned*)(U + off); *(LAS unsigned*)(tile + c * 130 + 2 * F.lane) = uv; }
        asm volatile("s_waitcnt lgkmcnt(0)" ::: "memory");
        bf16* ut = UT + (size_t)(h * NCH + n) * (HD * CH);
        for (int e = 0; e < HD; ++e) ut[e * CH + F.lane] = tile[F.lane * 130 + e];
        asm volatile("s_waitcnt lgkmcnt(0)" ::: "memory");
    }
}
__device__ __forceinline__ void p_dn_relayout2(Frame& F, const Args& A) {
    const bf16* KN = (const bf16*)F.out + (size_t)S * DM; bf16* KT = WSP(bf16, WS_KT); const float* GC = WSP(const float, WS_GC);
    LAS unsigned short* tile = (LAS unsigned short*)(F.lds + F.wave * 16640);
    for (int it = F.gw; it < NCH * NH; it += F.NGW) { const int n = it >> 3, h = it & 7, t0 = n * CH;
        for (int c = 0; c < 64; ++c) { const size_t off = (size_t)(t0 + c) * DM + h * HD + 2 * F.lane; *(LAS unsigned*)(tile + c * 130 + 2 * F.lane) = *(const unsigned*)(KN + off); }
        asm volatile("s_waitcnt lgkmcnt(0)" ::: "memory");
        const float f = expf(GC[(size_t)(t0 + 63) * 8 + h] - GC[(size_t)(t0 + F.lane) * 8 + h]);
        bf16* kt = KT + (size_t)(h * NCH + n) * (HD * CH);
        for (int d = 0; d < HD; ++d) kt[d * CH + F.lane] = (bf16)f2bf(bf2f(tile[F.lane * 130 + d]) * f);
        asm volatile("s_waitcnt lgkmcnt(0)" ::: "memory");
    }
}

constexpr size_t WS2_QN = WS_R1, WS2_KN = WS_R1 + T32, WS2_WNEG = WS_R1 + 2 * T32, WS2_ATT = WS_H, WS2_YD = WS_R1 + 2 * T32, WS2_HALT = WS_R1 + T32;
__device__ __forceinline__ bf16* ws2_kt(Frame& F) { return (bf16*)F.out; }
__device__ __forceinline__ bf16* ws2_ut(Frame& F) { return (bf16*)F.out + (size_t)S * DM; }

struct ConvHalo { unsigned q[3], k[3], v[3]; };
__device__ __forceinline__ void p_dn_conv2_halo(Frame& F, ConvHalo& H) {
    const bf16* QB = WSP(bf16, WS_R1); const bf16* KB = WSP(bf16, WS_R1 + T32); const bf16* VB = WSP(bf16, WS_R1 + 2 * T32);
    const int n = F.gw >> 3, h = F.gw & 7, t0 = n * CH, col = h * HD + 2 * F.lane;
#pragma unroll
    for (int j = 0; j < 3; ++j) { const int tt = t0 - 3 + j; H.q[j] = H.k[j] = H.v[j] = 0u;
        if (tt >= 0 && F.gw < NCH * NH) { H.q[j] = *(const unsigned*)(QB + (size_t)tt * DM + col); H.k[j] = *(const unsigned*)(KB + (size_t)tt * DM + col); H.v[j] = *(const unsigned*)(VB + (size_t)tt * DM + col); } }
}
struct ConvW { float w0[4], w1[4]; };
__device__ __forceinline__ void conv_w(const float* cw, int col, ConvW& W) {
#pragma unroll
    for (int j = 0; j < 4; ++j) { W.w0[j] = cw[(size_t)j * 3072 + col]; W.w1[j] = cw[(size_t)j * 3072 + col + 1]; }
}
__device__ __forceinline__ __amdgpu_buffer_rsrc_t mk_rsrc(const void* p) { return __builtin_amdgcn_make_buffer_rsrc((void*)p, 0, 0x7fffffff, 0x00020000); }
__device__ __forceinline__ void conv_load(const bf16* src, int t0, int col, unsigned (&xall)[CH]) {
    const __amdgpu_buffer_rsrc_t r = mk_rsrc(src + (size_t)t0 * DM);
#pragma unroll
    for (int c = 0; c < CH; ++c) xall[c] = __builtin_amdgcn_raw_buffer_load_b32(r, 2 * col, c * (DM * 2), 0);
}
template <bool NORM, bool DST, bool TILE> __device__ __forceinline__ void conv_pass(const unsigned (&xall)[CH], bf16* dst, LAS unsigned short* tile, const ConvW& W, const unsigned (&halo)[3], int t0, int col, int lane, float scale) {
    float a0 = bflo(halo[0]), a1 = bfhi(halo[0]), b0 = bflo(halo[1]), b1 = bfhi(halo[1]), c0 = bflo(halo[2]), c1 = bfhi(halo[2]);
    const __amdgpu_buffer_rsrc_t rd = mk_rsrc(DST ? dst + (size_t)t0 * DM : nullptr);
#pragma unroll
    for (int c = 0; c < CH; ++c) { const unsigned xv = xall[c]; const float d0 = bflo(xv), d1 = bfhi(xv);
        float y0 = siluf_(W.w0[0] * a0 + W.w0[1] * b0 + W.w0[2] * c0 + W.w0[3] * d0), y1 = siluf_(W.w1[0] * a1 + W.w1[1] * b1 + W.w1[2] * c1 + W.w1[3] * d1);
        if (NORM) { const float rs = scale * rsq_(wave_sum(y0 * y0 + y1 * y1) + EPS); y0 *= rs; y1 *= rs; }
        const unsigned o = pk2(y0, y1);
        if (DST) __builtin_amdgcn_raw_buffer_store_b32(o, rd, 2 * col, c * (DM * 2), 0);
        if (TILE) *(LAS unsigned*)(tile + c * 130 + 2 * lane) = o;
        a0 = b0; a1 = b1; b0 = c0; b1 = c1; c0 = d0; c1 = d1; }
}
__device__ __forceinline__ void conv_tile_out(const LAS unsigned short* tile, bf16* dstT, int lane) {
#pragma unroll 4
    for (int i = 0; i < 16; ++i) { const int d = 8 * i + (lane >> 3), ch = lane & 7; const LAS unsigned short* tp = tile + (8 * ch) * 130 + d;
        u32x4 w; w.x = (unsigned)tp[0] | ((unsigned)tp[130] << 16); w.y = (unsigned)tp[260] | ((unsigned)tp[390] << 16); w.z = (unsigned)tp[520] | ((unsigned)tp[650] << 16); w.w = (unsigned)tp[780] | ((unsigned)tp[910] << 16);
        *(u32x4*)(dstT + (size_t)d * CH + 8 * ch) = w; }
}
__device__ __forceinline__ void p_dn_conv2(Frame& F, const Args& A, const ConvHalo& H) {
    if (F.gw >= NCH * NH) return;
    bf16* QB = WSP(bf16, WS_R1); bf16* KB = WSP(bf16, WS_R1 + T32); const bf16* VB = WSP(bf16, WS_R1 + 2 * T32); const float* cw = A.in[3];
    LAS unsigned short* tile = (LAS unsigned short*)(F.lds + F.wave * 16640);
    const int n = F.gw >> 3, h = F.gw & 7, t0 = n * CH, col = h * HD + 2 * F.lane;
    bf16* ktr = ws2_kt(F) + (size_t)(h * NCH + n) * (HD * CH); bf16* vt = ws2_ut(F) + (size_t)(h * NCH + n) * (HD * CH);
    unsigned xa[CH]; ConvW W;
    conv_load(KB, t0, col, xa); conv_w(cw + 1024, col, W);
    conv_pass<true, true, true>(xa, KB, tile, W, H.k, t0, col, F.lane, 1.f);
    asm volatile("s_waitcnt lgkmcnt(0)" ::: "memory");
    conv_load(VB, t0, col, xa); conv_w(cw + 2048, col, W);
    __builtin_amdgcn_sched_barrier(0);
    conv_tile_out(tile, ktr, F.lane);
    asm volatile("s_waitcnt lgkmcnt(0)" ::: "memory");
    conv_pass<false, false, true>(xa, nullptr, tile, W, H.v, t0, col, F.lane, 1.f);
    asm volatile("s_waitcnt lgkmcnt(0)" ::: "memory");
    conv_load(QB, t0, col, xa); conv_w(cw, col, W);
    __builtin_amdgcn_sched_barrier(0);
    conv_tile_out(tile, vt, F.lane);
    asm volatile("s_waitcnt lgkmcnt(0)" ::: "memory");
    conv_pass<true, true, false>(xa, QB, tile, W, H.q, t0, col, F.lane, 0.08838834764831845f);
}

constexpr int CK_WAVE_LDS = 19200;
__device__ __forceinline__ void p_dn_chunk2(Frame& F, const Args& A) {
    if (F.gw >= NCH * NH) return;
    const int n = F.gw >> 3, h = F.gw & 7, t0 = n * CH, lane = F.lane, r = lane & 31, hh = lane >> 5;
    bf16* QN = WSP(bf16, WS2_QN); const bf16* KN = WSP(const bf16, WS2_KN); bf16* Wn = WSP(bf16, WS2_WNEG); bf16* ATT = WSP(bf16, WS2_ATT) + (size_t)(h * NCH + n) * (CH * CH);
    bf16* KT = ws2_kt(F) + (size_t)(h * NCH + n) * (HD * CH); bf16* UT = ws2_ut(F) + (size_t)(h * NCH + n) * (HD * CH);
    const float* BA = WSP(const float, WS_BA); float* EGL = WSP(float, WS_EGL);
    LAS unsigned char* wl = F.lds + F.wave * CK_WAVE_LDS; LAS float* Lw = (LAS float*)wl; LAS float* gcs = (LAS float*)(wl + 18432); LAS float* bes = gcs + 64; LAS float* fcs = bes + 64;
    float beta, gc, gl;
    { const int t = t0 + lane; const float b = BA[(size_t)t * 16 + h], a = BA[(size_t)t * 16 + 8 + h] + A.in[5][h];
      const float sp = (a > 20.f) ? a : log1pf(expf(a)); gc = -expf(A.in[4][h]) * sp; beta = 1.f / (1.f + expf(-b));
#pragma unroll
      for (int o = 1; o < 64; o <<= 1) { const float v = __shfl_up(gc, o); if (lane >= o) gc += v; }
      gl = __shfl(gc, 63);
      gcs[lane] = gc; bes[lane] = beta; fcs[lane] = expf(gl - gc);
      if (lane == 0) EGL[h * NCH + n] = expf(gl); }
    asm volatile("s_waitcnt lgkmcnt(0)" ::: "memory");
    {
        bf16x8 kf[2][8];
#pragma unroll
        for (int ti = 0; ti < 2; ++ti)
#pragma unroll
            for (int ks = 0; ks < 8; ++ks) kf[ti][ks] = *(const bf16x8*)(KN + (size_t)(t0 + 32 * ti + r) * DM + h * HD + 16 * ks + 8 * hh);
#pragma unroll
        for (int tt = 0; tt < 3; ++tt) { const int ti = (tt == 0) ? 0 : 1, tj = (tt == 2) ? 1 : 0;
            f32x16 acc;
#pragma unroll
            for (int i = 0; i < 16; ++i) acc[i] = 0.f;
#pragma unroll
            for (int ks = 0; ks < 8; ++ks) acc = __builtin_amdgcn_mfma_f32_32x32x16_bf16(kf[ti][ks], kf[tj][ks], acc, 0, 0, 0);
            const int j = 32 * tj + r; const float gcj = gcs[j];
#pragma unroll
            for (int g4 = 0; g4 < 4; ++g4) { const int i0 = 32 * ti + 8 * g4 + 4 * hh; const f32x4 gi = *(const LAS f32x4*)(gcs + i0), bi = *(const LAS f32x4*)(bes + i0);
#pragma unroll
                for (int e = 0; e < 4; ++e) { const int i = i0 + e; Lw[i * 68 + j] = (j < i) ? bi[e] * acc[4 * g4 + e] * __expf(gi[e] - gcj) : 0.f; } } }
        bf16x8 qf[2][8];
#pragma unroll
        for (int ti = 0; ti < 2; ++ti)
#pragma unroll
            for (int ks = 0; ks < 8; ++ks) qf[ti][ks] = *(const bf16x8*)(QN + (size_t)(t0 + 32 * ti + r) * DM + h * HD + 16 * ks + 8 * hh);
#pragma unroll
        for (int tt = 0; tt < 3; ++tt) { const int tj = (tt == 2) ? 1 : 0, ti = (tt == 0) ? 0 : 1;
            f32x16 acc;
#pragma unroll
            for (int i = 0; i < 16; ++i) acc[i] = 0.f;
#pragma unroll
            for (int ks = 0; ks < 8; ++ks) acc = __builtin_amdgcn_mfma_f32_32x32x16_bf16(kf[tj][ks], qf[ti][ks], acc, 0, 0, 0);
            const int i = 32 * ti + r; const float gci = gcs[i];
#pragma unroll
            for (int g4 = 0; g4 < 4; ++g4) { const int j0 = 32 * tj + 8 * g4 + 4 * hh; const f32x4 gj = *(const LAS f32x4*)(gcs + j0); float v[4];
#pragma unroll
                for (int e = 0; e < 4; ++e) v[e] = (j0 + e <= i) ? acc[4 * g4 + e] * __expf(gci - gj[e]) : 0.f;
                u32x2 w; w.x = cvtpk(v[0], v[1]); w.y = cvtpk(v[2], v[3]); *(u32x2*)(ATT + (size_t)i * CH + 32 * tj + 16 * (g4 & 1) + 8 * hh + 4 * (g4 >> 1)) = w; } }
        { const u32x4 z4 = {0u, 0u, 0u, 0u}; const int zi = lane >> 1, zj = 32 + 16 * (lane & 1); *(u32x4*)(ATT + (size_t)zi * CH + zj) = z4; *(u32x4*)(ATT + (size_t)zi * CH + zj + 8) = z4; }
#pragma unroll
        for (int ti = 0; ti < 2; ++ti) { const float eg = __expf(gcs[32 * ti + r]);
#pragma unroll
            for (int ks = 0; ks < 8; ++ks) { float f[8]; unpack8f(qf[ti][ks], f);
#pragma unroll
                for (int e = 0; e < 8; ++e) f[e] *= eg;
                const u32x4 pw = __builtin_bit_cast(u32x4, pack8f(f)); bf16* qd = QN + (size_t)(t0 + 32 * ti + r) * DM + h * HD + 32 * (ks >> 1) + 16 * hh + 4 * (ks & 1);
                u32x2 p0, p1; p0.x = pw.x; p0.y = pw.y; p1.x = pw.z; p1.y = pw.w; *(u32x2*)qd = p0; *(u32x2*)(qd + 8) = p1; } }
    }
    asm volatile("s_waitcnt lgkmcnt(0)" ::: "memory");
    float T[64];
#pragma unroll
    for (int i = 0; i < 64; ++i) { float acc = (lane == i) ? 1.f : 0.f;
#pragma unroll
        for (int j = 0; j < i; ++j) acc -= Lw[i * 68 + j] * T[j];
        T[i] = acc; }
    LAS unsigned short* Tb = (LAS unsigned short*)wl; LAS unsigned short* Tbg = Tb + 64 * 72;
    { const float eg = __expf(gc);
      asm volatile("s_waitcnt lgkmcnt(0)" ::: "memory");
#pragma unroll
      for (int i = 0; i < 64; ++i) { const float v = T[i] * beta; Tb[i * 72 + lane] = (unsigned short)f2bf(v); Tbg[i * 72 + lane] = (unsigned short)f2bf(v * eg); } }
    asm volatile("s_waitcnt lgkmcnt(0)" ::: "memory");
#ifdef DBG_CHK
    if (n < 128) { bf16* dump = WSP(bf16, 241 * MiB) + (size_t)(h * 128 + n) * 4096; for (int i = 0; i < 64; ++i) dump[i * 64 + lane] = Tbg[i * 72 + lane]; }
#endif
#ifdef DBG_CHK
    if (n < 32) { bf16* dk = WSP(bf16, 249 * MiB) + (size_t)(h * 32 + n) * 8192; for (int x = 0; x < 128; ++x) dk[x * 64 + lane] = KT[(size_t)x * CH + lane]; }
#endif
#ifdef DN2_VALU_UW
    for (int e = 0; e < HD; ++e) { float a = 0.f; for (int j2 = 0; j2 < 64; ++j2) a += bf2f(Tb[lane * 72 + j2]) * bf2f(UT[(size_t)e * CH + j2]); asm volatile("s_waitcnt vmcnt(0)" ::: "memory"); UT[(size_t)e * CH + lane] = (bf16)f2bf(a); asm volatile("s_waitcnt vmcnt(0)" ::: "memory"); }
    for (int d2 = 0; d2 < HD; ++d2) { float a = 0.f; for (int j2 = 0; j2 < 64; ++j2) a += bf2f(Tbg[lane * 72 + j2]) * bf2f(KT[(size_t)d2 * CH + j2]); Wn[(size_t)(t0 + lane) * DM + h * HD + d2] = (bf16)f2bf(-a); }
#else
#pragma unroll
    for (int te = 0; te < 4; ++te) { bf16x8 vfr[4];
#pragma unroll
        for (int ks2 = 0; ks2 < 4; ++ks2) vfr[ks2] = *(const bf16x8*)(UT + (size_t)(32 * te + r) * CH + 16 * ks2 + 8 * hh);
#pragma unroll
        for (int ti = 0; ti < 2; ++ti) { f32x16 acc;
#pragma unroll
            for (int i = 0; i < 16; ++i) acc[i] = 0.f;
#pragma unroll
            for (int ks2 = 0; ks2 < 4; ++ks2) if (ti == 1 || ks2 < 2) { const bf16x8 tb = *(const LAS bf16x8*)(Tb + (32 * ti + r) * 72 + 16 * ks2 + 8 * hh); acc = __builtin_amdgcn_mfma_f32_32x32x16_bf16(tb, vfr[ks2], acc, 0, 0, 0); }
#pragma unroll
            for (int g4 = 0; g4 < 4; ++g4) { u32x2 w; w.x = cvtpk(acc[4 * g4], acc[4 * g4 + 1]); w.y = cvtpk(acc[4 * g4 + 2], acc[4 * g4 + 3]); *(u32x2*)(UT + (size_t)(32 * te + r) * CH + 32 * ti + 8 * g4 + 4 * hh) = w; } } }
    f32x4 fsc[4][2];
#pragma unroll
    for (int ks2 = 0; ks2 < 4; ++ks2) { fsc[ks2][0] = *(const LAS f32x4*)(fcs + 16 * ks2 + 8 * hh); fsc[ks2][1] = *(const LAS f32x4*)(fcs + 16 * ks2 + 8 * hh + 4); }
#pragma unroll
    for (int td = 0; td < 4; ++td) { bf16x8 kfr[4];
#pragma unroll
        for (int ks2 = 0; ks2 < 4; ++ks2) kfr[ks2] = *(const bf16x8*)(KT + (size_t)(32 * td + r) * CH + 16 * ks2 + 8 * hh);
#pragma unroll
        for (int tc = 0; tc < 2; ++tc) { f32x16 acc;
#pragma unroll
            for (int i = 0; i < 16; ++i) acc[i] = 0.f;
#pragma unroll
            for (int ks2 = 0; ks2 < 4; ++ks2) if (tc == 1 || ks2 < 2) { const bf16x8 tg = *(const LAS bf16x8*)(Tbg + (32 * tc + r) * 72 + 16 * ks2 + 8 * hh); acc = __builtin_amdgcn_mfma_f32_32x32x16_bf16(kfr[ks2], tg, acc, 0, 0, 0); }
#pragma unroll
            for (int g4 = 0; g4 < 4; ++g4) { u32x2 w; w.x = cvtpk(-acc[4 * g4], -acc[4 * g4 + 1]); w.y = cvtpk(-acc[4 * g4 + 2], -acc[4 * g4 + 3]);
                *(u32x2*)(Wn + (size_t)(t0 + 32 * tc + r) * DM + h * HD + 32 * td + 16 * (g4 & 1) + 8 * hh + 4 * (g4 >> 1)) = w; } }
#pragma unroll
        for (int ks2 = 0; ks2 < 4; ++ks2) { float f[8]; unpack8f(kfr[ks2], f); const f32x4 f0 = fsc[ks2][0], f1 = fsc[ks2][1];
            f[0] *= f0[0]; f[1] *= f0[1]; f[2] *= f0[2]; f[3] *= f0[3]; f[4] *= f1[0]; f[5] *= f1[1]; f[6] *= f1[2]; f[7] *= f1[3];
            const u32x4 pw = __builtin_bit_cast(u32x4, pack8f(f)); const int ch = 2 * ks2 + hh; bf16* kd = KT + (size_t)(32 * td + r) * CH + 32 * (ch >> 2) + 16 * (ch & 1) + 4 * ((ch >> 1) & 1);
            u32x2 p0, p1; p0.x = pw.x; p0.y = pw.y; p1.x = pw.z; p1.y = pw.w; *(u32x2*)kd = p0; *(u32x2*)(kd + 8) = p1; } }
#endif
}

#ifndef DN2
#define DN2 1
#endif
#if DN2
#define SCAN_WNEG WS2_WNEG
#define SCAN_QP WSP(const bf16, WS2_QN)
#define SCAN_KT ws2_kt(F)
#define SCAN_UT ws2_ut(F)
#define SCAN_ATT WS2_ATT
#define SCAN_YD WS2_YD
#else
#define SCAN_WNEG WS_W
#define SCAN_QP ((const bf16*)F.out)
#define SCAN_KT WSP(bf16, WS_KT)
#define SCAN_UT WSP(bf16, WS_UT)
#define SCAN_ATT WS_ATT
#define SCAN_YD WS_YD
#endif
constexpr int SC_RW = 288, SC_RK = 160;
constexpr int SC_W = 0, SC_Q = 64 * SC_RW, SC_K = 2 * 64 * SC_RW, SC_A = SC_K + 128 * SC_RK, SC_BUF = SC_A + 64 * SC_RK;
__device__ __forceinline__ bf16x8 frag2(const LAS unsigned char* p) {
    const u32x2 a = *(const LAS u32x2*)p, b = *(const LAS u32x2*)(p + 32); u32x4 w; w.x = a.x; w.y = a.y; w.z = b.x; w.w = b.y; return __builtin_bit_cast(bf16x8, w);
}
__device__ __forceinline__ bf16x8 packb(const f32x4_t a, const f32x4_t b) { u32x4 w; w.x = cvtpk(a[0], a[1]); w.y = cvtpk(a[2], a[3]); w.z = cvtpk(b[0], b[1]); w.w = cvtpk(b[2], b[3]); return __builtin_bit_cast(bf16x8, w); }
constexpr int SCAN_WGS = 16;
__device__ __forceinline__ void p_dn_scan_fast(Frame& F, const Args& A) {
    if (blockIdx.x < SCAN_WGS) {
    const int h = blockIdx.x >> 1, hf = blockIdx.x & 1;
    const bf16* Wb = WSP(const bf16, SCAN_WNEG); const bf16* QP = SCAN_QP; const bf16* KT = SCAN_KT; const bf16* ATT = WSP(const bf16, SCAN_ATT); bf16* UT = SCAN_UT; const float* EGL = WSP(const float, WS_EGL);
    if (F.wave >= 4) {
        const int lt = F.tid - 256;
#if defined(SCAN_PROBE) && SCAN_PROBE == 2
        unsigned long long lp_sum = 0ull, lp_t0 = 0ull;
#define SCP_T0() (lp_t0 = __builtin_amdgcn_s_memrealtime())
#define SCP_T1() (lp_sum += __builtin_amdgcn_s_memrealtime() - lp_t0)
#else
#define SCP_T0() ((void)0)
#define SCP_T1() ((void)0)
#endif
        u32x4 rwA[4], rqA[4], rkA[4], raA[2], rwB[4], rqB[4], rkB[4], raB[2], rwC[4], rqC[4], rkC[4], raC[2];
#define SC_GLD(dst, voff, sbase) asm volatile("global_load_dwordx4 %0, %1, %2" : "=v"(dst) : "v"(voff), "s"(sbase) : "memory")
        const unsigned vo_w = (unsigned)((lt >> 4) * (DM * 2) + (lt & 15) * 16), vo_t = (unsigned)lt * 16u;
#define SC_ISSUE(n_, X) do { const bf16* bw_ = Wb + (size_t)((n_) * CH) * DM + h * HD; const bf16* bq_ = QP + (size_t)((n_) * CH) * DM + h * HD; \
            const bf16* bk_ = KT + (size_t)(h * NCH + (n_)) * (HD * CH); const bf16* ba_ = ATT + (size_t)(h * NCH + (n_)) * (CH * CH); \
            _Pragma("unroll") for (int i = 0; i < 4; ++i) { SC_GLD(rw##X[i], vo_w + (unsigned)i * (16u * DM * 2u), bw_); SC_GLD(rq##X[i], vo_w + (unsigned)i * (16u * DM * 2u), bq_); } \
            _Pragma("unroll") for (int i = 0; i < 4; ++i) { SC_GLD(rk##X[i], vo_t + (unsigned)i * 4096u, bk_); } \
            _Pragma("unroll") for (int i = 0; i < 2; ++i) { SC_GLD(ra##X[i], vo_t + (unsigned)i * 4096u, ba_); } } while (0)
#define SC_WAIT(N, X) asm volatile("s_waitcnt vmcnt(" #N ")" : "+v"(rw##X[0]), "+v"(rw##X[1]), "+v"(rw##X[2]), "+v"(rw##X[3]), "+v"(rq##X[0]), "+v"(rq##X[1]), "+v"(rq##X[2]), "+v"(rq##X[3]), \
            "+v"(rk##X[0]), "+v"(rk##X[1]), "+v"(rk##X[2]), "+v"(rk##X[3]), "+v"(ra##X[0]), "+v"(ra##X[1]) :: "memory")
#define SC_PUT(buf_, X) do { LAS unsigned char* b_ = F.lds + (buf_) * SC_BUF; \
            _Pragma("unroll") for (int i = 0; i < 4; ++i) { const int idx = lt + 256 * i, row = idx >> 4, ch = idx & 15; *(LAS u32x4*)(b_ + SC_W + row * SC_RW + 16 * ch) = rw##X[i]; *(LAS u32x4*)(b_ + SC_Q + row * SC_RW + 16 * ch) = rq##X[i]; } \
            _Pragma("unroll") for (int i = 0; i < 4; ++i) { const int idx = lt + 256 * i, row = idx >> 3, ch = idx & 7; *(LAS u32x4*)(b_ + SC_K + row * SC_RK + 16 * ch) = rk##X[i]; } \
            _Pragma("unroll") for (int i = 0; i < 2; ++i) { const int idx = lt + 256 * i, row = idx >> 3, ch = idx & 7; *(LAS u32x4*)(b_ + SC_A + row * SC_RK + 16 * ch) = ra##X[i]; } } while (0)
#define SC_STEP(n_, X) do { SCP_T0(); if ((n_) + 1 < NCH) { if ((n_) + 3 < NCH) SC_WAIT(28, X); else if ((n_) + 2 < NCH) SC_WAIT(14, X); else SC_WAIT(0, X); \
                SC_PUT(((n_) + 1) & 1, X); if ((n_) + 4 < NCH) SC_ISSUE((n_) + 4, X); } \
            asm volatile("s_waitcnt lgkmcnt(0)" ::: "memory"); SCP_T1(); __builtin_amdgcn_s_barrier(); } while (0)
        SC_ISSUE(0, A); SC_WAIT(0, A); SC_PUT(0, A);
        asm volatile("s_waitcnt lgkmcnt(0)" ::: "memory");
        __builtin_amdgcn_s_barrier();
        SC_ISSUE(1, A); SC_ISSUE(2, B); SC_ISSUE(3, C);
        for (int n = 0; n < NCH; n += 3) {
            SC_STEP(n, A);
            if (n + 1 < NCH) SC_STEP(n + 1, B);
            if (n + 2 < NCH) SC_STEP(n + 2, C);
        }
#if defined(SCAN_PROBE) && SCAN_PROBE == 2
        if (blockIdx.x == 0 && F.tid == 256) F.MISC[16] = (unsigned)lp_sum;
#endif
    } else {
        const int r = F.lane & 15, g = F.lane >> 4, e0 = (hf * 4 + F.wave) * 16;
        f32x4_t sacc[8];
#pragma unroll
        for (int i = 0; i < 8; ++i) sacc[i] = (f32x4_t){0.f, 0.f, 0.f, 0.f};
        bf16* utp = UT + (size_t)h * NCH * (HD * CH) + (size_t)(e0 + r) * CH + 4 * g;
        u32x2 un[4];
#pragma unroll
        for (int ct = 0; ct < 4; ++ct) un[ct] = *(const u32x2*)(utp + 16 * ct);
        float egl = EGL[h * NCH];
        __builtin_amdgcn_s_barrier();
#ifdef SCAN_PROBE
        unsigned long long sp_sum = 0ull;
#endif
        for (int n = 0; n < NCH; ++n) {
#ifdef SCAN_PROBE
            const unsigned long long sp_t0 = __builtin_amdgcn_s_memrealtime();
#endif
            const LAS unsigned char* b = F.lds + (n & 1) * SC_BUF; const LAS unsigned char* lw = b + SC_W + r * SC_RW + 16 * g; const LAS unsigned char* lq = b + SC_Q + r * SC_RW + 16 * g;
            const LAS unsigned char* lk = b + SC_K + r * SC_RK + 16 * g; const LAS unsigned char* la = b + SC_A + r * SC_RK + 16 * g;
            f32x4_t vacc[4], oacc[4]; bf16x8 sb[4], fa[16], fb[16];
#pragma unroll
            for (int ct = 0; ct < 4; ++ct)
#pragma unroll
                for (int kk = 0; kk < 4; ++kk) fa[4 * ct + kk] = *(const LAS bf16x8*)(lw + ct * 16 * SC_RW + kk * 64);
#pragma unroll
            for (int ct = 0; ct < 4; ++ct)
#pragma unroll
                for (int kk = 0; kk < 4; ++kk) fb[4 * ct + kk] = *(const LAS bf16x8*)(lq + ct * 16 * SC_RW + kk * 64);
            __builtin_amdgcn_sched_barrier(0);
#pragma unroll
            for (int kk = 0; kk < 4; ++kk) sb[kk] = packb(sacc[2 * kk], sacc[2 * kk + 1]);
#pragma unroll
            for (int ct = 0; ct < 4; ++ct) { vacc[ct] = (f32x4_t){bflo(un[ct].x), bfhi(un[ct].x), bflo(un[ct].y), bfhi(un[ct].y)}; oacc[ct] = (f32x4_t){0.f, 0.f, 0.f, 0.f}; }
            bf16* utc = utp + (size_t)n * (HD * CH);
            u32x2 unn[4]; float egln = 0.f;
            if (n + 1 < NCH) {
#pragma unroll
                for (int ct = 0; ct < 4; ++ct) unn[ct] = *(const u32x2*)(utc + HD * CH + 16 * ct);
                egln = EGL[h * NCH + n + 1]; }
#pragma unroll
            for (int kk = 0; kk < 4; ++kk)
#pragma unroll
                for (int ct = 0; ct < 4; ++ct) vacc[ct] = __builtin_amdgcn_mfma_f32_16x16x32_bf16(fa[4 * ct + kk], sb[kk], vacc[ct], 0, 0, 0);
            __builtin_amdgcn_sched_barrier(0);
#pragma unroll
            for (int mt = 0; mt < 8; ++mt)
#pragma unroll
                for (int k2 = 0; k2 < 2; ++k2) fa[2 * mt + k2] = *(const LAS bf16x8*)(lk + mt * 16 * SC_RK + k2 * 64);
            __builtin_amdgcn_sched_barrier(0);
#pragma unroll
            for (int kk = 0; kk < 4; ++kk)
#pragma unroll
                for (int ct = 0; ct < 4; ++ct) oacc[ct] = __builtin_amdgcn_mfma_f32_16x16x32_bf16(fb[4 * ct + kk], sb[kk], oacc[ct], 0, 0, 0);
            __builtin_amdgcn_sched_barrier(0);
#pragma unroll
            for (int ct = 0; ct < 4; ++ct)
#pragma unroll
                for (int k2 = 0; k2 < 2; ++k2) if (!(k2 == 1 && ct < 2)) fb[2 * ct + k2] = *(const LAS bf16x8*)(la + ct * 16 * SC_RK + k2 * 64);
            __builtin_amdgcn_sched_barrier(0);
            bf16x8 vb[2];
#pragma unroll
            for (int k2 = 0; k2 < 2; ++k2) vb[k2] = packb(vacc[2 * k2], vacc[2 * k2 + 1]);
#pragma unroll
            for (int mt = 0; mt < 8; ++mt) sacc[mt] = sacc[mt] * egl;
#pragma unroll
            for (int k2 = 0; k2 < 2; ++k2)
#pragma unroll
                for (int mt = 0; mt < 8; ++mt) sacc[mt] = __builtin_amdgcn_mfma_f32_16x16x32_bf16(fa[2 * mt + k2], vb[k2], sacc[mt], 0, 0, 0);
#pragma unroll
            for (int k2 = 0; k2 < 2; ++k2)
#pragma unroll
                for (int ct = 0; ct < 4; ++ct) if (!(k2 == 1 && ct < 2)) oacc[ct] = __builtin_amdgcn_mfma_f32_16x16x32_bf16(fb[2 * ct + k2], vb[k2], oacc[ct], 0, 0, 0);
#pragma unroll
            for (int ct = 0; ct < 4; ++ct) { u32x2 w; w.x = cvtpk(oacc[ct][0], oacc[ct][1]); w.y = cvtpk(oacc[ct][2], oacc[ct][3]); *(u32x2*)(utc + 16 * ct) = w; }
#pragma unroll
            for (int ct = 0; ct < 4; ++ct) un[ct] = unn[ct];
            egl = egln;
            asm volatile("s_waitcnt lgkmcnt(0)" ::: "memory");
#if defined(SCAN_PROBE) && SCAN_PROBE == 1
            asm volatile("s_waitcnt vmcnt(0)" ::: "memory"); sp_sum += __builtin_amdgcn_s_memrealtime() - sp_t0;
#endif
            __builtin_amdgcn_s_barrier();
        }
#if defined(SCAN_PROBE) && SCAN_PROBE == 1
        if (blockIdx.x == 0 && F.tid == 0) F.MISC[16] = (unsigned)sp_sum;
#endif
    }
    }
}

constexpr int SEG_G = 8, SEG_N = NCH / SEG_G;
constexpr size_t WS_SST = 241 * MiB;
constexpr size_t WS_MBB = 245 * MiB;
constexpr size_t WS_MBM = 249 * MiB;
static_assert(WS_MBM + (size_t)NH * (SEG_G - 1) * 128 * 128 * 4 <= WS_END, "segment scan buffers");

template <bool FINAL> __device__ __forceinline__ void scan_job(Frame& F, const Args& A, int h, int sg, int sub) {
    const bf16* Wb = WSP(const bf16, SCAN_WNEG); const bf16* QP = SCAN_QP; const bf16* KT = SCAN_KT; const bf16* ATT = WSP(const bf16, SCAN_ATT); bf16* UT = SCAN_UT; const float* EGL = WSP(const float, WS_EGL);
    const int n0 = sg * SEG_N, n1 = n0 + SEG_N;
    constexpr int NLD = FINAL ? 14 : 8;
    if (F.wave >= 4) {
        const int lt = F.tid - 256;
        u32x4 rwA[4], rqA[4], rkA[4], raA[2], rwB[4], rqB[4], rkB[4], raB[2], rwC[4], rqC[4], rkC[4], raC[2];
#define S2_GLD(dst, voff, sbase) asm volatile("global_load_dwordx4 %0, %1, %2" : "=v"(dst) : "v"(voff), "s"(sbase) : "memory")
        const unsigned vo_w = (unsigned)((lt >> 4) * (DM * 2) + (lt & 15) * 16), vo_t = (unsigned)lt * 16u;
#define S2_ISSUE(n_, X) do { const bf16* bw_ = Wb + (size_t)((n_) * CH) * DM + h * HD; const bf16* bk_ = KT + (size_t)(h * NCH + (n_)) * (HD * CH); \
            _Pragma("unroll") for (int i = 0; i < 4; ++i) { S2_GLD(rw##X[i], vo_w + (unsigned)i * (16u * DM * 2u), bw_); } \
            _Pragma("unroll") for (int i = 0; i < 4; ++i) { S2_GLD(rk##X[i], vo_t + (unsigned)i * 4096u, bk_); } \
            if constexpr (FINAL) { const bf16* bq_ = QP + (size_t)((n_) * CH) * DM + h * HD; const bf16* ba_ = ATT + (size_t)(h * NCH + (n_)) * (CH * CH); \
                _Pragma("unroll") for (int i = 0; i < 4; ++i) { S2_GLD(rq##X[i], vo_w + (unsigned)i * (16u * DM * 2u), bq_); } \
                _Pragma("unroll") for (int i = 0; i < 2; ++i) { S2_GLD(ra##X[i], vo_t + (unsigned)i * 4096u, ba_); } } } while (0)
#define S2_TIEF(X) "+v"(rw##X[0]), "+v"(rw##X[1]), "+v"(rw##X[2]), "+v"(rw##X[3]), "+v"(rq##X[0]), "+v"(rq##X[1]), "+v"(rq##X[2]), "+v"(rq##X[3]), "+v"(rk##X[0]), "+v"(rk##X[1]), "+v"(rk##X[2]), "+v"(rk##X[3]), "+v"(ra##X[0]), "+v"(ra##X[1])
#define S2_TIEA(X) "+v"(rw##X[0]), "+v"(rw##X[1]), "+v"(rw##X[2]), "+v"(rw##X[3]), "+v"(rk##X[0]), "+v"(rk##X[1]), "+v"(rk##X[2]), "+v"(rk##X[3])
#define S2_WAIT2(X) do { if constexpr (FINAL) asm volatile("s_waitcnt vmcnt(28)" : S2_TIEF(X) :: "memory"); else asm volatile("s_waitcnt vmcnt(16)" : S2_TIEA(X) :: "memory"); } while (0)
#define S2_WAIT0(X) do { if constexpr (FINAL) asm volatile("s_waitcnt vmcnt(0)" : S2_TIEF(X) :: "memory"); else asm volatile("s_waitcnt vmcnt(0)" : S2_TIEA(X) :: "memory"); } while (0)
#define S2_PUT(buf_, X) do { LAS unsigned char* b_ = F.lds + (buf_) * SC_BUF; \
            _Pragma("unroll") for (int i = 0; i < 4; ++i) { const int idx = lt + 256 * i, row = idx >> 4, ch = idx & 15; *(LAS u32x4*)(b_ + SC_W + row * SC_RW + 16 * ch) = rw##X[i]; \
                if constexpr (FINAL) *(LAS u32x4*)(b_ + SC_Q + row * SC_RW + 16 * ch) = rq##X[i]; } \
            _Pragma("unroll") for (int i = 0; i < 4; ++i) { const int idx = lt + 256 * i, row = idx >> 3, ch = idx & 7; *(LAS u32x4*)(b_ + SC_K + row * SC_RK + 16 * ch) = rk##X[i]; } \
            if constexpr (FINAL) { _Pragma("unroll") for (int i = 0; i < 2; ++i) { const int idx = lt + 256 * i, row = idx >> 3, ch = idx & 7; *(LAS u32x4*)(b_ + SC_A + row * SC_RK + 16 * ch) = ra##X[i]; } } } while (0)
#define S2_STEP(n_, X) do { S2_WAIT2(X); S2_PUT(((n_) + 1 - n0) & 1, X); { const int nn_ = ((n_) + 4 < n1) ? (n_) + 4 : n1 - 1; S2_ISSUE(nn_, X); } \
            asm volatile("s_waitcnt lgkmcnt(0)" ::: "memory"); __builtin_amdgcn_s_barrier(); } while (0)
        static_assert(SEG_N % 3 == 2, "loader tail below is written for SEG_N = 3k + 2");
        S2_ISSUE(n0, A); S2_WAIT0(A); S2_PUT(0, A);
        asm volatile("s_waitcnt lgkmcnt(0)" ::: "memory");
        __builtin_amdgcn_s_barrier();
        S2_ISSUE(n0 + 1, A); S2_ISSUE(n0 + 2, B); S2_ISSUE(n0 + 3, C);
        int n = n0;
        for (; n + 2 < n1; n += 3) { S2_STEP(n, A); S2_STEP(n + 1, B); S2_STEP(n + 2, C); }
        S2_STEP(n, A); S2_STEP(n + 1, B);
        asm volatile("s_waitcnt vmcnt(0)" ::: "memory");
    } else {
        const int r = F.lane & 15, g = F.lane >> 4;
        const int col = FINAL ? (sub * 4 + F.wave) * 16 + r : 64 * sub + 16 * F.wave + r;
        const bool real = FINAL || (col < 128);
        f32x4_t sacc[8];
        if constexpr (FINAL) { const float* sp = WSP(const float, WS_SST) + ((size_t)(h * SEG_G + sg) * 128 + col) * 128 + 4 * g;
#pragma unroll
            for (int mt = 0; mt < 8; ++mt) sacc[mt] = *(const f32x4_t*)(sp + 16 * mt); }
        else {
#pragma unroll
            for (int mt = 0; mt < 8; ++mt)
#pragma unroll
                for (int e = 0; e < 4; ++e) sacc[mt][e] = (!real && (16 * mt + 4 * g + e) == (col - 128)) ? 1.f : 0.f; }
        bf16* utp = UT + (size_t)h * NCH * (HD * CH) + (size_t)((FINAL ? col : (col & 127))) * CH + 4 * g;
        u32x2 un[4];
#pragma unroll
        for (int ct = 0; ct < 4; ++ct) { un[ct] = (u32x2){0u, 0u}; if (real) un[ct] = *(const u32x2*)(utp + (size_t)n0 * (HD * CH) + 16 * ct); }
        float egl = EGL[h * NCH + n0];
        __builtin_amdgcn_s_barrier();
        for (int n = n0; n < n1; ++n) {
            const LAS unsigned char* b = F.lds + ((n - n0) & 1) * SC_BUF; const LAS unsigned char* lw = b + SC_W + r * SC_RW + 16 * g; const LAS unsigned char* lq = b + SC_Q + r * SC_RW + 16 * g;
            const LAS unsigned char* lk = b + SC_K + r * SC_RK + 16 * g; const LAS unsigned char* la = b + SC_A + r * SC_RK + 16 * g;
            f32x4_t vacc[4], oacc[4]; bf16x8 sb[4], fa[16], fb[16];
#pragma unroll
            for (int ct = 0; ct < 4; ++ct)
#pragma unroll
                for (int kk = 0; kk < 4; ++kk) fa[4 * ct + kk] = *(const LAS bf16x8*)(lw + ct * 16 * SC_RW + kk * 64);
            if constexpr (FINAL) {
#pragma unroll
                for (int ct = 0; ct < 4; ++ct)
#pragma unroll
                    for (int kk = 0; kk < 4; ++kk) fb[4 * ct + kk] = *(const LAS bf16x8*)(lq + ct * 16 * SC_RW + kk * 64); }
            __builtin_amdgcn_sched_barrier(0);
#pragma unroll
            for (int kk = 0; kk < 4; ++kk) sb[kk] = packb(sacc[2 * kk], sacc[2 * kk + 1]);
#pragma unroll
            for (int ct = 0; ct < 4; ++ct) { vacc[ct] = (f32x4_t){bflo(un[ct].x), bfhi(un[ct].x), bflo(un[ct].y), bfhi(un[ct].y)}; oacc[ct] = (f32x4_t){0.f, 0.f, 0.f, 0.f}; }
            bf16* utc = utp + (size_t)n * (HD * CH);
            u32x2 unn[4]; float egln = 0.f;
#pragma unroll
            for (int ct = 0; ct < 4; ++ct) unn[ct] = (u32x2){0u, 0u};
            if (n + 1 < n1) { if (real) {
#pragma unroll
                    for (int ct = 0; ct < 4; ++ct) unn[ct] = *(const u32x2*)(utc + HD * CH + 16 * ct); }
                egln = EGL[h * NCH + n + 1]; }
#pragma unroll
            for (int kk = 0; kk < 4; ++kk)
#pragma unroll
                for (int ct = 0; ct < 4; ++ct) vacc[ct] = __builtin_amdgcn_mfma_f32_16x16x32_bf16(fa[4 * ct + kk], sb[kk], vacc[ct], 0, 0, 0);
            __builtin_amdgcn_sched_barrier(0);
#pragma unroll
            for (int mt = 0; mt < 8; ++mt)
#pragma unroll
                for (int k2 = 0; k2 < 2; ++k2) fa[2 * mt + k2] = *(const LAS bf16x8*)(lk + mt * 16 * SC_RK + k2 * 64);
            __builtin_amdgcn_sched_barrier(0);
            if constexpr (FINAL) {
#pragma unroll
                for (int kk = 0; kk < 4; ++kk)
#pragma unroll
                    for (int ct = 0; ct < 4; ++ct) oacc[ct] = __builtin_amdgcn_mfma_f32_16x16x32_bf16(fb[4 * ct + kk], sb[kk], oacc[ct], 0, 0, 0);
                __builtin_amdgcn_sched_barrier(0);
#pragma unroll
                for (int ct = 0; ct < 4; ++ct)
#pragma unroll
                    for (int k2 = 0; k2 < 2; ++k2) if (!(k2 == 1 && ct < 2)) fb[2 * ct + k2] = *(const LAS bf16x8*)(la + ct * 16 * SC_RK + k2 * 64);
                __builtin_amdgcn_sched_barrier(0); }
            bf16x8 vb[2];
#pragma unroll
            for (int k2 = 0; k2 < 2; ++k2) vb[k2] = packb(vacc[2 * k2], vacc[2 * k2 + 1]);
#pragma unroll
            for (int mt = 0; mt < 8; ++mt) sacc[mt] = sacc[mt] * egl;
#pragma unroll
            for (int k2 = 0; k2 < 2; ++k2)
#pragma unroll
                for (int mt = 0; mt < 8; ++mt) sacc[mt] = __builtin_amdgcn_mfma_f32_16x16x32_bf16(fa[2 * mt + k2], vb[k2], sacc[mt], 0, 0, 0);
            if constexpr (FINAL) {
#pragma unroll
                for (int k2 = 0; k2 < 2; ++k2)
#pragma unroll
                    for (int ct = 0; ct < 4; ++ct) if (!(k2 == 1 && ct < 2)) oacc[ct] = __builtin_amdgcn_mfma_f32_16x16x32_bf16(fb[2 * ct + k2], vb[k2], oacc[ct], 0, 0, 0);
#pragma unroll
                for (int ct = 0; ct < 4; ++ct) { u32x2 w; w.x = cvtpk(oacc[ct][0], oacc[ct][1]); w.y = cvtpk(oacc[ct][2], oacc[ct][3]); *(u32x2*)(utc + 16 * ct) = w; } }
#pragma unroll
            for (int ct = 0; ct < 4; ++ct) un[ct] = unn[ct];
            egl = egln;
            asm volatile("s_waitcnt lgkmcnt(0)" ::: "memory");
            __builtin_amdgcn_s_barrier();
        }
        if constexpr (!FINAL) {
            if (real) { float* bp = WSP(float, WS_MBB) + ((size_t)(h * (SEG_G - 1) + sg) * 128 + col) * 128 + 4 * g;
#pragma unroll
                for (int mt = 0; mt < 8; ++mt) *(f32x4_t*)(bp + 16 * mt) = sacc[mt]; }
            else { bf16* mp = WSP(bf16, WS_MBM) + (size_t)(h * (SEG_G - 1) + sg) * (128 * 128) + (col - 128);
#pragma unroll
                for (int mt = 0; mt < 8; ++mt)
#pragma unroll
                    for (int e = 0; e < 4; ++e) mp[(size_t)(16 * mt + 4 * g + e) * 128] = (bf16)f2bf(sacc[mt][e]); } }
    }
}
constexpr int MID_SPLIT = 8;
__device__ __forceinline__ void scan_mid(Frame& F, const Args& A, int h, int cg) {
    LAS float* Sl = (LAS float*)F.lds; LAS unsigned char* Mimg = F.lds + 16 * 132 * 4;
    float* SST = WSP(float, WS_SST) + (size_t)h * SEG_G * (128 * 128);
    const float* MBB = WSP(const float, WS_MBB) + (size_t)h * (SEG_G - 1) * (128 * 128); const bf16* MBM = WSP(const bf16, WS_MBM) + (size_t)h * (SEG_G - 1) * (128 * 128);
    const int r = F.lane & 15, g = F.lane >> 4, et = F.wave, col = 16 * cg + r;
    __syncthreads();
    for (int i = F.tid; i < 16 * 128; i += NWAVES * 64) { Sl[(i >> 7) * 132 + (i & 127)] = 0.f; SST[(size_t)(16 * cg + (i >> 7)) * 128 + (i & 127)] = 0.f; }
    u32x4 mreg[2][4]; f32x4_t accn[2];
#pragma unroll
    for (int p = 0; p < 2; ++p) {
#pragma unroll
        for (int i = 0; i < 4; ++i) mreg[p][i] = *(const u32x4*)(MBM + (size_t)p * (128 * 128) + (size_t)(F.tid + 512 * i) * 8);
        accn[p] = *(const f32x4_t*)(MBB + ((size_t)p * 128 + col) * 128 + 16 * et + 4 * g); }
#pragma unroll
    for (int sg = 0; sg < SEG_G - 1; ++sg) { const int p = sg & 1;
        __syncthreads();
#pragma unroll
        for (int i = 0; i < 4; ++i) { const int idx = F.tid + 512 * i, row = idx >> 4, ch = idx & 15; *(LAS u32x4*)(Mimg + row * 272 + 16 * ch) = mreg[p][i]; }
        if (sg + 2 < SEG_G - 1) {
#pragma unroll
            for (int i = 0; i < 4; ++i) mreg[p][i] = *(const u32x4*)(MBM + (size_t)(sg + 2) * (128 * 128) + (size_t)(F.tid + 512 * i) * 8); }
        f32x4_t acc = accn[p];
        if (sg + 2 < SEG_G - 1) accn[p] = *(const f32x4_t*)(MBB + ((size_t)(sg + 2) * 128 + col) * 128 + 16 * et + 4 * g);
        __syncthreads();
#pragma unroll
        for (int kk = 0; kk < 4; ++kk) {
            const LAS float* sp = Sl + r * 132 + 32 * kk + 8 * g; const f32x4 s0 = *(const LAS f32x4*)sp, s1 = *(const LAS f32x4*)(sp + 4);
            float sf[8] = {s0.x, s0.y, s0.z, s0.w, s1.x, s1.y, s1.z, s1.w}; const bf16x8 bfr = pack8f(sf);
            const bf16x8 afr = *(const LAS bf16x8*)(Mimg + (16 * et + r) * 272 + 64 * kk + 16 * g); acc = __builtin_amdgcn_mfma_f32_16x16x32_bf16(afr, bfr, acc, 0, 0, 0); }
        *(f32x4_t*)(SST + (size_t)(sg + 1) * (128 * 128) + (size_t)col * 128 + 16 * et + 4 * g) = acc;
        __syncthreads();
        *(LAS f32x4_t*)(Sl + r * 132 + 16 * et + 4 * g) = acc;
    }
    __syncthreads();
}
__device__ __forceinline__ void p_dn_scan2_A(Frame& F, const Args& A) { const int b = blockIdx.x; if (b < NH * (SEG_G - 1) * 4) { const int gid = 8 * (b >> 5) + (b & 7), sub = (b >> 3) & 3; scan_job<false>(F, A, gid / (SEG_G - 1), gid % (SEG_G - 1), sub); } }
__device__ __forceinline__ void p_dn_scan2_B(Frame& F, const Args& A) { if (blockIdx.x < NH * MID_SPLIT) scan_mid(F, A, blockIdx.x / MID_SPLIT, blockIdx.x % MID_SPLIT); }
__device__ __forceinline__ void p_dn_scan2_C(Frame& F, const Args& A) { const int b = blockIdx.x; if (b < NH * SEG_G * 2) { const int gid = 8 * (b >> 4) + (b & 7), sub = (b >> 3) & 1; scan_job<true>(F, A, gid / SEG_G, gid % SEG_G, sub); } }
__device__ __forceinline__ void p_dn_out_fast(Frame& F, const Args& A) {
    const bf16* OT = SCAN_UT; const bf16* Z = WSP(const bf16, WS_Z); bf16* YD = WSP(bf16, SCAN_YD); const float* ow = A.in[6];
    LAS unsigned short* tile = (LAS unsigned short*)(F.lds + F.wave * 16640);
    for (int it = F.gw; it < NCH * NH; it += F.NGW) { const int n = it >> 3, h = it & 7, t0 = n * CH;
        const bf16* ot = OT + (size_t)(h * NCH + n) * (HD * CH);
        u32x4 ov[16]; unsigned zall[CH];
#pragma unroll
        for (int i = 0; i < 16; ++i) { const int e = 8 * i + (F.lane >> 3), ch = F.lane & 7; ov[i] = *(const u32x4*)(ot + (size_t)e * CH + 8 * ch); }
#pragma unroll
        for (int c = 0; c < CH; ++c) zall[c] = *(const unsigned*)(Z + (size_t)(t0 + c) * DM + h * HD + 2 * F.lane);
        const float w0 = ow[2 * F.lane], w1 = ow[2 * F.lane + 1];
#pragma unroll
        for (int i = 0; i < 16; ++i) { const int e = 8 * i + (F.lane >> 3), ch = F.lane & 7; const u32x4 v = ov[i]; LAS unsigned short* tp = tile + e * 65 + 8 * ch;
            tp[0] = (unsigned short)v.x; tp[1] = (unsigned short)(v.x >> 16); tp[2] = (unsigned short)v.y; tp[3] = (unsigned short)(v.y >> 16); tp[4] = (unsigned short)v.z; tp[5] = (unsigned short)(v.z >> 16); tp[6] = (unsigned short)v.w; tp[7] = (unsigned short)(v.w >> 16); }
        asm volatile("s_waitcnt lgkmcnt(0)" ::: "memory");
#pragma unroll
        for (int c = 0; c < CH; ++c) { const float o0 = bf2f(tile[(2 * F.lane) * 65 + c]), o1 = bf2f(tile[(2 * F.lane + 1) * 65 + c]);
            const float rs = rsq_(wave_sum(o0 * o0 + o1 * o1) * (1.f / HD) + EPS);
            const size_t off = (size_t)(t0 + c) * DM + h * HD + 2 * F.lane; const unsigned zv = zall[c];
            *(unsigned*)(YD + off) = pk2(o0 * rs * w0 * siluf_(bflo(zv)), o1 * rs * w1 * siluf_(bfhi(zv))); }
        asm volatile("s_waitcnt lgkmcnt(0)" ::: "memory");
    }
}
#ifdef DBG_ATTN
constexpr int CW_DBG = 20000;
__device__ __forceinline__ void dbg_compare(Frame& F, const bf16* a, const bf16* b, size_t n) {
    float* acc = (float*)(WSP(unsigned, WS_CTL) + CW_DBG); float d2 = 0.f, r2 = 0.f;
    for (size_t i = (size_t)F.gw * 64 + F.lane; i < n; i += (size_t)F.NGW * 64) { const float x = bf2f(a[i]), y = bf2f(b[i]); d2 += (x - y) * (x - y); r2 += y * y; }
    d2 = wave_sum(d2); r2 = wave_sum(r2);
    if (F.lane == 0) { atomicAdd(acc, d2); atomicAdd(acc + 1, r2); }
}
#endif

#if defined(DBG_DET) || defined(DBG_L2L)
constexpr int CW_CS = 24000;
__device__ __forceinline__ void dbg_cksum(Frame& F, const void* p, size_t bytes, int slot) {
    const unsigned* w = (const unsigned*)p; unsigned acc = 0u; const size_t nw = bytes / 4;
#ifdef DBG_NANCNT
    for (size_t i = (size_t)F.gw * 64 + F.lane; i < nw; i += (size_t)F.NGW * 64) { const unsigned v = w[i]; acc += ((v & 0x7F80u) >= (141u << 7)) + ((v & 0x7F800000u) >= (141u << 23)); }
#else
    for (size_t i = (size_t)F.gw * 64 + F.lane; i < nw; i += (size_t)F.NGW * 64) { const unsigned v = w[i]; acc += v * 2654435761u + (unsigned)(i * 40503u) * (v >> 7); }
#endif
#pragma unroll
    for (int o = 1; o < 64; o <<= 1) acc += __shfl_xor(acc, o);
    if (F.lane == 0) atomicAdd(WSP(unsigned, WS_CTL) + CW_CS + slot, acc);
}
#endif

#ifdef DBG_SIG
constexpr int CW_SIG = 26000;
__device__ __forceinline__ void dbg_sig(Frame& F, const bf16* p, size_t n, int slot) {
    double acc = 0.0, acc2 = 0.0;
    for (size_t i = (size_t)F.gw * 64 + F.lane; i < n; i += (size_t)F.NGW * 64) { unsigned hsh = (unsigned)i * 2654435761u; hsh ^= hsh >> 15; hsh *= 2246822519u; hsh ^= hsh >> 13;
        const float wgt = (float)(hsh & 0xFFFFu) * (1.f / 32768.f) - 1.f; const float x = bf2f(p[i]); acc += (double)(x * wgt); acc2 += (double)(x * x); }
    long long q1 = (long long)(acc * 65536.0), q2 = (long long)(acc2 * 65536.0);
#pragma unroll
    for (int o = 1; o < 64; o <<= 1) { q1 += __shfl_xor(q1, o); q2 += __shfl_xor(q2, o); }
    if (F.lane == 0) { unsigned long long* a = (unsigned long long*)(WSP(unsigned, WS_CTL) + CW_SIG); atomicAdd(a + 2 * slot, (unsigned long long)q1); atomicAdd(a + 2 * slot + 1, (unsigned long long)q2); }
}
#endif

#ifdef DBG_CHK
constexpr int CW_CHK = 28000;
__device__ __forceinline__ float dbg_g(const float* BA, const Args& A, int t, int h) { const float a = BA[(size_t)t * 16 + 8 + h] + A.in[5][h]; const float sp = (a > 20.f) ? a : log1pf(expf(a)); return -expf(A.in[4][h]) * sp; }
__device__ __forceinline__ void dbg_chk_acc(Frame& F, int k, float err, float ref) {
    long long q1 = (long long)((double)err * (double)err * 1048576.0), q2 = (long long)((double)ref * (double)ref * 1048576.0);
    unsigned long long* a = (unsigned long long*)(WSP(unsigned, WS_CTL) + CW_CHK); atomicAdd(a + 2 * k, (unsigned long long)q1); atomicAdd(a + 2 * k + 1, (unsigned long long)q2);
}
__device__ __forceinline__ void dbg_chunk2_check(Frame& F, const Args& A) {
    const float* BA = WSP(const float, WS_BA); const bf16* KN = WSP(const bf16, WS2_KN); const bf16* QP = WSP(const bf16, WS2_QN); const bf16* Wn = WSP(const bf16, WS2_WNEG);
    const bf16* ATT = WSP(const bf16, WS2_ATT); const bf16* KT = ws2_kt(F); const float* EGL = WSP(const float, WS_EGL);
    const int s = F.gw * 64 + F.lane; if (s >= 8192) return;
    unsigned hsh = (unsigned)s * 2654435761u; hsh ^= hsh >> 15; hsh *= 2246822519u; hsh ^= hsh >> 13;
    const int n = hsh & 255, h = (hsh >> 8) & 7, i = (hsh >> 11) & 63, d = (hsh >> 17) & 127, t0 = n * CH;
    float gci = 0.f, gl = 0.f; { float a = 0.f; for (int j = 0; j < 64; ++j) { a += dbg_g(BA, A, t0 + j, h); if (j == i) gci = a; } gl = a; }
    const float beta_i = 1.f / (1.f + expf(-BA[(size_t)(t0 + i) * 16 + h]));
    const bf16* ki = KN + (size_t)(t0 + i) * DM + h * HD;
    dbg_chk_acc(F, 0, EGL[h * NCH + n] - expf(gl), expf(gl));
    { const float ref = bf2f(ki[d]) * expf(gl - gci); dbg_chk_acc(F, 1, bf2f(KT[(size_t)(h * NCH + n) * (HD * CH) + (size_t)d * CH + i]) - ref, ref); }
    { const float kt = bf2f(KT[(size_t)(h * NCH + n) * (HD * CH) + (size_t)d * CH + i]); dbg_chk_acc(F, 4, kt - bf2f(ki[d]), bf2f(ki[d])); }
    if (n < 128) { const int c = d & 63; const bf16* tg = WSP(const bf16, 241 * MiB) + (size_t)(h * 128 + n) * 4096; float lhs = bf2f(tg[i * 64 + c]); float gcj = 0.f, gcc = 0.f;
      for (int j = 0; j < 64; ++j) { gcj += dbg_g(BA, A, t0 + j, h); if (j == c) gcc = gcj;
          if (j < i) { const bf16* kj = KN + (size_t)(t0 + j) * DM + h * HD; float dot = 0.f; for (int x = 0; x < HD; ++x) dot += bf2f(ki[x]) * bf2f(kj[x]); lhs += beta_i * dot * expf(gci - gcj) * bf2f(tg[j * 64 + c]); } }
      const float beta_c = 1.f / (1.f + expf(-BA[(size_t)(t0 + c) * 16 + h])); const float ref = (i == c) ? beta_c * expf(gcc) : 0.f; dbg_chk_acc(F, 5, lhs - ref, (i == c) ? ref : 0.05f * beta_c * expf(gcc)); }
    if (n < 128) { const bf16* tg = WSP(const bf16, 241 * MiB) + (size_t)(h * 128 + n) * 4096; float ref = 0.f, mag = 0.f;
      for (int j = 0; j < 64; ++j) { const float t = bf2f(tg[i * 64 + j]) * bf2f(KN[(size_t)(t0 + j) * DM + h * HD + d]); ref += t; mag += fabsf(t); }
      dbg_chk_acc(F, 6, -bf2f(Wn[(size_t)(t0 + i) * DM + h * HD + d]) - ref, mag); }
    if (n < 128) { const bf16* tg = WSP(const bf16, 241 * MiB) + (size_t)(h * 128 + n) * 4096; float r7 = 0.f, r8 = 0.f, mag = 0.f, gcj = 0.f;
      for (int j = 0; j < 64; ++j) { gcj += dbg_g(BA, A, t0 + j, h); const float kk = bf2f(KN[(size_t)(t0 + j) * DM + h * HD + d]); const float t = bf2f(tg[i * 64 + j]) * kk;
          r7 += t * expf(gl - gcj); r8 += bf2f(tg[j * 64 + i]) * kk; mag += fabsf(t); }
      const float wv = -bf2f(Wn[(size_t)(t0 + i) * DM + h * HD + d]); dbg_chk_acc(F, 7, wv - r7, mag); dbg_chk_acc(F, 8, wv - r8, mag); }
    if (n < 32) { const bf16* dk = WSP(const bf16, 249 * MiB) + (size_t)(h * 32 + n) * 8192; dbg_chk_acc(F, 9, bf2f(dk[d * 64 + i]) - bf2f(ki[d]), bf2f(ki[d])); }
    if (n < 32) { const float ref = bf2f(ki[d]) * expf(gl - gci); dbg_chk_acc(F, 10, bf2f(KT[(size_t)(h * NCH + n) * (HD * CH) + (size_t)d * CH + i]) - ref, ref); }
    if (n < 128) { const bf16* tg = WSP(const bf16, 241 * MiB) + (size_t)(h * 128 + n) * 4096; float ref = 0.f, mag = 0.f;
      for (int j = 0; j < 64; ++j) { const float t = bf2f(tg[i * 64 + j]) * bf2f(KN[(size_t)(t0 + j) * DM + h * HD + d]); ref += t; mag += fabsf(t); }
      dbg_chk_acc(F, n >= 32 ? 11 : 12, -bf2f(Wn[(size_t)(t0 + i) * DM + h * HD + d]) - ref, mag); }
    { float lhs = -bf2f(Wn[(size_t)(t0 + i) * DM + h * HD + d]); float gcj = 0.f;
      for (int j = 0; j < i; ++j) { gcj += dbg_g(BA, A, t0 + j, h); const bf16* kj = KN + (size_t)(t0 + j) * DM + h * HD; float dot = 0.f; for (int x = 0; x < HD; ++x) dot += bf2f(ki[x]) * bf2f(kj[x]);
          lhs += beta_i * dot * expf(gci - gcj) * (-bf2f(Wn[(size_t)(t0 + j) * DM + h * HD + d])); }
      const float ref = beta_i * expf(gci) * bf2f(ki[d]); dbg_chk_acc(F, 2, lhs - ref, ref); }
    { const int j = d & 63; if (j <= i && gci > -20.f) { float gcj = 0.f; for (int x = 0; x <= j; ++x) gcj += dbg_g(BA, A, t0 + x, h);
          const bf16* kj = KN + (size_t)(t0 + j) * DM + h * HD; const bf16* qi = QP + (size_t)(t0 + i) * DM + h * HD; float dot = 0.f; for (int x = 0; x < HD; ++x) dot += bf2f(qi[x]) * bf2f(kj[x]);
          const float ref = dot * expf(-gcj); dbg_chk_acc(F, 3, bf2f(ATT[(size_t)(h * NCH + n) * (CH * CH) + (size_t)i * CH + j]) - ref, ref); }
      else if (j > i) dbg_chk_acc(F, 3, bf2f(ATT[(size_t)(h * NCH + n) * (CH * CH) + (size_t)i * CH + j]), 0.f); }
}
#endif

#ifdef DBG_TILE
constexpr int CW_TILE = 30000;
__device__ __forceinline__ void dbg_tile_check(Frame& F, const Args& A) {
    if (F.gw >= NCH * NH) return;
    const int n = F.gw >> 3, h = F.gw & 7, t0 = n * CH, lane = F.lane;
    const float* BA = WSP(const float, WS_BA); const bf16* KN = WSP(const bf16, WS2_KN); const bf16* KT = ws2_kt(F) + (size_t)(h * NCH + n) * (HD * CH);
    float gc = 0.f, gl = 0.f; { float a = 0.f; for (int j = 0; j < 64; ++j) { a += dbg_g(BA, A, t0 + j, h); if (j == lane) gc = a; } gl = a; }
    const float f = expf(gl - gc); int bad = 0;
    for (int d = 0; d < HD; ++d) { const float ref = bf2f(KN[(size_t)(t0 + lane) * DM + h * HD + d]) * f; const float got = bf2f(KT[(size_t)d * CH + lane]); if (!(fabsf(got - ref) <= 0.02f * fabsf(ref) + 1e-3f)) ++bad; }
    bad = (int)wave_sum((float)bad);
    if (lane == 0 && bad > 0) { unsigned* w = WSP(unsigned, WS_CTL) + CW_TILE; atomicAdd(w, 1u); atomicMin(w + 1, (unsigned)n); atomicOr(w + 2 + n, 1u << h); atomicAdd(w + 300, (unsigned)bad); atomicOr(w + 301, 1u << h); if (bad > 4096) atomicOr(w + 302, 1u << h); }
}
#endif
template <int R> __device__ __forceinline__ void post_rows(Frame& F, const Args& A, int m0, int stride) {
    const float* x = A.in[0]; const bf16* T = WSP(const bf16, WS_T); bf16* H2 = WSP(bf16, WS_H2);
    const f32x4* w1 = (const f32x4*)A.in[10] + F.lane; const f32x4* w2 = (const f32x4*)A.in[11] + F.lane;
    unsigned long long t8[R][4]; f32x4 xv[R][4];
#pragma unroll
    for (int k = 0; k < R; ++k) { const int m = m0 + k * stride; const unsigned long long* tr = (const unsigned long long*)(T + (size_t)m * DM) + F.lane; const f32x4* xr = (const f32x4*)(x + (size_t)m * DM) + F.lane;
#pragma unroll
        for (int j = 0; j < 4; ++j) { t8[k][j] = tr[64 * j]; xv[k][j] = xr[64 * j]; } }
#pragma unroll
    for (int k = 0; k < R; ++k) { const int m = m0 + k * stride; f32x4* orow = (f32x4*)(F.out + (size_t)m * DM) + F.lane;
        f32x4 tv[4]; float ss = 0.f;
#pragma unroll
        for (int j = 0; j < 4; ++j) { const unsigned long long w8 = t8[k][j]; const unsigned lo = (unsigned)w8, hi = (unsigned)(w8 >> 32); tv[j] = (f32x4){bflo(lo), bfhi(lo), bflo(hi), bfhi(hi)}; ss += (tv[j].x * tv[j].x + tv[j].y * tv[j].y) + (tv[j].z * tv[j].z + tv[j].w * tv[j].w); }
        const float rs = rsq_(wave_sum(ss) * (1.f / DM) + EPS); float s2 = 0.f;
#pragma unroll
        for (int j = 0; j < 4; ++j) { tv[j] = xv[k][j] + tv[j] * rs * w1[64 * j]; orow[64 * j] = tv[j]; s2 += (tv[j].x * tv[j].x + tv[j].y * tv[j].y) + (tv[j].z * tv[j].z + tv[j].w * tv[j].w); }
        const float r2 = rsq_(wave_sum(s2) * (1.f / DM) + EPS);
        unsigned long long* o8 = (unsigned long long*)(H2 + (size_t)m * DM) + F.lane;
#pragma unroll
        for (int j = 0; j < 4; ++j) { const f32x4 hv = tv[j] * r2 * w2[64 * j]; o8[64 * j] = (unsigned long long)pk2(hv.x, hv.y) | ((unsigned long long)pk2(hv.z, hv.w) << 32); } }
}
__device__ __forceinline__ void p_post_mix(Frame& F, const Args& A) {
    int m = F.gw;
    for (; m + F.NGW < S; m += 2 * F.NGW) post_rows<2>(F, A, m, F.NGW);
    if (m < S) post_rows<1>(F, A, m, F.NGW);
}
#if !defined(DBG_NAN) && !defined(DBG_DET) && !defined(DBG_ATTN)
template <int R> __device__ __forceinline__ void final_rows(Frame& F, const Args& A, int m0, int stride) {
    const bf16* Fd = WSP(const bf16, WS_F); const f32x4* w = (const f32x4*)A.in[15] + F.lane;
    unsigned long long f8[R][4]; f32x4 xv[R][4];
#pragma unroll
    for (int k = 0; k < R; ++k) { const int m = m0 + k * stride; const unsigned long long* fr = (const unsigned long long*)(Fd + (size_t)m * DM) + F.lane; const f32x4* orow = (const f32x4*)(F.out + (size_t)m * DM) + F.lane;
#pragma unroll
        for (int j = 0; j < 4; ++j) { f8[k][j] = fr[64 * j]; xv[k][j] = orow[64 * j]; } }
#pragma unroll
    for (int k = 0; k < R; ++k) { const int m = m0 + k * stride; f32x4* orow = (f32x4*)(F.out + (size_t)m * DM) + F.lane;
        f32x4 fv[4]; float ss = 0.f;
#pragma unroll
        for (int j = 0; j < 4; ++j) { const unsigned long long w8 = f8[k][j]; const unsigned lo = (unsigned)w8, hi = (unsigned)(w8 >> 32); fv[j] = (f32x4){bflo(lo), bfhi(lo), bflo(hi), bfhi(hi)}; ss += (fv[j].x * fv[j].x + fv[j].y * fv[j].y) + (fv[j].z * fv[j].z + fv[j].w * fv[j].w); }
        const float rs = rsq_(wave_sum(ss) * (1.f / DM) + EPS);
#pragma unroll
        for (int j = 0; j < 4; ++j) orow[64 * j] = xv[k][j] + fv[j] * rs * w[64 * j]; }
}
__device__ __forceinline__ void p_final(Frame& F, const Args& A) {
    int m = F.gw;
    for (; m + F.NGW < S; m += 2 * F.NGW) final_rows<2>(F, A, m, F.NGW);
    if (m < S) final_rows<1>(F, A, m, F.NGW);
}
#else
__device__ __forceinline__ void p_final(Frame& F, const Args& A) {
    const bf16* Fd = WSP(const bf16, WS_F);
    for (int m = F.gw; m < S; m += F.NGW) {
        const unsigned long long* fr = (const unsigned long long*)(Fd + (size_t)m * DM) + F.lane; f32x4* orow = (f32x4*)(F.out + (size_t)m * DM) + F.lane; const f32x4* w = (const f32x4*)A.in[15] + F.lane;
        f32x4 fv[4]; float ss = 0.f;
#pragma unroll
        for (int j = 0; j < 4; ++j) { const unsigned long long w8 = fr[64 * j]; const unsigned lo = (unsigned)w8, hi = (unsigned)(w8 >> 32); fv[j] = (f32x4){bflo(lo), bfhi(lo), bflo(hi), bfhi(hi)}; ss += (fv[j].x * fv[j].x + fv[j].y * fv[j].y) + (fv[j].z * fv[j].z + fv[j].w * fv[j].w); }
        const float rs = rsq_(wave_sum(ss) * (1.f / DM) + EPS);
#pragma unroll
        for (int j = 0; j < 4; ++j) { f32x4 ov = orow[64 * j] + fv[j] * rs * w[64 * j];
#ifdef DBG_NAN
#pragma unroll
            for (int e = 0; e < 4; ++e) if (!(fabsf(ov[e]) < 1e30f)) ov[e] = 12345.f;
#endif
            orow[64 * j] = ov; }
#ifdef DBG_DET
        { const unsigned* cs = WSP(const unsigned, WS_CTL) + CW_CS; float pz = 0.f;
          for (int k = 12; k >= 0; --k) if (cs[k] != cs[16 + k]) pz = __builtin_ldexpf(1.f, 40 - 2 * k);
#pragma unroll
          for (int j = 0; j < 4; ++j) orow[64 * j] = orow[64 * j] + pz; }
#endif
#ifdef DBG_ATTN
        { const float* acc = (const float*)(WSP(unsigned, WS_CTL) + CW_DBG); const float rv = acc[0] / acc[1]; const float pz = !(rv < DBG_TOL) ? 1000.f : 0.f;
#pragma unroll
          for (int j = 0; j < 4; ++j) orow[64 * j] = orow[64 * j] + pz; }
#endif
    }
}

#endif
constexpr int NPHASE = 18;
#ifndef MK_N_LAUNCHES
#define MK_N_LAUNCHES 1
#endif
constexpr int N_LAUNCHES = MK_N_LAUNCHES;
__global__ void __launch_bounds__(NWAVES * 64, 2) fwd(Args args) {
    extern __shared__ __attribute__((aligned(16))) unsigned char lds[];
    Frame F;
    F.lds = (LAS unsigned char*)lds; F.MISC = (volatile LAS unsigned*)(F.lds + MISC_OFF);
    F.tid = threadIdx.x; F.lane = F.tid & 63; F.wave = __builtin_amdgcn_readfirstlane(F.tid >> 6);
    F.G = gridDim.x; F.gw = blockIdx.x * NWAVES + F.wave; F.NGW = F.G * NWAVES;
    F.out = args.out; F.ws = args.ws;
    for (int u = F.tid; u < (LDS_BYTES - LDSCTL_OFF) / 4; u += NWAVES * 64) ((LAS unsigned*)(F.lds + LDSCTL_OFF))[u] = 0u;
    __syncthreads();
    XcdBarrier bar; bar.bar = (unsigned*)(F.ws + WS_CTL) + CW_BAR; bar.x = 0; bar.st = nullptr;
    if (N_LAUNCHES == 1) bar = xcd_barrier_post((unsigned*)(F.ws + WS_CTL) + CW_BAR, F.MISC + 8);
#define GRID_BAR() do { if (N_LAUNCHES == 1) xcd_barrier(bar); } while (0)
    const int lo = args.ph_lo, hi = args.ph_hi;
#ifdef PROBE_LO
    unsigned long long pr_t0 = 0ull, pr_dt = 0ull;
#define PROBE_AT(k) do { if (blockIdx.x == 0 && F.tid == 0) { if ((k) == PROBE_LO) pr_t0 = __builtin_amdgcn_s_memrealtime(); if ((k) == PROBE_HI + 1) pr_dt = __builtin_amdgcn_s_memrealtime() - pr_t0; } } while (0)
#else
#define PROBE_AT(k) do {} while (0)
#endif
#ifdef DBG_L2L
#define CK(k, p, n) dbg_cksum(F, (p), (n), (k))
#define CKB() GRID_BAR()
#else
#define CK(k, p, n) do {} while (0)
#define CKB() do {} while (0)
#endif
#if defined(ONLY_PH)
#define PH_EN(k) ((k) == ONLY_PH)
#elif defined(PH_MASK)
#define PH_EN(k) (((PH_MASK) >> (k)) & 1)
#else
#define PH_EN(k) true
#endif
#define IN(k) (PH_EN(k) && lo <= (k) && (k) < hi)
#define BOTH(k) (IN(k) && IN((k) + 1))
#define GEMM(EPI, Aoff, Boff, N_, K_, ...) do { pg8::Gemm g{(const pg8::bf16_t*)(F.ws + (Aoff)), (const pg8::bf16_t*)(F.ws + (Boff)), S, (N_), (K_)}; pg8::StaticOrder So; So.init(S, (N_), F.G, (int)blockIdx.x); \
        EPI E{__VA_ARGS__}; pg8::gemm_phase<EPI, pg8::StaticOrder, true, true>(F.lds + RING_OFF, g, So, E); } while (0)

    PROBE_AT(0);
    if (IN(0)) { p_prologue(F, args); if (BOTH(0)) GRID_BAR(); }
    CK(0, F.ws + WS_H, T32); CK(0, F.ws + WS_BA, 1 * MiB); CK(0, F.ws + WS_WTA, 41 * MiB - 512 * 1024); CKB();
    PROBE_AT(1);
    if (IN(1)) { GEMM(pg8::EpiRope, WS_H, WS_WTA, 3072, DM, WSP(pg8::bf16_t, WS_R1), WSP(const float, WS_COS), WSP(const float, WS_SIN), WSP(float, WS_KMEAN)); if (BOTH(1)) GRID_BAR(); }
    CK(1, F.ws + WS_R1, 3 * T32); CKB();
    PROBE_AT(2);
#ifndef TOPK2
#define TOPK2 1
#endif
#if !TOPK2
    if (IN(2)) { p_kmean(F, args); if (BOTH(2)) GRID_BAR(); }
#endif
    CK(2, F.ws + WS_KMEAN, 256 * 1024); CKB();
#ifndef ATTN_FAST
#define ATTN_FAST 1
#endif
#if ATTN_FAST
    PROBE_AT(3);
#if TOPK2
    if (IN(3)) { p_topk2(F, args); if (BOTH(3)) GRID_BAR(); }
#else
    if (IN(3)) { p_topk_bucket(F, args); if (BOTH(3)) GRID_BAR(); }
#endif
    CK(3, F.ws + WS_TOPI, (size_t)S * NH * 12); CKB();
    PROBE_AT(4);
#ifdef WGSTAT
#define WGSTAT_RUN(k, call) do { const unsigned long long t0_ = __builtin_amdgcn_s_memrealtime(); call; if (WGSTAT_PH == (k)) { __syncthreads(); if (F.tid == 0) { const unsigned dt_ = (unsigned)(__builtin_amdgcn_s_memrealtime() - t0_); \
        unsigned* w_ = WSP(unsigned, WS_CTL) + 30000; atomicMax(w_, dt_); atomicAdd(w_ + 1, dt_); atomicMin(w_ + 2, 0xFFFFFFFFu - dt_); } } } while (0)
#else
#define WGSTAT_RUN(k, call) call
#endif
    if (IN(4)) { PROBE_AT(40); WGSTAT_RUN(40, p_attn_sel(F, args)); GRID_BAR(); PROBE_AT(41); WGSTAT_RUN(41, p_attn_own(F, args)); PROBE_AT(42);
#ifdef DBG_ATTN
        GRID_BAR(); p_attn_naive(F, args); GRID_BAR(); dbg_compare(F, WSP(const bf16, WS_YA), (const bf16*)F.out, (size_t)S * DM);
#endif
        if (BOTH(4)) GRID_BAR(); }
    CK(4, F.ws + WS_YA, T32); CKB();
#else
    PROBE_AT(3);
    if (IN(3)) { p_topk(F, args); if (BOTH(3)) GRID_BAR(); }
    PROBE_AT(4);
    if (IN(4)) { p_attn_naive(F, args); if (BOTH(4)) GRID_BAR(); }
#endif
#ifdef DBG_CHK
    {   GEMM(pg8::EpiGen<0>, WS_H, WS_WTB, 4096, DM, WSP(pg8::bf16_t, WS_R1), DM, 1024, (size_t)S * DM, nullptr); GRID_BAR();
        { ConvHalo hl; p_dn_conv2_halo(F, hl); GRID_BAR(); p_dn_conv2(F, args, hl); GRID_BAR(); }
        p_dn_chunk2(F, args); GRID_BAR();
        dbg_chunk2_check(F, args); GRID_BAR();
#ifdef DBG_TILE
        if (blockIdx.x == 0 && F.tid == 0) WSP(unsigned, WS_CTL)[CW_TILE + 1] = 0xFFFFu; GRID_BAR(); dbg_tile_check(F, args); GRID_BAR();
#endif
        }
#elif defined(DBG_SIG)
    {
      { Frame Fp = F; asm volatile("" : "+s"(Fp.ws), "+s"(Fp.out), "+v"(Fp.lane), "+v"(Fp.tid));
        GEMM(pg8::EpiGen<0>, WS_H, WS_WTB, 4096, DM, WSP(pg8::bf16_t, WS_R1), DM, 1024, (size_t)S * DM, nullptr); GRID_BAR();
        p_dn_conv(Fp, args); GRID_BAR(); p_dn_chunk(Fp, args); GRID_BAR(); p_dn_relayout1(Fp, args); GRID_BAR(); p_dn_relayout2(Fp, args); GRID_BAR();
        dbg_sig(Fp, (const bf16*)Fp.out, (size_t)S * DM, 0); dbg_sig(Fp, WSPF(const bf16, WS_W), (size_t)S * DM, 1); dbg_sig(Fp, WSPF(const bf16, WS_KT), (size_t)S * DM, 2);
        dbg_sig(Fp, WSPF(const bf16, WS_UT), (size_t)S * DM, 3); dbg_sig(Fp, WSPF(const bf16, WS_ATT), (size_t)S * DM / 2, 4); GRID_BAR();
      }
      { Frame Fp = F; asm volatile("" : "+s"(Fp.ws), "+s"(Fp.out), "+v"(Fp.lane), "+v"(Fp.tid));
        p_hrecompute(Fp, args); GRID_BAR();
        GEMM(pg8::EpiGen<0>, WS_H, WS_WTB, 4096, DM, WSP(pg8::bf16_t, WS_R1), DM, 1024, (size_t)S * DM, nullptr); GRID_BAR();
        { ConvHalo hl; p_dn_conv2_halo(Fp, hl); GRID_BAR(); p_dn_conv2(Fp, args, hl); GRID_BAR(); }
        p_dn_chunk2(Fp, args); GRID_BAR();
        dbg_sig(Fp, WSPF(const bf16, WS2_QN), (size_t)S * DM, 8); dbg_sig(Fp, WSPF(const bf16, WS2_WNEG), (size_t)S * DM, 9); dbg_sig(Fp, ws2_kt(Fp), (size_t)S * DM, 10);
        dbg_sig(Fp, ws2_ut(Fp), (size_t)S * DM, 11); dbg_sig(Fp, WSPF(const bf16, WS2_ATT), (size_t)S * DM / 2, 12); GRID_BAR();
      }
    }
#elif defined(DBG_DET)
#define DET_PASS(P) { Frame Fp = F; asm volatile("" : "+s"(Fp.ws), "+s"(Fp.out), "+v"(Fp.lane), "+v"(Fp.tid)); \
    p_hrecompute(Fp, args); GRID_BAR(); \
    GEMM(pg8::EpiGen<0>, WS_H, WS_WTB, 4096, DM, WSP(pg8::bf16_t, WS_R1), DM, 1024, (size_t)S * DM, nullptr); GRID_BAR(); \
    dbg_cksum(Fp, Fp.ws + WS_R1, 4 * T32, (P) * 16 + 0); GRID_BAR(); \
    { ConvHalo hl; p_dn_conv2_halo(Fp, hl); GRID_BAR(); p_dn_conv2(Fp, args, hl); GRID_BAR(); } \
    dbg_cksum(Fp, Fp.ws + WS2_QN, T32, (P) * 16 + 1); dbg_cksum(Fp, Fp.ws + WS2_KN, T32, (P) * 16 + 2); dbg_cksum(Fp, ws2_kt(Fp), T32, (P) * 16 + 3); dbg_cksum(Fp, ws2_ut(Fp), T32, (P) * 16 + 4); GRID_BAR(); \
    p_dn_chunk2(Fp, args); GRID_BAR(); \
    dbg_cksum(Fp, Fp.ws + WS2_ATT, T32 / 2, (P) * 16 + 5); dbg_cksum(Fp, Fp.ws + WS2_QN, T32, (P) * 16 + 6); dbg_cksum(Fp, ws2_ut(Fp), T32, (P) * 16 + 7); dbg_cksum(Fp, Fp.ws + WS2_WNEG, T32, (P) * 16 + 8); \
    dbg_cksum(Fp, ws2_kt(Fp), T32, (P) * 16 + 9);  GRID_BAR(); \
    p_dn_scan_fast(Fp, args); GRID_BAR(); \
    dbg_cksum(Fp, ws2_ut(Fp), T32, (P) * 16 + 11); GRID_BAR(); \
    p_dn_out_fast(Fp, args); GRID_BAR(); \
    dbg_cksum(Fp, Fp.ws + WS2_YD, T32, (P) * 16 + 12); GRID_BAR(); }
    { DET_PASS(0) }
    { DET_PASS(1) }
    p_hrecompute(F, args); GRID_BAR();
#else
    PROBE_AT(5);
    if (IN(5)) { GEMM(pg8::EpiGen<0>, WS_H, WS_WTB, 4096, DM, WSP(pg8::bf16_t, WS_R1), DM, 1024, (size_t)S * DM, nullptr); if (BOTH(5)) GRID_BAR(); }
    CK(5, F.ws + WS_R1, 4 * T32); CKB();
#if DN2
    PROBE_AT(6);
    if (IN(6)) { ConvHalo hl; p_dn_conv2_halo(F, hl); GRID_BAR(); p_dn_conv2(F, args, hl); if (BOTH(6)) GRID_BAR(); }
    CK(6, F.ws + WS2_QN, 2 * T32); CK(6, F.out, 2 * T32); CKB();
    PROBE_AT(7);
    if (IN(7)) { p_dn_chunk2(F, args); if (BOTH(7)) GRID_BAR(); }
    CK(7, F.ws + WS2_ATT, T32 / 2); CK(7, F.ws + WS2_QN, T32); CK(7, F.out, 2 * T32); CK(7, F.ws + WS2_WNEG, T32); CK(7, F.ws + WS_EGL, 8192); CKB();
#else
    PROBE_AT(6);
    if (IN(6)) { p_dn_conv(F, args); if (BOTH(6)) GRID_BAR(); }
    PROBE_AT(7);
    if (IN(7)) { p_dn_chunk(F, args); if (BOTH(7)) GRID_BAR(); }
#endif
#ifndef DN_FAST
#define DN_FAST 1
#endif
#if DN_FAST
#if DN2
    PROBE_AT(8);
#ifndef SCAN2
#define SCAN2 1
#endif
#if SCAN2
    if (IN(8)) { PROBE_AT(80); p_dn_scan2_A(F, args); GRID_BAR(); PROBE_AT(81); p_dn_scan2_B(F, args); GRID_BAR(); PROBE_AT(82); if (blockIdx.x < 128) p_dn_scan2_C(F, args); else { p_hrecompute_sub(F, args, WSP(bf16, WS2_HALT), ((int)blockIdx.x - 128) * NWAVES + F.wave, 128 * NWAVES);
#if DN2_LATE_WT
            p_wtrans(F, args, WT_ITEMS_EARLY, WT_ITEMS_ALL, ((int)blockIdx.x - 128) * NWAVES + F.wave, 128 * NWAVES);
#endif
        } if (BOTH(8)) GRID_BAR(); PROBE_AT(83); }
#else
    if (IN(8)) { p_dn_scan_fast(F, args); if (BOTH(8)) GRID_BAR(); }
#endif
    CK(8, ws2_ut(F), T32); CKB();
#else
    PROBE_AT(8);
    if (IN(8)) { p_dn_relayout1(F, args); GRID_BAR(); p_dn_relayout2(F, args); GRID_BAR(); p_dn_scan_fast(F, args); if (BOTH(8)) GRID_BAR(); }
#endif
    PROBE_AT(9);
#if DN2 && SCAN2
    if (IN(9)) { p_dn_out_fast(F, args); if (BOTH(9)) GRID_BAR(); }
#else
    if (IN(9)) { p_dn_out_fast(F, args); p_hrecompute(F, args); if (BOTH(9)) GRID_BAR(); }
#endif
    CK(9, F.ws + WS2_YD, T32); CK(9, F.ws + WS_H, T32); CKB();
#else
    PROBE_AT(8);
    if (IN(8)) { p_dn_scan_naive(F, args); if (BOTH(8)) GRID_BAR(); }
    PROBE_AT(9);
    if (IN(9)) { p_dn_out(F, args); p_hrecompute(F, args); if (BOTH(9)) GRID_BAR(); }
#endif
#endif
    PROBE_AT(10);
    if (IN(10)) { GEMM(pg8::EpiGen<1>, WS2_HALT, WS_WTG, 2048, DM, (pg8::bf16_t*)F.out, DM, 1024, (size_t)S * DM, nullptr); if (BOTH(10)) GRID_BAR(); }
    CK(10, F.out, 2 * T32); CKB();
    PROBE_AT(11);
    if (IN(11)) { GEMM(pg8::EpiGen<2>, WS_YA, WS_WTOA, 1024, DM, (pg8::bf16_t*)F.out, DM, 0, 0, nullptr); if (BOTH(11)) GRID_BAR(); }
    CK(11, F.out, T32); CKB();
    PROBE_AT(12);
    if (IN(12)) { GEMM(pg8::EpiGen<3>, SCAN_YD, WS_WTOD, 1024, DM, (pg8::bf16_t*)F.out, DM, 0, 0, (const pg8::bf16_t*)F.out + (size_t)S * DM); if (BOTH(12)) GRID_BAR(); }
    CK(12, F.out, T32); CKB();
    PROBE_AT(13);
    if (IN(13)) { pg8::Gemm g{(const pg8::bf16_t*)F.out, WSP(const pg8::bf16_t, WS_WTOUT), S, DM, DM}; pg8::StaticOrder So; So.init(S, DM, F.G, (int)blockIdx.x);
        pg8::EpiGen<0> E{WSP(pg8::bf16_t, WS_T), DM, 0, 0, nullptr}; pg8::gemm_phase<pg8::EpiGen<0>, pg8::StaticOrder, true, true>(F.lds + RING_OFF, g, So, E); if (BOTH(13)) GRID_BAR(); }
    CK(13, F.ws + WS_T, 2 * T32); CKB();
    PROBE_AT(14);
    if (IN(14)) { p_post_mix(F, args); if (BOTH(14)) GRID_BAR(); }
    CK(14, F.out, 2 * T32); CK(14, F.ws + WS_H2, T32); CKB();
    PROBE_AT(15);
    if (IN(15)) { GEMM(pg8::EpiGen<4>, WS_H2, WS_WTGU, 2 * DFF, DM, WSP(pg8::bf16_t, WS_ACT), DFF, 0, 0, nullptr); if (BOTH(15)) GRID_BAR(); }
    CK(15, F.ws + WS_ACT, ACT_BYTES); CKB();
    PROBE_AT(16);
    if (IN(16)) { pg8::Gemm g{WSP(const pg8::bf16_t, WS_ACT), WSP(const pg8::bf16_t, WS_WTDN), S, DM, DFF}; pg8::StaticOrder So; So.init(S, DM, F.G, (int)blockIdx.x);
        pg8::EpiGen<0> E{WSP(pg8::bf16_t, WS_F), DM, 0, 0, nullptr}; pg8::gemm_phase<pg8::EpiGen<0>, pg8::StaticOrder, true, true>(F.lds + RING_OFF, g, So, E); if (BOTH(16)) GRID_BAR(); }
    CK(16, F.ws + WS_F, 2 * T32); CKB();
#ifdef DBG_TILE
    PROBE_AT(17);
    if (IN(17)) { const unsigned* w = WSP(const unsigned, WS_CTL) + CW_TILE; const unsigned cnt = w[0], mn = w[1]; const unsigned hm = (mn < 256u) ? w[2 + mn] : 0u;
        const int sel = DBG_TILE; const unsigned val = (sel == 1) ? (cnt > 120u ? 120u : cnt) : (sel == 2) ? (mn > 255u ? 127u : (mn >> 1)) : (sel == 3 ? (mn & 1u) * 8u + 0u + (hm & 0xFu) * 0u + (hm & 0xFFu) / 4u : (hm & 3u));
        float pz = __builtin_ldexpf(1.f, (int)val + 4); if (sel == 6) pz = __builtin_ldexpf(1.f, (int)(w[301] & 15u) + 4); if (sel == 7) pz = __builtin_ldexpf(1.f, (int)(w[301] >> 4) + 4); if (sel == 8) pz = __builtin_ldexpf(1.f, (int)(w[302] & 15u) + 4); if (sel == 9) pz = __builtin_ldexpf(1.f, (int)(w[302] >> 4) + 4);
        if (sel == 5) { unsigned be = w[300], lg = 0; while (be > 1u) { be >>= 1; ++lg; } pz = __builtin_ldexpf(1.f, (int)lg + 4); }
        for (size_t i = (size_t)F.gw * 64 + F.lane; i < (size_t)S * DM; i += (size_t)F.NGW * 64) F.out[i] = args.in[0][i] + pz; }
#elif defined(DBG_CHK)
    PROBE_AT(17);
    if (IN(17)) { const long long* sg = (const long long*)(WSP(unsigned, WS_CTL) + CW_CHK); float pz = 0.f;
        for (int k = 12; k >= 9; --k) { const double e2 = (double)sg[2 * k], r2 = (double)sg[2 * k + 1]; if (!(e2 <= 1e-3 * r2 + 16.0)) pz += 1024.f * (float)(1 << (2 * (k - 9))); }
        for (size_t i = (size_t)F.gw * 64 + F.lane; i < (size_t)S * DM; i += (size_t)F.NGW * 64) F.out[i] = args.in[0][i] + pz; }
#elif defined(DBG_SIG)
    PROBE_AT(17);
    if (IN(17)) { const long long* sg = (const long long*)(WSP(unsigned, WS_CTL) + CW_SIG); float pz = 0.f;
        for (int k = 4; k >= 0; --k) { const float a0 = (float)((double)sg[2 * k] / 65536.0), a1 = (float)((double)sg[2 * (8 + k)] / 65536.0), n0 = (float)((double)sg[2 * k + 1] / 65536.0), n1 = (float)((double)sg[2 * (8 + k) + 1] / 65536.0);
            const bool bad = !(fabsf(a0 - a1) <= 0.02f * sqrtf(n0) + 1e-3f) || !(fabsf(n0 - n1) <= 0.02f * (n0 + n1)); if (bad) pz = __builtin_ldexpf(1.f, 40 - 2 * k); }
        for (size_t i = (size_t)F.gw * 64 + F.lane; i < (size_t)S * DM; i += (size_t)F.NGW * 64) F.out[i] = args.in[0][i] + pz; }
#elif defined(DBG_DET)
    PROBE_AT(17);
    if (IN(17)) { const unsigned* cs = WSP(const unsigned, WS_CTL) + CW_CS; float pz = 0.f;
#ifdef DBG_NANCNT
        for (int k = 12; k >= 0; --k) if (cs[k] != 0u) pz = __builtin_ldexpf(1.f, 40 - 2 * k);
#else
        for (int k = 12; k >= 0; --k) if (cs[k] != cs[16 + k]) pz = __builtin_ldexpf(1.f, 40 - 2 * k);
#endif
        for (size_t i = (size_t)F.gw * 64 + F.lane; i < (size_t)S * DM; i += (size_t)F.NGW * 64) F.out[i] = args.in[0][i] + pz; }
#else
    PROBE_AT(17);
    if (IN(17)) { p_final(F, args); }
#endif
#ifdef WGSTAT
    if (blockIdx.x == 0 && F.tid == 0) { const unsigned* w_ = WSP(const unsigned, WS_CTL) + 30000; const unsigned v0 = __hip_atomic_load(w_, __ATOMIC_RELAXED, __HIP_MEMORY_SCOPE_AGENT), v1 = __hip_atomic_load(w_ + 1, __ATOMIC_RELAXED, __HIP_MEMORY_SCOPE_AGENT), v2 = __hip_atomic_load(w_ + 2, __ATOMIC_RELAXED, __HIP_MEMORY_SCOPE_AGENT);
        const unsigned long long dd = 8ull * (unsigned long long)(WGSTAT == 1 ? v0 : (WGSTAT == 2 ? v1 / (unsigned)F.G : 0xFFFFFFFFu - v2));
        const unsigned long long ts = __builtin_amdgcn_s_memrealtime(); while (__builtin_amdgcn_s_memrealtime() - ts < dd) __builtin_amdgcn_s_sleep(8); }
#endif
#ifdef SCAN_PROBE
    __syncthreads();
    if (blockIdx.x == 0 && F.tid == 0) { const unsigned long long ts = __builtin_amdgcn_s_memrealtime(); const unsigned long long dd = 8ull * (unsigned long long)F.MISC[16]; while (__builtin_amdgcn_s_memrealtime() - ts < dd) __builtin_amdgcn_s_sleep(8); }
#endif
#ifdef PROBE_LO
    PROBE_AT(18);
    if (blockIdx.x == 0 && F.tid == 0) { const unsigned long long ts = __builtin_amdgcn_s_memrealtime(); while (__builtin_amdgcn_s_memrealtime() - ts < 8ull * pr_dt) __builtin_amdgcn_s_sleep(8); }
#endif
#ifdef DBG_L2L
    GRID_BAR(); CK(17, F.out, 2 * T32); GRID_BAR();
    { unsigned* cs = WSP(unsigned, WS_CTL) + CW_CS; unsigned* save = WSP(unsigned, 253 * MiB);
      if (args.pass == 0) { if (blockIdx.x == 0 && F.tid < 32) save[F.tid] = cs[F.tid]; }
      else { float pz = 0.f; for (int k = 17; k >= 0; --k) if (cs[k] != save[k]) pz = __builtin_ldexpf(1.f, 44 - 2 * k);
          if (pz != 0.f) for (size_t i = (size_t)F.gw * 64 + F.lane; i < (size_t)S * DM; i += (size_t)F.NGW * 64) F.out[i] += pz; } }
#endif
#undef IN
#undef BOTH
}

extern "C" void kernel_launch(void* const* d_in, const int* in_sizes, int n_in, void* d_out, int out_size, void* d_ws, size_t ws_size, hipStream_t stream) {
    static int grid = 0;
    if (grid == 0) {
        if (n_in != 16 || in_sizes[0] != S * DM || out_size != S * DM || ws_size < WS_END) { fprintf(stderr, "kernel_launch: unexpected shapes (n_in %d, in0 %d, out %d, ws %zu); nothing launched\n", n_in, n_in > 0 ? in_sizes[0] : -1, out_size, ws_size); grid = -1; return; }
        int dev = 0, cus = 0, per_cu = 0;
        if (hipGetDevice(&dev) != hipSuccess || hipDeviceGetAttribute(&cus, hipDeviceAttributeMultiprocessorCount, dev) != hipSuccess) { grid = -1; return; }
        if (hipFuncSetAttribute((const void*)fwd, hipFuncAttributeMaxDynamicSharedMemorySize, LDS_BYTES) != hipSuccess) { fprintf(stderr, "kernel_launch: hipFuncSetAttribute failed\n"); grid = -1; return; }
        if (hipOccupancyMaxActiveBlocksPerMultiprocessor(&per_cu, (const void*)fwd, NWAVES * 64, LDS_BYTES) != hipSuccess || per_cu < 1) fprintf(stderr, "kernel_launch: occupancy query says %d\n", per_cu);
        (void)hipGetLastError();
        grid = cus;
    }
    if (grid < 0) return;
    if (hipMemsetAsync((char*)d_ws + WS_CTL, 0, CTL_ZERO_BYTES, stream) != hipSuccess) return;
    Args a{};
    for (int i = 0; i < 16; ++i) a.in[i] = (const float*)d_in[i];
    a.out = (float*)d_out; a.ws = (unsigned char*)d_ws;
#ifdef DBG_L2L
    hipMemsetAsync((char*)d_ws + CTL_ZERO_BYTES, 0xA5, WS_END - CTL_ZERO_BYTES, stream); hipMemsetAsync(d_out, 0xA5, (size_t)S * DM * 4, stream);
    for (int li = 0; li < 2; ++li) {
        if (li == 1) hipMemsetAsync((char*)d_ws + WS_CTL, 0, CTL_ZERO_BYTES, stream);
        a.ph_lo = 0; a.ph_hi = NPHASE; a.pass = li;
#else
    for (int li = 0; li < N_LAUNCHES; ++li) {
        a.ph_lo = (N_LAUNCHES == 1) ? 0 : li; a.ph_hi = (N_LAUNCHES == 1) ? NPHASE : li + 1;
#endif
        hipLaunchKernelGGL(fwd, dim3(grid), dim3(NWAVES * 64), LDS_BYTES, stream, a);
        if (hipPeekAtLastError() != hipSuccess) { fprintf(stderr, "kernel_launch: launch %d failed\n", li); break; }
    }
}
```

```cpp
#include <hip/hip_runtime.h>
#include <cstdio>
#include <cstdint>
#include <cmath>
namespace pg8 {
#define PG8_LAS __attribute__((address_space(3)))
typedef unsigned short bf16_t;
typedef short bf16x8 __attribute__((ext_vector_type(8)));
typedef float f32x4 __attribute__((ext_vector_type(4)));
typedef unsigned u32x4 __attribute__((ext_vector_type(4)));
constexpr int BM = 256, BK = 64, HALF = 128, HTB = HALF * BK * 2  , STAGE_BYTES = 8 * HTB, NXCD = 8, WGM = 8;

__host__ __device__ __forceinline__ int lds_byte(int r, int c) { const int st = (r >> 4) * 2 + (c >> 5), rr = r & 15, cc = c & 31, ob = rr * 64 + cc * 2; return st * 1024 + (ob ^ (((ob >> 9) & 1) << 5)); }
__host__ __device__ __forceinline__ void stage_rc(int b, int& R, int& C) { const int st = b / 1024, sb = b % 1024, swz = sb ^ (((sb >> 9) & 1) << 5); R = (st >> 1) * 16 + swz / 64; C = (st & 1) * 32 + (swz % 64) / 2; }
__host__ __device__ __forceinline__ int perm32(int rho) { const int n = rho >> 4, i = rho & 15; return 8 * (i >> 2) + 4 * n + (i & 3); }

struct Unit { int pm, pn; };
struct Gemm { const bf16_t* A; const bf16_t* Bt; int M, N, K; };

struct StaticOrder {
    int nM, nN, nwg, G, c;
    __host__ __device__ void init(int M, int N, int G_, int c_) { nM = M / BM; nN = N / BM; nwg = nM * nN; G = G_; c = c_; }
    __host__ __device__ bool next(int i, Unit& u) const {
        const long L = (long)i * G + c; if (L >= nwg) return false;
        int wgid = (int)L; { const int q = nwg / NXCD, r = nwg % NXCD, xcd = wgid % NXCD, off = wgid / NXCD; wgid = (xcd < r ? xcd * (q + 1) : r * (q + 1) + (xcd - r) * q) + off; }
        const int nig = WGM * nN, gid = wgid / nig, fm = gid * WGM, gsz = (nM - fm) < WGM ? (nM - fm) : WGM;
        u.pm = fm + ((wgid % nig) % gsz); u.pn = (wgid % nig) / gsz; return true;
    }
    __device__ __forceinline__ void a_ready(const Unit&) const {}
    __device__ __forceinline__ void done(const Unit&) const {}
};

__device__ __forceinline__ unsigned cvt_pk_bf16(float lo, float hi) { typedef __bf16 b2 __attribute__((ext_vector_type(2))); typedef float f2 __attribute__((ext_vector_type(2))); const f2 v = {lo, hi}; return __builtin_bit_cast(unsigned, __builtin_convertvector(v, b2)); }
template <class Epi, class Sched, bool ALIGN_EPI = false, bool SP2 = false>
__device__ __forceinline__ void gemm_phase(PG8_LAS unsigned char* lds, const Gemm g, const Sched& S, const Epi& E) {
    const int tid = threadIdx.x, wid = __builtin_amdgcn_readfirstlane(tid >> 6), lane = tid & 63, wr = wid >> 2, wc = wid & 3, fr = lane & 15, fq = lane >> 4;
    const int K = g.K, nt = K / BK;
    unsigned voffA[2], voffB[2];
#pragma unroll
    for (int i = 0; i < 2; ++i) { int R, C; stage_rc(tid * 16 + i * 8192, R, C); const int Rb = Epi::PERM ? ((R & ~31) + perm32(R & 31)) : R;
        voffA[i] = (unsigned)(R * K + C) * 2u; voffB[i] = (unsigned)(Rb * K + C) * 2u; }
    const size_t kstep = (size_t)(BK * 2);
    const size_t hstep = (size_t)HALF * K * 2;
    const size_t tstep = 2 * hstep;
    const unsigned ldsw = (unsigned)wid * 1024u;
    const int aoff = lds_byte(wr * 64 + fr, fq * 8), boff = lds_byte(wc * 32 + fr, fq * 8);
#define PG8_SA(b, h) (((b) * 2 + (h)) * HTB)
#define PG8_SB(b, h) ((4 + (b) * 2 + (h)) * HTB)
#define PG8_STAGE(bufoff, gbase, voff) do { _Pragma("unroll") for (int _i = 0; _i < 2; ++_i) \
        __builtin_amdgcn_global_load_lds((const unsigned*)((const char*)(gbase) + (voff)[_i]), (PG8_LAS unsigned*)(lds + (bufoff) + ldsw + _i * 8192), 16, 0, 0); } while (0)
#define PG8_LDA(dst, b, h) do { _Pragma("unroll") for (int m = 0; m < 4; ++m) _Pragma("unroll") for (int k = 0; k < 2; ++k) dst[m][k] = *(const PG8_LAS bf16x8*)(lds + PG8_SA(b, h) + aoff + m * 2048 + k * 1024); } while (0)
#define PG8_LDB(dst, b, h) do { _Pragma("unroll") for (int n = 0; n < 2; ++n) _Pragma("unroll") for (int k = 0; k < 2; ++k) dst[n][k] = *(const PG8_LAS bf16x8*)(lds + PG8_SB(b, h) + boff + n * 2048 + k * 1024); } while (0)
#define PG8_MMA(ai, bj, At, Bt) do { __builtin_amdgcn_s_setprio(1); _Pragma("unroll") for (int m = 0; m < 4; ++m) _Pragma("unroll") for (int n = 0; n < 2; ++n) _Pragma("unroll") for (int k = 0; k < 2; ++k) \
        acc[ai][bj][m][n] = __builtin_amdgcn_mfma_f32_16x16x32_bf16(Bt[n][k], At[m][k], acc[ai][bj][m][n], 0, 0, 0); __builtin_amdgcn_s_setprio(0); } while (0)
#define PG8_WAIT_V(n) asm volatile("s_waitcnt vmcnt(" #n ")" ::: "memory")
#define PG8_WAIT_L(n) asm volatile("s_waitcnt lgkmcnt(" #n ")" ::: "memory")
#define PG8_BAR __builtin_amdgcn_s_barrier()
#define PG8_SCHED __builtin_amdgcn_sched_barrier(0)
    Unit cur, nxt; int ui = 0;
    if (!S.next(0, cur)) return;
    f32x4 acc[2][2][4][2];
#pragma unroll
    for (int a = 0; a < 2; ++a)
#pragma unroll
        for (int b = 0; b < 2; ++b)
#pragma unroll
            for (int m = 0; m < 4; ++m)
#pragma unroll
                for (int n = 0; n < 2; ++n) acc[a][b][m][n] = (f32x4){0.f, 0.f, 0.f, 0.f};
    bf16x8 At[4][2], B0[2][2], B1[2][2];
    const char* cA = (const char*)g.A + (size_t)cur.pm * tstep; const char* cB = (const char*)g.Bt + (size_t)cur.pn * tstep;
    S.a_ready(cur);
    if constexpr (SP2) {
        PG8_STAGE(PG8_SB(0, 0), cB, voffB); PG8_STAGE(PG8_SB(0, 1), cB + hstep, voffB); PG8_STAGE(PG8_SA(0, 0), cA, voffA); PG8_STAGE(PG8_SA(0, 1), cA + hstep, voffA);
        if (wr == 1) PG8_BAR;
        PG8_WAIT_V(2); PG8_BAR;
        PG8_STAGE(PG8_SB(1, 0), cB + kstep, voffB); PG8_STAGE(PG8_SA(1, 0), cA + kstep, voffA); PG8_STAGE(PG8_SB(1, 1), cB + hstep + kstep, voffB);
        PG8_WAIT_V(6); PG8_BAR;
    } else {
        PG8_STAGE(PG8_SB(0, 0), cB, voffB); PG8_STAGE(PG8_SA(0, 0), cA, voffA); PG8_STAGE(PG8_SB(0, 1), cB + hstep, voffB); PG8_STAGE(PG8_SA(0, 1), cA + hstep, voffA);
        if (wr == 1) PG8_BAR;
        PG8_WAIT_V(4); PG8_BAR;
        PG8_STAGE(PG8_SB(1, 0), cB + kstep, voffB); PG8_STAGE(PG8_SA(1, 0), cA + kstep, voffA); PG8_STAGE(PG8_SB(1, 1), cB + hstep + kstep, voffB);
        PG8_WAIT_V(6); PG8_BAR;
    }
    for (;;) {
        const bool has_next = S.next(ui + 1, nxt);
        const char* nA = has_next ? (const char*)g.A + (size_t)nxt.pm * tstep : cA; const char* nB = has_next ? (const char*)g.Bt + (size_t)nxt.pn * tstep : cB;
        for (int t = 0; t < nt; t += 2) {
            const bool last = (t == nt - 2);
            const char* a1 = cA + (size_t)(t + 1) * kstep;
            const char* a2 = last ? nA : cA + (size_t)(t + 2) * kstep; const char* b2 = last ? nB : cB + (size_t)(t + 2) * kstep;
            const char* a3 = a2 + kstep; const char* b3 = b2 + kstep;
            if (last && has_next) S.a_ready(nxt);
            if constexpr (SP2) {
            PG8_LDB(B0, 0, 0); PG8_LDB(B1, 0, 1); PG8_SCHED; PG8_LDA(At, 0, 0); PG8_STAGE(PG8_SA(1, 1), a1 + hstep, voffA);
            PG8_WAIT_V(8); PG8_WAIT_L(0); PG8_BAR; PG8_MMA(0, 0, At, B0); PG8_MMA(0, 1, At, B1); PG8_BAR; PG8_SCHED;
            PG8_LDA(At, 0, 1); PG8_STAGE(PG8_SB(0, 0), b2, voffB); PG8_STAGE(PG8_SB(0, 1), b2 + hstep, voffB); PG8_STAGE(PG8_SA(0, 0), a2, voffA);
            PG8_WAIT_V(8); PG8_WAIT_L(0); PG8_BAR; PG8_MMA(1, 0, At, B0); PG8_MMA(1, 1, At, B1); PG8_BAR; PG8_SCHED;
            PG8_LDB(B0, 1, 0); PG8_LDB(B1, 1, 1); PG8_SCHED; PG8_LDA(At, 1, 0); PG8_STAGE(PG8_SA(0, 1), a2 + hstep, voffA);
            PG8_WAIT_V(8); PG8_WAIT_L(0); PG8_BAR; PG8_MMA(0, 0, At, B0); PG8_MMA(0, 1, At, B1); PG8_BAR; PG8_SCHED;
            PG8_LDA(At, 1, 1); PG8_STAGE(PG8_SB(1, 0), b3, voffB); PG8_STAGE(PG8_SB(1, 1), b3 + hstep, voffB); PG8_STAGE(PG8_SA(1, 0), a3, voffA);
            PG8_WAIT_V(8); PG8_WAIT_L(0); PG8_BAR; PG8_MMA(1, 0, At, B0); PG8_MMA(1, 1, At, B1); PG8_BAR; PG8_SCHED;
            } else {
            PG8_LDB(B0, 0, 0); PG8_SCHED; PG8_LDA(At, 0, 0); PG8_STAGE(PG8_SA(1, 1), a1 + hstep, voffA);
            PG8_WAIT_L(8); PG8_BAR; PG8_WAIT_L(0); PG8_MMA(0, 0, At, B0); PG8_BAR; PG8_SCHED;
            PG8_LDB(B1, 0, 1); PG8_STAGE(PG8_SB(0, 0), b2, voffB);
            PG8_BAR; PG8_WAIT_L(0); PG8_MMA(0, 1, At, B1); PG8_BAR;
            PG8_LDA(At, 0, 1); PG8_STAGE(PG8_SA(0, 0), a2, voffA);
            PG8_BAR; PG8_WAIT_L(0); PG8_MMA(1, 0, At, B0); PG8_BAR; PG8_SCHED;
            PG8_STAGE(PG8_SB(0, 1), b2 + hstep, voffB);
            PG8_WAIT_V(6); PG8_BAR; PG8_MMA(1, 1, At, B1); PG8_BAR;
            PG8_LDB(B0, 1, 0); PG8_SCHED; PG8_LDA(At, 1, 0); PG8_STAGE(PG8_SA(0, 1), a2 + hstep, voffA);
            PG8_WAIT_L(8); PG8_BAR; PG8_WAIT_L(0); PG8_MMA(0, 0, At, B0); PG8_BAR; PG8_SCHED;
            PG8_LDB(B1, 1, 1); PG8_STAGE(PG8_SB(1, 0), b3, voffB);
            PG8_BAR; PG8_WAIT_L(0); PG8_MMA(0, 1, At, B1); PG8_BAR;
            PG8_LDA(At, 1, 1); PG8_STAGE(PG8_SA(1, 0), a3, voffA);
            PG8_BAR; PG8_WAIT_L(0); PG8_MMA(1, 0, At, B0); PG8_BAR; PG8_SCHED;
            PG8_STAGE(PG8_SB(1, 1), b3 + hstep, voffB);
            PG8_WAIT_V(6); PG8_BAR; PG8_MMA(1, 1, At, B1); PG8_BAR;
            }
        }
        if constexpr (ALIGN_EPI) { if (wr == 0) PG8_BAR; }
        if constexpr (!Epi::AFTER_DRAIN) { E(acc, cur, wr, wc, fr, fq); S.done(cur); }
        if (!has_next) break;
#pragma unroll
        for (int a = 0; a < 2; ++a)
#pragma unroll
            for (int b = 0; b < 2; ++b)
#pragma unroll
                for (int m = 0; m < 4; ++m)
#pragma unroll
                    for (int n = 0; n < 2; ++n) acc[a][b][m][n] = (f32x4){0.f, 0.f, 0.f, 0.f};
        cur = nxt; cA = nA; cB = nB; ++ui;
        if constexpr (ALIGN_EPI) { if (wr == 1) PG8_BAR; }
    }
    PG8_WAIT_V(0);
    if constexpr (!ALIGN_EPI) { if (wr == 0) PG8_BAR; }
    PG8_BAR;
    if constexpr (Epi::AFTER_DRAIN) { E.fused(acc, cur, wr, wc, fr, fq, lds, wid, lane); S.done(cur); }
#undef PG8_SA
#undef PG8_SB
#undef PG8_STAGE
#undef PG8_LDA
#undef PG8_LDB
#undef PG8_MMA
#undef PG8_WAIT_V
#undef PG8_WAIT_L
#undef PG8_BAR
#undef PG8_SCHED
}
}
#define GAS __attribute__((address_space(1)))
#define LAS __attribute__((address_space(3)))
typedef unsigned short bf16;
typedef unsigned v4u __attribute__((ext_vector_type(4)));
typedef float f32x4 __attribute__((ext_vector_type(4)));
typedef short bf16x8 __attribute__((ext_vector_type(8)));
typedef GAS unsigned gu32;
typedef GAS unsigned long long gu64;
#define RLX_AGENT __ATOMIC_RELAXED, __HIP_MEMORY_SCOPE_AGENT
#define LDS_WAIT() asm volatile("s_waitcnt lgkmcnt(0)" ::: "memory")
#define VM_WAIT() asm volatile("s_waitcnt vmcnt(0)" ::: "memory")
__device__ __forceinline__ unsigned long long rt() { return __builtin_amdgcn_s_memrealtime(); }
typedef __bf16 hbf2_t __attribute__((ext_vector_type(2)));
typedef float hf2_t __attribute__((ext_vector_type(2)));
__device__ __forceinline__ unsigned pk2(float lo, float hi) { const hf2_t v = {lo, hi}; return __builtin_bit_cast(unsigned, __builtin_convertvector(v, hbf2_t)); }
__device__ __forceinline__ unsigned f2bf(float f) { return pk2(f, 0.f) & 0xffffu; }

#define XB_TMO      128
#define XB_XCNT(j)  (256  + 64 * (j))
#define XB_XSUB(j)  (1280 + 64 * (j))
#define XB_XGEN(j)  (2304 + 64 * (j))
#define XB_TOP      3328
#define XB_TOPGEN   3392
#define XCD_BAR_WORDS 3456
#define XB_SPIN_CAP (1u << 22)

__device__ __forceinline__ unsigned xb_ld(unsigned* p)              { return __hip_atomic_load(p, __ATOMIC_RELAXED, __HIP_MEMORY_SCOPE_AGENT); }
__device__ __forceinline__ unsigned xb_add(unsigned* p, unsigned v) { return __hip_atomic_fetch_add(p, v, __ATOMIC_RELAXED, __HIP_MEMORY_SCOPE_AGENT); }
__device__ __forceinline__ unsigned xb_xcc_id() { return (unsigned)__builtin_amdgcn_s_getreg((3 << 11) | 20) & 0xFu; }
#define XB_SPIN(cond, bar) do { unsigned _sp = 0; while (cond) { __builtin_amdgcn_s_sleep(1); \
    if ((++_sp & 255u) == 0u) { if (xb_ld(&(bar)[XB_TMO])) break; if (_sp > XB_SPIN_CAP) { atomicAdd(&(bar)[XB_TMO], 1u); break; } } } } while (0)

struct XcdBarrier {
    unsigned* bar; unsigned x;
    volatile LAS unsigned* st;
};

__device__ __forceinline__ XcdBarrier xcd_barrier_post(unsigned* bar, volatile LAS unsigned* st) {
    XcdBarrier b; b.bar = bar; b.x = xb_xcc_id(); b.st = st;
    if (threadIdx.x == 0) (void)xb_add(&bar[XB_XCNT(b.x)], 1u);
    return b;
}
__device__ __forceinline__ void xcd_barrier_complete(unsigned* bar, unsigned x, unsigned& nloc, unsigned& nx) {
    const unsigned G = gridDim.x * gridDim.y * gridDim.z;
    unsigned sum, cnt, mine, sp = 0u;
    for (;;) {
        sum = 0u; cnt = 0u; mine = 0u;
#pragma unroll
        for (unsigned j = 0; j < 16; ++j) { const unsigned c = xb_ld(&bar[XB_XCNT(j)]); sum += c; cnt += (c > 0u) ? 1u : 0u; mine = (j == x) ? c : mine; }
        if (sum == G) break;
        __builtin_amdgcn_s_sleep(1);
        if ((++sp & 255u) == 0u) { if (xb_ld(&bar[XB_TMO])) break; if (sp > XB_SPIN_CAP) { atomicAdd(&bar[XB_TMO], 1u); break; } }
    }
    nloc = mine > 0u ? mine : 1u; nx = cnt > 0u ? cnt : 1u;
}

__device__ __forceinline__ void xcd_barrier(const XcdBarrier& b) {
    asm volatile("s_waitcnt vmcnt(0)" ::: "memory");
    __syncthreads();
    if (threadIdx.x == 0) {
        unsigned* bar = b.bar;
        __builtin_amdgcn_s_waitcnt(0);
        unsigned nloc = b.st[0], nx = b.st[1];
        if (nloc == 0u) { xcd_barrier_complete(bar, b.x, nloc, nx); b.st[0] = nloc; b.st[1] = nx; }
        const unsigned old = xb_add(&bar[XB_XSUB(b.x)], 1u);
        const unsigned gen = old / nloc;
        if (old + 1u == (gen + 1u) * nloc) {
            __builtin_amdgcn_fence(__ATOMIC_RELEASE, "agent");
            asm volatile("s_waitcnt vmcnt(0)" ::: "memory");
            const unsigned og = xb_add(&bar[XB_TOP], 1u);
            const unsigned tg = og / nx;
            if (og + 1u == (tg + 1u) * nx) xb_add(&bar[XB_TOPGEN], 1u);
            else XB_SPIN(xb_ld(&bar[XB_TOPGEN]) == tg, bar);
            __builtin_amdgcn_fence(__ATOMIC_ACQUIRE, "agent");
            xb_add(&bar[XB_XGEN(b.x)], 1u);
            asm volatile("s_waitcnt vmcnt(0)" ::: "memory");
        } else {
            XB_SPIN(xb_ld(&bar[XB_XGEN(b.x)]) == gen, bar);
            __builtin_amdgcn_fence(__ATOMIC_ACQUIRE, "agent");
            asm volatile("s_waitcnt vmcnt(0)" ::: "memory");
        }
    }
    __syncthreads();
}

constexpr int S = 16384, DM = 1024, NH = 8, HD = 128, MBLK = 256, NBLK = S / MBLK, DFF = 2816, INTOT = 9232;
constexpr int CH = 64, NCH = S / CH;
constexpr float EPS = 1e-6f;
constexpr int NWAVES = 8;
#ifndef DN2_LATE_WT
#define DN2_LATE_WT 1
#endif

constexpr size_t MiB = 1u << 20;
constexpr size_t WS_CTL = 0, CTL_ZERO_BYTES = 1 * MiB;
constexpr size_t WS_COS = 1 * MiB, WS_SIN = 2 * MiB;
constexpr size_t WS_BA = 3 * MiB;
constexpr size_t WS_KMEAN = 4 * MiB;
constexpr size_t WS_TOPI = 5 * MiB;
constexpr size_t WS_BETA = 6 * MiB + 512 * 1024, WS_G = 7 * MiB, WS_GC = 7 * MiB + 512 * 1024;
constexpr size_t WS_WTA = 8 * MiB, WS_WTB = 14 * MiB, WS_WTG = 22 * MiB, WS_WTOA = 26 * MiB, WS_WTOD = 28 * MiB, WS_WTOUT = 30 * MiB, WS_WTGU = 32 * MiB, WS_WTDN = 43 * MiB;
constexpr size_t WS_H = 49 * MiB;
constexpr size_t WS_R1 = 81 * MiB;
constexpr size_t WS_Z = 177 * MiB, WS_YA = 209 * MiB, WS_END = 256 * MiB;
constexpr size_t ACT_BYTES = (size_t)S * DFF * 2;
constexpr size_t T32 = (size_t)S * DM * 2;
static_assert(WS_WTDN + (size_t)DM * DFF * 2 <= WS_H && WS_YA + T32 <= WS_END && WS_R1 + 3 * T32 == WS_Z, "ws map");
constexpr size_t WS_VN = WS_H;
constexpr size_t WS_W = WS_R1, WS_ATT = WS_R1 + T32, WS_O = WS_R1 + T32 + 16 * MiB, WS_YD = WS_R1;
constexpr size_t WS_T = 113 * MiB, WS_H2 = WS_H, WS_ACT = 81 * MiB, WS_F = 169 * MiB;
static_assert(WS_ACT + ACT_BYTES <= WS_F && WS_F + 2 * T32 <= WS_END && WS_O + T32 <= WS_Z && WS_T + 2 * T32 <= WS_Z, "overlay map");
constexpr int CW_BAR = 4096;

constexpr int RING_OFF = 0, RING_BYTES = 131072;
constexpr int LDS_BYTES = 163840;
constexpr int LDSCTL_OFF = LDS_BYTES - 4096, MISC_OFF = LDSCTL_OFF + 320;

typedef unsigned u32x4 __attribute__((ext_vector_type(4)));
typedef unsigned u32x2 __attribute__((ext_vector_type(2)));

__device__ __forceinline__ float bflo(unsigned u) { return __builtin_bit_cast(float, u << 16); }
__device__ __forceinline__ float bfhi(unsigned u) { return __builtin_bit_cast(float, u & 0xffff0000u); }
__device__ __forceinline__ float bf2f(bf16 b) { return __builtin_bit_cast(float, ((unsigned)b) << 16); }
__device__ __forceinline__ float wave_sum(float v) {
#define WS_DPP(ctrl) v += __builtin_bit_cast(float, __builtin_amdgcn_update_dpp(0, __builtin_bit_cast(int, v), (ctrl), 0xF, 0xF, true))
    WS_DPP(0xB1); WS_DPP(0x4E); WS_DPP(0x141); WS_DPP(0x140);
#undef WS_DPP
    const float s0 = __builtin_bit_cast(float, __builtin_amdgcn_readlane(__builtin_bit_cast(int, v), 0)), s1 = __builtin_bit_cast(float, __builtin_amdgcn_readlane(__builtin_bit_cast(int, v), 16));
    const float s2 = __builtin_bit_cast(float, __builtin_amdgcn_readlane(__builtin_bit_cast(int, v), 32)), s3 = __builtin_bit_cast(float, __builtin_amdgcn_readlane(__builtin_bit_cast(int, v), 48));
    return (s0 + s1) + (s2 + s3);
}
__device__ __forceinline__ float wave_max(float v) {
#pragma unroll
    for (int o = 1; o < 64; o <<= 1) v = fmaxf(v, __shfl_xor(v, o));
    return v;
}
__device__ __forceinline__ float rcp_(float x) { return __builtin_amdgcn_rcpf(x); }
__device__ __forceinline__ float rsq_(float x) { return __builtin_amdgcn_rsqf(x); }
__device__ __forceinline__ float sigmoidf_(float x) { return rcp_(1.f + __expf(-x)); }
__device__ __forceinline__ float siluf_(float x) { return x * rcp_(1.f + __expf(-x)); }
__device__ __forceinline__ float sigmoidf_e(float x) { return sigmoidf_(x); }
__device__ __forceinline__ float siluf_e(float x) { return siluf_(x); }

namespace pg8 {
struct EpiRope {
    static constexpr bool PERM = false, AFTER_DRAIN = false;
    bf16_t* base; const float* cosT; const float* sinT; float* kpart;
    __device__ __forceinline__ void operator()(const f32x4 (&acc)[2][2][4][2], const Unit& u, int wr, int wc, int fr, int fq) const {
        const int t = u.pn >> 2, pnl = u.pn & 3;
        bf16_t* ob = base + (size_t)t * ((size_t)S * DM);
        const bool rope = (t < 2) && (wc == 0);
        f32x4 cs[2][2];
#pragma unroll
        for (int bj = 0; bj < 2; ++bj)
#pragma unroll
            for (int n = 0; n < 2; ++n) cs[bj][n] = (f32x4){0.f, 0.f, 0.f, 0.f};
#pragma unroll
        for (int ai = 0; ai < 2; ++ai)
#pragma unroll
            for (int m = 0; m < 4; ++m) {
                const int row = u.pm * BM + ai * HALF + wr * 64 + m * 16 + fr;
                f32x4 cv = (f32x4){1.f, 1.f, 1.f, 1.f}, sv = (f32x4){0.f, 0.f, 0.f, 0.f};
                if (rope) { cv = *(const f32x4*)(cosT + (size_t)row * 16 + 4 * fq); sv = *(const f32x4*)(sinT + (size_t)row * 16 + 4 * fq); }
#pragma unroll
                for (int bj = 0; bj < 2; ++bj) {
                    f32x4 v0 = acc[ai][bj][m][0], v1 = acc[ai][bj][m][1];
                    if (rope) { const f32x4 n0 = v0 * cv - v1 * sv, n1 = v1 * cv + v0 * sv; v0 = n0; v1 = n1; }
                    cs[bj][0] = cs[bj][0] + v0; cs[bj][1] = cs[bj][1] + v1;
                    bf16_t* p = ob + (size_t)row * DM + pnl * 256 + bj * HALF + wc * 32 + 4 * fq;
                    u32x2 w0, w1; w0.x = cvt_pk_bf16(v0[0], v0[1]); w0.y = cvt_pk_bf16(v0[2], v0[3]); w1.x = cvt_pk_bf16(v1[0], v1[1]); w1.y = cvt_pk_bf16(v1[2], v1[3]);
                    *(u32x2*)p = w0; *(u32x2*)(p + 16) = w1;
                }
            }
        if (t == 1) {
#pragma unroll
            for (int bj = 0; bj < 2; ++bj)
#pragma unroll
                for (int n = 0; n < 2; ++n) { f32x4 s = cs[bj][n];
#pragma unroll
                    for (int o = 1; o < 16; o <<= 1) { s.x += __shfl_xor(s.x, o); s.y += __shfl_xor(s.y, o); s.z += __shfl_xor(s.z, o); s.w += __shfl_xor(s.w, o); }
                    if (fr == 0) *(f32x4*)(kpart + ((size_t)(u.pm * 2 + wr) * NH + 2 * pnl + bj) * HD + wc * 32 + 16 * n + 4 * fq) = s; } }
    }
};
template <int MODE> struct EpiGen {
    static constexpr bool PERM = true, AFTER_DRAIN = false;
    bf16_t* O; int ldc; int split_cols; size_t split_stride; const bf16_t* G2;
    __device__ __forceinline__ static void unpack8(const u32x4 w, float (&f)[8]) {
        f[0] = bflo(w.x); f[1] = bfhi(w.x); f[2] = bflo(w.y); f[3] = bfhi(w.y); f[4] = bflo(w.z); f[5] = bfhi(w.z); f[6] = bflo(w.w); f[7] = bfhi(w.w);
    }
    __device__ __forceinline__ void operator()(const f32x4 (&acc)[2][2][4][2], const Unit& u, int wr, int wc, int fr, int fq) const {
        const int row0 = u.pm * BM + wr * 64 + fr; int colt = u.pn * BM; bf16_t* base = O; const bf16_t* g2 = G2;
        if (split_cols) { const int t = colt / split_cols; base += (size_t)t * split_stride; colt -= t * split_cols; }
#pragma unroll
        for (int ai = 0; ai < 2; ++ai)
#pragma unroll
            for (int m = 0; m < 4; ++m) {
                const int row = row0 + ai * HALF + m * 16;
                if constexpr (MODE == 4) {
                    const f32x4 g0 = acc[ai][0][m][0], g1 = acc[ai][0][m][1], u0 = acc[ai][1][m][0], u1 = acc[ai][1][m][1];
                    float r[8];
#pragma unroll
                    for (int e = 0; e < 4; ++e) { r[e] = siluf_e(g0[e]) * u0[e]; r[4 + e] = siluf_e(g1[e]) * u1[e]; }
                    u32x4 w; w.x = cvt_pk_bf16(r[0], r[1]); w.y = cvt_pk_bf16(r[2], r[3]); w.z = cvt_pk_bf16(r[4], r[5]); w.w = cvt_pk_bf16(r[6], r[7]);
                    *(u32x4*)(base + (size_t)row * ldc + u.pn * HALF + wc * 32 + 8 * fq) = w;
                } else {
#pragma unroll
                    for (int bj = 0; bj < 2; ++bj) {
                        const f32x4 v0 = acc[ai][bj][m][0], v1 = acc[ai][bj][m][1];
                        float r[8] = {v0[0], v0[1], v0[2], v0[3], v1[0], v1[1], v1[2], v1[3]};
                        bf16_t* p = base + (size_t)row * ldc + colt + bj * HALF + wc * 32 + 8 * fq;
                        if constexpr (MODE == 1) {
#pragma unroll
                            for (int e = 0; e < 8; ++e) r[e] = sigmoidf_e(r[e]);
                        }
                        if constexpr (MODE == 2) { float g[8]; unpack8(*(const u32x4*)p, g);
#pragma unroll
                            for (int e = 0; e < 8; ++e) r[e] = r[e] * g[e]; }
                        if constexpr (MODE == 3) { float g[8], o[8]; unpack8(*(const u32x4*)(g2 + (size_t)row * ldc + colt + bj * HALF + wc * 32 + 8 * fq), g); unpack8(*(const u32x4*)p, o);
#pragma unroll
                            for (int e = 0; e < 8; ++e) r[e] = o[e] + r[e] * g[e]; }
                        u32x4 w; w.x = cvt_pk_bf16(r[0], r[1]); w.y = cvt_pk_bf16(r[2], r[3]); w.z = cvt_pk_bf16(r[4], r[5]); w.w = cvt_pk_bf16(r[6], r[7]);
                        *(u32x4*)p = w;
                    }
                }
            }
    }
};
struct EpiF32 {
    static constexpr bool PERM = false, AFTER_DRAIN = false;
    float* C; int ldc;
    __device__ __forceinline__ void operator()(const f32x4 (&acc)[2][2][4][2], const Unit& u, int wr, int wc, int fr, int fq) const {
        const int row0 = u.pm * BM + wr * 64 + fr, col0 = u.pn * BM + wc * 32 + 4 * fq;
#pragma unroll
        for (int ai = 0; ai < 2; ++ai)
#pragma unroll
            for (int m = 0; m < 4; ++m) { float* rowp = C + (size_t)(row0 + ai * HALF + m * 16) * ldc + col0;
#pragma unroll
                for (int bj = 0; bj < 2; ++bj)
#pragma unroll
                    for (int n = 0; n < 2; ++n) *(f32x4*)(rowp + bj * HALF + n * 16) = acc[ai][bj][m][n]; }
    }
};
struct PairOrder {
    StaticOrder so; int nblk, nN1;
    __host__ __device__ void init(int M, int N1, int nblk_, int G_, int c_) { so.init(M, N1, G_, c_); nblk = nblk_; nN1 = N1 / BM; }
    __host__ __device__ bool next(int i, Unit& u) const { if (!so.next(i / nblk, u)) return false; u.pn += (i % nblk) * nN1; return true; }
    __device__ __forceinline__ void a_ready(const Unit&) const {}
    __device__ __forceinline__ void done(const Unit&) const {}
};
}

struct Args { const float* in[16]; float* out; unsigned char* ws; int ph_lo, ph_hi, pass, pad; };
struct Frame {
    LAS unsigned char* lds;
    volatile LAS unsigned* MISC;
    int tid, lane, wave, G, gw, NGW;
    float* out; unsigned char* ws;
};
#define WSP(T, off) ((T*)(F.ws + (off)))
#define WSPF(T, off) ((T*)(Fp.ws + (off)))

struct WtItem { const float* src; bf16* dst; int ldw, K; };
__device__ __forceinline__ void tr_load(const WtItem& I, int lane, f32x4 (&v)[8]) {
#pragma unroll
    for (int i = 0; i < 8; ++i) v[i] = *(const f32x4*)(I.src + (size_t)((lane >> 3) + 8 * i) * I.ldw + 4 * (lane & 7));
}
__device__ __forceinline__ void tr_put(const f32x4 (&v)[8], LAS float* scr, int lane) {
#pragma unroll
    for (int i = 0; i < 8; ++i) { LAS float* s = scr + ((lane >> 3) + 8 * i) * 33 + 4 * (lane & 7); s[0] = v[i].x; s[1] = v[i].y; s[2] = v[i].z; s[3] = v[i].w; }
    LDS_WAIT(); asm volatile("" ::: "memory");
}
__device__ __forceinline__ void tr_out(const WtItem& I, const LAS float* scr, int lane) {
    const int c = lane & 7;
#pragma unroll
    for (int j = 0; j < 4; ++j) { const int n = (lane >> 3) + 8 * j; const LAS float* s = scr + (8 * c) * 33 + n;
        v4u o; o.x = pk2(s[0 * 33], s[1 * 33]); o.y = pk2(s[2 * 33], s[3 * 33]); o.z = pk2(s[4 * 33], s[5 * 33]); o.w = pk2(s[6 * 33], s[7 * 33]);
        *(GAS v4u*)(I.dst + (size_t)n * I.K + 8 * c) = o; }
    LDS_WAIT(); asm volatile("" ::: "memory");
}
__device__ __forceinline__ void rms_row_bf16(const float* xrow, const float* w, bf16* orow, int lane, f32x4 (&hv)[4]) {
    const f32x4* xr = (const f32x4*)xrow + lane; const f32x4* wr = (const f32x4*)w + lane;
    float ss = 0.f;
#pragma unroll
    for (int j = 0; j < 4; ++j) { hv[j] = xr[64 * j]; ss += (hv[j].x * hv[j].x + hv[j].y * hv[j].y) + (hv[j].z * hv[j].z + hv[j].w * hv[j].w); }
    const float rs = rsq_(wave_sum(ss) * (1.f / DM) + EPS);
    unsigned long long* o8 = (unsigned long long*)orow + lane;
#pragma unroll
    for (int j = 0; j < 4; ++j) { const f32x4 wv = wr[64 * j]; hv[j] = hv[j] * rs * wv;
        o8[64 * j] = (unsigned long long)pk2(hv[j].x, hv[j].y) | ((unsigned long long)pk2(hv[j].z, hv[j].w) << 32); }
}
__device__ __forceinline__ WtItem wt_decode(const Args& A, unsigned char* ws, int it) {
    constexpr int I_A = 16 * 96, I_B = 16 * 128, I_G = 16 * 64, I_O = 16 * 32, I_GU = 16 * 88;
    const float* w_in = A.in[2];
    int r = it; const float* W; int ldw, scol, nbn, K = DM, dmode = 0; size_t dst;
    if (r < I_A) { W = w_in; ldw = INTOT; scol = 0; nbn = 96; dst = WS_WTA; }
    else if ((r -= I_A) < I_B) { W = w_in; ldw = INTOT; scol = 3072; nbn = 128; dst = WS_WTB; }
    else if ((r -= I_B) < I_G) { W = w_in; ldw = INTOT; scol = 7184; nbn = 64; dst = WS_WTG; }
    else if ((r -= I_G) < I_O) { W = A.in[7]; ldw = DM; scol = 0; nbn = 32; dst = WS_WTOA; }
    else if ((r -= I_O) < I_O) { W = A.in[8]; ldw = DM; scol = 0; nbn = 32; dst = WS_WTOD; }
    else if ((r -= I_O) < I_O) { W = A.in[9]; ldw = DM; scol = 0; nbn = 32; dst = WS_WTOUT; }
    else if ((r -= I_O) < I_GU) { W = A.in[12]; ldw = DFF; scol = 0; nbn = 88; dst = WS_WTGU; dmode = 1; }
    else if ((r -= I_GU) < I_GU) { W = A.in[13]; ldw = DFF; scol = 0; nbn = 88; dst = WS_WTGU; dmode = 2; }
    else { r -= I_GU; W = A.in[14]; ldw = DM; scol = 0; nbn = 32; dst = WS_WTDN; K = DFF; }
    const int kb = r / nbn, nb = r % nbn, n0 = 32 * nb;
    const int drow0 = (dmode == 0) ? n0 : 256 * (n0 / 128) + (n0 % 128) + (dmode == 2 ? 128 : 0);
    WtItem I; I.src = W + (size_t)(64 * kb) * ldw + scol + n0; I.dst = (bf16*)(ws + dst) + (size_t)drow0 * K + 64 * kb; I.ldw = ldw; I.K = K; return I;
}
__device__ __forceinline__ void p_wtrans(Frame& F, const Args& A, int it0, int it1, int gw0, int ngw) {
    LAS float* scr = (LAS float*)(F.lds + RING_OFF + F.wave * 16384);
    int it = it0 + gw0; if (it >= it1) return;
    WtItem cur = wt_decode(A, F.ws, it); f32x4 v[8]; tr_load(cur, F.lane, v);
    for (;;) {
        const int itn = it + ngw; const bool more = itn < it1;
        tr_put(v, scr, F.lane);
        WtItem nxt = cur; if (more) { nxt = wt_decode(A, F.ws, itn); tr_load(nxt, F.lane, v); }
        tr_out(cur, scr, F.lane);
        if (!more) break;
        cur = nxt; it = itn;
    }
}
constexpr int WT_A_ITEMS = 2560;
constexpr int WT_ITEMS_EARLY = 16 * 96 + 16 * 128, WT_ITEMS_ALL = 16 * 96 + 16 * 128 + 16 * 64 + 3 * 16 * 32 + 2 * 16 * 88 + 44 * 32;
__device__ __forceinline__ void p_prologue(Frame& F, const Args& A) {
    const float* w_in = A.in[2];
#if DN2_LATE_WT
    p_wtrans(F, A, 0, WT_ITEMS_EARLY, F.gw, F.NGW);
#else
    p_wtrans(F, A, 0, WT_ITEMS_ALL, F.gw, F.NGW);
#endif
    { float* cosT = WSP(float, WS_COS); float* sinT = WSP(float, WS_SIN);
      for (int i = F.gw * 64 + F.lane; i < S * 16; i += F.NGW * 64) { const int pos = i >> 4, k = i & 15;
          const float inv = (float)pow(500000.0, -(double)k / 16.0); const float ang = (float)pos * inv;
          cosT[i] = cosf(ang); sinT[i] = sinf(ang); } }
    { const float* x = A.in[0]; bf16* H = WSP(bf16, WS_H); float* BA = WSP(float, WS_BA);
      constexpr int WP = 2064;
      LAS unsigned char* wimg = F.lds; LAS unsigned char* hl = F.lds + 36864 + F.wave * (4 * WP + 192);
      __syncthreads();
      { const int k8 = F.tid >> 2, c4 = 4 * (F.tid & 3); f32x4 wv[8];
#pragma unroll
        for (int i = 0; i < 8; ++i) wv[i] = *(const f32x4*)(w_in + (size_t)(8 * k8 + i) * INTOT + 7168 + c4);
#pragma unroll
        for (int c = 0; c < 4; ++c) { u32x4 o; o.x = pk2(wv[0][c], wv[1][c]); o.y = pk2(wv[2][c], wv[3][c]); o.z = pk2(wv[4][c], wv[5][c]); o.w = pk2(wv[6][c], wv[7][c]);
            *(LAS u32x4*)(wimg + (c4 + c) * WP + 16 * k8) = o; } }
      __syncthreads();
      const int r16 = F.lane & 15, g = F.lane >> 4;
      const LAS unsigned char* wrd = wimg + r16 * WP + 16 * g; const LAS unsigned char* hrd = hl + (r16 & 3) * WP + 16 * g;
      f32x4 nw[4];
#pragma unroll
      for (int j = 0; j < 4; ++j) nw[j] = ((const f32x4*)A.in[1])[F.lane + 64 * j];
      for (int m0 = F.gw; m0 < S; m0 += 4 * F.NGW) {
          f32x4 xv[4][4];
#pragma unroll
          for (int k = 0; k < 4; ++k) { const int m = m0 + k * F.NGW; const f32x4* xr = (const f32x4*)(x + (size_t)(m < S ? m : m0) * DM) + F.lane;
#pragma unroll
              for (int j = 0; j < 4; ++j) xv[k][j] = xr[64 * j]; }
#pragma unroll
          for (int k = 0; k < 4; ++k) { const int m = m0 + k * F.NGW; float ss = 0.f;
#pragma unroll
              for (int j = 0; j < 4; ++j) ss += (xv[k][j].x * xv[k][j].x + xv[k][j].y * xv[k][j].y) + (xv[k][j].z * xv[k][j].z + xv[k][j].w * xv[k][j].w);
              const float rs = rsq_(wave_sum(ss) * (1.f / DM) + EPS);
              unsigned long long* o8 = (unsigned long long*)(H + (size_t)m * DM) + F.lane;
#pragma unroll
              for (int j = 0; j < 4; ++j) { const f32x4 hv = xv[k][j] * rs * nw[j]; u32x2 p; p.x = pk2(hv.x, hv.y); p.y = pk2(hv.z, hv.w);
                  if (m < S) o8[64 * j] = (unsigned long long)p.x | ((unsigned long long)p.y << 32);
                  *(LAS u32x2*)(hl + k * WP + 8 * (F.lane + 64 * j)) = p; } }
          asm volatile("s_waitcnt lgkmcnt(0)" ::: "memory");
          f32x4 acc = {0.f, 0.f, 0.f, 0.f};
#pragma unroll 8
          for (int s = 0; s < 32; ++s) { const bf16x8 wf = *(const LAS bf16x8*)(wrd + 64 * s), hf = *(const LAS bf16x8*)(hrd + 64 * s);
              acc = __builtin_amdgcn_mfma_f32_16x16x32_bf16(wf, hf, acc, 0, 0, 0); }
          { const int m = m0 + r16 * F.NGW; if (r16 < 4 && m < S) *(f32x4*)(BA + (size_t)m * 16 + 4 * g) = acc; }
          asm volatile("s_waitcnt lgkmcnt(0)" ::: "memory");
      }
      __syncthreads(); }
}
__device__ __forceinline__ void p_hrecompute_sub(Frame& F, const Args& A, bf16* H, int gw0, int ngw) {
    const float* x = A.in[0];
    for (int m = gw0; m < S; m += ngw) { f32x4 hv[4]; rms_row_bf16(x + (size_t)m * DM, A.in[1], H + (size_t)m * DM, F.lane, hv); }
}
__device__ __forceinline__ void p_hrecompute(Frame& F, const Args& A) {
    const float* x = A.in[0]; bf16* H = WSP(bf16, WS_H);
    for (int m = F.gw; m < S; m += F.NGW) { f32x4 hv[4]; rms_row_bf16(x + (size_t)m * DM, A.in[1], H + (size_t)m * DM, F.lane, hv); }
}

__device__ __forceinline__ void p_kmean(Frame& F, const Args& A) {
    const bf16* KA = WSP(bf16, WS_R1 + T32); float* KM = WSP(float, WS_KMEAN);
    for (int it = F.gw; it < NBLK * NH; it += F.NGW) { const int blk = it >> 3, h = it & 7;
        float s0 = 0.f, s1 = 0.f; const bf16* p = KA + (size_t)(blk * MBLK) * DM + h * HD + 2 * F.lane;
#pragma unroll 32
        for (int r = 0; r < MBLK; ++r) { const unsigned v = *(const unsigned*)(p + (size_t)r * DM); s0 += bflo(v); s1 += bfhi(v); }
        KM[(size_t)it * HD + 2 * F.lane] = s0 * (1.f / MBLK); KM[(size_t)it * HD + 2 * F.lane + 1] = s1 * (1.f / MBLK); }
}
__device__ __forceinline__ void p_topk(Frame& F, const Args& A) {
    const bf16* QA = WSP(bf16, WS_R1); const float* KM = WSP(float, WS_KMEAN); int* TOPI = WSP(int, WS_TOPI);
    for (int it = F.gw; it < S * NH; it += F.NGW) { const int q = it >> 3, h = it & 7, qblk = q >> 8;
        float g = -INFINITY;
        if (F.lane < qblk) { const bf16* qp = QA + (size_t)q * DM + h * HD; const float* kp = KM + ((size_t)F.lane * NH + h) * HD; float a = 0.f;
#pragma unroll
            for (int c = 0; c < 16; ++c) { const u32x4 qv = *(const u32x4*)(qp + 8 * c); const f32x4 k0 = *(const f32x4*)(kp + 8 * c), k1 = *(const f32x4*)(kp + 8 * c + 4);
                a += bflo(qv.x) * k0.x + bfhi(qv.x) * k0.y + bflo(qv.y) * k0.z + bfhi(qv.y) * k0.w + bflo(qv.z) * k1.x + bfhi(qv.z) * k1.y + bflo(qv.w) * k1.z + bfhi(qv.w) * k1.w; }
            g = a; }
        int res = -1;
#pragma unroll
        for (int r = 0; r < 3; ++r) { float v = g; int i = F.lane;
#pragma unroll
            for (int o = 1; o < 64; o <<= 1) { const float ov = __shfl_xor(v, o); const int oi = __shfl_xor(i, o); if (ov > v || (ov == v && oi < i)) { v = ov; i = oi; } }
            if (F.lane == r) res = (r < qblk) ? i : -1;
            if (F.lane == i) g = -INFINITY; }
        if (F.lane < 3) TOPI[(size_t)it * 3 + F.lane] = res; }
}
__device__ __forceinline__ void p_attn_naive(Frame& F, const Args& A) {
    const bf16* QA = WSP(bf16, WS_R1); const bf16* KA = WSP(bf16, WS_R1 + T32); const bf16* VA = WSP(bf16, WS_R1 + 2 * T32); const int* TOPI = WSP(int, WS_TOPI);
#ifdef DBG_ATTN
    bf16* YA = (bf16*)F.out;
#else
    bf16* YA = WSP(bf16, WS_YA);
#endif
    for (int it = F.gw; it < S * NH; it += F.NGW) { const int q = it >> 3, h = it & 7, qblk = q >> 8;
        const bf16* qp = QA + (size_t)q * DM + h * HD;
        float m = -INFINITY, l = 0.f, o0 = 0.f, o1 = 0.f;
        for (int slot = 0; slot < 4; ++slot) {
            int kb = qblk; if (slot < 3) { kb = TOPI[(size_t)it * 3 + slot]; if (kb < 0) continue; }
            const bf16* kp = KA + (size_t)(kb * MBLK) * DM + h * HD; const bf16* vp = VA + (size_t)(kb * MBLK) * DM + h * HD;
            float s[4] = {0.f, 0.f, 0.f, 0.f};
#pragma unroll 4
            for (int c = 0; c < 16; ++c) { const u32x4 qv = *(const u32x4*)(qp + 8 * c);
                const float q0 = bflo(qv.x), q1 = bfhi(qv.x), q2 = bflo(qv.y), q3 = bfhi(qv.y), q4 = bflo(qv.z), q5 = bfhi(qv.z), q6 = bflo(qv.w), q7 = bfhi(qv.w);
#pragma unroll
                for (int jj = 0; jj < 4; ++jj) { const u32x4 kv = *(const u32x4*)(kp + (size_t)(F.lane + 64 * jj) * DM + 8 * c);
                    s[jj] += q0 * bflo(kv.x) + q1 * bfhi(kv.x) + q2 * bflo(kv.y) + q3 * bfhi(kv.y) + q4 * bflo(kv.z) + q5 * bfhi(kv.z) + q6 * bflo(kv.w) + q7 * bfhi(kv.w); } }
            float mx = -INFINITY;
#pragma unroll
            for (int jj = 0; jj < 4; ++jj) { s[jj] *= 0.08838834764831845f; if (slot == 3 && (kb * MBLK + F.lane + 64 * jj) > q) s[jj] = -INFINITY; mx = fmaxf(mx, s[jj]); }
            mx = wave_max(mx);
            const float mn = fmaxf(m, mx), sc = __expf(m - mn);
            float p[4], ps = 0.f;
#pragma unroll
            for (int jj = 0; jj < 4; ++jj) { p[jj] = __expf(s[jj] - mn); ps += p[jj]; }
            l = l * sc + wave_sum(ps); o0 *= sc; o1 *= sc; m = mn;
#pragma unroll
            for (int jj = 0; jj < 4; ++jj)
                for (int ln = 0; ln < 64; ++ln) { const float pj = __shfl(p[jj], ln); const unsigned vv = *(const unsigned*)(vp + (size_t)(ln + 64 * jj) * DM + 2 * F.lane); o0 += pj * bflo(vv); o1 += pj * bfhi(vv); }
        }
        const float il = 1.f / l;
        *(unsigned*)(YA + (size_t)q * DM + h * HD + 2 * F.lane) = pk2(o0 * il, o1 * il); }
}


typedef float f32x16 __attribute__((ext_vector_type(16)));
typedef short s16x4 __attribute__((ext_vector_type(4)));
typedef float f32x2_t __attribute__((ext_vector_type(2)));
typedef __bf16 bf16x2_t __attribute__((ext_vector_type(2)));
constexpr size_t WS_BUCKET = 241 * MiB, WS_ML = 249 * MiB, WS_OP2 = WS_Z;
constexpr int BUCKET_PER_HEAD = 256 * 2016;
constexpr int CW_CNT = 16384;
static_assert(WS_BUCKET + (size_t)NH * BUCKET_PER_HEAD * 2 <= WS_ML && WS_ML + (size_t)3 * S * NH * 8 <= WS_END, "bucket map");
constexpr float SM_C = 0.08838834764831845f * 1.4426950408889634f;

__device__ __forceinline__ int bucket_off(int kb) { return 256 * (63 * kb - (kb * (kb - 1)) / 2); }
__device__ __forceinline__ unsigned attn_off(unsigned row, unsigned ch) { return 256u * row + 16u * (ch ^ (((row & 3u) << 2) | ((row >> 2) & 3u))); }
__device__ __forceinline__ unsigned cvtpk(float lo, float hi) { f32x2_t v = {lo, hi}; bf16x2_t b = __builtin_convertvector(v, bf16x2_t); return __builtin_bit_cast(unsigned, b); }
__device__ __forceinline__ s16x4 vtr16(const LAS unsigned char* p) { typedef short v4i16_t __attribute__((ext_vector_type(4))); return __builtin_bit_cast(s16x4, __builtin_amdgcn_ds_read_tr16_b64_v4i16((LAS v4i16_t*)p)); }

__device__ __forceinline__ void unpack8f(const bf16x8 v, float (&f)[8]) { const u32x4 w = __builtin_bit_cast(u32x4, v);
    f[0] = bflo(w.x); f[1] = bfhi(w.x); f[2] = bflo(w.y); f[3] = bfhi(w.y); f[4] = bflo(w.z); f[5] = bfhi(w.z); f[6] = bflo(w.w); f[7] = bfhi(w.w); }
__device__ __forceinline__ bf16x8 pack8f(const float (&f)[8]) { u32x4 w; w.x = cvtpk(f[0], f[1]); w.y = cvtpk(f[2], f[3]); w.z = cvtpk(f[4], f[5]); w.w = cvtpk(f[6], f[7]); return __builtin_bit_cast(bf16x8, w); }

__device__ __forceinline__ void attn_stage(const bf16* src, LAS unsigned char* img, int tid) {
#pragma unroll
    for (int i = 0; i < 8; ++i) { const int n = tid + 512 * i, row = n >> 4, ch = n & 15;
        const u32x4 v = *(const u32x4*)(src + (size_t)row * DM + 8 * ch); *(LAS u32x4*)(img + attn_off(row, ch)) = v; }
}
struct AttnState { float m, l; f32x16 o[4]; };
__device__ __forceinline__ float half_max(float v) { const auto t = __builtin_amdgcn_permlane32_swap(__builtin_bit_cast(unsigned, v), __builtin_bit_cast(unsigned, v), false, false); return fmaxf(__builtin_bit_cast(float, t[0]), __builtin_bit_cast(float, t[1])); }
__device__ __forceinline__ float half_sum(float v) { const auto t = __builtin_amdgcn_permlane32_swap(__builtin_bit_cast(unsigned, v), __builtin_bit_cast(unsigned, v), false, false); return __builtin_bit_cast(float, t[0]) + __builtin_bit_cast(float, t[1]); }
template <int NT> __device__ __forceinline__ void attn_wave(const bf16x8 (&qf)[8], const LAS unsigned char* Kimg, const LAS unsigned char* Vimg, int nt, int diag, int lane, AttnState& st) {
    const int r = lane & 31, hh = lane >> 5, blk = (lane >> 4) & 1, q4 = (lane & 15) >> 2, p4 = lane & 3;
    const LAS unsigned char* kad[8];
#pragma unroll
    for (int ks = 0; ks < 8; ++ks) kad[ks] = Kimg + attn_off(r, 2 * ks + hh);
    const LAS unsigned char* vad[4][4];
#pragma unroll
    for (int i = 0; i < 4; ++i) { const unsigned rl = 16u * (i >> 1) + 8u * (i & 1) + 4u * hh + q4, x = ((rl & 3u) << 2) | ((rl >> 2) & 3u), cb = 2u * blk + (p4 >> 1);
#pragma unroll
        for (int c = 0; c < 4; ++c) vad[i][c] = Vimg + 256u * rl + 16u * (cb ^ (x & 3u)) + 8u * (p4 & 1) + 64u * ((unsigned)c ^ (x >> 2)); }
    st.m = -INFINITY; st.l = 0.f;
#pragma unroll
    for (int c = 0; c < 4; ++c)
#pragma unroll
        for (int i = 0; i < 16; ++i) st.o[c][i] = 0.f;
    auto tile = [&](const int kt) __attribute__((always_inline)) {
        f32x16 s;
#pragma unroll
        for (int i = 0; i < 16; ++i) s[i] = 0.f;
#pragma unroll
        for (int ks = 0; ks < 8; ++ks) { const bf16x8 kf = *(const LAS bf16x8*)(kad[ks] + kt * 8192); s = __builtin_amdgcn_mfma_f32_32x32x16_bf16(kf, qf[ks], s, 0, 0, 0); }
        float tmax = -INFINITY;
#pragma unroll
        for (int i = 0; i < 16; ++i) { if (kt == diag && ((i & 3) + 8 * (i >> 2) + 4 * hh) > r) s[i] = -INFINITY; tmax = fmaxf(tmax, s[i]); }
        tmax = fmaxf(tmax, __shfl_xor(tmax, 32)) * SM_C;
        if (!(tmax - st.m <= 8.f)) { const float mn = fmaxf(st.m, tmax), alpha = __builtin_amdgcn_exp2f(st.m - mn); st.l *= alpha; st.m = mn;
#pragma unroll
            for (int c = 0; c < 4; ++c)
#pragma unroll
                for (int i = 0; i < 16; ++i) st.o[c][i] *= alpha; }
        float rs = 0.f; const float nm = -st.m;
#pragma unroll
        for (int i = 0; i < 16; ++i) { s[i] = __builtin_amdgcn_exp2f(__builtin_fmaf(s[i], SM_C, nm)); rs += s[i]; }
        st.l += rs + __shfl_xor(rs, 32);
#pragma unroll
        for (int sp = 0; sp < 2; ++sp) {
            u32x4 pw; pw.x = cvtpk(s[8 * sp], s[8 * sp + 1]); pw.y = cvtpk(s[8 * sp + 2], s[8 * sp + 3]); pw.z = cvtpk(s[8 * sp + 4], s[8 * sp + 5]); pw.w = cvtpk(s[8 * sp + 6], s[8 * sp + 7]);
            const bf16x8 pf = __builtin_bit_cast(bf16x8, pw);
#pragma unroll
            for (int c = 0; c < 4; ++c) {
                const s16x4 lo = vtr16(vad[2 * sp][c] + kt * 8192);
                const s16x4 hi = vtr16(vad[2 * sp + 1][c] + kt * 8192);
                const bf16x8 vf = __builtin_shufflevector(lo, hi, 0, 1, 2, 3, 4, 5, 6, 7);
                st.o[c] = __builtin_amdgcn_mfma_f32_32x32x16_bf16(vf, pf, st.o[c], 0, 0, 0);
            }
        }
    };
    if constexpr (NT > 0) {
#pragma unroll
        for (int kt = 0; kt < NT; ++kt) tile(kt);
    } else { for (int kt = 0; kt < nt; ++kt) tile(kt); }
}
__device__ __forceinline__ void p_topk_bucket(Frame& F, const Args& A) {
    const bf16* QA = WSP(bf16, WS_R1); const float* KM = WSP(float, WS_KMEAN); int* TOPI = WSP(int, WS_TOPI);
    unsigned* CNT = WSP(unsigned, WS_CTL) + CW_CNT; unsigned short* BUCKET = WSP(unsigned short, WS_BUCKET); f32x2_t* ML = WSP(f32x2_t, WS_ML);
    for (int it = F.gw; it < S * NH; it += F.NGW) { const int q = it >> 3, h = it & 7, qblk = q >> 8;
        float g = -INFINITY;
        if (F.lane < qblk) { const bf16* qp = QA + (size_t)q * DM + h * HD; const float* kp = KM + ((size_t)F.lane * NH + h) * HD; float a = 0.f;
#pragma unroll
            for (int c = 0; c < 16; ++c) { const u32x4 qv = *(const u32x4*)(qp + 8 * c); const f32x4 k0 = *(const f32x4*)(kp + 8 * c), k1 = *(const f32x4*)(kp + 8 * c + 4);
                a += bflo(qv.x) * k0.x + bfhi(qv.x) * k0.y + bflo(qv.y) * k0.z + bfhi(qv.y) * k0.w + bflo(qv.z) * k1.x + bfhi(qv.z) * k1.y + bflo(qv.w) * k1.z + bfhi(qv.w) * k1.w; }
            g = a; }
        int res = -1;
#pragma unroll
        for (int r = 0; r < 3; ++r) { float v = g; int i = F.lane;
#pragma unroll
            for (int o = 1; o < 64; o <<= 1) { const float ov = __shfl_xor(v, o); const int oi = __shfl_xor(i, o); if (ov > v || (ov == v && oi < i)) { v = ov; i = oi; } }
            if (F.lane == r) res = (r < qblk) ? i : -1;
            if (F.lane == i) g = -INFINITY; }
        if (F.lane < 3) { TOPI[(size_t)it * 3 + F.lane] = res;
            if (res >= 0) { const unsigned pos = __hip_atomic_fetch_add(CNT + h * NBLK + res, 1u, __ATOMIC_RELAXED, __HIP_MEMORY_SCOPE_AGENT);
                BUCKET[(size_t)h * BUCKET_PER_HEAD + bucket_off(res) + pos] = (unsigned short)((q << 2) | F.lane); }
            else ML[((size_t)F.lane * S + q) * NH + h] = (f32x2_t){-INFINITY, 0.f}; } }
}

__device__ __forceinline__ void p_topk2(Frame& F, const Args& A) {
    const bf16* QA = WSP(bf16, WS_R1); const float* KP = WSP(const float, WS_KMEAN);
    unsigned* CNT = WSP(unsigned, WS_CTL) + CW_CNT; unsigned short* BUCKET = WSP(unsigned short, WS_BUCKET); f32x2_t* ML = WSP(f32x2_t, WS_ML);
    LAS unsigned char* Kimg = F.lds;
    LAS int* lcnt = (LAS int*)(F.lds + 16384); LAS int* lbase = lcnt + 64;
    const int lane = F.lane, r = lane & 31, hh = lane >> 5;
    for (int u = blockIdx.x; u < NBLK * NH; u += F.G) { const int qblk = u >> 3, h = u & 7, q = qblk * MBLK + 32 * F.wave + r;
        __syncthreads();
        { const int n = F.tid >> 3, c = F.tid & 7; const float* p0 = KP + ((size_t)(n * 2) * NH + h) * HD + 16 * c; const float* p1 = p0 + (size_t)NH * HD;
#pragma unroll
          for (int half = 0; half < 2; ++half) { const f32x4 a0 = *(const f32x4*)(p0 + 8 * half), a1 = *(const f32x4*)(p0 + 8 * half + 4), c0 = *(const f32x4*)(p1 + 8 * half), c1 = *(const f32x4*)(p1 + 8 * half + 4);
              float f[8] = {(a0.x + c0.x) * (1.f / MBLK), (a0.y + c0.y) * (1.f / MBLK), (a0.z + c0.z) * (1.f / MBLK), (a0.w + c0.w) * (1.f / MBLK), (a1.x + c1.x) * (1.f / MBLK), (a1.y + c1.y) * (1.f / MBLK), (a1.z + c1.z) * (1.f / MBLK), (a1.w + c1.w) * (1.f / MBLK)};
              *(LAS bf16x8*)(Kimg + attn_off(n, 2 * c + half)) = pack8f(f); } }
        if (F.tid < 64) lcnt[F.tid] = 0;
        __syncthreads();
        float bv[3] = {-INFINITY, -INFINITY, -INFINITY}; int bi[3] = {0, 0, 0};
        if (qblk > 0) {
            bf16x8 qf[8];
#pragma unroll
            for (int ks = 0; ks < 8; ++ks) qf[ks] = *(const bf16x8*)(QA + (size_t)q * DM + h * HD + 16 * ks + 8 * hh);
            const int nt = (qblk > 32) ? 2 : 1;
            for (int tn = 0; tn < nt; ++tn) {
                f32x16 acc;
#pragma unroll
                for (int i = 0; i < 16; ++i) acc[i] = 0.f;
#pragma unroll
                for (int ks = 0; ks < 8; ++ks) { const bf16x8 kf = *(const LAS bf16x8*)(Kimg + attn_off(32 * tn + r, 2 * ks + hh)); acc = __builtin_amdgcn_mfma_f32_32x32x16_bf16(kf, qf[ks], acc, 0, 0, 0); }
#pragma unroll
                for (int i = 0; i < 16; ++i) { const int n = 32 * tn + (i & 3) + 8 * (i >> 2) + 4 * hh; const float v = (n < qblk) ? acc[i] : -INFINITY;
                    const bool g0 = v > bv[0], g1 = v > bv[1], g2 = v > bv[2];
                    bv[2] = g1 ? bv[1] : (g2 ? v : bv[2]); bi[2] = g1 ? bi[1] : (g2 ? n : bi[2]);
                    bv[1] = g0 ? bv[0] : (g1 ? v : bv[1]); bi[1] = g0 ? bi[0] : (g1 ? n : bi[1]);
                    bv[0] = g0 ? v : bv[0]; bi[0] = g0 ? n : bi[0]; }
            }
            float ov[3]; int oi[3];
#pragma unroll
            for (int k = 0; k < 3; ++k) { ov[k] = __shfl_xor(bv[k], 32); oi[k] = __shfl_xor(bi[k], 32); }
#pragma unroll
            for (int k = 0; k < 3; ++k) { const float v = ov[k]; const int n = oi[k];
#define TK_GT(v_, n_, w_, m_) ((v_) > (w_) || ((v_) == (w_) && (n_) < (m_)))
                const bool ok = v > -INFINITY, g0 = ok && TK_GT(v, n, bv[0], bi[0]), g1 = ok && TK_GT(v, n, bv[1], bi[1]), g2 = ok && TK_GT(v, n, bv[2], bi[2]);
                bv[2] = g1 ? bv[1] : (g2 ? v : bv[2]); bi[2] = g1 ? bi[1] : (g2 ? n : bi[2]);
                bv[1] = g0 ? bv[0] : (g1 ? v : bv[1]); bi[1] = g0 ? bi[0] : (g1 ? n : bi[1]);
                bv[0] = g0 ? v : bv[0]; bi[0] = g0 ? n : bi[0]; }
        }
        int rank[3] = {0, 0, 0}; bool valid[3];
#pragma unroll
        for (int k = 0; k < 3; ++k) { valid[k] = (hh == 0) && (k < qblk) && (bv[k] > -INFINITY);
            if (valid[k]) rank[k] = __hip_atomic_fetch_add(lcnt + bi[k], 1, __ATOMIC_RELAXED, __HIP_MEMORY_SCOPE_WORKGROUP);
            else if (hh == 0) ML[((size_t)k * S + q) * NH + h] = (f32x2_t){-INFINITY, 0.f}; }
        __syncthreads();
        if (F.tid < 64) { const int c = lcnt[F.tid]; if (c > 0) lbase[F.tid] = (int)__hip_atomic_fetch_add(CNT + h * NBLK + F.tid, (unsigned)c, __ATOMIC_RELAXED, __HIP_MEMORY_SCOPE_AGENT); }
        __syncthreads();
#pragma unroll
        for (int k = 0; k < 3; ++k) if (valid[k]) BUCKET[(size_t)h * BUCKET_PER_HEAD + bucket_off(bi[k]) + lbase[bi[k]] + rank[k]] = (unsigned short)((q << 2) | k);
    }
    __syncthreads();
}
__device__ __forceinline__ bf16* op_slot(Frame& F, int r) { return r < 2 ? (bf16*)F.out + (size_t)r * S * DM : WSP(bf16, WS_OP2); }
__device__ __forceinline__ void p_attn_sel(Frame& F, const Args& A) {
    const bf16* QA = WSP(bf16, WS_R1); const bf16* KA = WSP(bf16, WS_R1 + T32); const bf16* VA = WSP(bf16, WS_R1 + 2 * T32);
    const unsigned* CNT = WSP(const unsigned, WS_CTL) + CW_CNT; const unsigned short* BUCKET = WSP(const unsigned short, WS_BUCKET); f32x2_t* ML = WSP(f32x2_t, WS_ML);
    LAS unsigned char* Kimg = F.lds; LAS unsigned char* Vimg = F.lds + 65536; LAS int* pre = (LAS int*)(F.lds + LDSCTL_OFF + 1024);
    constexpr int AS_UW = 4, AS_SW = 3;
    LAS int* prew = (LAS int*)(F.lds + 131072);
    __syncthreads();
    { const int nb = (int)((CNT[F.tid] + 255u) >> 8), wb = nb ? AS_SW + AS_UW * nb : 0;
      int inc = nb, incw = wb;
#pragma unroll
      for (int o = 1; o < 64; o <<= 1) { const int v = __shfl_up(inc, o), vw = __shfl_up(incw, o); if (F.lane >= o) { inc += v; incw += vw; } }
      LAS int* wtot = pre + 520;
      if (F.lane == 63) { wtot[F.wave] = inc; wtot[8 + F.wave] = incw; }
      __syncthreads();
      int base = 0, basew = 0;
#pragma unroll
      for (int w = 0; w < NWAVES; ++w) { base += (w < F.wave) ? wtot[w] : 0; basew += (w < F.wave) ? wtot[8 + w] : 0; }
      pre[F.tid] = base + inc - nb; prew[F.tid] = basew + incw - wb;
      if (F.tid == NWAVES * 64 - 1) { pre[NH * NBLK] = base + inc; prew[NH * NBLK] = basew + incw; } }
    __syncthreads();
    const int totalw = prew[NH * NBLK];
    auto first_unit = [&](const int x) __attribute__((always_inline)) -> int {
        int lo = 0, hi = NH * NBLK - 1; while (lo < hi) { const int mid = (lo + hi + 1) >> 1; if (prew[mid] <= x) lo = mid; else hi = mid - 1; }
        const int nbl = pre[lo + 1] - pre[lo], d = x - prew[lo];
        int j = 0; if (d > 0) { j = (d - AS_SW + AS_UW - 1) / AS_UW; j = j < 1 ? 1 : j; j = j > nbl ? nbl : j; }
        return pre[lo] + j; };
#define AS_DECODE(u_, h_, kb_, b_, cnt_) do { int lo_ = 0, hi_ = NH * NBLK - 1; while (lo_ < hi_) { const int mid_ = (lo_ + hi_ + 1) >> 1; if (pre[mid_] <= (u_)) lo_ = mid_; else hi_ = mid_ - 1; } \
        h_ = lo_ >> 6; kb_ = lo_ & 63; b_ = (u_) - pre[lo_]; cnt_ = (int)CNT[lo_]; } while (0)
    const int hh = F.lane >> 5;
    bf16x8 qf[8];
    const int u1 = first_unit((int)(((long long)(blockIdx.x + 1) * totalw) / F.G)); int hs = -1, kbs = -1;
    int u = first_unit((int)(((long long)blockIdx.x * totalw) / F.G)), h = 0, kb = 0, b = 0, cnt = 0, q = 0, r = 0; bool valid = false;
    if (u < u1) { AS_DECODE(u, h, kb, b, cnt);
        const int e = 256 * b + 32 * F.wave + (F.lane & 31); valid = e < cnt;
        const unsigned ent = BUCKET[(size_t)h * BUCKET_PER_HEAD + bucket_off(kb) + (valid ? e : 256 * b)]; q = (int)(ent >> 2); r = (int)(ent & 3u);
#pragma unroll
        for (int ks = 0; ks < 8; ++ks) qf[ks] = *(const bf16x8*)(QA + (size_t)q * DM + h * HD + 16 * ks + 8 * hh); }
    while (u < u1) {
        if (h != hs || kb != kbs) {
            __syncthreads();
            attn_stage(KA + (size_t)(kb * MBLK) * DM + h * HD, Kimg, F.tid); attn_stage(VA + (size_t)(kb * MBLK) * DM + h * HD, Vimg, F.tid);
            __syncthreads(); hs = h; kbs = kb; }
        const int un = u + 1; int hn = 0, kbn = 0, bn = 0, cntn = 0; unsigned entn = 0u; bool validn = false;
        if (un < u1) { AS_DECODE(un, hn, kbn, bn, cntn);
            const int e = 256 * bn + 32 * F.wave + (F.lane & 31); validn = e < cntn;
            entn = BUCKET[(size_t)hn * BUCKET_PER_HEAD + bucket_off(kbn) + (validn ? e : 256 * bn)]; }
        AttnState st; if (__ballot(valid) != 0ull) attn_wave<8>(qf, Kimg, Vimg, 8, -1, F.lane, st);
        const int qc = q, rc = r, hc = h; const bool vc = valid;
        if (un < u1) { q = (int)(entn >> 2); r = (int)(entn & 3u); h = hn; kb = kbn; valid = validn;
#pragma unroll
            for (int ks = 0; ks < 8; ++ks) qf[ks] = *(const bf16x8*)(QA + (size_t)q * DM + h * HD + 16 * ks + 8 * hh); }
        if (vc) {
            bf16* op = op_slot(F, rc) + (size_t)qc * DM + hc * HD + 64 * hh;
#pragma unroll
            for (int c = 0; c < 4; ++c)
#pragma unroll
                for (int g2 = 0; g2 < 2; ++g2) { u32x4 w; w.x = cvtpk(st.o[c][8 * g2], st.o[c][8 * g2 + 1]); w.y = cvtpk(st.o[c][8 * g2 + 2], st.o[c][8 * g2 + 3]); w.z = cvtpk(st.o[c][8 * g2 + 4], st.o[c][8 * g2 + 5]); w.w = cvtpk(st.o[c][8 * g2 + 6], st.o[c][8 * g2 + 7]);
                    *(u32x4*)(op + 16 * c + 8 * g2) = w; }
            if (hh == 0) ML[((size_t)rc * S + qc) * NH + hc] = (f32x2_t){st.m, st.l}; }
        u = un;
    }
    __syncthreads();
}
__device__ __forceinline__ void p_attn_own(Frame& F, const Args& A) {
    const bf16* QA = WSP(bf16, WS_R1); const bf16* KA = WSP(bf16, WS_R1 + T32); const bf16* VA = WSP(bf16, WS_R1 + 2 * T32); const f32x2_t* ML = WSP(const f32x2_t, WS_ML); bf16* YA = WSP(bf16, WS_YA);
    LAS unsigned char* Kimg = F.lds; LAS unsigned char* Vimg = F.lds + 65536;
    for (int u = blockIdx.x; u < NH * NBLK; u += F.G) { const int h = u & 7, qb = u >> 3;
        __syncthreads();
        attn_stage(KA + (size_t)(qb * MBLK) * DM + h * HD, Kimg, F.tid); attn_stage(VA + (size_t)(qb * MBLK) * DM + h * HD, Vimg, F.tid);
        __syncthreads();
        const int q = qb * MBLK + 32 * F.wave + (F.lane & 31), hh = F.lane >> 5;
        bf16x8 qf[8];
#pragma unroll
        for (int ks = 0; ks < 8; ++ks) qf[ks] = *(const bf16x8*)(QA + (size_t)q * DM + h * HD + 16 * ks + 8 * hh);
        AttnState st; attn_wave<0>(qf, Kimg, Vimg, F.wave + 1, F.wave, F.lane, st);
        float mr[3], lr[3], M = st.m;
#pragma unroll
        for (int r = 0; r < 3; ++r) { const f32x2_t ml = ML[((size_t)r * S + q) * NH + h]; mr[r] = ml.x; lr[r] = ml.y; M = fmaxf(M, ml.x); }
        const float w0 = __builtin_amdgcn_exp2f(st.m - M); float L = st.l * w0; float wr[3];
#pragma unroll
        for (int r = 0; r < 3; ++r) { wr[r] = (lr[r] > 0.f) ? __builtin_amdgcn_exp2f(mr[r] - M) : 0.f; L += lr[r] * wr[r]; }
        const float iL = rcp_(L);
        const size_t pbase = (size_t)q * DM + h * HD + 64 * hh;
        const bf16* ps0 = op_slot(F, 0) + pbase; const bf16* ps1 = op_slot(F, 1) + pbase; const bf16* ps2 = op_slot(F, 2) + pbase;
#pragma unroll
        for (int half = 0; half < 2; ++half) {
            bf16x8 pl[4][3];
#pragma unroll
            for (int k = 0; k < 4; ++k) { pl[k][0] = *(const bf16x8*)(ps0 + 32 * half + 8 * k); pl[k][1] = *(const bf16x8*)(ps1 + 32 * half + 8 * k); pl[k][2] = *(const bf16x8*)(ps2 + 32 * half + 8 * k); }
            __builtin_amdgcn_sched_barrier(0);
#pragma unroll
            for (int k = 0; k < 4; ++k) { const int c = 2 * half + (k >> 1), g2 = k & 1;
                float v[8];
#pragma unroll
                for (int e = 0; e < 8; ++e) v[e] = st.o[c][8 * g2 + e] * w0;
#pragma unroll
                for (int r = 0; r < 3; ++r) { float pf[8]; unpack8f(pl[k][r], pf); const bool on = wr[r] != 0.f;
#pragma unroll
                    for (int e = 0; e < 8; ++e) v[e] += on ? wr[r] * pf[e] : 0.f; }
                u32x2 wa, wb; wa.x = cvtpk(v[0] * iL, v[1] * iL); wa.y = cvtpk(v[2] * iL, v[3] * iL); wb.x = cvtpk(v[4] * iL, v[5] * iL); wb.y = cvtpk(v[6] * iL, v[7] * iL);
                bf16* yp = YA + (size_t)q * DM + h * HD + 32 * c + 16 * g2 + 4 * hh; *(u32x2*)yp = wa; *(u32x2*)(yp + 8) = wb; }
        }
    }
    __syncthreads();
}
__device__ __forceinline__ void p_dn_conv(Frame& F, const Args& A) {
    const bf16* QB = WSP(bf16, WS_R1); const bf16* KB = WSP(bf16, WS_R1 + T32); const bf16* VB = WSP(bf16, WS_R1 + 2 * T32);
    bf16* QN = (bf16*)F.out; bf16* KN = (bf16*)F.out + (size_t)S * DM; bf16* VN = WSP(bf16, WS_VN);
    const float* cw = A.in[3]; const float* BA = WSP(const float, WS_BA); float* BETA = WSP(float, WS_BETA); float* G = WSP(float, WS_G);
    for (int it = F.gw; it < S * NH; it += F.NGW) { const int t = it >> 3, h = it & 7, c = h * HD + 2 * F.lane;
        float aq0 = 0.f, aq1 = 0.f, ak0 = 0.f, ak1 = 0.f, av0 = 0.f, av1 = 0.f;
#pragma unroll
        for (int j = 0; j < 4; ++j) { const int tt = t + j - 3; if (tt < 0) continue;
            const unsigned xq = *(const unsigned*)(QB + (size_t)tt * DM + c), xk = *(const unsigned*)(KB + (size_t)tt * DM + c), xv = *(const unsigned*)(VB + (size_t)tt * DM + c);
            const float* w = cw + (size_t)j * 3072;
            aq0 += w[c] * bflo(xq); aq1 += w[c + 1] * bfhi(xq); ak0 += w[1024 + c] * bflo(xk); ak1 += w[1024 + c + 1] * bfhi(xk); av0 += w[2048 + c] * bflo(xv); av1 += w[2048 + c + 1] * bfhi(xv); }
        aq0 = siluf_(aq0); aq1 = siluf_(aq1); ak0 = siluf_(ak0); ak1 = siluf_(ak1); av0 = siluf_(av0); av1 = siluf_(av1);
        const float rq = rsq_(wave_sum(aq0 * aq0 + aq1 * aq1) + EPS) * 0.08838834764831845f, rk = rsq_(wave_sum(ak0 * ak0 + ak1 * ak1) + EPS);
        *(unsigned*)(QN + (size_t)t * DM + c) = pk2(aq0 * rq, aq1 * rq); *(unsigned*)(KN + (size_t)t * DM + c) = pk2(ak0 * rk, ak1 * rk); *(unsigned*)(VN + (size_t)t * DM + c) = pk2(av0, av1);
        if (F.lane == 0) { const float b = BA[(size_t)t * 16 + h], a = BA[(size_t)t * 16 + 8 + h] + A.in[5][h];
            const float sp = (a > 20.f) ? a : log1pf(expf(a));
            BETA[(size_t)t * 8 + h] = 1.f / (1.f + expf(-b)); G[(size_t)t * 8 + h] = -expf(A.in[4][h]) * sp; } }
}
__device__ __forceinline__ void p_dn_chunk(Frame& F, const Args& A) {
    const bf16* QN = (const bf16*)F.out; const bf16* KN = (const bf16*)F.out + (size_t)S * DM; bf16* VU = WSP(bf16, WS_VN); bf16* Wb = WSP(bf16, WS_W); bf16* ATT = WSP(bf16, WS_ATT);
    const float* BETA = WSP(const float, WS_BETA); const float* G = WSP(const float, WS_G); float* GC = WSP(float, WS_GC);
    LAS float* Kc = (LAS float*)(F.lds); LAS float* Qc = Kc + 64 * 132; LAS float* Lm = Qc + 64 * 132; LAS float* Tm = Lm + 64 * 65; LAS float* gcs = Tm + 64 * 65; LAS float* bes = gcs + 64; LAS float* bge = bes + 64;
    const int tid = F.tid;
    for (int item = blockIdx.x; item < NCH * NH; item += F.G) { const int n = item >> 3, h = item & 7, t0 = n * CH;
        __syncthreads();
        if (tid < 64) { gcs[tid] = G[(size_t)(t0 + tid) * 8 + h]; bes[tid] = BETA[(size_t)(t0 + tid) * 8 + h]; }
        __syncthreads();
        if (tid == 0) { float a = 0.f; for (int i = 0; i < 64; ++i) { a += gcs[i]; gcs[i] = a; } }
#pragma unroll
        for (int r = 0; r < 2; ++r) { const int idx = tid + 512 * r, row = idx >> 4, c8 = idx & 15;
            const u32x4 kv = *(const u32x4*)(KN + (size_t)(t0 + row) * DM + h * HD + 8 * c8), qv = *(const u32x4*)(QN + (size_t)(t0 + row) * DM + h * HD + 8 * c8);
            LAS float* kd = Kc + row * 132 + 8 * c8; LAS float* qd = Qc + row * 132 + 8 * c8;
            kd[0] = bflo(kv.x); kd[1] = bfhi(kv.x); kd[2] = bflo(kv.y); kd[3] = bfhi(kv.y); kd[4] = bflo(kv.z); kd[5] = bfhi(kv.z); kd[6] = bflo(kv.w); kd[7] = bfhi(kv.w);
            qd[0] = bflo(qv.x); qd[1] = bfhi(qv.x); qd[2] = bflo(qv.y); qd[3] = bfhi(qv.y); qd[4] = bflo(qv.z); qd[5] = bfhi(qv.z); qd[6] = bflo(qv.w); qd[7] = bfhi(qv.w); }
        __syncthreads();
        if (tid < 64) { GC[(size_t)(t0 + tid) * 8 + h] = gcs[tid]; bge[tid] = bes[tid] * expf(gcs[tid]); }
        for (int r = 0; r < 8; ++r) { const int p = tid + 512 * r, i = p >> 6, j = p & 63;
            float dk = 0.f, dq = 0.f;
            if (j <= i) { const LAS float* ki = Kc + i * 132; const LAS float* kj = Kc + j * 132; const LAS float* qi = Qc + i * 132;
                for (int d = 0; d < HD; ++d) { dk += ki[d] * kj[d]; dq += qi[d] * kj[d]; } }
            const float dec = (j <= i) ? expf(gcs[i] - gcs[j]) : 0.f;
            Lm[i * 65 + j] = (j < i) ? bes[i] * dk * dec : 0.f;
            ATT[((size_t)(h * NCH + n) * 64 + i) * 64 + j] = (bf16)f2bf((j <= i) ? dq * dec : 0.f); }
        __syncthreads();
        if (tid < 64) { const int c = tid;
            for (int i = 0; i < 64; ++i) { float acc = (i == c) ? 1.f : 0.f; for (int j = 0; j < i; ++j) acc -= Lm[i * 65 + j] * Tm[j * 65 + c]; Tm[i * 65 + c] = acc; } }
        __syncthreads();
#pragma unroll
        for (int r = 0; r < 2; ++r) { const int idx = tid + 512 * r, row = idx >> 4, c8 = idx & 15;
            const u32x4 vv = *(const u32x4*)(VU + (size_t)(t0 + row) * DM + h * HD + 8 * c8); LAS float* vd = Qc + row * 132 + 8 * c8;
            vd[0] = bflo(vv.x); vd[1] = bfhi(vv.x); vd[2] = bflo(vv.y); vd[3] = bfhi(vv.y); vd[4] = bflo(vv.z); vd[5] = bfhi(vv.z); vd[6] = bflo(vv.w); vd[7] = bfhi(vv.w); }
        __syncthreads();
        { const int d = tid & 127, ig = tid >> 7;
          for (int ii = 0; ii < 16; ++ii) { const int i = ig * 16 + ii; float au = 0.f, aw = 0.f;
              for (int j = 0; j <= i; ++j) { const float t = Tm[i * 65 + j]; au += t * bes[j] * Qc[j * 132 + d]; aw += t * bge[j] * Kc[j * 132 + d]; }
              VU[(size_t)(t0 + i) * DM + h * HD + d] = (bf16)f2bf(au); Wb[(size_t)(t0 + i) * DM + h * HD + d] = (bf16)f2bf(aw); } }
    }
    __syncthreads();
}
__device__ __forceinline__ void p_dn_scan_naive(Frame& F, const Args& A) {
    if (blockIdx.x < 4) {
    const bf16* QN = (const bf16*)F.out; const bf16* KN = (const bf16*)F.out + (size_t)S * DM; const bf16* U = WSP(const bf16, WS_VN); const bf16* Wb = WSP(const bf16, WS_W); const bf16* ATT = WSP(const bf16, WS_ATT);
    const float* GC = WSP(const float, WS_GC); bf16* O = WSP(bf16, WS_O);
    LAS float* vn = (LAS float*)F.lds;
    const int tid = F.tid, wv = tid >> 6, h = blockIdx.x * 2 + (wv >> 2), e = (wv & 3) * 32 + (F.lane & 31), half = F.lane >> 5;
    float s[64];
#pragma unroll
    for (int d = 0; d < 64; ++d) s[d] = 0.f;
    for (int n = 0; n < NCH; ++n) { const int t0 = n * CH; const float gl = GC[(size_t)(t0 + 63) * 8 + h];
        for (int c = 0; c < 64; ++c) { const size_t ro = (size_t)(t0 + c) * DM + h * HD; const bf16* wp = Wb + ro + 64 * half; float a = 0.f;
#pragma unroll
            for (int d8 = 0; d8 < 8; ++d8) { if ((d8 & 1) == 0) asm volatile("" ::: "memory"); const u32x4 wv4 = *(const u32x4*)(wp + 8 * d8);
                a += bflo(wv4.x) * s[8 * d8] + bfhi(wv4.x) * s[8 * d8 + 1] + bflo(wv4.y) * s[8 * d8 + 2] + bfhi(wv4.y) * s[8 * d8 + 3] + bflo(wv4.z) * s[8 * d8 + 4] + bfhi(wv4.z) * s[8 * d8 + 5] + bflo(wv4.w) * s[8 * d8 + 6] + bfhi(wv4.w) * s[8 * d8 + 7]; }
            a += __shfl_xor(a, 32);
            vn[c * 512 + tid] = bf2f(U[ro + e]) - a; }
        for (int c = 0; c < 64; ++c) { const size_t ro = (size_t)(t0 + c) * DM + h * HD; const bf16* qp = QN + ro + 64 * half; float a = 0.f;
#pragma unroll
            for (int d8 = 0; d8 < 8; ++d8) { if ((d8 & 1) == 0) asm volatile("" ::: "memory"); const u32x4 wv4 = *(const u32x4*)(qp + 8 * d8);
                a += bflo(wv4.x) * s[8 * d8] + bfhi(wv4.x) * s[8 * d8 + 1] + bflo(wv4.y) * s[8 * d8 + 2] + bfhi(wv4.y) * s[8 * d8 + 3] + bflo(wv4.z) * s[8 * d8 + 4] + bfhi(wv4.z) * s[8 * d8 + 5] + bflo(wv4.w) * s[8 * d8 + 6] + bfhi(wv4.w) * s[8 * d8 + 7]; }
            a += __shfl_xor(a, 32);
            a *= expf(GC[(size_t)(t0 + c) * 8 + h]);
            const bf16* ap = ATT + ((size_t)(h * NCH + n) * 64 + c) * 64; float b = 0.f;
            for (int j = 0; j <= c; ++j) b += bf2f(ap[j]) * vn[j * 512 + tid];
            if (half == 0) O[ro + e] = (bf16)f2bf(a + b); }
        const float egl = expf(gl);
#pragma unroll
        for (int d = 0; d < 64; ++d) s[d] *= egl;
        for (int c = 0; c < 64; ++c) { const size_t ro = (size_t)(t0 + c) * DM + h * HD; const bf16* kp = KN + ro + 64 * half; const float f = vn[c * 512 + tid] * expf(gl - GC[(size_t)(t0 + c) * 8 + h]);
#pragma unroll
            for (int d8 = 0; d8 < 8; ++d8) { if ((d8 & 1) == 0) asm volatile("" ::: "memory"); const u32x4 wv4 = *(const u32x4*)(kp + 8 * d8);
                s[8 * d8] += f * bflo(wv4.x); s[8 * d8 + 1] += f * bfhi(wv4.x); s[8 * d8 + 2] += f * bflo(wv4.y); s[8 * d8 + 3] += f * bfhi(wv4.y); s[8 * d8 + 4] += f * bflo(wv4.z); s[8 * d8 + 5] += f * bfhi(wv4.z); s[8 * d8 + 6] += f * bflo(wv4.w); s[8 * d8 + 7] += f * bfhi(wv4.w); } }
    }
    }
}
__device__ __forceinline__ void p_dn_out(Frame& F, const Args& A) {
    const bf16* O = WSP(const bf16, WS_O); const bf16* Z = WSP(const bf16, WS_Z); bf16* YD = WSP(bf16, WS_YD); const float* ow = A.in[6];
    for (int it = F.gw; it < S * NH; it += F.NGW) { const int t = it >> 3, h = it & 7; const size_t off = (size_t)t * DM + h * HD + 2 * F.lane;
        const unsigned ov = *(const unsigned*)(O + off), zv = *(const unsigned*)(Z + off); const float o0 = bflo(ov), o1 = bfhi(ov);
        const float rs = rsq_(wave_sum(o0 * o0 + o1 * o1) * (1.f / HD) + EPS);
        *(unsigned*)(YD + off) = pk2(o0 * rs * ow[2 * F.lane] * siluf_(bflo(zv)), o1 * rs * ow[2 * F.lane + 1] * siluf_(bfhi(zv))); }
}


constexpr size_t WS_UT = WS_O;
constexpr size_t WS_KT = WS_VN;
constexpr size_t WS_EGL = WS_KMEAN;
typedef float f32x4_t __attribute__((ext_vector_type(4)));

__device__ __forceinline__ void p_dn_relayout1(Frame& F, const Args& A) {
    bf16* QN = (bf16*)F.out; bf16* Wb = WSP(bf16, WS_W); const bf16* U = WSP(const bf16, WS_VN); bf16* UT = WSP(bf16, WS_UT); const float* GC = WSP(const float, WS_GC); float* EGL = WSP(float, WS_EGL);
    LAS unsigned short* tile = (LAS unsigned short*)(F.lds + F.wave * 16640);
    for (int it = F.gw; it < NCH * NH; it += F.NGW) { const int n = it >> 3, h = it & 7, t0 = n * CH;
        if (F.lane == 0) EGL[h * NCH + n] = expf(GC[(size_t)(t0 + 63) * 8 + h]);
        for (int c = 0; c < 64; ++c) { const size_t off = (size_t)(t0 + c) * DM + h * HD + 2 * F.lane; const float eg = expf(GC[(size_t)(t0 + c) * 8 + h]);
            const unsigned qv = *(const unsigned*)(QN + off); *(unsigned*)(QN + off) = pk2(bflo(qv) * eg, bfhi(qv) * eg);
            const unsigned wv = *(const unsigned*)(Wb + off); *(unsigned*)(Wb + off) = wv ^ 0x80008000u;
            const unsigned uv = *(const unsigned*)(U + off); *(LAS unsigned*)(tile + c * 130 + 2 * F.lane) = uv; }
        asm volatile("s_waitcnt lgkmcnt(0)" ::: "memory");
        bf16* ut = UT + (size_t)(h * NCH + n) * (HD * CH);
        for (int e = 0; e < HD; ++e) ut[e * CH + F.lane] = tile[F.lane * 130 + e];
        asm volatile("s_waitcnt lgkmcnt(0)" ::: "memory");
    }
}
__device__ __forceinline__ void p_dn_relayout2(Frame& F, const Args& A) {
    const bf16* KN = (const bf16*)F.out + (size_t)S * DM; bf16* KT = WSP(bf16, WS_KT); const float* GC = WSP(const float, WS_GC);
    LAS unsigned short* tile = (LAS unsigned short*)(F.lds + F.wave * 16640);
    for (int it = F.gw; it < NCH * NH; it += F.NGW) { const int n = it >> 3, h = it & 7, t0 = n * CH;
        for (int c = 0; c < 64; ++c) { const size_t off = (size_t)(t0 + c) * DM + h * HD + 2 * F.lane; *(LAS unsigned*)(tile + c * 130 + 2 * F.lane) = *(const unsigned*)(KN + off); }
        asm volatile("s_waitcnt lgkmcnt(0)" ::: "memory");
        const float f = expf(GC[(size_t)(t0 + 63) * 8 + h] - GC[(size_t)(t0 + F.lane) * 8 + h]);
        bf16* kt = KT + (size_t)(h * NCH + n) * (HD * CH);
        for (int d = 0; d < HD; ++d) kt[d * CH + F.lane] = (bf16)f2bf(bf2f(tile[F.lane * 130 + d]) * f);
        asm volatile("s_waitcnt lgkmcnt(0)" ::: "memory");
    }
}

constexpr size_t WS2_QN = WS_R1, WS2_KN = WS_R1 + T32, WS2_WNEG = WS_R1 + 2 * T32, WS2_ATT = WS_H, WS2_YD = WS_R1 + 2 * T32, WS2_HALT = WS_R1 + T32;
__device__ __forceinline__ bf16* ws2_kt(Frame& F) { return (bf16*)F.out; }
__device__ __forceinline__ bf16* ws2_ut(Frame& F) { return (bf16*)F.out + (size_t)S * DM; }

struct ConvHalo { unsigned q[3], k[3], v[3]; };
__device__ __forceinline__ void p_dn_conv2_halo(Frame& F, ConvHalo& H) {
    const bf16* QB = WSP(bf16, WS_R1); const bf16* KB = WSP(bf16, WS_R1 + T32); const bf16* VB = WSP(bf16, WS_R1 + 2 * T32);
    const int n = F.gw >> 3, h = F.gw & 7, t0 = n * CH, col = h * HD + 2 * F.lane;
#pragma unroll
    for (int j = 0; j < 3; ++j) { const int tt = t0 - 3 + j; H.q[j] = H.k[j] = H.v[j] = 0u;
        if (tt >= 0 && F.gw < NCH * NH) { H.q[j] = *(const unsigned*)(QB + (size_t)tt * DM + col); H.k[j] = *(const unsigned*)(KB + (size_t)tt * DM + col); H.v[j] = *(const unsigned*)(VB + (size_t)tt * DM + col); } }
}
struct ConvW { float w0[4], w1[4]; };
__device__ __forceinline__ void conv_w(const float* cw, int col, ConvW& W) {
#pragma unroll
    for (int j = 0; j < 4; ++j) { W.w0[j] = cw[(size_t)j * 3072 + col]; W.w1[j] = cw[(size_t)j * 3072 + col + 1]; }
}
__device__ __forceinline__ __amdgpu_buffer_rsrc_t mk_rsrc(const void* p) { return __builtin_amdgcn_make_buffer_rsrc((void*)p, 0, 0x7fffffff, 0x00020000); }
__device__ __forceinline__ void conv_load(const bf16* src, int t0, int col, unsigned (&xall)[CH]) {
    const __amdgpu_buffer_rsrc_t r = mk_rsrc(src + (size_t)t0 * DM);
#pragma unroll
    for (int c = 0; c < CH; ++c) xall[c] = __builtin_amdgcn_raw_buffer_load_b32(r, 2 * col, c * (DM * 2), 0);
}
template <bool NORM, bool DST, bool TILE> __device__ __forceinline__ void conv_pass(const unsigned (&xall)[CH], bf16* dst, LAS unsigned short* tile, const ConvW& W, const unsigned (&halo)[3], int t0, int col, int lane, float scale) {
    float a0 = bflo(halo[0]), a1 = bfhi(halo[0]), b0 = bflo(halo[1]), b1 = bfhi(halo[1]), c0 = bflo(halo[2]), c1 = bfhi(halo[2]);
    const __amdgpu_buffer_rsrc_t rd = mk_rsrc(DST ? dst + (size_t)t0 * DM : nullptr);
#pragma unroll
    for (int c = 0; c < CH; ++c) { const unsigned xv = xall[c]; const float d0 = bflo(xv), d1 = bfhi(xv);
        float y0 = siluf_(W.w0[0] * a0 + W.w0[1] * b0 + W.w0[2] * c0 + W.w0[3] * d0), y1 = siluf_(W.w1[0] * a1 + W.w1[1] * b1 + W.w1[2] * c1 + W.w1[3] * d1);
        if (NORM) { const float rs = scale * rsq_(wave_sum(y0 * y0 + y1 * y1) + EPS); y0 *= rs; y1 *= rs; }
        const unsigned o = pk2(y0, y1);
        if (DST) __builtin_amdgcn_raw_buffer_store_b32(o, rd, 2 * col, c * (DM * 2), 0);
        if (TILE) *(LAS unsigned*)(tile + c * 130 + 2 * lane) = o;
        a0 = b0; a1 = b1; b0 = c0; b1 = c1; c0 = d0; c1 = d1; }
}
__device__ __forceinline__ void conv_tile_out(const LAS unsigned short* tile, bf16* dstT, int lane) {
#pragma unroll 4
    for (int i = 0; i < 16; ++i) { const int d = 8 * i + (lane >> 3), ch = lane & 7; const LAS unsigned short* tp = tile + (8 * ch) * 130 + d;
        u32x4 w; w.x = (unsigned)tp[0] | ((unsigned)tp[130] << 16); w.y = (unsigned)tp[260] | ((unsigned)tp[390] << 16); w.z = (unsigned)tp[520] | ((unsigned)tp[650] << 16); w.w = (unsigned)tp[780] | ((unsigned)tp[910] << 16);
        *(u32x4*)(dstT + (size_t)d * CH + 8 * ch) = w; }
}
__device__ __forceinline__ void p_dn_conv2(Frame& F, const Args& A, const ConvHalo& H) {
    if (F.gw >= NCH * NH) return;
    bf16* QB = WSP(bf16, WS_R1); bf16* KB = WSP(bf16, WS_R1 + T32); const bf16* VB = WSP(bf16, WS_R1 + 2 * T32); const float* cw = A.in[3];
    LAS unsigned short* tile = (LAS unsigned short*)(F.lds + F.wave * 16640);
    const int n = F.gw >> 3, h = F.gw & 7, t0 = n * CH, col = h * HD + 2 * F.lane;
    bf16* ktr = ws2_kt(F) + (size_t)(h * NCH + n) * (HD * CH); bf16* vt = ws2_ut(F) + (size_t)(h * NCH + n) * (HD * CH);
    unsigned xa[CH]; ConvW W;
    conv_load(KB, t0, col, xa); conv_w(cw + 1024, col, W);
    conv_pass<true, true, true>(xa, KB, tile, W, H.k, t0, col, F.lane, 1.f);
    asm volatile("s_waitcnt lgkmcnt(0)" ::: "memory");
    conv_load(VB, t0, col, xa); conv_w(cw + 2048, col, W);
    __builtin_amdgcn_sched_barrier(0);
    conv_tile_out(tile, ktr, F.lane);
    asm volatile("s_waitcnt lgkmcnt(0)" ::: "memory");
    conv_pass<false, false, true>(xa, nullptr, tile, W, H.v, t0, col, F.lane, 1.f);
    asm volatile("s_waitcnt lgkmcnt(0)" ::: "memory");
    conv_load(QB, t0, col, xa); conv_w(cw, col, W);
    __builtin_amdgcn_sched_barrier(0);
    conv_tile_out(tile, vt, F.lane);
    asm volatile("s_waitcnt lgkmcnt(0)" ::: "memory");
    conv_pass<true, true, false>(xa, QB, tile, W, H.q, t0, col, F.lane, 0.08838834764831845f);
}

constexpr int CK_WAVE_LDS = 19200;
__device__ __forceinline__ void p_dn_chunk2(Frame& F, const Args& A) {
    if (F.gw >= NCH * NH) return;
    const int n = F.gw >> 3, h = F.gw & 7, t0 = n * CH, lane = F.lane, r = lane & 31, hh = lane >> 5;
    bf16* QN = WSP(bf16, WS2_QN); const bf16* KN = WSP(const bf16, WS2_KN); bf16* Wn = WSP(bf16, WS2_WNEG); bf16* ATT = WSP(bf16, WS2_ATT) + (size_t)(h * NCH + n) * (CH * CH);
    bf16* KT = ws2_kt(F) + (size_t)(h * NCH + n) * (HD * CH); bf16* UT = ws2_ut(F) + (size_t)(h * NCH + n) * (HD * CH);
    const float* BA = WSP(const float, WS_BA); float* EGL = WSP(float, WS_EGL);
    LAS unsigned char* wl = F.lds + F.wave * CK_WAVE_LDS; LAS float* Lw = (LAS float*)wl; LAS float* gcs = (LAS float*)(wl + 18432); LAS float* bes = gcs + 64; LAS float* fcs = bes + 64;
    float beta, gc, gl;
    { const int t = t0 + lane; const float b = BA[(size_t)t * 16 + h], a = BA[(size_t)t * 16 + 8 + h] + A.in[5][h];
      const float sp = (a > 20.f) ? a : log1pf(expf(a)); gc = -expf(A.in[4][h]) * sp; beta = 1.f / (1.f + expf(-b));
#pragma unroll
      for (int o = 1; o < 64; o <<= 1) { const float v = __shfl_up(gc, o); if (lane >= o) gc += v; }
      gl = __shfl(gc, 63);
      gcs[lane] = gc; bes[lane] = beta; fcs[lane] = expf(gl - gc);
      if (lane == 0) EGL[h * NCH + n] = expf(gl); }
    asm volatile("s_waitcnt lgkmcnt(0)" ::: "memory");
    {
        bf16x8 kf[2][8];
#pragma unroll
        for (int ti = 0; ti < 2; ++ti)
#pragma unroll
            for (int ks = 0; ks < 8; ++ks) kf[ti][ks] = *(const bf16x8*)(KN + (size_t)(t0 + 32 * ti + r) * DM + h * HD + 16 * ks + 8 * hh);
#pragma unroll
        for (int tt = 0; tt < 3; ++tt) { const int ti = (tt == 0) ? 0 : 1, tj = (tt == 2) ? 1 : 0;
            f32x16 acc;
#pragma unroll
            for (int i = 0; i < 16; ++i) acc[i] = 0.f;
#pragma unroll
            for (int ks = 0; ks < 8; ++ks) acc = __builtin_amdgcn_mfma_f32_32x32x16_bf16(kf[ti][ks], kf[tj][ks], acc, 0, 0, 0);
            const int j = 32 * tj + r; const float gcj = gcs[j];
#pragma unroll
            for (int g4 = 0; g4 < 4; ++g4) { const int i0 = 32 * ti + 8 * g4 + 4 * hh; const f32x4 gi = *(const LAS f32x4*)(gcs + i0), bi = *(const LAS f32x4*)(bes + i0);
#pragma unroll
                for (int e = 0; e < 4; ++e) { const int i = i0 + e; Lw[i * 68 + j] = (j < i) ? bi[e] * acc[4 * g4 + e] * __expf(gi[e] - gcj) : 0.f; } } }
        bf16x8 qf[2][8];
#pragma unroll
        for (int ti = 0; ti < 2; ++ti)
#pragma unroll
            for (int ks = 0; ks < 8; ++ks) qf[ti][ks] = *(const bf16x8*)(QN + (size_t)(t0 + 32 * ti + r) * DM + h * HD + 16 * ks + 8 * hh);
#pragma unroll
        for (int tt = 0; tt < 3; ++tt) { const int tj = (tt == 2) ? 1 : 0, ti = (tt == 0) ? 0 : 1;
            f32x16 acc;
#pragma unroll
            for (int i = 0; i < 16; ++i) acc[i] = 0.f;
#pragma unroll
            for (int ks = 0; ks < 8; ++ks) acc = __builtin_amdgcn_mfma_f32_32x32x16_bf16(kf[tj][ks], qf[ti][ks], acc, 0, 0, 0);
            const int i = 32 * ti + r; const float gci = gcs[i];
#pragma unroll
            for (int g4 = 0; g4 < 4; ++g4) { const int j0 = 32 * tj + 8 * g4 + 4 * hh; const f32x4 gj = *(const LAS f32x4*)(gcs + j0); float v[4];
#pragma unroll
                for (int e = 0; e < 4; ++e) v[e] = (j0 + e <= i) ? acc[4 * g4 + e] * __expf(gci - gj[e]) : 0.f;
                u32x2 w; w.x = cvtpk(v[0], v[1]); w.y = cvtpk(v[2], v[3]); *(u32x2*)(ATT + (size_t)i * CH + 32 * tj + 16 * (g4 & 1) + 8 * hh + 4 * (g4 >> 1)) = w; } }
        { const u32x4 z4 = {0u, 0u, 0u, 0u}; const int zi = lane >> 1, zj = 32 + 16 * (lane & 1); *(u32x4*)(ATT + (size_t)zi * CH + zj) = z4; *(u32x4*)(ATT + (size_t)zi * CH + zj + 8) = z4; }
#pragma unroll
        for (int ti = 0; ti < 2; ++ti) { const float eg = __expf(gcs[32 * ti + r]);
#pragma unroll
            for (int ks = 0; ks < 8; ++ks) { float f[8]; unpack8f(qf[ti][ks], f);
#pragma unroll
                for (int e = 0; e < 8; ++e) f[e] *= eg;
                const u32x4 pw = __builtin_bit_cast(u32x4, pack8f(f)); bf16* qd = QN + (size_t)(t0 + 32 * ti + r) * DM + h * HD + 32 * (ks >> 1) + 16 * hh + 4 * (ks & 1);
                u32x2 p0, p1; p0.x = pw.x; p0.y = pw.y; p1.x = pw.z; p1.y = pw.w; *(u32x2*)qd = p0; *(u32x2*)(qd + 8) = p1; } }
    }
    asm volatile("s_waitcnt lgkmcnt(0)" ::: "memory");
    float T[64];
#pragma unroll
    for (int i = 0; i < 64; ++i) { float acc = (lane == i) ? 1.f : 0.f;
#pragma unroll
        for (int j = 0; j < i; ++j) acc -= Lw[i * 68 + j] * T[j];
        T[i] = acc; }
    LAS unsigned short* Tb = (LAS unsigned short*)wl; LAS unsigned short* Tbg = Tb + 64 * 72;
    { const float eg = __expf(gc);
      asm volatile("s_waitcnt lgkmcnt(0)" ::: "memory");
#pragma unroll
      for (int i = 0; i < 64; ++i) { const float v = T[i] * beta; Tb[i * 72 + lane] = (unsigned short)f2bf(v); Tbg[i * 72 + lane] = (unsigned short)f2bf(v * eg); } }
    asm volatile("s_waitcnt lgkmcnt(0)" ::: "memory");
#ifdef DBG_CHK
    if (n < 128) { bf16* dump = WSP(bf16, 241 * MiB) + (size_t)(h * 128 + n) * 4096; for (int i = 0; i < 64; ++i) dump[i * 64 + lane] = Tbg[i * 72 + lane]; }
#endif
#ifdef DBG_CHK
    if (n < 32) { bf16* dk = WSP(bf16, 249 * MiB) + (size_t)(h * 32 + n) * 8192; for (int x = 0; x < 128; ++x) dk[x * 64 + lane] = KT[(size_t)x * CH + lane]; }
#endif
#ifdef DN2_VALU_UW
    for (int e = 0; e < HD; ++e) { float a = 0.f; for (int j2 = 0; j2 < 64; ++j2) a += bf2f(Tb[lane * 72 + j2]) * bf2f(UT[(size_t)e * CH + j2]); asm volatile("s_waitcnt vmcnt(0)" ::: "memory"); UT[(size_t)e * CH + lane] = (bf16)f2bf(a); asm volatile("s_waitcnt vmcnt(0)" ::: "memory"); }
    for (int d2 = 0; d2 < HD; ++d2) { float a = 0.f; for (int j2 = 0; j2 < 64; ++j2) a += bf2f(Tbg[lane * 72 + j2]) * bf2f(KT[(size_t)d2 * CH + j2]); Wn[(size_t)(t0 + lane) * DM + h * HD + d2] = (bf16)f2bf(-a); }
#else
#pragma unroll
    for (int te = 0; te < 4; ++te) { bf16x8 vfr[4];
#pragma unroll
        for (int ks2 = 0; ks2 < 4; ++ks2) vfr[ks2] = *(const bf16x8*)(UT + (size_t)(32 * te + r) * CH + 16 * ks2 + 8 * hh);
#pragma unroll
        for (int ti = 0; ti < 2; ++ti) { f32x16 acc;
#pragma unroll
            for (int i = 0; i < 16; ++i) acc[i] = 0.f;
#pragma unroll
            for (int ks2 = 0; ks2 < 4; ++ks2) if (ti == 1 || ks2 < 2) { const bf16x8 tb = *(const LAS bf16x8*)(Tb + (32 * ti + r) * 72 + 16 * ks2 + 8 * hh); acc = __builtin_amdgcn_mfma_f32_32x32x16_bf16(tb, vfr[ks2], acc, 0, 0, 0); }
#pragma unroll
            for (int g4 = 0; g4 < 4; ++g4) { u32x2 w; w.x = cvtpk(acc[4 * g4], acc[4 * g4 + 1]); w.y = cvtpk(acc[4 * g4 + 2], acc[4 * g4 + 3]); *(u32x2*)(UT + (size_t)(32 * te + r) * CH + 32 * ti + 8 * g4 + 4 * hh) = w; } } }
    f32x4 fsc[4][2];
#pragma unroll
    for (int ks2 = 0; ks2 < 4; ++ks2) { fsc[ks2][0] = *(const LAS f32x4*)(fcs + 16 * ks2 + 8 * hh); fsc[ks2][1] = *(const LAS f32x4*)(fcs + 16 * ks2 + 8 * hh + 4); }
#pragma unroll
    for (int td = 0; td < 4; ++td) { bf16x8 kfr[4];
#pragma unroll
        for (int ks2 = 0; ks2 < 4; ++ks2) kfr[ks2] = *(const bf16x8*)(KT + (size_t)(32 * td + r) * CH + 16 * ks2 + 8 * hh);
#pragma unroll
        for (int tc = 0; tc < 2; ++tc) { f32x16 acc;
#pragma unroll
            for (int i = 0; i < 16; ++i) acc[i] = 0.f;
#pragma unroll
            for (int ks2 = 0; ks2 < 4; ++ks2) if (tc == 1 || ks2 < 2) { const bf16x8 tg = *(const LAS bf16x8*)(Tbg + (32 * tc + r) * 72 + 16 * ks2 + 8 * hh); acc = __builtin_amdgcn_mfma_f32_32x32x16_bf16(kfr[ks2], tg, acc, 0, 0, 0); }
#pragma unroll
            for (int g4 = 0; g4 < 4; ++g4) { u32x2 w; w.x = cvtpk(-acc[4 * g4], -acc[4 * g4 + 1]); w.y = cvtpk(-acc[4 * g4 + 2], -acc[4 * g4 + 3]);
                *(u32x2*)(Wn + (size_t)(t0 + 32 * tc + r) * DM + h * HD + 32 * td + 16 * (g4 & 1) + 8 * hh + 4 * (g4 >> 1)) = w; } }
#pragma unroll
        for (int ks2 = 0; ks2 < 4; ++ks2) { float f[8]; unpack8f(kfr[ks2], f); const f32x4 f0 = fsc[ks2][0], f1 = fsc[ks2][1];
            f[0] *= f0[0]; f[1] *= f0[1]; f[2] *= f0[2]; f[3] *= f0[3]; f[4] *= f1[0]; f[5] *= f1[1]; f[6] *= f1[2]; f[7] *= f1[3];
            const u32x4 pw = __builtin_bit_cast(u32x4, pack8f(f)); const int ch = 2 * ks2 + hh; bf16* kd = KT + (size_t)(32 * td + r) * CH + 32 * (ch >> 2) + 16 * (ch & 1) + 4 * ((ch >> 1) & 1);
            u32x2 p0, p1; p0.x = pw.x; p0.y = pw.y; p1.x = pw.z; p1.y = pw.w; *(u32x2*)kd = p0; *(u32x2*)(kd + 8) = p1; } }
#endif
}

#ifndef DN2
#define DN2 1
#endif
#if DN2
#define SCAN_WNEG WS2_WNEG
#define SCAN_QP WSP(const bf16, WS2_QN)
#define SCAN_KT ws2_kt(F)
#define SCAN_UT ws2_ut(F)
#define SCAN_ATT WS2_ATT
#define SCAN_YD WS2_YD
#else
#define SCAN_WNEG WS_W
#define SCAN_QP ((const bf16*)F.out)
#define SCAN_KT WSP(bf16, WS_KT)
#define SCAN_UT WSP(bf16, WS_UT)
#define SCAN_ATT WS_ATT
#define SCAN_YD WS_YD
#endif
constexpr int SC_RW = 288, SC_RK = 160;
constexpr int SC_W = 0, SC_Q = 64 * SC_RW, SC_K = 2 * 64 * SC_RW, SC_A = SC_K + 128 * SC_RK, SC_BUF = SC_A + 64 * SC_RK;
__device__ __forceinline__ bf16x8 frag2(const LAS unsigned char* p) {
    const u32x2 a = *(const LAS u32x2*)p, b = *(const LAS u32x2*)(p + 32); u32x4 w; w.x = a.x; w.y = a.y; w.z = b.x; w.w = b.y; return __builtin_bit_cast(bf16x8, w);
}
__device__ __forceinline__ bf16x8 packb(const f32x4_t a, const f32x4_t b) { u32x4 w; w.x = cvtpk(a[0], a[1]); w.y = cvtpk(a[2], a[3]); w.z = cvtpk(b[0], b[1]); w.w = cvtpk(b[2], b[3]); return __builtin_bit_cast(bf16x8, w); }
constexpr int SCAN_WGS = 16;
__device__ __forceinline__ void p_dn_scan_fast(Frame& F, const Args& A) {
    if (blockIdx.x < SCAN_WGS) {
    const int h = blockIdx.x >> 1, hf = blockIdx.x & 1;
    const bf16* Wb = WSP(const bf16, SCAN_WNEG); const bf16* QP = SCAN_QP; const bf16* KT = SCAN_KT; const bf16* ATT = WSP(const bf16, SCAN_ATT); bf16* UT = SCAN_UT; const float* EGL = WSP(const float, WS_EGL);
    if (F.wave >= 4) {
        const int lt = F.tid - 256;
#if defined(SCAN_PROBE) && SCAN_PROBE == 2
        unsigned long long lp_sum = 0ull, lp_t0 = 0ull;
#define SCP_T0() (lp_t0 = __builtin_amdgcn_s_memrealtime())
#define SCP_T1() (lp_sum += __builtin_amdgcn_s_memrealtime() - lp_t0)
#else
#define SCP_T0() ((void)0)
#define SCP_T1() ((void)0)
#endif
        u32x4 rwA[4], rqA[4], rkA[4], raA[2], rwB[4], rqB[4], rkB[4], raB[2], rwC[4], rqC[4], rkC[4], raC[2];
#define SC_GLD(dst, voff, sbase) asm volatile("global_load_dwordx4 %0, %1, %2" : "=v"(dst) : "v"(voff), "s"(sbase) : "memory")
        const unsigned vo_w = (unsigned)((lt >> 4) * (DM * 2) + (lt & 15) * 16), vo_t = (unsigned)lt * 16u;
#define SC_ISSUE(n_, X) do { const bf16* bw_ = Wb + (size_t)((n_) * CH) * DM + h * HD; const bf16* bq_ = QP + (size_t)((n_) * CH) * DM + h * HD; \
            const bf16* bk_ = KT + (size_t)(h * NCH + (n_)) * (HD * CH); const bf16* ba_ = ATT + (size_t)(h * NCH + (n_)) * (CH * CH); \
            _Pragma("unroll") for (int i = 0; i < 4; ++i) { SC_GLD(rw##X[i], vo_w + (unsigned)i * (16u * DM * 2u), bw_); SC_GLD(rq##X[i], vo_w + (unsigned)i * (16u * DM * 2u), bq_); } \
            _Pragma("unroll") for (int i = 0; i < 4; ++i) { SC_GLD(rk##X[i], vo_t + (unsigned)i * 4096u, bk_); } \
            _Pragma("unroll") for (int i = 0; i < 2; ++i) { SC_GLD(ra##X[i], vo_t + (unsigned)i * 4096u, ba_); } } while (0)
#define SC_WAIT(N, X) asm volatile("s_waitcnt vmcnt(" #N ")" : "+v"(rw##X[0]), "+v"(rw##X[1]), "+v"(rw##X[2]), "+v"(rw##X[3]), "+v"(rq##X[0]), "+v"(rq##X[1]), "+v"(rq##X[2]), "+v"(rq##X[3]), \
            "+v"(rk##X[0]), "+v"(rk##X[1]), "+v"(rk##X[2]), "+v"(rk##X[3]), "+v"(ra##X[0]), "+v"(ra##X[1]) :: "memory")
#define SC_PUT(buf_, X) do { LAS unsigned char* b_ = F.lds + (buf_) * SC_BUF; \
            _Pragma("unroll") for (int i = 0; i < 4; ++i) { const int idx = lt + 256 * i, row = idx >> 4, ch = idx & 15; *(LAS u32x4*)(b_ + SC_W + row * SC_RW + 16 * ch) = rw##X[i]; *(LAS u32x4*)(b_ + SC_Q + row * SC_RW + 16 * ch) = rq##X[i]; } \
            _Pragma("unroll") for (int i = 0; i < 4; ++i) { const int idx = lt + 256 * i, row = idx >> 3, ch = idx & 7; *(LAS u32x4*)(b_ + SC_K + row * SC_RK + 16 * ch) = rk##X[i]; } \
            _Pragma("unroll") for (int i = 0; i < 2; ++i) { const int idx = lt + 256 * i, row = idx >> 3, ch = idx & 7; *(LAS u32x4*)(b_ + SC_A + row * SC_RK + 16 * ch) = ra##X[i]; } } while (0)
#define SC_STEP(n_, X) do { SCP_T0(); if ((n_) + 1 < NCH) { if ((n_) + 3 < NCH) SC_WAIT(28, X); else if ((n_) + 2 < NCH) SC_WAIT(14, X); else SC_WAIT(0, X); \
                SC_PUT(((n_) + 1) & 1, X); if ((n_) + 4 < NCH) SC_ISSUE((n_) + 4, X); } \
            asm volatile("s_waitcnt lgkmcnt(0)" ::: "memory"); SCP_T1(); __builtin_amdgcn_s_barrier(); } while (0)
        SC_ISSUE(0, A); SC_WAIT(0, A); SC_PUT(0, A);
        asm volatile("s_waitcnt lgkmcnt(0)" ::: "memory");
        __builtin_amdgcn_s_barrier();
        SC_ISSUE(1, A); SC_ISSUE(2, B); SC_ISSUE(3, C);
        for (int n = 0; n < NCH; n += 3) {
            SC_STEP(n, A);
            if (n + 1 < NCH) SC_STEP(n + 1, B);
            if (n + 2 < NCH) SC_STEP(n + 2, C);
        }
#if defined(SCAN_PROBE) && SCAN_PROBE == 2
        if (blockIdx.x == 0 && F.tid == 256) F.MISC[16] = (unsigned)lp_sum;
#endif
    } else {
        const int r = F.lane & 15, g = F.lane >> 4, e0 = (hf * 4 + F.wave) * 16;
        f32x4_t sacc[8];
#pragma unroll
        for (int i = 0; i < 8; ++i) sacc[i] = (f32x4_t){0.f, 0.f, 0.f, 0.f};
        bf16* utp = UT + (size_t)h * NCH * (HD * CH) + (size_t)(e0 + r) * CH + 4 * g;
        u32x2 un[4];
#pragma unroll
        for (int ct = 0; ct < 4; ++ct) un[ct] = *(const u32x2*)(utp + 16 * ct);
        float egl = EGL[h * NCH];
        __builtin_amdgcn_s_barrier();
#ifdef SCAN_PROBE
        unsigned long long sp_sum = 0ull;
#endif
        for (int n = 0; n < NCH; ++n) {
#ifdef SCAN_PROBE
            const unsigned long long sp_t0 = __builtin_amdgcn_s_memrealtime();
#endif
            const LAS unsigned char* b = F.lds + (n & 1) * SC_BUF; const LAS unsigned char* lw = b + SC_W + r * SC_RW + 16 * g; const LAS unsigned char* lq = b + SC_Q + r * SC_RW + 16 * g;
            const LAS unsigned char* lk = b + SC_K + r * SC_RK + 16 * g; const LAS unsigned char* la = b + SC_A + r * SC_RK + 16 * g;
            f32x4_t vacc[4], oacc[4]; bf16x8 sb[4], fa[16], fb[16];
#pragma unroll
            for (int ct = 0; ct < 4; ++ct)
#pragma unroll
                for (int kk = 0; kk < 4; ++kk) fa[4 * ct + kk] = *(const LAS bf16x8*)(lw + ct * 16 * SC_RW + kk * 64);
#pragma unroll
            for (int ct = 0; ct < 4; ++ct)
#pragma unroll
                for (int kk = 0; kk < 4; ++kk) fb[4 * ct + kk] = *(const LAS bf16x8*)(lq + ct * 16 * SC_RW + kk * 64);
            __builtin_amdgcn_sched_barrier(0);
#pragma unroll
            for (int kk = 0; kk < 4; ++kk) sb[kk] = packb(sacc[2 * kk], sacc[2 * kk + 1]);
#pragma unroll
            for (int ct = 0; ct < 4; ++ct) { vacc[ct] = (f32x4_t){bflo(un[ct].x), bfhi(un[ct].x), bflo(un[ct].y), bfhi(un[ct].y)}; oacc[ct] = (f32x4_t){0.f, 0.f, 0.f, 0.f}; }
            bf16* utc = utp + (size_t)n * (HD * CH);
            u32x2 unn[4]; float egln = 0.f;
            if (n + 1 < NCH) {
#pragma unroll
                for (int ct = 0; ct < 4; ++ct) unn[ct] = *(const u32x2*)(utc + HD * CH + 16 * ct);
                egln = EGL[h * NCH + n + 1]; }
#pragma unroll
            for (int kk = 0; kk < 4; ++kk)
#pragma unroll
                for (int ct = 0; ct < 4; ++ct) vacc[ct] = __builtin_amdgcn_mfma_f32_16x16x32_bf16(fa[4 * ct + kk], sb[kk], vacc[ct], 0, 0, 0);
            __builtin_amdgcn_sched_barrier(0);
#pragma unroll
            for (int mt = 0; mt < 8; ++mt)
#pragma unroll
                for (int k2 = 0; k2 < 2; ++k2) fa[2 * mt + k2] = *(const LAS bf16x8*)(lk + mt * 16 * SC_RK + k2 * 64);
            __builtin_amdgcn_sched_barrier(0);
#pragma unroll
            for (int kk = 0; kk < 4; ++kk)
#pragma unroll
                for (int ct = 0; ct < 4; ++ct) oacc[ct] = __builtin_amdgcn_mfma_f32_16x16x32_bf16(fb[4 * ct + kk], sb[kk], oacc[ct], 0, 0, 0);
            __builtin_amdgcn_sched_barrier(0);
#pragma unroll
            for (int ct = 0; ct < 4; ++ct)
#pragma unroll
                for (int k2 = 0; k2 < 2; ++k2) if (!(k2 == 1 && ct < 2)) fb[2 * ct + k2] = *(const LAS bf16x8*)(la + ct * 16 * SC_RK + k2 * 64);
            __builtin_amdgcn_sched_barrier(0);
            bf16x8 vb[2];
#pragma unroll
            for (int k2 = 0; k2 < 2; ++k2) vb[k2] = packb(vacc[2 * k2], vacc[2 * k2 + 1]);
#pragma unroll
            for (int mt = 0; mt < 8; ++mt) sacc[mt] = sacc[mt] * egl;
#pragma unroll
            for (int k2 = 0; k2 < 2; ++k2)
#pragma unroll
                for (int mt = 0; mt < 8; ++mt) sacc[mt] = __builtin_amdgcn_mfma_f32_16x16x32_bf16(fa[2 * mt + k2], vb[k2], sacc[mt], 0, 0, 0);
#pragma unroll
            for (int k2 = 0; k2 < 2; ++k2)
#pragma unroll
                for (int ct = 0; ct < 4; ++ct) if (!(k2 == 1 && ct < 2)) oacc[ct] = __builtin_amdgcn_mfma_f32_16x16x32_bf16(fb[2 * ct + k2], vb[k2], oacc[ct], 0, 0, 0);
#pragma unroll
            for (int ct = 0; ct < 4; ++ct) { u32x2 w; w.x = cvtpk(oacc[ct][0], oacc[ct][1]); w.y = cvtpk(oacc[ct][2], oacc[ct][3]); *(u32x2*)(utc + 16 * ct) = w; }
#pragma unroll
            for (int ct = 0; ct < 4; ++ct) un[ct] = unn[ct];
            egl = egln;
            asm volatile("s_waitcnt lgkmcnt(0)" ::: "memory");
#if defined(SCAN_PROBE) && SCAN_PROBE == 1
            asm volatile("s_waitcnt vmcnt(0)" ::: "memory"); sp_sum += __builtin_amdgcn_s_memrealtime() - sp_t0;
#endif
            __builtin_amdgcn_s_barrier();
        }
#if defined(SCAN_PROBE) && SCAN_PROBE == 1
        if (blockIdx.x == 0 && F.tid == 0) F.MISC[16] = (unsigned)sp_sum;
#endif
    }
    }
}

constexpr int SEG_G = 8, SEG_N = NCH / SEG_G;
constexpr size_t WS_SST = 241 * MiB;
constexpr size_t WS_MBB = 245 * MiB;
constexpr size_t WS_MBM = 249 * MiB;
static_assert(WS_MBM + (size_t)NH * (SEG_G - 1) * 128 * 128 * 4 <= WS_END, "segment scan buffers");

template <bool FINAL> __device__ __forceinline__ void scan_job(Frame& F, const Args& A, int h, int sg, int sub) {
    const bf16* Wb = WSP(const bf16, SCAN_WNEG); const bf16* QP = SCAN_QP; const bf16* KT = SCAN_KT; const bf16* ATT = WSP(const bf16, SCAN_ATT); bf16* UT = SCAN_UT; const float* EGL = WSP(const float, WS_EGL);
    const int n0 = sg * SEG_N, n1 = n0 + SEG_N;
    constexpr int NLD = FINAL ? 14 : 8;
    if (F.wave >= 4) {
        const int lt = F.tid - 256;
        u32x4 rwA[4], rqA[4], rkA[4], raA[2], rwB[4], rqB[4], rkB[4], raB[2], rwC[4], rqC[4], rkC[4], raC[2];
#define S2_GLD(dst, voff, sbase) asm volatile("global_load_dwordx4 %0, %1, %2" : "=v"(dst) : "v"(voff), "s"(sbase) : "memory")
        const unsigned vo_w = (unsigned)((lt >> 4) * (DM * 2) + (lt & 15) * 16), vo_t = (unsigned)lt * 16u;
#define S2_ISSUE(n_, X) do { const bf16* bw_ = Wb + (size_t)((n_) * CH) * DM + h * HD; const bf16* bk_ = KT + (size_t)(h * NCH + (n_)) * (HD * CH); \
            _Pragma("unroll") for (int i = 0; i < 4; ++i) { S2_GLD(rw##X[i], vo_w + (unsigned)i * (16u * DM * 2u), bw_); } \
            _Pragma("unroll") for (int i = 0; i < 4; ++i) { S2_GLD(rk##X[i], vo_t + (unsigned)i * 4096u, bk_); } \
            if constexpr (FINAL) { const bf16* bq_ = QP + (size_t)((n_) * CH) * DM + h * HD; const bf16* ba_ = ATT + (size_t)(h * NCH + (n_)) * (CH * CH); \
                _Pragma("unroll") for (int i = 0; i < 4; ++i) { S2_GLD(rq##X[i], vo_w + (unsigned)i * (16u * DM * 2u), bq_); } \
                _Pragma("unroll") for (int i = 0; i < 2; ++i) { S2_GLD(ra##X[i], vo_t + (unsigned)i * 4096u, ba_); } } } while (0)
#define S2_TIEF(X) "+v"(rw##X[0]), "+v"(rw##X[1]), "+v"(rw##X[2]), "+v"(rw##X[3]), "+v"(rq##X[0]), "+v"(rq##X[1]), "+v"(rq##X[2]), "+v"(rq##X[3]), "+v"(rk##X[0]), "+v"(rk##X[1]), "+v"(rk##X[2]), "+v"(rk##X[3]), "+v"(ra##X[0]), "+v"(ra##X[1])
#define S2_TIEA(X) "+v"(rw##X[0]), "+v"(rw##X[1]), "+v"(rw##X[2]), "+v"(rw##X[3]), "+v"(rk##X[0]), "+v"(rk##X[1]), "+v"(rk##X[2]), "+v"(rk##X[3])
#define S2_WAIT2(X) do { if constexpr (FINAL) asm volatile("s_waitcnt vmcnt(28)" : S2_TIEF(X) :: "memory"); else asm volatile("s_waitcnt vmcnt(16)" : S2_TIEA(X) :: "memory"); } while (0)
#define S2_WAIT0(X) do { if constexpr (FINAL) asm volatile("s_waitcnt vmcnt(0)" : S2_TIEF(X) :: "memory"); else asm volatile("s_waitcnt vmcnt(0)" : S2_TIEA(X) :: "memory"); } while (0)
#define S2_PUT(buf_, X) do { LAS unsigned char* b_ = F.lds + (buf_) * SC_BUF; \
            _Pragma("unroll") for (int i = 0; i < 4; ++i) { const int idx = lt + 256 * i, row = idx >> 4, ch = idx & 15; *(LAS u32x4*)(b_ + SC_W + row * SC_RW + 16 * ch) = rw##X[i]; \
                if constexpr (FINAL) *(LAS u32x4*)(b_ + SC_Q + row * SC_RW + 16 * ch) = rq##X[i]; } \
            _Pragma("unroll") for (int i = 0; i < 4; ++i) { const int idx = lt + 256 * i, row = idx >> 3, ch = idx & 7; *(LAS u32x4*)(b_ + SC_K + row * SC_RK + 16 * ch) = rk##X[i]; } \
            if constexpr (FINAL) { _Pragma("unroll") for (int i = 0; i < 2; ++i) { const int idx = lt + 256 * i, row = idx >> 3, ch = idx & 7; *(LAS u32x4*)(b_ + SC_A + row * SC_RK + 16 * ch) = ra##X[i]; } } } while (0)
#define S2_STEP(n_, X) do { S2_WAIT2(X); S2_PUT(((n_) + 1 - n0) & 1, X); { const int nn_ = ((n_) + 4 < n1) ? (n_) + 4 : n1 - 1; S2_ISSUE(nn_, X); } \
            asm volatile("s_waitcnt lgkmcnt(0)" ::: "memory"); __builtin_amdgcn_s_barrier(); } while (0)
        static_assert(SEG_N % 3 == 2, "loader tail below is written for SEG_N = 3k + 2");
        S2_ISSUE(n0, A); S2_WAIT0(A); S2_PUT(0, A);
        asm volatile("s_waitcnt lgkmcnt(0)" ::: "memory");
        __builtin_amdgcn_s_barrier();
        S2_ISSUE(n0 + 1, A); S2_ISSUE(n0 + 2, B); S2_ISSUE(n0 + 3, C);
        int n = n0;
        for (; n + 2 < n1; n += 3) { S2_STEP(n, A); S2_STEP(n + 1, B); S2_STEP(n + 2, C); }
        S2_STEP(n, A); S2_STEP(n + 1, B);
        asm volatile("s_waitcnt vmcnt(0)" ::: "memory");
    } else {
        const int r = F.lane & 15, g = F.lane >> 4;
        const int col = FINAL ? (sub * 4 + F.wave) * 16 + r : 64 * sub + 16 * F.wave + r;
        const bool real = FINAL || (col < 128);
        f32x4_t sacc[8];
        if constexpr (FINAL) { const float* sp = WSP(const float, WS_SST) + ((size_t)(h * SEG_G + sg) * 128 + col) * 128 + 4 * g;
#pragma unroll
            for (int mt = 0; mt < 8; ++mt) sacc[mt] = *(const f32x4_t*)(sp + 16 * mt); }
        else {
#pragma unroll
            for (int mt = 0; mt < 8; ++mt)
#pragma unroll
                for (int e = 0; e < 4; ++e) sacc[mt][e] = (!real && (16 * mt + 4 * g + e) == (col - 128)) ? 1.f : 0.f; }
        bf16* utp = UT + (size_t)h * NCH * (HD * CH) + (size_t)((FINAL ? col : (col & 127))) * CH + 4 * g;
        u32x2 un[4];
#pragma unroll
        for (int ct = 0; ct < 4; ++ct) { un[ct] = (u32x2){0u, 0u}; if (real) un[ct] = *(const u32x2*)(utp + (size_t)n0 * (HD * CH) + 16 * ct); }
        float egl = EGL[h * NCH + n0];
        __builtin_amdgcn_s_barrier();
        for (int n = n0; n < n1; ++n) {
            const LAS unsigned char* b = F.lds + ((n - n0) & 1) * SC_BUF; const LAS unsigned char* lw = b + SC_W + r * SC_RW + 16 * g; const LAS unsigned char* lq = b + SC_Q + r * SC_RW + 16 * g;
            const LAS unsigned char* lk = b + SC_K + r * SC_RK + 16 * g; const LAS unsigned char* la = b + SC_A + r * SC_RK + 16 * g;
            f32x4_t vacc[4], oacc[4]; bf16x8 sb[4], fa[16], fb[16];
#pragma unroll
            for (int ct = 0; ct < 4; ++ct)
#pragma unroll
                for (int kk = 0; kk < 4; ++kk) fa[4 * ct + kk] = *(const LAS bf16x8*)(lw + ct * 16 * SC_RW + kk * 64);
            if constexpr (FINAL) {
#pragma unroll
                for (int ct = 0; ct < 4; ++ct)
#pragma unroll
                    for (int kk = 0; kk < 4; ++kk) fb[4 * ct + kk] = *(const LAS bf16x8*)(lq + ct * 16 * SC_RW + kk * 64); }
            __builtin_amdgcn_sched_barrier(0);
#pragma unroll
            for (int kk = 0; kk < 4; ++kk) sb[kk] = packb(sacc[2 * kk], sacc[2 * kk + 1]);
#pragma unroll
            for (int ct = 0; ct < 4; ++ct) { vacc[ct] = (f32x4_t){bflo(un[ct].x), bfhi(un[ct].x), bflo(un[ct].y), bfhi(un[ct].y)}; oacc[ct] = (f32x4_t){0.f, 0.f, 0.f, 0.f}; }
            bf16* utc = utp + (size_t)n * (HD * CH);
            u32x2 unn[4]; float egln = 0.f;
#pragma unroll
            for (int ct = 0; ct < 4; ++ct) unn[ct] = (u32x2){0u, 0u};
            if (n + 1 < n1) { if (real) {
#pragma unroll
                    for (int ct = 0; ct < 4; ++ct) unn[ct] = *(const u32x2*)(utc + HD * CH + 16 * ct); }
                egln = EGL[h * NCH + n + 1]; }
#pragma unroll
            for (int kk = 0; kk < 4; ++kk)
#pragma unroll
                for (int ct = 0; ct < 4; ++ct) vacc[ct] = __builtin_amdgcn_mfma_f32_16x16x32_bf16(fa[4 * ct + kk], sb[kk], vacc[ct], 0, 0, 0);
            __builtin_amdgcn_sched_barrier(0);
#pragma unroll
            for (int mt = 0; mt < 8; ++mt)
#pragma unroll
                for (int k2 = 0; k2 < 2; ++k2) fa[2 * mt + k2] = *(const LAS bf16x8*)(lk + mt * 16 * SC_RK + k2 * 64);
            __builtin_amdgcn_sched_barrier(0);
            if constexpr (FINAL) {
#pragma unroll
                for (int kk = 0; kk < 4; ++kk)
#pragma unroll
                    for (int ct = 0; ct < 4; ++ct) oacc[ct] = __builtin_amdgcn_mfma_f32_16x16x32_bf16(fb[4 * ct + kk], sb[kk], oacc[ct], 0, 0, 0);
                __builtin_amdgcn_sched_barrier(0);
#pragma unroll
                for (int ct = 0; ct < 4; ++ct)
#pragma unroll
                    for (int k2 = 0; k2 < 2; ++k2) if (!(k2 == 1 && ct < 2)) fb[2 * ct + k2] = *(const LAS bf16x8*)(la + ct * 16 * SC_RK + k2 * 64);
                __builtin_amdgcn_sched_barrier(0); }
            bf16x8 vb[2];
#pragma unroll
            for (int k2 = 0; k2 < 2; ++k2) vb[k2] = packb(vacc[2 * k2], vacc[2 * k2 + 1]);
#pragma unroll
            for (int mt = 0; mt < 8; ++mt) sacc[mt] = sacc[mt] * egl;
#pragma unroll
            for (int k2 = 0; k2 < 2; ++k2)
#pragma unroll
                for (int mt = 0; mt < 8; ++mt) sacc[mt] = __builtin_amdgcn_mfma_f32_16x16x32_bf16(fa[2 * mt + k2], vb[k2], sacc[mt], 0, 0, 0);
            if constexpr (FINAL) {
#pragma unroll
                for (int k2 = 0; k2 < 2; ++k2)
#pragma unroll
                    for (int ct = 0; ct < 4; ++ct) if (!(k2 == 1 && ct < 2)) oacc[ct] = __builtin_amdgcn_mfma_f32_16x16x32_bf16(fb[2 * ct + k2], vb[k2], oacc[ct], 0, 0, 0);
#pragma unroll
                for (int ct = 0; ct < 4; ++ct) { u32x2 w; w.x = cvtpk(oacc[ct][0], oacc[ct][1]); w.y = cvtpk(oacc[ct][2], oacc[ct][3]); *(u32x2*)(utc + 16 * ct) = w; } }
#pragma unroll
            for (int ct = 0; ct < 4; ++ct) un[ct] = unn[ct];
            egl = egln;
            asm volatile("s_waitcnt lgkmcnt(0)" ::: "memory");
            __builtin_amdgcn_s_barrier();
        }
        if constexpr (!FINAL) {
            if (real) { float* bp = WSP(float, WS_MBB) + ((size_t)(h * (SEG_G - 1) + sg) * 128 + col) * 128 + 4 * g;
#pragma unroll
                for (int mt = 0; mt < 8; ++mt) *(f32x4_t*)(bp + 16 * mt) = sacc[mt]; }
            else { bf16* mp = WSP(bf16, WS_MBM) + (size_t)(h * (SEG_G - 1) + sg) * (128 * 128) + (col - 128);
#pragma unroll
                for (int mt = 0; mt < 8; ++mt)
#pragma unroll
                    for (int e = 0; e < 4; ++e) mp[(size_t)(16 * mt + 4 * g + e) * 128] = (bf16)f2bf(sacc[mt][e]); } }
    }
}
constexpr int MID_SPLIT = 8;
__device__ __forceinline__ void scan_mid(Frame& F, const Args& A, int h, int cg) {
    LAS float* Sl = (LAS float*)F.lds; LAS unsigned char* Mimg = F.lds + 16 * 132 * 4;
    float* SST = WSP(float, WS_SST) + (size_t)h * SEG_G * (128 * 128);
    const float* MBB = WSP(const float, WS_MBB) + (size_t)h * (SEG_G - 1) * (128 * 128); const bf16* MBM = WSP(const bf16, WS_MBM) + (size_t)h * (SEG_G - 1) * (128 * 128);
    const int r = F.lane & 15, g = F.lane >> 4, et = F.wave, col = 16 * cg + r;
    __syncthreads();
    for (int i = F.tid; i < 16 * 128; i += NWAVES * 64) { Sl[(i >> 7) * 132 + (i & 127)] = 0.f; SST[(size_t)(16 * cg + (i >> 7)) * 128 + (i & 127)] = 0.f; }
    u32x4 mreg[2][4]; f32x4_t accn[2];
#pragma unroll
    for (int p = 0; p < 2; ++p) {
#pragma unroll
        for (int i = 0; i < 4; ++i) mreg[p][i] = *(const u32x4*)(MBM + (size_t)p * (128 * 128) + (size_t)(F.tid + 512 * i) * 8);
        accn[p] = *(const f32x4_t*)(MBB + ((size_t)p * 128 + col) * 128 + 16 * et + 4 * g); }
#pragma unroll
    for (int sg = 0; sg < SEG_G - 1; ++sg) { const int p = sg & 1;
        __syncthreads();
#pragma unroll
        for (int i = 0; i < 4; ++i) { const int idx = F.tid + 512 * i, row = idx >> 4, ch = idx & 15; *(LAS u32x4*)(Mimg + row * 272 + 16 * ch) = mreg[p][i]; }
        if (sg + 2 < SEG_G - 1) {
#pragma unroll
            for (int i = 0; i < 4; ++i) mreg[p][i] = *(const u32x4*)(MBM + (size_t)(sg + 2) * (128 * 128) + (size_t)(F.tid + 512 * i) * 8); }
        f32x4_t acc = accn[p];
        if (sg + 2 < SEG_G - 1) accn[p] = *(const f32x4_t*)(MBB + ((size_t)(sg + 2) * 128 + col) * 128 + 16 * et + 4 * g);
        __syncthreads();
#pragma unroll
        for (int kk = 0; kk < 4; ++kk) {
            const LAS float* sp = Sl + r * 132 + 32 * kk + 8 * g; const f32x4 s0 = *(const LAS f32x4*)sp, s1 = *(const LAS f32x4*)(sp + 4);
            float sf[8] = {s0.x, s0.y, s0.z, s0.w, s1.x, s1.y, s1.z, s1.w}; const bf16x8 bfr = pack8f(sf);
            const bf16x8 afr = *(const LAS bf16x8*)(Mimg + (16 * et + r) * 272 + 64 * kk + 16 * g); acc = __builtin_amdgcn_mfma_f32_16x16x32_bf16(afr, bfr, acc, 0, 0, 0); }
        *(f32x4_t*)(SST + (size_t)(sg + 1) * (128 * 128) + (size_t)col * 128 + 16 * et + 4 * g) = acc;
        __syncthreads();
        *(LAS f32x4_t*)(Sl + r * 132 + 16 * et + 4 * g) = acc;
    }
    __syncthreads();
}
__device__ __forceinline__ void p_dn_scan2_A(Frame& F, const Args& A) { const int b = blockIdx.x; if (b < NH * (SEG_G - 1) * 4) { const int gid = 8 * (b >> 5) + (b & 7), sub = (b >> 3) & 3; scan_job<false>(F, A, gid / (SEG_G - 1), gid % (SEG_G - 1), sub); } }
__device__ __forceinline__ void p_dn_scan2_B(Frame& F, const Args& A) { if (blockIdx.x < NH * MID_SPLIT) scan_mid(F, A, blockIdx.x / MID_SPLIT, blockIdx.x % MID_SPLIT); }
__device__ __forceinline__ void p_dn_scan2_C(Frame& F, const Args& A) { const int b = blockIdx.x; if (b < NH * SEG_G * 2) { const int gid = 8 * (b >> 4) + (b & 7), sub = (b >> 3) & 1; scan_job<true>(F, A, gid / SEG_G, gid % SEG_G, sub); } }
__device__ __forceinline__ void p_dn_out_fast(Frame& F, const Args& A) {
    const bf16* OT = SCAN_UT; const bf16* Z = WSP(const bf16, WS_Z); bf16* YD = WSP(bf16, SCAN_YD); const float* ow = A.in[6];
    LAS unsigned short* tile = (LAS unsigned short*)(F.lds + F.wave * 16640);
    for (int it = F.gw; it < NCH * NH; it += F.NGW) { const int n = it >> 3, h = it & 7, t0 = n * CH;
        const bf16* ot = OT + (size_t)(h * NCH + n) * (HD * CH);
        u32x4 ov[16]; unsigned zall[CH];
#pragma unroll
        for (int i = 0; i < 16; ++i) { const int e = 8 * i + (F.lane >> 3), ch = F.lane & 7; ov[i] = *(const u32x4*)(ot + (size_t)e * CH + 8 * ch); }
#pragma unroll
        for (int c = 0; c < CH; ++c) zall[c] = *(const unsigned*)(Z + (size_t)(t0 + c) * DM + h * HD + 2 * F.lane);
        const float w0 = ow[2 * F.lane], w1 = ow[2 * F.lane + 1];
#pragma unroll
        for (int i = 0; i < 16; ++i) { const int e = 8 * i + (F.lane >> 3), ch = F.lane & 7; const u32x4 v = ov[i]; LAS unsigned short* tp = tile + e * 65 + 8 * ch;
            tp[0] = (unsigned short)v.x; tp[1] = (unsigned short)(v.x >> 16); tp[2] = (unsigned short)v.y; tp[3] = (unsigned short)(v.y >> 16); tp[4] = (unsigned short)v.z; tp[5] = (unsigned short)(v.z >> 16); tp[6] = (unsigned short)v.w; tp[7] = (unsigned short)(v.w >> 16); }
        asm volatile("s_waitcnt lgkmcnt(0)" ::: "memory");
#pragma unroll
        for (int c = 0; c < CH; ++c) { const float o0 = bf2f(tile[(2 * F.lane) * 65 + c]), o1 = bf2f(tile[(2 * F.lane + 1) * 65 + c]);
            const float rs = rsq_(wave_sum(o0 * o0 + o1 * o1) * (1.f / HD) + EPS);
            const size_t off = (size_t)(t0 + c) * DM + h * HD + 2 * F.lane; const unsigned zv = zall[c];
            *(unsigned*)(YD + off) = pk2(o0 * rs * w0 * siluf_(bflo(zv)), o1 * rs * w1 * siluf_(bfhi(zv))); }
        asm volatile("s_waitcnt lgkmcnt(0)" ::: "memory");
    }
}
#ifdef DBG_ATTN
constexpr int CW_DBG = 20000;
__device__ __forceinline__ void dbg_compare(Frame& F, const bf16* a, const bf16* b, size_t n) {
    float* acc = (float*)(WSP(unsigned, WS_CTL) + CW_DBG); float d2 = 0.f, r2 = 0.f;
    for (size_t i = (size_t)F.gw * 64 + F.lane; i < n; i += (size_t)F.NGW * 64) { const float x = bf2f(a[i]), y = bf2f(b[i]); d2 += (x - y) * (x - y); r2 += y * y; }
    d2 = wave_sum(d2); r2 = wave_sum(r2);
    if (F.lane == 0) { atomicAdd(acc, d2); atomicAdd(acc + 1, r2); }
}
#endif

#if defined(DBG_DET) || defined(DBG_L2L)
constexpr int CW_CS = 24000;
__device__ __forceinline__ void dbg_cksum(Frame& F, const void* p, size_t bytes, int slot) {
    const unsigned* w = (const unsigned*)p; unsigned acc = 0u; const size_t nw = bytes / 4;
#ifdef DBG_NANCNT
    for (size_t i = (size_t)F.gw * 64 + F.lane; i < nw; i += (size_t)F.NGW * 64) { const unsigned v = w[i]; acc += ((v & 0x7F80u) >= (141u << 7)) + ((v & 0x7F800000u) >= (141u << 23)); }
#else
    for (size_t i = (size_t)F.gw * 64 + F.lane; i < nw; i += (size_t)F.NGW * 64) { const unsigned v = w[i]; acc += v * 2654435761u + (unsigned)(i * 40503u) * (v >> 7); }
#endif
#pragma unroll
    for (int o = 1; o < 64; o <<= 1) acc += __shfl_xor(acc, o);
    if (F.lane == 0) atomicAdd(WSP(unsigned, WS_CTL) + CW_CS + slot, acc);
}
#endif

#ifdef DBG_SIG
constexpr int CW_SIG = 26000;
__device__ __forceinline__ void dbg_sig(Frame& F, const bf16* p, size_t n, int slot) {
    double acc = 0.0, acc2 = 0.0;
    for (size_t i = (size_t)F.gw * 64 + F.lane; i < n; i += (size_t)F.NGW * 64) { unsigned hsh = (unsigned)i * 2654435761u; hsh ^= hsh >> 15; hsh *= 2246822519u; hsh ^= hsh >> 13;
        const float wgt = (float)(hsh & 0xFFFFu) * (1.f / 32768.f) - 1.f; const float x = bf2f(p[i]); acc += (double)(x * wgt); acc2 += (double)(x * x); }
    long long q1 = (long long)(acc * 65536.0), q2 = (long long)(acc2 * 65536.0);
#pragma unroll
    for (int o = 1; o < 64; o <<= 1) { q1 += __shfl_xor(q1, o); q2 += __shfl_xor(q2, o); }
    if (F.lane == 0) { unsigned long long* a = (unsigned long long*)(WSP(unsigned, WS_CTL) + CW_SIG); atomicAdd(a + 2 * slot, (unsigned long long)q1); atomicAdd(a + 2 * slot + 1, (unsigned long long)q2); }
}
#endif

#ifdef DBG_CHK
constexpr int CW_CHK = 28000;
__device__ __forceinline__ float dbg_g(const float* BA, const Args& A, int t, int h) { const float a = BA[(size_t)t * 16 + 8 + h] + A.in[5][h]; const float sp = (a > 20.f) ? a : log1pf(expf(a)); return -expf(A.in[4][h]) * sp; }
__device__ __forceinline__ void dbg_chk_acc(Frame& F, int k, float err, float ref) {
    long long q1 = (long long)((double)err * (double)err * 1048576.0), q2 = (long long)((double)ref * (double)ref * 1048576.0);
    unsigned long long* a = (unsigned long long*)(WSP(unsigned, WS_CTL) + CW_CHK); atomicAdd(a + 2 * k, (unsigned long long)q1); atomicAdd(a + 2 * k + 1, (unsigned long long)q2);
}
__device__ __forceinline__ void dbg_chunk2_check(Frame& F, const Args& A) {
    const float* BA = WSP(const float, WS_BA); const bf16* KN = WSP(const bf16, WS2_KN); const bf16* QP = WSP(const bf16, WS2_QN); const bf16* Wn = WSP(const bf16, WS2_WNEG);
    const bf16* ATT = WSP(const bf16, WS2_ATT); const bf16* KT = ws2_kt(F); const float* EGL = WSP(const float, WS_EGL);
    const int s = F.gw * 64 + F.lane; if (s >= 8192) return;
    unsigned hsh = (unsigned)s * 2654435761u; hsh ^= hsh >> 15; hsh *= 2246822519u; hsh ^= hsh >> 13;
    const int n = hsh & 255, h = (hsh >> 8) & 7, i = (hsh >> 11) & 63, d = (hsh >> 17) & 127, t0 = n * CH;
    float gci = 0.f, gl = 0.f; { float a = 0.f; for (int j = 0; j < 64; ++j) { a += dbg_g(BA, A, t0 + j, h); if (j == i) gci = a; } gl = a; }
    const float beta_i = 1.f / (1.f + expf(-BA[(size_t)(t0 + i) * 16 + h]));
    const bf16* ki = KN + (size_t)(t0 + i) * DM + h * HD;
    dbg_chk_acc(F, 0, EGL[h * NCH + n] - expf(gl), expf(gl));
    { const float ref = bf2f(ki[d]) * expf(gl - gci); dbg_chk_acc(F, 1, bf2f(KT[(size_t)(h * NCH + n) * (HD * CH) + (size_t)d * CH + i]) - ref, ref); }
    { const float kt = bf2f(KT[(size_t)(h * NCH + n) * (HD * CH) + (size_t)d * CH + i]); dbg_chk_acc(F, 4, kt - bf2f(ki[d]), bf2f(ki[d])); }
    if (n < 128) { const int c = d & 63; const bf16* tg = WSP(const bf16, 241 * MiB) + (size_t)(h * 128 + n) * 4096; float lhs = bf2f(tg[i * 64 + c]); float gcj = 0.f, gcc = 0.f;
      for (int j = 0; j < 64; ++j) { gcj += dbg_g(BA, A, t0 + j, h); if (j == c) gcc = gcj;
          if (j < i) { const bf16* kj = KN + (size_t)(t0 + j) * DM + h * HD; float dot = 0.f; for (int x = 0; x < HD; ++x) dot += bf2f(ki[x]) * bf2f(kj[x]); lhs += beta_i * dot * expf(gci - gcj) * bf2f(tg[j * 64 + c]); } }
      const float beta_c = 1.f / (1.f + expf(-BA[(size_t)(t0 + c) * 16 + h])); const float ref = (i == c) ? beta_c * expf(gcc) : 0.f; dbg_chk_acc(F, 5, lhs - ref, (i == c) ? ref : 0.05f * beta_c * expf(gcc)); }
    if (n < 128) { const bf16* tg = WSP(const bf16, 241 * MiB) + (size_t)(h * 128 + n) * 4096; float ref = 0.f, mag = 0.f;
      for (int j = 0; j < 64; ++j) { const float t = bf2f(tg[i * 64 + j]) * bf2f(KN[(size_t)(t0 + j) * DM + h * HD + d]); ref += t; mag += fabsf(t); }
      dbg_chk_acc(F, 6, -bf2f(Wn[(size_t)(t0 + i) * DM + h * HD + d]) - ref, mag); }
    if (n < 128) { const bf16* tg = WSP(const bf16, 241 * MiB) + (size_t)(h * 128 + n) * 4096; float r7 = 0.f, r8 = 0.f, mag = 0.f, gcj = 0.f;
      for (int j = 0; j < 64; ++j) { gcj += dbg_g(BA, A, t0 + j, h); const float kk = bf2f(KN[(size_t)(t0 + j) * DM + h * HD + d]); const float t = bf2f(tg[i * 64 + j]) * kk;
          r7 += t * expf(gl - gcj); r8 += bf2f(tg[j * 64 + i]) * kk; mag += fabsf(t); }
      const float wv = -bf2f(Wn[(size_t)(t0 + i) * DM + h * HD + d]); dbg_chk_acc(F, 7, wv - r7, mag); dbg_chk_acc(F, 8, wv - r8, mag); }
    if (n < 32) { const bf16* dk = WSP(const bf16, 249 * MiB) + (size_t)(h * 32 + n) * 8192; dbg_chk_acc(F, 9, bf2f(dk[d * 64 + i]) - bf2f(ki[d]), bf2f(ki[d])); }
    if (n < 32) { const float ref = bf2f(ki[d]) * expf(gl - gci); dbg_chk_acc(F, 10, bf2f(KT[(size_t)(h * NCH + n) * (HD * CH) + (size_t)d * CH + i]) - ref, ref); }
    if (n < 128) { const bf16* tg = WSP(const bf16, 241 * MiB) + (size_t)(h * 128 + n) * 4096; float ref = 0.f, mag = 0.f;
      for (int j = 0; j < 64; ++j) { const float t = bf2f(tg[i * 64 + j]) * bf2f(KN[(size_t)(t0 + j) * DM + h * HD + d]); ref += t; mag += fabsf(t); }
      dbg_chk_acc(F, n >= 32 ? 11 : 12, -bf2f(Wn[(size_t)(t0 + i) * DM + h * HD + d]) - ref, mag); }
    { float lhs = -bf2f(Wn[(size_t)(t0 + i) * DM + h * HD + d]); float gcj = 0.f;
      for (int j = 0; j < i; ++j) { gcj += dbg_g(BA, A, t0 + j, h); const bf16* kj = KN + (size_t)(t0 + j) * DM + h * HD; float dot = 0.f; for (int x = 0; x < HD; ++x) dot += bf2f(ki[x]) * bf2f(kj[x]);
          lhs += beta_i * dot * expf(gci - gcj) * (-bf2f(Wn[(size_t)(t0 + j) * DM + h * HD + d])); }
      const float ref = beta_i * expf(gci) * bf2f(ki[d]); dbg_chk_acc(F, 2, lhs - ref, ref); }
    { const int j = d & 63; if (j <= i && gci > -20.f) { float gcj = 0.f; for (int x = 0; x <= j; ++x) gcj += dbg_g(BA, A, t0 + x, h);
          const bf16* kj = KN + (size_t)(t0 + j) * DM + h * HD; const bf16* qi = QP + (size_t)(t0 + i) * DM + h * HD; float dot = 0.f; for (int x = 0; x < HD; ++x) dot += bf2f(qi[x]) * bf2f(kj[x]);
          const float ref = dot * expf(-gcj); dbg_chk_acc(F, 3, bf2f(ATT[(size_t)(h * NCH + n) * (CH * CH) + (size_t)i * CH + j]) - ref, ref); }
      else if (j > i) dbg_chk_acc(F, 3, bf2f(ATT[(size_t)(h * NCH + n) * (CH * CH) + (size_t)i * CH + j]), 0.f); }
}
#endif

#ifdef DBG_TILE
constexpr int CW_TILE = 30000;
__device__ __forceinline__ void dbg_tile_check(Frame& F, const Args& A) {
    if (F.gw >= NCH * NH) return;
    const int n = F.gw >> 3, h = F.gw & 7, t0 = n * CH, lane = F.lane;
    const float* BA = WSP(const float, WS_BA); const bf16* KN = WSP(const bf16, WS2_KN); const bf16* KT = ws2_kt(F) + (size_t)(h * NCH + n) * (HD * CH);
    float gc = 0.f, gl = 0.f; { float a = 0.f; for (int j = 0; j < 64; ++j) { a += dbg_g(BA, A, t0 + j, h); if (j == lane) gc = a; } gl = a; }
    const float f = expf(gl - gc); int bad = 0;
    for (int d = 0; d < HD; ++d) { const float ref = bf2f(KN[(size_t)(t0 + lane) * DM + h * HD + d]) * f; const float got = bf2f(KT[(size_t)d * CH + lane]); if (!(fabsf(got - ref) <= 0.02f * fabsf(ref) + 1e-3f)) ++bad; }
    bad = (int)wave_sum((float)bad);
    if (lane == 0 && bad > 0) { unsigned* w = WSP(unsigned, WS_CTL) + CW_TILE; atomicAdd(w, 1u); atomicMin(w + 1, (unsigned)n); atomicOr(w + 2 + n, 1u << h); atomicAdd(w + 300, (unsigned)bad); atomicOr(w + 301, 1u << h); if (bad > 4096) atomicOr(w + 302, 1u << h); }
}
#endif
template <int R> __device__ __forceinline__ void post_rows(Frame& F, const Args& A, int m0, int stride) {
    const float* x = A.in[0]; const bf16* T = WSP(const bf16, WS_T); bf16* H2 = WSP(bf16, WS_H2);
    const f32x4* w1 = (const f32x4*)A.in[10] + F.lane; const f32x4* w2 = (const f32x4*)A.in[11] + F.lane;
    unsigned long long t8[R][4]; f32x4 xv[R][4];
#pragma unroll
    for (int k = 0; k < R; ++k) { const int m = m0 + k * stride; const unsigned long long* tr = (const unsigned long long*)(T + (size_t)m * DM) + F.lane; const f32x4* xr = (const f32x4*)(x + (size_t)m * DM) + F.lane;
#pragma unroll
        for (int j = 0; j < 4; ++j) { t8[k][j] = tr[64 * j]; xv[k][j] = xr[64 * j]; } }
#pragma unroll
    for (int k = 0; k < R; ++k) { const int m = m0 + k * stride; f32x4* orow = (f32x4*)(F.out + (size_t)m * DM) + F.lane;
        f32x4 tv[4]; float ss = 0.f;
#pragma unroll
        for (int j = 0; j < 4; ++j) { const unsigned long long w8 = t8[k][j]; const unsigned lo = (unsigned)w8, hi = (unsigned)(w8 >> 32); tv[j] = (f32x4){bflo(lo), bfhi(lo), bflo(hi), bfhi(hi)}; ss += (tv[j].x * tv[j].x + tv[j].y * tv[j].y) + (tv[j].z * tv[j].z + tv[j].w * tv[j].w); }
        const float rs = rsq_(wave_sum(ss) * (1.f / DM) + EPS); float s2 = 0.f;
#pragma unroll
        for (int j = 0; j < 4; ++j) { tv[j] = xv[k][j] + tv[j] * rs * w1[64 * j]; orow[64 * j] = tv[j]; s2 += (tv[j].x * tv[j].x + tv[j].y * tv[j].y) + (tv[j].z * tv[j].z + tv[j].w * tv[j].w); }
        const float r2 = rsq_(wave_sum(s2) * (1.f / DM) + EPS);
        unsigned long long* o8 = (unsigned long long*)(H2 + (size_t)m * DM) + F.lane;
#pragma unroll
        for (int j = 0; j < 4; ++j) { const f32x4 hv = tv[j] * r2 * w2[64 * j]; o8[64 * j] = (unsigned long long)pk2(hv.x, hv.y) | ((unsigned long long)pk2(hv.z, hv.w) << 32); } }
}
__device__ __forceinline__ void p_post_mix(Frame& F, const Args& A) {
    int m = F.gw;
    for (; m + F.NGW < S; m += 2 * F.NGW) post_rows<2>(F, A, m, F.NGW);
    if (m < S) post_rows<1>(F, A, m, F.NGW);
}
#if !defined(DBG_NAN) && !defined(DBG_DET) && !defined(DBG_ATTN)
template <int R> __device__ __forceinline__ void final_rows(Frame& F, const Args& A, int m0, int stride) {
    const bf16* Fd = WSP(const bf16, WS_F); const f32x4* w = (const f32x4*)A.in[15] + F.lane;
    unsigned long long f8[R][4]; f32x4 xv[R][4];
#pragma unroll
    for (int k = 0; k < R; ++k) { const int m = m0 + k * stride; const unsigned long long* fr = (const unsigned long long*)(Fd + (size_t)m * DM) + F.lane; const f32x4* orow = (const f32x4*)(F.out + (size_t)m * DM) + F.lane;
#pragma unroll
        for (int j = 0; j < 4; ++j) { f8[k][j] = fr[64 * j]; xv[k][j] = orow[64 * j]; } }
#pragma unroll
    for (int k = 0; k < R; ++k) { const int m = m0 + k * stride; f32x4* orow = (f32x4*)(F.out + (size_t)m * DM) + F.lane;
        f32x4 fv[4]; float ss = 0.f;
#pragma unroll
        for (int j = 0; j < 4; ++j) { const unsigned long long w8 = f8[k][j]; const unsigned lo = (unsigned)w8, hi = (unsigned)(w8 >> 32); fv[j] = (f32x4){bflo(lo), bfhi(lo), bflo(hi), bfhi(hi)}; ss += (fv[j].x * fv[j].x + fv[j].y * fv[j].y) + (fv[j].z * fv[j].z + fv[j].w * fv[j].w); }
        const float rs = rsq_(wave_sum(ss) * (1.f / DM) + EPS);
#pragma unroll
        for (int j = 0; j < 4; ++j) orow[64 * j] = xv[k][j] + fv[j] * rs * w[64 * j]; }
}
__device__ __forceinline__ void p_final(Frame& F, const Args& A) {
    int m = F.gw;
    for (; m + F.NGW < S; m += 2 * F.NGW) final_rows<2>(F, A, m, F.NGW);
    if (m < S) final_rows<1>(F, A, m, F.NGW);
}
#else
__device__ __forceinline__ void p_final(Frame& F, const Args& A) {
    const bf16* Fd = WSP(const bf16, WS_F);
    for (int m = F.gw; m < S; m += F.NGW) {
        const unsigned long long* fr = (const unsigned long long*)(Fd + (size_t)m * DM) + F.lane; f32x4* orow = (f32x4*)(F.out + (size_t)m * DM) + F.lane; const f32x4* w = (const f32x4*)A.in[15] + F.lane;
        f32x4 fv[4]; float ss = 0.f;
#pragma unroll
        for (int j = 0; j < 4; ++j) { const unsigned long long w8 = fr[64 * j]; const unsigned lo = (unsigned)w8, hi = (unsigned)(w8 >> 32); fv[j] = (f32x4){bflo(lo), bfhi(lo), bflo(hi), bfhi(hi)}; ss += (fv[j].x * fv[j].x + fv[j].y * fv[j].y) + (fv[j].z * fv[j].z + fv[j].w * fv[j].w); }
        const float rs = rsq_(wave_sum(ss) * (1.f / DM) + EPS);
#pragma unroll
        for (int j = 0; j < 4; ++j) { f32x4 ov = orow[64 * j] + fv[j] * rs * w[64 * j];
#ifdef DBG_NAN
#pragma unroll
            for (int e = 0; e < 4; ++e) if (!(fabsf(ov[e]) < 1e30f)) ov[e] = 12345.f;
#endif
            orow[64 * j] = ov; }
#ifdef DBG_DET
        { const unsigned* cs = WSP(const unsigned, WS_CTL) + CW_CS; float pz = 0.f;
          for (int k = 12; k >= 0; --k) if (cs[k] != cs[16 + k]) pz = __builtin_ldexpf(1.f, 40 - 2 * k);
#pragma unroll
          for (int j = 0; j < 4; ++j) orow[64 * j] = orow[64 * j] + pz; }
#endif
#ifdef DBG_ATTN
        { const float* acc = (const float*)(WSP(unsigned, WS_CTL) + CW_DBG); const float rv = acc[0] / acc[1]; const float pz = !(rv < DBG_TOL) ? 1000.f : 0.f;
#pragma unroll
          for (int j = 0; j < 4; ++j) orow[64 * j] = orow[64 * j] + pz; }
#endif
    }
}

#endif
constexpr int NPHASE = 18;
#ifndef MK_N_LAUNCHES
#define MK_N_LAUNCHES 1
#endif
constexpr int N_LAUNCHES = MK_N_LAUNCHES;
__global__ void __launch_bounds__(NWAVES * 64, 2) fwd(Args args) {
    extern __shared__ __attribute__((aligned(16))) unsigned char lds[];
    Frame F;
    F.lds = (LAS unsigned char*)lds; F.MISC = (volatile LAS unsigned*)(F.lds + MISC_OFF);
    F.tid = threadIdx.x; F.lane = F.tid & 63; F.wave = __builtin_amdgcn_readfirstlane(F.tid >> 6);
    F.G = gridDim.x; F.gw = blockIdx.x * NWAVES + F.wave; F.NGW = F.G * NWAVES;
    F.out = args.out; F.ws = args.ws;
    for (int u = F.tid; u < (LDS_BYTES - LDSCTL_OFF) / 4; u += NWAVES * 64) ((LAS unsigned*)(F.lds + LDSCTL_OFF))[u] = 0u;
    __syncthreads();
    XcdBarrier bar; bar.bar = (unsigned*)(F.ws + WS_CTL) + CW_BAR; bar.x = 0; bar.st = nullptr;
    if (N_LAUNCHES == 1) bar = xcd_barrier_post((unsigned*)(F.ws + WS_CTL) + CW_BAR, F.MISC + 8);
#define GRID_BAR() do { if (N_LAUNCHES == 1) xcd_barrier(bar); } while (0)
    const int lo = args.ph_lo, hi = args.ph_hi;
#ifdef PROBE_LO
    unsigned long long pr_t0 = 0ull, pr_dt = 0ull;
#define PROBE_AT(k) do { if (blockIdx.x == 0 && F.tid == 0) { if ((k) == PROBE_LO) pr_t0 = __builtin_amdgcn_s_memrealtime(); if ((k) == PROBE_HI + 1) pr_dt = __builtin_amdgcn_s_memrealtime() - pr_t0; } } while (0)
#else
#define PROBE_AT(k) do {} while (0)
#endif
#ifdef DBG_L2L
#define CK(k, p, n) dbg_cksum(F, (p), (n), (k))
#define CKB() GRID_BAR()
#else
#define CK(k, p, n) do {} while (0)
#define CKB() do {} while (0)
#endif
#if defined(ONLY_PH)
#define PH_EN(k) ((k) == ONLY_PH)
#elif defined(PH_MASK)
#define PH_EN(k) (((PH_MASK) >> (k)) & 1)
#else
#define PH_EN(k) true
#endif
#define IN(k) (PH_EN(k) && lo <= (k) && (k) < hi)
#define BOTH(k) (IN(k) && IN((k) + 1))
#define GEMM(EPI, Aoff, Boff, N_, K_, ...) do { pg8::Gemm g{(const pg8::bf16_t*)(F.ws + (Aoff)), (const pg8::bf16_t*)(F.ws + (Boff)), S, (N_), (K_)}; pg8::StaticOrder So; So.init(S, (N_), F.G, (int)blockIdx.x); \
        EPI E{__VA_ARGS__}; pg8::gemm_phase<EPI, pg8::StaticOrder, true, true>(F.lds + RING_OFF, g, So, E); } while (0)

    PROBE_AT(0);
    if (IN(0)) { p_prologue(F, args); if (BOTH(0)) GRID_BAR(); }
    CK(0, F.ws + WS_H, T32); CK(0, F.ws + WS_BA, 1 * MiB); CK(0, F.ws + WS_WTA, 41 * MiB - 512 * 1024); CKB();
    PROBE_AT(1);
    if (IN(1)) { GEMM(pg8::EpiRope, WS_H, WS_WTA, 3072, DM, WSP(pg8::bf16_t, WS_R1), WSP(const float, WS_COS), WSP(const float, WS_SIN), WSP(float, WS_KMEAN)); if (BOTH(1)) GRID_BAR(); }
    CK(1, F.ws + WS_R1, 3 * T32); CKB();
    PROBE_AT(2);
#ifndef TOPK2
#define TOPK2 1
#endif
#if !TOPK2
    if (IN(2)) { p_kmean(F, args); if (BOTH(2)) GRID_BAR(); }
#endif
    CK(2, F.ws + WS_KMEAN, 256 * 1024); CKB();
#ifndef ATTN_FAST
#define ATTN_FAST 1
#endif
#if ATTN_FAST
    PROBE_AT(3);
#if TOPK2
    if (IN(3)) { p_topk2(F, args); if (BOTH(3)) GRID_BAR();
#ifdef BAR_PROBE
        for (int i_ = 0; i_ < 8; ++i_) GRID_BAR();
#endif
    }
#else
    if (IN(3)) { p_topk_bucket(F, args); if (BOTH(3)) GRID_BAR(); }
#endif
    CK(3, F.ws + WS_TOPI, (size_t)S * NH * 12); CKB();
    PROBE_AT(4);
#ifdef WGSTAT
#define WGSTAT_RUN(k, call) do { const unsigned long long t0_ = __builtin_amdgcn_s_memrealtime(); call; if (WGSTAT_PH == (k)) { __syncthreads(); if (F.tid == 0) { const unsigned dt_ = (unsigned)(__builtin_amdgcn_s_memrealtime() - t0_); \
        unsigned* w_ = WSP(unsigned, WS_CTL) + 30000; atomicMax(w_, dt_); atomicAdd(w_ + 1, dt_); atomicMin(w_ + 2, 0xFFFFFFFFu - dt_); } } } while (0)
#else
#define WGSTAT_RUN(k, call) call
#endif
    if (IN(4)) { PROBE_AT(40); WGSTAT_RUN(40, p_attn_sel(F, args)); GRID_BAR(); PROBE_AT(41); WGSTAT_RUN(41, p_attn_own(F, args)); PROBE_AT(42);
#ifdef DBG_ATTN
        GRID_BAR(); p_attn_naive(F, args); GRID_BAR(); dbg_compare(F, WSP(const bf16, WS_YA), (const bf16*)F.out, (size_t)S * DM);
#endif
        if (BOTH(4)) GRID_BAR(); }
    CK(4, F.ws + WS_YA, T32); CKB();
#else
    PROBE_AT(3);
    if (IN(3)) { p_topk(F, args); if (BOTH(3)) GRID_BAR(); }
    PROBE_AT(4);
    if (IN(4)) { p_attn_naive(F, args); if (BOTH(4)) GRID_BAR(); }
#endif
#ifdef DBG_CHK
    {   GEMM(pg8::EpiGen<0>, WS_H, WS_WTB, 4096, DM, WSP(pg8::bf16_t, WS_R1), DM, 1024, (size_t)S * DM, nullptr); GRID_BAR();
        { ConvHalo hl; p_dn_conv2_halo(F, hl); GRID_BAR(); p_dn_conv2(F, args, hl); GRID_BAR(); }
        p_dn_chunk2(F, args); GRID_BAR();
        dbg_chunk2_check(F, args); GRID_BAR();
#ifdef DBG_TILE
        if (blockIdx.x == 0 && F.tid == 0) WSP(unsigned, WS_CTL)[CW_TILE + 1] = 0xFFFFu; GRID_BAR(); dbg_tile_check(F, args); GRID_BAR();
#endif
        }
#elif defined(DBG_SIG)
    {
      { Frame Fp = F; asm volatile("" : "+s"(Fp.ws), "+s"(Fp.out), "+v"(Fp.lane), "+v"(Fp.tid));
        GEMM(pg8::EpiGen<0>, WS_H, WS_WTB, 4096, DM, WSP(pg8::bf16_t, WS_R1), DM, 1024, (size_t)S * DM, nullptr); GRID_BAR();
        p_dn_conv(Fp, args); GRID_BAR(); p_dn_chunk(Fp, args); GRID_BAR(); p_dn_relayout1(Fp, args); GRID_BAR(); p_dn_relayout2(Fp, args); GRID_BAR();
        dbg_sig(Fp, (const bf16*)Fp.out, (size_t)S * DM, 0); dbg_sig(Fp, WSPF(const bf16, WS_W), (size_t)S * DM, 1); dbg_sig(Fp, WSPF(const bf16, WS_KT), (size_t)S * DM, 2);
        dbg_sig(Fp, WSPF(const bf16, WS_UT), (size_t)S * DM, 3); dbg_sig(Fp, WSPF(const bf16, WS_ATT), (size_t)S * DM / 2, 4); GRID_BAR();
      }
      { Frame Fp = F; asm volatile("" : "+s"(Fp.ws), "+s"(Fp.out), "+v"(Fp.lane), "+v"(Fp.tid));
        p_hrecompute(Fp, args); GRID_BAR();
        GEMM(pg8::EpiGen<0>, WS_H, WS_WTB, 4096, DM, WSP(pg8::bf16_t, WS_R1), DM, 1024, (size_t)S * DM, nullptr); GRID_BAR();
        { ConvHalo hl; p_dn_conv2_halo(Fp, hl); GRID_BAR(); p_dn_conv2(Fp, args, hl); GRID_BAR(); }
        p_dn_chunk2(Fp, args); GRID_BAR();
        dbg_sig(Fp, WSPF(const bf16, WS2_QN), (size_t)S * DM, 8); dbg_sig(Fp, WSPF(const bf16, WS2_WNEG), (size_t)S * DM, 9); dbg_sig(Fp, ws2_kt(Fp), (size_t)S * DM, 10);
        dbg_sig(Fp, ws2_ut(Fp), (size_t)S * DM, 11); dbg_sig(Fp, WSPF(const bf16, WS2_ATT), (size_t)S * DM / 2, 12); GRID_BAR();
      }
    }
#elif defined(DBG_DET)
#define DET_PASS(P) { Frame Fp = F; asm volatile("" : "+s"(Fp.ws), "+s"(Fp.out), "+v"(Fp.lane), "+v"(Fp.tid)); \
    p_hrecompute(Fp, args); GRID_BAR(); \
    GEMM(pg8::EpiGen<0>, WS_H, WS_WTB, 4096, DM, WSP(pg8::bf16_t, WS_R1), DM, 1024, (size_t)S * DM, nullptr); GRID_BAR(); \
    dbg_cksum(Fp, Fp.ws + WS_R1, 4 * T32, (P) * 16 + 0); GRID_BAR(); \
    { ConvHalo hl; p_dn_conv2_halo(Fp, hl); GRID_BAR(); p_dn_conv2(Fp, args, hl); GRID_BAR(); } \
    dbg_cksum(Fp, Fp.ws + WS2_QN, T32, (P) * 16 + 1); dbg_cksum(Fp, Fp.ws + WS2_KN, T32, (P) * 16 + 2); dbg_cksum(Fp, ws2_kt(Fp), T32, (P) * 16 + 3); dbg_cksum(Fp, ws2_ut(Fp), T32, (P) * 16 + 4); GRID_BAR(); \
    p_dn_chunk2(Fp, args); GRID_BAR(); \
    dbg_cksum(Fp, Fp.ws + WS2_ATT, T32 / 2, (P) * 16 + 5); dbg_cksum(Fp, Fp.ws + WS2_QN, T32, (P) * 16 + 6); dbg_cksum(Fp, ws2_ut(Fp), T32, (P) * 16 + 7); dbg_cksum(Fp, Fp.ws + WS2_WNEG, T32, (P) * 16 + 8); \
    dbg_cksum(Fp, ws2_kt(Fp), T32, (P) * 16 + 9);  GRID_BAR(); \
    p_dn_scan_fast(Fp, args); GRID_BAR(); \
    dbg_cksum(Fp, ws2_ut(Fp), T32, (P) * 16 + 11); GRID_BAR(); \
    p_dn_out_fast(Fp, args); GRID_BAR(); \
    dbg_cksum(Fp, Fp.ws + WS2_YD, T32, (P) * 16 + 12); GRID_BAR(); }
    { DET_PASS(0) }
    { DET_PASS(1) }
    p_hrecompute(F, args); GRID_BAR();
#else
    PROBE_AT(5);
    if (IN(5)) { GEMM(pg8::EpiGen<0>, WS_H, WS_WTB, 4096, DM, WSP(pg8::bf16_t, WS_R1), DM, 1024, (size_t)S * DM, nullptr); if (BOTH(5)) GRID_BAR(); }
    CK(5, F.ws + WS_R1, 4 * T32); CKB();
#if DN2
    PROBE_AT(6);
    if (IN(6)) { ConvHalo hl; p_dn_conv2_halo(F, hl); GRID_BAR(); p_dn_conv2(F, args, hl); if (BOTH(6)) GRID_BAR(); }
    CK(6, F.ws + WS2_QN, 2 * T32); CK(6, F.out, 2 * T32); CKB();
    PROBE_AT(7);
    if (IN(7)) { p_dn_chunk2(F, args); if (BOTH(7)) GRID_BAR(); }
    CK(7, F.ws + WS2_ATT, T32 / 2); CK(7, F.ws + WS2_QN, T32); CK(7, F.out, 2 * T32); CK(7, F.ws + WS2_WNEG, T32); CK(7, F.ws + WS_EGL, 8192); CKB();
#else
    PROBE_AT(6);
    if (IN(6)) { p_dn_conv(F, args); if (BOTH(6)) GRID_BAR(); }
    PROBE_AT(7);
    if (IN(7)) { p_dn_chunk(F, args); if (BOTH(7)) GRID_BAR(); }
#endif
#ifndef DN_FAST
#define DN_FAST 1
#endif
#if DN_FAST
#if DN2
    PROBE_AT(8);
#ifndef SCAN2
#define SCAN2 1
#endif
#if SCAN2
    if (IN(8)) { PROBE_AT(80); p_dn_scan2_A(F, args); GRID_BAR(); PROBE_AT(81); p_dn_scan2_B(F, args); GRID_BAR(); PROBE_AT(82); if (blockIdx.x < 128) p_dn_scan2_C(F, args); else { p_hrecompute_sub(F, args, WSP(bf16, WS2_HALT), ((int)blockIdx.x - 128) * NWAVES + F.wave, 128 * NWAVES);
#if DN2_LATE_WT
            p_wtrans(F, args, WT_ITEMS_EARLY, WT_ITEMS_ALL, ((int)blockIdx.x - 128) * NWAVES + F.wave, 128 * NWAVES);
#endif
        } if (BOTH(8)) GRID_BAR(); PROBE_AT(83); }
#else
    if (IN(8)) { p_dn_scan_fast(F, args); if (BOTH(8)) GRID_BAR(); }
#endif
    CK(8, ws2_ut(F), T32); CKB();
#else
    PROBE_AT(8);
    if (IN(8)) { p_dn_relayout1(F, args); GRID_BAR(); p_dn_relayout2(F, args); GRID_BAR(); p_dn_scan_fast(F, args); if (BOTH(8)) GRID_BAR(); }
#endif
    PROBE_AT(9);
#if DN2 && SCAN2
    if (IN(9)) { p_dn_out_fast(F, args); if (BOTH(9)) GRID_BAR(); }
#else
    if (IN(9)) { p_dn_out_fast(F, args); p_hrecompute(F, args); if (BOTH(9)) GRID_BAR(); }
#endif
    CK(9, F.ws + WS2_YD, T32); CK(9, F.ws + WS_H, T32); CKB();
#else
    PROBE_AT(8);
    if (IN(8)) { p_dn_scan_naive(F, args); if (BOTH(8)) GRID_BAR(); }
    PROBE_AT(9);
    if (IN(9)) { p_dn_out(F, args); p_hrecompute(F, args); if (BOTH(9)) GRID_BAR(); }
#endif
#endif
    PROBE_AT(10);
    if (IN(10)) { pg8::Gemm g{(const pg8::bf16_t*)(F.ws + WS2_HALT), (const pg8::bf16_t*)(F.ws + WS_WTG), S, 2048, DM}; pg8::PairOrder Po; Po.init(S, DM, 2, F.G, (int)blockIdx.x);
        pg8::EpiGen<1> E{(pg8::bf16_t*)F.out, DM, 1024, (size_t)S * DM, nullptr}; pg8::gemm_phase<pg8::EpiGen<1>, pg8::PairOrder, true, true>(F.lds + RING_OFF, g, Po, E); if (BOTH(10) && N_LAUNCHES != 1) GRID_BAR(); }
    CK(10, F.out, 2 * T32); CKB();
    PROBE_AT(11);
    if (IN(11)) { GEMM(pg8::EpiGen<2>, WS_YA, WS_WTOA, 1024, DM, (pg8::bf16_t*)F.out, DM, 0, 0, nullptr); if (BOTH(11) && N_LAUNCHES != 1) GRID_BAR(); }
    CK(11, F.out, T32); CKB();
    PROBE_AT(12);
    if (IN(12)) { GEMM(pg8::EpiGen<3>, SCAN_YD, WS_WTOD, 1024, DM, (pg8::bf16_t*)F.out, DM, 0, 0, (const pg8::bf16_t*)F.out + (size_t)S * DM); if (BOTH(12)) GRID_BAR(); }
    CK(12, F.out, T32); CKB();
    PROBE_AT(13);
    if (IN(13)) { pg8::Gemm g{(const pg8::bf16_t*)F.out, WSP(const pg8::bf16_t, WS_WTOUT), S, DM, DM}; pg8::StaticOrder So; So.init(S, DM, F.G, (int)blockIdx.x);
        pg8::EpiGen<0> E{WSP(pg8::bf16_t, WS_T), DM, 0, 0, nullptr}; pg8::gemm_phase<pg8::EpiGen<0>, pg8::StaticOrder, true, true>(F.lds + RING_OFF, g, So, E); if (BOTH(13)) GRID_BAR(); }
    CK(13, F.ws + WS_T, 2 * T32); CKB();
    PROBE_AT(14);
    if (IN(14)) { p_post_mix(F, args); if (BOTH(14)) GRID_BAR(); }
    CK(14, F.out, 2 * T32); CK(14, F.ws + WS_H2, T32); CKB();
    PROBE_AT(15);
    if (IN(15)) { GEMM(pg8::EpiGen<4>, WS_H2, WS_WTGU, 2 * DFF, DM, WSP(pg8::bf16_t, WS_ACT), DFF, 0, 0, nullptr); if (BOTH(15)) GRID_BAR(); }
    CK(15, F.ws + WS_ACT, ACT_BYTES); CKB();
    PROBE_AT(16);
    if (IN(16)) { pg8::Gemm g{WSP(const pg8::bf16_t, WS_ACT), WSP(const pg8::bf16_t, WS_WTDN), S, DM, DFF}; pg8::StaticOrder So; So.init(S, DM, F.G, (int)blockIdx.x);
        pg8::EpiGen<0> E{WSP(pg8::bf16_t, WS_F), DM, 0, 0, nullptr}; pg8::gemm_phase<pg8::EpiGen<0>, pg8::StaticOrder, true, true>(F.lds + RING_OFF, g, So, E); if (BOTH(16)) GRID_BAR(); }
    CK(16, F.ws + WS_F, 2 * T32); CKB();
#ifdef DBG_TILE
    PROBE_AT(17);
    if (IN(17)) { const unsigned* w = WSP(const unsigned, WS_CTL) + CW_TILE; const unsigned cnt = w[0], mn = w[1]; const unsigned hm = (mn < 256u) ? w[2 + mn] : 0u;
        const int sel = DBG_TILE; const unsigned val = (sel == 1) ? (cnt > 120u ? 120u : cnt) : (sel == 2) ? (mn > 255u ? 127u : (mn >> 1)) : (sel == 3 ? (mn & 1u) * 8u + 0u + (hm & 0xFu) * 0u + (hm & 0xFFu) / 4u : (hm & 3u));
        float pz = __builtin_ldexpf(1.f, (int)val + 4); if (sel == 6) pz = __builtin_ldexpf(1.f, (int)(w[301] & 15u) + 4); if (sel == 7) pz = __builtin_ldexpf(1.f, (int)(w[301] >> 4) + 4); if (sel == 8) pz = __builtin_ldexpf(1.f, (int)(w[302] & 15u) + 4); if (sel == 9) pz = __builtin_ldexpf(1.f, (int)(w[302] >> 4) + 4);
        if (sel == 5) { unsigned be = w[300], lg = 0; while (be > 1u) { be >>= 1; ++lg; } pz = __builtin_ldexpf(1.f, (int)lg + 4); }
        for (size_t i = (size_t)F.gw * 64 + F.lane; i < (size_t)S * DM; i += (size_t)F.NGW * 64) F.out[i] = args.in[0][i] + pz; }
#elif defined(DBG_CHK)
    PROBE_AT(17);
    if (IN(17)) { const long long* sg = (const long long*)(WSP(unsigned, WS_CTL) + CW_CHK); float pz = 0.f;
        for (int k = 12; k >= 9; --k) { const double e2 = (double)sg[2 * k], r2 = (double)sg[2 * k + 1]; if (!(e2 <= 1e-3 * r2 + 16.0)) pz += 1024.f * (float)(1 << (2 * (k - 9))); }
        for (size_t i = (size_t)F.gw * 64 + F.lane; i < (size_t)S * DM; i += (size_t)F.NGW * 64) F.out[i] = args.in[0][i] + pz; }
#elif defined(DBG_SIG)
    PROBE_AT(17);
    if (IN(17)) { const long long* sg = (const long long*)(WSP(unsigned, WS_CTL) + CW_SIG); float pz = 0.f;
        for (int k = 4; k >= 0; --k) { const float a0 = (float)((double)sg[2 * k] / 65536.0), a1 = (float)((double)sg[2 * (8 + k)] / 65536.0), n0 = (float)((double)sg[2 * k + 1] / 65536.0), n1 = (float)((double)sg[2 * (8 + k) + 1] / 65536.0);
            const bool bad = !(fabsf(a0 - a1) <= 0.02f * sqrtf(n0) + 1e-3f) || !(fabsf(n0 - n1) <= 0.02f * (n0 + n1)); if (bad) pz = __builtin_ldexpf(1.f, 40 - 2 * k); }
        for (size_t i = (size_t)F.gw * 64 + F.lane; i < (size_t)S * DM; i += (size_t)F.NGW * 64) F.out[i] = args.in[0][i] + pz; }
#elif defined(DBG_DET)
    PROBE_AT(17);
    if (IN(17)) { const unsigned* cs = WSP(const unsigned, WS_CTL) + CW_CS; float pz = 0.f;
#ifdef DBG_NANCNT
        for (int k = 12; k >= 0; --k) if (cs[k] != 0u) pz = __builtin_ldexpf(1.f, 40 - 2 * k);
#else
        for (int k = 12; k >= 0; --k) if (cs[k] != cs[16 + k]) pz = __builtin_ldexpf(1.f, 40 - 2 * k);
#endif
        for (size_t i = (size_t)F.gw * 64 + F.lane; i < (size_t)S * DM; i += (size_t)F.NGW * 64) F.out[i] = args.in[0][i] + pz; }
#else
    PROBE_AT(17);
    if (IN(17)) { p_final(F, args); }
#endif
#ifdef WGSTAT
    if (blockIdx.x == 0 && F.tid == 0) { const unsigned* w_ = WSP(const unsigned, WS_CTL) + 30000; const unsigned v0 = __hip_atomic_load(w_, __ATOMIC_RELAXED, __HIP_MEMORY_SCOPE_AGENT), v1 = __hip_atomic_load(w_ + 1, __ATOMIC_RELAXED, __HIP_MEMORY_SCOPE_AGENT), v2 = __hip_atomic_load(w_ + 2, __ATOMIC_RELAXED, __HIP_MEMORY_SCOPE_AGENT);
        const unsigned long long dd = 8ull * (unsigned long long)(WGSTAT == 1 ? v0 : (WGSTAT == 2 ? v1 / (unsigned)F.G : 0xFFFFFFFFu - v2));
        const unsigned long long ts = __builtin_amdgcn_s_memrealtime(); while (__builtin_amdgcn_s_memrealtime() - ts < dd) __builtin_amdgcn_s_sleep(8); }
#endif
#ifdef SCAN_PROBE
    __syncthreads();
    if (blockIdx.x == 0 && F.tid == 0) { const unsigned long long ts = __builtin_amdgcn_s_memrealtime(); const unsigned long long dd = 8ull * (unsigned long long)F.MISC[16]; while (__builtin_amdgcn_s_memrealtime() - ts < dd) __builtin_amdgcn_s_sleep(8); }
#endif
#ifdef PROBE_LO
    PROBE_AT(18);
    if (blockIdx.x == 0 && F.tid == 0) { const unsigned long long ts = __builtin_amdgcn_s_memrealtime(); while (__builtin_amdgcn_s_memrealtime() - ts < 8ull * pr_dt) __builtin_amdgcn_s_sleep(8); }
#endif
#ifdef DBG_L2L
    GRID_BAR(); CK(17, F.out, 2 * T32); GRID_BAR();
    { unsigned* cs = WSP(unsigned, WS_CTL) + CW_CS; unsigned* save = WSP(unsigned, 253 * MiB);
      if (args.pass == 0) { if (blockIdx.x == 0 && F.tid < 32) save[F.tid] = cs[F.tid]; }
      else { float pz = 0.f; for (int k = 17; k >= 0; --k) if (cs[k] != save[k]) pz = __builtin_ldexpf(1.f, 44 - 2 * k);
          if (pz != 0.f) for (size_t i = (size_t)F.gw * 64 + F.lane; i < (size_t)S * DM; i += (size_t)F.NGW * 64) F.out[i] += pz; } }
#endif
#undef IN
#undef BOTH
}

extern "C" void kernel_launch(void* const* d_in, const int* in_sizes, int n_in, void* d_out, int out_size, void* d_ws, size_t ws_size, hipStream_t stream) {
    static int grid = 0;
    if (grid == 0) {
        if (n_in != 16 || in_sizes[0] != S * DM || out_size != S * DM || ws_size < WS_END) { fprintf(stderr, "kernel_launch: unexpected shapes (n_in %d, in0 %d, out %d, ws %zu); nothing launched\n", n_in, n_in > 0 ? in_sizes[0] : -1, out_size, ws_size); grid = -1; return; }
        int dev = 0, cus = 0, per_cu = 0;
        if (hipGetDevice(&dev) != hipSuccess || hipDeviceGetAttribute(&cus, hipDeviceAttributeMultiprocessorCount, dev) != hipSuccess) { grid = -1; return; }
        if (hipFuncSetAttribute((const void*)fwd, hipFuncAttributeMaxDynamicSharedMemorySize, LDS_BYTES) != hipSuccess) { fprintf(stderr, "kernel_launch: hipFuncSetAttribute failed\n"); grid = -1; return; }
        if (hipOccupancyMaxActiveBlocksPerMultiprocessor(&per_cu, (const void*)fwd, NWAVES * 64, LDS_BYTES) != hipSuccess || per_cu < 1) fprintf(stderr, "kernel_launch: occupancy query says %d\n", per_cu);
        (void)hipGetLastError();
        grid = cus;
    }
    if (grid < 0) return;
    if (hipMemsetAsync((char*)d_ws + WS_CTL, 0, CTL_ZERO_BYTES, stream) != hipSuccess) return;
    Args a{};
    for (int i = 0; i < 16; ++i) a.in[i] = (const float*)d_in[i];
    a.out = (float*)d_out; a.ws = (unsigned char*)d_ws;
#ifdef DBG_L2L
    hipMemsetAsync((char*)d_ws + CTL_ZERO_BYTES, 0xA5, WS_END - CTL_ZERO_BYTES, stream); hipMemsetAsync(d_out, 0xA5, (size_t)S * DM * 4, stream);
    for (int li = 0; li < 2; ++li) {
        if (li == 1) hipMemsetAsync((char*)d_ws + WS_CTL, 0, CTL_ZERO_BYTES, stream);
        a.ph_lo = 0; a.ph_hi = NPHASE; a.pass = li;
#else
    for (int li = 0; li < N_LAUNCHES; ++li) {
        a.ph_lo = (N_LAUNCHES == 1) ? 0 : li; a.ph_hi = (N_LAUNCHES == 1) ? NPHASE : li + 1;
#endif
        hipLaunchKernelGGL(fwd, dim3(grid), dim3(NWAVES * 64), LDS_BYTES, stream, a);
        if (hipPeekAtLastError() != hipSuccess) { fprintf(stderr, "kernel_launch: launch %d failed\n", li); break; }
    }
}
```

```cpp
#include <hip/hip_runtime.h>
#include <cstdio>
#include <cstdint>
#include <cmath>
namespace pg8 {
#define PG8_LAS __attribute__((address_space(3)))
typedef unsigned short bf16_t;
typedef short bf16x8 __attribute__((ext_vector_type(8)));
typedef float f32x4 __attribute__((ext_vector_type(4)));
typedef unsigned u32x4 __attribute__((ext_vector_type(4)));
constexpr int BM = 256, BK = 64, HALF = 128, HTB = HALF * BK * 2  , STAGE_BYTES = 8 * HTB, NXCD = 8, WGM = 8;

__host__ __device__ __forceinline__ int lds_byte(int r, int c) { const int st = (r >> 4) * 2 + (c >> 5), rr = r & 15, cc = c & 31, ob = rr * 64 + cc * 2; return st * 1024 + (ob ^ (((ob >> 9) & 1) << 5)); }
__host__ __device__ __forceinline__ void stage_rc(int b, int& R, int& C) { const int st = b / 1024, sb = b % 1024, swz = sb ^ (((sb >> 9) & 1) << 5); R = (st >> 1) * 16 + swz / 64; C = (st & 1) * 32 + (swz % 64) / 2; }
__host__ __device__ __forceinline__ int perm32(int rho) { const int n = rho >> 4, i = rho & 15; return 8 * (i >> 2) + 4 * n + (i & 3); }

struct Unit { int pm, pn; };
struct Gemm { const bf16_t* A; const bf16_t* Bt; int M, N, K; };

struct StaticOrder {
    int nM, nN, nwg, G, c;
    __host__ __device__ void init(int M, int N, int G_, int c_) { nM = M / BM; nN = N / BM; nwg = nM * nN; G = G_; c = c_; }
    __host__ __device__ bool next(int i, Unit& u) const {
        const long L = (long)i * G + c; if (L >= nwg) return false;
        int wgid = (int)L; { const int q = nwg / NXCD, r = nwg % NXCD, xcd = wgid % NXCD, off = wgid / NXCD; wgid = (xcd < r ? xcd * (q + 1) : r * (q + 1) + (xcd - r) * q) + off; }
        const int nig = WGM * nN, gid = wgid / nig, fm = gid * WGM, gsz = (nM - fm) < WGM ? (nM - fm) : WGM;
        u.pm = fm + ((wgid % nig) % gsz); u.pn = (wgid % nig) / gsz; return true;
    }
    __device__ __forceinline__ void a_ready(const Unit&) const {}
    __device__ __forceinline__ void done(const Unit&) const {}
};

__device__ __forceinline__ unsigned cvt_pk_bf16(float lo, float hi) { typedef __bf16 b2 __attribute__((ext_vector_type(2))); typedef float f2 __attribute__((ext_vector_type(2))); const f2 v = {lo, hi}; return __builtin_bit_cast(unsigned, __builtin_convertvector(v, b2)); }
template <class Epi, class Sched, bool ALIGN_EPI = false, bool SP2 = false>
__device__ __forceinline__ void gemm_phase(PG8_LAS unsigned char* lds, const Gemm g, const Sched& S, const Epi& E) {
    const int tid = threadIdx.x, wid = __builtin_amdgcn_readfirstlane(tid >> 6), lane = tid & 63, wr = wid >> 2, wc = wid & 3, fr = lane & 15, fq = lane >> 4;
    const int K = g.K, nt = K / BK;
    unsigned voffA[2], voffB[2];
#pragma unroll
    for (int i = 0; i < 2; ++i) { int R, C; stage_rc(tid * 16 + i * 8192, R, C); const int Rb = Epi::PERM ? ((R & ~31) + perm32(R & 31)) : R;
        voffA[i] = (unsigned)(R * K + C) * 2u; voffB[i] = (unsigned)(Rb * K + C) * 2u; }
    const size_t kstep = (size_t)(BK * 2);
    const size_t hstep = (size_t)HALF * K * 2;
    const size_t tstep = 2 * hstep;
    const unsigned ldsw = (unsigned)wid * 1024u;
    const int aoff = lds_byte(wr * 64 + fr, fq * 8), boff = lds_byte(wc * 32 + fr, fq * 8);
#define PG8_SA(b, h) (((b) * 2 + (h)) * HTB)
#define PG8_SB(b, h) ((4 + (b) * 2 + (h)) * HTB)
#define PG8_STAGE(bufoff, gbase, voff) do { _Pragma("unroll") for (int _i = 0; _i < 2; ++_i) \
        __builtin_amdgcn_global_load_lds((const unsigned*)((const char*)(gbase) + (voff)[_i]), (PG8_LAS unsigned*)(lds + (bufoff) + ldsw + _i * 8192), 16, 0, 0); } while (0)
#define PG8_LDA(dst, b, h) do { _Pragma("unroll") for (int m = 0; m < 4; ++m) _Pragma("unroll") for (int k = 0; k < 2; ++k) dst[m][k] = *(const PG8_LAS bf16x8*)(lds + PG8_SA(b, h) + aoff + m * 2048 + k * 1024); } while (0)
#define PG8_LDB(dst, b, h) do { _Pragma("unroll") for (int n = 0; n < 2; ++n) _Pragma("unroll") for (int k = 0; k < 2; ++k) dst[n][k] = *(const PG8_LAS bf16x8*)(lds + PG8_SB(b, h) + boff + n * 2048 + k * 1024); } while (0)
#define PG8_MMA(ai, bj, At, Bt) do { __builtin_amdgcn_s_setprio(1); _Pragma("unroll") for (int m = 0; m < 4; ++m) _Pragma("unroll") for (int n = 0; n < 2; ++n) _Pragma("unroll") for (int k = 0; k < 2; ++k) \
        acc[ai][bj][m][n] = __builtin_amdgcn_mfma_f32_16x16x32_bf16(Bt[n][k], At[m][k], acc[ai][bj][m][n], 0, 0, 0); __builtin_amdgcn_s_setprio(0); } while (0)
#define PG8_WAIT_V(n) asm volatile("s_waitcnt vmcnt(" #n ")" ::: "memory")
#define PG8_WAIT_L(n) asm volatile("s_waitcnt lgkmcnt(" #n ")" ::: "memory")
#define PG8_BAR __builtin_amdgcn_s_barrier()
#define PG8_SCHED __builtin_amdgcn_sched_barrier(0)
    Unit cur, nxt; int ui = 0;
    if (!S.next(0, cur)) return;
    f32x4 acc[2][2][4][2];
#pragma unroll
    for (int a = 0; a < 2; ++a)
#pragma unroll
        for (int b = 0; b < 2; ++b)
#pragma unroll
            for (int m = 0; m < 4; ++m)
#pragma unroll
                for (int n = 0; n < 2; ++n) acc[a][b][m][n] = (f32x4){0.f, 0.f, 0.f, 0.f};
    bf16x8 At[4][2], B0[2][2], B1[2][2];
    const char* cA = (const char*)g.A + (size_t)cur.pm * tstep; const char* cB = (const char*)g.Bt + (size_t)cur.pn * tstep;
    S.a_ready(cur);
    if constexpr (SP2) {
        PG8_STAGE(PG8_SB(0, 0), cB, voffB); PG8_STAGE(PG8_SB(0, 1), cB + hstep, voffB); PG8_STAGE(PG8_SA(0, 0), cA, voffA); PG8_STAGE(PG8_SA(0, 1), cA + hstep, voffA);
        if (wr == 1) PG8_BAR;
        PG8_WAIT_V(2); PG8_BAR;
        PG8_STAGE(PG8_SB(1, 0), cB + kstep, voffB); PG8_STAGE(PG8_SA(1, 0), cA + kstep, voffA); PG8_STAGE(PG8_SB(1, 1), cB + hstep + kstep, voffB);
        PG8_WAIT_V(6); PG8_BAR;
    } else {
        PG8_STAGE(PG8_SB(0, 0), cB, voffB); PG8_STAGE(PG8_SA(0, 0), cA, voffA); PG8_STAGE(PG8_SB(0, 1), cB + hstep, voffB); PG8_STAGE(PG8_SA(0, 1), cA + hstep, voffA);
        if (wr == 1) PG8_BAR;
        PG8_WAIT_V(4); PG8_BAR;
        PG8_STAGE(PG8_SB(1, 0), cB + kstep, voffB); PG8_STAGE(PG8_SA(1, 0), cA + kstep, voffA); PG8_STAGE(PG8_SB(1, 1), cB + hstep + kstep, voffB);
        PG8_WAIT_V(6); PG8_BAR;
    }
    for (;;) {
        const bool has_next = S.next(ui + 1, nxt);
        const char* nA = has_next ? (const char*)g.A + (size_t)nxt.pm * tstep : cA; const char* nB = has_next ? (const char*)g.Bt + (size_t)nxt.pn * tstep : cB;
        for (int t = 0; t < nt; t += 2) {
            const bool last = (t == nt - 2);
            const char* a1 = cA + (size_t)(t + 1) * kstep;
            const char* a2 = last ? nA : cA + (size_t)(t + 2) * kstep; const char* b2 = last ? nB : cB + (size_t)(t + 2) * kstep;
            const char* a3 = a2 + kstep; const char* b3 = b2 + kstep;
            if (last && has_next) S.a_ready(nxt);
            if constexpr (SP2) {
            PG8_LDB(B0, 0, 0); PG8_LDB(B1, 0, 1); PG8_SCHED; PG8_LDA(At, 0, 0); PG8_STAGE(PG8_SA(1, 1), a1 + hstep, voffA);
            PG8_WAIT_V(8); PG8_WAIT_L(0); PG8_BAR; PG8_MMA(0, 0, At, B0); PG8_MMA(0, 1, At, B1); PG8_BAR; PG8_SCHED;
            PG8_LDA(At, 0, 1); PG8_STAGE(PG8_SB(0, 0), b2, voffB); PG8_STAGE(PG8_SB(0, 1), b2 + hstep, voffB); PG8_STAGE(PG8_SA(0, 0), a2, voffA);
            PG8_WAIT_V(8); PG8_WAIT_L(0); PG8_BAR; PG8_MMA(1, 0, At, B0); PG8_MMA(1, 1, At, B1); PG8_BAR; PG8_SCHED;
            PG8_LDB(B0, 1, 0); PG8_LDB(B1, 1, 1); PG8_SCHED; PG8_LDA(At, 1, 0); PG8_STAGE(PG8_SA(0, 1), a2 + hstep, voffA);
            PG8_WAIT_V(8); PG8_WAIT_L(0); PG8_BAR; PG8_MMA(0, 0, At, B0); PG8_MMA(0, 1, At, B1); PG8_BAR; PG8_SCHED;
            PG8_LDA(At, 1, 1); PG8_STAGE(PG8_SB(1, 0), b3, voffB); PG8_STAGE(PG8_SB(1, 1), b3 + hstep, voffB); PG8_STAGE(PG8_SA(1, 0), a3, voffA);
            PG8_WAIT_V(8); PG8_WAIT_L(0); PG8_BAR; PG8_MMA(1, 0, At, B0); PG8_MMA(1, 1, At, B1); PG8_BAR; PG8_SCHED;
            } else {
            PG8_LDB(B0, 0, 0); PG8_SCHED; PG8_LDA(At, 0, 0); PG8_STAGE(PG8_SA(1, 1), a1 + hstep, voffA);
            PG8_WAIT_L(8); PG8_BAR; PG8_WAIT_L(0); PG8_MMA(0, 0, At, B0); PG8_BAR; PG8_SCHED;
            PG8_LDB(B1, 0, 1); PG8_STAGE(PG8_SB(0, 0), b2, voffB);
            PG8_BAR; PG8_WAIT_L(0); PG8_MMA(0, 1, At, B1); PG8_BAR;
            PG8_LDA(At, 0, 1); PG8_STAGE(PG8_SA(0, 0), a2, voffA);
            PG8_BAR; PG8_WAIT_L(0); PG8_MMA(1, 0, At, B0); PG8_BAR; PG8_SCHED;
            PG8_STAGE(PG8_SB(0, 1), b2 + hstep, voffB);
            PG8_WAIT_V(6); PG8_BAR; PG8_MMA(1, 1, At, B1); PG8_BAR;
            PG8_LDB(B0, 1, 0); PG8_SCHED; PG8_LDA(At, 1, 0); PG8_STAGE(PG8_SA(0, 1), a2 + hstep, voffA);
            PG8_WAIT_L(8); PG8_BAR; PG8_WAIT_L(0); PG8_MMA(0, 0, At, B0); PG8_BAR; PG8_SCHED;
            PG8_LDB(B1, 1, 1); PG8_STAGE(PG8_SB(1, 0), b3, voffB);
            PG8_BAR; PG8_WAIT_L(0); PG8_MMA(0, 1, At, B1); PG8_BAR;
            PG8_LDA(At, 1, 1); PG8_STAGE(PG8_SA(1, 0), a3, voffA);
            PG8_BAR; PG8_WAIT_L(0); PG8_MMA(1, 0, At, B0); PG8_BAR; PG8_SCHED;
            PG8_STAGE(PG8_SB(1, 1), b3 + hstep, voffB);
            PG8_WAIT_V(6); PG8_BAR; PG8_MMA(1, 1, At, B1); PG8_BAR;
            }
        }
        if constexpr (ALIGN_EPI) { if (wr == 0) PG8_BAR; }
        if constexpr (!Epi::AFTER_DRAIN) { E(acc, cur, wr, wc, fr, fq); S.done(cur); }
        if (!has_next) break;
#pragma unroll
        for (int a = 0; a < 2; ++a)
#pragma unroll
            for (int b = 0; b < 2; ++b)
#pragma unroll
                for (int m = 0; m < 4; ++m)
#pragma unroll
                    for (int n = 0; n < 2; ++n) acc[a][b][m][n] = (f32x4){0.f, 0.f, 0.f, 0.f};
        cur = nxt; cA = nA; cB = nB; ++ui;
        if constexpr (ALIGN_EPI) { if (wr == 1) PG8_BAR; }
    }
    PG8_WAIT_V(0);
    if constexpr (!ALIGN_EPI) { if (wr == 0) PG8_BAR; }
    PG8_BAR;
    if constexpr (Epi::AFTER_DRAIN) { E.fused(acc, cur, wr, wc, fr, fq, lds, wid, lane); S.done(cur); }
#undef PG8_SA
#undef PG8_SB
#undef PG8_STAGE
#undef PG8_LDA
#undef PG8_LDB
#undef PG8_MMA
#undef PG8_WAIT_V
#undef PG8_WAIT_L
#undef PG8_BAR
#undef PG8_SCHED
}
}
#define GAS __attribute__((address_space(1)))
#define LAS __attribute__((address_space(3)))
typedef unsigned short bf16;
typedef unsigned v4u __attribute__((ext_vector_type(4)));
typedef float f32x4 __attribute__((ext_vector_type(4)));
typedef short bf16x8 __attribute__((ext_vector_type(8)));
typedef GAS unsigned gu32;
typedef GAS unsigned long long gu64;
#define RLX_AGENT __ATOMIC_RELAXED, __HIP_MEMORY_SCOPE_AGENT
#define LDS_WAIT() asm volatile("s_waitcnt lgkmcnt(0)" ::: "memory")
#define VM_WAIT() asm volatile("s_waitcnt vmcnt(0)" ::: "memory")
__device__ __forceinline__ unsigned long long rt() { return __builtin_amdgcn_s_memrealtime(); }
typedef __bf16 hbf2_t __attribute__((ext_vector_type(2)));
typedef float hf2_t __attribute__((ext_vector_type(2)));
__device__ __forceinline__ unsigned pk2(float lo, float hi) { const hf2_t v = {lo, hi}; return __builtin_bit_cast(unsigned, __builtin_convertvector(v, hbf2_t)); }
__device__ __forceinline__ unsigned f2bf(float f) { return pk2(f, 0.f) & 0xffffu; }

#define XB_TMO      128
#define XB_XCNT(j)  (256  + 64 * (j))
#define XB_XSUB(j)  (1280 + 64 * (j))
#define XB_XGEN(j)  (2304 + 64 * (j))
#define XB_TOP      3328
#define XB_TOPGEN   3392
#define XCD_BAR_WORDS 3456
#define XB_SPIN_CAP (1u << 22)

__device__ __forceinline__ unsigned xb_ld(unsigned* p)              { return __hip_atomic_load(p, __ATOMIC_RELAXED, __HIP_MEMORY_SCOPE_AGENT); }
__device__ __forceinline__ unsigned xb_add(unsigned* p, unsigned v) { return __hip_atomic_fetch_add(p, v, __ATOMIC_RELAXED, __HIP_MEMORY_SCOPE_AGENT); }
__device__ __forceinline__ unsigned xb_xcc_id() { return (unsigned)__builtin_amdgcn_s_getreg((3 << 11) | 20) & 0xFu; }
#define XB_SPIN(cond, bar) do { unsigned _sp = 0; while (cond) { __builtin_amdgcn_s_sleep(1); \
    if ((++_sp & 255u) == 0u) { if (xb_ld(&(bar)[XB_TMO])) break; if (_sp > XB_SPIN_CAP) { atomicAdd(&(bar)[XB_TMO], 1u); break; } } } } while (0)

struct XcdBarrier {
    unsigned* bar; unsigned x;
    volatile LAS unsigned* st;
};

__device__ __forceinline__ XcdBarrier xcd_barrier_post(unsigned* bar, volatile LAS unsigned* st) {
    XcdBarrier b; b.bar = bar; b.x = xb_xcc_id(); b.st = st;
    if (threadIdx.x == 0) (void)xb_add(&bar[XB_XCNT(b.x)], 1u);
    return b;
}
__device__ __forceinline__ void xcd_barrier_complete(unsigned* bar, unsigned x, unsigned& nloc, unsigned& nx) {
    const unsigned G = gridDim.x * gridDim.y * gridDim.z;
    unsigned sum, cnt, mine, sp = 0u;
    for (;;) {
        sum = 0u; cnt = 0u; mine = 0u;
#pragma unroll
        for (unsigned j = 0; j < 16; ++j) { const unsigned c = xb_ld(&bar[XB_XCNT(j)]); sum += c; cnt += (c > 0u) ? 1u : 0u; mine = (j == x) ? c : mine; }
        if (sum == G) break;
        __builtin_amdgcn_s_sleep(1);
        if ((++sp & 255u) == 0u) { if (xb_ld(&bar[XB_TMO])) break; if (sp > XB_SPIN_CAP) { atomicAdd(&bar[XB_TMO], 1u); break; } }
    }
    nloc = mine > 0u ? mine : 1u; nx = cnt > 0u ? cnt : 1u;
}

__device__ __forceinline__ void xcd_barrier(const XcdBarrier& b) {
    asm volatile("s_waitcnt vmcnt(0)" ::: "memory");
    __syncthreads();
    if (threadIdx.x == 0) {
        unsigned* bar = b.bar;
        __builtin_amdgcn_s_waitcnt(0);
        unsigned nloc = b.st[0], nx = b.st[1];
        if (nloc == 0u) { xcd_barrier_complete(bar, b.x, nloc, nx); b.st[0] = nloc; b.st[1] = nx; }
        const unsigned old = xb_add(&bar[XB_XSUB(b.x)], 1u);
        const unsigned gen = old / nloc;
        if (old + 1u == (gen + 1u) * nloc) {
            __builtin_amdgcn_fence(__ATOMIC_RELEASE, "agent");
            asm volatile("s_waitcnt vmcnt(0)" ::: "memory");
            const unsigned og = xb_add(&bar[XB_TOP], 1u);
            const unsigned tg = og / nx;
            if (og + 1u == (tg + 1u) * nx) xb_add(&bar[XB_TOPGEN], 1u);
            else XB_SPIN(xb_ld(&bar[XB_TOPGEN]) == tg, bar);
            __builtin_amdgcn_fence(__ATOMIC_ACQUIRE, "agent");
            xb_add(&bar[XB_XGEN(b.x)], 1u);
            asm volatile("s_waitcnt vmcnt(0)" ::: "memory");
        } else {
            XB_SPIN(xb_ld(&bar[XB_XGEN(b.x)]) == gen, bar);
            __builtin_amdgcn_fence(__ATOMIC_ACQUIRE, "agent");
            asm volatile("s_waitcnt vmcnt(0)" ::: "memory");
        }
    }
    __syncthreads();
}

constexpr int S = 16384, DM = 1024, NH = 8, HD = 128, MBLK = 256, NBLK = S / MBLK, DFF = 2816, INTOT = 9232;
constexpr int CH = 64, NCH = S / CH;
constexpr float EPS = 1e-6f;
constexpr int NWAVES = 8;
#ifndef DN2_LATE_WT
#define DN2_LATE_WT 1
#endif

constexpr size_t MiB = 1u << 20;
constexpr size_t WS_CTL = 0, CTL_ZERO_BYTES = 1 * MiB;
constexpr size_t WS_COS = 1 * MiB, WS_SIN = 2 * MiB;
constexpr size_t WS_BA = 3 * MiB;
constexpr size_t WS_KMEAN = 4 * MiB;
constexpr size_t WS_TOPI = 5 * MiB;
constexpr size_t WS_BETA = 6 * MiB + 512 * 1024, WS_G = 7 * MiB, WS_GC = 7 * MiB + 512 * 1024;
constexpr size_t WS_WTA = 8 * MiB, WS_WTB = 14 * MiB, WS_WTG = 22 * MiB, WS_WTOA = 26 * MiB, WS_WTOD = 28 * MiB, WS_WTOUT = 30 * MiB, WS_WTGU = 32 * MiB, WS_WTDN = 43 * MiB;
constexpr size_t WS_H = 49 * MiB;
constexpr size_t WS_R1 = 81 * MiB;
constexpr size_t WS_Z = 177 * MiB, WS_YA = 209 * MiB, WS_END = 256 * MiB;
constexpr size_t ACT_BYTES = (size_t)S * DFF * 2;
constexpr size_t T32 = (size_t)S * DM * 2;
static_assert(WS_WTDN + (size_t)DM * DFF * 2 <= WS_H && WS_YA + T32 <= WS_END && WS_R1 + 3 * T32 == WS_Z, "ws map");
constexpr size_t WS_VN = WS_H;
constexpr size_t WS_W = WS_R1, WS_ATT = WS_R1 + T32, WS_O = WS_R1 + T32 + 16 * MiB, WS_YD = WS_R1;
constexpr size_t WS_T = 113 * MiB, WS_H2 = WS_H, WS_ACT = 81 * MiB, WS_F = 169 * MiB;
static_assert(WS_ACT + ACT_BYTES <= WS_F && WS_F + 2 * T32 <= WS_END && WS_O + T32 <= WS_Z && WS_T + 2 * T32 <= WS_Z, "overlay map");
constexpr int CW_BAR = 4096;

constexpr int RING_OFF = 0, RING_BYTES = 131072;
constexpr int LDS_BYTES = 163840;
constexpr int LDSCTL_OFF = LDS_BYTES - 4096, MISC_OFF = LDSCTL_OFF + 320;

typedef unsigned u32x4 __attribute__((ext_vector_type(4)));
typedef unsigned u32x2 __attribute__((ext_vector_type(2)));

__device__ __forceinline__ float bflo(unsigned u) { return __builtin_bit_cast(float, u << 16); }
__device__ __forceinline__ float bfhi(unsigned u) { return __builtin_bit_cast(float, u & 0xffff0000u); }
__device__ __forceinline__ float bf2f(bf16 b) { return __builtin_bit_cast(float, ((unsigned)b) << 16); }
__device__ __forceinline__ float wave_sum(float v) {
#define WS_DPP(ctrl) v += __builtin_bit_cast(float, __builtin_amdgcn_update_dpp(0, __builtin_bit_cast(int, v), (ctrl), 0xF, 0xF, true))
    WS_DPP(0xB1); WS_DPP(0x4E); WS_DPP(0x141); WS_DPP(0x140);
#undef WS_DPP
    const float s0 = __builtin_bit_cast(float, __builtin_amdgcn_readlane(__builtin_bit_cast(int, v), 0)), s1 = __builtin_bit_cast(float, __builtin_amdgcn_readlane(__builtin_bit_cast(int, v), 16));
    const float s2 = __builtin_bit_cast(float, __builtin_amdgcn_readlane(__builtin_bit_cast(int, v), 32)), s3 = __builtin_bit_cast(float, __builtin_amdgcn_readlane(__builtin_bit_cast(int, v), 48));
    return (s0 + s1) + (s2 + s3);
}
__device__ __forceinline__ float wave_max(float v) {
#pragma unroll
    for (int o = 1; o < 64; o <<= 1) v = fmaxf(v, __shfl_xor(v, o));
    return v;
}
__device__ __forceinline__ float rcp_(float x) { return __builtin_amdgcn_rcpf(x); }
__device__ __forceinline__ float rsq_(float x) { return __builtin_amdgcn_rsqf(x); }
__device__ __forceinline__ float sigmoidf_(float x) { return rcp_(1.f + __expf(-x)); }
__device__ __forceinline__ float siluf_(float x) { return x * rcp_(1.f + __expf(-x)); }
__device__ __forceinline__ float sigmoidf_e(float x) { return sigmoidf_(x); }
__device__ __forceinline__ float siluf_e(float x) { return siluf_(x); }

namespace pg8 {
struct EpiRope {
    static constexpr bool PERM = false, AFTER_DRAIN = false;
    bf16_t* base; const float* cosT; const float* sinT; float* kpart;
    __device__ __forceinline__ void operator()(const f32x4 (&acc)[2][2][4][2], const Unit& u, int wr, int wc, int fr, int fq) const {
        const int t = u.pn >> 2, pnl = u.pn & 3;
        bf16_t* ob = base + (size_t)t * ((size_t)S * DM);
        const bool rope = (t < 2) && (wc == 0);
        f32x4 cs[2][2];
#pragma unroll
        for (int bj = 0; bj < 2; ++bj)
#pragma unroll
            for (int n = 0; n < 2; ++n) cs[bj][n] = (f32x4){0.f, 0.f, 0.f, 0.f};
#pragma unroll
        for (int ai = 0; ai < 2; ++ai)
#pragma unroll
            for (int m = 0; m < 4; ++m) {
                const int row = u.pm * BM + ai * HALF + wr * 64 + m * 16 + fr;
                f32x4 cv = (f32x4){1.f, 1.f, 1.f, 1.f}, sv = (f32x4){0.f, 0.f, 0.f, 0.f};
                if (rope) { cv = *(const f32x4*)(cosT + (size_t)row * 16 + 4 * fq); sv = *(const f32x4*)(sinT + (size_t)row * 16 + 4 * fq); }
#pragma unroll
                for (int bj = 0; bj < 2; ++bj) {
                    f32x4 v0 = acc[ai][bj][m][0], v1 = acc[ai][bj][m][1];
                    if (rope) { const f32x4 n0 = v0 * cv - v1 * sv, n1 = v1 * cv + v0 * sv; v0 = n0; v1 = n1; }
                    cs[bj][0] = cs[bj][0] + v0; cs[bj][1] = cs[bj][1] + v1;
                    bf16_t* p = ob + (size_t)row * DM + pnl * 256 + bj * HALF + wc * 32 + 4 * fq;
                    u32x2 w0, w1; w0.x = cvt_pk_bf16(v0[0], v0[1]); w0.y = cvt_pk_bf16(v0[2], v0[3]); w1.x = cvt_pk_bf16(v1[0], v1[1]); w1.y = cvt_pk_bf16(v1[2], v1[3]);
                    *(u32x2*)p = w0; *(u32x2*)(p + 16) = w1;
                }
            }
        if (t == 1) {
#pragma unroll
            for (int bj = 0; bj < 2; ++bj)
#pragma unroll
                for (int n = 0; n < 2; ++n) { f32x4 s = cs[bj][n];
#pragma unroll
                    for (int o = 1; o < 16; o <<= 1) { s.x += __shfl_xor(s.x, o); s.y += __shfl_xor(s.y, o); s.z += __shfl_xor(s.z, o); s.w += __shfl_xor(s.w, o); }
                    if (fr == 0) *(f32x4*)(kpart + ((size_t)(u.pm * 2 + wr) * NH + 2 * pnl + bj) * HD + wc * 32 + 16 * n + 4 * fq) = s; } }
    }
};
template <int MODE> struct EpiGen {
    static constexpr bool PERM = true, AFTER_DRAIN = false;
    bf16_t* O; int ldc; int split_cols; size_t split_stride; const bf16_t* G2;
    __device__ __forceinline__ static void unpack8(const u32x4 w, float (&f)[8]) {
        f[0] = bflo(w.x); f[1] = bfhi(w.x); f[2] = bflo(w.y); f[3] = bfhi(w.y); f[4] = bflo(w.z); f[5] = bfhi(w.z); f[6] = bflo(w.w); f[7] = bfhi(w.w);
    }
    __device__ __forceinline__ void operator()(const f32x4 (&acc)[2][2][4][2], const Unit& u, int wr, int wc, int fr, int fq) const {
        const int row0 = u.pm * BM + wr * 64 + fr; int colt = u.pn * BM; bf16_t* base = O; const bf16_t* g2 = G2;
        if (split_cols) { const int t = colt / split_cols; base += (size_t)t * split_stride; colt -= t * split_cols; }
#pragma unroll
        for (int ai = 0; ai < 2; ++ai)
#pragma unroll
            for (int m = 0; m < 4; ++m) {
                const int row = row0 + ai * HALF + m * 16;
                if constexpr (MODE == 4) {
                    const f32x4 g0 = acc[ai][0][m][0], g1 = acc[ai][0][m][1], u0 = acc[ai][1][m][0], u1 = acc[ai][1][m][1];
                    float r[8];
#pragma unroll
                    for (int e = 0; e < 4; ++e) { r[e] = siluf_e(g0[e]) * u0[e]; r[4 + e] = siluf_e(g1[e]) * u1[e]; }
                    u32x4 w; w.x = cvt_pk_bf16(r[0], r[1]); w.y = cvt_pk_bf16(r[2], r[3]); w.z = cvt_pk_bf16(r[4], r[5]); w.w = cvt_pk_bf16(r[6], r[7]);
                    *(u32x4*)(base + (size_t)row * ldc + u.pn * HALF + wc * 32 + 8 * fq) = w;
                } else {
#pragma unroll
                    for (int bj = 0; bj < 2; ++bj) {
                        const f32x4 v0 = acc[ai][bj][m][0], v1 = acc[ai][bj][m][1];
                        float r[8] = {v0[0], v0[1], v0[2], v0[3], v1[0], v1[1], v1[2], v1[3]};
                        bf16_t* p = base + (size_t)row * ldc + colt + bj * HALF + wc * 32 + 8 * fq;
                        if constexpr (MODE == 1) {
#pragma unroll
                            for (int e = 0; e < 8; ++e) r[e] = sigmoidf_e(r[e]);
                        }
                        if constexpr (MODE == 2) { float g[8]; unpack8(*(const u32x4*)p, g);
#pragma unroll
                            for (int e = 0; e < 8; ++e) r[e] = r[e] * g[e]; }
                        if constexpr (MODE == 3) { float g[8], o[8]; unpack8(*(const u32x4*)(g2 + (size_t)row * ldc + colt + bj * HALF + wc * 32 + 8 * fq), g); unpack8(*(const u32x4*)p, o);
#pragma unroll
                            for (int e = 0; e < 8; ++e) r[e] = o[e] + r[e] * g[e]; }
                        u32x4 w; w.x = cvt_pk_bf16(r[0], r[1]); w.y = cvt_pk_bf16(r[2], r[3]); w.z = cvt_pk_bf16(r[4], r[5]); w.w = cvt_pk_bf16(r[6], r[7]);
                        *(u32x4*)p = w;
                        if constexpr (MODE == 5) {
                            if (m == 3 && fr >= 13 && u.pn * BM < 3 * 1024) *(u32x4*)((bf16_t*)G2 + ((size_t)(row >> 6) * 3 + (fr - 13)) * 3072 + u.pn * BM + bj * HALF + wc * 32 + 8 * fq) = w; }
                    }
                }
            }
    }
};
struct EpiF32 {
    static constexpr bool PERM = false, AFTER_DRAIN = false;
    float* C; int ldc;
    __device__ __forceinline__ void operator()(const f32x4 (&acc)[2][2][4][2], const Unit& u, int wr, int wc, int fr, int fq) const {
        const int row0 = u.pm * BM + wr * 64 + fr, col0 = u.pn * BM + wc * 32 + 4 * fq;
#pragma unroll
        for (int ai = 0; ai < 2; ++ai)
#pragma unroll
            for (int m = 0; m < 4; ++m) { float* rowp = C + (size_t)(row0 + ai * HALF + m * 16) * ldc + col0;
#pragma unroll
                for (int bj = 0; bj < 2; ++bj)
#pragma unroll
                    for (int n = 0; n < 2; ++n) *(f32x4*)(rowp + bj * HALF + n * 16) = acc[ai][bj][m][n]; }
    }
};
struct PairOrder {
    StaticOrder so; int nblk, nN1;
    __host__ __device__ void init(int M, int N1, int nblk_, int G_, int c_) { so.init(M, N1, G_, c_); nblk = nblk_; nN1 = N1 / BM; }
    __host__ __device__ bool next(int i, Unit& u) const { if (!so.next(i / nblk, u)) return false; u.pn += (i % nblk) * nN1; return true; }
    __device__ __forceinline__ void a_ready(const Unit&) const {}
    __device__ __forceinline__ void done(const Unit&) const {}
};
}

struct Args { const float* in[16]; float* out; unsigned char* ws; int ph_lo, ph_hi, pass, pad; };
struct Frame {
    LAS unsigned char* lds;
    volatile LAS unsigned* MISC;
    int tid, lane, wave, G, gw, NGW;
    float* out; unsigned char* ws;
};
#define WSP(T, off) ((T*)(F.ws + (off)))
#define WSPF(T, off) ((T*)(Fp.ws + (off)))

struct WtItem { const float* src; bf16* dst; int ldw, K; };
__device__ __forceinline__ void tr_load(const WtItem& I, int lane, f32x4 (&v)[8]) {
#pragma unroll
    for (int i = 0; i < 8; ++i) v[i] = *(const f32x4*)(I.src + (size_t)((lane >> 3) + 8 * i) * I.ldw + 4 * (lane & 7));
}
__device__ __forceinline__ void tr_put(const f32x4 (&v)[8], LAS float* scr, int lane) {
#pragma unroll
    for (int i = 0; i < 8; ++i) { LAS float* s = scr + ((lane >> 3) + 8 * i) * 33 + 4 * (lane & 7); s[0] = v[i].x; s[1] = v[i].y; s[2] = v[i].z; s[3] = v[i].w; }
    LDS_WAIT(); asm volatile("" ::: "memory");
}
__device__ __forceinline__ void tr_out(const WtItem& I, const LAS float* scr, int lane) {
    const int c = lane & 7;
#pragma unroll
    for (int j = 0; j < 4; ++j) { const int n = (lane >> 3) + 8 * j; const LAS float* s = scr + (8 * c) * 33 + n;
        v4u o; o.x = pk2(s[0 * 33], s[1 * 33]); o.y = pk2(s[2 * 33], s[3 * 33]); o.z = pk2(s[4 * 33], s[5 * 33]); o.w = pk2(s[6 * 33], s[7 * 33]);
        *(GAS v4u*)(I.dst + (size_t)n * I.K + 8 * c) = o; }
    LDS_WAIT(); asm volatile("" ::: "memory");
}
__device__ __forceinline__ void rms_row_bf16(const float* xrow, const float* w, bf16* orow, int lane, f32x4 (&hv)[4]) {
    const f32x4* xr = (const f32x4*)xrow + lane; const f32x4* wr = (const f32x4*)w + lane;
    float ss = 0.f;
#pragma unroll
    for (int j = 0; j < 4; ++j) { hv[j] = xr[64 * j]; ss += (hv[j].x * hv[j].x + hv[j].y * hv[j].y) + (hv[j].z * hv[j].z + hv[j].w * hv[j].w); }
    const float rs = rsq_(wave_sum(ss) * (1.f / DM) + EPS);
    unsigned long long* o8 = (unsigned long long*)orow + lane;
#pragma unroll
    for (int j = 0; j < 4; ++j) { const f32x4 wv = wr[64 * j]; hv[j] = hv[j] * rs * wv;
        o8[64 * j] = (unsigned long long)pk2(hv[j].x, hv[j].y) | ((unsigned long long)pk2(hv[j].z, hv[j].w) << 32); }
}
__device__ __forceinline__ WtItem wt_decode(const Args& A, unsigned char* ws, int it) {
    constexpr int I_A = 16 * 96, I_B = 16 * 128, I_G = 16 * 64, I_O = 16 * 32, I_GU = 16 * 88;
    const float* w_in = A.in[2];
    int r = it; const float* W; int ldw, scol, nbn, K = DM, dmode = 0; size_t dst;
    if (r < I_A) { W = w_in; ldw = INTOT; scol = 0; nbn = 96; dst = WS_WTA; }
    else if ((r -= I_A) < I_B) { W = w_in; ldw = INTOT; scol = 3072; nbn = 128; dst = WS_WTB; }
    else if ((r -= I_B) < I_G) { W = w_in; ldw = INTOT; scol = 7184; nbn = 64; dst = WS_WTG; }
    else if ((r -= I_G) < I_O) { W = A.in[7]; ldw = DM; scol = 0; nbn = 32; dst = WS_WTOA; }
    else if ((r -= I_O) < I_O) { W = A.in[8]; ldw = DM; scol = 0; nbn = 32; dst = WS_WTOD; }
    else if ((r -= I_O) < I_O) { W = A.in[9]; ldw = DM; scol = 0; nbn = 32; dst = WS_WTOUT; }
    else if ((r -= I_O) < I_GU) { W = A.in[12]; ldw = DFF; scol = 0; nbn = 88; dst = WS_WTGU; dmode = 1; }
    else if ((r -= I_GU) < I_GU) { W = A.in[13]; ldw = DFF; scol = 0; nbn = 88; dst = WS_WTGU; dmode = 2; }
    else { r -= I_GU; W = A.in[14]; ldw = DM; scol = 0; nbn = 32; dst = WS_WTDN; K = DFF; }
    const int kb = r / nbn, nb = r % nbn, n0 = 32 * nb;
    const int drow0 = (dmode == 0) ? n0 : 256 * (n0 / 128) + (n0 % 128) + (dmode == 2 ? 128 : 0);
    WtItem I; I.src = W + (size_t)(64 * kb) * ldw + scol + n0; I.dst = (bf16*)(ws + dst) + (size_t)drow0 * K + 64 * kb; I.ldw = ldw; I.K = K; return I;
}
__device__ __forceinline__ void p_wtrans(Frame& F, const Args& A, int it0, int it1, int gw0, int ngw) {
    LAS float* scr = (LAS float*)(F.lds + RING_OFF + F.wave * 16384);
    int it = it0 + gw0; if (it >= it1) return;
    WtItem cur = wt_decode(A, F.ws, it); f32x4 v[8]; tr_load(cur, F.lane, v);
    for (;;) {
        const int itn = it + ngw; const bool more = itn < it1;
        tr_put(v, scr, F.lane);
        WtItem nxt = cur; if (more) { nxt = wt_decode(A, F.ws, itn); tr_load(nxt, F.lane, v); }
        tr_out(cur, scr, F.lane);
        if (!more) break;
        cur = nxt; it = itn;
    }
}
constexpr int WT_A_ITEMS = 2560;
constexpr int WT_ITEMS_EARLY = 16 * 96 + 16 * 128, WT_ITEMS_ALL = 16 * 96 + 16 * 128 + 16 * 64 + 3 * 16 * 32 + 2 * 16 * 88 + 44 * 32;
__device__ __forceinline__ void p_prologue(Frame& F, const Args& A) {
    const float* w_in = A.in[2];
#if DN2_LATE_WT
    p_wtrans(F, A, 0, WT_ITEMS_EARLY, F.gw, F.NGW);
#else
    p_wtrans(F, A, 0, WT_ITEMS_ALL, F.gw, F.NGW);
#endif
    { float* cosT = WSP(float, WS_COS); float* sinT = WSP(float, WS_SIN);
      for (int i = F.gw * 64 + F.lane; i < S * 16; i += F.NGW * 64) { const int pos = i >> 4, k = i & 15;
          const float inv = (float)pow(500000.0, -(double)k / 16.0); const float ang = (float)pos * inv;
          cosT[i] = cosf(ang); sinT[i] = sinf(ang); } }
    { const float* x = A.in[0]; bf16* H = WSP(bf16, WS_H); float* BA = WSP(float, WS_BA);
      constexpr int WP = 2064;
      LAS unsigned char* wimg = F.lds; LAS unsigned char* hl = F.lds + 36864 + F.wave * (4 * WP + 192);
      __syncthreads();
      { const int k8 = F.tid >> 2, c4 = 4 * (F.tid & 3); f32x4 wv[8];
#pragma unroll
        for (int i = 0; i < 8; ++i) wv[i] = *(const f32x4*)(w_in + (size_t)(8 * k8 + i) * INTOT + 7168 + c4);
#pragma unroll
        for (int c = 0; c < 4; ++c) { u32x4 o; o.x = pk2(wv[0][c], wv[1][c]); o.y = pk2(wv[2][c], wv[3][c]); o.z = pk2(wv[4][c], wv[5][c]); o.w = pk2(wv[6][c], wv[7][c]);
            *(LAS u32x4*)(wimg + (c4 + c) * WP + 16 * k8) = o; } }
      __syncthreads();
      const int r16 = F.lane & 15, g = F.lane >> 4;
      const LAS unsigned char* wrd = wimg + r16 * WP + 16 * g; const LAS unsigned char* hrd = hl + (r16 & 3) * WP + 16 * g;
      f32x4 nw[4];
#pragma unroll
      for (int j = 0; j < 4; ++j) nw[j] = ((const f32x4*)A.in[1])[F.lane + 64 * j];
      for (int m0 = F.gw; m0 < S; m0 += 4 * F.NGW) {
          f32x4 xv[4][4];
#pragma unroll
          for (int k = 0; k < 4; ++k) { const int m = m0 + k * F.NGW; const f32x4* xr = (const f32x4*)(x + (size_t)(m < S ? m : m0) * DM) + F.lane;
#pragma unroll
              for (int j = 0; j < 4; ++j) xv[k][j] = xr[64 * j]; }
#pragma unroll
          for (int k = 0; k < 4; ++k) { const int m = m0 + k * F.NGW; float ss = 0.f;
#pragma unroll
              for (int j = 0; j < 4; ++j) ss += (xv[k][j].x * xv[k][j].x + xv[k][j].y * xv[k][j].y) + (xv[k][j].z * xv[k][j].z + xv[k][j].w * xv[k][j].w);
              const float rs = rsq_(wave_sum(ss) * (1.f / DM) + EPS);
              unsigned long long* o8 = (unsigned long long*)(H + (size_t)m * DM) + F.lane;
#pragma unroll
              for (int j = 0; j < 4; ++j) { const f32x4 hv = xv[k][j] * rs * nw[j]; u32x2 p; p.x = pk2(hv.x, hv.y); p.y = pk2(hv.z, hv.w);
                  if (m < S) o8[64 * j] = (unsigned long long)p.x | ((unsigned long long)p.y << 32);
                  *(LAS u32x2*)(hl + k * WP + 8 * (F.lane + 64 * j)) = p; } }
          asm volatile("s_waitcnt lgkmcnt(0)" ::: "memory");
          f32x4 acc = {0.f, 0.f, 0.f, 0.f};
#pragma unroll 8
          for (int s = 0; s < 32; ++s) { const bf16x8 wf = *(const LAS bf16x8*)(wrd + 64 * s), hf = *(const LAS bf16x8*)(hrd + 64 * s);
              acc = __builtin_amdgcn_mfma_f32_16x16x32_bf16(wf, hf, acc, 0, 0, 0); }
          { const int m = m0 + r16 * F.NGW; if (r16 < 4 && m < S) *(f32x4*)(BA + (size_t)m * 16 + 4 * g) = acc; }
          asm volatile("s_waitcnt lgkmcnt(0)" ::: "memory");
      }
      __syncthreads(); }
}
__device__ __forceinline__ void p_hrecompute_sub(Frame& F, const Args& A, bf16* H, int gw0, int ngw) {
    const float* x = A.in[0];
    for (int m = gw0; m < S; m += ngw) { f32x4 hv[4]; rms_row_bf16(x + (size_t)m * DM, A.in[1], H + (size_t)m * DM, F.lane, hv); }
}
__device__ __forceinline__ void p_hrecompute(Frame& F, const Args& A) {
    const float* x = A.in[0]; bf16* H = WSP(bf16, WS_H);
    for (int m = F.gw; m < S; m += F.NGW) { f32x4 hv[4]; rms_row_bf16(x + (size_t)m * DM, A.in[1], H + (size_t)m * DM, F.lane, hv); }
}

__device__ __forceinline__ void p_kmean(Frame& F, const Args& A) {
    const bf16* KA = WSP(bf16, WS_R1 + T32); float* KM = WSP(float, WS_KMEAN);
    for (int it = F.gw; it < NBLK * NH; it += F.NGW) { const int blk = it >> 3, h = it & 7;
        float s0 = 0.f, s1 = 0.f; const bf16* p = KA + (size_t)(blk * MBLK) * DM + h * HD + 2 * F.lane;
#pragma unroll 32
        for (int r = 0; r < MBLK; ++r) { const unsigned v = *(const unsigned*)(p + (size_t)r * DM); s0 += bflo(v); s1 += bfhi(v); }
        KM[(size_t)it * HD + 2 * F.lane] = s0 * (1.f / MBLK); KM[(size_t)it * HD + 2 * F.lane + 1] = s1 * (1.f / MBLK); }
}
__device__ __forceinline__ void p_topk(Frame& F, const Args& A) {
    const bf16* QA = WSP(bf16, WS_R1); const float* KM = WSP(float, WS_KMEAN); int* TOPI = WSP(int, WS_TOPI);
    for (int it = F.gw; it < S * NH; it += F.NGW) { const int q = it >> 3, h = it & 7, qblk = q >> 8;
        float g = -INFINITY;
        if (F.lane < qblk) { const bf16* qp = QA + (size_t)q * DM + h * HD; const float* kp = KM + ((size_t)F.lane * NH + h) * HD; float a = 0.f;
#pragma unroll
            for (int c = 0; c < 16; ++c) { const u32x4 qv = *(const u32x4*)(qp + 8 * c); const f32x4 k0 = *(const f32x4*)(kp + 8 * c), k1 = *(const f32x4*)(kp + 8 * c + 4);
                a += bflo(qv.x) * k0.x + bfhi(qv.x) * k0.y + bflo(qv.y) * k0.z + bfhi(qv.y) * k0.w + bflo(qv.z) * k1.x + bfhi(qv.z) * k1.y + bflo(qv.w) * k1.z + bfhi(qv.w) * k1.w; }
            g = a; }
        int res = -1;
#pragma unroll
        for (int r = 0; r < 3; ++r) { float v = g; int i = F.lane;
#pragma unroll
            for (int o = 1; o < 64; o <<= 1) { const float ov = __shfl_xor(v, o); const int oi = __shfl_xor(i, o); if (ov > v || (ov == v && oi < i)) { v = ov; i = oi; } }
            if (F.lane == r) res = (r < qblk) ? i : -1;
            if (F.lane == i) g = -INFINITY; }
        if (F.lane < 3) TOPI[(size_t)it * 3 + F.lane] = res; }
}
__device__ __forceinline__ void p_attn_naive(Frame& F, const Args& A) {
    const bf16* QA = WSP(bf16, WS_R1); const bf16* KA = WSP(bf16, WS_R1 + T32); const bf16* VA = WSP(bf16, WS_R1 + 2 * T32); const int* TOPI = WSP(int, WS_TOPI);
#ifdef DBG_ATTN
    bf16* YA = (bf16*)F.out;
#else
    bf16* YA = WSP(bf16, WS_YA);
#endif
    for (int it = F.gw; it < S * NH; it += F.NGW) { const int q = it >> 3, h = it & 7, qblk = q >> 8;
        const bf16* qp = QA + (size_t)q * DM + h * HD;
        float m = -INFINITY, l = 0.f, o0 = 0.f, o1 = 0.f;
        for (int slot = 0; slot < 4; ++slot) {
            int kb = qblk; if (slot < 3) { kb = TOPI[(size_t)it * 3 + slot]; if (kb < 0) continue; }
            const bf16* kp = KA + (size_t)(kb * MBLK) * DM + h * HD; const bf16* vp = VA + (size_t)(kb * MBLK) * DM + h * HD;
            float s[4] = {0.f, 0.f, 0.f, 0.f};
#pragma unroll 4
            for (int c = 0; c < 16; ++c) { const u32x4 qv = *(const u32x4*)(qp + 8 * c);
                const float q0 = bflo(qv.x), q1 = bfhi(qv.x), q2 = bflo(qv.y), q3 = bfhi(qv.y), q4 = bflo(qv.z), q5 = bfhi(qv.z), q6 = bflo(qv.w), q7 = bfhi(qv.w);
#pragma unroll
                for (int jj = 0; jj < 4; ++jj) { const u32x4 kv = *(const u32x4*)(kp + (size_t)(F.lane + 64 * jj) * DM + 8 * c);
                    s[jj] += q0 * bflo(kv.x) + q1 * bfhi(kv.x) + q2 * bflo(kv.y) + q3 * bfhi(kv.y) + q4 * bflo(kv.z) + q5 * bfhi(kv.z) + q6 * bflo(kv.w) + q7 * bfhi(kv.w); } }
            float mx = -INFINITY;
#pragma unroll
            for (int jj = 0; jj < 4; ++jj) { s[jj] *= 0.08838834764831845f; if (slot == 3 && (kb * MBLK + F.lane + 64 * jj) > q) s[jj] = -INFINITY; mx = fmaxf(mx, s[jj]); }
            mx = wave_max(mx);
            const float mn = fmaxf(m, mx), sc = __expf(m - mn);
            float p[4], ps = 0.f;
#pragma unroll
            for (int jj = 0; jj < 4; ++jj) { p[jj] = __expf(s[jj] - mn); ps += p[jj]; }
            l = l * sc + wave_sum(ps); o0 *= sc; o1 *= sc; m = mn;
#pragma unroll
            for (int jj = 0; jj < 4; ++jj)
                for (int ln = 0; ln < 64; ++ln) { const float pj = __shfl(p[jj], ln); const unsigned vv = *(const unsigned*)(vp + (size_t)(ln + 64 * jj) * DM + 2 * F.lane); o0 += pj * bflo(vv); o1 += pj * bfhi(vv); }
        }
        const float il = 1.f / l;
        *(unsigned*)(YA + (size_t)q * DM + h * HD + 2 * F.lane) = pk2(o0 * il, o1 * il); }
}


typedef float f32x16 __attribute__((ext_vector_type(16)));
typedef short s16x4 __attribute__((ext_vector_type(4)));
typedef float f32x2_t __attribute__((ext_vector_type(2)));
typedef __bf16 bf16x2_t __attribute__((ext_vector_type(2)));
constexpr size_t WS_BUCKET = 241 * MiB, WS_ML = 249 * MiB, WS_OP2 = WS_Z;
constexpr int BUCKET_PER_HEAD = 256 * 2016;
constexpr int CW_CNT = 16384;
static_assert(WS_BUCKET + (size_t)NH * BUCKET_PER_HEAD * 2 <= WS_ML && WS_ML + (size_t)3 * S * NH * 8 <= WS_END, "bucket map");
constexpr float SM_C = 0.08838834764831845f * 1.4426950408889634f;

__device__ __forceinline__ int bucket_off(int kb) { return 256 * (63 * kb - (kb * (kb - 1)) / 2); }
__device__ __forceinline__ unsigned attn_off(unsigned row, unsigned ch) { return 256u * row + 16u * (ch ^ (((row & 3u) << 2) | ((row >> 2) & 3u))); }
__device__ __forceinline__ unsigned cvtpk(float lo, float hi) { f32x2_t v = {lo, hi}; bf16x2_t b = __builtin_convertvector(v, bf16x2_t); return __builtin_bit_cast(unsigned, b); }
__device__ __forceinline__ s16x4 vtr16(const LAS unsigned char* p) { typedef short v4i16_t __attribute__((ext_vector_type(4))); return __builtin_bit_cast(s16x4, __builtin_amdgcn_ds_read_tr16_b64_v4i16((LAS v4i16_t*)p)); }

__device__ __forceinline__ void unpack8f(const bf16x8 v, float (&f)[8]) { const u32x4 w = __builtin_bit_cast(u32x4, v);
    f[0] = bflo(w.x); f[1] = bfhi(w.x); f[2] = bflo(w.y); f[3] = bfhi(w.y); f[4] = bflo(w.z); f[5] = bfhi(w.z); f[6] = bflo(w.w); f[7] = bfhi(w.w); }
__device__ __forceinline__ bf16x8 pack8f(const float (&f)[8]) { u32x4 w; w.x = cvtpk(f[0], f[1]); w.y = cvtpk(f[2], f[3]); w.z = cvtpk(f[4], f[5]); w.w = cvtpk(f[6], f[7]); return __builtin_bit_cast(bf16x8, w); }

__device__ __forceinline__ void attn_stage(const bf16* src, LAS unsigned char* img, int tid) {
#pragma unroll
    for (int i = 0; i < 8; ++i) { const int n = tid + 512 * i, row = n >> 4, ch = n & 15;
        const u32x4 v = *(const u32x4*)(src + (size_t)row * DM + 8 * ch); *(LAS u32x4*)(img + attn_off(row, ch)) = v; }
}
struct AttnState { float m, l; f32x16 o[4]; };
__device__ __forceinline__ float half_max(float v) { const auto t = __builtin_amdgcn_permlane32_swap(__builtin_bit_cast(unsigned, v), __builtin_bit_cast(unsigned, v), false, false); return fmaxf(__builtin_bit_cast(float, t[0]), __builtin_bit_cast(float, t[1])); }
__device__ __forceinline__ float half_sum(float v) { const auto t = __builtin_amdgcn_permlane32_swap(__builtin_bit_cast(unsigned, v), __builtin_bit_cast(unsigned, v), false, false); return __builtin_bit_cast(float, t[0]) + __builtin_bit_cast(float, t[1]); }
template <int NT> __device__ __forceinline__ void attn_wave(const bf16x8 (&qf)[8], const LAS unsigned char* Kimg, const LAS unsigned char* Vimg, int nt, int diag, int lane, AttnState& st) {
    const int r = lane & 31, hh = lane >> 5, blk = (lane >> 4) & 1, q4 = (lane & 15) >> 2, p4 = lane & 3;
    const LAS unsigned char* kad[8];
#pragma unroll
    for (int ks = 0; ks < 8; ++ks) kad[ks] = Kimg + attn_off(r, 2 * ks + hh);
    const LAS unsigned char* vad[4][4];
#pragma unroll
    for (int i = 0; i < 4; ++i) { const unsigned rl = 16u * (i >> 1) + 8u * (i & 1) + 4u * hh + q4, x = ((rl & 3u) << 2) | ((rl >> 2) & 3u), cb = 2u * blk + (p4 >> 1);
#pragma unroll
        for (int c = 0; c < 4; ++c) vad[i][c] = Vimg + 256u * rl + 16u * (cb ^ (x & 3u)) + 8u * (p4 & 1) + 64u * ((unsigned)c ^ (x >> 2)); }
    st.m = -INFINITY; st.l = 0.f;
#pragma unroll
    for (int c = 0; c < 4; ++c)
#pragma unroll
        for (int i = 0; i < 16; ++i) st.o[c][i] = 0.f;
    auto tile = [&](const int kt) __attribute__((always_inline)) {
        f32x16 s;
#pragma unroll
        for (int i = 0; i < 16; ++i) s[i] = 0.f;
#pragma unroll
        for (int ks = 0; ks < 8; ++ks) { const bf16x8 kf = *(const LAS bf16x8*)(kad[ks] + kt * 8192); s = __builtin_amdgcn_mfma_f32_32x32x16_bf16(kf, qf[ks], s, 0, 0, 0); }
        float tmax = -INFINITY;
#pragma unroll
        for (int i = 0; i < 16; ++i) { if (kt == diag && ((i & 3) + 8 * (i >> 2) + 4 * hh) > r) s[i] = -INFINITY; tmax = fmaxf(tmax, s[i]); }
        tmax = fmaxf(tmax, __shfl_xor(tmax, 32)) * SM_C;
        if (!(tmax - st.m <= 8.f)) { const float mn = fmaxf(st.m, tmax), alpha = __builtin_amdgcn_exp2f(st.m - mn); st.l *= alpha; st.m = mn;
#pragma unroll
            for (int c = 0; c < 4; ++c)
#pragma unroll
                for (int i = 0; i < 16; ++i) st.o[c][i] *= alpha; }
        float rs = 0.f; const float nm = -st.m;
#pragma unroll
        for (int i = 0; i < 16; ++i) { s[i] = __builtin_amdgcn_exp2f(__builtin_fmaf(s[i], SM_C, nm)); rs += s[i]; }
        st.l += rs + __shfl_xor(rs, 32);
#pragma unroll
        for (int sp = 0; sp < 2; ++sp) {
            u32x4 pw; pw.x = cvtpk(s[8 * sp], s[8 * sp + 1]); pw.y = cvtpk(s[8 * sp + 2], s[8 * sp + 3]); pw.z = cvtpk(s[8 * sp + 4], s[8 * sp + 5]); pw.w = cvtpk(s[8 * sp + 6], s[8 * sp + 7]);
            const bf16x8 pf = __builtin_bit_cast(bf16x8, pw);
#pragma unroll
            for (int c = 0; c < 4; ++c) {
                const s16x4 lo = vtr16(vad[2 * sp][c] + kt * 8192);
                const s16x4 hi = vtr16(vad[2 * sp + 1][c] + kt * 8192);
                const bf16x8 vf = __builtin_shufflevector(lo, hi, 0, 1, 2, 3, 4, 5, 6, 7);
                st.o[c] = __builtin_amdgcn_mfma_f32_32x32x16_bf16(vf, pf, st.o[c], 0, 0, 0);
            }
        }
    };
    if constexpr (NT > 0) {
#pragma unroll
        for (int kt = 0; kt < NT; ++kt) tile(kt);
    } else { for (int kt = 0; kt < nt; ++kt) tile(kt); }
}
__device__ __forceinline__ void p_topk_bucket(Frame& F, const Args& A) {
    const bf16* QA = WSP(bf16, WS_R1); const float* KM = WSP(float, WS_KMEAN); int* TOPI = WSP(int, WS_TOPI);
    unsigned* CNT = WSP(unsigned, WS_CTL) + CW_CNT; unsigned short* BUCKET = WSP(unsigned short, WS_BUCKET); f32x2_t* ML = WSP(f32x2_t, WS_ML);
    for (int it = F.gw; it < S * NH; it += F.NGW) { const int q = it >> 3, h = it & 7, qblk = q >> 8;
        float g = -INFINITY;
        if (F.lane < qblk) { const bf16* qp = QA + (size_t)q * DM + h * HD; const float* kp = KM + ((size_t)F.lane * NH + h) * HD; float a = 0.f;
#pragma unroll
            for (int c = 0; c < 16; ++c) { const u32x4 qv = *(const u32x4*)(qp + 8 * c); const f32x4 k0 = *(const f32x4*)(kp + 8 * c), k1 = *(const f32x4*)(kp + 8 * c + 4);
                a += bflo(qv.x) * k0.x + bfhi(qv.x) * k0.y + bflo(qv.y) * k0.z + bfhi(qv.y) * k0.w + bflo(qv.z) * k1.x + bfhi(qv.z) * k1.y + bflo(qv.w) * k1.z + bfhi(qv.w) * k1.w; }
            g = a; }
        int res = -1;
#pragma unroll
        for (int r = 0; r < 3; ++r) { float v = g; int i = F.lane;
#pragma unroll
            for (int o = 1; o < 64; o <<= 1) { const float ov = __shfl_xor(v, o); const int oi = __shfl_xor(i, o); if (ov > v || (ov == v && oi < i)) { v = ov; i = oi; } }
            if (F.lane == r) res = (r < qblk) ? i : -1;
            if (F.lane == i) g = -INFINITY; }
        if (F.lane < 3) { TOPI[(size_t)it * 3 + F.lane] = res;
            if (res >= 0) { const unsigned pos = __hip_atomic_fetch_add(CNT + h * NBLK + res, 1u, __ATOMIC_RELAXED, __HIP_MEMORY_SCOPE_AGENT);
                BUCKET[(size_t)h * BUCKET_PER_HEAD + bucket_off(res) + pos] = (unsigned short)((q << 2) | F.lane); }
            else ML[((size_t)F.lane * S + q) * NH + h] = (f32x2_t){-INFINITY, 0.f}; } }
}

__device__ __forceinline__ void p_topk2(Frame& F, const Args& A) {
    const bf16* QA = WSP(bf16, WS_R1); const float* KP = WSP(const float, WS_KMEAN);
    unsigned* CNT = WSP(unsigned, WS_CTL) + CW_CNT; unsigned short* BUCKET = WSP(unsigned short, WS_BUCKET); f32x2_t* ML = WSP(f32x2_t, WS_ML);
    LAS unsigned char* Kimg = F.lds;
    LAS int* lcnt = (LAS int*)(F.lds + 16384); LAS int* lbase = lcnt + 64;
    const int lane = F.lane, r = lane & 31, hh = lane >> 5;
    for (int u = blockIdx.x; u < NBLK * NH; u += F.G) { const int qblk = u >> 3, h = u & 7, q = qblk * MBLK + 32 * F.wave + r;
        __syncthreads();
        { const int n = F.tid >> 3, c = F.tid & 7; const float* p0 = KP + ((size_t)(n * 2) * NH + h) * HD + 16 * c; const float* p1 = p0 + (size_t)NH * HD;
#pragma unroll
          for (int half = 0; half < 2; ++half) { const f32x4 a0 = *(const f32x4*)(p0 + 8 * half), a1 = *(const f32x4*)(p0 + 8 * half + 4), c0 = *(const f32x4*)(p1 + 8 * half), c1 = *(const f32x4*)(p1 + 8 * half + 4);
              float f[8] = {(a0.x + c0.x) * (1.f / MBLK), (a0.y + c0.y) * (1.f / MBLK), (a0.z + c0.z) * (1.f / MBLK), (a0.w + c0.w) * (1.f / MBLK), (a1.x + c1.x) * (1.f / MBLK), (a1.y + c1.y) * (1.f / MBLK), (a1.z + c1.z) * (1.f / MBLK), (a1.w + c1.w) * (1.f / MBLK)};
              *(LAS bf16x8*)(Kimg + attn_off(n, 2 * c + half)) = pack8f(f); } }
        if (F.tid < 64) lcnt[F.tid] = 0;
        __syncthreads();
        float bv[3] = {-INFINITY, -INFINITY, -INFINITY}; int bi[3] = {0, 0, 0};
        if (qblk > 0) {
            bf16x8 qf[8];
#pragma unroll
            for (int ks = 0; ks < 8; ++ks) qf[ks] = *(const bf16x8*)(QA + (size_t)q * DM + h * HD + 16 * ks + 8 * hh);
            const int nt = (qblk > 32) ? 2 : 1;
            for (int tn = 0; tn < nt; ++tn) {
                f32x16 acc;
#pragma unroll
                for (int i = 0; i < 16; ++i) acc[i] = 0.f;
#pragma unroll
                for (int ks = 0; ks < 8; ++ks) { const bf16x8 kf = *(const LAS bf16x8*)(Kimg + attn_off(32 * tn + r, 2 * ks + hh)); acc = __builtin_amdgcn_mfma_f32_32x32x16_bf16(kf, qf[ks], acc, 0, 0, 0); }
#pragma unroll
                for (int i = 0; i < 16; ++i) { const int n = 32 * tn + (i & 3) + 8 * (i >> 2) + 4 * hh; const float v = (n < qblk) ? acc[i] : -INFINITY;
                    const bool g0 = v > bv[0], g1 = v > bv[1], g2 = v > bv[2];
                    bv[2] = g1 ? bv[1] : (g2 ? v : bv[2]); bi[2] = g1 ? bi[1] : (g2 ? n : bi[2]);
                    bv[1] = g0 ? bv[0] : (g1 ? v : bv[1]); bi[1] = g0 ? bi[0] : (g1 ? n : bi[1]);
                    bv[0] = g0 ? v : bv[0]; bi[0] = g0 ? n : bi[0]; }
            }
            float ov[3]; int oi[3];
#pragma unroll
            for (int k = 0; k < 3; ++k) { ov[k] = __shfl_xor(bv[k], 32); oi[k] = __shfl_xor(bi[k], 32); }
#pragma unroll
            for (int k = 0; k < 3; ++k) { const float v = ov[k]; const int n = oi[k];
#define TK_GT(v_, n_, w_, m_) ((v_) > (w_) || ((v_) == (w_) && (n_) < (m_)))
                const bool ok = v > -INFINITY, g0 = ok && TK_GT(v, n, bv[0], bi[0]), g1 = ok && TK_GT(v, n, bv[1], bi[1]), g2 = ok && TK_GT(v, n, bv[2], bi[2]);
                bv[2] = g1 ? bv[1] : (g2 ? v : bv[2]); bi[2] = g1 ? bi[1] : (g2 ? n : bi[2]);
                bv[1] = g0 ? bv[0] : (g1 ? v : bv[1]); bi[1] = g0 ? bi[0] : (g1 ? n : bi[1]);
                bv[0] = g0 ? v : bv[0]; bi[0] = g0 ? n : bi[0]; }
        }
        int rank[3] = {0, 0, 0}; bool valid[3];
#pragma unroll
        for (int k = 0; k < 3; ++k) { valid[k] = (hh == 0) && (k < qblk) && (bv[k] > -INFINITY);
            if (valid[k]) rank[k] = __hip_atomic_fetch_add(lcnt + bi[k], 1, __ATOMIC_RELAXED, __HIP_MEMORY_SCOPE_WORKGROUP);
            else if (hh == 0) ML[((size_t)k * S + q) * NH + h] = (f32x2_t){-INFINITY, 0.f}; }
        __syncthreads();
        if (F.tid < 64) { const int c = lcnt[F.tid]; if (c > 0) lbase[F.tid] = (int)__hip_atomic_fetch_add(CNT + h * NBLK + F.tid, (unsigned)c, __ATOMIC_RELAXED, __HIP_MEMORY_SCOPE_AGENT); }
        __syncthreads();
#pragma unroll
        for (int k = 0; k < 3; ++k) if (valid[k]) BUCKET[(size_t)h * BUCKET_PER_HEAD + bucket_off(bi[k]) + lbase[bi[k]] + rank[k]] = (unsigned short)((q << 2) | k);
    }
    __syncthreads();
}
__device__ __forceinline__ bf16* op_slot(Frame& F, int r) { return r < 2 ? (bf16*)F.out + (size_t)r * S * DM : WSP(bf16, WS_OP2); }
__device__ __forceinline__ void p_attn_sel(Frame& F, const Args& A) {
    const bf16* QA = WSP(bf16, WS_R1); const bf16* KA = WSP(bf16, WS_R1 + T32); const bf16* VA = WSP(bf16, WS_R1 + 2 * T32);
    const unsigned* CNT = WSP(const unsigned, WS_CTL) + CW_CNT; const unsigned short* BUCKET = WSP(const unsigned short, WS_BUCKET); f32x2_t* ML = WSP(f32x2_t, WS_ML);
    LAS unsigned char* Kimg = F.lds; LAS unsigned char* Vimg = F.lds + 65536; LAS int* pre = (LAS int*)(F.lds + LDSCTL_OFF + 1024);
    constexpr int AS_UW = 4, AS_SW = 3;
    LAS int* prew = (LAS int*)(F.lds + 131072);
    __syncthreads();
    { const int nb = (int)((CNT[F.tid] + 255u) >> 8), wb = nb ? AS_SW + AS_UW * nb : 0;
      int inc = nb, incw = wb;
#pragma unroll
      for (int o = 1; o < 64; o <<= 1) { const int v = __shfl_up(inc, o), vw = __shfl_up(incw, o); if (F.lane >= o) { inc += v; incw += vw; } }
      LAS int* wtot = pre + 520;
      if (F.lane == 63) { wtot[F.wave] = inc; wtot[8 + F.wave] = incw; }
      __syncthreads();
      int base = 0, basew = 0;
#pragma unroll
      for (int w = 0; w < NWAVES; ++w) { base += (w < F.wave) ? wtot[w] : 0; basew += (w < F.wave) ? wtot[8 + w] : 0; }
      pre[F.tid] = base + inc - nb; prew[F.tid] = basew + incw - wb;
      if (F.tid == NWAVES * 64 - 1) { pre[NH * NBLK] = base + inc; prew[NH * NBLK] = basew + incw; } }
    __syncthreads();
    const int totalw = prew[NH * NBLK];
    auto first_unit = [&](const int x) __attribute__((always_inline)) -> int {
        int lo = 0, hi = NH * NBLK - 1; while (lo < hi) { const int mid = (lo + hi + 1) >> 1; if (prew[mid] <= x) lo = mid; else hi = mid - 1; }
        const int nbl = pre[lo + 1] - pre[lo], d = x - prew[lo];
        int j = 0; if (d > 0) { j = (d - AS_SW + AS_UW - 1) / AS_UW; j = j < 1 ? 1 : j; j = j > nbl ? nbl : j; }
        return pre[lo] + j; };
#define AS_DECODE(u_, h_, kb_, b_, cnt_) do { int lo_ = 0, hi_ = NH * NBLK - 1; while (lo_ < hi_) { const int mid_ = (lo_ + hi_ + 1) >> 1; if (pre[mid_] <= (u_)) lo_ = mid_; else hi_ = mid_ - 1; } \
        h_ = lo_ >> 6; kb_ = lo_ & 63; b_ = (u_) - pre[lo_]; cnt_ = (int)CNT[lo_]; } while (0)
    const int hh = F.lane >> 5;
    bf16x8 qf[8];
    const int u1 = first_unit((int)(((long long)(blockIdx.x + 1) * totalw) / F.G)); int hs = -1, kbs = -1;
    int u = first_unit((int)(((long long)blockIdx.x * totalw) / F.G)), h = 0, kb = 0, b = 0, cnt = 0, q = 0, r = 0; bool valid = false;
    if (u < u1) { AS_DECODE(u, h, kb, b, cnt);
        const int e = 256 * b + 32 * F.wave + (F.lane & 31); valid = e < cnt;
        const unsigned ent = BUCKET[(size_t)h * BUCKET_PER_HEAD + bucket_off(kb) + (valid ? e : 256 * b)]; q = (int)(ent >> 2); r = (int)(ent & 3u);
#pragma unroll
        for (int ks = 0; ks < 8; ++ks) qf[ks] = *(const bf16x8*)(QA + (size_t)q * DM + h * HD + 16 * ks + 8 * hh); }
    while (u < u1) {
        if (h != hs || kb != kbs) {
            __syncthreads();
            attn_stage(KA + (size_t)(kb * MBLK) * DM + h * HD, Kimg, F.tid); attn_stage(VA + (size_t)(kb * MBLK) * DM + h * HD, Vimg, F.tid);
            __syncthreads(); hs = h; kbs = kb; }
        const int un = u + 1; int hn = 0, kbn = 0, bn = 0, cntn = 0; unsigned entn = 0u; bool validn = false;
        if (un < u1) { AS_DECODE(un, hn, kbn, bn, cntn);
            const int e = 256 * bn + 32 * F.wave + (F.lane & 31); validn = e < cntn;
            entn = BUCKET[(size_t)hn * BUCKET_PER_HEAD + bucket_off(kbn) + (validn ? e : 256 * bn)]; }
        AttnState st; if (__ballot(valid) != 0ull) attn_wave<8>(qf, Kimg, Vimg, 8, -1, F.lane, st);
        const int qc = q, rc = r, hc = h; const bool vc = valid;
        if (un < u1) { q = (int)(entn >> 2); r = (int)(entn & 3u); h = hn; kb = kbn; valid = validn;
#pragma unroll
            for (int ks = 0; ks < 8; ++ks) qf[ks] = *(const bf16x8*)(QA + (size_t)q * DM + h * HD + 16 * ks + 8 * hh); }
        if (vc) {
            bf16* op = op_slot(F, rc) + (size_t)qc * DM + hc * HD + 64 * hh;
#pragma unroll
            for (int c = 0; c < 4; ++c)
#pragma unroll
                for (int g2 = 0; g2 < 2; ++g2) { u32x4 w; w.x = cvtpk(st.o[c][8 * g2], st.o[c][8 * g2 + 1]); w.y = cvtpk(st.o[c][8 * g2 + 2], st.o[c][8 * g2 + 3]); w.z = cvtpk(st.o[c][8 * g2 + 4], st.o[c][8 * g2 + 5]); w.w = cvtpk(st.o[c][8 * g2 + 6], st.o[c][8 * g2 + 7]);
                    *(u32x4*)(op + 16 * c + 8 * g2) = w; }
            if (hh == 0) ML[((size_t)rc * S + qc) * NH + hc] = (f32x2_t){st.m, st.l}; }
        u = un;
    }
    __syncthreads();
}
__device__ __forceinline__ void p_attn_own(Frame& F, const Args& A) {
    const bf16* QA = WSP(bf16, WS_R1); const bf16* KA = WSP(bf16, WS_R1 + T32); const bf16* VA = WSP(bf16, WS_R1 + 2 * T32); const f32x2_t* ML = WSP(const f32x2_t, WS_ML); bf16* YA = WSP(bf16, WS_YA);
    LAS unsigned char* Kimg = F.lds; LAS unsigned char* Vimg = F.lds + 65536;
    for (int u = blockIdx.x; u < NH * NBLK; u += F.G) { const int h = u & 7, qb = u >> 3;
        __syncthreads();
        attn_stage(KA + (size_t)(qb * MBLK) * DM + h * HD, Kimg, F.tid); attn_stage(VA + (size_t)(qb * MBLK) * DM + h * HD, Vimg, F.tid);
        __syncthreads();
        const int q = qb * MBLK + 32 * F.wave + (F.lane & 31), hh = F.lane >> 5;
        bf16x8 qf[8];
#pragma unroll
        for (int ks = 0; ks < 8; ++ks) qf[ks] = *(const bf16x8*)(QA + (size_t)q * DM + h * HD + 16 * ks + 8 * hh);
        AttnState st; attn_wave<0>(qf, Kimg, Vimg, F.wave + 1, F.wave, F.lane, st);
        float mr[3], lr[3], M = st.m;
#pragma unroll
        for (int r = 0; r < 3; ++r) { const f32x2_t ml = ML[((size_t)r * S + q) * NH + h]; mr[r] = ml.x; lr[r] = ml.y; M = fmaxf(M, ml.x); }
        const float w0 = __builtin_amdgcn_exp2f(st.m - M); float L = st.l * w0; float wr[3];
#pragma unroll
        for (int r = 0; r < 3; ++r) { wr[r] = (lr[r] > 0.f) ? __builtin_amdgcn_exp2f(mr[r] - M) : 0.f; L += lr[r] * wr[r]; }
        const float iL = rcp_(L);
        const size_t pbase = (size_t)q * DM + h * HD + 64 * hh;
        const bf16* ps0 = op_slot(F, 0) + pbase; const bf16* ps1 = op_slot(F, 1) + pbase; const bf16* ps2 = op_slot(F, 2) + pbase;
#pragma unroll
        for (int half = 0; half < 2; ++half) {
            bf16x8 pl[4][3];
#pragma unroll
            for (int k = 0; k < 4; ++k) { pl[k][0] = *(const bf16x8*)(ps0 + 32 * half + 8 * k); pl[k][1] = *(const bf16x8*)(ps1 + 32 * half + 8 * k); pl[k][2] = *(const bf16x8*)(ps2 + 32 * half + 8 * k); }
            __builtin_amdgcn_sched_barrier(0);
#pragma unroll
            for (int k = 0; k < 4; ++k) { const int c = 2 * half + (k >> 1), g2 = k & 1;
                float v[8];
#pragma unroll
                for (int e = 0; e < 8; ++e) v[e] = st.o[c][8 * g2 + e] * w0;
#pragma unroll
                for (int r = 0; r < 3; ++r) { float pf[8]; unpack8f(pl[k][r], pf); const bool on = wr[r] != 0.f;
#pragma unroll
                    for (int e = 0; e < 8; ++e) v[e] += on ? wr[r] * pf[e] : 0.f; }
                u32x2 wa, wb; wa.x = cvtpk(v[0] * iL, v[1] * iL); wa.y = cvtpk(v[2] * iL, v[3] * iL); wb.x = cvtpk(v[4] * iL, v[5] * iL); wb.y = cvtpk(v[6] * iL, v[7] * iL);
                bf16* yp = YA + (size_t)q * DM + h * HD + 32 * c + 16 * g2 + 4 * hh; *(u32x2*)yp = wa; *(u32x2*)(yp + 8) = wb; }
        }
    }
    __syncthreads();
}
__device__ __forceinline__ void p_dn_conv(Frame& F, const Args& A) {
    const bf16* QB = WSP(bf16, WS_R1); const bf16* KB = WSP(bf16, WS_R1 + T32); const bf16* VB = WSP(bf16, WS_R1 + 2 * T32);
    bf16* QN = (bf16*)F.out; bf16* KN = (bf16*)F.out + (size_t)S * DM; bf16* VN = WSP(bf16, WS_VN);
    const float* cw = A.in[3]; const float* BA = WSP(const float, WS_BA); float* BETA = WSP(float, WS_BETA); float* G = WSP(float, WS_G);
    for (int it = F.gw; it < S * NH; it += F.NGW) { const int t = it >> 3, h = it & 7, c = h * HD + 2 * F.lane;
        float aq0 = 0.f, aq1 = 0.f, ak0 = 0.f, ak1 = 0.f, av0 = 0.f, av1 = 0.f;
#pragma unroll
        for (int j = 0; j < 4; ++j) { const int tt = t + j - 3; if (tt < 0) continue;
            const unsigned xq = *(const unsigned*)(QB + (size_t)tt * DM + c), xk = *(const unsigned*)(KB + (size_t)tt * DM + c), xv = *(const unsigned*)(VB + (size_t)tt * DM + c);
            const float* w = cw + (size_t)j * 3072;
            aq0 += w[c] * bflo(xq); aq1 += w[c + 1] * bfhi(xq); ak0 += w[1024 + c] * bflo(xk); ak1 += w[1024 + c + 1] * bfhi(xk); av0 += w[2048 + c] * bflo(xv); av1 += w[2048 + c + 1] * bfhi(xv); }
        aq0 = siluf_(aq0); aq1 = siluf_(aq1); ak0 = siluf_(ak0); ak1 = siluf_(ak1); av0 = siluf_(av0); av1 = siluf_(av1);
        const float rq = rsq_(wave_sum(aq0 * aq0 + aq1 * aq1) + EPS) * 0.08838834764831845f, rk = rsq_(wave_sum(ak0 * ak0 + ak1 * ak1) + EPS);
        *(unsigned*)(QN + (size_t)t * DM + c) = pk2(aq0 * rq, aq1 * rq); *(unsigned*)(KN + (size_t)t * DM + c) = pk2(ak0 * rk, ak1 * rk); *(unsigned*)(VN + (size_t)t * DM + c) = pk2(av0, av1);
        if (F.lane == 0) { const float b = BA[(size_t)t * 16 + h], a = BA[(size_t)t * 16 + 8 + h] + A.in[5][h];
            const float sp = (a > 20.f) ? a : log1pf(expf(a));
            BETA[(size_t)t * 8 + h] = 1.f / (1.f + expf(-b)); G[(size_t)t * 8 + h] = -expf(A.in[4][h]) * sp; } }
}
__device__ __forceinline__ void p_dn_chunk(Frame& F, const Args& A) {
    const bf16* QN = (const bf16*)F.out; const bf16* KN = (const bf16*)F.out + (size_t)S * DM; bf16* VU = WSP(bf16, WS_VN); bf16* Wb = WSP(bf16, WS_W); bf16* ATT = WSP(bf16, WS_ATT);
    const float* BETA = WSP(const float, WS_BETA); const float* G = WSP(const float, WS_G); float* GC = WSP(float, WS_GC);
    LAS float* Kc = (LAS float*)(F.lds); LAS float* Qc = Kc + 64 * 132; LAS float* Lm = Qc + 64 * 132; LAS float* Tm = Lm + 64 * 65; LAS float* gcs = Tm + 64 * 65; LAS float* bes = gcs + 64; LAS float* bge = bes + 64;
    const int tid = F.tid;
    for (int item = blockIdx.x; item < NCH * NH; item += F.G) { const int n = item >> 3, h = item & 7, t0 = n * CH;
        __syncthreads();
        if (tid < 64) { gcs[tid] = G[(size_t)(t0 + tid) * 8 + h]; bes[tid] = BETA[(size_t)(t0 + tid) * 8 + h]; }
        __syncthreads();
        if (tid == 0) { float a = 0.f; for (int i = 0; i < 64; ++i) { a += gcs[i]; gcs[i] = a; } }
#pragma unroll
        for (int r = 0; r < 2; ++r) { const int idx = tid + 512 * r, row = idx >> 4, c8 = idx & 15;
            const u32x4 kv = *(const u32x4*)(KN + (size_t)(t0 + row) * DM + h * HD + 8 * c8), qv = *(const u32x4*)(QN + (size_t)(t0 + row) * DM + h * HD + 8 * c8);
            LAS float* kd = Kc + row * 132 + 8 * c8; LAS float* qd = Qc + row * 132 + 8 * c8;
            kd[0] = bflo(kv.x); kd[1] = bfhi(kv.x); kd[2] = bflo(kv.y); kd[3] = bfhi(kv.y); kd[4] = bflo(kv.z); kd[5] = bfhi(kv.z); kd[6] = bflo(kv.w); kd[7] = bfhi(kv.w);
            qd[0] = bflo(qv.x); qd[1] = bfhi(qv.x); qd[2] = bflo(qv.y); qd[3] = bfhi(qv.y); qd[4] = bflo(qv.z); qd[5] = bfhi(qv.z); qd[6] = bflo(qv.w); qd[7] = bfhi(qv.w); }
        __syncthreads();
        if (tid < 64) { GC[(size_t)(t0 + tid) * 8 + h] = gcs[tid]; bge[tid] = bes[tid] * expf(gcs[tid]); }
        for (int r = 0; r < 8; ++r) { const int p = tid + 512 * r, i = p >> 6, j = p & 63;
            float dk = 0.f, dq = 0.f;
            if (j <= i) { const LAS float* ki = Kc + i * 132; const LAS float* kj = Kc + j * 132; const LAS float* qi = Qc + i * 132;
                for (int d = 0; d < HD; ++d) { dk += ki[d] * kj[d]; dq += qi[d] * kj[d]; } }
            const float dec = (j <= i) ? expf(gcs[i] - gcs[j]) : 0.f;
            Lm[i * 65 + j] = (j < i) ? bes[i] * dk * dec : 0.f;
            ATT[((size_t)(h * NCH + n) * 64 + i) * 64 + j] = (bf16)f2bf((j <= i) ? dq * dec : 0.f); }
        __syncthreads();
        if (tid < 64) { const int c = tid;
            for (int i = 0; i < 64; ++i) { float acc = (i == c) ? 1.f : 0.f; for (int j = 0; j < i; ++j) acc -= Lm[i * 65 + j] * Tm[j * 65 + c]; Tm[i * 65 + c] = acc; } }
        __syncthreads();
#pragma unroll
        for (int r = 0; r < 2; ++r) { const int idx = tid + 512 * r, row = idx >> 4, c8 = idx & 15;
            const u32x4 vv = *(const u32x4*)(VU + (size_t)(t0 + row) * DM + h * HD + 8 * c8); LAS float* vd = Qc + row * 132 + 8 * c8;
            vd[0] = bflo(vv.x); vd[1] = bfhi(vv.x); vd[2] = bflo(vv.y); vd[3] = bfhi(vv.y); vd[4] = bflo(vv.z); vd[5] = bfhi(vv.z); vd[6] = bflo(vv.w); vd[7] = bfhi(vv.w); }
        __syncthreads();
        { const int d = tid & 127, ig = tid >> 7;
          for (int ii = 0; ii < 16; ++ii) { const int i = ig * 16 + ii; float au = 0.f, aw = 0.f;
              for (int j = 0; j <= i; ++j) { const float t = Tm[i * 65 + j]; au += t * bes[j] * Qc[j * 132 + d]; aw += t * bge[j] * Kc[j * 132 + d]; }
              VU[(size_t)(t0 + i) * DM + h * HD + d] = (bf16)f2bf(au); Wb[(size_t)(t0 + i) * DM + h * HD + d] = (bf16)f2bf(aw); } }
    }
    __syncthreads();
}
__device__ __forceinline__ void p_dn_scan_naive(Frame& F, const Args& A) {
    if (blockIdx.x < 4) {
    const bf16* QN = (const bf16*)F.out; const bf16* KN = (const bf16*)F.out + (size_t)S * DM; const bf16* U = WSP(const bf16, WS_VN); const bf16* Wb = WSP(const bf16, WS_W); const bf16* ATT = WSP(const bf16, WS_ATT);
    const float* GC = WSP(const float, WS_GC); bf16* O = WSP(bf16, WS_O);
    LAS float* vn = (LAS float*)F.lds;
    const int tid = F.tid, wv = tid >> 6, h = blockIdx.x * 2 + (wv >> 2), e = (wv & 3) * 32 + (F.lane & 31), half = F.lane >> 5;
    float s[64];
#pragma unroll
    for (int d = 0; d < 64; ++d) s[d] = 0.f;
    for (int n = 0; n < NCH; ++n) { const int t0 = n * CH; const float gl = GC[(size_t)(t0 + 63) * 8 + h];
        for (int c = 0; c < 64; ++c) { const size_t ro = (size_t)(t0 + c) * DM + h * HD; const bf16* wp = Wb + ro + 64 * half; float a = 0.f;
#pragma unroll
            for (int d8 = 0; d8 < 8; ++d8) { if ((d8 & 1) == 0) asm volatile("" ::: "memory"); const u32x4 wv4 = *(const u32x4*)(wp + 8 * d8);
                a += bflo(wv4.x) * s[8 * d8] + bfhi(wv4.x) * s[8 * d8 + 1] + bflo(wv4.y) * s[8 * d8 + 2] + bfhi(wv4.y) * s[8 * d8 + 3] + bflo(wv4.z) * s[8 * d8 + 4] + bfhi(wv4.z) * s[8 * d8 + 5] + bflo(wv4.w) * s[8 * d8 + 6] + bfhi(wv4.w) * s[8 * d8 + 7]; }
            a += __shfl_xor(a, 32);
            vn[c * 512 + tid] = bf2f(U[ro + e]) - a; }
        for (int c = 0; c < 64; ++c) { const size_t ro = (size_t)(t0 + c) * DM + h * HD; const bf16* qp = QN + ro + 64 * half; float a = 0.f;
#pragma unroll
            for (int d8 = 0; d8 < 8; ++d8) { if ((d8 & 1) == 0) asm volatile("" ::: "memory"); const u32x4 wv4 = *(const u32x4*)(qp + 8 * d8);
                a += bflo(wv4.x) * s[8 * d8] + bfhi(wv4.x) * s[8 * d8 + 1] + bflo(wv4.y) * s[8 * d8 + 2] + bfhi(wv4.y) * s[8 * d8 + 3] + bflo(wv4.z) * s[8 * d8 + 4] + bfhi(wv4.z) * s[8 * d8 + 5] + bflo(wv4.w) * s[8 * d8 + 6] + bfhi(wv4.w) * s[8 * d8 + 7]; }
            a += __shfl_xor(a, 32);
            a *= expf(GC[(size_t)(t0 + c) * 8 + h]);
            const bf16* ap = ATT + ((size_t)(h * NCH + n) * 64 + c) * 64; float b = 0.f;
            for (int j = 0; j <= c; ++j) b += bf2f(ap[j]) * vn[j * 512 + tid];
            if (half == 0) O[ro + e] = (bf16)f2bf(a + b); }
        const float egl = expf(gl);
#pragma unroll
        for (int d = 0; d < 64; ++d) s[d] *= egl;
        for (int c = 0; c < 64; ++c) { const size_t ro = (size_t)(t0 + c) * DM + h * HD; const bf16* kp = KN + ro + 64 * half; const float f = vn[c * 512 + tid] * expf(gl - GC[(size_t)(t0 + c) * 8 + h]);
#pragma unroll
            for (int d8 = 0; d8 < 8; ++d8) { if ((d8 & 1) == 0) asm volatile("" ::: "memory"); const u32x4 wv4 = *(const u32x4*)(kp + 8 * d8);
                s[8 * d8] += f * bflo(wv4.x); s[8 * d8 + 1] += f * bfhi(wv4.x); s[8 * d8 + 2] += f * bflo(wv4.y); s[8 * d8 + 3] += f * bfhi(wv4.y); s[8 * d8 + 4] += f * bflo(wv4.z); s[8 * d8 + 5] += f * bfhi(wv4.z); s[8 * d8 + 6] += f * bflo(wv4.w); s[8 * d8 + 7] += f * bfhi(wv4.w); } }
    }
    }
}
__device__ __forceinline__ void p_dn_out(Frame& F, const Args& A) {
    const bf16* O = WSP(const bf16, WS_O); const bf16* Z = WSP(const bf16, WS_Z); bf16* YD = WSP(bf16, WS_YD); const float* ow = A.in[6];
    for (int it = F.gw; it < S * NH; it += F.NGW) { const int t = it >> 3, h = it & 7; const size_t off = (size_t)t * DM + h * HD + 2 * F.lane;
        const unsigned ov = *(const unsigned*)(O + off), zv = *(const unsigned*)(Z + off); const float o0 = bflo(ov), o1 = bfhi(ov);
        const float rs = rsq_(wave_sum(o0 * o0 + o1 * o1) * (1.f / HD) + EPS);
        *(unsigned*)(YD + off) = pk2(o0 * rs * ow[2 * F.lane] * siluf_(bflo(zv)), o1 * rs * ow[2 * F.lane + 1] * siluf_(bfhi(zv))); }
}


constexpr size_t WS_UT = WS_O;
constexpr size_t WS_KT = WS_VN;
constexpr size_t WS_EGL = WS_KMEAN;
typedef float f32x4_t __attribute__((ext_vector_type(4)));

__device__ __forceinline__ void p_dn_relayout1(Frame& F, const Args& A) {
    bf16* QN = (bf16*)F.out; bf16* Wb = WSP(bf16, WS_W); const bf16* U = WSP(const bf16, WS_VN); bf16* UT = WSP(bf16, WS_UT); const float* GC = WSP(const float, WS_GC); float* EGL = WSP(float, WS_EGL);
    LAS unsigned short* tile = (LAS unsigned short*)(F.lds + F.wave * 16640);
    for (int it = F.gw; it < NCH * NH; it += F.NGW) { const int n = it >> 3, h = it & 7, t0 = n * CH;
        if (F.lane == 0) EGL[h * NCH + n] = expf(GC[(size_t)(t0 + 63) * 8 + h]);
        for (int c = 0; c < 64; ++c) { const size_t off = (size_t)(t0 + c) * DM + h * HD + 2 * F.lane; const float eg = expf(GC[(size_t)(t0 + c) * 8 + h]);
            const unsigned qv = *(const unsigned*)(QN + off); *(unsigned*)(QN + off) = pk2(bflo(qv) * eg, bfhi(qv) * eg);
            const unsigned wv = *(const unsigned*)(Wb + off); *(unsigned*)(Wb + off) = wv ^ 0x80008000u;
            const unsigned uv = *(const unsigned*)(U + off); *(LAS unsigned*)(tile + c * 130 + 2 * F.lane) = uv; }
        asm volatile("s_waitcnt lgkmcnt(0)" ::: "memory");
        bf16* ut = UT + (size_t)(h * NCH + n) * (HD * CH);
        for (int e = 0; e < HD; ++e) ut[e * CH + F.lane] = tile[F.lane * 130 + e];
        asm volatile("s_waitcnt lgkmcnt(0)" ::: "memory");
    }
}
__device__ __forceinline__ void p_dn_relayout2(Frame& F, const Args& A) {
    const bf16* KN = (const bf16*)F.out + (size_t)S * DM; bf16* KT = WSP(bf16, WS_KT); const float* GC = WSP(const float, WS_GC);
    LAS unsigned short* tile = (LAS unsigned short*)(F.lds + F.wave * 16640);
    for (int it = F.gw; it < NCH * NH; it += F.NGW) { const int n = it >> 3, h = it & 7, t0 = n * CH;
        for (int c = 0; c < 64; ++c) { const size_t off = (size_t)(t0 + c) * DM + h * HD + 2 * F.lane; *(LAS unsigned*)(tile + c * 130 + 2 * F.lane) = *(const unsigned*)(KN + off); }
        asm volatile("s_waitcnt lgkmcnt(0)" ::: "memory");
        const float f = expf(GC[(size_t)(t0 + 63) * 8 + h] - GC[(size_t)(t0 + F.lane) * 8 + h]);
        bf16* kt = KT + (size_t)(h * NCH + n) * (HD * CH);
        for (int d = 0; d < HD; ++d) kt[d * CH + F.lane] = (bf16)f2bf(bf2f(tile[F.lane * 130 + d]) * f);
        asm volatile("s_waitcnt lgkmcnt(0)" ::: "memory");
    }
}

constexpr size_t WS2_QN = WS_R1, WS2_KN = WS_R1 + T32, WS2_WNEG = WS_R1 + 2 * T32, WS2_ATT = WS_H, WS2_YD = WS_R1 + 2 * T32, WS2_HALT = WS_R1 + T32;
__device__ __forceinline__ bf16* ws2_kt(Frame& F) { return (bf16*)F.out; }
__device__ __forceinline__ bf16* ws2_ut(Frame& F) { return (bf16*)F.out + (size_t)S * DM; }

struct ConvHalo { unsigned q[3], k[3], v[3]; };
constexpr size_t WS_HALO = 241 * MiB;
__device__ __forceinline__ void p_dn_conv2_halo(Frame& F, ConvHalo& H) {
    const bf16* HB = WSP(const bf16, WS_HALO);
    const int n = F.gw >> 3, h = F.gw & 7, col = h * HD + 2 * F.lane;
#pragma unroll
    for (int j = 0; j < 3; ++j) { H.q[j] = H.k[j] = H.v[j] = 0u;
        if (n > 0 && F.gw < NCH * NH) { const bf16* hp = HB + ((size_t)(n - 1) * 3 + j) * 3072 + col; H.q[j] = *(const unsigned*)hp; H.k[j] = *(const unsigned*)(hp + 1024); H.v[j] = *(const unsigned*)(hp + 2048); } }
}
struct ConvW { float w0[4], w1[4]; };
__device__ __forceinline__ void conv_w(const float* cw, int col, ConvW& W) {
#pragma unroll
    for (int j = 0; j < 4; ++j) { W.w0[j] = cw[(size_t)j * 3072 + col]; W.w1[j] = cw[(size_t)j * 3072 + col + 1]; }
}
__device__ __forceinline__ __amdgpu_buffer_rsrc_t mk_rsrc(const void* p) { return __builtin_amdgcn_make_buffer_rsrc((void*)p, 0, 0x7fffffff, 0x00020000); }
__device__ __forceinline__ void conv_load(const bf16* src, int t0, int col, unsigned (&xall)[CH]) {
    const __amdgpu_buffer_rsrc_t r = mk_rsrc(src + (size_t)t0 * DM);
#pragma unroll
    for (int c = 0; c < CH; ++c) xall[c] = __builtin_amdgcn_raw_buffer_load_b32(r, 2 * col, c * (DM * 2), 0);
}
template <bool NORM, bool DST, bool TILE> __device__ __forceinline__ void conv_pass(const unsigned (&xall)[CH], bf16* dst, LAS unsigned short* tile, const ConvW& W, const unsigned (&halo)[3], int t0, int col, int lane, float scale) {
    float a0 = bflo(halo[0]), a1 = bfhi(halo[0]), b0 = bflo(halo[1]), b1 = bfhi(halo[1]), c0 = bflo(halo[2]), c1 = bfhi(halo[2]);
    const __amdgpu_buffer_rsrc_t rd = mk_rsrc(DST ? dst + (size_t)t0 * DM : nullptr);
#pragma unroll
    for (int c = 0; c < CH; ++c) { const unsigned xv = xall[c]; const float d0 = bflo(xv), d1 = bfhi(xv);
        float y0 = siluf_(W.w0[0] * a0 + W.w0[1] * b0 + W.w0[2] * c0 + W.w0[3] * d0), y1 = siluf_(W.w1[0] * a1 + W.w1[1] * b1 + W.w1[2] * c1 + W.w1[3] * d1);
        if (NORM) { const float rs = scale * rsq_(wave_sum(y0 * y0 + y1 * y1) + EPS); y0 *= rs; y1 *= rs; }
        const unsigned o = pk2(y0, y1);
        if (DST) __builtin_amdgcn_raw_buffer_store_b32(o, rd, 2 * col, c * (DM * 2), 0);
        if (TILE) *(LAS unsigned*)(tile + c * 130 + 2 * lane) = o;
        a0 = b0; a1 = b1; b0 = c0; b1 = c1; c0 = d0; c1 = d1; }
}
__device__ __forceinline__ void conv_tile_out(const LAS unsigned short* tile, bf16* dstT, int lane) {
#pragma unroll 4
    for (int i = 0; i < 16; ++i) { const int d = 8 * i + (lane >> 3), ch = lane & 7; const LAS unsigned short* tp = tile + (8 * ch) * 130 + d;
        u32x4 w; w.x = (unsigned)tp[0] | ((unsigned)tp[130] << 16); w.y = (unsigned)tp[260] | ((unsigned)tp[390] << 16); w.z = (unsigned)tp[520] | ((unsigned)tp[650] << 16); w.w = (unsigned)tp[780] | ((unsigned)tp[910] << 16);
        *(u32x4*)(dstT + (size_t)d * CH + 8 * ch) = w; }
}
__device__ __forceinline__ void p_dn_conv2(Frame& F, const Args& A, const ConvHalo& H) {
    if (F.gw >= NCH * NH) return;
    bf16* QB = WSP(bf16, WS_R1); bf16* KB = WSP(bf16, WS_R1 + T32); const bf16* VB = WSP(bf16, WS_R1 + 2 * T32); const float* cw = A.in[3];
    LAS unsigned short* tile = (LAS unsigned short*)(F.lds + F.wave * 16640);
    const int n = F.gw >> 3, h = F.gw & 7, t0 = n * CH, col = h * HD + 2 * F.lane;
    bf16* ktr = ws2_kt(F) + (size_t)(h * NCH + n) * (HD * CH); bf16* vt = ws2_ut(F) + (size_t)(h * NCH + n) * (HD * CH);
    unsigned xa[CH]; ConvW W;
    conv_load(KB, t0, col, xa); conv_w(cw + 1024, col, W);
    conv_pass<true, true, true>(xa, KB, tile, W, H.k, t0, col, F.lane, 1.f);
    asm volatile("s_waitcnt lgkmcnt(0)" ::: "memory");
    conv_load(VB, t0, col, xa); conv_w(cw + 2048, col, W);
    __builtin_amdgcn_sched_barrier(0);
    conv_tile_out(tile, ktr, F.lane);
    asm volatile("s_waitcnt lgkmcnt(0)" ::: "memory");
    conv_pass<false, false, true>(xa, nullptr, tile, W, H.v, t0, col, F.lane, 1.f);
    asm volatile("s_waitcnt lgkmcnt(0)" ::: "memory");
    conv_load(QB, t0, col, xa); conv_w(cw, col, W);
    __builtin_amdgcn_sched_barrier(0);
    conv_tile_out(tile, vt, F.lane);
    asm volatile("s_waitcnt lgkmcnt(0)" ::: "memory");
    conv_pass<true, true, false>(xa, QB, tile, W, H.q, t0, col, F.lane, 0.08838834764831845f);
}

constexpr int CK_WAVE_LDS = 19200;
__device__ __forceinline__ void p_dn_chunk2(Frame& F, const Args& A) {
    if (F.gw >= NCH * NH) return;
    const int n = F.gw >> 3, h = F.gw & 7, t0 = n * CH, lane = F.lane, r = lane & 31, hh = lane >> 5;
    bf16* QN = WSP(bf16, WS2_QN); const bf16* KN = WSP(const bf16, WS2_KN); bf16* Wn = WSP(bf16, WS2_WNEG); bf16* ATT = WSP(bf16, WS2_ATT) + (size_t)(h * NCH + n) * (CH * CH);
    bf16* KT = ws2_kt(F) + (size_t)(h * NCH + n) * (HD * CH); bf16* UT = ws2_ut(F) + (size_t)(h * NCH + n) * (HD * CH);
    const float* BA = WSP(const float, WS_BA); float* EGL = WSP(float, WS_EGL);
    LAS unsigned char* wl = F.lds + F.wave * CK_WAVE_LDS; LAS float* Lw = (LAS float*)wl; LAS float* gcs = (LAS float*)(wl + 18432); LAS float* bes = gcs + 64; LAS float* fcs = bes + 64;
    float beta, gc, gl;
    { const int t = t0 + lane; const float b = BA[(size_t)t * 16 + h], a = BA[(size_t)t * 16 + 8 + h] + A.in[5][h];
      const float sp = (a > 20.f) ? a : log1pf(expf(a)); gc = -expf(A.in[4][h]) * sp; beta = 1.f / (1.f + expf(-b));
#pragma unroll
      for (int o = 1; o < 64; o <<= 1) { const float v = __shfl_up(gc, o); if (lane >= o) gc += v; }
      gl = __shfl(gc, 63);
      gcs[lane] = gc; bes[lane] = beta; fcs[lane] = expf(gl - gc);
      if (lane == 0) EGL[h * NCH + n] = expf(gl); }
    asm volatile("s_waitcnt lgkmcnt(0)" ::: "memory");
    {
        bf16x8 kf[2][8];
#pragma unroll
        for (int ti = 0; ti < 2; ++ti)
#pragma unroll
            for (int ks = 0; ks < 8; ++ks) kf[ti][ks] = *(const bf16x8*)(KN + (size_t)(t0 + 32 * ti + r) * DM + h * HD + 16 * ks + 8 * hh);
#pragma unroll
        for (int tt = 0; tt < 3; ++tt) { const int ti = (tt == 0) ? 0 : 1, tj = (tt == 2) ? 1 : 0;
            f32x16 acc;
#pragma unroll
            for (int i = 0; i < 16; ++i) acc[i] = 0.f;
#pragma unroll
            for (int ks = 0; ks < 8; ++ks) acc = __builtin_amdgcn_mfma_f32_32x32x16_bf16(kf[ti][ks], kf[tj][ks], acc, 0, 0, 0);
            const int j = 32 * tj + r; const float gcj = gcs[j];
#pragma unroll
            for (int g4 = 0; g4 < 4; ++g4) { const int i0 = 32 * ti + 8 * g4 + 4 * hh; const f32x4 gi = *(const LAS f32x4*)(gcs + i0), bi = *(const LAS f32x4*)(bes + i0);
#pragma unroll
                for (int e = 0; e < 4; ++e) { const int i = i0 + e; Lw[i * 68 + j] = (j < i) ? bi[e] * acc[4 * g4 + e] * __expf(gi[e] - gcj) : 0.f; } } }
        bf16x8 qf[2][8];
#pragma unroll
        for (int ti = 0; ti < 2; ++ti)
#pragma unroll
            for (int ks = 0; ks < 8; ++ks) qf[ti][ks] = *(const bf16x8*)(QN + (size_t)(t0 + 32 * ti + r) * DM + h * HD + 16 * ks + 8 * hh);
#pragma unroll
        for (int tt = 0; tt < 3; ++tt) { const int tj = (tt == 2) ? 1 : 0, ti = (tt == 0) ? 0 : 1;
            f32x16 acc;
#pragma unroll
            for (int i = 0; i < 16; ++i) acc[i] = 0.f;
#pragma unroll
            for (int ks = 0; ks < 8; ++ks) acc = __builtin_amdgcn_mfma_f32_32x32x16_bf16(kf[tj][ks], qf[ti][ks], acc, 0, 0, 0);
            const int i = 32 * ti + r; const float gci = gcs[i];
#pragma unroll
            for (int g4 = 0; g4 < 4; ++g4) { const int j0 = 32 * tj + 8 * g4 + 4 * hh; const f32x4 gj = *(const LAS f32x4*)(gcs + j0); float v[4];
#pragma unroll
                for (int e = 0; e < 4; ++e) v[e] = (j0 + e <= i) ? acc[4 * g4 + e] * __expf(gci - gj[e]) : 0.f;
                u32x2 w; w.x = cvtpk(v[0], v[1]); w.y = cvtpk(v[2], v[3]); *(u32x2*)(ATT + (size_t)i * CH + 32 * tj + 16 * (g4 & 1) + 8 * hh + 4 * (g4 >> 1)) = w; } }
        { const u32x4 z4 = {0u, 0u, 0u, 0u}; const int zi = lane >> 1, zj = 32 + 16 * (lane & 1); *(u32x4*)(ATT + (size_t)zi * CH + zj) = z4; *(u32x4*)(ATT + (size_t)zi * CH + zj + 8) = z4; }
#pragma unroll
        for (int ti = 0; ti < 2; ++ti) { const float eg = __expf(gcs[32 * ti + r]);
#pragma unroll
            for (int ks = 0; ks < 8; ++ks) { float f[8]; unpack8f(qf[ti][ks], f);
#pragma unroll
                for (int e = 0; e < 8; ++e) f[e] *= eg;
                const u32x4 pw = __builtin_bit_cast(u32x4, pack8f(f)); bf16* qd = QN + (size_t)(t0 + 32 * ti + r) * DM + h * HD + 32 * (ks >> 1) + 16 * hh + 4 * (ks & 1);
                u32x2 p0, p1; p0.x = pw.x; p0.y = pw.y; p1.x = pw.z; p1.y = pw.w; *(u32x2*)qd = p0; *(u32x2*)(qd + 8) = p1; } }
    }
    asm volatile("s_waitcnt lgkmcnt(0)" ::: "memory");
    float T[64];
#pragma unroll
    for (int i = 0; i < 64; ++i) { float acc = (lane == i) ? 1.f : 0.f;
#pragma unroll
        for (int j = 0; j < i; ++j) acc -= Lw[i * 68 + j] * T[j];
        T[i] = acc; }
    LAS unsigned short* Tb = (LAS unsigned short*)wl; LAS unsigned short* Tbg = Tb + 64 * 72;
    { const float eg = __expf(gc);
      asm volatile("s_waitcnt lgkmcnt(0)" ::: "memory");
#pragma unroll
      for (int i = 0; i < 64; ++i) { const float v = T[i] * beta; Tb[i * 72 + lane] = (unsigned short)f2bf(v); Tbg[i * 72 + lane] = (unsigned short)f2bf(v * eg); } }
    asm volatile("s_waitcnt lgkmcnt(0)" ::: "memory");
#ifdef DBG_CHK
    if (n < 128) { bf16* dump = WSP(bf16, 241 * MiB) + (size_t)(h * 128 + n) * 4096; for (int i = 0; i < 64; ++i) dump[i * 64 + lane] = Tbg[i * 72 + lane]; }
#endif
#ifdef DBG_CHK
    if (n < 32) { bf16* dk = WSP(bf16, 249 * MiB) + (size_t)(h * 32 + n) * 8192; for (int x = 0; x < 128; ++x) dk[x * 64 + lane] = KT[(size_t)x * CH + lane]; }
#endif
#ifdef DN2_VALU_UW
    for (int e = 0; e < HD; ++e) { float a = 0.f; for (int j2 = 0; j2 < 64; ++j2) a += bf2f(Tb[lane * 72 + j2]) * bf2f(UT[(size_t)e * CH + j2]); asm volatile("s_waitcnt vmcnt(0)" ::: "memory"); UT[(size_t)e * CH + lane] = (bf16)f2bf(a); asm volatile("s_waitcnt vmcnt(0)" ::: "memory"); }
    for (int d2 = 0; d2 < HD; ++d2) { float a = 0.f; for (int j2 = 0; j2 < 64; ++j2) a += bf2f(Tbg[lane * 72 + j2]) * bf2f(KT[(size_t)d2 * CH + j2]); Wn[(size_t)(t0 + lane) * DM + h * HD + d2] = (bf16)f2bf(-a); }
#else
#pragma unroll
    for (int te = 0; te < 4; ++te) { bf16x8 vfr[4];
#pragma unroll
        for (int ks2 = 0; ks2 < 4; ++ks2) vfr[ks2] = *(const bf16x8*)(UT + (size_t)(32 * te + r) * CH + 16 * ks2 + 8 * hh);
#pragma unroll
        for (int ti = 0; ti < 2; ++ti) { f32x16 acc;
#pragma unroll
            for (int i = 0; i < 16; ++i) acc[i] = 0.f;
#pragma unroll
            for (int ks2 = 0; ks2 < 4; ++ks2) if (ti == 1 || ks2 < 2) { const bf16x8 tb = *(const LAS bf16x8*)(Tb + (32 * ti + r) * 72 + 16 * ks2 + 8 * hh); acc = __builtin_amdgcn_mfma_f32_32x32x16_bf16(tb, vfr[ks2], acc, 0, 0, 0); }
#pragma unroll
            for (int g4 = 0; g4 < 4; ++g4) { u32x2 w; w.x = cvtpk(acc[4 * g4], acc[4 * g4 + 1]); w.y = cvtpk(acc[4 * g4 + 2], acc[4 * g4 + 3]); *(u32x2*)(UT + (size_t)(32 * te + r) * CH + 32 * ti + 8 * g4 + 4 * hh) = w; } } }
    f32x4 fsc[4][2];
#pragma unroll
    for (int ks2 = 0; ks2 < 4; ++ks2) { fsc[ks2][0] = *(const LAS f32x4*)(fcs + 16 * ks2 + 8 * hh); fsc[ks2][1] = *(const LAS f32x4*)(fcs + 16 * ks2 + 8 * hh + 4); }
#pragma unroll
    for (int td = 0; td < 4; ++td) { bf16x8 kfr[4];
#pragma unroll
        for (int ks2 = 0; ks2 < 4; ++ks2) kfr[ks2] = *(const bf16x8*)(KT + (size_t)(32 * td + r) * CH + 16 * ks2 + 8 * hh);
#pragma unroll
        for (int tc = 0; tc < 2; ++tc) { f32x16 acc;
#pragma unroll
            for (int i = 0; i < 16; ++i) acc[i] = 0.f;
#pragma unroll
            for (int ks2 = 0; ks2 < 4; ++ks2) if (tc == 1 || ks2 < 2) { const bf16x8 tg = *(const LAS bf16x8*)(Tbg + (32 * tc + r) * 72 + 16 * ks2 + 8 * hh); acc = __builtin_amdgcn_mfma_f32_32x32x16_bf16(kfr[ks2], tg, acc, 0, 0, 0); }
#pragma unroll
            for (int g4 = 0; g4 < 4; ++g4) { u32x2 w; w.x = cvtpk(-acc[4 * g4], -acc[4 * g4 + 1]); w.y = cvtpk(-acc[4 * g4 + 2], -acc[4 * g4 + 3]);
                *(u32x2*)(Wn + (size_t)(t0 + 32 * tc + r) * DM + h * HD + 32 * td + 16 * (g4 & 1) + 8 * hh + 4 * (g4 >> 1)) = w; } }
#pragma unroll
        for (int ks2 = 0; ks2 < 4; ++ks2) { float f[8]; unpack8f(kfr[ks2], f); const f32x4 f0 = fsc[ks2][0], f1 = fsc[ks2][1];
            f[0] *= f0[0]; f[1] *= f0[1]; f[2] *= f0[2]; f[3] *= f0[3]; f[4] *= f1[0]; f[5] *= f1[1]; f[6] *= f1[2]; f[7] *= f1[3];
            const u32x4 pw = __builtin_bit_cast(u32x4, pack8f(f)); const int ch = 2 * ks2 + hh; bf16* kd = KT + (size_t)(32 * td + r) * CH + 32 * (ch >> 2) + 16 * (ch & 1) + 4 * ((ch >> 1) & 1);
            u32x2 p0, p1; p0.x = pw.x; p0.y = pw.y; p1.x = pw.z; p1.y = pw.w; *(u32x2*)kd = p0; *(u32x2*)(kd + 8) = p1; } }
#endif
}

#ifndef DN2
#define DN2 1
#endif
#if DN2
#define SCAN_WNEG WS2_WNEG
#define SCAN_QP WSP(const bf16, WS2_QN)
#define SCAN_KT ws2_kt(F)
#define SCAN_UT ws2_ut(F)
#define SCAN_ATT WS2_ATT
#define SCAN_YD WS2_YD
#else
#define SCAN_WNEG WS_W
#define SCAN_QP ((const bf16*)F.out)
#define SCAN_KT WSP(bf16, WS_KT)
#define SCAN_UT WSP(bf16, WS_UT)
#define SCAN_ATT WS_ATT
#define SCAN_YD WS_YD
#endif
constexpr int SC_RW = 288, SC_RK = 160;
constexpr int SC_W = 0, SC_Q = 64 * SC_RW, SC_K = 2 * 64 * SC_RW, SC_A = SC_K + 128 * SC_RK, SC_BUF = SC_A + 64 * SC_RK;
__device__ __forceinline__ bf16x8 frag2(const LAS unsigned char* p) {
    const u32x2 a = *(const LAS u32x2*)p, b = *(const LAS u32x2*)(p + 32); u32x4 w; w.x = a.x; w.y = a.y; w.z = b.x; w.w = b.y; return __builtin_bit_cast(bf16x8, w);
}
__device__ __forceinline__ bf16x8 packb(const f32x4_t a, const f32x4_t b) { u32x4 w; w.x = cvtpk(a[0], a[1]); w.y = cvtpk(a[2], a[3]); w.z = cvtpk(b[0], b[1]); w.w = cvtpk(b[2], b[3]); return __builtin_bit_cast(bf16x8, w); }
constexpr int SCAN_WGS = 16;
__device__ __forceinline__ void p_dn_scan_fast(Frame& F, const Args& A) {
    if (blockIdx.x < SCAN_WGS) {
    const int h = blockIdx.x >> 1, hf = blockIdx.x & 1;
    const bf16* Wb = WSP(const bf16, SCAN_WNEG); const bf16* QP = SCAN_QP; const bf16* KT = SCAN_KT; const bf16* ATT = WSP(const bf16, SCAN_ATT); bf16* UT = SCAN_UT; const float* EGL = WSP(const float, WS_EGL);
    if (F.wave >= 4) {
        const int lt = F.tid - 256;
#if defined(SCAN_PROBE) && SCAN_PROBE == 2
        unsigned long long lp_sum = 0ull, lp_t0 = 0ull;
#define SCP_T0() (lp_t0 = __builtin_amdgcn_s_memrealtime())
#define SCP_T1() (lp_sum += __builtin_amdgcn_s_memrealtime() - lp_t0)
#else
#define SCP_T0() ((void)0)
#define SCP_T1() ((void)0)
#endif
        u32x4 rwA[4], rqA[4], rkA[4], raA[2], rwB[4], rqB[4], rkB[4], raB[2], rwC[4], rqC[4], rkC[4], raC[2];
#define SC_GLD(dst, voff, sbase) asm volatile("global_load_dwordx4 %0, %1, %2" : "=v"(dst) : "v"(voff), "s"(sbase) : "memory")
        const unsigned vo_w = (unsigned)((lt >> 4) * (DM * 2) + (lt & 15) * 16), vo_t = (unsigned)lt * 16u;
#define SC_ISSUE(n_, X) do { const bf16* bw_ = Wb + (size_t)((n_) * CH) * DM + h * HD; const bf16* bq_ = QP + (size_t)((n_) * CH) * DM + h * HD; \
            const bf16* bk_ = KT + (size_t)(h * NCH + (n_)) * (HD * CH); const bf16* ba_ = ATT + (size_t)(h * NCH + (n_)) * (CH * CH); \
            _Pragma("unroll") for (int i = 0; i < 4; ++i) { SC_GLD(rw##X[i], vo_w + (unsigned)i * (16u * DM * 2u), bw_); SC_GLD(rq##X[i], vo_w + (unsigned)i * (16u * DM * 2u), bq_); } \
            _Pragma("unroll") for (int i = 0; i < 4; ++i) { SC_GLD(rk##X[i], vo_t + (unsigned)i * 4096u, bk_); } \
            _Pragma("unroll") for (int i = 0; i < 2; ++i) { SC_GLD(ra##X[i], vo_t + (unsigned)i * 4096u, ba_); } } while (0)
#define SC_WAIT(N, X) asm volatile("s_waitcnt vmcnt(" #N ")" : "+v"(rw##X[0]), "+v"(rw##X[1]), "+v"(rw##X[2]), "+v"(rw##X[3]), "+v"(rq##X[0]), "+v"(rq##X[1]), "+v"(rq##X[2]), "+v"(rq##X[3]), \
            "+v"(rk##X[0]), "+v"(rk##X[1]), "+v"(rk##X[2]), "+v"(rk##X[3]), "+v"(ra##X[0]), "+v"(ra##X[1]) :: "memory")
#define SC_PUT(buf_, X) do { LAS unsigned char* b_ = F.lds + (buf_) * SC_BUF; \
            _Pragma("unroll") for (int i = 0; i < 4; ++i) { const int idx = lt + 256 * i, row = idx >> 4, ch = idx & 15; *(LAS u32x4*)(b_ + SC_W + row * SC_RW + 16 * ch) = rw##X[i]; *(LAS u32x4*)(b_ + SC_Q + row * SC_RW + 16 * ch) = rq##X[i]; } \
            _Pragma("unroll") for (int i = 0; i < 4; ++i) { const int idx = lt + 256 * i, row = idx >> 3, ch = idx & 7; *(LAS u32x4*)(b_ + SC_K + row * SC_RK + 16 * ch) = rk##X[i]; } \
            _Pragma("unroll") for (int i = 0; i < 2; ++i) { const int idx = lt + 256 * i, row = idx >> 3, ch = idx & 7; *(LAS u32x4*)(b_ + SC_A + row * SC_RK + 16 * ch) = ra##X[i]; } } while (0)
#define SC_STEP(n_, X) do { SCP_T0(); if ((n_) + 1 < NCH) { if ((n_) + 3 < NCH) SC_WAIT(28, X); else if ((n_) + 2 < NCH) SC_WAIT(14, X); else SC_WAIT(0, X); \
                SC_PUT(((n_) + 1) & 1, X); if ((n_) + 4 < NCH) SC_ISSUE((n_) + 4, X); } \
            asm volatile("s_waitcnt lgkmcnt(0)" ::: "memory"); SCP_T1(); __builtin_amdgcn_s_barrier(); } while (0)
        SC_ISSUE(0, A); SC_WAIT(0, A); SC_PUT(0, A);
        asm volatile("s_waitcnt lgkmcnt(0)" ::: "memory");
        __builtin_amdgcn_s_barrier();
        SC_ISSUE(1, A); SC_ISSUE(2, B); SC_ISSUE(3, C);
        for (int n = 0; n < NCH; n += 3) {
            SC_STEP(n, A);
            if (n + 1 < NCH) SC_STEP(n + 1, B);
            if (n + 2 < NCH) SC_STEP(n + 2, C);
        }
#if defined(SCAN_PROBE) && SCAN_PROBE == 2
        if (blockIdx.x == 0 && F.tid == 256) F.MISC[16] = (unsigned)lp_sum;
#endif
    } else {
        const int r = F.lane & 15, g = F.lane >> 4, e0 = (hf * 4 + F.wave) * 16;
        f32x4_t sacc[8];
#pragma unroll
        for (int i = 0; i < 8; ++i) sacc[i] = (f32x4_t){0.f, 0.f, 0.f, 0.f};
        bf16* utp = UT + (size_t)h * NCH * (HD * CH) + (size_t)(e0 + r) * CH + 4 * g;
        u32x2 un[4];
#pragma unroll
        for (int ct = 0; ct < 4; ++ct) un[ct] = *(const u32x2*)(utp + 16 * ct);
        float egl = EGL[h * NCH];
        __builtin_amdgcn_s_barrier();
#ifdef SCAN_PROBE
        unsigned long long sp_sum = 0ull;
#endif
        for (int n = 0; n < NCH; ++n) {
#ifdef SCAN_PROBE
            const unsigned long long sp_t0 = __builtin_amdgcn_s_memrealtime();
#endif
            const LAS unsigned char* b = F.lds + (n & 1) * SC_BUF; const LAS unsigned char* lw = b + SC_W + r * SC_RW + 16 * g; const LAS unsigned char* lq = b + SC_Q + r * SC_RW + 16 * g;
            const LAS unsigned char* lk = b + SC_K + r * SC_RK + 16 * g; const LAS unsigned char* la = b + SC_A + r * SC_RK + 16 * g;
            f32x4_t vacc[4], oacc[4]; bf16x8 sb[4], fa[16], fb[16];
#pragma unroll
            for (int ct = 0; ct < 4; ++ct)
#pragma unroll
                for (int kk = 0; kk < 4; ++kk) fa[4 * ct + kk] = *(const LAS bf16x8*)(lw + ct * 16 * SC_RW + kk * 64);
#pragma unroll
            for (int ct = 0; ct < 4; ++ct)
#pragma unroll
                for (int kk = 0; kk < 4; ++kk) fb[4 * ct + kk] = *(const LAS bf16x8*)(lq + ct * 16 * SC_RW + kk * 64);
            __builtin_amdgcn_sched_barrier(0);
#pragma unroll
            for (int kk = 0; kk < 4; ++kk) sb[kk] = packb(sacc[2 * kk], sacc[2 * kk + 1]);
#pragma unroll
            for (int ct = 0; ct < 4; ++ct) { vacc[ct] = (f32x4_t){bflo(un[ct].x), bfhi(un[ct].x), bflo(un[ct].y), bfhi(un[ct].y)}; oacc[ct] = (f32x4_t){0.f, 0.f, 0.f, 0.f}; }
            bf16* utc = utp + (size_t)n * (HD * CH);
            u32x2 unn[4]; float egln = 0.f;
            if (n + 1 < NCH) {
#pragma unroll
                for (int ct = 0; ct < 4; ++ct) unn[ct] = *(const u32x2*)(utc + HD * CH + 16 * ct);
                egln = EGL[h * NCH + n + 1]; }
#pragma unroll
            for (int kk = 0; kk < 4; ++kk)
#pragma unroll
                for (int ct = 0; ct < 4; ++ct) vacc[ct] = __builtin_amdgcn_mfma_f32_16x16x32_bf16(fa[4 * ct + kk], sb[kk], vacc[ct], 0, 0, 0);
            __builtin_amdgcn_sched_barrier(0);
#pragma unroll
            for (int mt = 0; mt < 8; ++mt)
#pragma unroll
                for (int k2 = 0; k2 < 2; ++k2) fa[2 * mt + k2] = *(const LAS bf16x8*)(lk + mt * 16 * SC_RK + k2 * 64);
            __builtin_amdgcn_sched_barrier(0);
#pragma unroll
            for (int kk = 0; kk < 4; ++kk)
#pragma unroll
                for (int ct = 0; ct < 4; ++ct) oacc[ct] = __builtin_amdgcn_mfma_f32_16x16x32_bf16(fb[4 * ct + kk], sb[kk], oacc[ct], 0, 0, 0);
            __builtin_amdgcn_sched_barrier(0);
#pragma unroll
            for (int ct = 0; ct < 4; ++ct)
#pragma unroll
                for (int k2 = 0; k2 < 2; ++k2) if (!(k2 == 1 && ct < 2)) fb[2 * ct + k2] = *(const LAS bf16x8*)(la + ct * 16 * SC_RK + k2 * 64);
            __builtin_amdgcn_sched_barrier(0);
            bf16x8 vb[2];
#pragma unroll
            for (int k2 = 0; k2 < 2; ++k2) vb[k2] = packb(vacc[2 * k2], vacc[2 * k2 + 1]);
#pragma unroll
            for (int mt = 0; mt < 8; ++mt) sacc[mt] = sacc[mt] * egl;
#pragma unroll
            for (int k2 = 0; k2 < 2; ++k2)
#pragma unroll
                for (int mt = 0; mt < 8; ++mt) sacc[mt] = __builtin_amdgcn_mfma_f32_16x16x32_bf16(fa[2 * mt + k2], vb[k2], sacc[mt], 0, 0, 0);
#pragma unroll
            for (int k2 = 0; k2 < 2; ++k2)
#pragma unroll
                for (int ct = 0; ct < 4; ++ct) if (!(k2 == 1 && ct < 2)) oacc[ct] = __builtin_amdgcn_mfma_f32_16x16x32_bf16(fb[2 * ct + k2], vb[k2], oacc[ct], 0, 0, 0);
#pragma unroll
            for (int ct = 0; ct < 4; ++ct) { u32x2 w; w.x = cvtpk(oacc[ct][0], oacc[ct][1]); w.y = cvtpk(oacc[ct][2], oacc[ct][3]); *(u32x2*)(utc + 16 * ct) = w; }
#pragma unroll
            for (int ct = 0; ct < 4; ++ct) un[ct] = unn[ct];
            egl = egln;
            asm volatile("s_waitcnt lgkmcnt(0)" ::: "memory");
#if defined(SCAN_PROBE) && SCAN_PROBE == 1
            asm volatile("s_waitcnt vmcnt(0)" ::: "memory"); sp_sum += __builtin_amdgcn_s_memrealtime() - sp_t0;
#endif
            __builtin_amdgcn_s_barrier();
        }
#if defined(SCAN_PROBE) && SCAN_PROBE == 1
        if (blockIdx.x == 0 && F.tid == 0) F.MISC[16] = (unsigned)sp_sum;
#endif
    }
    }
}

constexpr int SEG_G = 8, SEG_N = NCH / SEG_G;
constexpr size_t WS_SST = 241 * MiB;
constexpr size_t WS_MBB = 245 * MiB;
constexpr size_t WS_MBM = 249 * MiB;
static_assert(WS_MBM + (size_t)NH * (SEG_G - 1) * 128 * 128 * 4 <= WS_END, "segment scan buffers");

template <bool FINAL> __device__ __forceinline__ void scan_job(Frame& F, const Args& A, int h, int sg, int sub) {
    const bf16* Wb = WSP(const bf16, SCAN_WNEG); const bf16* QP = SCAN_QP; const bf16* KT = SCAN_KT; const bf16* ATT = WSP(const bf16, SCAN_ATT); bf16* UT = SCAN_UT; const float* EGL = WSP(const float, WS_EGL);
    const int n0 = sg * SEG_N, n1 = n0 + SEG_N;
    constexpr int NLD = FINAL ? 14 : 8;
    if (F.wave >= 4) {
        const int lt = F.tid - 256;
        u32x4 rwA[4], rqA[4], rkA[4], raA[2], rwB[4], rqB[4], rkB[4], raB[2], rwC[4], rqC[4], rkC[4], raC[2];
#define S2_GLD(dst, voff, sbase) asm volatile("global_load_dwordx4 %0, %1, %2" : "=v"(dst) : "v"(voff), "s"(sbase) : "memory")
        const unsigned vo_w = (unsigned)((lt >> 4) * (DM * 2) + (lt & 15) * 16), vo_t = (unsigned)lt * 16u;
#define S2_ISSUE(n_, X) do { const bf16* bw_ = Wb + (size_t)((n_) * CH) * DM + h * HD; const bf16* bk_ = KT + (size_t)(h * NCH + (n_)) * (HD * CH); \
            _Pragma("unroll") for (int i = 0; i < 4; ++i) { S2_GLD(rw##X[i], vo_w + (unsigned)i * (16u * DM * 2u), bw_); } \
            _Pragma("unroll") for (int i = 0; i < 4; ++i) { S2_GLD(rk##X[i], vo_t + (unsigned)i * 4096u, bk_); } \
            if constexpr (FINAL) { const bf16* bq_ = QP + (size_t)((n_) * CH) * DM + h * HD; const bf16* ba_ = ATT + (size_t)(h * NCH + (n_)) * (CH * CH); \
                _Pragma("unroll") for (int i = 0; i < 4; ++i) { S2_GLD(rq##X[i], vo_w + (unsigned)i * (16u * DM * 2u), bq_); } \
                _Pragma("unroll") for (int i = 0; i < 2; ++i) { S2_GLD(ra##X[i], vo_t + (unsigned)i * 4096u, ba_); } } } while (0)
#define S2_TIEF(X) "+v"(rw##X[0]), "+v"(rw##X[1]), "+v"(rw##X[2]), "+v"(rw##X[3]), "+v"(rq##X[0]), "+v"(rq##X[1]), "+v"(rq##X[2]), "+v"(rq##X[3]), "+v"(rk##X[0]), "+v"(rk##X[1]), "+v"(rk##X[2]), "+v"(rk##X[3]), "+v"(ra##X[0]), "+v"(ra##X[1])
#define S2_TIEA(X) "+v"(rw##X[0]), "+v"(rw##X[1]), "+v"(rw##X[2]), "+v"(rw##X[3]), "+v"(rk##X[0]), "+v"(rk##X[1]), "+v"(rk##X[2]), "+v"(rk##X[3])
#define S2_WAIT2(X) do { if constexpr (FINAL) asm volatile("s_waitcnt vmcnt(28)" : S2_TIEF(X) :: "memory"); else asm volatile("s_waitcnt vmcnt(16)" : S2_TIEA(X) :: "memory"); } while (0)
#define S2_WAIT0(X) do { if constexpr (FINAL) asm volatile("s_waitcnt vmcnt(0)" : S2_TIEF(X) :: "memory"); else asm volatile("s_waitcnt vmcnt(0)" : S2_TIEA(X) :: "memory"); } while (0)
#define S2_PUT(buf_, X) do { LAS unsigned char* b_ = F.lds + (buf_) * SC_BUF; \
            _Pragma("unroll") for (int i = 0; i < 4; ++i) { const int idx = lt + 256 * i, row = idx >> 4, ch = idx & 15; *(LAS u32x4*)(b_ + SC_W + row * SC_RW + 16 * ch) = rw##X[i]; \
                if constexpr (FINAL) *(LAS u32x4*)(b_ + SC_Q + row * SC_RW + 16 * ch) = rq##X[i]; } \
            _Pragma("unroll") for (int i = 0; i < 4; ++i) { const int idx = lt + 256 * i, row = idx >> 3, ch = idx & 7; *(LAS u32x4*)(b_ + SC_K + row * SC_RK + 16 * ch) = rk##X[i]; } \
            if constexpr (FINAL) { _Pragma("unroll") for (int i = 0; i < 2; ++i) { const int idx = lt + 256 * i, row = idx >> 3, ch = idx & 7; *(LAS u32x4*)(b_ + SC_A + row * SC_RK + 16 * ch) = ra##X[i]; } } } while (0)
#define S2_STEP(n_, X) do { S2_WAIT2(X); S2_PUT(((n_) + 1 - n0) & 1, X); { const int nn_ = ((n_) + 4 < n1) ? (n_) + 4 : n1 - 1; S2_ISSUE(nn_, X); } \
            asm volatile("s_waitcnt lgkmcnt(0)" ::: "memory"); __builtin_amdgcn_s_barrier(); } while (0)
        static_assert(SEG_N % 3 == 2, "loader tail below is written for SEG_N = 3k + 2");
        S2_ISSUE(n0, A); S2_WAIT0(A); S2_PUT(0, A);
        asm volatile("s_waitcnt lgkmcnt(0)" ::: "memory");
        __builtin_amdgcn_s_barrier();
        S2_ISSUE(n0 + 1, A); S2_ISSUE(n0 + 2, B); S2_ISSUE(n0 + 3, C);
        int n = n0;
        for (; n + 2 < n1; n += 3) { S2_STEP(n, A); S2_STEP(n + 1, B); S2_STEP(n + 2, C); }
        S2_STEP(n, A); S2_STEP(n + 1, B);
        asm volatile("s_waitcnt vmcnt(0)" ::: "memory");
    } else {
        const int r = F.lane & 15, g = F.lane >> 4;
        const int col = FINAL ? (sub * 4 + F.wave) * 16 + r : 64 * sub + 16 * F.wave + r;
        const bool real = FINAL || (col < 128);
        f32x4_t sacc[8];
        if constexpr (FINAL) { const float* sp = WSP(const float, WS_SST) + ((size_t)(h * SEG_G + sg) * 128 + col) * 128 + 4 * g;
#pragma unroll
            for (int mt = 0; mt < 8; ++mt) sacc[mt] = *(const f32x4_t*)(sp + 16 * mt); }
        else {
#pragma unroll
            for (int mt = 0; mt < 8; ++mt)
#pragma unroll
                for (int e = 0; e < 4; ++e) sacc[mt][e] = (!real && (16 * mt + 4 * g + e) == (col - 128)) ? 1.f : 0.f; }
        bf16* utp = UT + (size_t)h * NCH * (HD * CH) + (size_t)((FINAL ? col : (col & 127))) * CH + 4 * g;
        u32x2 un[4];
#pragma unroll
        for (int ct = 0; ct < 4; ++ct) { un[ct] = (u32x2){0u, 0u}; if (real) un[ct] = *(const u32x2*)(utp + (size_t)n0 * (HD * CH) + 16 * ct); }
        float egl = EGL[h * NCH + n0];
        __builtin_amdgcn_s_barrier();
        for (int n = n0; n < n1; ++n) {
            const LAS unsigned char* b = F.lds + ((n - n0) & 1) * SC_BUF; const LAS unsigned char* lw = b + SC_W + r * SC_RW + 16 * g; const LAS unsigned char* lq = b + SC_Q + r * SC_RW + 16 * g;
            const LAS unsigned char* lk = b + SC_K + r * SC_RK + 16 * g; const LAS unsigned char* la = b + SC_A + r * SC_RK + 16 * g;
            f32x4_t vacc[4], oacc[4]; bf16x8 sb[4], fa[16], fb[16];
#pragma unroll
            for (int ct = 0; ct < 4; ++ct)
#pragma unroll
                for (int kk = 0; kk < 4; ++kk) fa[4 * ct + kk] = *(const LAS bf16x8*)(lw + ct * 16 * SC_RW + kk * 64);
            if constexpr (FINAL) {
#pragma unroll
                for (int ct = 0; ct < 4; ++ct)
#pragma unroll
                    for (int kk = 0; kk < 4; ++kk) fb[4 * ct + kk] = *(const LAS bf16x8*)(lq + ct * 16 * SC_RW + kk * 64); }
            __builtin_amdgcn_sched_barrier(0);
#pragma unroll
            for (int kk = 0; kk < 4; ++kk) sb[kk] = packb(sacc[2 * kk], sacc[2 * kk + 1]);
#pragma unroll
            for (int ct = 0; ct < 4; ++ct) { vacc[ct] = (f32x4_t){bflo(un[ct].x), bfhi(un[ct].x), bflo(un[ct].y), bfhi(un[ct].y)}; oacc[ct] = (f32x4_t){0.f, 0.f, 0.f, 0.f}; }
            bf16* utc = utp + (size_t)n * (HD * CH);
            u32x2 unn[4]; float egln = 0.f;
#pragma unroll
            for (int ct = 0; ct < 4; ++ct) unn[ct] = (u32x2){0u, 0u};
            if (n + 1 < n1) { if (real) {
#pragma unroll
                    for (int ct = 0; ct < 4; ++ct) unn[ct] = *(const u32x2*)(utc + HD * CH + 16 * ct); }
                egln = EGL[h * NCH + n + 1]; }
#pragma unroll
            for (int kk = 0; kk < 4; ++kk)
#pragma unroll
                for (int ct = 0; ct < 4; ++ct) vacc[ct] = __builtin_amdgcn_mfma_f32_16x16x32_bf16(fa[4 * ct + kk], sb[kk], vacc[ct], 0, 0, 0);
            __builtin_amdgcn_sched_barrier(0);
#pragma unroll
            for (int mt = 0; mt < 8; ++mt)
#pragma unroll
                for (int k2 = 0; k2 < 2; ++k2) fa[2 * mt + k2] = *(const LAS bf16x8*)(lk + mt * 16 * SC_RK + k2 * 64);
            __builtin_amdgcn_sched_barrier(0);
            if constexpr (FINAL) {
#pragma unroll
                for (int kk = 0; kk < 4; ++kk)
#pragma unroll
                    for (int ct = 0; ct < 4; ++ct) oacc[ct] = __builtin_amdgcn_mfma_f32_16x16x32_bf16(fb[4 * ct + kk], sb[kk], oacc[ct], 0, 0, 0);
                __builtin_amdgcn_sched_barrier(0);
#pragma unroll
                for (int ct = 0; ct < 4; ++ct)
#pragma unroll
                    for (int k2 = 0; k2 < 2; ++k2) if (!(k2 == 1 && ct < 2)) fb[2 * ct + k2] = *(const LAS bf16x8*)(la + ct * 16 * SC_RK + k2 * 64);
                __builtin_amdgcn_sched_barrier(0); }
            bf16x8 vb[2];
#pragma unroll
            for (int k2 = 0; k2 < 2; ++k2) vb[k2] = packb(vacc[2 * k2], vacc[2 * k2 + 1]);
#pragma unroll
            for (int mt = 0; mt < 8; ++mt) sacc[mt] = sacc[mt] * egl;
#pragma unroll
            for (int k2 = 0; k2 < 2; ++k2)
#pragma unroll
                for (int mt = 0; mt < 8; ++mt) sacc[mt] = __builtin_amdgcn_mfma_f32_16x16x32_bf16(fa[2 * mt + k2], vb[k2], sacc[mt], 0, 0, 0);
            if constexpr (FINAL) {
#pragma unroll
                for (int k2 = 0; k2 < 2; ++k2)
#pragma unroll
                    for (int ct = 0; ct < 4; ++ct) if (!(k2 == 1 && ct < 2)) oacc[ct] = __builtin_amdgcn_mfma_f32_16x16x32_bf16(fb[2 * ct + k2], vb[k2], oacc[ct], 0, 0, 0);
#pragma unroll
                for (int ct = 0; ct < 4; ++ct) { u32x2 w; w.x = cvtpk(oacc[ct][0], oacc[ct][1]); w.y = cvtpk(oacc[ct][2], oacc[ct][3]); *(u32x2*)(utc + 16 * ct) = w; } }
#pragma unroll
            for (int ct = 0; ct < 4; ++ct) un[ct] = unn[ct];
            egl = egln;
            asm volatile("s_waitcnt lgkmcnt(0)" ::: "memory");
            __builtin_amdgcn_s_barrier();
        }
        if constexpr (!FINAL) {
            if (real) { float* bp = WSP(float, WS_MBB) + ((size_t)(h * (SEG_G - 1) + sg) * 128 + col) * 128 + 4 * g;
#pragma unroll
                for (int mt = 0; mt < 8; ++mt) *(f32x4_t*)(bp + 16 * mt) = sacc[mt]; }
            else { bf16* mp = WSP(bf16, WS_MBM) + (size_t)(h * (SEG_G - 1) + sg) * (128 * 128) + (col - 128);
#pragma unroll
                for (int mt = 0; mt < 8; ++mt)
#pragma unroll
                    for (int e = 0; e < 4; ++e) mp[(size_t)(16 * mt + 4 * g + e) * 128] = (bf16)f2bf(sacc[mt][e]); } }
    }
}
constexpr int MID_SPLIT = 8;
__device__ __forceinline__ void scan_mid(Frame& F, const Args& A, int h, int cg) {
    LAS float* Sl = (LAS float*)F.lds; LAS unsigned char* Mimg = F.lds + 16 * 132 * 4;
    float* SST = WSP(float, WS_SST) + (size_t)h * SEG_G * (128 * 128);
    const float* MBB = WSP(const float, WS_MBB) + (size_t)h * (SEG_G - 1) * (128 * 128); const bf16* MBM = WSP(const bf16, WS_MBM) + (size_t)h * (SEG_G - 1) * (128 * 128);
    const int r = F.lane & 15, g = F.lane >> 4, et = F.wave, col = 16 * cg + r;
    __syncthreads();
    for (int i = F.tid; i < 16 * 128; i += NWAVES * 64) { Sl[(i >> 7) * 132 + (i & 127)] = 0.f; SST[(size_t)(16 * cg + (i >> 7)) * 128 + (i & 127)] = 0.f; }
    u32x4 mreg[2][4]; f32x4_t accn[2];
#pragma unroll
    for (int p = 0; p < 2; ++p) {
#pragma unroll
        for (int i = 0; i < 4; ++i) mreg[p][i] = *(const u32x4*)(MBM + (size_t)p * (128 * 128) + (size_t)(F.tid + 512 * i) * 8);
        accn[p] = *(const f32x4_t*)(MBB + ((size_t)p * 128 + col) * 128 + 16 * et + 4 * g); }
#pragma unroll
    for (int sg = 0; sg < SEG_G - 1; ++sg) { const int p = sg & 1;
        __syncthreads();
#pragma unroll
        for (int i = 0; i < 4; ++i) { const int idx = F.tid + 512 * i, row = idx >> 4, ch = idx & 15; *(LAS u32x4*)(Mimg + row * 272 + 16 * ch) = mreg[p][i]; }
        if (sg + 2 < SEG_G - 1) {
#pragma unroll
            for (int i = 0; i < 4; ++i) mreg[p][i] = *(const u32x4*)(MBM + (size_t)(sg + 2) * (128 * 128) + (size_t)(F.tid + 512 * i) * 8); }
        f32x4_t acc = accn[p];
        if (sg + 2 < SEG_G - 1) accn[p] = *(const f32x4_t*)(MBB + ((size_t)(sg + 2) * 128 + col) * 128 + 16 * et + 4 * g);
        __syncthreads();
#pragma unroll
        for (int kk = 0; kk < 4; ++kk) {
            const LAS float* sp = Sl + r * 132 + 32 * kk + 8 * g; const f32x4 s0 = *(const LAS f32x4*)sp, s1 = *(const LAS f32x4*)(sp + 4);
            float sf[8] = {s0.x, s0.y, s0.z, s0.w, s1.x, s1.y, s1.z, s1.w}; const bf16x8 bfr = pack8f(sf);
            const bf16x8 afr = *(const LAS bf16x8*)(Mimg + (16 * et + r) * 272 + 64 * kk + 16 * g); acc = __builtin_amdgcn_mfma_f32_16x16x32_bf16(afr, bfr, acc, 0, 0, 0); }
        *(f32x4_t*)(SST + (size_t)(sg + 1) * (128 * 128) + (size_t)col * 128 + 16 * et + 4 * g) = acc;
        __syncthreads();
        *(LAS f32x4_t*)(Sl + r * 132 + 16 * et + 4 * g) = acc;
    }
    __syncthreads();
}
__device__ __forceinline__ void p_dn_scan2_A(Frame& F, const Args& A) { const int b = blockIdx.x; if (b < NH * (SEG_G - 1) * 4) { const int gid = 8 * (b >> 5) + (b & 7), sub = (b >> 3) & 3; scan_job<false>(F, A, gid / (SEG_G - 1), gid % (SEG_G - 1), sub); } }
__device__ __forceinline__ void p_dn_scan2_B(Frame& F, const Args& A) { if (blockIdx.x < NH * MID_SPLIT) scan_mid(F, A, blockIdx.x / MID_SPLIT, blockIdx.x % MID_SPLIT); }
__device__ __forceinline__ void p_dn_scan2_C(Frame& F, const Args& A) { const int b = blockIdx.x; if (b < NH * SEG_G * 2) { const int gid = 8 * (b >> 4) + (b & 7), sub = (b >> 3) & 1; scan_job<true>(F, A, gid / SEG_G, gid % SEG_G, sub); } }
__device__ __forceinline__ void p_dn_out_fast(Frame& F, const Args& A) {
    const bf16* OT = SCAN_UT; const bf16* Z = WSP(const bf16, WS_Z); bf16* YD = WSP(bf16, SCAN_YD); const float* ow = A.in[6];
    LAS unsigned short* tile = (LAS unsigned short*)(F.lds + F.wave * 16640);
    for (int it = F.gw; it < NCH * NH; it += F.NGW) { const int n = it >> 3, h = it & 7, t0 = n * CH;
        const bf16* ot = OT + (size_t)(h * NCH + n) * (HD * CH);
        u32x4 ov[16]; unsigned zall[CH];
#pragma unroll
        for (int i = 0; i < 16; ++i) { const int e = 8 * i + (F.lane >> 3), ch = F.lane & 7; ov[i] = *(const u32x4*)(ot + (size_t)e * CH + 8 * ch); }
#pragma unroll
        for (int c = 0; c < CH; ++c) zall[c] = *(const unsigned*)(Z + (size_t)(t0 + c) * DM + h * HD + 2 * F.lane);
        const float w0 = ow[2 * F.lane], w1 = ow[2 * F.lane + 1];
#pragma unroll
        for (int i = 0; i < 16; ++i) { const int e = 8 * i + (F.lane >> 3), ch = F.lane & 7; const u32x4 v = ov[i]; LAS unsigned short* tp = tile + e * 65 + 8 * ch;
            tp[0] = (unsigned short)v.x; tp[1] = (unsigned short)(v.x >> 16); tp[2] = (unsigned short)v.y; tp[3] = (unsigned short)(v.y >> 16); tp[4] = (unsigned short)v.z; tp[5] = (unsigned short)(v.z >> 16); tp[6] = (unsigned short)v.w; tp[7] = (unsigned short)(v.w >> 16); }
        asm volatile("s_waitcnt lgkmcnt(0)" ::: "memory");
#pragma unroll
        for (int c = 0; c < CH; ++c) { const float o0 = bf2f(tile[(2 * F.lane) * 65 + c]), o1 = bf2f(tile[(2 * F.lane + 1) * 65 + c]);
            const float rs = rsq_(wave_sum(o0 * o0 + o1 * o1) * (1.f / HD) + EPS);
            const size_t off = (size_t)(t0 + c) * DM + h * HD + 2 * F.lane; const unsigned zv = zall[c];
            *(unsigned*)(YD + off) = pk2(o0 * rs * w0 * siluf_(bflo(zv)), o1 * rs * w1 * siluf_(bfhi(zv))); }
        asm volatile("s_waitcnt lgkmcnt(0)" ::: "memory");
    }
}
#ifdef DBG_ATTN
constexpr int CW_DBG = 20000;
__device__ __forceinline__ void dbg_compare(Frame& F, const bf16* a, const bf16* b, size_t n) {
    float* acc = (float*)(WSP(unsigned, WS_CTL) + CW_DBG); float d2 = 0.f, r2 = 0.f;
    for (size_t i = (size_t)F.gw * 64 + F.lane; i < n; i += (size_t)F.NGW * 64) { const float x = bf2f(a[i]), y = bf2f(b[i]); d2 += (x - y) * (x - y); r2 += y * y; }
    d2 = wave_sum(d2); r2 = wave_sum(r2);
    if (F.lane == 0) { atomicAdd(acc, d2); atomicAdd(acc + 1, r2); }
}
#endif

#if defined(DBG_DET) || defined(DBG_L2L)
constexpr int CW_CS = 24000;
__device__ __forceinline__ void dbg_cksum(Frame& F, const void* p, size_t bytes, int slot) {
    const unsigned* w = (const unsigned*)p; unsigned acc = 0u; const size_t nw = bytes / 4;
#ifdef DBG_NANCNT
    for (size_t i = (size_t)F.gw * 64 + F.lane; i < nw; i += (size_t)F.NGW * 64) { const unsigned v = w[i]; acc += ((v & 0x7F80u) >= (141u << 7)) + ((v & 0x7F800000u) >= (141u << 23)); }
#else
    for (size_t i = (size_t)F.gw * 64 + F.lane; i < nw; i += (size_t)F.NGW * 64) { const unsigned v = w[i]; acc += v * 2654435761u + (unsigned)(i * 40503u) * (v >> 7); }
#endif
#pragma unroll
    for (int o = 1; o < 64; o <<= 1) acc += __shfl_xor(acc, o);
    if (F.lane == 0) atomicAdd(WSP(unsigned, WS_CTL) + CW_CS + slot, acc);
}
#endif

#ifdef DBG_SIG
constexpr int CW_SIG = 26000;
__device__ __forceinline__ void dbg_sig(Frame& F, const bf16* p, size_t n, int slot) {
    double acc = 0.0, acc2 = 0.0;
    for (size_t i = (size_t)F.gw * 64 + F.lane; i < n; i += (size_t)F.NGW * 64) { unsigned hsh = (unsigned)i * 2654435761u; hsh ^= hsh >> 15; hsh *= 2246822519u; hsh ^= hsh >> 13;
        const float wgt = (float)(hsh & 0xFFFFu) * (1.f / 32768.f) - 1.f; const float x = bf2f(p[i]); acc += (double)(x * wgt); acc2 += (double)(x * x); }
    long long q1 = (long long)(acc * 65536.0), q2 = (long long)(acc2 * 65536.0);
#pragma unroll
    for (int o = 1; o < 64; o <<= 1) { q1 += __shfl_xor(q1, o); q2 += __shfl_xor(q2, o); }
    if (F.lane == 0) { unsigned long long* a = (unsigned long long*)(WSP(unsigned, WS_CTL) + CW_SIG); atomicAdd(a + 2 * slot, (unsigned long long)q1); atomicAdd(a + 2 * slot + 1, (unsigned long long)q2); }
}
#endif

#ifdef DBG_CHK
constexpr int CW_CHK = 28000;
__device__ __forceinline__ float dbg_g(const float* BA, const Args& A, int t, int h) { const float a = BA[(size_t)t * 16 + 8 + h] + A.in[5][h]; const float sp = (a > 20.f) ? a : log1pf(expf(a)); return -expf(A.in[4][h]) * sp; }
__device__ __forceinline__ void dbg_chk_acc(Frame& F, int k, float err, float ref) {
    long long q1 = (long long)((double)err * (double)err * 1048576.0), q2 = (long long)((double)ref * (double)ref * 1048576.0);
    unsigned long long* a = (unsigned long long*)(WSP(unsigned, WS_CTL) + CW_CHK); atomicAdd(a + 2 * k, (unsigned long long)q1); atomicAdd(a + 2 * k + 1, (unsigned long long)q2);
}
__device__ __forceinline__ void dbg_chunk2_check(Frame& F, const Args& A) {
    const float* BA = WSP(const float, WS_BA); const bf16* KN = WSP(const bf16, WS2_KN); const bf16* QP = WSP(const bf16, WS2_QN); const bf16* Wn = WSP(const bf16, WS2_WNEG);
    const bf16* ATT = WSP(const bf16, WS2_ATT); const bf16* KT = ws2_kt(F); const float* EGL = WSP(const float, WS_EGL);
    const int s = F.gw * 64 + F.lane; if (s >= 8192) return;
    unsigned hsh = (unsigned)s * 2654435761u; hsh ^= hsh >> 15; hsh *= 2246822519u; hsh ^= hsh >> 13;
    const int n = hsh & 255, h = (hsh >> 8) & 7, i = (hsh >> 11) & 63, d = (hsh >> 17) & 127, t0 = n * CH;
    float gci = 0.f, gl = 0.f; { float a = 0.f; for (int j = 0; j < 64; ++j) { a += dbg_g(BA, A, t0 + j, h); if (j == i) gci = a; } gl = a; }
    const float beta_i = 1.f / (1.f + expf(-BA[(size_t)(t0 + i) * 16 + h]));
    const bf16* ki = KN + (size_t)(t0 + i) * DM + h * HD;
    dbg_chk_acc(F, 0, EGL[h * NCH + n] - expf(gl), expf(gl));
    { const float ref = bf2f(ki[d]) * expf(gl - gci); dbg_chk_acc(F, 1, bf2f(KT[(size_t)(h * NCH + n) * (HD * CH) + (size_t)d * CH + i]) - ref, ref); }
    { const float kt = bf2f(KT[(size_t)(h * NCH + n) * (HD * CH) + (size_t)d * CH + i]); dbg_chk_acc(F, 4, kt - bf2f(ki[d]), bf2f(ki[d])); }
    if (n < 128) { const int c = d & 63; const bf16* tg = WSP(const bf16, 241 * MiB) + (size_t)(h * 128 + n) * 4096; float lhs = bf2f(tg[i * 64 + c]); float gcj = 0.f, gcc = 0.f;
      for (int j = 0; j < 64; ++j) { gcj += dbg_g(BA, A, t0 + j, h); if (j == c) gcc = gcj;
          if (j < i) { const bf16* kj = KN + (size_t)(t0 + j) * DM + h * HD; float dot = 0.f; for (int x = 0; x < HD; ++x) dot += bf2f(ki[x]) * bf2f(kj[x]); lhs += beta_i * dot * expf(gci - gcj) * bf2f(tg[j * 64 + c]); } }
      const float beta_c = 1.f / (1.f + expf(-BA[(size_t)(t0 + c) * 16 + h])); const float ref = (i == c) ? beta_c * expf(gcc) : 0.f; dbg_chk_acc(F, 5, lhs - ref, (i == c) ? ref : 0.05f * beta_c * expf(gcc)); }
    if (n < 128) { const bf16* tg = WSP(const bf16, 241 * MiB) + (size_t)(h * 128 + n) * 4096; float ref = 0.f, mag = 0.f;
      for (int j = 0; j < 64; ++j) { const float t = bf2f(tg[i * 64 + j]) * bf2f(KN[(size_t)(t0 + j) * DM + h * HD + d]); ref += t; mag += fabsf(t); }
      dbg_chk_acc(F, 6, -bf2f(Wn[(size_t)(t0 + i) * DM + h * HD + d]) - ref, mag); }
    if (n < 128) { const bf16* tg = WSP(const bf16, 241 * MiB) + (size_t)(h * 128 + n) * 4096; float r7 = 0.f, r8 = 0.f, mag = 0.f, gcj = 0.f;
      for (int j = 0; j < 64; ++j) { gcj += dbg_g(BA, A, t0 + j, h); const float kk = bf2f(KN[(size_t)(t0 + j) * DM + h * HD + d]); const float t = bf2f(tg[i * 64 + j]) * kk;
          r7 += t * expf(gl - gcj); r8 += bf2f(tg[j * 64 + i]) * kk; mag += fabsf(t); }
      const float wv = -bf2f(Wn[(size_t)(t0 + i) * DM + h * HD + d]); dbg_chk_acc(F, 7, wv - r7, mag); dbg_chk_acc(F, 8, wv - r8, mag); }
    if (n < 32) { const bf16* dk = WSP(const bf16, 249 * MiB) + (size_t)(h * 32 + n) * 8192; dbg_chk_acc(F, 9, bf2f(dk[d * 64 + i]) - bf2f(ki[d]), bf2f(ki[d])); }
    if (n < 32) { const float ref = bf2f(ki[d]) * expf(gl - gci); dbg_chk_acc(F, 10, bf2f(KT[(size_t)(h * NCH + n) * (HD * CH) + (size_t)d * CH + i]) - ref, ref); }
    if (n < 128) { const bf16* tg = WSP(const bf16, 241 * MiB) + (size_t)(h * 128 + n) * 4096; float ref = 0.f, mag = 0.f;
      for (int j = 0; j < 64; ++j) { const float t = bf2f(tg[i * 64 + j]) * bf2f(KN[(size_t)(t0 + j) * DM + h * HD + d]); ref += t; mag += fabsf(t); }
      dbg_chk_acc(F, n >= 32 ? 11 : 12, -bf2f(Wn[(size_t)(t0 + i) * DM + h * HD + d]) - ref, mag); }
    { float lhs = -bf2f(Wn[(size_t)(t0 + i) * DM + h * HD + d]); float gcj = 0.f;
      for (int j = 0; j < i; ++j) { gcj += dbg_g(BA, A, t0 + j, h); const bf16* kj = KN + (size_t)(t0 + j) * DM + h * HD; float dot = 0.f; for (int x = 0; x < HD; ++x) dot += bf2f(ki[x]) * bf2f(kj[x]);
          lhs += beta_i * dot * expf(gci - gcj) * (-bf2f(Wn[(size_t)(t0 + j) * DM + h * HD + d])); }
      const float ref = beta_i * expf(gci) * bf2f(ki[d]); dbg_chk_acc(F, 2, lhs - ref, ref); }
    { const int j = d & 63; if (j <= i && gci > -20.f) { float gcj = 0.f; for (int x = 0; x <= j; ++x) gcj += dbg_g(BA, A, t0 + x, h);
          const bf16* kj = KN + (size_t)(t0 + j) * DM + h * HD; const bf16* qi = QP + (size_t)(t0 + i) * DM + h * HD; float dot = 0.f; for (int x = 0; x < HD; ++x) dot += bf2f(qi[x]) * bf2f(kj[x]);
          const float ref = dot * expf(-gcj); dbg_chk_acc(F, 3, bf2f(ATT[(size_t)(h * NCH + n) * (CH * CH) + (size_t)i * CH + j]) - ref, ref); }
      else if (j > i) dbg_chk_acc(F, 3, bf2f(ATT[(size_t)(h * NCH + n) * (CH * CH) + (size_t)i * CH + j]), 0.f); }
}
#endif

#ifdef DBG_TILE
constexpr int CW_TILE = 30000;
__device__ __forceinline__ void dbg_tile_check(Frame& F, const Args& A) {
    if (F.gw >= NCH * NH) return;
    const int n = F.gw >> 3, h = F.gw & 7, t0 = n * CH, lane = F.lane;
    const float* BA = WSP(const float, WS_BA); const bf16* KN = WSP(const bf16, WS2_KN); const bf16* KT = ws2_kt(F) + (size_t)(h * NCH + n) * (HD * CH);
    float gc = 0.f, gl = 0.f; { float a = 0.f; for (int j = 0; j < 64; ++j) { a += dbg_g(BA, A, t0 + j, h); if (j == lane) gc = a; } gl = a; }
    const float f = expf(gl - gc); int bad = 0;
    for (int d = 0; d < HD; ++d) { const float ref = bf2f(KN[(size_t)(t0 + lane) * DM + h * HD + d]) * f; const float got = bf2f(KT[(size_t)d * CH + lane]); if (!(fabsf(got - ref) <= 0.02f * fabsf(ref) + 1e-3f)) ++bad; }
    bad = (int)wave_sum((float)bad);
    if (lane == 0 && bad > 0) { unsigned* w = WSP(unsigned, WS_CTL) + CW_TILE; atomicAdd(w, 1u); atomicMin(w + 1, (unsigned)n); atomicOr(w + 2 + n, 1u << h); atomicAdd(w + 300, (unsigned)bad); atomicOr(w + 301, 1u << h); if (bad > 4096) atomicOr(w + 302, 1u << h); }
}
#endif
template <int R> __device__ __forceinline__ void post_rows(Frame& F, const Args& A, int m0, int stride) {
    const float* x = A.in[0]; const bf16* T = WSP(const bf16, WS_T); bf16* H2 = WSP(bf16, WS_H2);
    const f32x4* w1 = (const f32x4*)A.in[10] + F.lane; const f32x4* w2 = (const f32x4*)A.in[11] + F.lane;
    unsigned long long t8[R][4]; f32x4 xv[R][4];
#pragma unroll
    for (int k = 0; k < R; ++k) { const int m = m0 + k * stride; const unsigned long long* tr = (const unsigned long long*)(T + (size_t)m * DM) + F.lane; const f32x4* xr = (const f32x4*)(x + (size_t)m * DM) + F.lane;
#pragma unroll
        for (int j = 0; j < 4; ++j) { t8[k][j] = tr[64 * j]; xv[k][j] = xr[64 * j]; } }
#pragma unroll
    for (int k = 0; k < R; ++k) { const int m = m0 + k * stride; f32x4* orow = (f32x4*)(F.out + (size_t)m * DM) + F.lane;
        f32x4 tv[4]; float ss = 0.f;
#pragma unroll
        for (int j = 0; j < 4; ++j) { const unsigned long long w8 = t8[k][j]; const unsigned lo = (unsigned)w8, hi = (unsigned)(w8 >> 32); tv[j] = (f32x4){bflo(lo), bfhi(lo), bflo(hi), bfhi(hi)}; ss += (tv[j].x * tv[j].x + tv[j].y * tv[j].y) + (tv[j].z * tv[j].z + tv[j].w * tv[j].w); }
        const float rs = rsq_(wave_sum(ss) * (1.f / DM) + EPS); float s2 = 0.f;
#pragma unroll
        for (int j = 0; j < 4; ++j) { tv[j] = xv[k][j] + tv[j] * rs * w1[64 * j]; orow[64 * j] = tv[j]; s2 += (tv[j].x * tv[j].x + tv[j].y * tv[j].y) + (tv[j].z * tv[j].z + tv[j].w * tv[j].w); }
        const float r2 = rsq_(wave_sum(s2) * (1.f / DM) + EPS);
        unsigned long long* o8 = (unsigned long long*)(H2 + (size_t)m * DM) + F.lane;
#pragma unroll
        for (int j = 0; j < 4; ++j) { const f32x4 hv = tv[j] * r2 * w2[64 * j]; o8[64 * j] = (unsigned long long)pk2(hv.x, hv.y) | ((unsigned long long)pk2(hv.z, hv.w) << 32); } }
}
__device__ __forceinline__ void p_post_mix(Frame& F, const Args& A) {
    int m = F.gw;
    for (; m + F.NGW < S; m += 2 * F.NGW) post_rows<2>(F, A, m, F.NGW);
    if (m < S) post_rows<1>(F, A, m, F.NGW);
}
#if !defined(DBG_NAN) && !defined(DBG_DET) && !defined(DBG_ATTN)
template <int R> __device__ __forceinline__ void final_rows(Frame& F, const Args& A, int m0, int stride) {
    const bf16* Fd = WSP(const bf16, WS_F); const f32x4* w = (const f32x4*)A.in[15] + F.lane;
    unsigned long long f8[R][4]; f32x4 xv[R][4];
#pragma unroll
    for (int k = 0; k < R; ++k) { const int m = m0 + k * stride; const unsigned long long* fr = (const unsigned long long*)(Fd + (size_t)m * DM) + F.lane; const f32x4* orow = (const f32x4*)(F.out + (size_t)m * DM) + F.lane;
#pragma unroll
        for (int j = 0; j < 4; ++j) { f8[k][j] = fr[64 * j]; xv[k][j] = orow[64 * j]; } }
#pragma unroll
    for (int k = 0; k < R; ++k) { const int m = m0 + k * stride; f32x4* orow = (f32x4*)(F.out + (size_t)m * DM) + F.lane;
        f32x4 fv[4]; float ss = 0.f;
#pragma unroll
        for (int j = 0; j < 4; ++j) { const unsigned long long w8 = f8[k][j]; const unsigned lo = (unsigned)w8, hi = (unsigned)(w8 >> 32); fv[j] = (f32x4){bflo(lo), bfhi(lo), bflo(hi), bfhi(hi)}; ss += (fv[j].x * fv[j].x + fv[j].y * fv[j].y) + (fv[j].z * fv[j].z + fv[j].w * fv[j].w); }
        const float rs = rsq_(wave_sum(ss) * (1.f / DM) + EPS);
#pragma unroll
        for (int j = 0; j < 4; ++j) orow[64 * j] = xv[k][j] + fv[j] * rs * w[64 * j]; }
}
__device__ __forceinline__ void p_final(Frame& F, const Args& A) {
    int m = F.gw;
    for (; m + F.NGW < S; m += 2 * F.NGW) final_rows<2>(F, A, m, F.NGW);
    if (m < S) final_rows<1>(F, A, m, F.NGW);
}
#else
__device__ __forceinline__ void p_final(Frame& F, const Args& A) {
    const bf16* Fd = WSP(const bf16, WS_F);
    for (int m = F.gw; m < S; m += F.NGW) {
        const unsigned long long* fr = (const unsigned long long*)(Fd + (size_t)m * DM) + F.lane; f32x4* orow = (f32x4*)(F.out + (size_t)m * DM) + F.lane; const f32x4* w = (const f32x4*)A.in[15] + F.lane;
        f32x4 fv[4]; float ss = 0.f;
#pragma unroll
        for (int j = 0; j < 4; ++j) { const unsigned long long w8 = fr[64 * j]; const unsigned lo = (unsigned)w8, hi = (unsigned)(w8 >> 32); fv[j] = (f32x4){bflo(lo), bfhi(lo), bflo(hi), bfhi(hi)}; ss += (fv[j].x * fv[j].x + fv[j].y * fv[j].y) + (fv[j].z * fv[j].z + fv[j].w * fv[j].w); }
        const float rs = rsq_(wave_sum(ss) * (1.f / DM) + EPS);
#pragma unroll
        for (int j = 0; j < 4; ++j) { f32x4 ov = orow[64 * j] + fv[j] * rs * w[64 * j];
#ifdef DBG_NAN
#pragma unroll
            for (int e = 0; e < 4; ++e) if (!(fabsf(ov[e]) < 1e30f)) ov[e] = 12345.f;
#endif
            orow[64 * j] = ov; }
#ifdef DBG_DET
        { const unsigned* cs = WSP(const unsigned, WS_CTL) + CW_CS; float pz = 0.f;
          for (int k = 12; k >= 0; --k) if (cs[k] != cs[16 + k]) pz = __builtin_ldexpf(1.f, 40 - 2 * k);
#pragma unroll
          for (int j = 0; j < 4; ++j) orow[64 * j] = orow[64 * j] + pz; }
#endif
#ifdef DBG_ATTN
        { const float* acc = (const float*)(WSP(unsigned, WS_CTL) + CW_DBG); const float rv = acc[0] / acc[1]; const float pz = !(rv < DBG_TOL) ? 1000.f : 0.f;
#pragma unroll
          for (int j = 0; j < 4; ++j) orow[64 * j] = orow[64 * j] + pz; }
#endif
    }
}

#endif
constexpr int NPHASE = 18;
#ifndef MK_N_LAUNCHES
#define MK_N_LAUNCHES 1
#endif
constexpr int N_LAUNCHES = MK_N_LAUNCHES;
__global__ void __launch_bounds__(NWAVES * 64, 2) fwd(Args args) {
    extern __shared__ __attribute__((aligned(16))) unsigned char lds[];
    Frame F;
    F.lds = (LAS unsigned char*)lds; F.MISC = (volatile LAS unsigned*)(F.lds + MISC_OFF);
    F.tid = threadIdx.x; F.lane = F.tid & 63; F.wave = __builtin_amdgcn_readfirstlane(F.tid >> 6);
    F.G = gridDim.x; F.gw = blockIdx.x * NWAVES + F.wave; F.NGW = F.G * NWAVES;
    F.out = args.out; F.ws = args.ws;
    for (int u = F.tid; u < (LDS_BYTES - LDSCTL_OFF) / 4; u += NWAVES * 64) ((LAS unsigned*)(F.lds + LDSCTL_OFF))[u] = 0u;
    __syncthreads();
    XcdBarrier bar; bar.bar = (unsigned*)(F.ws + WS_CTL) + CW_BAR; bar.x = 0; bar.st = nullptr;
    if (N_LAUNCHES == 1) bar = xcd_barrier_post((unsigned*)(F.ws + WS_CTL) + CW_BAR, F.MISC + 8);
#define GRID_BAR() do { if (N_LAUNCHES == 1) xcd_barrier(bar); } while (0)
    const int lo = args.ph_lo, hi = args.ph_hi;
#ifdef PROBE_LO
    unsigned long long pr_t0 = 0ull, pr_dt = 0ull;
#define PROBE_AT(k) do { if (blockIdx.x == 0 && F.tid == 0) { if ((k) == PROBE_LO) pr_t0 = __builtin_amdgcn_s_memrealtime(); if ((k) == PROBE_HI + 1) pr_dt = __builtin_amdgcn_s_memrealtime() - pr_t0; } } while (0)
#else
#define PROBE_AT(k) do {} while (0)
#endif
#ifdef DBG_L2L
#define CK(k, p, n) dbg_cksum(F, (p), (n), (k))
#define CKB() GRID_BAR()
#else
#define CK(k, p, n) do {} while (0)
#define CKB() do {} while (0)
#endif
#if defined(ONLY_PH)
#define PH_EN(k) ((k) == ONLY_PH)
#elif defined(PH_MASK)
#define PH_EN(k) (((PH_MASK) >> (k)) & 1)
#else
#define PH_EN(k) true
#endif
#define IN(k) (PH_EN(k) && lo <= (k) && (k) < hi)
#define BOTH(k) (IN(k) && IN((k) + 1))
#define GEMM(EPI, Aoff, Boff, N_, K_, ...) do { pg8::Gemm g{(const pg8::bf16_t*)(F.ws + (Aoff)), (const pg8::bf16_t*)(F.ws + (Boff)), S, (N_), (K_)}; pg8::StaticOrder So; So.init(S, (N_), F.G, (int)blockIdx.x); \
        EPI E{__VA_ARGS__}; pg8::gemm_phase<EPI, pg8::StaticOrder, true, true>(F.lds + RING_OFF, g, So, E); } while (0)

    PROBE_AT(0);
    if (IN(0)) { p_prologue(F, args); if (BOTH(0)) GRID_BAR(); }
    CK(0, F.ws + WS_H, T32); CK(0, F.ws + WS_BA, 1 * MiB); CK(0, F.ws + WS_WTA, 41 * MiB - 512 * 1024); CKB();
    PROBE_AT(1);
    if (IN(1)) { GEMM(pg8::EpiRope, WS_H, WS_WTA, 3072, DM, WSP(pg8::bf16_t, WS_R1), WSP(const float, WS_COS), WSP(const float, WS_SIN), WSP(float, WS_KMEAN)); if (BOTH(1)) GRID_BAR(); }
    CK(1, F.ws + WS_R1, 3 * T32); CKB();
    PROBE_AT(2);
#ifndef TOPK2
#define TOPK2 1
#endif
#if !TOPK2
    if (IN(2)) { p_kmean(F, args); if (BOTH(2)) GRID_BAR(); }
#endif
    CK(2, F.ws + WS_KMEAN, 256 * 1024); CKB();
#ifndef ATTN_FAST
#define ATTN_FAST 1
#endif
#if ATTN_FAST
    PROBE_AT(3);
#if TOPK2
    if (IN(3)) { p_topk2(F, args); if (BOTH(3)) GRID_BAR();
#ifdef BAR_PROBE
        for (int i_ = 0; i_ < 8; ++i_) GRID_BAR();
#endif
    }
#else
    if (IN(3)) { p_topk_bucket(F, args); if (BOTH(3)) GRID_BAR(); }
#endif
    CK(3, F.ws + WS_TOPI, (size_t)S * NH * 12); CKB();
    PROBE_AT(4);
#ifdef WGSTAT
#define WGSTAT_RUN(k, call) do { const unsigned long long t0_ = __builtin_amdgcn_s_memrealtime(); call; if (WGSTAT_PH == (k)) { __syncthreads(); if (F.tid == 0) { const unsigned dt_ = (unsigned)(__builtin_amdgcn_s_memrealtime() - t0_); \
        unsigned* w_ = WSP(unsigned, WS_CTL) + 30000; atomicMax(w_, dt_); atomicAdd(w_ + 1, dt_); atomicMin(w_ + 2, 0xFFFFFFFFu - dt_); } } } while (0)
#else
#define WGSTAT_RUN(k, call) call
#endif
    if (IN(4)) { PROBE_AT(40); WGSTAT_RUN(40, p_attn_sel(F, args)); GRID_BAR(); PROBE_AT(41); WGSTAT_RUN(41, p_attn_own(F, args)); PROBE_AT(42);
#ifdef DBG_ATTN
        GRID_BAR(); p_attn_naive(F, args); GRID_BAR(); dbg_compare(F, WSP(const bf16, WS_YA), (const bf16*)F.out, (size_t)S * DM);
#endif
        if (BOTH(4)) GRID_BAR(); }
    CK(4, F.ws + WS_YA, T32); CKB();
#else
    PROBE_AT(3);
    if (IN(3)) { p_topk(F, args); if (BOTH(3)) GRID_BAR(); }
    PROBE_AT(4);
    if (IN(4)) { p_attn_naive(F, args); if (BOTH(4)) GRID_BAR(); }
#endif
#ifdef DBG_CHK
    {   GEMM(pg8::EpiGen<0>, WS_H, WS_WTB, 4096, DM, WSP(pg8::bf16_t, WS_R1), DM, 1024, (size_t)S * DM, nullptr); GRID_BAR();
        { ConvHalo hl; p_dn_conv2_halo(F, hl); GRID_BAR(); p_dn_conv2(F, args, hl); GRID_BAR(); }
        p_dn_chunk2(F, args); GRID_BAR();
        dbg_chunk2_check(F, args); GRID_BAR();
#ifdef DBG_TILE
        if (blockIdx.x == 0 && F.tid == 0) WSP(unsigned, WS_CTL)[CW_TILE + 1] = 0xFFFFu; GRID_BAR(); dbg_tile_check(F, args); GRID_BAR();
#endif
        }
#elif defined(DBG_SIG)
    {
      { Frame Fp = F; asm volatile("" : "+s"(Fp.ws), "+s"(Fp.out), "+v"(Fp.lane), "+v"(Fp.tid));
        GEMM(pg8::EpiGen<0>, WS_H, WS_WTB, 4096, DM, WSP(pg8::bf16_t, WS_R1), DM, 1024, (size_t)S * DM, nullptr); GRID_BAR();
        p_dn_conv(Fp, args); GRID_BAR(); p_dn_chunk(Fp, args); GRID_BAR(); p_dn_relayout1(Fp, args); GRID_BAR(); p_dn_relayout2(Fp, args); GRID_BAR();
        dbg_sig(Fp, (const bf16*)Fp.out, (size_t)S * DM, 0); dbg_sig(Fp, WSPF(const bf16, WS_W), (size_t)S * DM, 1); dbg_sig(Fp, WSPF(const bf16, WS_KT), (size_t)S * DM, 2);
        dbg_sig(Fp, WSPF(const bf16, WS_UT), (size_t)S * DM, 3); dbg_sig(Fp, WSPF(const bf16, WS_ATT), (size_t)S * DM / 2, 4); GRID_BAR();
      }
      { Frame Fp = F; asm volatile("" : "+s"(Fp.ws), "+s"(Fp.out), "+v"(Fp.lane), "+v"(Fp.tid));
        p_hrecompute(Fp, args); GRID_BAR();
        GEMM(pg8::EpiGen<0>, WS_H, WS_WTB, 4096, DM, WSP(pg8::bf16_t, WS_R1), DM, 1024, (size_t)S * DM, nullptr); GRID_BAR();
        { ConvHalo hl; p_dn_conv2_halo(Fp, hl); GRID_BAR(); p_dn_conv2(Fp, args, hl); GRID_BAR(); }
        p_dn_chunk2(Fp, args); GRID_BAR();
        dbg_sig(Fp, WSPF(const bf16, WS2_QN), (size_t)S * DM, 8); dbg_sig(Fp, WSPF(const bf16, WS2_WNEG), (size_t)S * DM, 9); dbg_sig(Fp, ws2_kt(Fp), (size_t)S * DM, 10);
        dbg_sig(Fp, ws2_ut(Fp), (size_t)S * DM, 11); dbg_sig(Fp, WSPF(const bf16, WS2_ATT), (size_t)S * DM / 2, 12); GRID_BAR();
      }
    }
#elif defined(DBG_DET)
#define DET_PASS(P) { Frame Fp = F; asm volatile("" : "+s"(Fp.ws), "+s"(Fp.out), "+v"(Fp.lane), "+v"(Fp.tid)); \
    p_hrecompute(Fp, args); GRID_BAR(); \
    GEMM(pg8::EpiGen<0>, WS_H, WS_WTB, 4096, DM, WSP(pg8::bf16_t, WS_R1), DM, 1024, (size_t)S * DM, nullptr); GRID_BAR(); \
    dbg_cksum(Fp, Fp.ws + WS_R1, 4 * T32, (P) * 16 + 0); GRID_BAR(); \
    { ConvHalo hl; p_dn_conv2_halo(Fp, hl); GRID_BAR(); p_dn_conv2(Fp, args, hl); GRID_BAR(); } \
    dbg_cksum(Fp, Fp.ws + WS2_QN, T32, (P) * 16 + 1); dbg_cksum(Fp, Fp.ws + WS2_KN, T32, (P) * 16 + 2); dbg_cksum(Fp, ws2_kt(Fp), T32, (P) * 16 + 3); dbg_cksum(Fp, ws2_ut(Fp), T32, (P) * 16 + 4); GRID_BAR(); \
    p_dn_chunk2(Fp, args); GRID_BAR(); \
    dbg_cksum(Fp, Fp.ws + WS2_ATT, T32 / 2, (P) * 16 + 5); dbg_cksum(Fp, Fp.ws + WS2_QN, T32, (P) * 16 + 6); dbg_cksum(Fp, ws2_ut(Fp), T32, (P) * 16 + 7); dbg_cksum(Fp, Fp.ws + WS2_WNEG, T32, (P) * 16 + 8); \
    dbg_cksum(Fp, ws2_kt(Fp), T32, (P) * 16 + 9);  GRID_BAR(); \
    p_dn_scan_fast(Fp, args); GRID_BAR(); \
    dbg_cksum(Fp, ws2_ut(Fp), T32, (P) * 16 + 11); GRID_BAR(); \
    p_dn_out_fast(Fp, args); GRID_BAR(); \
    dbg_cksum(Fp, Fp.ws + WS2_YD, T32, (P) * 16 + 12); GRID_BAR(); }
    { DET_PASS(0) }
    { DET_PASS(1) }
    p_hrecompute(F, args); GRID_BAR();
#else
    PROBE_AT(5);
    if (IN(5)) { GEMM(pg8::EpiGen<5>, WS_H, WS_WTB, 4096, DM, WSP(pg8::bf16_t, WS_R1), DM, 1024, (size_t)S * DM, WSP(const pg8::bf16_t, WS_HALO)); if (BOTH(5)) GRID_BAR(); }
    CK(5, F.ws + WS_R1, 4 * T32); CKB();
#if DN2
    PROBE_AT(6);
    if (IN(6)) { ConvHalo hl; p_dn_conv2_halo(F, hl); if (N_LAUNCHES != 1) GRID_BAR(); p_dn_conv2(F, args, hl); if (BOTH(6)) GRID_BAR(); }
    CK(6, F.ws + WS2_QN, 2 * T32); CK(6, F.out, 2 * T32); CKB();
    PROBE_AT(7);
    if (IN(7)) { p_dn_chunk2(F, args); if (BOTH(7)) GRID_BAR(); }
    CK(7, F.ws + WS2_ATT, T32 / 2); CK(7, F.ws + WS2_QN, T32); CK(7, F.out, 2 * T32); CK(7, F.ws + WS2_WNEG, T32); CK(7, F.ws + WS_EGL, 8192); CKB();
#else
    PROBE_AT(6);
    if (IN(6)) { p_dn_conv(F, args); if (BOTH(6)) GRID_BAR(); }
    PROBE_AT(7);
    if (IN(7)) { p_dn_chunk(F, args); if (BOTH(7)) GRID_BAR(); }
#endif
#ifndef DN_FAST
#define DN_FAST 1
#endif
#if DN_FAST
#if DN2
    PROBE_AT(8);
#ifndef SCAN2
#define SCAN2 1
#endif
#if SCAN2
    if (IN(8)) { PROBE_AT(80); p_dn_scan2_A(F, args); GRID_BAR(); PROBE_AT(81); p_dn_scan2_B(F, args); GRID_BAR(); PROBE_AT(82); if (blockIdx.x < 128) p_dn_scan2_C(F, args); else { p_hrecompute_sub(F, args, WSP(bf16, WS2_HALT), ((int)blockIdx.x - 128) * NWAVES + F.wave, 128 * NWAVES);
#if DN2_LATE_WT
            p_wtrans(F, args, WT_ITEMS_EARLY, WT_ITEMS_ALL, ((int)blockIdx.x - 128) * NWAVES + F.wave, 128 * NWAVES);
#endif
        } if (BOTH(8)) GRID_BAR(); PROBE_AT(83); }
#else
    if (IN(8)) { p_dn_scan_fast(F, args); if (BOTH(8)) GRID_BAR(); }
#endif
    CK(8, ws2_ut(F), T32); CKB();
#else
    PROBE_AT(8);
    if (IN(8)) { p_dn_relayout1(F, args); GRID_BAR(); p_dn_relayout2(F, args); GRID_BAR(); p_dn_scan_fast(F, args); if (BOTH(8)) GRID_BAR(); }
#endif
    PROBE_AT(9);
#if DN2 && SCAN2
    if (IN(9)) { p_dn_out_fast(F, args); if (BOTH(9)) GRID_BAR(); }
#else
    if (IN(9)) { p_dn_out_fast(F, args); p_hrecompute(F, args); if (BOTH(9)) GRID_BAR(); }
#endif
    CK(9, F.ws + WS2_YD, T32); CK(9, F.ws + WS_H, T32); CKB();
#else
    PROBE_AT(8);
    if (IN(8)) { p_dn_scan_naive(F, args); if (BOTH(8)) GRID_BAR(); }
    PROBE_AT(9);
    if (IN(9)) { p_dn_out(F, args); p_hrecompute(F, args); if (BOTH(9)) GRID_BAR(); }
#endif
#endif
    PROBE_AT(10);
    if (IN(10)) { pg8::Gemm g{(const pg8::bf16_t*)(F.ws + WS2_HALT), (const pg8::bf16_t*)(F.ws + WS_WTG), S, 2048, DM}; pg8::PairOrder Po; Po.init(S, DM, 2, F.G, (int)blockIdx.x);
        pg8::EpiGen<1> E{(pg8::bf16_t*)F.out, DM, 1024, (size_t)S * DM, nullptr}; pg8::gemm_phase<pg8::EpiGen<1>, pg8::PairOrder, true, true>(F.lds + RING_OFF, g, Po, E); if (BOTH(10) && N_LAUNCHES != 1) GRID_BAR(); }
    CK(10, F.out, 2 * T32); CKB();
    PROBE_AT(11);
    if (IN(11)) { GEMM(pg8::EpiGen<2>, WS_YA, WS_WTOA, 1024, DM, (pg8::bf16_t*)F.out, DM, 0, 0, nullptr); if (BOTH(11) && N_LAUNCHES != 1) GRID_BAR(); }
    CK(11, F.out, T32); CKB();
    PROBE_AT(12);
    if (IN(12)) { GEMM(pg8::EpiGen<3>, SCAN_YD, WS_WTOD, 1024, DM, (pg8::bf16_t*)F.out, DM, 0, 0, (const pg8::bf16_t*)F.out + (size_t)S * DM); if (BOTH(12)) GRID_BAR(); }
    CK(12, F.out, T32); CKB();
    PROBE_AT(13);
    if (IN(13)) { pg8::Gemm g{(const pg8::bf16_t*)F.out, WSP(const pg8::bf16_t, WS_WTOUT), S, DM, DM}; pg8::StaticOrder So; So.init(S, DM, F.G, (int)blockIdx.x);
        pg8::EpiGen<0> E{WSP(pg8::bf16_t, WS_T), DM, 0, 0, nullptr}; pg8::gemm_phase<pg8::EpiGen<0>, pg8::StaticOrder, true, true>(F.lds + RING_OFF, g, So, E); if (BOTH(13)) GRID_BAR(); }
    CK(13, F.ws + WS_T, 2 * T32); CKB();
    PROBE_AT(14);
    if (IN(14)) { p_post_mix(F, args); if (BOTH(14)) GRID_BAR(); }
    CK(14, F.out, 2 * T32); CK(14, F.ws + WS_H2, T32); CKB();
    PROBE_AT(15);
    if (IN(15)) { GEMM(pg8::EpiGen<4>, WS_H2, WS_WTGU, 2 * DFF, DM, WSP(pg8::bf16_t, WS_ACT), DFF, 0, 0, nullptr); if (BOTH(15)) GRID_BAR(); }
    CK(15, F.ws + WS_ACT, ACT_BYTES); CKB();
    PROBE_AT(16);
    if (IN(16)) { pg8::Gemm g{WSP(const pg8::bf16_t, WS_ACT), WSP(const pg8::bf16_t, WS_WTDN), S, DM, DFF}; pg8::StaticOrder So; So.init(S, DM, F.G, (int)blockIdx.x);
        pg8::EpiGen<0> E{WSP(pg8::bf16_t, WS_F), DM, 0, 0, nullptr}; pg8::gemm_phase<pg8::EpiGen<0>, pg8::StaticOrder, true, true>(F.lds + RING_OFF, g, So, E); if (BOTH(16)) GRID_BAR(); }
    CK(16, F.ws + WS_F, 2 * T32); CKB();
#ifdef DBG_TILE
    PROBE_AT(17);
    if (IN(17)) { const unsigned* w = WSP(const unsigned, WS_CTL) + CW_TILE; const unsigned cnt = w[0], mn = w[1]; const unsigned hm = (mn < 256u) ? w[2 + mn] : 0u;
        const int sel = DBG_TILE; const unsigned val = (sel == 1) ? (cnt > 120u ? 120u : cnt) : (sel == 2) ? (mn > 255u ? 127u : (mn >> 1)) : (sel == 3 ? (mn & 1u) * 8u + 0u + (hm & 0xFu) * 0u + (hm & 0xFFu) / 4u : (hm & 3u));
        float pz = __builtin_ldexpf(1.f, (int)val + 4); if (sel == 6) pz = __builtin_ldexpf(1.f, (int)(w[301] & 15u) + 4); if (sel == 7) pz = __builtin_ldexpf(1.f, (int)(w[301] >> 4) + 4); if (sel == 8) pz = __builtin_ldexpf(1.f, (int)(w[302] & 15u) + 4); if (sel == 9) pz = __builtin_ldexpf(1.f, (int)(w[302] >> 4) + 4);
        if (sel == 5) { unsigned be = w[300], lg = 0; while (be > 1u) { be >>= 1; ++lg; } pz = __builtin_ldexpf(1.f, (int)lg + 4); }
        for (size_t i = (size_t)F.gw * 64 + F.lane; i < (size_t)S * DM; i += (size_t)F.NGW * 64) F.out[i] = args.in[0][i] + pz; }
#elif defined(DBG_CHK)
    PROBE_AT(17);
    if (IN(17)) { const long long* sg = (const long long*)(WSP(unsigned, WS_CTL) + CW_CHK); float pz = 0.f;
        for (int k = 12; k >= 9; --k) { const double e2 = (double)sg[2 * k], r2 = (double)sg[2 * k + 1]; if (!(e2 <= 1e-3 * r2 + 16.0)) pz += 1024.f * (float)(1 << (2 * (k - 9))); }
        for (size_t i = (size_t)F.gw * 64 + F.lane; i < (size_t)S * DM; i += (size_t)F.NGW * 64) F.out[i] = args.in[0][i] + pz; }
#elif defined(DBG_SIG)
    PROBE_AT(17);
    if (IN(17)) { const long long* sg = (const long long*)(WSP(unsigned, WS_CTL) + CW_SIG); float pz = 0.f;
        for (int k = 4; k >= 0; --k) { const float a0 = (float)((double)sg[2 * k] / 65536.0), a1 = (float)((double)sg[2 * (8 + k)] / 65536.0), n0 = (float)((double)sg[2 * k + 1] / 65536.0), n1 = (float)((double)sg[2 * (8 + k) + 1] / 65536.0);
            const bool bad = !(fabsf(a0 - a1) <= 0.02f * sqrtf(n0) + 1e-3f) || !(fabsf(n0 - n1) <= 0.02f * (n0 + n1)); if (bad) pz = __builtin_ldexpf(1.f, 40 - 2 * k); }
        for (size_t i = (size_t)F.gw * 64 + F.lane; i < (size_t)S * DM; i += (size_t)F.NGW * 64) F.out[i] = args.in[0][i] + pz; }
#elif defined(DBG_DET)
    PROBE_AT(17);
    if (IN(17)) { const unsigned* cs = WSP(const unsigned, WS_CTL) + CW_CS; float pz = 0.f;
#ifdef DBG_NANCNT
        for (int k = 12; k >= 0; --k) if (cs[k] != 0u) pz = __builtin_ldexpf(1.f, 40 - 2 * k);
#else
        for (int k = 12; k >= 0; --k) if (cs[k] != cs[16 + k]) pz = __builtin_ldexpf(1.f, 40 - 2 * k);
#endif
        for (size_t i = (size_t)F.gw * 64 + F.lane; i < (size_t)S * DM; i += (size_t)F.NGW * 64) F.out[i] = args.in[0][i] + pz; }
#else
    PROBE_AT(17);
    if (IN(17)) { p_final(F, args); }
#endif
#ifdef WGSTAT
    if (blockIdx.x == 0 && F.tid == 0) { const unsigned* w_ = WSP(const unsigned, WS_CTL) + 30000; const unsigned v0 = __hip_atomic_load(w_, __ATOMIC_RELAXED, __HIP_MEMORY_SCOPE_AGENT), v1 = __hip_atomic_load(w_ + 1, __ATOMIC_RELAXED, __HIP_MEMORY_SCOPE_AGENT), v2 = __hip_atomic_load(w_ + 2, __ATOMIC_RELAXED, __HIP_MEMORY_SCOPE_AGENT);
        const unsigned long long dd = 8ull * (unsigned long long)(WGSTAT == 1 ? v0 : (WGSTAT == 2 ? v1 / (unsigned)F.G : 0xFFFFFFFFu - v2));
        const unsigned long long ts = __builtin_amdgcn_s_memrealtime(); while (__builtin_amdgcn_s_memrealtime() - ts < dd) __builtin_amdgcn_s_sleep(8); }
#endif
#ifdef SCAN_PROBE
    __syncthreads();
    if (blockIdx.x == 0 && F.tid == 0) { const unsigned long long ts = __builtin_amdgcn_s_memrealtime(); const unsigned long long dd = 8ull * (unsigned long long)F.MISC[16]; while (__builtin_amdgcn_s_memrealtime() - ts < dd) __builtin_amdgcn_s_sleep(8); }
#endif
#ifdef PROBE_LO
    PROBE_AT(18);
    if (blockIdx.x == 0 && F.tid == 0) { const unsigned long long ts = __builtin_amdgcn_s_memrealtime(); while (__builtin_amdgcn_s_memrealtime() - ts < 8ull * pr_dt) __builtin_amdgcn_s_sleep(8); }
#endif
#ifdef DBG_L2L
    GRID_BAR(); CK(17, F.out, 2 * T32); GRID_BAR();
    { unsigned* cs = WSP(unsigned, WS_CTL) + CW_CS; unsigned* save = WSP(unsigned, 253 * MiB);
      if (args.pass == 0) { if (blockIdx.x == 0 && F.tid < 32) save[F.tid] = cs[F.tid]; }
      else { float pz = 0.f; for (int k = 17; k >= 0; --k) if (cs[k] != save[k]) pz = __builtin_ldexpf(1.f, 44 - 2 * k);
          if (pz != 0.f) for (size_t i = (size_t)F.gw * 64 + F.lane; i < (size_t)S * DM; i += (size_t)F.NGW * 64) F.out[i] += pz; } }
#endif
#undef IN
#undef BOTH
}

extern "C" void kernel_launch(void* const* d_in, const int* in_sizes, int n_in, void* d_out, int out_size, void* d_ws, size_t ws_size, hipStream_t stream) {
    static int grid = 0;
    if (grid == 0) {
        if (n_in != 16 || in_sizes[0] != S * DM || out_size != S * DM || ws_size < WS_END) { fprintf(stderr, "kernel_launch: unexpected shapes (n_in %d, in0 %d, out %d, ws %zu); nothing launched\n", n_in, n_in > 0 ? in_sizes[0] : -1, out_size, ws_size); grid = -1; return; }
        int dev = 0, cus = 0, per_cu = 0;
        if (hipGetDevice(&dev) != hipSuccess || hipDeviceGetAttribute(&cus, hipDeviceAttributeMultiprocessorCount, dev) != hipSuccess) { grid = -1; return; }
        if (hipFuncSetAttribute((const void*)fwd, hipFuncAttributeMaxDynamicSharedMemorySize, LDS_BYTES) != hipSuccess) { fprintf(stderr, "kernel_launch: hipFuncSetAttribute failed\n"); grid = -1; return; }
        if (hipOccupancyMaxActiveBlocksPerMultiprocessor(&per_cu, (const void*)fwd, NWAVES * 64, LDS_BYTES) != hipSuccess || per_cu < 1) fprintf(stderr, "kernel_launch: occupancy query says %d\n", per_cu);
        (void)hipGetLastError();
        grid = cus;
    }
    if (grid < 0) return;
    if (hipMemsetAsync((char*)d_ws + WS_CTL, 0, CTL_ZERO_BYTES, stream) != hipSuccess) return;
    Args a{};
    for (int i = 0; i < 16; ++i) a.in[i] = (const float*)d_in[i];
    a.out = (float*)d_out; a.ws = (unsigned char*)d_ws;
#ifdef DBG_L2L
    hipMemsetAsync((char*)d_ws + CTL_ZERO_BYTES, 0xA5, WS_END - CTL_ZERO_BYTES, stream); hipMemsetAsync(d_out, 0xA5, (size_t)S * DM * 4, stream);
    for (int li = 0; li < 2; ++li) {
        if (li == 1) hipMemsetAsync((char*)d_ws + WS_CTL, 0, CTL_ZERO_BYTES, stream);
        a.ph_lo = 0; a.ph_hi = NPHASE; a.pass = li;
#else
    for (int li = 0; li < N_LAUNCHES; ++li) {
        a.ph_lo = (N_LAUNCHES == 1) ? 0 : li; a.ph_hi = (N_LAUNCHES == 1) ? NPHASE : li + 1;
#endif
        hipLaunchKernelGGL(fwd, dim3(grid), dim3(NWAVES * 64), LDS_BYTES, stream, a);
        if (hipPeekAtLastError() != hipSuccess) { fprintf(stderr, "kernel_launch: launch %d failed\n", li); break; }
    }
}
```

```cpp
#include <hip/hip_runtime.h>
#include <cstdio>
#include <cstdint>
#include <cmath>
namespace pg8 {
#define PG8_LAS __attribute__((address_space(3)))
typedef unsigned short bf16_t;
typedef short bf16x8 __attribute__((ext_vector_type(8)));
typedef float f32x4 __attribute__((ext_vector_type(4)));
typedef unsigned u32x4 __attribute__((ext_vector_type(4)));
constexpr int BM = 256, BK = 64, HALF = 128, HTB = HALF * BK * 2  , STAGE_BYTES = 8 * HTB, NXCD = 8, WGM = 8;

__host__ __device__ __forceinline__ int lds_byte(int r, int c) { const int st = (r >> 4) * 2 + (c >> 5), rr = r & 15, cc = c & 31, ob = rr * 64 + cc * 2; return st * 1024 + (ob ^ (((ob >> 9) & 1) << 5)); }
__host__ __device__ __forceinline__ void stage_rc(int b, int& R, int& C) { const int st = b / 1024, sb = b % 1024, swz = sb ^ (((sb >> 9) & 1) << 5); R = (st >> 1) * 16 + swz / 64; C = (st & 1) * 32 + (swz % 64) / 2; }
__host__ __device__ __forceinline__ int perm32(int rho) { const int n = rho >> 4, i = rho & 15; return 8 * (i >> 2) + 4 * n + (i & 3); }

struct Unit { int pm, pn; };
struct Gemm { const bf16_t* A; const bf16_t* Bt; int M, N, K; };

struct StaticOrder {
    int nM, nN, nwg, G, c;
    __host__ __device__ void init(int M, int N, int G_, int c_) { nM = M / BM; nN = N / BM; nwg = nM * nN; G = G_; c = c_; }
    __host__ __device__ bool next(int i, Unit& u) const {
        const long L = (long)i * G + c; if (L >= nwg) return false;
        int wgid = (int)L; { const int q = nwg / NXCD, r = nwg % NXCD, xcd = wgid % NXCD, off = wgid / NXCD; wgid = (xcd < r ? xcd * (q + 1) : r * (q + 1) + (xcd - r) * q) + off; }
        const int nig = WGM * nN, gid = wgid / nig, fm = gid * WGM, gsz = (nM - fm) < WGM ? (nM - fm) : WGM;
        u.pm = fm + ((wgid % nig) % gsz); u.pn = (wgid % nig) / gsz; return true;
    }
    __device__ __forceinline__ void a_ready(const Unit&) const {}
    __device__ __forceinline__ void done(const Unit&) const {}
};

__device__ __forceinline__ unsigned cvt_pk_bf16(float lo, float hi) { typedef __bf16 b2 __attribute__((ext_vector_type(2))); typedef float f2 __attribute__((ext_vector_type(2))); const f2 v = {lo, hi}; return __builtin_bit_cast(unsigned, __builtin_convertvector(v, b2)); }
template <class Epi, class Sched, bool ALIGN_EPI = false, bool SP2 = false>
__device__ __forceinline__ void gemm_phase(PG8_LAS unsigned char* lds, const Gemm g, const Sched& S, const Epi& E) {
    const int tid = threadIdx.x, wid = __builtin_amdgcn_readfirstlane(tid >> 6), lane = tid & 63, wr = wid >> 2, wc = wid & 3, fr = lane & 15, fq = lane >> 4;
    const int K = g.K, nt = K / BK;
    unsigned voffA[2], voffB[2];
#pragma unroll
    for (int i = 0; i < 2; ++i) { int R, C; stage_rc(tid * 16 + i * 8192, R, C); const int Rb = Epi::PERM ? ((R & ~31) + perm32(R & 31)) : R;
        voffA[i] = (unsigned)(R * K + C) * 2u; voffB[i] = (unsigned)(Rb * K + C) * 2u; }
    const size_t kstep = (size_t)(BK * 2);
    const size_t hstep = (size_t)HALF * K * 2;
    const size_t tstep = 2 * hstep;
    const unsigned ldsw = (unsigned)wid * 1024u;
    const int aoff = lds_byte(wr * 64 + fr, fq * 8), boff = lds_byte(wc * 32 + fr, fq * 8);
#define PG8_SA(b, h) (((b) * 2 + (h)) * HTB)
#define PG8_SB(b, h) ((4 + (b) * 2 + (h)) * HTB)
#define PG8_STAGE(bufoff, gbase, voff) do { _Pragma("unroll") for (int _i = 0; _i < 2; ++_i) \
        __builtin_amdgcn_global_load_lds((const unsigned*)((const char*)(gbase) + (voff)[_i]), (PG8_LAS unsigned*)(lds + (bufoff) + ldsw + _i * 8192), 16, 0, 0); } while (0)
#define PG8_LDA(dst, b, h) do { _Pragma("unroll") for (int m = 0; m < 4; ++m) _Pragma("unroll") for (int k = 0; k < 2; ++k) dst[m][k] = *(const PG8_LAS bf16x8*)(lds + PG8_SA(b, h) + aoff + m * 2048 + k * 1024); } while (0)
#define PG8_LDB(dst, b, h) do { _Pragma("unroll") for (int n = 0; n < 2; ++n) _Pragma("unroll") for (int k = 0; k < 2; ++k) dst[n][k] = *(const PG8_LAS bf16x8*)(lds + PG8_SB(b, h) + boff + n * 2048 + k * 1024); } while (0)
#define PG8_MMA(ai, bj, At, Bt) do { __builtin_amdgcn_s_setprio(1); _Pragma("unroll") for (int m = 0; m < 4; ++m) _Pragma("unroll") for (int n = 0; n < 2; ++n) _Pragma("unroll") for (int k = 0; k < 2; ++k) \
        acc[ai][bj][m][n] = __builtin_amdgcn_mfma_f32_16x16x32_bf16(Bt[n][k], At[m][k], acc[ai][bj][m][n], 0, 0, 0); __builtin_amdgcn_s_setprio(0); } while (0)
#define PG8_WAIT_V(n) asm volatile("s_waitcnt vmcnt(" #n ")" ::: "memory")
#define PG8_WAIT_L(n) asm volatile("s_waitcnt lgkmcnt(" #n ")" ::: "memory")
#define PG8_BAR __builtin_amdgcn_s_barrier()
#define PG8_SCHED __builtin_amdgcn_sched_barrier(0)
    Unit cur, nxt; int ui = 0;
    if (!S.next(0, cur)) return;
    f32x4 acc[2][2][4][2];
#pragma unroll
    for (int a = 0; a < 2; ++a)
#pragma unroll
        for (int b = 0; b < 2; ++b)
#pragma unroll
            for (int m = 0; m < 4; ++m)
#pragma unroll
                for (int n = 0; n < 2; ++n) acc[a][b][m][n] = (f32x4){0.f, 0.f, 0.f, 0.f};
    bf16x8 At[4][2], B0[2][2], B1[2][2];
    const char* cA = (const char*)g.A + (size_t)cur.pm * tstep; const char* cB = (const char*)g.Bt + (size_t)cur.pn * tstep;
    S.a_ready(cur);
    if constexpr (SP2) {
        PG8_STAGE(PG8_SB(0, 0), cB, voffB); PG8_STAGE(PG8_SB(0, 1), cB + hstep, voffB); PG8_STAGE(PG8_SA(0, 0), cA, voffA); PG8_STAGE(PG8_SA(0, 1), cA + hstep, voffA);
        if (wr == 1) PG8_BAR;
        PG8_WAIT_V(2); PG8_BAR;
        PG8_STAGE(PG8_SB(1, 0), cB + kstep, voffB); PG8_STAGE(PG8_SA(1, 0), cA + kstep, voffA); PG8_STAGE(PG8_SB(1, 1), cB + hstep + kstep, voffB);
        PG8_WAIT_V(6); PG8_BAR;
    } else {
        PG8_STAGE(PG8_SB(0, 0), cB, voffB); PG8_STAGE(PG8_SA(0, 0), cA, voffA); PG8_STAGE(PG8_SB(0, 1), cB + hstep, voffB); PG8_STAGE(PG8_SA(0, 1), cA + hstep, voffA);
        if (wr == 1) PG8_BAR;
        PG8_WAIT_V(4); PG8_BAR;
        PG8_STAGE(PG8_SB(1, 0), cB + kstep, voffB); PG8_STAGE(PG8_SA(1, 0), cA + kstep, voffA); PG8_STAGE(PG8_SB(1, 1), cB + hstep + kstep, voffB);
        PG8_WAIT_V(6); PG8_BAR;
    }
    for (;;) {
        const bool has_next = S.next(ui + 1, nxt);
        const char* nA = has_next ? (const char*)g.A + (size_t)nxt.pm * tstep : cA; const char* nB = has_next ? (const char*)g.Bt + (size_t)nxt.pn * tstep : cB;
        for (int t = 0; t < nt; t += 2) {
            const bool last = (t == nt - 2);
            const char* a1 = cA + (size_t)(t + 1) * kstep;
            const char* a2 = last ? nA : cA + (size_t)(t + 2) * kstep; const char* b2 = last ? nB : cB + (size_t)(t + 2) * kstep;
            const char* a3 = a2 + kstep; const char* b3 = b2 + kstep;
            if (last && has_next) S.a_ready(nxt);
            if constexpr (SP2) {
            PG8_LDB(B0, 0, 0); PG8_LDB(B1, 0, 1); PG8_SCHED; PG8_LDA(At, 0, 0); PG8_STAGE(PG8_SA(1, 1), a1 + hstep, voffA);
            PG8_WAIT_V(8); PG8_WAIT_L(0); PG8_BAR; PG8_MMA(0, 0, At, B0); PG8_MMA(0, 1, At, B1); PG8_BAR; PG8_SCHED;
            PG8_LDA(At, 0, 1); PG8_STAGE(PG8_SB(0, 0), b2, voffB); PG8_STAGE(PG8_SB(0, 1), b2 + hstep, voffB); PG8_STAGE(PG8_SA(0, 0), a2, voffA);
            PG8_WAIT_V(8); PG8_WAIT_L(0); PG8_BAR; PG8_MMA(1, 0, At, B0); PG8_MMA(1, 1, At, B1); PG8_BAR; PG8_SCHED;
            PG8_LDB(B0, 1, 0); PG8_LDB(B1, 1, 1); PG8_SCHED; PG8_LDA(At, 1, 0); PG8_STAGE(PG8_SA(0, 1), a2 + hstep, voffA);
            PG8_WAIT_V(8); PG8_WAIT_L(0); PG8_BAR; PG8_MMA(0, 0, At, B0); PG8_MMA(0, 1, At, B1); PG8_BAR; PG8_SCHED;
            PG8_LDA(At, 1, 1); PG8_STAGE(PG8_SB(1, 0), b3, voffB); PG8_STAGE(PG8_SB(1, 1), b3 + hstep, voffB); PG8_STAGE(PG8_SA(1, 0), a3, voffA);
            PG8_WAIT_V(8); PG8_WAIT_L(0); PG8_BAR; PG8_MMA(1, 0, At, B0); PG8_MMA(1, 1, At, B1); PG8_BAR; PG8_SCHED;
            } else {
            PG8_LDB(B0, 0, 0); PG8_SCHED; PG8_LDA(At, 0, 0); PG8_STAGE(PG8_SA(1, 1), a1 + hstep, voffA);
            PG8_WAIT_L(8); PG8_BAR; PG8_WAIT_L(0); PG8_MMA(0, 0, At, B0); PG8_BAR; PG8_SCHED;
            PG8_LDB(B1, 0, 1); PG8_STAGE(PG8_SB(0, 0), b2, voffB);
            PG8_BAR; PG8_WAIT_L(0); PG8_MMA(0, 1, At, B1); PG8_BAR;
            PG8_LDA(At, 0, 1); PG8_STAGE(PG8_SA(0, 0), a2, voffA);
            PG8_BAR; PG8_WAIT_L(0); PG8_MMA(1, 0, At, B0); PG8_BAR; PG8_SCHED;
            PG8_STAGE(PG8_SB(0, 1), b2 + hstep, voffB);
            PG8_WAIT_V(6); PG8_BAR; PG8_MMA(1, 1, At, B1); PG8_BAR;
            PG8_LDB(B0, 1, 0); PG8_SCHED; PG8_LDA(At, 1, 0); PG8_STAGE(PG8_SA(0, 1), a2 + hstep, voffA);
            PG8_WAIT_L(8); PG8_BAR; PG8_WAIT_L(0); PG8_MMA(0, 0, At, B0); PG8_BAR; PG8_SCHED;
            PG8_LDB(B1, 1, 1); PG8_STAGE(PG8_SB(1, 0), b3, voffB);
            PG8_BAR; PG8_WAIT_L(0); PG8_MMA(0, 1, At, B1); PG8_BAR;
            PG8_LDA(At, 1, 1); PG8_STAGE(PG8_SA(1, 0), a3, voffA);
            PG8_BAR; PG8_WAIT_L(0); PG8_MMA(1, 0, At, B0); PG8_BAR; PG8_SCHED;
            PG8_STAGE(PG8_SB(1, 1), b3 + hstep, voffB);
            PG8_WAIT_V(6); PG8_BAR; PG8_MMA(1, 1, At, B1); PG8_BAR;
            }
        }
        if constexpr (ALIGN_EPI) { if (wr == 0) PG8_BAR; }
        if constexpr (!Epi::AFTER_DRAIN) { E(acc, cur, wr, wc, fr, fq); S.done(cur); }
        if (!has_next) break;
#pragma unroll
        for (int a = 0; a < 2; ++a)
#pragma unroll
            for (int b = 0; b < 2; ++b)
#pragma unroll
                for (int m = 0; m < 4; ++m)
#pragma unroll
                    for (int n = 0; n < 2; ++n) acc[a][b][m][n] = (f32x4){0.f, 0.f, 0.f, 0.f};
        cur = nxt; cA = nA; cB = nB; ++ui;
        if constexpr (ALIGN_EPI) { if (wr == 1) PG8_BAR; }
    }
    PG8_WAIT_V(0);
    if constexpr (!ALIGN_EPI) { if (wr == 0) PG8_BAR; }
    PG8_BAR;
    if constexpr (Epi::AFTER_DRAIN) { E.fused(acc, cur, wr, wc, fr, fq, lds, wid, lane); S.done(cur); }
#undef PG8_SA
#undef PG8_SB
#undef PG8_STAGE
#undef PG8_LDA
#undef PG8_LDB
#undef PG8_MMA
#undef PG8_WAIT_V
#undef PG8_WAIT_L
#undef PG8_BAR
#undef PG8_SCHED
}
}
#define GAS __attribute__((address_space(1)))
#define LAS __attribute__((address_space(3)))
typedef unsigned short bf16;
typedef unsigned v4u __attribute__((ext_vector_type(4)));
typedef float f32x4 __attribute__((ext_vector_type(4)));
typedef short bf16x8 __attribute__((ext_vector_type(8)));
typedef GAS unsigned gu32;
typedef GAS unsigned long long gu64;
#define RLX_AGENT __ATOMIC_RELAXED, __HIP_MEMORY_SCOPE_AGENT
#define LDS_WAIT() asm volatile("s_waitcnt lgkmcnt(0)" ::: "memory")
#define VM_WAIT() asm volatile("s_waitcnt vmcnt(0)" ::: "memory")
__device__ __forceinline__ unsigned long long rt() { return __builtin_amdgcn_s_memrealtime(); }
typedef __bf16 hbf2_t __attribute__((ext_vector_type(2)));
typedef float hf2_t __attribute__((ext_vector_type(2)));
__device__ __forceinline__ unsigned pk2(float lo, float hi) { const hf2_t v = {lo, hi}; return __builtin_bit_cast(unsigned, __builtin_convertvector(v, hbf2_t)); }
__device__ __forceinline__ unsigned f2bf(float f) { return pk2(f, 0.f) & 0xffffu; }

#define XB_TMO      128
#define XB_XCNT(j)  (256  + 64 * (j))
#define XB_XSUB(j)  (1280 + 64 * (j))
#define XB_XGEN(j)  (2304 + 64 * (j))
#define XB_TOP      3328
#define XB_TOPGEN   3392
#define XCD_BAR_WORDS 3456
#define XB_SPIN_CAP (1u << 22)

__device__ __forceinline__ unsigned xb_ld(unsigned* p)              { return __hip_atomic_load(p, __ATOMIC_RELAXED, __HIP_MEMORY_SCOPE_AGENT); }
__device__ __forceinline__ unsigned xb_add(unsigned* p, unsigned v) { return __hip_atomic_fetch_add(p, v, __ATOMIC_RELAXED, __HIP_MEMORY_SCOPE_AGENT); }
__device__ __forceinline__ unsigned xb_xcc_id() { return (unsigned)__builtin_amdgcn_s_getreg((3 << 11) | 20) & 0xFu; }
#define XB_SPIN(cond, bar) do { unsigned _sp = 0; while (cond) { __builtin_amdgcn_s_sleep(1); \
    if ((++_sp & 255u) == 0u) { if (xb_ld(&(bar)[XB_TMO])) break; if (_sp > XB_SPIN_CAP) { atomicAdd(&(bar)[XB_TMO], 1u); break; } } } } while (0)

struct XcdBarrier {
    unsigned* bar; unsigned x;
    volatile LAS unsigned* st;
};

__device__ __forceinline__ XcdBarrier xcd_barrier_post(unsigned* bar, volatile LAS unsigned* st) {
    XcdBarrier b; b.bar = bar; b.x = xb_xcc_id(); b.st = st;
    if (threadIdx.x == 0) (void)xb_add(&bar[XB_XCNT(b.x)], 1u);
    return b;
}
__device__ __forceinline__ void xcd_barrier_complete(unsigned* bar, unsigned x, unsigned& nloc, unsigned& nx) {
    const unsigned G = gridDim.x * gridDim.y * gridDim.z;
    unsigned sum, cnt, mine, sp = 0u;
    for (;;) {
        sum = 0u; cnt = 0u; mine = 0u;
#pragma unroll
        for (unsigned j = 0; j < 16; ++j) { const unsigned c = xb_ld(&bar[XB_XCNT(j)]); sum += c; cnt += (c > 0u) ? 1u : 0u; mine = (j == x) ? c : mine; }
        if (sum == G) break;
        __builtin_amdgcn_s_sleep(1);
        if ((++sp & 255u) == 0u) { if (xb_ld(&bar[XB_TMO])) break; if (sp > XB_SPIN_CAP) { atomicAdd(&bar[XB_TMO], 1u); break; } }
    }
    nloc = mine > 0u ? mine : 1u; nx = cnt > 0u ? cnt : 1u;
}

__device__ __forceinline__ void xcd_barrier(const XcdBarrier& b) {
    asm volatile("s_waitcnt vmcnt(0)" ::: "memory");
    __syncthreads();
    if (threadIdx.x == 0) {
        unsigned* bar = b.bar;
        __builtin_amdgcn_s_waitcnt(0);
        unsigned nloc = b.st[0], nx = b.st[1];
        if (nloc == 0u) { xcd_barrier_complete(bar, b.x, nloc, nx); b.st[0] = nloc; b.st[1] = nx; }
        const unsigned old = xb_add(&bar[XB_XSUB(b.x)], 1u);
        const unsigned gen = old / nloc;
        if (old + 1u == (gen + 1u) * nloc) {
            __builtin_amdgcn_fence(__ATOMIC_RELEASE, "agent");
            asm volatile("s_waitcnt vmcnt(0)" ::: "memory");
            const unsigned og = xb_add(&bar[XB_TOP], 1u);
            const unsigned tg = og / nx;
            if (og + 1u == (tg + 1u) * nx) xb_add(&bar[XB_TOPGEN], 1u);
            else XB_SPIN(xb_ld(&bar[XB_TOPGEN]) == tg, bar);
            __builtin_amdgcn_fence(__ATOMIC_ACQUIRE, "agent");
            xb_add(&bar[XB_XGEN(b.x)], 1u);
            asm volatile("s_waitcnt vmcnt(0)" ::: "memory");
        } else {
            XB_SPIN(xb_ld(&bar[XB_XGEN(b.x)]) == gen, bar);
            __builtin_amdgcn_fence(__ATOMIC_ACQUIRE, "agent");
            asm volatile("s_waitcnt vmcnt(0)" ::: "memory");
        }
    }
    __syncthreads();
}

constexpr int S = 16384, DM = 1024, NH = 8, HD = 128, MBLK = 256, NBLK = S / MBLK, DFF = 2816, INTOT = 9232;
constexpr int CH = 64, NCH = S / CH;
constexpr float EPS = 1e-6f;
constexpr int NWAVES = 8;
#ifndef DN2_LATE_WT
#define DN2_LATE_WT 1
#endif

constexpr size_t MiB = 1u << 20;
constexpr size_t WS_CTL = 0, CTL_ZERO_BYTES = 1 * MiB;
constexpr size_t WS_COS = 1 * MiB, WS_SIN = 2 * MiB;
constexpr size_t WS_BA = 3 * MiB;
constexpr size_t WS_KMEAN = 4 * MiB;
constexpr size_t WS_TOPI = 5 * MiB;
constexpr size_t WS_BETA = 6 * MiB + 512 * 1024, WS_G = 7 * MiB, WS_GC = 7 * MiB + 512 * 1024;
constexpr size_t WS_WTA = 8 * MiB, WS_WTB = 14 * MiB, WS_WTG = 22 * MiB, WS_WTOA = 26 * MiB, WS_WTOD = 28 * MiB, WS_WTOUT = 30 * MiB, WS_WTGU = 32 * MiB, WS_WTDN = 43 * MiB;
constexpr size_t WS_H = 49 * MiB;
constexpr size_t WS_R1 = 81 * MiB;
constexpr size_t WS_Z = 177 * MiB, WS_YA = 209 * MiB, WS_END = 256 * MiB;
constexpr size_t ACT_BYTES = (size_t)S * DFF * 2;
constexpr size_t T32 = (size_t)S * DM * 2;
static_assert(WS_WTDN + (size_t)DM * DFF * 2 <= WS_H && WS_YA + T32 <= WS_END && WS_R1 + 3 * T32 == WS_Z, "ws map");
constexpr size_t WS_VN = WS_H;
constexpr size_t WS_W = WS_R1, WS_ATT = WS_R1 + T32, WS_O = WS_R1 + T32 + 16 * MiB, WS_YD = WS_R1;
constexpr size_t WS_T = 113 * MiB, WS_H2 = WS_H, WS_ACT = 81 * MiB, WS_F = 169 * MiB, WS_X1B = 209 * MiB;
static_assert(WS_ACT + ACT_BYTES <= WS_F && WS_F + 2 * T32 <= WS_END && WS_O + T32 <= WS_Z && WS_T + 2 * T32 <= WS_Z, "overlay map");
constexpr int CW_BAR = 4096;

constexpr int RING_OFF = 0, RING_BYTES = 131072;
constexpr int LDS_BYTES = 163840;
constexpr int LDSCTL_OFF = LDS_BYTES - 4096, MISC_OFF = LDSCTL_OFF + 320;

typedef unsigned u32x4 __attribute__((ext_vector_type(4)));
typedef unsigned u32x2 __attribute__((ext_vector_type(2)));

__device__ __forceinline__ float bflo(unsigned u) { return __builtin_bit_cast(float, u << 16); }
__device__ __forceinline__ float bfhi(unsigned u) { return __builtin_bit_cast(float, u & 0xffff0000u); }
__device__ __forceinline__ float bf2f(bf16 b) { return __builtin_bit_cast(float, ((unsigned)b) << 16); }
__device__ __forceinline__ float wave_sum(float v) {
#define WS_DPP(ctrl) v += __builtin_bit_cast(float, __builtin_amdgcn_update_dpp(0, __builtin_bit_cast(int, v), (ctrl), 0xF, 0xF, true))
    WS_DPP(0xB1); WS_DPP(0x4E); WS_DPP(0x141); WS_DPP(0x140);
#undef WS_DPP
    const float s0 = __builtin_bit_cast(float, __builtin_amdgcn_readlane(__builtin_bit_cast(int, v), 0)), s1 = __builtin_bit_cast(float, __builtin_amdgcn_readlane(__builtin_bit_cast(int, v), 16));
    const float s2 = __builtin_bit_cast(float, __builtin_amdgcn_readlane(__builtin_bit_cast(int, v), 32)), s3 = __builtin_bit_cast(float, __builtin_amdgcn_readlane(__builtin_bit_cast(int, v), 48));
    return (s0 + s1) + (s2 + s3);
}
__device__ __forceinline__ float wave_max(float v) {
#pragma unroll
    for (int o = 1; o < 64; o <<= 1) v = fmaxf(v, __shfl_xor(v, o));
    return v;
}
__device__ __forceinline__ float rcp_(float x) { return __builtin_amdgcn_rcpf(x); }
__device__ __forceinline__ float rsq_(float x) { return __builtin_amdgcn_rsqf(x); }
__device__ __forceinline__ float sigmoidf_(float x) { return rcp_(1.f + __expf(-x)); }
__device__ __forceinline__ float siluf_(float x) { return x * rcp_(1.f + __expf(-x)); }
__device__ __forceinline__ float sigmoidf_e(float x) { return sigmoidf_(x); }
__device__ __forceinline__ float siluf_e(float x) { return siluf_(x); }

namespace pg8 {
struct EpiRope {
    static constexpr bool PERM = false, AFTER_DRAIN = false;
    bf16_t* base; const float* cosT; const float* sinT; float* kpart;
    __device__ __forceinline__ void operator()(const f32x4 (&acc)[2][2][4][2], const Unit& u, int wr, int wc, int fr, int fq) const {
        const int t = u.pn >> 2, pnl = u.pn & 3;
        bf16_t* ob = base + (size_t)t * ((size_t)S * DM);
        const bool rope = (t < 2) && (wc == 0);
        f32x4 cs[2][2];
#pragma unroll
        for (int bj = 0; bj < 2; ++bj)
#pragma unroll
            for (int n = 0; n < 2; ++n) cs[bj][n] = (f32x4){0.f, 0.f, 0.f, 0.f};
#pragma unroll
        for (int ai = 0; ai < 2; ++ai)
#pragma unroll
            for (int m = 0; m < 4; ++m) {
                const int row = u.pm * BM + ai * HALF + wr * 64 + m * 16 + fr;
                f32x4 cv = (f32x4){1.f, 1.f, 1.f, 1.f}, sv = (f32x4){0.f, 0.f, 0.f, 0.f};
                if (rope) { cv = *(const f32x4*)(cosT + (size_t)row * 16 + 4 * fq); sv = *(const f32x4*)(sinT + (size_t)row * 16 + 4 * fq); }
#pragma unroll
                for (int bj = 0; bj < 2; ++bj) {
                    f32x4 v0 = acc[ai][bj][m][0], v1 = acc[ai][bj][m][1];
                    if (rope) { const f32x4 n0 = v0 * cv - v1 * sv, n1 = v1 * cv + v0 * sv; v0 = n0; v1 = n1; }
                    cs[bj][0] = cs[bj][0] + v0; cs[bj][1] = cs[bj][1] + v1;
                    bf16_t* p = ob + (size_t)row * DM + pnl * 256 + bj * HALF + wc * 32 + 4 * fq;
                    u32x2 w0, w1; w0.x = cvt_pk_bf16(v0[0], v0[1]); w0.y = cvt_pk_bf16(v0[2], v0[3]); w1.x = cvt_pk_bf16(v1[0], v1[1]); w1.y = cvt_pk_bf16(v1[2], v1[3]);
                    *(u32x2*)p = w0; *(u32x2*)(p + 16) = w1;
                }
            }
        if (t == 1) {
#pragma unroll
            for (int bj = 0; bj < 2; ++bj)
#pragma unroll
                for (int n = 0; n < 2; ++n) { f32x4 s = cs[bj][n];
#pragma unroll
                    for (int o = 1; o < 16; o <<= 1) { s.x += __shfl_xor(s.x, o); s.y += __shfl_xor(s.y, o); s.z += __shfl_xor(s.z, o); s.w += __shfl_xor(s.w, o); }
                    if (fr == 0) *(f32x4*)(kpart + ((size_t)(u.pm * 2 + wr) * NH + 2 * pnl + bj) * HD + wc * 32 + 16 * n + 4 * fq) = s; } }
    }
};
template <int MODE> struct EpiGen {
    static constexpr bool PERM = true, AFTER_DRAIN = false;
    bf16_t* O; int ldc; int split_cols; size_t split_stride; const bf16_t* G2;
    __device__ __forceinline__ static void unpack8(const u32x4 w, float (&f)[8]) {
        f[0] = bflo(w.x); f[1] = bfhi(w.x); f[2] = bflo(w.y); f[3] = bfhi(w.y); f[4] = bflo(w.z); f[5] = bfhi(w.z); f[6] = bflo(w.w); f[7] = bfhi(w.w);
    }
    __device__ __forceinline__ void operator()(const f32x4 (&acc)[2][2][4][2], const Unit& u, int wr, int wc, int fr, int fq) const {
        const int row0 = u.pm * BM + wr * 64 + fr; int colt = u.pn * BM; bf16_t* base = O; const bf16_t* g2 = G2;
        if (split_cols) { const int t = colt / split_cols; base += (size_t)t * split_stride; colt -= t * split_cols; }
#pragma unroll
        for (int ai = 0; ai < 2; ++ai)
#pragma unroll
            for (int m = 0; m < 4; ++m) {
                const int row = row0 + ai * HALF + m * 16;
                if constexpr (MODE == 4) {
                    const f32x4 g0 = acc[ai][0][m][0], g1 = acc[ai][0][m][1], u0 = acc[ai][1][m][0], u1 = acc[ai][1][m][1];
                    float r[8];
#pragma unroll
                    for (int e = 0; e < 4; ++e) { r[e] = siluf_e(g0[e]) * u0[e]; r[4 + e] = siluf_e(g1[e]) * u1[e]; }
                    u32x4 w; w.x = cvt_pk_bf16(r[0], r[1]); w.y = cvt_pk_bf16(r[2], r[3]); w.z = cvt_pk_bf16(r[4], r[5]); w.w = cvt_pk_bf16(r[6], r[7]);
                    *(u32x4*)(base + (size_t)row * ldc + u.pn * HALF + wc * 32 + 8 * fq) = w;
                } else {
#pragma unroll
                    for (int bj = 0; bj < 2; ++bj) {
                        const f32x4 v0 = acc[ai][bj][m][0], v1 = acc[ai][bj][m][1];
                        float r[8] = {v0[0], v0[1], v0[2], v0[3], v1[0], v1[1], v1[2], v1[3]};
                        bf16_t* p = base + (size_t)row * ldc + colt + bj * HALF + wc * 32 + 8 * fq;
                        if constexpr (MODE == 1) {
#pragma unroll
                            for (int e = 0; e < 8; ++e) r[e] = sigmoidf_e(r[e]);
                        }
                        if constexpr (MODE == 2) { float g[8]; unpack8(*(const u32x4*)p, g);
#pragma unroll
                            for (int e = 0; e < 8; ++e) r[e] = r[e] * g[e]; }
                        if constexpr (MODE == 3) { float g[8], o[8]; unpack8(*(const u32x4*)(g2 + (size_t)row * ldc + colt + bj * HALF + wc * 32 + 8 * fq), g); unpack8(*(const u32x4*)p, o);
#pragma unroll
                            for (int e = 0; e < 8; ++e) r[e] = o[e] + r[e] * g[e]; }
                        u32x4 w; w.x = cvt_pk_bf16(r[0], r[1]); w.y = cvt_pk_bf16(r[2], r[3]); w.z = cvt_pk_bf16(r[4], r[5]); w.w = cvt_pk_bf16(r[6], r[7]);
                        *(u32x4*)p = w;
                        if constexpr (MODE == 5) {
                            if (m == 3 && fr >= 13 && u.pn * BM < 3 * 1024) *(u32x4*)((bf16_t*)G2 + ((size_t)(row >> 6) * 3 + (fr - 13)) * 3072 + u.pn * BM + bj * HALF + wc * 32 + 8 * fq) = w; }
                    }
                }
            }
    }
};
struct EpiF32 {
    static constexpr bool PERM = false, AFTER_DRAIN = false;
    float* C; int ldc;
    __device__ __forceinline__ void operator()(const f32x4 (&acc)[2][2][4][2], const Unit& u, int wr, int wc, int fr, int fq) const {
        const int row0 = u.pm * BM + wr * 64 + fr, col0 = u.pn * BM + wc * 32 + 4 * fq;
#pragma unroll
        for (int ai = 0; ai < 2; ++ai)
#pragma unroll
            for (int m = 0; m < 4; ++m) { float* rowp = C + (size_t)(row0 + ai * HALF + m * 16) * ldc + col0;
#pragma unroll
                for (int bj = 0; bj < 2; ++bj)
#pragma unroll
                    for (int n = 0; n < 2; ++n) *(f32x4*)(rowp + bj * HALF + n * 16) = acc[ai][bj][m][n]; }
    }
};
struct PairOrder {
    StaticOrder so; int nblk, nN1;
    __host__ __device__ void init(int M, int N1, int nblk_, int G_, int c_) { so.init(M, N1, G_, c_); nblk = nblk_; nN1 = N1 / BM; }
    __host__ __device__ bool next(int i, Unit& u) const { if (!so.next(i / nblk, u)) return false; u.pn += (i % nblk) * nN1; return true; }
    __device__ __forceinline__ void a_ready(const Unit&) const {}
    __device__ __forceinline__ void done(const Unit&) const {}
};
}

struct Args { const float* in[16]; float* out; unsigned char* ws; int ph_lo, ph_hi, pass, pad; };
struct Frame {
    LAS unsigned char* lds;
    volatile LAS unsigned* MISC;
    int tid, lane, wave, G, gw, NGW;
    float* out; unsigned char* ws;
};
#define WSP(T, off) ((T*)(F.ws + (off)))
#define WSPF(T, off) ((T*)(Fp.ws + (off)))

struct WtItem { const float* src; bf16* dst; int ldw, K; };
__device__ __forceinline__ void tr_load(const WtItem& I, int lane, f32x4 (&v)[8]) {
#pragma unroll
    for (int i = 0; i < 8; ++i) v[i] = *(const f32x4*)(I.src + (size_t)((lane >> 3) + 8 * i) * I.ldw + 4 * (lane & 7));
}
__device__ __forceinline__ void tr_put(const f32x4 (&v)[8], LAS float* scr, int lane) {
#pragma unroll
    for (int i = 0; i < 8; ++i) { LAS float* s = scr + ((lane >> 3) + 8 * i) * 33 + 4 * (lane & 7); s[0] = v[i].x; s[1] = v[i].y; s[2] = v[i].z; s[3] = v[i].w; }
    LDS_WAIT(); asm volatile("" ::: "memory");
}
__device__ __forceinline__ void tr_out(const WtItem& I, const LAS float* scr, int lane) {
    const int c = lane & 7;
#pragma unroll
    for (int j = 0; j < 4; ++j) { const int n = (lane >> 3) + 8 * j; const LAS float* s = scr + (8 * c) * 33 + n;
        v4u o; o.x = pk2(s[0 * 33], s[1 * 33]); o.y = pk2(s[2 * 33], s[3 * 33]); o.z = pk2(s[4 * 33], s[5 * 33]); o.w = pk2(s[6 * 33], s[7 * 33]);
        *(GAS v4u*)(I.dst + (size_t)n * I.K + 8 * c) = o; }
    LDS_WAIT(); asm volatile("" ::: "memory");
}
__device__ __forceinline__ void rms_row_bf16(const float* xrow, const float* w, bf16* orow, int lane, f32x4 (&hv)[4]) {
    const f32x4* xr = (const f32x4*)xrow + lane; const f32x4* wr = (const f32x4*)w + lane;
    float ss = 0.f;
#pragma unroll
    for (int j = 0; j < 4; ++j) { hv[j] = xr[64 * j]; ss += (hv[j].x * hv[j].x + hv[j].y * hv[j].y) + (hv[j].z * hv[j].z + hv[j].w * hv[j].w); }
    const float rs = rsq_(wave_sum(ss) * (1.f / DM) + EPS);
    unsigned long long* o8 = (unsigned long long*)orow + lane;
#pragma unroll
    for (int j = 0; j < 4; ++j) { const f32x4 wv = wr[64 * j]; hv[j] = hv[j] * rs * wv;
        o8[64 * j] = (unsigned long long)pk2(hv[j].x, hv[j].y) | ((unsigned long long)pk2(hv[j].z, hv[j].w) << 32); }
}
__device__ __forceinline__ WtItem wt_decode(const Args& A, unsigned char* ws, int it) {
    constexpr int I_A = 16 * 96, I_B = 16 * 128, I_G = 16 * 64, I_O = 16 * 32, I_GU = 16 * 88;
    const float* w_in = A.in[2];
    int r = it; const float* W; int ldw, scol, nbn, K = DM, dmode = 0; size_t dst;
    if (r < I_A) { W = w_in; ldw = INTOT; scol = 0; nbn = 96; dst = WS_WTA; }
    else if ((r -= I_A) < I_B) { W = w_in; ldw = INTOT; scol = 3072; nbn = 128; dst = WS_WTB; }
    else if ((r -= I_B) < I_G) { W = w_in; ldw = INTOT; scol = 7184; nbn = 64; dst = WS_WTG; }
    else if ((r -= I_G) < I_O) { W = A.in[7]; ldw = DM; scol = 0; nbn = 32; dst = WS_WTOA; }
    else if ((r -= I_O) < I_O) { W = A.in[8]; ldw = DM; scol = 0; nbn = 32; dst = WS_WTOD; }
    else if ((r -= I_O) < I_O) { W = A.in[9]; ldw = DM; scol = 0; nbn = 32; dst = WS_WTOUT; }
    else if ((r -= I_O) < I_GU) { W = A.in[12]; ldw = DFF; scol = 0; nbn = 88; dst = WS_WTGU; dmode = 1; }
    else if ((r -= I_GU) < I_GU) { W = A.in[13]; ldw = DFF; scol = 0; nbn = 88; dst = WS_WTGU; dmode = 2; }
    else { r -= I_GU; W = A.in[14]; ldw = DM; scol = 0; nbn = 32; dst = WS_WTDN; K = DFF; }
    const int kb = r / nbn, nb = r % nbn, n0 = 32 * nb;
    const int drow0 = (dmode == 0) ? n0 : 256 * (n0 / 128) + (n0 % 128) + (dmode == 2 ? 128 : 0);
    WtItem I; I.src = W + (size_t)(64 * kb) * ldw + scol + n0; I.dst = (bf16*)(ws + dst) + (size_t)drow0 * K + 64 * kb; I.ldw = ldw; I.K = K; return I;
}
__device__ __forceinline__ void p_wtrans(Frame& F, const Args& A, int it0, int it1, int gw0, int ngw) {
    LAS float* scr = (LAS float*)(F.lds + RING_OFF + F.wave * 16384);
    int it = it0 + gw0; if (it >= it1) return;
    WtItem cur = wt_decode(A, F.ws, it); f32x4 v[8]; tr_load(cur, F.lane, v);
    for (;;) {
        const int itn = it + ngw; const bool more = itn < it1;
        tr_put(v, scr, F.lane);
        WtItem nxt = cur; if (more) { nxt = wt_decode(A, F.ws, itn); tr_load(nxt, F.lane, v); }
        tr_out(cur, scr, F.lane);
        if (!more) break;
        cur = nxt; it = itn;
    }
}
constexpr int WT_A_ITEMS = 2560;
constexpr int WT_ITEMS_EARLY = 16 * 96 + 16 * 128, WT_ITEMS_ALL = 16 * 96 + 16 * 128 + 16 * 64 + 3 * 16 * 32 + 2 * 16 * 88 + 44 * 32;
__device__ __forceinline__ void p_prologue(Frame& F, const Args& A) {
    const float* w_in = A.in[2];
#if DN2_LATE_WT
    p_wtrans(F, A, 0, WT_ITEMS_EARLY, F.gw, F.NGW);
#else
    p_wtrans(F, A, 0, WT_ITEMS_ALL, F.gw, F.NGW);
#endif
    { float* cosT = WSP(float, WS_COS); float* sinT = WSP(float, WS_SIN);
      for (int i = F.gw * 64 + F.lane; i < S * 16; i += F.NGW * 64) { const int pos = i >> 4, k = i & 15;
          const float inv = (float)pow(500000.0, -(double)k / 16.0); const float ang = (float)pos * inv;
          cosT[i] = cosf(ang); sinT[i] = sinf(ang); } }
    { const float* x = A.in[0]; bf16* H = WSP(bf16, WS_H); float* BA = WSP(float, WS_BA);
      constexpr int WP = 2064;
      LAS unsigned char* wimg = F.lds; LAS unsigned char* hl = F.lds + 36864 + F.wave * (4 * WP + 192);
      __syncthreads();
      { const int k8 = F.tid >> 2, c4 = 4 * (F.tid & 3); f32x4 wv[8];
#pragma unroll
        for (int i = 0; i < 8; ++i) wv[i] = *(const f32x4*)(w_in + (size_t)(8 * k8 + i) * INTOT + 7168 + c4);
#pragma unroll
        for (int c = 0; c < 4; ++c) { u32x4 o; o.x = pk2(wv[0][c], wv[1][c]); o.y = pk2(wv[2][c], wv[3][c]); o.z = pk2(wv[4][c], wv[5][c]); o.w = pk2(wv[6][c], wv[7][c]);
            *(LAS u32x4*)(wimg + (c4 + c) * WP + 16 * k8) = o; } }
      __syncthreads();
      const int r16 = F.lane & 15, g = F.lane >> 4;
      const LAS unsigned char* wrd = wimg + r16 * WP + 16 * g; const LAS unsigned char* hrd = hl + (r16 & 3) * WP + 16 * g;
      f32x4 nw[4];
#pragma unroll
      for (int j = 0; j < 4; ++j) nw[j] = ((const f32x4*)A.in[1])[F.lane + 64 * j];
      for (int m0 = F.gw; m0 < S; m0 += 4 * F.NGW) {
          f32x4 xv[4][4];
#pragma unroll
          for (int k = 0; k < 4; ++k) { const int m = m0 + k * F.NGW; const f32x4* xr = (const f32x4*)(x + (size_t)(m < S ? m : m0) * DM) + F.lane;
#pragma unroll
              for (int j = 0; j < 4; ++j) xv[k][j] = xr[64 * j]; }
#pragma unroll
          for (int k = 0; k < 4; ++k) { const int m = m0 + k * F.NGW; float ss = 0.f;
#pragma unroll
              for (int j = 0; j < 4; ++j) ss += (xv[k][j].x * xv[k][j].x + xv[k][j].y * xv[k][j].y) + (xv[k][j].z * xv[k][j].z + xv[k][j].w * xv[k][j].w);
              const float rs = rsq_(wave_sum(ss) * (1.f / DM) + EPS);
              unsigned long long* o8 = (unsigned long long*)(H + (size_t)m * DM) + F.lane;
#pragma unroll
              for (int j = 0; j < 4; ++j) { const f32x4 hv = xv[k][j] * rs * nw[j]; u32x2 p; p.x = pk2(hv.x, hv.y); p.y = pk2(hv.z, hv.w);
                  if (m < S) o8[64 * j] = (unsigned long long)p.x | ((unsigned long long)p.y << 32);
                  *(LAS u32x2*)(hl + k * WP + 8 * (F.lane + 64 * j)) = p; } }
          asm volatile("s_waitcnt lgkmcnt(0)" ::: "memory");
          f32x4 acc = {0.f, 0.f, 0.f, 0.f};
#pragma unroll 8
          for (int s = 0; s < 32; ++s) { const bf16x8 wf = *(const LAS bf16x8*)(wrd + 64 * s), hf = *(const LAS bf16x8*)(hrd + 64 * s);
              acc = __builtin_amdgcn_mfma_f32_16x16x32_bf16(wf, hf, acc, 0, 0, 0); }
          { const int m = m0 + r16 * F.NGW; if (r16 < 4 && m < S) *(f32x4*)(BA + (size_t)m * 16 + 4 * g) = acc; }
          asm volatile("s_waitcnt lgkmcnt(0)" ::: "memory");
      }
      __syncthreads(); }
}
__device__ __forceinline__ void p_hrecompute_sub(Frame& F, const Args& A, bf16* H, int gw0, int ngw) {
    const float* x = A.in[0];
    for (int m = gw0; m < S; m += ngw) { f32x4 hv[4]; rms_row_bf16(x + (size_t)m * DM, A.in[1], H + (size_t)m * DM, F.lane, hv); }
}
__device__ __forceinline__ void p_hrecompute(Frame& F, const Args& A) {
    const float* x = A.in[0]; bf16* H = WSP(bf16, WS_H);
    for (int m = F.gw; m < S; m += F.NGW) { f32x4 hv[4]; rms_row_bf16(x + (size_t)m * DM, A.in[1], H + (size_t)m * DM, F.lane, hv); }
}

__device__ __forceinline__ void p_kmean(Frame& F, const Args& A) {
    const bf16* KA = WSP(bf16, WS_R1 + T32); float* KM = WSP(float, WS_KMEAN);
    for (int it = F.gw; it < NBLK * NH; it += F.NGW) { const int blk = it >> 3, h = it & 7;
        float s0 = 0.f, s1 = 0.f; const bf16* p = KA + (size_t)(blk * MBLK) * DM + h * HD + 2 * F.lane;
#pragma unroll 32
        for (int r = 0; r < MBLK; ++r) { const unsigned v = *(const unsigned*)(p + (size_t)r * DM); s0 += bflo(v); s1 += bfhi(v); }
        KM[(size_t)it * HD + 2 * F.lane] = s0 * (1.f / MBLK); KM[(size_t)it * HD + 2 * F.lane + 1] = s1 * (1.f / MBLK); }
}
__device__ __forceinline__ void p_topk(Frame& F, const Args& A) {
    const bf16* QA = WSP(bf16, WS_R1); const float* KM = WSP(float, WS_KMEAN); int* TOPI = WSP(int, WS_TOPI);
    for (int it = F.gw; it < S * NH; it += F.NGW) { const int q = it >> 3, h = it & 7, qblk = q >> 8;
        float g = -INFINITY;
        if (F.lane < qblk) { const bf16* qp = QA + (size_t)q * DM + h * HD; const float* kp = KM + ((size_t)F.lane * NH + h) * HD; float a = 0.f;
#pragma unroll
            for (int c = 0; c < 16; ++c) { const u32x4 qv = *(const u32x4*)(qp + 8 * c); const f32x4 k0 = *(const f32x4*)(kp + 8 * c), k1 = *(const f32x4*)(kp + 8 * c + 4);
                a += bflo(qv.x) * k0.x + bfhi(qv.x) * k0.y + bflo(qv.y) * k0.z + bfhi(qv.y) * k0.w + bflo(qv.z) * k1.x + bfhi(qv.z) * k1.y + bflo(qv.w) * k1.z + bfhi(qv.w) * k1.w; }
            g = a; }
        int res = -1;
#pragma unroll
        for (int r = 0; r < 3; ++r) { float v = g; int i = F.lane;
#pragma unroll
            for (int o = 1; o < 64; o <<= 1) { const float ov = __shfl_xor(v, o); const int oi = __shfl_xor(i, o); if (ov > v || (ov == v && oi < i)) { v = ov; i = oi; } }
            if (F.lane == r) res = (r < qblk) ? i : -1;
            if (F.lane == i) g = -INFINITY; }
        if (F.lane < 3) TOPI[(size_t)it * 3 + F.lane] = res; }
}
__device__ __forceinline__ void p_attn_naive(Frame& F, const Args& A) {
    const bf16* QA = WSP(bf16, WS_R1); const bf16* KA = WSP(bf16, WS_R1 + T32); const bf16* VA = WSP(bf16, WS_R1 + 2 * T32); const int* TOPI = WSP(int, WS_TOPI);
#ifdef DBG_ATTN
    bf16* YA = (bf16*)F.out;
#else
    bf16* YA = WSP(bf16, WS_YA);
#endif
    for (int it = F.gw; it < S * NH; it += F.NGW) { const int q = it >> 3, h = it & 7, qblk = q >> 8;
        const bf16* qp = QA + (size_t)q * DM + h * HD;
        float m = -INFINITY, l = 0.f, o0 = 0.f, o1 = 0.f;
        for (int slot = 0; slot < 4; ++slot) {
            int kb = qblk; if (slot < 3) { kb = TOPI[(size_t)it * 3 + slot]; if (kb < 0) continue; }
            const bf16* kp = KA + (size_t)(kb * MBLK) * DM + h * HD; const bf16* vp = VA + (size_t)(kb * MBLK) * DM + h * HD;
            float s[4] = {0.f, 0.f, 0.f, 0.f};
#pragma unroll 4
            for (int c = 0; c < 16; ++c) { const u32x4 qv = *(const u32x4*)(qp + 8 * c);
                const float q0 = bflo(qv.x), q1 = bfhi(qv.x), q2 = bflo(qv.y), q3 = bfhi(qv.y), q4 = bflo(qv.z), q5 = bfhi(qv.z), q6 = bflo(qv.w), q7 = bfhi(qv.w);
#pragma unroll
                for (int jj = 0; jj < 4; ++jj) { const u32x4 kv = *(const u32x4*)(kp + (size_t)(F.lane + 64 * jj) * DM + 8 * c);
                    s[jj] += q0 * bflo(kv.x) + q1 * bfhi(kv.x) + q2 * bflo(kv.y) + q3 * bfhi(kv.y) + q4 * bflo(kv.z) + q5 * bfhi(kv.z) + q6 * bflo(kv.w) + q7 * bfhi(kv.w); } }
            float mx = -INFINITY;
#pragma unroll
            for (int jj = 0; jj < 4; ++jj) { s[jj] *= 0.08838834764831845f; if (slot == 3 && (kb * MBLK + F.lane + 64 * jj) > q) s[jj] = -INFINITY; mx = fmaxf(mx, s[jj]); }
            mx = wave_max(mx);
            const float mn = fmaxf(m, mx), sc = __expf(m - mn);
            float p[4], ps = 0.f;
#pragma unroll
            for (int jj = 0; jj < 4; ++jj) { p[jj] = __expf(s[jj] - mn); ps += p[jj]; }
            l = l * sc + wave_sum(ps); o0 *= sc; o1 *= sc; m = mn;
#pragma unroll
            for (int jj = 0; jj < 4; ++jj)
                for (int ln = 0; ln < 64; ++ln) { const float pj = __shfl(p[jj], ln); const unsigned vv = *(const unsigned*)(vp + (size_t)(ln + 64 * jj) * DM + 2 * F.lane); o0 += pj * bflo(vv); o1 += pj * bfhi(vv); }
        }
        const float il = 1.f / l;
        *(unsigned*)(YA + (size_t)q * DM + h * HD + 2 * F.lane) = pk2(o0 * il, o1 * il); }
}


typedef float f32x16 __attribute__((ext_vector_type(16)));
typedef short s16x4 __attribute__((ext_vector_type(4)));
typedef float f32x2_t __attribute__((ext_vector_type(2)));
typedef __bf16 bf16x2_t __attribute__((ext_vector_type(2)));
constexpr size_t WS_BUCKET = 241 * MiB, WS_ML = 249 * MiB, WS_OP2 = WS_Z;
constexpr int BUCKET_PER_HEAD = 256 * 2016;
constexpr int CW_CNT = 16384;
static_assert(WS_BUCKET + (size_t)NH * BUCKET_PER_HEAD * 2 <= WS_ML && WS_ML + (size_t)3 * S * NH * 8 <= WS_END, "bucket map");
constexpr float SM_C = 0.08838834764831845f * 1.4426950408889634f;

__device__ __forceinline__ int bucket_off(int kb) { return 256 * (63 * kb - (kb * (kb - 1)) / 2); }
__device__ __forceinline__ unsigned attn_off(unsigned row, unsigned ch) { return 256u * row + 16u * (ch ^ (((row & 3u) << 2) | ((row >> 2) & 3u))); }
__device__ __forceinline__ unsigned cvtpk(float lo, float hi) { f32x2_t v = {lo, hi}; bf16x2_t b = __builtin_convertvector(v, bf16x2_t); return __builtin_bit_cast(unsigned, b); }
__device__ __forceinline__ s16x4 vtr16(const LAS unsigned char* p) { typedef short v4i16_t __attribute__((ext_vector_type(4))); return __builtin_bit_cast(s16x4, __builtin_amdgcn_ds_read_tr16_b64_v4i16((LAS v4i16_t*)p)); }

__device__ __forceinline__ void unpack8f(const bf16x8 v, float (&f)[8]) { const u32x4 w = __builtin_bit_cast(u32x4, v);
    f[0] = bflo(w.x); f[1] = bfhi(w.x); f[2] = bflo(w.y); f[3] = bfhi(w.y); f[4] = bflo(w.z); f[5] = bfhi(w.z); f[6] = bflo(w.w); f[7] = bfhi(w.w); }
__device__ __forceinline__ bf16x8 pack8f(const float (&f)[8]) { u32x4 w; w.x = cvtpk(f[0], f[1]); w.y = cvtpk(f[2], f[3]); w.z = cvtpk(f[4], f[5]); w.w = cvtpk(f[6], f[7]); return __builtin_bit_cast(bf16x8, w); }

__device__ __forceinline__ void attn_stage(const bf16* src, LAS unsigned char* img, int tid) {
#pragma unroll
    for (int i = 0; i < 8; ++i) { const int n = tid + 512 * i, row = n >> 4, ch = n & 15;
        const u32x4 v = *(const u32x4*)(src + (size_t)row * DM + 8 * ch); *(LAS u32x4*)(img + attn_off(row, ch)) = v; }
}
struct AttnState { float m, l; f32x16 o[4]; };
__device__ __forceinline__ float half_max(float v) { const auto t = __builtin_amdgcn_permlane32_swap(__builtin_bit_cast(unsigned, v), __builtin_bit_cast(unsigned, v), false, false); return fmaxf(__builtin_bit_cast(float, t[0]), __builtin_bit_cast(float, t[1])); }
__device__ __forceinline__ float half_sum(float v) { const auto t = __builtin_amdgcn_permlane32_swap(__builtin_bit_cast(unsigned, v), __builtin_bit_cast(unsigned, v), false, false); return __builtin_bit_cast(float, t[0]) + __builtin_bit_cast(float, t[1]); }
template <int NT> __device__ __forceinline__ void attn_wave(const bf16x8 (&qf)[8], const LAS unsigned char* Kimg, const LAS unsigned char* Vimg, int nt, int diag, int lane, AttnState& st) {
    const int r = lane & 31, hh = lane >> 5, blk = (lane >> 4) & 1, q4 = (lane & 15) >> 2, p4 = lane & 3;
    const LAS unsigned char* kad[8];
#pragma unroll
    for (int ks = 0; ks < 8; ++ks) kad[ks] = Kimg + attn_off(r, 2 * ks + hh);
    const LAS unsigned char* vad[4][4];
#pragma unroll
    for (int i = 0; i < 4; ++i) { const unsigned rl = 16u * (i >> 1) + 8u * (i & 1) + 4u * hh + q4, x = ((rl & 3u) << 2) | ((rl >> 2) & 3u), cb = 2u * blk + (p4 >> 1);
#pragma unroll
        for (int c = 0; c < 4; ++c) vad[i][c] = Vimg + 256u * rl + 16u * (cb ^ (x & 3u)) + 8u * (p4 & 1) + 64u * ((unsigned)c ^ (x >> 2)); }
    st.m = -INFINITY; st.l = 0.f;
#pragma unroll
    for (int c = 0; c < 4; ++c)
#pragma unroll
        for (int i = 0; i < 16; ++i) st.o[c][i] = 0.f;
    auto tile = [&](const int kt) __attribute__((always_inline)) {
        f32x16 s;
#pragma unroll
        for (int i = 0; i < 16; ++i) s[i] = 0.f;
#pragma unroll
        for (int ks = 0; ks < 8; ++ks) { const bf16x8 kf = *(const LAS bf16x8*)(kad[ks] + kt * 8192); s = __builtin_amdgcn_mfma_f32_32x32x16_bf16(kf, qf[ks], s, 0, 0, 0); }
        float tmax = -INFINITY;
#pragma unroll
        for (int i = 0; i < 16; ++i) { if (kt == diag && ((i & 3) + 8 * (i >> 2) + 4 * hh) > r) s[i] = -INFINITY; tmax = fmaxf(tmax, s[i]); }
        tmax = fmaxf(tmax, __shfl_xor(tmax, 32)) * SM_C;
        if (!(tmax - st.m <= 8.f)) { const float mn = fmaxf(st.m, tmax), alpha = __builtin_amdgcn_exp2f(st.m - mn); st.l *= alpha; st.m = mn;
#pragma unroll
            for (int c = 0; c < 4; ++c)
#pragma unroll
                for (int i = 0; i < 16; ++i) st.o[c][i] *= alpha; }
        float rs = 0.f; const float nm = -st.m;
#pragma unroll
        for (int i = 0; i < 16; ++i) { s[i] = __builtin_amdgcn_exp2f(__builtin_fmaf(s[i], SM_C, nm)); rs += s[i]; }
        st.l += rs + __shfl_xor(rs, 32);
#pragma unroll
        for (int sp = 0; sp < 2; ++sp) {
            u32x4 pw; pw.x = cvtpk(s[8 * sp], s[8 * sp + 1]); pw.y = cvtpk(s[8 * sp + 2], s[8 * sp + 3]); pw.z = cvtpk(s[8 * sp + 4], s[8 * sp + 5]); pw.w = cvtpk(s[8 * sp + 6], s[8 * sp + 7]);
            const bf16x8 pf = __builtin_bit_cast(bf16x8, pw);
#pragma unroll
            for (int c = 0; c < 4; ++c) {
                const s16x4 lo = vtr16(vad[2 * sp][c] + kt * 8192);
                const s16x4 hi = vtr16(vad[2 * sp + 1][c] + kt * 8192);
                const bf16x8 vf = __builtin_shufflevector(lo, hi, 0, 1, 2, 3, 4, 5, 6, 7);
                st.o[c] = __builtin_amdgcn_mfma_f32_32x32x16_bf16(vf, pf, st.o[c], 0, 0, 0);
            }
        }
    };
    if constexpr (NT > 0) {
#pragma unroll
        for (int kt = 0; kt < NT; ++kt) tile(kt);
    } else { for (int kt = 0; kt < nt; ++kt) tile(kt); }
}
__device__ __forceinline__ void p_topk_bucket(Frame& F, const Args& A) {
    const bf16* QA = WSP(bf16, WS_R1); const float* KM = WSP(float, WS_KMEAN); int* TOPI = WSP(int, WS_TOPI);
    unsigned* CNT = WSP(unsigned, WS_CTL) + CW_CNT; unsigned short* BUCKET = WSP(unsigned short, WS_BUCKET); f32x2_t* ML = WSP(f32x2_t, WS_ML);
    for (int it = F.gw; it < S * NH; it += F.NGW) { const int q = it >> 3, h = it & 7, qblk = q >> 8;
        float g = -INFINITY;
        if (F.lane < qblk) { const bf16* qp = QA + (size_t)q * DM + h * HD; const float* kp = KM + ((size_t)F.lane * NH + h) * HD; float a = 0.f;
#pragma unroll
            for (int c = 0; c < 16; ++c) { const u32x4 qv = *(const u32x4*)(qp + 8 * c); const f32x4 k0 = *(const f32x4*)(kp + 8 * c), k1 = *(const f32x4*)(kp + 8 * c + 4);
                a += bflo(qv.x) * k0.x + bfhi(qv.x) * k0.y + bflo(qv.y) * k0.z + bfhi(qv.y) * k0.w + bflo(qv.z) * k1.x + bfhi(qv.z) * k1.y + bflo(qv.w) * k1.z + bfhi(qv.w) * k1.w; }
            g = a; }
        int res = -1;
#pragma unroll
        for (int r = 0; r < 3; ++r) { float v = g; int i = F.lane;
#pragma unroll
            for (int o = 1; o < 64; o <<= 1) { const float ov = __shfl_xor(v, o); const int oi = __shfl_xor(i, o); if (ov > v || (ov == v && oi < i)) { v = ov; i = oi; } }
            if (F.lane == r) res = (r < qblk) ? i : -1;
            if (F.lane == i) g = -INFINITY; }
        if (F.lane < 3) { TOPI[(size_t)it * 3 + F.lane] = res;
            if (res >= 0) { const unsigned pos = __hip_atomic_fetch_add(CNT + h * NBLK + res, 1u, __ATOMIC_RELAXED, __HIP_MEMORY_SCOPE_AGENT);
                BUCKET[(size_t)h * BUCKET_PER_HEAD + bucket_off(res) + pos] = (unsigned short)((q << 2) | F.lane); }
            else ML[((size_t)F.lane * S + q) * NH + h] = (f32x2_t){-INFINITY, 0.f}; } }
}

__device__ __forceinline__ void p_topk2(Frame& F, const Args& A) {
    const bf16* QA = WSP(bf16, WS_R1); const float* KP = WSP(const float, WS_KMEAN);
    unsigned* CNT = WSP(unsigned, WS_CTL) + CW_CNT; unsigned short* BUCKET = WSP(unsigned short, WS_BUCKET); f32x2_t* ML = WSP(f32x2_t, WS_ML);
    LAS unsigned char* Kimg = F.lds;
    LAS int* lcnt = (LAS int*)(F.lds + 16384); LAS int* lbase = lcnt + 64;
    const int lane = F.lane, r = lane & 31, hh = lane >> 5;
    for (int u = blockIdx.x; u < NBLK * NH; u += F.G) { const int qblk = u >> 3, h = u & 7, q = qblk * MBLK + 32 * F.wave + r;
        __syncthreads();
        { const int n = F.tid >> 3, c = F.tid & 7; const float* p0 = KP + ((size_t)(n * 2) * NH + h) * HD + 16 * c; const float* p1 = p0 + (size_t)NH * HD;
#pragma unroll
          for (int half = 0; half < 2; ++half) { const f32x4 a0 = *(const f32x4*)(p0 + 8 * half), a1 = *(const f32x4*)(p0 + 8 * half + 4), c0 = *(const f32x4*)(p1 + 8 * half), c1 = *(const f32x4*)(p1 + 8 * half + 4);
              float f[8] = {(a0.x + c0.x) * (1.f / MBLK), (a0.y + c0.y) * (1.f / MBLK), (a0.z + c0.z) * (1.f / MBLK), (a0.w + c0.w) * (1.f / MBLK), (a1.x + c1.x) * (1.f / MBLK), (a1.y + c1.y) * (1.f / MBLK), (a1.z + c1.z) * (1.f / MBLK), (a1.w + c1.w) * (1.f / MBLK)};
              *(LAS bf16x8*)(Kimg + attn_off(n, 2 * c + half)) = pack8f(f); } }
        if (F.tid < 64) lcnt[F.tid] = 0;
        __syncthreads();
        float bv[3] = {-INFINITY, -INFINITY, -INFINITY}; int bi[3] = {0, 0, 0};
        if (qblk > 0) {
            bf16x8 qf[8];
#pragma unroll
            for (int ks = 0; ks < 8; ++ks) qf[ks] = *(const bf16x8*)(QA + (size_t)q * DM + h * HD + 16 * ks + 8 * hh);
            const int nt = (qblk > 32) ? 2 : 1;
            for (int tn = 0; tn < nt; ++tn) {
                f32x16 acc;
#pragma unroll
                for (int i = 0; i < 16; ++i) acc[i] = 0.f;
#pragma unroll
                for (int ks = 0; ks < 8; ++ks) { const bf16x8 kf = *(const LAS bf16x8*)(Kimg + attn_off(32 * tn + r, 2 * ks + hh)); acc = __builtin_amdgcn_mfma_f32_32x32x16_bf16(kf, qf[ks], acc, 0, 0, 0); }
#pragma unroll
                for (int i = 0; i < 16; ++i) { const int n = 32 * tn + (i & 3) + 8 * (i >> 2) + 4 * hh; const float v = (n < qblk) ? acc[i] : -INFINITY;
                    const bool g0 = v > bv[0], g1 = v > bv[1], g2 = v > bv[2];
                    bv[2] = g1 ? bv[1] : (g2 ? v : bv[2]); bi[2] = g1 ? bi[1] : (g2 ? n : bi[2]);
                    bv[1] = g0 ? bv[0] : (g1 ? v : bv[1]); bi[1] = g0 ? bi[0] : (g1 ? n : bi[1]);
                    bv[0] = g0 ? v : bv[0]; bi[0] = g0 ? n : bi[0]; }
            }
            float ov[3]; int oi[3];
#pragma unroll
            for (int k = 0; k < 3; ++k) { ov[k] = __shfl_xor(bv[k], 32); oi[k] = __shfl_xor(bi[k], 32); }
#pragma unroll
            for (int k = 0; k < 3; ++k) { const float v = ov[k]; const int n = oi[k];
#define TK_GT(v_, n_, w_, m_) ((v_) > (w_) || ((v_) == (w_) && (n_) < (m_)))
                const bool ok = v > -INFINITY, g0 = ok && TK_GT(v, n, bv[0], bi[0]), g1 = ok && TK_GT(v, n, bv[1], bi[1]), g2 = ok && TK_GT(v, n, bv[2], bi[2]);
                bv[2] = g1 ? bv[1] : (g2 ? v : bv[2]); bi[2] = g1 ? bi[1] : (g2 ? n : bi[2]);
                bv[1] = g0 ? bv[0] : (g1 ? v : bv[1]); bi[1] = g0 ? bi[0] : (g1 ? n : bi[1]);
                bv[0] = g0 ? v : bv[0]; bi[0] = g0 ? n : bi[0]; }
        }
        int rank[3] = {0, 0, 0}; bool valid[3];
#pragma unroll
        for (int k = 0; k < 3; ++k) { valid[k] = (hh == 0) && (k < qblk) && (bv[k] > -INFINITY);
            if (valid[k]) rank[k] = __hip_atomic_fetch_add(lcnt + bi[k], 1, __ATOMIC_RELAXED, __HIP_MEMORY_SCOPE_WORKGROUP);
            else if (hh == 0) ML[((size_t)k * S + q) * NH + h] = (f32x2_t){-INFINITY, 0.f}; }
        __syncthreads();
        if (F.tid < 64) { const int c = lcnt[F.tid]; if (c > 0) lbase[F.tid] = (int)__hip_atomic_fetch_add(CNT + h * NBLK + F.tid, (unsigned)c, __ATOMIC_RELAXED, __HIP_MEMORY_SCOPE_AGENT); }
        __syncthreads();
#pragma unroll
        for (int k = 0; k < 3; ++k) if (valid[k]) BUCKET[(size_t)h * BUCKET_PER_HEAD + bucket_off(bi[k]) + lbase[bi[k]] + rank[k]] = (unsigned short)((q << 2) | k);
    }
    __syncthreads();
}
__device__ __forceinline__ bf16* op_slot(Frame& F, int r) { return r < 2 ? (bf16*)F.out + (size_t)r * S * DM : WSP(bf16, WS_OP2); }
__device__ __forceinline__ void p_attn_sel(Frame& F, const Args& A) {
    const bf16* QA = WSP(bf16, WS_R1); const bf16* KA = WSP(bf16, WS_R1 + T32); const bf16* VA = WSP(bf16, WS_R1 + 2 * T32);
    const unsigned* CNT = WSP(const unsigned, WS_CTL) + CW_CNT; const unsigned short* BUCKET = WSP(const unsigned short, WS_BUCKET); f32x2_t* ML = WSP(f32x2_t, WS_ML);
    LAS unsigned char* Kimg = F.lds; LAS unsigned char* Vimg = F.lds + 65536; LAS int* pre = (LAS int*)(F.lds + LDSCTL_OFF + 1024);
    constexpr int AS_UW = 4, AS_SW = 3;
    LAS int* prew = (LAS int*)(F.lds + 131072);
    __syncthreads();
    { const int nb = (int)((CNT[F.tid] + 255u) >> 8), wb = nb ? AS_SW + AS_UW * nb : 0;
      int inc = nb, incw = wb;
#pragma unroll
      for (int o = 1; o < 64; o <<= 1) { const int v = __shfl_up(inc, o), vw = __shfl_up(incw, o); if (F.lane >= o) { inc += v; incw += vw; } }
      LAS int* wtot = pre + 520;
      if (F.lane == 63) { wtot[F.wave] = inc; wtot[8 + F.wave] = incw; }
      __syncthreads();
      int base = 0, basew = 0;
#pragma unroll
      for (int w = 0; w < NWAVES; ++w) { base += (w < F.wave) ? wtot[w] : 0; basew += (w < F.wave) ? wtot[8 + w] : 0; }
      pre[F.tid] = base + inc - nb; prew[F.tid] = basew + incw - wb;
      if (F.tid == NWAVES * 64 - 1) { pre[NH * NBLK] = base + inc; prew[NH * NBLK] = basew + incw; } }
    __syncthreads();
    const int totalw = prew[NH * NBLK];
    auto first_unit = [&](const int x) __attribute__((always_inline)) -> int {
        int lo = 0, hi = NH * NBLK - 1; while (lo < hi) { const int mid = (lo + hi + 1) >> 1; if (prew[mid] <= x) lo = mid; else hi = mid - 1; }
        const int nbl = pre[lo + 1] - pre[lo], d = x - prew[lo];
        int j = 0; if (d > 0) { j = (d - AS_SW + AS_UW - 1) / AS_UW; j = j < 1 ? 1 : j; j = j > nbl ? nbl : j; }
        return pre[lo] + j; };
#define AS_DECODE(u_, h_, kb_, b_, cnt_) do { int lo_ = 0, hi_ = NH * NBLK - 1; while (lo_ < hi_) { const int mid_ = (lo_ + hi_ + 1) >> 1; if (pre[mid_] <= (u_)) lo_ = mid_; else hi_ = mid_ - 1; } \
        h_ = lo_ >> 6; kb_ = lo_ & 63; b_ = (u_) - pre[lo_]; cnt_ = (int)CNT[lo_]; } while (0)
    const int hh = F.lane >> 5;
    bf16x8 qf[8];
    const int u1 = first_unit((int)(((long long)(blockIdx.x + 1) * totalw) / F.G)); int hs = -1, kbs = -1;
    int u = first_unit((int)(((long long)blockIdx.x * totalw) / F.G)), h = 0, kb = 0, b = 0, cnt = 0, q = 0, r = 0; bool valid = false;
    if (u < u1) { AS_DECODE(u, h, kb, b, cnt);
        const int e = 256 * b + 32 * F.wave + (F.lane & 31); valid = e < cnt;
        const unsigned ent = BUCKET[(size_t)h * BUCKET_PER_HEAD + bucket_off(kb) + (valid ? e : 256 * b)]; q = (int)(ent >> 2); r = (int)(ent & 3u);
#pragma unroll
        for (int ks = 0; ks < 8; ++ks) qf[ks] = *(const bf16x8*)(QA + (size_t)q * DM + h * HD + 16 * ks + 8 * hh); }
    while (u < u1) {
        if (h != hs || kb != kbs) {
            __syncthreads();
            attn_stage(KA + (size_t)(kb * MBLK) * DM + h * HD, Kimg, F.tid); attn_stage(VA + (size_t)(kb * MBLK) * DM + h * HD, Vimg, F.tid);
            __syncthreads(); hs = h; kbs = kb; }
        const int un = u + 1; int hn = 0, kbn = 0, bn = 0, cntn = 0; unsigned entn = 0u; bool validn = false;
        if (un < u1) { AS_DECODE(un, hn, kbn, bn, cntn);
            const int e = 256 * bn + 32 * F.wave + (F.lane & 31); validn = e < cntn;
            entn = BUCKET[(size_t)hn * BUCKET_PER_HEAD + bucket_off(kbn) + (validn ? e : 256 * bn)]; }
        AttnState st; if (__ballot(valid) != 0ull) attn_wave<8>(qf, Kimg, Vimg, 8, -1, F.lane, st);
        const int qc = q, rc = r, hc = h; const bool vc = valid;
        if (un < u1) { q = (int)(entn >> 2); r = (int)(entn & 3u); h = hn; kb = kbn; valid = validn;
#pragma unroll
            for (int ks = 0; ks < 8; ++ks) qf[ks] = *(const bf16x8*)(QA + (size_t)q * DM + h * HD + 16 * ks + 8 * hh); }
        if (vc) {
            bf16* op = op_slot(F, rc) + (size_t)qc * DM + hc * HD + 64 * hh;
#pragma unroll
            for (int c = 0; c < 4; ++c)
#pragma unroll
                for (int g2 = 0; g2 < 2; ++g2) { u32x4 w; w.x = cvtpk(st.o[c][8 * g2], st.o[c][8 * g2 + 1]); w.y = cvtpk(st.o[c][8 * g2 + 2], st.o[c][8 * g2 + 3]); w.z = cvtpk(st.o[c][8 * g2 + 4], st.o[c][8 * g2 + 5]); w.w = cvtpk(st.o[c][8 * g2 + 6], st.o[c][8 * g2 + 7]);
                    *(u32x4*)(op + 16 * c + 8 * g2) = w; }
            if (hh == 0) ML[((size_t)rc * S + qc) * NH + hc] = (f32x2_t){st.m, st.l}; }
        u = un;
    }
    __syncthreads();
}
__device__ __forceinline__ void p_attn_own(Frame& F, const Args& A) {
    const bf16* QA = WSP(bf16, WS_R1); const bf16* KA = WSP(bf16, WS_R1 + T32); const bf16* VA = WSP(bf16, WS_R1 + 2 * T32); const f32x2_t* ML = WSP(const f32x2_t, WS_ML); bf16* YA = WSP(bf16, WS_YA);
    LAS unsigned char* Kimg = F.lds; LAS unsigned char* Vimg = F.lds + 65536;
    for (int u = blockIdx.x; u < NH * NBLK; u += F.G) { const int h = u & 7, qb = u >> 3;
        __syncthreads();
        attn_stage(KA + (size_t)(qb * MBLK) * DM + h * HD, Kimg, F.tid); attn_stage(VA + (size_t)(qb * MBLK) * DM + h * HD, Vimg, F.tid);
        __syncthreads();
        const int q = qb * MBLK + 32 * F.wave + (F.lane & 31), hh = F.lane >> 5;
        bf16x8 qf[8];
#pragma unroll
        for (int ks = 0; ks < 8; ++ks) qf[ks] = *(const bf16x8*)(QA + (size_t)q * DM + h * HD + 16 * ks + 8 * hh);
        AttnState st; attn_wave<0>(qf, Kimg, Vimg, F.wave + 1, F.wave, F.lane, st);
        float mr[3], lr[3], M = st.m;
#pragma unroll
        for (int r = 0; r < 3; ++r) { const f32x2_t ml = ML[((size_t)r * S + q) * NH + h]; mr[r] = ml.x; lr[r] = ml.y; M = fmaxf(M, ml.x); }
        const float w0 = __builtin_amdgcn_exp2f(st.m - M); float L = st.l * w0; float wr[3];
#pragma unroll
        for (int r = 0; r < 3; ++r) { wr[r] = (lr[r] > 0.f) ? __builtin_amdgcn_exp2f(mr[r] - M) : 0.f; L += lr[r] * wr[r]; }
        const float iL = rcp_(L);
        const size_t pbase = (size_t)q * DM + h * HD + 64 * hh;
        const bf16* ps0 = op_slot(F, 0) + pbase; const bf16* ps1 = op_slot(F, 1) + pbase; const bf16* ps2 = op_slot(F, 2) + pbase;
#pragma unroll
        for (int half = 0; half < 2; ++half) {
            bf16x8 pl[4][3];
#pragma unroll
            for (int k = 0; k < 4; ++k) { pl[k][0] = *(const bf16x8*)(ps0 + 32 * half + 8 * k); pl[k][1] = *(const bf16x8*)(ps1 + 32 * half + 8 * k); pl[k][2] = *(const bf16x8*)(ps2 + 32 * half + 8 * k); }
            __builtin_amdgcn_sched_barrier(0);
#pragma unroll
            for (int k = 0; k < 4; ++k) { const int c = 2 * half + (k >> 1), g2 = k & 1;
                float v[8];
#pragma unroll
                for (int e = 0; e < 8; ++e) v[e] = st.o[c][8 * g2 + e] * w0;
#pragma unroll
                for (int r = 0; r < 3; ++r) { float pf[8]; unpack8f(pl[k][r], pf); const bool on = wr[r] != 0.f;
#pragma unroll
                    for (int e = 0; e < 8; ++e) v[e] += on ? wr[r] * pf[e] : 0.f; }
                u32x2 wa, wb; wa.x = cvtpk(v[0] * iL, v[1] * iL); wa.y = cvtpk(v[2] * iL, v[3] * iL); wb.x = cvtpk(v[4] * iL, v[5] * iL); wb.y = cvtpk(v[6] * iL, v[7] * iL);
                bf16* yp = YA + (size_t)q * DM + h * HD + 32 * c + 16 * g2 + 4 * hh; *(u32x2*)yp = wa; *(u32x2*)(yp + 8) = wb; }
        }
    }
    __syncthreads();
}
__device__ __forceinline__ void p_dn_conv(Frame& F, const Args& A) {
    const bf16* QB = WSP(bf16, WS_R1); const bf16* KB = WSP(bf16, WS_R1 + T32); const bf16* VB = WSP(bf16, WS_R1 + 2 * T32);
    bf16* QN = (bf16*)F.out; bf16* KN = (bf16*)F.out + (size_t)S * DM; bf16* VN = WSP(bf16, WS_VN);
    const float* cw = A.in[3]; const float* BA = WSP(const float, WS_BA); float* BETA = WSP(float, WS_BETA); float* G = WSP(float, WS_G);
    for (int it = F.gw; it < S * NH; it += F.NGW) { const int t = it >> 3, h = it & 7, c = h * HD + 2 * F.lane;
        float aq0 = 0.f, aq1 = 0.f, ak0 = 0.f, ak1 = 0.f, av0 = 0.f, av1 = 0.f;
#pragma unroll
        for (int j = 0; j < 4; ++j) { const int tt = t + j - 3; if (tt < 0) continue;
            const unsigned xq = *(const unsigned*)(QB + (size_t)tt * DM + c), xk = *(const unsigned*)(KB + (size_t)tt * DM + c), xv = *(const unsigned*)(VB + (size_t)tt * DM + c);
            const float* w = cw + (size_t)j * 3072;
            aq0 += w[c] * bflo(xq); aq1 += w[c + 1] * bfhi(xq); ak0 += w[1024 + c] * bflo(xk); ak1 += w[1024 + c + 1] * bfhi(xk); av0 += w[2048 + c] * bflo(xv); av1 += w[2048 + c + 1] * bfhi(xv); }
        aq0 = siluf_(aq0); aq1 = siluf_(aq1); ak0 = siluf_(ak0); ak1 = siluf_(ak1); av0 = siluf_(av0); av1 = siluf_(av1);
        const float rq = rsq_(wave_sum(aq0 * aq0 + aq1 * aq1) + EPS) * 0.08838834764831845f, rk = rsq_(wave_sum(ak0 * ak0 + ak1 * ak1) + EPS);
        *(unsigned*)(QN + (size_t)t * DM + c) = pk2(aq0 * rq, aq1 * rq); *(unsigned*)(KN + (size_t)t * DM + c) = pk2(ak0 * rk, ak1 * rk); *(unsigned*)(VN + (size_t)t * DM + c) = pk2(av0, av1);
        if (F.lane == 0) { const float b = BA[(size_t)t * 16 + h], a = BA[(size_t)t * 16 + 8 + h] + A.in[5][h];
            const float sp = (a > 20.f) ? a : log1pf(expf(a));
            BETA[(size_t)t * 8 + h] = 1.f / (1.f + expf(-b)); G[(size_t)t * 8 + h] = -expf(A.in[4][h]) * sp; } }
}
__device__ __forceinline__ void p_dn_chunk(Frame& F, const Args& A) {
    const bf16* QN = (const bf16*)F.out; const bf16* KN = (const bf16*)F.out + (size_t)S * DM; bf16* VU = WSP(bf16, WS_VN); bf16* Wb = WSP(bf16, WS_W); bf16* ATT = WSP(bf16, WS_ATT);
    const float* BETA = WSP(const float, WS_BETA); const float* G = WSP(const float, WS_G); float* GC = WSP(float, WS_GC);
    LAS float* Kc = (LAS float*)(F.lds); LAS float* Qc = Kc + 64 * 132; LAS float* Lm = Qc + 64 * 132; LAS float* Tm = Lm + 64 * 65; LAS float* gcs = Tm + 64 * 65; LAS float* bes = gcs + 64; LAS float* bge = bes + 64;
    const int tid = F.tid;
    for (int item = blockIdx.x; item < NCH * NH; item += F.G) { const int n = item >> 3, h = item & 7, t0 = n * CH;
        __syncthreads();
        if (tid < 64) { gcs[tid] = G[(size_t)(t0 + tid) * 8 + h]; bes[tid] = BETA[(size_t)(t0 + tid) * 8 + h]; }
        __syncthreads();
        if (tid == 0) { float a = 0.f; for (int i = 0; i < 64; ++i) { a += gcs[i]; gcs[i] = a; } }
#pragma unroll
        for (int r = 0; r < 2; ++r) { const int idx = tid + 512 * r, row = idx >> 4, c8 = idx & 15;
            const u32x4 kv = *(const u32x4*)(KN + (size_t)(t0 + row) * DM + h * HD + 8 * c8), qv = *(const u32x4*)(QN + (size_t)(t0 + row) * DM + h * HD + 8 * c8);
            LAS float* kd = Kc + row * 132 + 8 * c8; LAS float* qd = Qc + row * 132 + 8 * c8;
            kd[0] = bflo(kv.x); kd[1] = bfhi(kv.x); kd[2] = bflo(kv.y); kd[3] = bfhi(kv.y); kd[4] = bflo(kv.z); kd[5] = bfhi(kv.z); kd[6] = bflo(kv.w); kd[7] = bfhi(kv.w);
            qd[0] = bflo(qv.x); qd[1] = bfhi(qv.x); qd[2] = bflo(qv.y); qd[3] = bfhi(qv.y); qd[4] = bflo(qv.z); qd[5] = bfhi(qv.z); qd[6] = bflo(qv.w); qd[7] = bfhi(qv.w); }
        __syncthreads();
        if (tid < 64) { GC[(size_t)(t0 + tid) * 8 + h] = gcs[tid]; bge[tid] = bes[tid] * expf(gcs[tid]); }
        for (int r = 0; r < 8; ++r) { const int p = tid + 512 * r, i = p >> 6, j = p & 63;
            float dk = 0.f, dq = 0.f;
            if (j <= i) { const LAS float* ki = Kc + i * 132; const LAS float* kj = Kc + j * 132; const LAS float* qi = Qc + i * 132;
                for (int d = 0; d < HD; ++d) { dk += ki[d] * kj[d]; dq += qi[d] * kj[d]; } }
            const float dec = (j <= i) ? expf(gcs[i] - gcs[j]) : 0.f;
            Lm[i * 65 + j] = (j < i) ? bes[i] * dk * dec : 0.f;
            ATT[((size_t)(h * NCH + n) * 64 + i) * 64 + j] = (bf16)f2bf((j <= i) ? dq * dec : 0.f); }
        __syncthreads();
        if (tid < 64) { const int c = tid;
            for (int i = 0; i < 64; ++i) { float acc = (i == c) ? 1.f : 0.f; for (int j = 0; j < i; ++j) acc -= Lm[i * 65 + j] * Tm[j * 65 + c]; Tm[i * 65 + c] = acc; } }
        __syncthreads();
#pragma unroll
        for (int r = 0; r < 2; ++r) { const int idx = tid + 512 * r, row = idx >> 4, c8 = idx & 15;
            const u32x4 vv = *(const u32x4*)(VU + (size_t)(t0 + row) * DM + h * HD + 8 * c8); LAS float* vd = Qc + row * 132 + 8 * c8;
            vd[0] = bflo(vv.x); vd[1] = bfhi(vv.x); vd[2] = bflo(vv.y); vd[3] = bfhi(vv.y); vd[4] = bflo(vv.z); vd[5] = bfhi(vv.z); vd[6] = bflo(vv.w); vd[7] = bfhi(vv.w); }
        __syncthreads();
        { const int d = tid & 127, ig = tid >> 7;
          for (int ii = 0; ii < 16; ++ii) { const int i = ig * 16 + ii; float au = 0.f, aw = 0.f;
              for (int j = 0; j <= i; ++j) { const float t = Tm[i * 65 + j]; au += t * bes[j] * Qc[j * 132 + d]; aw += t * bge[j] * Kc[j * 132 + d]; }
              VU[(size_t)(t0 + i) * DM + h * HD + d] = (bf16)f2bf(au); Wb[(size_t)(t0 + i) * DM + h * HD + d] = (bf16)f2bf(aw); } }
    }
    __syncthreads();
}
__device__ __forceinline__ void p_dn_scan_naive(Frame& F, const Args& A) {
    if (blockIdx.x < 4) {
    const bf16* QN = (const bf16*)F.out; const bf16* KN = (const bf16*)F.out + (size_t)S * DM; const bf16* U = WSP(const bf16, WS_VN); const bf16* Wb = WSP(const bf16, WS_W); const bf16* ATT = WSP(const bf16, WS_ATT);
    const float* GC = WSP(const float, WS_GC); bf16* O = WSP(bf16, WS_O);
    LAS float* vn = (LAS float*)F.lds;
    const int tid = F.tid, wv = tid >> 6, h = blockIdx.x * 2 + (wv >> 2), e = (wv & 3) * 32 + (F.lane & 31), half = F.lane >> 5;
    float s[64];
#pragma unroll
    for (int d = 0; d < 64; ++d) s[d] = 0.f;
    for (int n = 0; n < NCH; ++n) { const int t0 = n * CH; const float gl = GC[(size_t)(t0 + 63) * 8 + h];
        for (int c = 0; c < 64; ++c) { const size_t ro = (size_t)(t0 + c) * DM + h * HD; const bf16* wp = Wb + ro + 64 * half; float a = 0.f;
#pragma unroll
            for (int d8 = 0; d8 < 8; ++d8) { if ((d8 & 1) == 0) asm volatile("" ::: "memory"); const u32x4 wv4 = *(const u32x4*)(wp + 8 * d8);
                a += bflo(wv4.x) * s[8 * d8] + bfhi(wv4.x) * s[8 * d8 + 1] + bflo(wv4.y) * s[8 * d8 + 2] + bfhi(wv4.y) * s[8 * d8 + 3] + bflo(wv4.z) * s[8 * d8 + 4] + bfhi(wv4.z) * s[8 * d8 + 5] + bflo(wv4.w) * s[8 * d8 + 6] + bfhi(wv4.w) * s[8 * d8 + 7]; }
            a += __shfl_xor(a, 32);
            vn[c * 512 + tid] = bf2f(U[ro + e]) - a; }
        for (int c = 0; c < 64; ++c) { const size_t ro = (size_t)(t0 + c) * DM + h * HD; const bf16* qp = QN + ro + 64 * half; float a = 0.f;
#pragma unroll
            for (int d8 = 0; d8 < 8; ++d8) { if ((d8 & 1) == 0) asm volatile("" ::: "memory"); const u32x4 wv4 = *(const u32x4*)(qp + 8 * d8);
                a += bflo(wv4.x) * s[8 * d8] + bfhi(wv4.x) * s[8 * d8 + 1] + bflo(wv4.y) * s[8 * d8 + 2] + bfhi(wv4.y) * s[8 * d8 + 3] + bflo(wv4.z) * s[8 * d8 + 4] + bfhi(wv4.z) * s[8 * d8 + 5] + bflo(wv4.w) * s[8 * d8 + 6] + bfhi(wv4.w) * s[8 * d8 + 7]; }
            a += __shfl_xor(a, 32);
            a *= expf(GC[(size_t)(t0 + c) * 8 + h]);
            const bf16* ap = ATT + ((size_t)(h * NCH + n) * 64 + c) * 64; float b = 0.f;
            for (int j = 0; j <= c; ++j) b += bf2f(ap[j]) * vn[j * 512 + tid];
            if (half == 0) O[ro + e] = (bf16)f2bf(a + b); }
        const float egl = expf(gl);
#pragma unroll
        for (int d = 0; d < 64; ++d) s[d] *= egl;
        for (int c = 0; c < 64; ++c) { const size_t ro = (size_t)(t0 + c) * DM + h * HD; const bf16* kp = KN + ro + 64 * half; const float f = vn[c * 512 + tid] * expf(gl - GC[(size_t)(t0 + c) * 8 + h]);
#pragma unroll
            for (int d8 = 0; d8 < 8; ++d8) { if ((d8 & 1) == 0) asm volatile("" ::: "memory"); const u32x4 wv4 = *(const u32x4*)(kp + 8 * d8);
                s[8 * d8] += f * bflo(wv4.x); s[8 * d8 + 1] += f * bfhi(wv4.x); s[8 * d8 + 2] += f * bflo(wv4.y); s[8 * d8 + 3] += f * bfhi(wv4.y); s[8 * d8 + 4] += f * bflo(wv4.z); s[8 * d8 + 5] += f * bfhi(wv4.z); s[8 * d8 + 6] += f * bflo(wv4.w); s[8 * d8 + 7] += f * bfhi(wv4.w); } }
    }
    }
}
__device__ __forceinline__ void p_dn_out(Frame& F, const Args& A) {
    const bf16* O = WSP(const bf16, WS_O); const bf16* Z = WSP(const bf16, WS_Z); bf16* YD = WSP(bf16, WS_YD); const float* ow = A.in[6];
    for (int it = F.gw; it < S * NH; it += F.NGW) { const int t = it >> 3, h = it & 7; const size_t off = (size_t)t * DM + h * HD + 2 * F.lane;
        const unsigned ov = *(const unsigned*)(O + off), zv = *(const unsigned*)(Z + off); const float o0 = bflo(ov), o1 = bfhi(ov);
        const float rs = rsq_(wave_sum(o0 * o0 + o1 * o1) * (1.f / HD) + EPS);
        *(unsigned*)(YD + off) = pk2(o0 * rs * ow[2 * F.lane] * siluf_(bflo(zv)), o1 * rs * ow[2 * F.lane + 1] * siluf_(bfhi(zv))); }
}


constexpr size_t WS_UT = WS_O;
constexpr size_t WS_KT = WS_VN;
constexpr size_t WS_EGL = WS_KMEAN;
typedef float f32x4_t __attribute__((ext_vector_type(4)));

__device__ __forceinline__ void p_dn_relayout1(Frame& F, const Args& A) {
    bf16* QN = (bf16*)F.out; bf16* Wb = WSP(bf16, WS_W); const bf16* U = WSP(const bf16, WS_VN); bf16* UT = WSP(bf16, WS_UT); const float* GC = WSP(const float, WS_GC); float* EGL = WSP(float, WS_EGL);
    LAS unsigned short* tile = (LAS unsigned short*)(F.lds + F.wave * 16640);
    for (int it = F.gw; it < NCH * NH; it += F.NGW) { const int n = it >> 3, h = it & 7, t0 = n * CH;
        if (F.lane == 0) EGL[h * NCH + n] = expf(GC[(size_t)(t0 + 63) * 8 + h]);
        for (int c = 0; c < 64; ++c) { const size_t off = (size_t)(t0 + c) * DM + h * HD + 2 * F.lane; const float eg = expf(GC[(size_t)(t0 + c) * 8 + h]);
            const unsigned qv = *(const unsigned*)(QN + off); *(unsigned*)(QN + off) = pk2(bflo(qv) * eg, bfhi(qv) * eg);
            const unsigned wv = *(const unsigned*)(Wb + off); *(unsigned*)(Wb + off) = wv ^ 0x80008000u;
            const unsigned uv = *(const unsigned*)(U + off); *(LAS unsigned*)(tile + c * 130 + 2 * F.lane) = uv; }
        asm volatile("s_waitcnt lgkmcnt(0)" ::: "memory");
        bf16* ut = UT + (size_t)(h * NCH + n) * (HD * CH);
        for (int e = 0; e < HD; ++e) ut[e * CH + F.lane] = tile[F.lane * 130 + e];
        asm volatile("s_waitcnt lgkmcnt(0)" ::: "memory");
    }
}
__device__ __forceinline__ void p_dn_relayout2(Frame& F, const Args& A) {
    const bf16* KN = (const bf16*)F.out + (size_t)S * DM; bf16* KT = WSP(bf16, WS_KT); const float* GC = WSP(const float, WS_GC);
    LAS unsigned short* tile = (LAS unsigned short*)(F.lds + F.wave * 16640);
    for (int it = F.gw; it < NCH * NH; it += F.NGW) { const int n = it >> 3, h = it & 7, t0 = n * CH;
        for (int c = 0; c < 64; ++c) { const size_t off = (size_t)(t0 + c) * DM + h * HD + 2 * F.lane; *(LAS unsigned*)(tile + c * 130 + 2 * F.lane) = *(const unsigned*)(KN + off); }
        asm volatile("s_waitcnt lgkmcnt(0)" ::: "memory");
        const float f = expf(GC[(size_t)(t0 + 63) * 8 + h] - GC[(size_t)(t0 + F.lane) * 8 + h]);
        bf16* kt = KT + (size_t)(h * NCH + n) * (HD * CH);
        for (int d = 0; d < HD; ++d) kt[d * CH + F.lane] = (bf16)f2bf(bf2f(tile[F.lane * 130 + d]) * f);
        asm volatile("s_waitcnt lgkmcnt(0)" ::: "memory");
    }
}

constexpr size_t WS2_QN = WS_R1, WS2_KN = WS_R1 + T32, WS2_WNEG = WS_R1 + 2 * T32, WS2_ATT = WS_H, WS2_YD = WS_R1 + 2 * T32, WS2_HALT = WS_R1 + T32;
__device__ __forceinline__ bf16* ws2_kt(Frame& F) { return (bf16*)F.out; }
__device__ __forceinline__ bf16* ws2_ut(Frame& F) { return (bf16*)F.out + (size_t)S * DM; }

struct ConvHalo { unsigned q[3], k[3], v[3]; };
constexpr size_t WS_HALO = 241 * MiB;
__device__ __forceinline__ void p_dn_conv2_halo(Frame& F, ConvHalo& H) {
    const bf16* HB = WSP(const bf16, WS_HALO);
    const int n = F.gw >> 3, h = F.gw & 7, col = h * HD + 2 * F.lane;
#pragma unroll
    for (int j = 0; j < 3; ++j) { H.q[j] = H.k[j] = H.v[j] = 0u;
        if (n > 0 && F.gw < NCH * NH) { const bf16* hp = HB + ((size_t)(n - 1) * 3 + j) * 3072 + col; H.q[j] = *(const unsigned*)hp; H.k[j] = *(const unsigned*)(hp + 1024); H.v[j] = *(const unsigned*)(hp + 2048); } }
}
struct ConvW { float w0[4], w1[4]; };
__device__ __forceinline__ void conv_w(const float* cw, int col, ConvW& W) {
#pragma unroll
    for (int j = 0; j < 4; ++j) { W.w0[j] = cw[(size_t)j * 3072 + col]; W.w1[j] = cw[(size_t)j * 3072 + col + 1]; }
}
__device__ __forceinline__ __amdgpu_buffer_rsrc_t mk_rsrc(const void* p) { return __builtin_amdgcn_make_buffer_rsrc((void*)p, 0, 0x7fffffff, 0x00020000); }
__device__ __forceinline__ void conv_load(const bf16* src, int t0, int col, unsigned (&xall)[CH]) {
    const __amdgpu_buffer_rsrc_t r = mk_rsrc(src + (size_t)t0 * DM);
#pragma unroll
    for (int c = 0; c < CH; ++c) xall[c] = __builtin_amdgcn_raw_buffer_load_b32(r, 2 * col, c * (DM * 2), 0);
}
template <bool NORM, bool DST, bool TILE> __device__ __forceinline__ void conv_pass(const unsigned (&xall)[CH], bf16* dst, LAS unsigned short* tile, const ConvW& W, const unsigned (&halo)[3], int t0, int col, int lane, float scale) {
    float a0 = bflo(halo[0]), a1 = bfhi(halo[0]), b0 = bflo(halo[1]), b1 = bfhi(halo[1]), c0 = bflo(halo[2]), c1 = bfhi(halo[2]);
    const __amdgpu_buffer_rsrc_t rd = mk_rsrc(DST ? dst + (size_t)t0 * DM : nullptr);
#pragma unroll
    for (int c = 0; c < CH; ++c) { const unsigned xv = xall[c]; const float d0 = bflo(xv), d1 = bfhi(xv);
        float y0 = siluf_(W.w0[0] * a0 + W.w0[1] * b0 + W.w0[2] * c0 + W.w0[3] * d0), y1 = siluf_(W.w1[0] * a1 + W.w1[1] * b1 + W.w1[2] * c1 + W.w1[3] * d1);
        if (NORM) { const float rs = scale * rsq_(wave_sum(y0 * y0 + y1 * y1) + EPS); y0 *= rs; y1 *= rs; }
        const unsigned o = pk2(y0, y1);
        if (DST) __builtin_amdgcn_raw_buffer_store_b32(o, rd, 2 * col, c * (DM * 2), 0);
        if (TILE) *(LAS unsigned*)(tile + c * 130 + 2 * lane) = o;
        a0 = b0; a1 = b1; b0 = c0; b1 = c1; c0 = d0; c1 = d1; }
}
__device__ __forceinline__ void conv_tile_out(const LAS unsigned short* tile, bf16* dstT, int lane) {
#pragma unroll 4
    for (int i = 0; i < 16; ++i) { const int d = 8 * i + (lane >> 3), ch = lane & 7; const LAS unsigned short* tp = tile + (8 * ch) * 130 + d;
        u32x4 w; w.x = (unsigned)tp[0] | ((unsigned)tp[130] << 16); w.y = (unsigned)tp[260] | ((unsigned)tp[390] << 16); w.z = (unsigned)tp[520] | ((unsigned)tp[650] << 16); w.w = (unsigned)tp[780] | ((unsigned)tp[910] << 16);
        *(u32x4*)(dstT + (size_t)d * CH + 8 * ch) = w; }
}
__device__ __forceinline__ void p_dn_conv2(Frame& F, const Args& A, const ConvHalo& H) {
    if (F.gw >= NCH * NH) return;
    bf16* QB = WSP(bf16, WS_R1); bf16* KB = WSP(bf16, WS_R1 + T32); const bf16* VB = WSP(bf16, WS_R1 + 2 * T32); const float* cw = A.in[3];
    LAS unsigned short* tile = (LAS unsigned short*)(F.lds + F.wave * 16640);
    const int n = F.gw >> 3, h = F.gw & 7, t0 = n * CH, col = h * HD + 2 * F.lane;
    bf16* ktr = ws2_kt(F) + (size_t)(h * NCH + n) * (HD * CH); bf16* vt = ws2_ut(F) + (size_t)(h * NCH + n) * (HD * CH);
    unsigned xa[CH]; ConvW W;
    conv_load(KB, t0, col, xa); conv_w(cw + 1024, col, W);
    conv_pass<true, true, true>(xa, KB, tile, W, H.k, t0, col, F.lane, 1.f);
    asm volatile("s_waitcnt lgkmcnt(0)" ::: "memory");
    conv_load(VB, t0, col, xa); conv_w(cw + 2048, col, W);
    __builtin_amdgcn_sched_barrier(0);
    conv_tile_out(tile, ktr, F.lane);
    asm volatile("s_waitcnt lgkmcnt(0)" ::: "memory");
    conv_pass<false, false, true>(xa, nullptr, tile, W, H.v, t0, col, F.lane, 1.f);
    asm volatile("s_waitcnt lgkmcnt(0)" ::: "memory");
    conv_load(QB, t0, col, xa); conv_w(cw, col, W);
    __builtin_amdgcn_sched_barrier(0);
    conv_tile_out(tile, vt, F.lane);
    asm volatile("s_waitcnt lgkmcnt(0)" ::: "memory");
    conv_pass<true, true, false>(xa, QB, tile, W, H.q, t0, col, F.lane, 0.08838834764831845f);
}

constexpr int CK_WAVE_LDS = 19200;
__device__ __forceinline__ void p_dn_chunk2(Frame& F, const Args& A) {
    if (F.gw >= NCH * NH) return;
    const int n = F.gw >> 3, h = F.gw & 7, t0 = n * CH, lane = F.lane, r = lane & 31, hh = lane >> 5;
    bf16* QN = WSP(bf16, WS2_QN); const bf16* KN = WSP(const bf16, WS2_KN); bf16* Wn = WSP(bf16, WS2_WNEG); bf16* ATT = WSP(bf16, WS2_ATT) + (size_t)(h * NCH + n) * (CH * CH);
    bf16* KT = ws2_kt(F) + (size_t)(h * NCH + n) * (HD * CH); bf16* UT = ws2_ut(F) + (size_t)(h * NCH + n) * (HD * CH);
    const float* BA = WSP(const float, WS_BA); float* EGL = WSP(float, WS_EGL);
    LAS unsigned char* wl = F.lds + F.wave * CK_WAVE_LDS; LAS float* Lw = (LAS float*)wl; LAS float* gcs = (LAS float*)(wl + 18432); LAS float* bes = gcs + 64; LAS float* fcs = bes + 64;
    float beta, gc, gl;
    { const int t = t0 + lane; const float b = BA[(size_t)t * 16 + h], a = BA[(size_t)t * 16 + 8 + h] + A.in[5][h];
      const float sp = (a > 20.f) ? a : log1pf(expf(a)); gc = -expf(A.in[4][h]) * sp; beta = 1.f / (1.f + expf(-b));
#pragma unroll
      for (int o = 1; o < 64; o <<= 1) { const float v = __shfl_up(gc, o); if (lane >= o) gc += v; }
      gl = __shfl(gc, 63);
      gcs[lane] = gc; bes[lane] = beta; fcs[lane] = expf(gl - gc);
      if (lane == 0) EGL[h * NCH + n] = expf(gl); }
    asm volatile("s_waitcnt lgkmcnt(0)" ::: "memory");
    {
        bf16x8 kf[2][8];
#pragma unroll
        for (int ti = 0; ti < 2; ++ti)
#pragma unroll
            for (int ks = 0; ks < 8; ++ks) kf[ti][ks] = *(const bf16x8*)(KN + (size_t)(t0 + 32 * ti + r) * DM + h * HD + 16 * ks + 8 * hh);
#pragma unroll
        for (int tt = 0; tt < 3; ++tt) { const int ti = (tt == 0) ? 0 : 1, tj = (tt == 2) ? 1 : 0;
            f32x16 acc;
#pragma unroll
            for (int i = 0; i < 16; ++i) acc[i] = 0.f;
#pragma unroll
            for (int ks = 0; ks < 8; ++ks) acc = __builtin_amdgcn_mfma_f32_32x32x16_bf16(kf[ti][ks], kf[tj][ks], acc, 0, 0, 0);
            const int j = 32 * tj + r; const float gcj = gcs[j];
#pragma unroll
            for (int g4 = 0; g4 < 4; ++g4) { const int i0 = 32 * ti + 8 * g4 + 4 * hh; const f32x4 gi = *(const LAS f32x4*)(gcs + i0), bi = *(const LAS f32x4*)(bes + i0);
#pragma unroll
                for (int e = 0; e < 4; ++e) { const int i = i0 + e; Lw[i * 68 + j] = (j < i) ? bi[e] * acc[4 * g4 + e] * __expf(gi[e] - gcj) : 0.f; } } }
        bf16x8 qf[2][8];
#pragma unroll
        for (int ti = 0; ti < 2; ++ti)
#pragma unroll
            for (int ks = 0; ks < 8; ++ks) qf[ti][ks] = *(const bf16x8*)(QN + (size_t)(t0 + 32 * ti + r) * DM + h * HD + 16 * ks + 8 * hh);
#pragma unroll
        for (int tt = 0; tt < 3; ++tt) { const int tj = (tt == 2) ? 1 : 0, ti = (tt == 0) ? 0 : 1;
            f32x16 acc;
#pragma unroll
            for (int i = 0; i < 16; ++i) acc[i] = 0.f;
#pragma unroll
            for (int ks = 0; ks < 8; ++ks) acc = __builtin_amdgcn_mfma_f32_32x32x16_bf16(kf[tj][ks], qf[ti][ks], acc, 0, 0, 0);
            const int i = 32 * ti + r; const float gci = gcs[i];
#pragma unroll
            for (int g4 = 0; g4 < 4; ++g4) { const int j0 = 32 * tj + 8 * g4 + 4 * hh; const f32x4 gj = *(const LAS f32x4*)(gcs + j0); float v[4];
#pragma unroll
                for (int e = 0; e < 4; ++e) v[e] = (j0 + e <= i) ? acc[4 * g4 + e] * __expf(gci - gj[e]) : 0.f;
                u32x2 w; w.x = cvtpk(v[0], v[1]); w.y = cvtpk(v[2], v[3]); *(u32x2*)(ATT + (size_t)i * CH + 32 * tj + 16 * (g4 & 1) + 8 * hh + 4 * (g4 >> 1)) = w; } }
        { const u32x4 z4 = {0u, 0u, 0u, 0u}; const int zi = lane >> 1, zj = 32 + 16 * (lane & 1); *(u32x4*)(ATT + (size_t)zi * CH + zj) = z4; *(u32x4*)(ATT + (size_t)zi * CH + zj + 8) = z4; }
#pragma unroll
        for (int ti = 0; ti < 2; ++ti) { const float eg = __expf(gcs[32 * ti + r]);
#pragma unroll
            for (int ks = 0; ks < 8; ++ks) { float f[8]; unpack8f(qf[ti][ks], f);
#pragma unroll
                for (int e = 0; e < 8; ++e) f[e] *= eg;
                const u32x4 pw = __builtin_bit_cast(u32x4, pack8f(f)); bf16* qd = QN + (size_t)(t0 + 32 * ti + r) * DM + h * HD + 32 * (ks >> 1) + 16 * hh + 4 * (ks & 1);
                u32x2 p0, p1; p0.x = pw.x; p0.y = pw.y; p1.x = pw.z; p1.y = pw.w; *(u32x2*)qd = p0; *(u32x2*)(qd + 8) = p1; } }
    }
    asm volatile("s_waitcnt lgkmcnt(0)" ::: "memory");
    float T[64];
#pragma unroll
    for (int i = 0; i < 64; ++i) { float acc = (lane == i) ? 1.f : 0.f;
#pragma unroll
        for (int j = 0; j < i; ++j) acc -= Lw[i * 68 + j] * T[j];
        T[i] = acc; }
    LAS unsigned short* Tb = (LAS unsigned short*)wl; LAS unsigned short* Tbg = Tb + 64 * 72;
    { const float eg = __expf(gc);
      asm volatile("s_waitcnt lgkmcnt(0)" ::: "memory");
#pragma unroll
      for (int i = 0; i < 64; ++i) { const float v = T[i] * beta; Tb[i * 72 + lane] = (unsigned short)f2bf(v); Tbg[i * 72 + lane] = (unsigned short)f2bf(v * eg); } }
    asm volatile("s_waitcnt lgkmcnt(0)" ::: "memory");
#ifdef DBG_CHK
    if (n < 128) { bf16* dump = WSP(bf16, 241 * MiB) + (size_t)(h * 128 + n) * 4096; for (int i = 0; i < 64; ++i) dump[i * 64 + lane] = Tbg[i * 72 + lane]; }
#endif
#ifdef DBG_CHK
    if (n < 32) { bf16* dk = WSP(bf16, 249 * MiB) + (size_t)(h * 32 + n) * 8192; for (int x = 0; x < 128; ++x) dk[x * 64 + lane] = KT[(size_t)x * CH + lane]; }
#endif
#ifdef DN2_VALU_UW
    for (int e = 0; e < HD; ++e) { float a = 0.f; for (int j2 = 0; j2 < 64; ++j2) a += bf2f(Tb[lane * 72 + j2]) * bf2f(UT[(size_t)e * CH + j2]); asm volatile("s_waitcnt vmcnt(0)" ::: "memory"); UT[(size_t)e * CH + lane] = (bf16)f2bf(a); asm volatile("s_waitcnt vmcnt(0)" ::: "memory"); }
    for (int d2 = 0; d2 < HD; ++d2) { float a = 0.f; for (int j2 = 0; j2 < 64; ++j2) a += bf2f(Tbg[lane * 72 + j2]) * bf2f(KT[(size_t)d2 * CH + j2]); Wn[(size_t)(t0 + lane) * DM + h * HD + d2] = (bf16)f2bf(-a); }
#else
#pragma unroll
    for (int te = 0; te < 4; ++te) { bf16x8 vfr[4];
#pragma unroll
        for (int ks2 = 0; ks2 < 4; ++ks2) vfr[ks2] = *(const bf16x8*)(UT + (size_t)(32 * te + r) * CH + 16 * ks2 + 8 * hh);
#pragma unroll
        for (int ti = 0; ti < 2; ++ti) { f32x16 acc;
#pragma unroll
            for (int i = 0; i < 16; ++i) acc[i] = 0.f;
#pragma unroll
            for (int ks2 = 0; ks2 < 4; ++ks2) if (ti == 1 || ks2 < 2) { const bf16x8 tb = *(const LAS bf16x8*)(Tb + (32 * ti + r) * 72 + 16 * ks2 + 8 * hh); acc = __builtin_amdgcn_mfma_f32_32x32x16_bf16(tb, vfr[ks2], acc, 0, 0, 0); }
#pragma unroll
            for (int g4 = 0; g4 < 4; ++g4) { u32x2 w; w.x = cvtpk(acc[4 * g4], acc[4 * g4 + 1]); w.y = cvtpk(acc[4 * g4 + 2], acc[4 * g4 + 3]); *(u32x2*)(UT + (size_t)(32 * te + r) * CH + 32 * ti + 8 * g4 + 4 * hh) = w; } } }
    f32x4 fsc[4][2];
#pragma unroll
    for (int ks2 = 0; ks2 < 4; ++ks2) { fsc[ks2][0] = *(const LAS f32x4*)(fcs + 16 * ks2 + 8 * hh); fsc[ks2][1] = *(const LAS f32x4*)(fcs + 16 * ks2 + 8 * hh + 4); }
#pragma unroll
    for (int td = 0; td < 4; ++td) { bf16x8 kfr[4];
#pragma unroll
        for (int ks2 = 0; ks2 < 4; ++ks2) kfr[ks2] = *(const bf16x8*)(KT + (size_t)(32 * td + r) * CH + 16 * ks2 + 8 * hh);
#pragma unroll
        for (int tc = 0; tc < 2; ++tc) { f32x16 acc;
#pragma unroll
            for (int i = 0; i < 16; ++i) acc[i] = 0.f;
#pragma unroll
            for (int ks2 = 0; ks2 < 4; ++ks2) if (tc == 1 || ks2 < 2) { const bf16x8 tg = *(const LAS bf16x8*)(Tbg + (32 * tc + r) * 72 + 16 * ks2 + 8 * hh); acc = __builtin_amdgcn_mfma_f32_32x32x16_bf16(kfr[ks2], tg, acc, 0, 0, 0); }
#pragma unroll
            for (int g4 = 0; g4 < 4; ++g4) { u32x2 w; w.x = cvtpk(-acc[4 * g4], -acc[4 * g4 + 1]); w.y = cvtpk(-acc[4 * g4 + 2], -acc[4 * g4 + 3]);
                *(u32x2*)(Wn + (size_t)(t0 + 32 * tc + r) * DM + h * HD + 32 * td + 16 * (g4 & 1) + 8 * hh + 4 * (g4 >> 1)) = w; } }
#pragma unroll
        for (int ks2 = 0; ks2 < 4; ++ks2) { float f[8]; unpack8f(kfr[ks2], f); const f32x4 f0 = fsc[ks2][0], f1 = fsc[ks2][1];
            f[0] *= f0[0]; f[1] *= f0[1]; f[2] *= f0[2]; f[3] *= f0[3]; f[4] *= f1[0]; f[5] *= f1[1]; f[6] *= f1[2]; f[7] *= f1[3];
            const u32x4 pw = __builtin_bit_cast(u32x4, pack8f(f)); const int ch = 2 * ks2 + hh; bf16* kd = KT + (size_t)(32 * td + r) * CH + 32 * (ch >> 2) + 16 * (ch & 1) + 4 * ((ch >> 1) & 1);
            u32x2 p0, p1; p0.x = pw.x; p0.y = pw.y; p1.x = pw.z; p1.y = pw.w; *(u32x2*)kd = p0; *(u32x2*)(kd + 8) = p1; } }
#endif
}

#ifndef DN2
#define DN2 1
#endif
#if DN2
#define SCAN_WNEG WS2_WNEG
#define SCAN_QP WSP(const bf16, WS2_QN)
#define SCAN_KT ws2_kt(F)
#define SCAN_UT ws2_ut(F)
#define SCAN_ATT WS2_ATT
#define SCAN_YD WS2_YD
#else
#define SCAN_WNEG WS_W
#define SCAN_QP ((const bf16*)F.out)
#define SCAN_KT WSP(bf16, WS_KT)
#define SCAN_UT WSP(bf16, WS_UT)
#define SCAN_ATT WS_ATT
#define SCAN_YD WS_YD
#endif
constexpr int SC_RW = 288, SC_RK = 160;
constexpr int SC_W = 0, SC_Q = 64 * SC_RW, SC_K = 2 * 64 * SC_RW, SC_A = SC_K + 128 * SC_RK, SC_BUF = SC_A + 64 * SC_RK;
__device__ __forceinline__ bf16x8 frag2(const LAS unsigned char* p) {
    const u32x2 a = *(const LAS u32x2*)p, b = *(const LAS u32x2*)(p + 32); u32x4 w; w.x = a.x; w.y = a.y; w.z = b.x; w.w = b.y; return __builtin_bit_cast(bf16x8, w);
}
__device__ __forceinline__ bf16x8 packb(const f32x4_t a, const f32x4_t b) { u32x4 w; w.x = cvtpk(a[0], a[1]); w.y = cvtpk(a[2], a[3]); w.z = cvtpk(b[0], b[1]); w.w = cvtpk(b[2], b[3]); return __builtin_bit_cast(bf16x8, w); }
constexpr int SCAN_WGS = 16;
__device__ __forceinline__ void p_dn_scan_fast(Frame& F, const Args& A) {
    if (blockIdx.x < SCAN_WGS) {
    const int h = blockIdx.x >> 1, hf = blockIdx.x & 1;
    const bf16* Wb = WSP(const bf16, SCAN_WNEG); const bf16* QP = SCAN_QP; const bf16* KT = SCAN_KT; const bf16* ATT = WSP(const bf16, SCAN_ATT); bf16* UT = SCAN_UT; const float* EGL = WSP(const float, WS_EGL);
    if (F.wave >= 4) {
        const int lt = F.tid - 256;
#if defined(SCAN_PROBE) && SCAN_PROBE == 2
        unsigned long long lp_sum = 0ull, lp_t0 = 0ull;
#define SCP_T0() (lp_t0 = __builtin_amdgcn_s_memrealtime())
#define SCP_T1() (lp_sum += __builtin_amdgcn_s_memrealtime() - lp_t0)
#else
#define SCP_T0() ((void)0)
#define SCP_T1() ((void)0)
#endif
        u32x4 rwA[4], rqA[4], rkA[4], raA[2], rwB[4], rqB[4], rkB[4], raB[2], rwC[4], rqC[4], rkC[4], raC[2];
#define SC_GLD(dst, voff, sbase) asm volatile("global_load_dwordx4 %0, %1, %2" : "=v"(dst) : "v"(voff), "s"(sbase) : "memory")
        const unsigned vo_w = (unsigned)((lt >> 4) * (DM * 2) + (lt & 15) * 16), vo_t = (unsigned)lt * 16u;
#define SC_ISSUE(n_, X) do { const bf16* bw_ = Wb + (size_t)((n_) * CH) * DM + h * HD; const bf16* bq_ = QP + (size_t)((n_) * CH) * DM + h * HD; \
            const bf16* bk_ = KT + (size_t)(h * NCH + (n_)) * (HD * CH); const bf16* ba_ = ATT + (size_t)(h * NCH + (n_)) * (CH * CH); \
            _Pragma("unroll") for (int i = 0; i < 4; ++i) { SC_GLD(rw##X[i], vo_w + (unsigned)i * (16u * DM * 2u), bw_); SC_GLD(rq##X[i], vo_w + (unsigned)i * (16u * DM * 2u), bq_); } \
            _Pragma("unroll") for (int i = 0; i < 4; ++i) { SC_GLD(rk##X[i], vo_t + (unsigned)i * 4096u, bk_); } \
            _Pragma("unroll") for (int i = 0; i < 2; ++i) { SC_GLD(ra##X[i], vo_t + (unsigned)i * 4096u, ba_); } } while (0)
#define SC_WAIT(N, X) asm volatile("s_waitcnt vmcnt(" #N ")" : "+v"(rw##X[0]), "+v"(rw##X[1]), "+v"(rw##X[2]), "+v"(rw##X[3]), "+v"(rq##X[0]), "+v"(rq##X[1]), "+v"(rq##X[2]), "+v"(rq##X[3]), \
            "+v"(rk##X[0]), "+v"(rk##X[1]), "+v"(rk##X[2]), "+v"(rk##X[3]), "+v"(ra##X[0]), "+v"(ra##X[1]) :: "memory")
#define SC_PUT(buf_, X) do { LAS unsigned char* b_ = F.lds + (buf_) * SC_BUF; \
            _Pragma("unroll") for (int i = 0; i < 4; ++i) { const int idx = lt + 256 * i, row = idx >> 4, ch = idx & 15; *(LAS u32x4*)(b_ + SC_W + row * SC_RW + 16 * ch) = rw##X[i]; *(LAS u32x4*)(b_ + SC_Q + row * SC_RW + 16 * ch) = rq##X[i]; } \
            _Pragma("unroll") for (int i = 0; i < 4; ++i) { const int idx = lt + 256 * i, row = idx >> 3, ch = idx & 7; *(LAS u32x4*)(b_ + SC_K + row * SC_RK + 16 * ch) = rk##X[i]; } \
            _Pragma("unroll") for (int i = 0; i < 2; ++i) { const int idx = lt + 256 * i, row = idx >> 3, ch = idx & 7; *(LAS u32x4*)(b_ + SC_A + row * SC_RK + 16 * ch) = ra##X[i]; } } while (0)
#define SC_STEP(n_, X) do { SCP_T0(); if ((n_) + 1 < NCH) { if ((n_) + 3 < NCH) SC_WAIT(28, X); else if ((n_) + 2 < NCH) SC_WAIT(14, X); else SC_WAIT(0, X); \
                SC_PUT(((n_) + 1) & 1, X); if ((n_) + 4 < NCH) SC_ISSUE((n_) + 4, X); } \
            asm volatile("s_waitcnt lgkmcnt(0)" ::: "memory"); SCP_T1(); __builtin_amdgcn_s_barrier(); } while (0)
        SC_ISSUE(0, A); SC_WAIT(0, A); SC_PUT(0, A);
        asm volatile("s_waitcnt lgkmcnt(0)" ::: "memory");
        __builtin_amdgcn_s_barrier();
        SC_ISSUE(1, A); SC_ISSUE(2, B); SC_ISSUE(3, C);
        for (int n = 0; n < NCH; n += 3) {
            SC_STEP(n, A);
            if (n + 1 < NCH) SC_STEP(n + 1, B);
            if (n + 2 < NCH) SC_STEP(n + 2, C);
        }
#if defined(SCAN_PROBE) && SCAN_PROBE == 2
        if (blockIdx.x == 0 && F.tid == 256) F.MISC[16] = (unsigned)lp_sum;
#endif
    } else {
        const int r = F.lane & 15, g = F.lane >> 4, e0 = (hf * 4 + F.wave) * 16;
        f32x4_t sacc[8];
#pragma unroll
        for (int i = 0; i < 8; ++i) sacc[i] = (f32x4_t){0.f, 0.f, 0.f, 0.f};
        bf16* utp = UT + (size_t)h * NCH * (HD * CH) + (size_t)(e0 + r) * CH + 4 * g;
        u32x2 un[4];
#pragma unroll
        for (int ct = 0; ct < 4; ++ct) un[ct] = *(const u32x2*)(utp + 16 * ct);
        float egl = EGL[h * NCH];
        __builtin_amdgcn_s_barrier();
#ifdef SCAN_PROBE
        unsigned long long sp_sum = 0ull;
#endif
        for (int n = 0; n < NCH; ++n) {
#ifdef SCAN_PROBE
            const unsigned long long sp_t0 = __builtin_amdgcn_s_memrealtime();
#endif
            const LAS unsigned char* b = F.lds + (n & 1) * SC_BUF; const LAS unsigned char* lw = b + SC_W + r * SC_RW + 16 * g; const LAS unsigned char* lq = b + SC_Q + r * SC_RW + 16 * g;
            const LAS unsigned char* lk = b + SC_K + r * SC_RK + 16 * g; const LAS unsigned char* la = b + SC_A + r * SC_RK + 16 * g;
            f32x4_t vacc[4], oacc[4]; bf16x8 sb[4], fa[16], fb[16];
#pragma unroll
            for (int ct = 0; ct < 4; ++ct)
#pragma unroll
                for (int kk = 0; kk < 4; ++kk) fa[4 * ct + kk] = *(const LAS bf16x8*)(lw + ct * 16 * SC_RW + kk * 64);
#pragma unroll
            for (int ct = 0; ct < 4; ++ct)
#pragma unroll
                for (int kk = 0; kk < 4; ++kk) fb[4 * ct + kk] = *(const LAS bf16x8*)(lq + ct * 16 * SC_RW + kk * 64);
            __builtin_amdgcn_sched_barrier(0);
#pragma unroll
            for (int kk = 0; kk < 4; ++kk) sb[kk] = packb(sacc[2 * kk], sacc[2 * kk + 1]);
#pragma unroll
            for (int ct = 0; ct < 4; ++ct) { vacc[ct] = (f32x4_t){bflo(un[ct].x), bfhi(un[ct].x), bflo(un[ct].y), bfhi(un[ct].y)}; oacc[ct] = (f32x4_t){0.f, 0.f, 0.f, 0.f}; }
            bf16* utc = utp + (size_t)n * (HD * CH);
            u32x2 unn[4]; float egln = 0.f;
            if (n + 1 < NCH) {
#pragma unroll
                for (int ct = 0; ct < 4; ++ct) unn[ct] = *(const u32x2*)(utc + HD * CH + 16 * ct);
                egln = EGL[h * NCH + n + 1]; }
#pragma unroll
            for (int kk = 0; kk < 4; ++kk)
#pragma unroll
                for (int ct = 0; ct < 4; ++ct) vacc[ct] = __builtin_amdgcn_mfma_f32_16x16x32_bf16(fa[4 * ct + kk], sb[kk], vacc[ct], 0, 0, 0);
            __builtin_amdgcn_sched_barrier(0);
#pragma unroll
            for (int mt = 0; mt < 8; ++mt)
#pragma unroll
                for (int k2 = 0; k2 < 2; ++k2) fa[2 * mt + k2] = *(const LAS bf16x8*)(lk + mt * 16 * SC_RK + k2 * 64);
            __builtin_amdgcn_sched_barrier(0);
#pragma unroll
            for (int kk = 0; kk < 4; ++kk)
#pragma unroll
                for (int ct = 0; ct < 4; ++ct) oacc[ct] = __builtin_amdgcn_mfma_f32_16x16x32_bf16(fb[4 * ct + kk], sb[kk], oacc[ct], 0, 0, 0);
            __builtin_amdgcn_sched_barrier(0);
#pragma unroll
            for (int ct = 0; ct < 4; ++ct)
#pragma unroll
                for (int k2 = 0; k2 < 2; ++k2) if (!(k2 == 1 && ct < 2)) fb[2 * ct + k2] = *(const LAS bf16x8*)(la + ct * 16 * SC_RK + k2 * 64);
            __builtin_amdgcn_sched_barrier(0);
            bf16x8 vb[2];
#pragma unroll
            for (int k2 = 0; k2 < 2; ++k2) vb[k2] = packb(vacc[2 * k2], vacc[2 * k2 + 1]);
#pragma unroll
            for (int mt = 0; mt < 8; ++mt) sacc[mt] = sacc[mt] * egl;
#pragma unroll
            for (int k2 = 0; k2 < 2; ++k2)
#pragma unroll
                for (int mt = 0; mt < 8; ++mt) sacc[mt] = __builtin_amdgcn_mfma_f32_16x16x32_bf16(fa[2 * mt + k2], vb[k2], sacc[mt], 0, 0, 0);
#pragma unroll
            for (int k2 = 0; k2 < 2; ++k2)
#pragma unroll
                for (int ct = 0; ct < 4; ++ct) if (!(k2 == 1 && ct < 2)) oacc[ct] = __builtin_amdgcn_mfma_f32_16x16x32_bf16(fb[2 * ct + k2], vb[k2], oacc[ct], 0, 0, 0);
#pragma unroll
            for (int ct = 0; ct < 4; ++ct) { u32x2 w; w.x = cvtpk(oacc[ct][0], oacc[ct][1]); w.y = cvtpk(oacc[ct][2], oacc[ct][3]); *(u32x2*)(utc + 16 * ct) = w; }
#pragma unroll
            for (int ct = 0; ct < 4; ++ct) un[ct] = unn[ct];
            egl = egln;
            asm volatile("s_waitcnt lgkmcnt(0)" ::: "memory");
#if defined(SCAN_PROBE) && SCAN_PROBE == 1
            asm volatile("s_waitcnt vmcnt(0)" ::: "memory"); sp_sum += __builtin_amdgcn_s_memrealtime() - sp_t0;
#endif
            __builtin_amdgcn_s_barrier();
        }
#if defined(SCAN_PROBE) && SCAN_PROBE == 1
        if (blockIdx.x == 0 && F.tid == 0) F.MISC[16] = (unsigned)sp_sum;
#endif
    }
    }
}

constexpr int SEG_G = 8, SEG_N = NCH / SEG_G;
constexpr size_t WS_SST = 241 * MiB;
constexpr size_t WS_MBB = 245 * MiB;
constexpr size_t WS_MBM = 249 * MiB;
static_assert(WS_MBM + (size_t)NH * (SEG_G - 1) * 128 * 128 * 4 <= WS_END, "segment scan buffers");

template <bool FINAL> __device__ __forceinline__ void scan_job(Frame& F, const Args& A, int h, int sg, int sub) {
    const bf16* Wb = WSP(const bf16, SCAN_WNEG); const bf16* QP = SCAN_QP; const bf16* KT = SCAN_KT; const bf16* ATT = WSP(const bf16, SCAN_ATT); bf16* UT = SCAN_UT; const float* EGL = WSP(const float, WS_EGL);
    const int n0 = sg * SEG_N, n1 = n0 + SEG_N;
    constexpr int NLD = FINAL ? 14 : 8;
    if (F.wave >= 4) {
        const int lt = F.tid - 256;
        u32x4 rwA[4], rqA[4], rkA[4], raA[2], rwB[4], rqB[4], rkB[4], raB[2], rwC[4], rqC[4], rkC[4], raC[2];
#define S2_GLD(dst, voff, sbase) asm volatile("global_load_dwordx4 %0, %1, %2" : "=v"(dst) : "v"(voff), "s"(sbase) : "memory")
        const unsigned vo_w = (unsigned)((lt >> 4) * (DM * 2) + (lt & 15) * 16), vo_t = (unsigned)lt * 16u;
#define S2_ISSUE(n_, X) do { const bf16* bw_ = Wb + (size_t)((n_) * CH) * DM + h * HD; const bf16* bk_ = KT + (size_t)(h * NCH + (n_)) * (HD * CH); \
            _Pragma("unroll") for (int i = 0; i < 4; ++i) { S2_GLD(rw##X[i], vo_w + (unsigned)i * (16u * DM * 2u), bw_); } \
            _Pragma("unroll") for (int i = 0; i < 4; ++i) { S2_GLD(rk##X[i], vo_t + (unsigned)i * 4096u, bk_); } \
            if constexpr (FINAL) { const bf16* bq_ = QP + (size_t)((n_) * CH) * DM + h * HD; const bf16* ba_ = ATT + (size_t)(h * NCH + (n_)) * (CH * CH); \
                _Pragma("unroll") for (int i = 0; i < 4; ++i) { S2_GLD(rq##X[i], vo_w + (unsigned)i * (16u * DM * 2u), bq_); } \
                _Pragma("unroll") for (int i = 0; i < 2; ++i) { S2_GLD(ra##X[i], vo_t + (unsigned)i * 4096u, ba_); } } } while (0)
#define S2_TIEF(X) "+v"(rw##X[0]), "+v"(rw##X[1]), "+v"(rw##X[2]), "+v"(rw##X[3]), "+v"(rq##X[0]), "+v"(rq##X[1]), "+v"(rq##X[2]), "+v"(rq##X[3]), "+v"(rk##X[0]), "+v"(rk##X[1]), "+v"(rk##X[2]), "+v"(rk##X[3]), "+v"(ra##X[0]), "+v"(ra##X[1])
#define S2_TIEA(X) "+v"(rw##X[0]), "+v"(rw##X[1]), "+v"(rw##X[2]), "+v"(rw##X[3]), "+v"(rk##X[0]), "+v"(rk##X[1]), "+v"(rk##X[2]), "+v"(rk##X[3])
#define S2_WAIT2(X) do { if constexpr (FINAL) asm volatile("s_waitcnt vmcnt(28)" : S2_TIEF(X) :: "memory"); else asm volatile("s_waitcnt vmcnt(16)" : S2_TIEA(X) :: "memory"); } while (0)
#define S2_WAIT0(X) do { if constexpr (FINAL) asm volatile("s_waitcnt vmcnt(0)" : S2_TIEF(X) :: "memory"); else asm volatile("s_waitcnt vmcnt(0)" : S2_TIEA(X) :: "memory"); } while (0)
#define S2_PUT(buf_, X) do { LAS unsigned char* b_ = F.lds + (buf_) * SC_BUF; \
            _Pragma("unroll") for (int i = 0; i < 4; ++i) { const int idx = lt + 256 * i, row = idx >> 4, ch = idx & 15; *(LAS u32x4*)(b_ + SC_W + row * SC_RW + 16 * ch) = rw##X[i]; \
                if constexpr (FINAL) *(LAS u32x4*)(b_ + SC_Q + row * SC_RW + 16 * ch) = rq##X[i]; } \
            _Pragma("unroll") for (int i = 0; i < 4; ++i) { const int idx = lt + 256 * i, row = idx >> 3, ch = idx & 7; *(LAS u32x4*)(b_ + SC_K + row * SC_RK + 16 * ch) = rk##X[i]; } \
            if constexpr (FINAL) { _Pragma("unroll") for (int i = 0; i < 2; ++i) { const int idx = lt + 256 * i, row = idx >> 3, ch = idx & 7; *(LAS u32x4*)(b_ + SC_A + row * SC_RK + 16 * ch) = ra##X[i]; } } } while (0)
#define S2_STEP(n_, X) do { S2_WAIT2(X); S2_PUT(((n_) + 1 - n0) & 1, X); { const int nn_ = ((n_) + 4 < n1) ? (n_) + 4 : n1 - 1; S2_ISSUE(nn_, X); } \
            asm volatile("s_waitcnt lgkmcnt(0)" ::: "memory"); __builtin_amdgcn_s_barrier(); } while (0)
        static_assert(SEG_N % 3 == 2, "loader tail below is written for SEG_N = 3k + 2");
        S2_ISSUE(n0, A); S2_WAIT0(A); S2_PUT(0, A);
        asm volatile("s_waitcnt lgkmcnt(0)" ::: "memory");
        __builtin_amdgcn_s_barrier();
        S2_ISSUE(n0 + 1, A); S2_ISSUE(n0 + 2, B); S2_ISSUE(n0 + 3, C);
        int n = n0;
        for (; n + 2 < n1; n += 3) { S2_STEP(n, A); S2_STEP(n + 1, B); S2_STEP(n + 2, C); }
        S2_STEP(n, A); S2_STEP(n + 1, B);
        asm volatile("s_waitcnt vmcnt(0)" ::: "memory");
    } else {
        const int r = F.lane & 15, g = F.lane >> 4;
        const int col = FINAL ? (sub * 4 + F.wave) * 16 + r : 64 * sub + 16 * F.wave + r;
        const bool real = FINAL || (col < 128);
        f32x4_t sacc[8];
        if constexpr (FINAL) { const float* sp = WSP(const float, WS_SST) + ((size_t)(h * SEG_G + sg) * 128 + col) * 128 + 4 * g;
#pragma unroll
            for (int mt = 0; mt < 8; ++mt) sacc[mt] = *(const f32x4_t*)(sp + 16 * mt); }
        else {
#pragma unroll
            for (int mt = 0; mt < 8; ++mt)
#pragma unroll
                for (int e = 0; e < 4; ++e) sacc[mt][e] = (!real && (16 * mt + 4 * g + e) == (col - 128)) ? 1.f : 0.f; }
        bf16* utp = UT + (size_t)h * NCH * (HD * CH) + (size_t)((FINAL ? col : (col & 127))) * CH + 4 * g;
        u32x2 un[4];
#pragma unroll
        for (int ct = 0; ct < 4; ++ct) { un[ct] = (u32x2){0u, 0u}; if (real) un[ct] = *(const u32x2*)(utp + (size_t)n0 * (HD * CH) + 16 * ct); }
        float egl = EGL[h * NCH + n0];
        __builtin_amdgcn_s_barrier();
        for (int n = n0; n < n1; ++n) {
            const LAS unsigned char* b = F.lds + ((n - n0) & 1) * SC_BUF; const LAS unsigned char* lw = b + SC_W + r * SC_RW + 16 * g; const LAS unsigned char* lq = b + SC_Q + r * SC_RW + 16 * g;
            const LAS unsigned char* lk = b + SC_K + r * SC_RK + 16 * g; const LAS unsigned char* la = b + SC_A + r * SC_RK + 16 * g;
            f32x4_t vacc[4], oacc[4]; bf16x8 sb[4], fa[16], fb[16];
#pragma unroll
            for (int ct = 0; ct < 4; ++ct)
#pragma unroll
                for (int kk = 0; kk < 4; ++kk) fa[4 * ct + kk] = *(const LAS bf16x8*)(lw + ct * 16 * SC_RW + kk * 64);
            if constexpr (FINAL) {
#pragma unroll
                for (int ct = 0; ct < 4; ++ct)
#pragma unroll
                    for (int kk = 0; kk < 4; ++kk) fb[4 * ct + kk] = *(const LAS bf16x8*)(lq + ct * 16 * SC_RW + kk * 64); }
            __builtin_amdgcn_sched_barrier(0);
#pragma unroll
            for (int kk = 0; kk < 4; ++kk) sb[kk] = packb(sacc[2 * kk], sacc[2 * kk + 1]);
#pragma unroll
            for (int ct = 0; ct < 4; ++ct) { vacc[ct] = (f32x4_t){bflo(un[ct].x), bfhi(un[ct].x), bflo(un[ct].y), bfhi(un[ct].y)}; oacc[ct] = (f32x4_t){0.f, 0.f, 0.f, 0.f}; }
            bf16* utc = utp + (size_t)n * (HD * CH);
            u32x2 unn[4]; float egln = 0.f;
#pragma unroll
            for (int ct = 0; ct < 4; ++ct) unn[ct] = (u32x2){0u, 0u};
            if (n + 1 < n1) { if (real) {
#pragma unroll
                    for (int ct = 0; ct < 4; ++ct) unn[ct] = *(const u32x2*)(utc + HD * CH + 16 * ct); }
                egln = EGL[h * NCH + n + 1]; }
#pragma unroll
            for (int kk = 0; kk < 4; ++kk)
#pragma unroll
                for (int ct = 0; ct < 4; ++ct) vacc[ct] = __builtin_amdgcn_mfma_f32_16x16x32_bf16(fa[4 * ct + kk], sb[kk], vacc[ct], 0, 0, 0);
            __builtin_amdgcn_sched_barrier(0);
#pragma unroll
            for (int mt = 0; mt < 8; ++mt)
#pragma unroll
                for (int k2 = 0; k2 < 2; ++k2) fa[2 * mt + k2] = *(const LAS bf16x8*)(lk + mt * 16 * SC_RK + k2 * 64);
            __builtin_amdgcn_sched_barrier(0);
            if constexpr (FINAL) {
#pragma unroll
                for (int kk = 0; kk < 4; ++kk)
#pragma unroll
                    for (int ct = 0; ct < 4; ++ct) oacc[ct] = __builtin_amdgcn_mfma_f32_16x16x32_bf16(fb[4 * ct + kk], sb[kk], oacc[ct], 0, 0, 0);
                __builtin_amdgcn_sched_barrier(0);
#pragma unroll
                for (int ct = 0; ct < 4; ++ct)
#pragma unroll
                    for (int k2 = 0; k2 < 2; ++k2) if (!(k2 == 1 && ct < 2)) fb[2 * ct + k2] = *(const LAS bf16x8*)(la + ct * 16 * SC_RK + k2 * 64);
                __builtin_amdgcn_sched_barrier(0); }
            bf16x8 vb[2];
#pragma unroll
            for (int k2 = 0; k2 < 2; ++k2) vb[k2] = packb(vacc[2 * k2], vacc[2 * k2 + 1]);
#pragma unroll
            for (int mt = 0; mt < 8; ++mt) sacc[mt] = sacc[mt] * egl;
#pragma unroll
            for (int k2 = 0; k2 < 2; ++k2)
#pragma unroll
                for (int mt = 0; mt < 8; ++mt) sacc[mt] = __builtin_amdgcn_mfma_f32_16x16x32_bf16(fa[2 * mt + k2], vb[k2], sacc[mt], 0, 0, 0);
            if constexpr (FINAL) {
#pragma unroll
                for (int k2 = 0; k2 < 2; ++k2)
#pragma unroll
                    for (int ct = 0; ct < 4; ++ct) if (!(k2 == 1 && ct < 2)) oacc[ct] = __builtin_amdgcn_mfma_f32_16x16x32_bf16(fb[2 * ct + k2], vb[k2], oacc[ct], 0, 0, 0);
#pragma unroll
                for (int ct = 0; ct < 4; ++ct) { u32x2 w; w.x = cvtpk(oacc[ct][0], oacc[ct][1]); w.y = cvtpk(oacc[ct][2], oacc[ct][3]); *(u32x2*)(utc + 16 * ct) = w; } }
#pragma unroll
            for (int ct = 0; ct < 4; ++ct) un[ct] = unn[ct];
            egl = egln;
            asm volatile("s_waitcnt lgkmcnt(0)" ::: "memory");
            __builtin_amdgcn_s_barrier();
        }
        if constexpr (!FINAL) {
            if (real) { float* bp = WSP(float, WS_MBB) + ((size_t)(h * (SEG_G - 1) + sg) * 128 + col) * 128 + 4 * g;
#pragma unroll
                for (int mt = 0; mt < 8; ++mt) *(f32x4_t*)(bp + 16 * mt) = sacc[mt]; }
            else { bf16* mp = WSP(bf16, WS_MBM) + (size_t)(h * (SEG_G - 1) + sg) * (128 * 128) + (col - 128);
#pragma unroll
                for (int mt = 0; mt < 8; ++mt)
#pragma unroll
                    for (int e = 0; e < 4; ++e) mp[(size_t)(16 * mt + 4 * g + e) * 128] = (bf16)f2bf(sacc[mt][e]); } }
    }
}
constexpr int MID_SPLIT = 8;
__device__ __forceinline__ void scan_mid(Frame& F, const Args& A, int h, int cg) {
    LAS float* Sl = (LAS float*)F.lds; LAS unsigned char* Mimg = F.lds + 16 * 132 * 4;
    float* SST = WSP(float, WS_SST) + (size_t)h * SEG_G * (128 * 128);
    const float* MBB = WSP(const float, WS_MBB) + (size_t)h * (SEG_G - 1) * (128 * 128); const bf16* MBM = WSP(const bf16, WS_MBM) + (size_t)h * (SEG_G - 1) * (128 * 128);
    const int r = F.lane & 15, g = F.lane >> 4, et = F.wave, col = 16 * cg + r;
    __syncthreads();
    for (int i = F.tid; i < 16 * 128; i += NWAVES * 64) { Sl[(i >> 7) * 132 + (i & 127)] = 0.f; SST[(size_t)(16 * cg + (i >> 7)) * 128 + (i & 127)] = 0.f; }
    u32x4 mreg[2][4]; f32x4_t accn[2];
#pragma unroll
    for (int p = 0; p < 2; ++p) {
#pragma unroll
        for (int i = 0; i < 4; ++i) mreg[p][i] = *(const u32x4*)(MBM + (size_t)p * (128 * 128) + (size_t)(F.tid + 512 * i) * 8);
        accn[p] = *(const f32x4_t*)(MBB + ((size_t)p * 128 + col) * 128 + 16 * et + 4 * g); }
#pragma unroll
    for (int sg = 0; sg < SEG_G - 1; ++sg) { const int p = sg & 1;
        __syncthreads();
#pragma unroll
        for (int i = 0; i < 4; ++i) { const int idx = F.tid + 512 * i, row = idx >> 4, ch = idx & 15; *(LAS u32x4*)(Mimg + row * 272 + 16 * ch) = mreg[p][i]; }
        if (sg + 2 < SEG_G - 1) {
#pragma unroll
            for (int i = 0; i < 4; ++i) mreg[p][i] = *(const u32x4*)(MBM + (size_t)(sg + 2) * (128 * 128) + (size_t)(F.tid + 512 * i) * 8); }
        f32x4_t acc = accn[p];
        if (sg + 2 < SEG_G - 1) accn[p] = *(const f32x4_t*)(MBB + ((size_t)(sg + 2) * 128 + col) * 128 + 16 * et + 4 * g);
        __syncthreads();
#pragma unroll
        for (int kk = 0; kk < 4; ++kk) {
            const LAS float* sp = Sl + r * 132 + 32 * kk + 8 * g; const f32x4 s0 = *(const LAS f32x4*)sp, s1 = *(const LAS f32x4*)(sp + 4);
            float sf[8] = {s0.x, s0.y, s0.z, s0.w, s1.x, s1.y, s1.z, s1.w}; const bf16x8 bfr = pack8f(sf);
            const bf16x8 afr = *(const LAS bf16x8*)(Mimg + (16 * et + r) * 272 + 64 * kk + 16 * g); acc = __builtin_amdgcn_mfma_f32_16x16x32_bf16(afr, bfr, acc, 0, 0, 0); }
        *(f32x4_t*)(SST + (size_t)(sg + 1) * (128 * 128) + (size_t)col * 128 + 16 * et + 4 * g) = acc;
        __syncthreads();
        *(LAS f32x4_t*)(Sl + r * 132 + 16 * et + 4 * g) = acc;
    }
    __syncthreads();
}
__device__ __forceinline__ void p_dn_scan2_A(Frame& F, const Args& A) { const int b = blockIdx.x; if (b < NH * (SEG_G - 1) * 4) { const int gid = 8 * (b >> 5) + (b & 7), sub = (b >> 3) & 3; scan_job<false>(F, A, gid / (SEG_G - 1), gid % (SEG_G - 1), sub); } }
__device__ __forceinline__ void p_dn_scan2_B(Frame& F, const Args& A) { if (blockIdx.x < NH * MID_SPLIT) scan_mid(F, A, blockIdx.x / MID_SPLIT, blockIdx.x % MID_SPLIT); }
__device__ __forceinline__ void p_dn_scan2_C(Frame& F, const Args& A) { const int b = blockIdx.x; if (b < NH * SEG_G * 2) { const int gid = 8 * (b >> 4) + (b & 7), sub = (b >> 3) & 1; scan_job<true>(F, A, gid / SEG_G, gid % SEG_G, sub); } }
__device__ __forceinline__ void p_dn_out_fast(Frame& F, const Args& A) {
    const bf16* OT = SCAN_UT; const bf16* Z = WSP(const bf16, WS_Z); bf16* YD = WSP(bf16, SCAN_YD); const float* ow = A.in[6];
    LAS unsigned short* tile = (LAS unsigned short*)(F.lds + F.wave * 16640);
    for (int it = F.gw; it < NCH * NH; it += F.NGW) { const int n = it >> 3, h = it & 7, t0 = n * CH;
        const bf16* ot = OT + (size_t)(h * NCH + n) * (HD * CH);
        u32x4 ov[16]; unsigned zall[CH];
#pragma unroll
        for (int i = 0; i < 16; ++i) { const int e = 8 * i + (F.lane >> 3), ch = F.lane & 7; ov[i] = *(const u32x4*)(ot + (size_t)e * CH + 8 * ch); }
#pragma unroll
        for (int c = 0; c < CH; ++c) zall[c] = *(const unsigned*)(Z + (size_t)(t0 + c) * DM + h * HD + 2 * F.lane);
        const float w0 = ow[2 * F.lane], w1 = ow[2 * F.lane + 1];
#pragma unroll
        for (int i = 0; i < 16; ++i) { const int e = 8 * i + (F.lane >> 3), ch = F.lane & 7; const u32x4 v = ov[i]; LAS unsigned short* tp = tile + e * 65 + 8 * ch;
            tp[0] = (unsigned short)v.x; tp[1] = (unsigned short)(v.x >> 16); tp[2] = (unsigned short)v.y; tp[3] = (unsigned short)(v.y >> 16); tp[4] = (unsigned short)v.z; tp[5] = (unsigned short)(v.z >> 16); tp[6] = (unsigned short)v.w; tp[7] = (unsigned short)(v.w >> 16); }
        asm volatile("s_waitcnt lgkmcnt(0)" ::: "memory");
#pragma unroll
        for (int c = 0; c < CH; ++c) { const float o0 = bf2f(tile[(2 * F.lane) * 65 + c]), o1 = bf2f(tile[(2 * F.lane + 1) * 65 + c]);
            const float rs = rsq_(wave_sum(o0 * o0 + o1 * o1) * (1.f / HD) + EPS);
            const size_t off = (size_t)(t0 + c) * DM + h * HD + 2 * F.lane; const unsigned zv = zall[c];
            *(unsigned*)(YD + off) = pk2(o0 * rs * w0 * siluf_(bflo(zv)), o1 * rs * w1 * siluf_(bfhi(zv))); }
        asm volatile("s_waitcnt lgkmcnt(0)" ::: "memory");
    }
}
#ifdef DBG_ATTN
constexpr int CW_DBG = 20000;
__device__ __forceinline__ void dbg_compare(Frame& F, const bf16* a, const bf16* b, size_t n) {
    float* acc = (float*)(WSP(unsigned, WS_CTL) + CW_DBG); float d2 = 0.f, r2 = 0.f;
    for (size_t i = (size_t)F.gw * 64 + F.lane; i < n; i += (size_t)F.NGW * 64) { const float x = bf2f(a[i]), y = bf2f(b[i]); d2 += (x - y) * (x - y); r2 += y * y; }
    d2 = wave_sum(d2); r2 = wave_sum(r2);
    if (F.lane == 0) { atomicAdd(acc, d2); atomicAdd(acc + 1, r2); }
}
#endif

#if defined(DBG_DET) || defined(DBG_L2L)
constexpr int CW_CS = 24000;
__device__ __forceinline__ void dbg_cksum(Frame& F, const void* p, size_t bytes, int slot) {
    const unsigned* w = (const unsigned*)p; unsigned acc = 0u; const size_t nw = bytes / 4;
#ifdef DBG_NANCNT
    for (size_t i = (size_t)F.gw * 64 + F.lane; i < nw; i += (size_t)F.NGW * 64) { const unsigned v = w[i]; acc += ((v & 0x7F80u) >= (141u << 7)) + ((v & 0x7F800000u) >= (141u << 23)); }
#else
    for (size_t i = (size_t)F.gw * 64 + F.lane; i < nw; i += (size_t)F.NGW * 64) { const unsigned v = w[i]; acc += v * 2654435761u + (unsigned)(i * 40503u) * (v >> 7); }
#endif
#pragma unroll
    for (int o = 1; o < 64; o <<= 1) acc += __shfl_xor(acc, o);
    if (F.lane == 0) atomicAdd(WSP(unsigned, WS_CTL) + CW_CS + slot, acc);
}
#endif

#ifdef DBG_SIG
constexpr int CW_SIG = 26000;
__device__ __forceinline__ void dbg_sig(Frame& F, const bf16* p, size_t n, int slot) {
    double acc = 0.0, acc2 = 0.0;
    for (size_t i = (size_t)F.gw * 64 + F.lane; i < n; i += (size_t)F.NGW * 64) { unsigned hsh = (unsigned)i * 2654435761u; hsh ^= hsh >> 15; hsh *= 2246822519u; hsh ^= hsh >> 13;
        const float wgt = (float)(hsh & 0xFFFFu) * (1.f / 32768.f) - 1.f; const float x = bf2f(p[i]); acc += (double)(x * wgt); acc2 += (double)(x * x); }
    long long q1 = (long long)(acc * 65536.0), q2 = (long long)(acc2 * 65536.0);
#pragma unroll
    for (int o = 1; o < 64; o <<= 1) { q1 += __shfl_xor(q1, o); q2 += __shfl_xor(q2, o); }
    if (F.lane == 0) { unsigned long long* a = (unsigned long long*)(WSP(unsigned, WS_CTL) + CW_SIG); atomicAdd(a + 2 * slot, (unsigned long long)q1); atomicAdd(a + 2 * slot + 1, (unsigned long long)q2); }
}
#endif

#ifdef DBG_CHK
constexpr int CW_CHK = 28000;
__device__ __forceinline__ float dbg_g(const float* BA, const Args& A, int t, int h) { const float a = BA[(size_t)t * 16 + 8 + h] + A.in[5][h]; const float sp = (a > 20.f) ? a : log1pf(expf(a)); return -expf(A.in[4][h]) * sp; }
__device__ __forceinline__ void dbg_chk_acc(Frame& F, int k, float err, float ref) {
    long long q1 = (long long)((double)err * (double)err * 1048576.0), q2 = (long long)((double)ref * (double)ref * 1048576.0);
    unsigned long long* a = (unsigned long long*)(WSP(unsigned, WS_CTL) + CW_CHK); atomicAdd(a + 2 * k, (unsigned long long)q1); atomicAdd(a + 2 * k + 1, (unsigned long long)q2);
}
__device__ __forceinline__ void dbg_chunk2_check(Frame& F, const Args& A) {
    const float* BA = WSP(const float, WS_BA); const bf16* KN = WSP(const bf16, WS2_KN); const bf16* QP = WSP(const bf16, WS2_QN); const bf16* Wn = WSP(const bf16, WS2_WNEG);
    const bf16* ATT = WSP(const bf16, WS2_ATT); const bf16* KT = ws2_kt(F); const float* EGL = WSP(const float, WS_EGL);
    const int s = F.gw * 64 + F.lane; if (s >= 8192) return;
    unsigned hsh = (unsigned)s * 2654435761u; hsh ^= hsh >> 15; hsh *= 2246822519u; hsh ^= hsh >> 13;
    const int n = hsh & 255, h = (hsh >> 8) & 7, i = (hsh >> 11) & 63, d = (hsh >> 17) & 127, t0 = n * CH;
    float gci = 0.f, gl = 0.f; { float a = 0.f; for (int j = 0; j < 64; ++j) { a += dbg_g(BA, A, t0 + j, h); if (j == i) gci = a; } gl = a; }
    const float beta_i = 1.f / (1.f + expf(-BA[(size_t)(t0 + i) * 16 + h]));
    const bf16* ki = KN + (size_t)(t0 + i) * DM + h * HD;
    dbg_chk_acc(F, 0, EGL[h * NCH + n] - expf(gl), expf(gl));
    { const float ref = bf2f(ki[d]) * expf(gl - gci); dbg_chk_acc(F, 1, bf2f(KT[(size_t)(h * NCH + n) * (HD * CH) + (size_t)d * CH + i]) - ref, ref); }
    { const float kt = bf2f(KT[(size_t)(h * NCH + n) * (HD * CH) + (size_t)d * CH + i]); dbg_chk_acc(F, 4, kt - bf2f(ki[d]), bf2f(ki[d])); }
    if (n < 128) { const int c = d & 63; const bf16* tg = WSP(const bf16, 241 * MiB) + (size_t)(h * 128 + n) * 4096; float lhs = bf2f(tg[i * 64 + c]); float gcj = 0.f, gcc = 0.f;
      for (int j = 0; j < 64; ++j) { gcj += dbg_g(BA, A, t0 + j, h); if (j == c) gcc = gcj;
          if (j < i) { const bf16* kj = KN + (size_t)(t0 + j) * DM + h * HD; float dot = 0.f; for (int x = 0; x < HD; ++x) dot += bf2f(ki[x]) * bf2f(kj[x]); lhs += beta_i * dot * expf(gci - gcj) * bf2f(tg[j * 64 + c]); } }
      const float beta_c = 1.f / (1.f + expf(-BA[(size_t)(t0 + c) * 16 + h])); const float ref = (i == c) ? beta_c * expf(gcc) : 0.f; dbg_chk_acc(F, 5, lhs - ref, (i == c) ? ref : 0.05f * beta_c * expf(gcc)); }
    if (n < 128) { const bf16* tg = WSP(const bf16, 241 * MiB) + (size_t)(h * 128 + n) * 4096; float ref = 0.f, mag = 0.f;
      for (int j = 0; j < 64; ++j) { const float t = bf2f(tg[i * 64 + j]) * bf2f(KN[(size_t)(t0 + j) * DM + h * HD + d]); ref += t; mag += fabsf(t); }
      dbg_chk_acc(F, 6, -bf2f(Wn[(size_t)(t0 + i) * DM + h * HD + d]) - ref, mag); }
    if (n < 128) { const bf16* tg = WSP(const bf16, 241 * MiB) + (size_t)(h * 128 + n) * 4096; float r7 = 0.f, r8 = 0.f, mag = 0.f, gcj = 0.f;
      for (int j = 0; j < 64; ++j) { gcj += dbg_g(BA, A, t0 + j, h); const float kk = bf2f(KN[(size_t)(t0 + j) * DM + h * HD + d]); const float t = bf2f(tg[i * 64 + j]) * kk;
          r7 += t * expf(gl - gcj); r8 += bf2f(tg[j * 64 + i]) * kk; mag += fabsf(t); }
      const float wv = -bf2f(Wn[(size_t)(t0 + i) * DM + h * HD + d]); dbg_chk_acc(F, 7, wv - r7, mag); dbg_chk_acc(F, 8, wv - r8, mag); }
    if (n < 32) { const bf16* dk = WSP(const bf16, 249 * MiB) + (size_t)(h * 32 + n) * 8192; dbg_chk_acc(F, 9, bf2f(dk[d * 64 + i]) - bf2f(ki[d]), bf2f(ki[d])); }
    if (n < 32) { const float ref = bf2f(ki[d]) * expf(gl - gci); dbg_chk_acc(F, 10, bf2f(KT[(size_t)(h * NCH + n) * (HD * CH) + (size_t)d * CH + i]) - ref, ref); }
    if (n < 128) { const bf16* tg = WSP(const bf16, 241 * MiB) + (size_t)(h * 128 + n) * 4096; float ref = 0.f, mag = 0.f;
      for (int j = 0; j < 64; ++j) { const float t = bf2f(tg[i * 64 + j]) * bf2f(KN[(size_t)(t0 + j) * DM + h * HD + d]); ref += t; mag += fabsf(t); }
      dbg_chk_acc(F, n >= 32 ? 11 : 12, -bf2f(Wn[(size_t)(t0 + i) * DM + h * HD + d]) - ref, mag); }
    { float lhs = -bf2f(Wn[(size_t)(t0 + i) * DM + h * HD + d]); float gcj = 0.f;
      for (int j = 0; j < i; ++j) { gcj += dbg_g(BA, A, t0 + j, h); const bf16* kj = KN + (size_t)(t0 + j) * DM + h * HD; float dot = 0.f; for (int x = 0; x < HD; ++x) dot += bf2f(ki[x]) * bf2f(kj[x]);
          lhs += beta_i * dot * expf(gci - gcj) * (-bf2f(Wn[(size_t)(t0 + j) * DM + h * HD + d])); }
      const float ref = beta_i * expf(gci) * bf2f(ki[d]); dbg_chk_acc(F, 2, lhs - ref, ref); }
    { const int j = d & 63; if (j <= i && gci > -20.f) { float gcj = 0.f; for (int x = 0; x <= j; ++x) gcj += dbg_g(BA, A, t0 + x, h);
          const bf16* kj = KN + (size_t)(t0 + j) * DM + h * HD; const bf16* qi = QP + (size_t)(t0 + i) * DM + h * HD; float dot = 0.f; for (int x = 0; x < HD; ++x) dot += bf2f(qi[x]) * bf2f(kj[x]);
          const float ref = dot * expf(-gcj); dbg_chk_acc(F, 3, bf2f(ATT[(size_t)(h * NCH + n) * (CH * CH) + (size_t)i * CH + j]) - ref, ref); }
      else if (j > i) dbg_chk_acc(F, 3, bf2f(ATT[(size_t)(h * NCH + n) * (CH * CH) + (size_t)i * CH + j]), 0.f); }
}
#endif

#ifdef DBG_TILE
constexpr int CW_TILE = 30000;
__device__ __forceinline__ void dbg_tile_check(Frame& F, const Args& A) {
    if (F.gw >= NCH * NH) return;
    const int n = F.gw >> 3, h = F.gw & 7, t0 = n * CH, lane = F.lane;
    const float* BA = WSP(const float, WS_BA); const bf16* KN = WSP(const bf16, WS2_KN); const bf16* KT = ws2_kt(F) + (size_t)(h * NCH + n) * (HD * CH);
    float gc = 0.f, gl = 0.f; { float a = 0.f; for (int j = 0; j < 64; ++j) { a += dbg_g(BA, A, t0 + j, h); if (j == lane) gc = a; } gl = a; }
    const float f = expf(gl - gc); int bad = 0;
    for (int d = 0; d < HD; ++d) { const float ref = bf2f(KN[(size_t)(t0 + lane) * DM + h * HD + d]) * f; const float got = bf2f(KT[(size_t)d * CH + lane]); if (!(fabsf(got - ref) <= 0.02f * fabsf(ref) + 1e-3f)) ++bad; }
    bad = (int)wave_sum((float)bad);
    if (lane == 0 && bad > 0) { unsigned* w = WSP(unsigned, WS_CTL) + CW_TILE; atomicAdd(w, 1u); atomicMin(w + 1, (unsigned)n); atomicOr(w + 2 + n, 1u << h); atomicAdd(w + 300, (unsigned)bad); atomicOr(w + 301, 1u << h); if (bad > 4096) atomicOr(w + 302, 1u << h); }
}
#endif
template <int R> __device__ __forceinline__ void post_rows(Frame& F, const Args& A, int m0, int stride) {
    const float* x = A.in[0]; const bf16* T = WSP(const bf16, WS_T); bf16* H2 = WSP(bf16, WS_H2);
    const f32x4* w1 = (const f32x4*)A.in[10] + F.lane; const f32x4* w2 = (const f32x4*)A.in[11] + F.lane;
    unsigned long long t8[R][4]; f32x4 xv[R][4];
#pragma unroll
    for (int k = 0; k < R; ++k) { const int m = m0 + k * stride; const unsigned long long* tr = (const unsigned long long*)(T + (size_t)m * DM) + F.lane; const f32x4* xr = (const f32x4*)(x + (size_t)m * DM) + F.lane;
#pragma unroll
        for (int j = 0; j < 4; ++j) { t8[k][j] = tr[64 * j]; xv[k][j] = xr[64 * j]; } }
#pragma unroll
    for (int k = 0; k < R; ++k) { const int m = m0 + k * stride; unsigned long long* x1row = (unsigned long long*)(WSP(bf16, WS_X1B) + (size_t)m * DM) + F.lane;
        f32x4 tv[4]; float ss = 0.f;
#pragma unroll
        for (int j = 0; j < 4; ++j) { const unsigned long long w8 = t8[k][j]; const unsigned lo = (unsigned)w8, hi = (unsigned)(w8 >> 32); tv[j] = (f32x4){bflo(lo), bfhi(lo), bflo(hi), bfhi(hi)}; ss += (tv[j].x * tv[j].x + tv[j].y * tv[j].y) + (tv[j].z * tv[j].z + tv[j].w * tv[j].w); }
        const float rs = rsq_(wave_sum(ss) * (1.f / DM) + EPS); float s2 = 0.f;
#pragma unroll
        for (int j = 0; j < 4; ++j) { tv[j] = xv[k][j] + tv[j] * rs * w1[64 * j]; x1row[64 * j] = (unsigned long long)pk2(tv[j].x, tv[j].y) | ((unsigned long long)pk2(tv[j].z, tv[j].w) << 32);
            s2 += (tv[j].x * tv[j].x + tv[j].y * tv[j].y) + (tv[j].z * tv[j].z + tv[j].w * tv[j].w); }
        const float r2 = rsq_(wave_sum(s2) * (1.f / DM) + EPS);
        unsigned long long* o8 = (unsigned long long*)(H2 + (size_t)m * DM) + F.lane;
#pragma unroll
        for (int j = 0; j < 4; ++j) { const f32x4 hv = tv[j] * r2 * w2[64 * j]; o8[64 * j] = (unsigned long long)pk2(hv.x, hv.y) | ((unsigned long long)pk2(hv.z, hv.w) << 32); } }
}
__device__ __forceinline__ void p_post_mix(Frame& F, const Args& A) {
    int m = F.gw;
    for (; m + F.NGW < S; m += 2 * F.NGW) post_rows<2>(F, A, m, F.NGW);
    if (m < S) post_rows<1>(F, A, m, F.NGW);
}
#if !defined(DBG_NAN) && !defined(DBG_DET) && !defined(DBG_ATTN)
template <int R> __device__ __forceinline__ void final_rows(Frame& F, const Args& A, int m0, int stride) {
    const bf16* Fd = WSP(const bf16, WS_F); const f32x4* w = (const f32x4*)A.in[15] + F.lane;
    unsigned long long f8[R][4], x8[R][4];
#pragma unroll
    for (int k = 0; k < R; ++k) { const int m = m0 + k * stride; const unsigned long long* fr = (const unsigned long long*)(Fd + (size_t)m * DM) + F.lane; const unsigned long long* xr = (const unsigned long long*)(WSP(const bf16, WS_X1B) + (size_t)m * DM) + F.lane;
#pragma unroll
        for (int j = 0; j < 4; ++j) { f8[k][j] = fr[64 * j]; x8[k][j] = xr[64 * j]; } }
#pragma unroll
    for (int k = 0; k < R; ++k) { const int m = m0 + k * stride; f32x4* orow = (f32x4*)(F.out + (size_t)m * DM) + F.lane;
        f32x4 fv[4]; float ss = 0.f;
#pragma unroll
        for (int j = 0; j < 4; ++j) { const unsigned long long w8 = f8[k][j]; const unsigned lo = (unsigned)w8, hi = (unsigned)(w8 >> 32); fv[j] = (f32x4){bflo(lo), bfhi(lo), bflo(hi), bfhi(hi)}; ss += (fv[j].x * fv[j].x + fv[j].y * fv[j].y) + (fv[j].z * fv[j].z + fv[j].w * fv[j].w); }
        const float rs = rsq_(wave_sum(ss) * (1.f / DM) + EPS);
#pragma unroll
        for (int j = 0; j < 4; ++j) { const unsigned lo = (unsigned)x8[k][j], hi = (unsigned)(x8[k][j] >> 32); const f32x4 xv = {bflo(lo), bfhi(lo), bflo(hi), bfhi(hi)}; orow[64 * j] = xv + fv[j] * rs * w[64 * j]; } }
}
__device__ __forceinline__ void p_final(Frame& F, const Args& A) {
    int m = F.gw;
    for (; m + F.NGW < S; m += 2 * F.NGW) final_rows<2>(F, A, m, F.NGW);
    if (m < S) final_rows<1>(F, A, m, F.NGW);
}
#else
__device__ __forceinline__ void p_final(Frame& F, const Args& A) {
    const bf16* Fd = WSP(const bf16, WS_F);
    for (int m = F.gw; m < S; m += F.NGW) {
        const unsigned long long* fr = (const unsigned long long*)(Fd + (size_t)m * DM) + F.lane; f32x4* orow = (f32x4*)(F.out + (size_t)m * DM) + F.lane; const f32x4* w = (const f32x4*)A.in[15] + F.lane;
        f32x4 fv[4]; float ss = 0.f;
#pragma unroll
        for (int j = 0; j < 4; ++j) { const unsigned long long w8 = fr[64 * j]; const unsigned lo = (unsigned)w8, hi = (unsigned)(w8 >> 32); fv[j] = (f32x4){bflo(lo), bfhi(lo), bflo(hi), bfhi(hi)}; ss += (fv[j].x * fv[j].x + fv[j].y * fv[j].y) + (fv[j].z * fv[j].z + fv[j].w * fv[j].w); }
        const float rs = rsq_(wave_sum(ss) * (1.f / DM) + EPS);
#pragma unroll
        for (int j = 0; j < 4; ++j) { f32x4 ov = orow[64 * j] + fv[j] * rs * w[64 * j];
#ifdef DBG_NAN
#pragma unroll
            for (int e = 0; e < 4; ++e) if (!(fabsf(ov[e]) < 1e30f)) ov[e] = 12345.f;
#endif
            orow[64 * j] = ov; }
#ifdef DBG_DET
        { const unsigned* cs = WSP(const unsigned, WS_CTL) + CW_CS; float pz = 0.f;
          for (int k = 12; k >= 0; --k) if (cs[k] != cs[16 + k]) pz = __builtin_ldexpf(1.f, 40 - 2 * k);
#pragma unroll
          for (int j = 0; j < 4; ++j) orow[64 * j] = orow[64 * j] + pz; }
#endif
#ifdef DBG_ATTN
        { const float* acc = (const float*)(WSP(unsigned, WS_CTL) + CW_DBG); const float rv = acc[0] / acc[1]; const float pz = !(rv < DBG_TOL) ? 1000.f : 0.f;
#pragma unroll
          for (int j = 0; j < 4; ++j) orow[64 * j] = orow[64 * j] + pz; }
#endif
    }
}

#endif
constexpr int NPHASE = 18;
#ifndef MK_N_LAUNCHES
#define MK_N_LAUNCHES 1
#endif
constexpr int N_LAUNCHES = MK_N_LAUNCHES;
__global__ void __launch_bounds__(NWAVES * 64, 2) fwd(Args args) {
    extern __shared__ __attribute__((aligned(16))) unsigned char lds[];
    Frame F;
    F.lds = (LAS unsigned char*)lds; F.MISC = (volatile LAS unsigned*)(F.lds + MISC_OFF);
    F.tid = threadIdx.x; F.lane = F.tid & 63; F.wave = __builtin_amdgcn_readfirstlane(F.tid >> 6);
    F.G = gridDim.x; F.gw = blockIdx.x * NWAVES + F.wave; F.NGW = F.G * NWAVES;
    F.out = args.out; F.ws = args.ws;
    for (int u = F.tid; u < (LDS_BYTES - LDSCTL_OFF) / 4; u += NWAVES * 64) ((LAS unsigned*)(F.lds + LDSCTL_OFF))[u] = 0u;
    __syncthreads();
    XcdBarrier bar; bar.bar = (unsigned*)(F.ws + WS_CTL) + CW_BAR; bar.x = 0; bar.st = nullptr;
    if (N_LAUNCHES == 1) bar = xcd_barrier_post((unsigned*)(F.ws + WS_CTL) + CW_BAR, F.MISC + 8);
#define GRID_BAR() do { if (N_LAUNCHES == 1) xcd_barrier(bar); } while (0)
    const int lo = args.ph_lo, hi = args.ph_hi;
#ifdef PROBE_LO
    unsigned long long pr_t0 = 0ull, pr_dt = 0ull;
#define PROBE_AT(k) do { if (blockIdx.x == 0 && F.tid == 0) { if ((k) == PROBE_LO) pr_t0 = __builtin_amdgcn_s_memrealtime(); if ((k) == PROBE_HI + 1) pr_dt = __builtin_amdgcn_s_memrealtime() - pr_t0; } } while (0)
#else
#define PROBE_AT(k) do {} while (0)
#endif
#ifdef DBG_L2L
#define CK(k, p, n) dbg_cksum(F, (p), (n), (k))
#define CKB() GRID_BAR()
#else
#define CK(k, p, n) do {} while (0)
#define CKB() do {} while (0)
#endif
#if defined(ONLY_PH)
#define PH_EN(k) ((k) == ONLY_PH)
#elif defined(PH_MASK)
#define PH_EN(k) (((PH_MASK) >> (k)) & 1)
#else
#define PH_EN(k) true
#endif
#define IN(k) (PH_EN(k) && lo <= (k) && (k) < hi)
#define BOTH(k) (IN(k) && IN((k) + 1))
#define GEMM(EPI, Aoff, Boff, N_, K_, ...) do { pg8::Gemm g{(const pg8::bf16_t*)(F.ws + (Aoff)), (const pg8::bf16_t*)(F.ws + (Boff)), S, (N_), (K_)}; pg8::StaticOrder So; So.init(S, (N_), F.G, (int)blockIdx.x); \
        EPI E{__VA_ARGS__}; pg8::gemm_phase<EPI, pg8::StaticOrder, true, true>(F.lds + RING_OFF, g, So, E); } while (0)

    PROBE_AT(0);
    if (IN(0)) { p_prologue(F, args); if (BOTH(0)) GRID_BAR(); }
    CK(0, F.ws + WS_H, T32); CK(0, F.ws + WS_BA, 1 * MiB); CK(0, F.ws + WS_WTA, 41 * MiB - 512 * 1024); CKB();
    PROBE_AT(1);
    if (IN(1)) { GEMM(pg8::EpiRope, WS_H, WS_WTA, 3072, DM, WSP(pg8::bf16_t, WS_R1), WSP(const float, WS_COS), WSP(const float, WS_SIN), WSP(float, WS_KMEAN)); if (BOTH(1)) GRID_BAR(); }
    CK(1, F.ws + WS_R1, 3 * T32); CKB();
    PROBE_AT(2);
#ifndef TOPK2
#define TOPK2 1
#endif
#if !TOPK2
    if (IN(2)) { p_kmean(F, args); if (BOTH(2)) GRID_BAR(); }
#endif
    CK(2, F.ws + WS_KMEAN, 256 * 1024); CKB();
#ifndef ATTN_FAST
#define ATTN_FAST 1
#endif
#if ATTN_FAST
    PROBE_AT(3);
#if TOPK2
    if (IN(3)) { p_topk2(F, args); if (BOTH(3)) GRID_BAR();
#ifdef BAR_PROBE
        for (int i_ = 0; i_ < 8; ++i_) GRID_BAR();
#endif
    }
#else
    if (IN(3)) { p_topk_bucket(F, args); if (BOTH(3)) GRID_BAR(); }
#endif
    CK(3, F.ws + WS_TOPI, (size_t)S * NH * 12); CKB();
    PROBE_AT(4);
#ifdef WGSTAT
#define WGSTAT_RUN(k, call) do { const unsigned long long t0_ = __builtin_amdgcn_s_memrealtime(); call; if (WGSTAT_PH == (k)) { __syncthreads(); if (F.tid == 0) { const unsigned dt_ = (unsigned)(__builtin_amdgcn_s_memrealtime() - t0_); \
        unsigned* w_ = WSP(unsigned, WS_CTL) + 30000; atomicMax(w_, dt_); atomicAdd(w_ + 1, dt_); atomicMin(w_ + 2, 0xFFFFFFFFu - dt_); } } } while (0)
#else
#define WGSTAT_RUN(k, call) call
#endif
    if (IN(4)) { PROBE_AT(40); WGSTAT_RUN(40, p_attn_sel(F, args)); GRID_BAR(); PROBE_AT(41); WGSTAT_RUN(41, p_attn_own(F, args)); PROBE_AT(42);
#ifdef DBG_ATTN
        GRID_BAR(); p_attn_naive(F, args); GRID_BAR(); dbg_compare(F, WSP(const bf16, WS_YA), (const bf16*)F.out, (size_t)S * DM);
#endif
        if (BOTH(4)) GRID_BAR(); }
    CK(4, F.ws + WS_YA, T32); CKB();
#else
    PROBE_AT(3);
    if (IN(3)) { p_topk(F, args); if (BOTH(3)) GRID_BAR(); }
    PROBE_AT(4);
    if (IN(4)) { p_attn_naive(F, args); if (BOTH(4)) GRID_BAR(); }
#endif
#ifdef DBG_CHK
    {   GEMM(pg8::EpiGen<0>, WS_H, WS_WTB, 4096, DM, WSP(pg8::bf16_t, WS_R1), DM, 1024, (size_t)S * DM, nullptr); GRID_BAR();
        { ConvHalo hl; p_dn_conv2_halo(F, hl); GRID_BAR(); p_dn_conv2(F, args, hl); GRID_BAR(); }
        p_dn_chunk2(F, args); GRID_BAR();
        dbg_chunk2_check(F, args); GRID_BAR();
#ifdef DBG_TILE
        if (blockIdx.x == 0 && F.tid == 0) WSP(unsigned, WS_CTL)[CW_TILE + 1] = 0xFFFFu; GRID_BAR(); dbg_tile_check(F, args); GRID_BAR();
#endif
        }
#elif defined(DBG_SIG)
    {
      { Frame Fp = F; asm volatile("" : "+s"(Fp.ws), "+s"(Fp.out), "+v"(Fp.lane), "+v"(Fp.tid));
        GEMM(pg8::EpiGen<0>, WS_H, WS_WTB, 4096, DM, WSP(pg8::bf16_t, WS_R1), DM, 1024, (size_t)S * DM, nullptr); GRID_BAR();
        p_dn_conv(Fp, args); GRID_BAR(); p_dn_chunk(Fp, args); GRID_BAR(); p_dn_relayout1(Fp, args); GRID_BAR(); p_dn_relayout2(Fp, args); GRID_BAR();
        dbg_sig(Fp, (const bf16*)Fp.out, (size_t)S * DM, 0); dbg_sig(Fp, WSPF(const bf16, WS_W), (size_t)S * DM, 1); dbg_sig(Fp, WSPF(const bf16, WS_KT), (size_t)S * DM, 2);
        dbg_sig(Fp, WSPF(const bf16, WS_UT), (size_t)S * DM, 3); dbg_sig(Fp, WSPF(const bf16, WS_ATT), (size_t)S * DM / 2, 4); GRID_BAR();
      }
      { Frame Fp = F; asm volatile("" : "+s"(Fp.ws), "+s"(Fp.out), "+v"(Fp.lane), "+v"(Fp.tid));
        p_hrecompute(Fp, args); GRID_BAR();
        GEMM(pg8::EpiGen<0>, WS_H, WS_WTB, 4096, DM, WSP(pg8::bf16_t, WS_R1), DM, 1024, (size_t)S * DM, nullptr); GRID_BAR();
        { ConvHalo hl; p_dn_conv2_halo(Fp, hl); GRID_BAR(); p_dn_conv2(Fp, args, hl); GRID_BAR(); }
        p_dn_chunk2(Fp, args); GRID_BAR();
        dbg_sig(Fp, WSPF(const bf16, WS2_QN), (size_t)S * DM, 8); dbg_sig(Fp, WSPF(const bf16, WS2_WNEG), (size_t)S * DM, 9); dbg_sig(Fp, ws2_kt(Fp), (size_t)S * DM, 10);
        dbg_sig(Fp, ws2_ut(Fp), (size_t)S * DM, 11); dbg_sig(Fp, WSPF(const bf16, WS2_ATT), (size_t)S * DM / 2, 12); GRID_BAR();
      }
    }
#elif defined(DBG_DET)
#define DET_PASS(P) { Frame Fp = F; asm volatile("" : "+s"(Fp.ws), "+s"(Fp.out), "+v"(Fp.lane), "+v"(Fp.tid)); \
    p_hrecompute(Fp, args); GRID_BAR(); \
    GEMM(pg8::EpiGen<0>, WS_H, WS_WTB, 4096, DM, WSP(pg8::bf16_t, WS_R1), DM, 1024, (size_t)S * DM, nullptr); GRID_BAR(); \
    dbg_cksum(Fp, Fp.ws + WS_R1, 4 * T32, (P) * 16 + 0); GRID_BAR(); \
    { ConvHalo hl; p_dn_conv2_halo(Fp, hl); GRID_BAR(); p_dn_conv2(Fp, args, hl); GRID_BAR(); } \
    dbg_cksum(Fp, Fp.ws + WS2_QN, T32, (P) * 16 + 1); dbg_cksum(Fp, Fp.ws + WS2_KN, T32, (P) * 16 + 2); dbg_cksum(Fp, ws2_kt(Fp), T32, (P) * 16 + 3); dbg_cksum(Fp, ws2_ut(Fp), T32, (P) * 16 + 4); GRID_BAR(); \
    p_dn_chunk2(Fp, args); GRID_BAR(); \
    dbg_cksum(Fp, Fp.ws + WS2_ATT, T32 / 2, (P) * 16 + 5); dbg_cksum(Fp, Fp.ws + WS2_QN, T32, (P) * 16 + 6); dbg_cksum(Fp, ws2_ut(Fp), T32, (P) * 16 + 7); dbg_cksum(Fp, Fp.ws + WS2_WNEG, T32, (P) * 16 + 8); \
    dbg_cksum(Fp, ws2_kt(Fp), T32, (P) * 16 + 9);  GRID_BAR(); \
    p_dn_scan_fast(Fp, args); GRID_BAR(); \
    dbg_cksum(Fp, ws2_ut(Fp), T32, (P) * 16 + 11); GRID_BAR(); \
    p_dn_out_fast(Fp, args); GRID_BAR(); \
    dbg_cksum(Fp, Fp.ws + WS2_YD, T32, (P) * 16 + 12); GRID_BAR(); }
    { DET_PASS(0) }
    { DET_PASS(1) }
    p_hrecompute(F, args); GRID_BAR();
#else
    PROBE_AT(5);
    if (IN(5)) { GEMM(pg8::EpiGen<5>, WS_H, WS_WTB, 4096, DM, WSP(pg8::bf16_t, WS_R1), DM, 1024, (size_t)S * DM, WSP(const pg8::bf16_t, WS_HALO)); if (BOTH(5)) GRID_BAR(); }
    CK(5, F.ws + WS_R1, 4 * T32); CKB();
#if DN2
    PROBE_AT(6);
    if (IN(6)) { ConvHalo hl; p_dn_conv2_halo(F, hl); if (N_LAUNCHES != 1) GRID_BAR(); p_dn_conv2(F, args, hl); if (BOTH(6)) GRID_BAR(); }
    CK(6, F.ws + WS2_QN, 2 * T32); CK(6, F.out, 2 * T32); CKB();
    PROBE_AT(7);
    if (IN(7)) { p_dn_chunk2(F, args); if (BOTH(7)) GRID_BAR(); }
    CK(7, F.ws + WS2_ATT, T32 / 2); CK(7, F.ws + WS2_QN, T32); CK(7, F.out, 2 * T32); CK(7, F.ws + WS2_WNEG, T32); CK(7, F.ws + WS_EGL, 8192); CKB();
#else
    PROBE_AT(6);
    if (IN(6)) { p_dn_conv(F, args); if (BOTH(6)) GRID_BAR(); }
    PROBE_AT(7);
    if (IN(7)) { p_dn_chunk(F, args); if (BOTH(7)) GRID_BAR(); }
#endif
#ifndef DN_FAST
#define DN_FAST 1
#endif
#if DN_FAST
#if DN2
    PROBE_AT(8);
#ifndef SCAN2
#define SCAN2 1
#endif
#if SCAN2
    if (IN(8)) { PROBE_AT(80); p_dn_scan2_A(F, args); GRID_BAR(); PROBE_AT(81); p_dn_scan2_B(F, args); GRID_BAR(); PROBE_AT(82); if (blockIdx.x < 128) p_dn_scan2_C(F, args); else { p_hrecompute_sub(F, args, WSP(bf16, WS2_HALT), ((int)blockIdx.x - 128) * NWAVES + F.wave, 128 * NWAVES);
#if DN2_LATE_WT
            p_wtrans(F, args, WT_ITEMS_EARLY, WT_ITEMS_ALL, ((int)blockIdx.x - 128) * NWAVES + F.wave, 128 * NWAVES);
#endif
        } if (BOTH(8)) GRID_BAR(); PROBE_AT(83); }
#else
    if (IN(8)) { p_dn_scan_fast(F, args); if (BOTH(8)) GRID_BAR(); }
#endif
    CK(8, ws2_ut(F), T32); CKB();
#else
    PROBE_AT(8);
    if (IN(8)) { p_dn_relayout1(F, args); GRID_BAR(); p_dn_relayout2(F, args); GRID_BAR(); p_dn_scan_fast(F, args); if (BOTH(8)) GRID_BAR(); }
#endif
    PROBE_AT(9);
#if DN2 && SCAN2
    if (IN(9)) { p_dn_out_fast(F, args); if (BOTH(9)) GRID_BAR(); }
#else
    if (IN(9)) { p_dn_out_fast(F, args); p_hrecompute(F, args); if (BOTH(9)) GRID_BAR(); }
#endif
    CK(9, F.ws + WS2_YD, T32); CK(9, F.ws + WS_H, T32); CKB();
#else
    PROBE_AT(8);
    if (IN(8)) { p_dn_scan_naive(F, args); if (BOTH(8)) GRID_BAR(); }
    PROBE_AT(9);
    if (IN(9)) { p_dn_out(F, args); p_hrecompute(F, args); if (BOTH(9)) GRID_BAR(); }
#endif
#endif
    PROBE_AT(10);
    if (IN(10)) { pg8::Gemm g{(const pg8::bf16_t*)(F.ws + WS2_HALT), (const pg8::bf16_t*)(F.ws + WS_WTG), S, 2048, DM}; pg8::PairOrder Po; Po.init(S, DM, 2, F.G, (int)blockIdx.x);
        pg8::EpiGen<1> E{(pg8::bf16_t*)F.out, DM, 1024, (size_t)S * DM, nullptr}; pg8::gemm_phase<pg8::EpiGen<1>, pg8::PairOrder, true, true>(F.lds + RING_OFF, g, Po, E); if (BOTH(10) && N_LAUNCHES != 1) GRID_BAR(); }
    CK(10, F.out, 2 * T32); CKB();
    PROBE_AT(11);
    if (IN(11)) { GEMM(pg8::EpiGen<2>, WS_YA, WS_WTOA, 1024, DM, (pg8::bf16_t*)F.out, DM, 0, 0, nullptr); if (BOTH(11) && N_LAUNCHES != 1) GRID_BAR(); }
    CK(11, F.out, T32); CKB();
    PROBE_AT(12);
    if (IN(12)) { GEMM(pg8::EpiGen<3>, SCAN_YD, WS_WTOD, 1024, DM, (pg8::bf16_t*)F.out, DM, 0, 0, (const pg8::bf16_t*)F.out + (size_t)S * DM); if (BOTH(12)) GRID_BAR(); }
    CK(12, F.out, T32); CKB();
    PROBE_AT(13);
    if (IN(13)) { pg8::Gemm g{(const pg8::bf16_t*)F.out, WSP(const pg8::bf16_t, WS_WTOUT), S, DM, DM}; pg8::StaticOrder So; So.init(S, DM, F.G, (int)blockIdx.x);
        pg8::EpiGen<0> E{WSP(pg8::bf16_t, WS_T), DM, 0, 0, nullptr}; pg8::gemm_phase<pg8::EpiGen<0>, pg8::StaticOrder, true, true>(F.lds + RING_OFF, g, So, E); if (BOTH(13)) GRID_BAR(); }
    CK(13, F.ws + WS_T, 2 * T32); CKB();
    PROBE_AT(14);
    if (IN(14)) { p_post_mix(F, args); if (BOTH(14)) GRID_BAR(); }
    CK(14, F.out, 2 * T32); CK(14, F.ws + WS_H2, T32); CKB();
    PROBE_AT(15);
    if (IN(15)) { GEMM(pg8::EpiGen<4>, WS_H2, WS_WTGU, 2 * DFF, DM, WSP(pg8::bf16_t, WS_ACT), DFF, 0, 0, nullptr); if (BOTH(15)) GRID_BAR(); }
    CK(15, F.ws + WS_ACT, ACT_BYTES); CKB();
    PROBE_AT(16);
    if (IN(16)) { pg8::Gemm g{WSP(const pg8::bf16_t, WS_ACT), WSP(const pg8::bf16_t, WS_WTDN), S, DM, DFF}; pg8::StaticOrder So; So.init(S, DM, F.G, (int)blockIdx.x);
        pg8::EpiGen<0> E{WSP(pg8::bf16_t, WS_F), DM, 0, 0, nullptr}; pg8::gemm_phase<pg8::EpiGen<0>, pg8::StaticOrder, true, true>(F.lds + RING_OFF, g, So, E); if (BOTH(16)) GRID_BAR(); }
    CK(16, F.ws + WS_F, 2 * T32); CKB();
#ifdef DBG_TILE
    PROBE_AT(17);
    if (IN(17)) { const unsigned* w = WSP(const unsigned, WS_CTL) + CW_TILE; const unsigned cnt = w[0], mn = w[1]; const unsigned hm = (mn < 256u) ? w[2 + mn] : 0u;
        const int sel = DBG_TILE; const unsigned val = (sel == 1) ? (cnt > 120u ? 120u : cnt) : (sel == 2) ? (mn > 255u ? 127u : (mn >> 1)) : (sel == 3 ? (mn & 1u) * 8u + 0u + (hm & 0xFu) * 0u + (hm & 0xFFu) / 4u : (hm & 3u));
        float pz = __builtin_ldexpf(1.f, (int)val + 4); if (sel == 6) pz = __builtin_ldexpf(1.f, (int)(w[301] & 15u) + 4); if (sel == 7) pz = __builtin_ldexpf(1.f, (int)(w[301] >> 4) + 4); if (sel == 8) pz = __builtin_ldexpf(1.f, (int)(w[302] & 15u) + 4); if (sel == 9) pz = __builtin_ldexpf(1.f, (int)(w[302] >> 4) + 4);
        if (sel == 5) { unsigned be = w[300], lg = 0; while (be > 1u) { be >>= 1; ++lg; } pz = __builtin_ldexpf(1.f, (int)lg + 4); }
        for (size_t i = (size_t)F.gw * 64 + F.lane; i < (size_t)S * DM; i += (size_t)F.NGW * 64) F.out[i] = args.in[0][i] + pz; }
#elif defined(DBG_CHK)
    PROBE_AT(17);
    if (IN(17)) { const long long* sg = (const long long*)(WSP(unsigned, WS_CTL) + CW_CHK); float pz = 0.f;
        for (int k = 12; k >= 9; --k) { const double e2 = (double)sg[2 * k], r2 = (double)sg[2 * k + 1]; if (!(e2 <= 1e-3 * r2 + 16.0)) pz += 1024.f * (float)(1 << (2 * (k - 9))); }
        for (size_t i = (size_t)F.gw * 64 + F.lane; i < (size_t)S * DM; i += (size_t)F.NGW * 64) F.out[i] = args.in[0][i] + pz; }
#elif defined(DBG_SIG)
    PROBE_AT(17);
    if (IN(17)) { const long long* sg = (const long long*)(WSP(unsigned, WS_CTL) + CW_SIG); float pz = 0.f;
        for (int k = 4; k >= 0; --k) { const float a0 = (float)((double)sg[2 * k] / 65536.0), a1 = (float)((double)sg[2 * (8 + k)] / 65536.0), n0 = (float)((double)sg[2 * k + 1] / 65536.0), n1 = (float)((double)sg[2 * (8 + k) + 1] / 65536.0);
            const bool bad = !(fabsf(a0 - a1) <= 0.02f * sqrtf(n0) + 1e-3f) || !(fabsf(n0 - n1) <= 0.02f * (n0 + n1)); if (bad) pz = __builtin_ldexpf(1.f, 40 - 2 * k); }
        for (size_t i = (size_t)F.gw * 64 + F.lane; i < (size_t)S * DM; i += (size_t)F.NGW * 64) F.out[i] = args.in[0][i] + pz; }
#elif defined(DBG_DET)
    PROBE_AT(17);
    if (IN(17)) { const unsigned* cs = WSP(const unsigned, WS_CTL) + CW_CS; float pz = 0.f;
#ifdef DBG_NANCNT
        for (int k = 12; k >= 0; --k) if (cs[k] != 0u) pz = __builtin_ldexpf(1.f, 40 - 2 * k);
#else
        for (int k = 12; k >= 0; --k) if (cs[k] != cs[16 + k]) pz = __builtin_ldexpf(1.f, 40 - 2 * k);
#endif
        for (size_t i = (size_t)F.gw * 64 + F.lane; i < (size_t)S * DM; i += (size_t)F.NGW * 64) F.out[i] = args.in[0][i] + pz; }
#else
    PROBE_AT(17);
    if (IN(17)) { p_final(F, args); }
#endif
#ifdef WGSTAT
    if (blockIdx.x == 0 && F.tid == 0) { const unsigned* w_ = WSP(const unsigned, WS_CTL) + 30000; const unsigned v0 = __hip_atomic_load(w_, __ATOMIC_RELAXED, __HIP_MEMORY_SCOPE_AGENT), v1 = __hip_atomic_load(w_ + 1, __ATOMIC_RELAXED, __HIP_MEMORY_SCOPE_AGENT), v2 = __hip_atomic_load(w_ + 2, __ATOMIC_RELAXED, __HIP_MEMORY_SCOPE_AGENT);
        const unsigned long long dd = 8ull * (unsigned long long)(WGSTAT == 1 ? v0 : (WGSTAT == 2 ? v1 / (unsigned)F.G : 0xFFFFFFFFu - v2));
        const unsigned long long ts = __builtin_amdgcn_s_memrealtime(); while (__builtin_amdgcn_s_memrealtime() - ts < dd) __builtin_amdgcn_s_sleep(8); }
#endif
#ifdef SCAN_PROBE
    __syncthreads();
    if (blockIdx.x == 0 && F.tid == 0) { const unsigned long long ts = __builtin_amdgcn_s_memrealtime(); const unsigned long long dd = 8ull * (unsigned long long)F.MISC[16]; while (__builtin_amdgcn_s_memrealtime() - ts < dd) __builtin_amdgcn_s_sleep(8); }
#endif
#ifdef PROBE_LO
    PROBE_AT(18);
    if (blockIdx.x == 0 && F.tid == 0) { const unsigned long long ts = __builtin_amdgcn_s_memrealtime(); while (__builtin_amdgcn_s_memrealtime() - ts < 8ull * pr_dt) __builtin_amdgcn_s_sleep(8); }
#endif
#ifdef DBG_L2L
    GRID_BAR(); CK(17, F.out, 2 * T32); GRID_BAR();
    { unsigned* cs = WSP(unsigned, WS_CTL) + CW_CS; unsigned* save = WSP(unsigned, 253 * MiB);
      if (args.pass == 0) { if (blockIdx.x == 0 && F.tid < 32) save[F.tid] = cs[F.tid]; }
      else { float pz = 0.f; for (int k = 17; k >= 0; --k) if (cs[k] != save[k]) pz = __builtin_ldexpf(1.f, 44 - 2 * k);
          if (pz != 0.f) for (size_t i = (size_t)F.gw * 64 + F.lane; i < (size_t)S * DM; i += (size_t)F.NGW * 64) F.out[i] += pz; } }
#endif
#undef IN
#undef BOTH
}

extern "C" void kernel_launch(void* const* d_in, const int* in_sizes, int n_in, void* d_out, int out_size, void* d_ws, size_t ws_size, hipStream_t stream) {
    static int grid = 0;
    if (grid == 0) {
        if (n_in != 16 || in_sizes[0] != S * DM || out_size != S * DM || ws_size < WS_END) { fprintf(stderr, "kernel_launch: unexpected shapes (n_in %d, in0 %d, out %d, ws %zu); nothing launched\n", n_in, n_in > 0 ? in_sizes[0] : -1, out_size, ws_size); grid = -1; return; }
        int dev = 0, cus = 0, per_cu = 0;
        if (hipGetDevice(&dev) != hipSuccess || hipDeviceGetAttribute(&cus, hipDeviceAttributeMultiprocessorCount, dev) != hipSuccess) { grid = -1; return; }
        if (hipFuncSetAttribute((const void*)fwd, hipFuncAttributeMaxDynamicSharedMemorySize, LDS_BYTES) != hipSuccess) { fprintf(stderr, "kernel_launch: hipFuncSetAttribute failed\n"); grid = -1; return; }
        if (hipOccupancyMaxActiveBlocksPerMultiprocessor(&per_cu, (const void*)fwd, NWAVES * 64, LDS_BYTES) != hipSuccess || per_cu < 1) fprintf(stderr, "kernel_launch: occupancy query says %d\n", per_cu);
        (void)hipGetLastError();
        grid = cus;
    }
    if (grid < 0) return;
    if (hipMemsetAsync((char*)d_ws + WS_CTL, 0, CTL_ZERO_BYTES, stream) != hipSuccess) return;
    Args a{};
    for (int i = 0; i < 16; ++i) a.in[i] = (const float*)d_in[i];
    a.out = (float*)d_out; a.ws = (unsigned char*)d_ws;
#ifdef DBG_L2L
    hipMemsetAsync((char*)d_ws + CTL_ZERO_BYTES, 0xA5, WS_END - CTL_ZERO_BYTES, stream); hipMemsetAsync(d_out, 0xA5, (size_t)S * DM * 4, stream);
    for (int li = 0; li < 2; ++li) {
        if (li == 1) hipMemsetAsync((char*)d_ws + WS_CTL, 0, CTL_ZERO_BYTES, stream);
        a.ph_lo = 0; a.ph_hi = NPHASE; a.pass = li;
#else
    for (int li = 0; li < N_LAUNCHES; ++li) {
        a.ph_lo = (N_LAUNCHES == 1) ? 0 : li; a.ph_hi = (N_LAUNCHES == 1) ? NPHASE : li + 1;
#endif
        hipLaunchKernelGGL(fwd, dim3(grid), dim3(NWAVES * 64), LDS_BYTES, stream, a);
        if (hipPeekAtLastError() != hipSuccess) { fprintf(stderr, "kernel_launch: launch %d failed\n", li); break; }
    }
}
```

```cpp
#include <hip/hip_runtime.h>
#include <cstdio>
#include <cstdint>
#include <cmath>
namespace pg8 {
#define PG8_LAS __attribute__((address_space(3)))
typedef unsigned short bf16_t;
typedef short bf16x8 __attribute__((ext_vector_type(8)));
typedef float f32x4 __attribute__((ext_vector_type(4)));
typedef unsigned u32x4 __attribute__((ext_vector_type(4)));
constexpr int BM = 256, BK = 64, HALF = 128, HTB = HALF * BK * 2  , STAGE_BYTES = 8 * HTB, NXCD = 8, WGM = 8;

__host__ __device__ __forceinline__ int lds_byte(int r, int c) { const int st = (r >> 4) * 2 + (c >> 5), rr = r & 15, cc = c & 31, ob = rr * 64 + cc * 2; return st * 1024 + (ob ^ (((ob >> 9) & 1) << 5)); }
__host__ __device__ __forceinline__ void stage_rc(int b, int& R, int& C) { const int st = b / 1024, sb = b % 1024, swz = sb ^ (((sb >> 9) & 1) << 5); R = (st >> 1) * 16 + swz / 64; C = (st & 1) * 32 + (swz % 64) / 2; }
__host__ __device__ __forceinline__ int perm32(int rho) { const int n = rho >> 4, i = rho & 15; return 8 * (i >> 2) + 4 * n + (i & 3); }

struct Unit { int pm, pn; };
struct Gemm { const bf16_t* A; const bf16_t* Bt; int M, N, K; };

struct StaticOrder {
    int nM, nN, nwg, G, c;
    __host__ __device__ void init(int M, int N, int G_, int c_) { nM = M / BM; nN = N / BM; nwg = nM * nN; G = G_; c = c_; }
    __host__ __device__ bool next(int i, Unit& u) const {
        const long L = (long)i * G + c; if (L >= nwg) return false;
        int wgid = (int)L; { const int q = nwg / NXCD, r = nwg % NXCD, xcd = wgid % NXCD, off = wgid / NXCD; wgid = (xcd < r ? xcd * (q + 1) : r * (q + 1) + (xcd - r) * q) + off; }
        const int nig = WGM * nN, gid = wgid / nig, fm = gid * WGM, gsz = (nM - fm) < WGM ? (nM - fm) : WGM;
        u.pm = fm + ((wgid % nig) % gsz); u.pn = (wgid % nig) / gsz; return true;
    }
    __device__ __forceinline__ void a_ready(const Unit&) const {}
    __device__ __forceinline__ void done(const Unit&) const {}
};

__device__ __forceinline__ unsigned cvt_pk_bf16(float lo, float hi) { typedef __bf16 b2 __attribute__((ext_vector_type(2))); typedef float f2 __attribute__((ext_vector_type(2))); const f2 v = {lo, hi}; return __builtin_bit_cast(unsigned, __builtin_convertvector(v, b2)); }
template <class Epi, class Sched, bool ALIGN_EPI = false, bool SP2 = false>
__device__ __forceinline__ void gemm_phase(PG8_LAS unsigned char* lds, const Gemm g, const Sched& S, const Epi& E) {
    const int tid = threadIdx.x, wid = __builtin_amdgcn_readfirstlane(tid >> 6), lane = tid & 63, wr = wid >> 2, wc = wid & 3, fr = lane & 15, fq = lane >> 4;
    const int K = g.K, nt = K / BK;
    unsigned voffA[2], voffB[2];
#pragma unroll
    for (int i = 0; i < 2; ++i) { int R, C; stage_rc(tid * 16 + i * 8192, R, C); const int Rb = Epi::PERM ? ((R & ~31) + perm32(R & 31)) : R;
        voffA[i] = (unsigned)(R * K + C) * 2u; voffB[i] = (unsigned)(Rb * K + C) * 2u; }
    const size_t kstep = (size_t)(BK * 2);
    const size_t hstep = (size_t)HALF * K * 2;
    const size_t tstep = 2 * hstep;
    const unsigned ldsw = (unsigned)wid * 1024u;
    const int aoff = lds_byte(wr * 64 + fr, fq * 8), boff = lds_byte(wc * 32 + fr, fq * 8);
#define PG8_SA(b, h) (((b) * 2 + (h)) * HTB)
#define PG8_SB(b, h) ((4 + (b) * 2 + (h)) * HTB)
#define PG8_STAGE(bufoff, gbase, voff) do { _Pragma("unroll") for (int _i = 0; _i < 2; ++_i) \
        __builtin_amdgcn_global_load_lds((const unsigned*)((const char*)(gbase) + (voff)[_i]), (PG8_LAS unsigned*)(lds + (bufoff) + ldsw + _i * 8192), 16, 0, 0); } while (0)
#define PG8_LDA(dst, b, h) do { _Pragma("unroll") for (int m = 0; m < 4; ++m) _Pragma("unroll") for (int k = 0; k < 2; ++k) dst[m][k] = *(const PG8_LAS bf16x8*)(lds + PG8_SA(b, h) + aoff + m * 2048 + k * 1024); } while (0)
#define PG8_LDB(dst, b, h) do { _Pragma("unroll") for (int n = 0; n < 2; ++n) _Pragma("unroll") for (int k = 0; k < 2; ++k) dst[n][k] = *(const PG8_LAS bf16x8*)(lds + PG8_SB(b, h) + boff + n * 2048 + k * 1024); } while (0)
#define PG8_MMA(ai, bj, At, Bt) do { __builtin_amdgcn_s_setprio(1); _Pragma("unroll") for (int m = 0; m < 4; ++m) _Pragma("unroll") for (int n = 0; n < 2; ++n) _Pragma("unroll") for (int k = 0; k < 2; ++k) \
        acc[ai][bj][m][n] = __builtin_amdgcn_mfma_f32_16x16x32_bf16(Bt[n][k], At[m][k], acc[ai][bj][m][n], 0, 0, 0); __builtin_amdgcn_s_setprio(0); } while (0)
#define PG8_WAIT_V(n) asm volatile("s_waitcnt vmcnt(" #n ")" ::: "memory")
#define PG8_WAIT_L(n) asm volatile("s_waitcnt lgkmcnt(" #n ")" ::: "memory")
#define PG8_BAR __builtin_amdgcn_s_barrier()
#define PG8_SCHED __builtin_amdgcn_sched_barrier(0)
    Unit cur, nxt; int ui = 0;
    if (!S.next(0, cur)) return;
    f32x4 acc[2][2][4][2];
#pragma unroll
    for (int a = 0; a < 2; ++a)
#pragma unroll
        for (int b = 0; b < 2; ++b)
#pragma unroll
            for (int m = 0; m < 4; ++m)
#pragma unroll
                for (int n = 0; n < 2; ++n) acc[a][b][m][n] = (f32x4){0.f, 0.f, 0.f, 0.f};
    bf16x8 At[4][2], B0[2][2], B1[2][2];
    const char* cA = (const char*)g.A + (size_t)cur.pm * tstep; const char* cB = (const char*)g.Bt + (size_t)cur.pn * tstep;
    S.a_ready(cur);
    if constexpr (SP2) {
        PG8_STAGE(PG8_SB(0, 0), cB, voffB); PG8_STAGE(PG8_SB(0, 1), cB + hstep, voffB); PG8_STAGE(PG8_SA(0, 0), cA, voffA); PG8_STAGE(PG8_SA(0, 1), cA + hstep, voffA);
        if (wr == 1) PG8_BAR;
        PG8_WAIT_V(2); PG8_BAR;
        PG8_STAGE(PG8_SB(1, 0), cB + kstep, voffB); PG8_STAGE(PG8_SA(1, 0), cA + kstep, voffA); PG8_STAGE(PG8_SB(1, 1), cB + hstep + kstep, voffB);
        PG8_WAIT_V(6); PG8_BAR;
    } else {
        PG8_STAGE(PG8_SB(0, 0), cB, voffB); PG8_STAGE(PG8_SA(0, 0), cA, voffA); PG8_STAGE(PG8_SB(0, 1), cB + hstep, voffB); PG8_STAGE(PG8_SA(0, 1), cA + hstep, voffA);
        if (wr == 1) PG8_BAR;
        PG8_WAIT_V(4); PG8_BAR;
        PG8_STAGE(PG8_SB(1, 0), cB + kstep, voffB); PG8_STAGE(PG8_SA(1, 0), cA + kstep, voffA); PG8_STAGE(PG8_SB(1, 1), cB + hstep + kstep, voffB);
        PG8_WAIT_V(6); PG8_BAR;
    }
    for (;;) {
        const bool has_next = S.next(ui + 1, nxt);
        const char* nA = has_next ? (const char*)g.A + (size_t)nxt.pm * tstep : cA; const char* nB = has_next ? (const char*)g.Bt + (size_t)nxt.pn * tstep : cB;
        for (int t = 0; t < nt; t += 2) {
            const bool last = (t == nt - 2);
            const char* a1 = cA + (size_t)(t + 1) * kstep;
            const char* a2 = last ? nA : cA + (size_t)(t + 2) * kstep; const char* b2 = last ? nB : cB + (size_t)(t + 2) * kstep;
            const char* a3 = a2 + kstep; const char* b3 = b2 + kstep;
            if (last && has_next) S.a_ready(nxt);
            if constexpr (SP2) {
            PG8_LDB(B0, 0, 0); PG8_LDB(B1, 0, 1); PG8_SCHED; PG8_LDA(At, 0, 0); PG8_STAGE(PG8_SA(1, 1), a1 + hstep, voffA);
            PG8_WAIT_V(8); PG8_WAIT_L(0); PG8_BAR; PG8_MMA(0, 0, At, B0); PG8_MMA(0, 1, At, B1); PG8_BAR; PG8_SCHED;
            PG8_LDA(At, 0, 1); PG8_STAGE(PG8_SB(0, 0), b2, voffB); PG8_STAGE(PG8_SB(0, 1), b2 + hstep, voffB); PG8_STAGE(PG8_SA(0, 0), a2, voffA);
            PG8_WAIT_V(8); PG8_WAIT_L(0); PG8_BAR; PG8_MMA(1, 0, At, B0); PG8_MMA(1, 1, At, B1); PG8_BAR; PG8_SCHED;
            PG8_LDB(B0, 1, 0); PG8_LDB(B1, 1, 1); PG8_SCHED; PG8_LDA(At, 1, 0); PG8_STAGE(PG8_SA(0, 1), a2 + hstep, voffA);
            PG8_WAIT_V(8); PG8_WAIT_L(0); PG8_BAR; PG8_MMA(0, 0, At, B0); PG8_MMA(0, 1, At, B1); PG8_BAR; PG8_SCHED;
            PG8_LDA(At, 1, 1); PG8_STAGE(PG8_SB(1, 0), b3, voffB); PG8_STAGE(PG8_SB(1, 1), b3 + hstep, voffB); PG8_STAGE(PG8_SA(1, 0), a3, voffA);
            PG8_WAIT_V(8); PG8_WAIT_L(0); PG8_BAR; PG8_MMA(1, 0, At, B0); PG8_MMA(1, 1, At, B1); PG8_BAR; PG8_SCHED;
            } else {
            PG8_LDB(B0, 0, 0); PG8_SCHED; PG8_LDA(At, 0, 0); PG8_STAGE(PG8_SA(1, 1), a1 + hstep, voffA);
            PG8_WAIT_L(8); PG8_BAR; PG8_WAIT_L(0); PG8_MMA(0, 0, At, B0); PG8_BAR; PG8_SCHED;
            PG8_LDB(B1, 0, 1); PG8_STAGE(PG8_SB(0, 0), b2, voffB);
            PG8_BAR; PG8_WAIT_L(0); PG8_MMA(0, 1, At, B1); PG8_BAR;
            PG8_LDA(At, 0, 1); PG8_STAGE(PG8_SA(0, 0), a2, voffA);
            PG8_BAR; PG8_WAIT_L(0); PG8_MMA(1, 0, At, B0); PG8_BAR; PG8_SCHED;
            PG8_STAGE(PG8_SB(0, 1), b2 + hstep, voffB);
            PG8_WAIT_V(6); PG8_BAR; PG8_MMA(1, 1, At, B1); PG8_BAR;
            PG8_LDB(B0, 1, 0); PG8_SCHED; PG8_LDA(At, 1, 0); PG8_STAGE(PG8_SA(0, 1), a2 + hstep, voffA);
            PG8_WAIT_L(8); PG8_BAR; PG8_WAIT_L(0); PG8_MMA(0, 0, At, B0); PG8_BAR; PG8_SCHED;
            PG8_LDB(B1, 1, 1); PG8_STAGE(PG8_SB(1, 0), b3, voffB);
            PG8_BAR; PG8_WAIT_L(0); PG8_MMA(0, 1, At, B1); PG8_BAR;
            PG8_LDA(At, 1, 1); PG8_STAGE(PG8_SA(1, 0), a3, voffA);
            PG8_BAR; PG8_WAIT_L(0); PG8_MMA(1, 0, At, B0); PG8_BAR; PG8_SCHED;
            PG8_STAGE(PG8_SB(1, 1), b3 + hstep, voffB);
            PG8_WAIT_V(6); PG8_BAR; PG8_MMA(1, 1, At, B1); PG8_BAR;
            }
        }
        if constexpr (ALIGN_EPI) { if (wr == 0) PG8_BAR; }
        if constexpr (!Epi::AFTER_DRAIN) { E(acc, cur, wr, wc, fr, fq); S.done(cur); }
        if (!has_next) break;
#pragma unroll
        for (int a = 0; a < 2; ++a)
#pragma unroll
            for (int b = 0; b < 2; ++b)
#pragma unroll
                for (int m = 0; m < 4; ++m)
#pragma unroll
                    for (int n = 0; n < 2; ++n) acc[a][b][m][n] = (f32x4){0.f, 0.f, 0.f, 0.f};
        cur = nxt; cA = nA; cB = nB; ++ui;
        if constexpr (ALIGN_EPI) { if (wr == 1) PG8_BAR; }
    }
    PG8_WAIT_V(0);
    if constexpr (!ALIGN_EPI) { if (wr == 0) PG8_BAR; }
    PG8_BAR;
    if constexpr (Epi::AFTER_DRAIN) { E.fused(acc, cur, wr, wc, fr, fq, lds, wid, lane); S.done(cur); }
#undef PG8_SA
#undef PG8_SB
#undef PG8_STAGE
#undef PG8_LDA
#undef PG8_LDB
#undef PG8_MMA
#undef PG8_WAIT_V
#undef PG8_WAIT_L
#undef PG8_BAR
#undef PG8_SCHED
}
}
#define GAS __attribute__((address_space(1)))
#define LAS __attribute__((address_space(3)))
typedef unsigned short bf16;
typedef unsigned v4u __attribute__((ext_vector_type(4)));
typedef float f32x4 __attribute__((ext_vector_type(4)));
typedef short bf16x8 __attribute__((ext_vector_type(8)));
typedef GAS unsigned gu32;
typedef GAS unsigned long long gu64;
#define RLX_AGENT __ATOMIC_RELAXED, __HIP_MEMORY_SCOPE_AGENT
#define LDS_WAIT() asm volatile("s_waitcnt lgkmcnt(0)" ::: "memory")
#define VM_WAIT() asm volatile("s_waitcnt vmcnt(0)" ::: "memory")
__device__ __forceinline__ unsigned long long rt() { return __builtin_amdgcn_s_memrealtime(); }
typedef __bf16 hbf2_t __attribute__((ext_vector_type(2)));
typedef float hf2_t __attribute__((ext_vector_type(2)));
__device__ __forceinline__ unsigned pk2(float lo, float hi) { const hf2_t v = {lo, hi}; return __builtin_bit_cast(unsigned, __builtin_convertvector(v, hbf2_t)); }
__device__ __forceinline__ unsigned f2bf(float f) { return pk2(f, 0.f) & 0xffffu; }

#define XB_TMO      128
#define XB_XCNT(j)  (256  + 64 * (j))
#define XB_XSUB(j)  (1280 + 64 * (j))
#define XB_XGEN(j)  (2304 + 64 * (j))
#define XB_TOP      3328
#define XB_TOPGEN   3392
#define XCD_BAR_WORDS 3456
#define XB_SPIN_CAP (1u << 22)

__device__ __forceinline__ unsigned xb_ld(unsigned* p)              { return __hip_atomic_load(p, __ATOMIC_RELAXED, __HIP_MEMORY_SCOPE_AGENT); }
__device__ __forceinline__ unsigned xb_add(unsigned* p, unsigned v) { return __hip_atomic_fetch_add(p, v, __ATOMIC_RELAXED, __HIP_MEMORY_SCOPE_AGENT); }
__device__ __forceinline__ unsigned xb_xcc_id() { return (unsigned)__builtin_amdgcn_s_getreg((3 << 11) | 20) & 0xFu; }
#define XB_SPIN(cond, bar) do { unsigned _sp = 0; while (cond) { __builtin_amdgcn_s_sleep(1); \
    if ((++_sp & 255u) == 0u) { if (xb_ld(&(bar)[XB_TMO])) break; if (_sp > XB_SPIN_CAP) { atomicAdd(&(bar)[XB_TMO], 1u); break; } } } } while (0)

struct XcdBarrier {
    unsigned* bar; unsigned x;
    volatile LAS unsigned* st;
};

__device__ __forceinline__ XcdBarrier xcd_barrier_post(unsigned* bar, volatile LAS unsigned* st) {
    XcdBarrier b; b.bar = bar; b.x = xb_xcc_id(); b.st = st;
    if (threadIdx.x == 0) (void)xb_add(&bar[XB_XCNT(b.x)], 1u);
    return b;
}
__device__ __forceinline__ void xcd_barrier_complete(unsigned* bar, unsigned x, unsigned& nloc, unsigned& nx) {
    const unsigned G = gridDim.x * gridDim.y * gridDim.z;
    unsigned sum, cnt, mine, sp = 0u;
    for (;;) {
        sum = 0u; cnt = 0u; mine = 0u;
#pragma unroll
        for (unsigned j = 0; j < 16; ++j) { const unsigned c = xb_ld(&bar[XB_XCNT(j)]); sum += c; cnt += (c > 0u) ? 1u : 0u; mine = (j == x) ? c : mine; }
        if (sum == G) break;
        __builtin_amdgcn_s_sleep(1);
        if ((++sp & 255u) == 0u) { if (xb_ld(&bar[XB_TMO])) break; if (sp > XB_SPIN_CAP) { atomicAdd(&bar[XB_TMO], 1u); break; } }
    }
    nloc = mine > 0u ? mine : 1u; nx = cnt > 0u ? cnt : 1u;
}

__device__ __forceinline__ void xcd_barrier(const XcdBarrier& b) {
    asm volatile("s_waitcnt vmcnt(0)" ::: "memory");
    __syncthreads();
    if (threadIdx.x == 0) {
        unsigned* bar = b.bar;
        __builtin_amdgcn_s_waitcnt(0);
        unsigned nloc = b.st[0], nx = b.st[1];
        if (nloc == 0u) { xcd_barrier_complete(bar, b.x, nloc, nx); b.st[0] = nloc; b.st[1] = nx; }
        const unsigned old = xb_add(&bar[XB_XSUB(b.x)], 1u);
        const unsigned gen = old / nloc;
        if (old + 1u == (gen + 1u) * nloc) {
            __builtin_amdgcn_fence(__ATOMIC_RELEASE, "agent");
            asm volatile("s_waitcnt vmcnt(0)" ::: "memory");
            const unsigned og = xb_add(&bar[XB_TOP], 1u);
            const unsigned tg = og / nx;
            if (og + 1u == (tg + 1u) * nx) xb_add(&bar[XB_TOPGEN], 1u);
            else XB_SPIN(xb_ld(&bar[XB_TOPGEN]) == tg, bar);
            __builtin_amdgcn_fence(__ATOMIC_ACQUIRE, "agent");
            xb_add(&bar[XB_XGEN(b.x)], 1u);
            asm volatile("s_waitcnt vmcnt(0)" ::: "memory");
        } else {
            XB_SPIN(xb_ld(&bar[XB_XGEN(b.x)]) == gen, bar);
            __builtin_amdgcn_fence(__ATOMIC_ACQUIRE, "agent");
            asm volatile("s_waitcnt vmcnt(0)" ::: "memory");
        }
    }
    __syncthreads();
}

constexpr int S = 16384, DM = 1024, NH = 8, HD = 128, MBLK = 256, NBLK = S / MBLK, DFF = 2816, INTOT = 9232;
constexpr int CH = 64, NCH = S / CH;
constexpr float EPS = 1e-6f;
constexpr int NWAVES = 8;
#ifndef DN2_LATE_WT
#define DN2_LATE_WT 1
#endif

constexpr size_t MiB = 1u << 20;
constexpr size_t WS_CTL = 0, CTL_ZERO_BYTES = 1 * MiB;
constexpr size_t WS_COS = 1 * MiB, WS_SIN = 2 * MiB;
constexpr size_t WS_BA = 3 * MiB;
constexpr size_t WS_KMEAN = 4 * MiB;
constexpr size_t WS_TOPI = 5 * MiB;
constexpr size_t WS_BETA = 6 * MiB + 512 * 1024, WS_G = 7 * MiB, WS_GC = 7 * MiB + 512 * 1024;
constexpr size_t WS_WTA = 8 * MiB, WS_WTB = 14 * MiB, WS_WTG = 22 * MiB, WS_WTOA = 26 * MiB, WS_WTOD = 28 * MiB, WS_WTOUT = 30 * MiB, WS_WTGU = 32 * MiB, WS_WTDN = 43 * MiB;
constexpr size_t WS_H = 49 * MiB;
constexpr size_t WS_R1 = 81 * MiB;
constexpr size_t WS_Z = 177 * MiB, WS_YA = 209 * MiB, WS_END = 256 * MiB;
constexpr size_t ACT_BYTES = (size_t)S * DFF * 2;
constexpr size_t T32 = (size_t)S * DM * 2;
static_assert(WS_WTDN + (size_t)DM * DFF * 2 <= WS_H && WS_YA + T32 <= WS_END && WS_R1 + 3 * T32 == WS_Z, "ws map");
constexpr size_t WS_VN = WS_H;
constexpr size_t WS_W = WS_R1, WS_ATT = WS_R1 + T32, WS_O = WS_R1 + T32 + 16 * MiB, WS_YD = WS_R1;
constexpr size_t WS_T = 113 * MiB, WS_H2 = WS_H, WS_ACT = 81 * MiB, WS_F = 169 * MiB, WS_X1B = 209 * MiB;
static_assert(WS_ACT + ACT_BYTES <= WS_F && WS_F + 2 * T32 <= WS_END && WS_O + T32 <= WS_Z && WS_T + 2 * T32 <= WS_Z, "overlay map");
constexpr int CW_BAR = 4096;

constexpr int RING_OFF = 0, RING_BYTES = 131072;
constexpr int LDS_BYTES = 163840;
constexpr int LDSCTL_OFF = LDS_BYTES - 4096, MISC_OFF = LDSCTL_OFF + 320;

typedef unsigned u32x4 __attribute__((ext_vector_type(4)));
typedef unsigned u32x2 __attribute__((ext_vector_type(2)));

__device__ __forceinline__ float bflo(unsigned u) { return __builtin_bit_cast(float, u << 16); }
__device__ __forceinline__ float bfhi(unsigned u) { return __builtin_bit_cast(float, u & 0xffff0000u); }
__device__ __forceinline__ float bf2f(bf16 b) { return __builtin_bit_cast(float, ((unsigned)b) << 16); }
__device__ __forceinline__ float wave_sum(float v) {
#define WS_DPP(ctrl) v += __builtin_bit_cast(float, __builtin_amdgcn_update_dpp(0, __builtin_bit_cast(int, v), (ctrl), 0xF, 0xF, true))
    WS_DPP(0xB1); WS_DPP(0x4E); WS_DPP(0x141); WS_DPP(0x140);
#undef WS_DPP
    const float s0 = __builtin_bit_cast(float, __builtin_amdgcn_readlane(__builtin_bit_cast(int, v), 0)), s1 = __builtin_bit_cast(float, __builtin_amdgcn_readlane(__builtin_bit_cast(int, v), 16));
    const float s2 = __builtin_bit_cast(float, __builtin_amdgcn_readlane(__builtin_bit_cast(int, v), 32)), s3 = __builtin_bit_cast(float, __builtin_amdgcn_readlane(__builtin_bit_cast(int, v), 48));
    return (s0 + s1) + (s2 + s3);
}
__device__ __forceinline__ float wave_max(float v) {
#pragma unroll
    for (int o = 1; o < 64; o <<= 1) v = fmaxf(v, __shfl_xor(v, o));
    return v;
}
__device__ __forceinline__ float rcp_(float x) { return __builtin_amdgcn_rcpf(x); }
__device__ __forceinline__ float rsq_(float x) { return __builtin_amdgcn_rsqf(x); }
__device__ __forceinline__ float sigmoidf_(float x) { return rcp_(1.f + __expf(-x)); }
__device__ __forceinline__ float siluf_(float x) { return x * rcp_(1.f + __expf(-x)); }
__device__ __forceinline__ float sigmoidf_e(float x) { return sigmoidf_(x); }
__device__ __forceinline__ float siluf_e(float x) { return siluf_(x); }

namespace pg8 {
struct EpiRope {
    static constexpr bool PERM = false, AFTER_DRAIN = false;
    bf16_t* base; const float* cosT; const float* sinT; float* kpart;
    __device__ __forceinline__ void operator()(const f32x4 (&acc)[2][2][4][2], const Unit& u, int wr, int wc, int fr, int fq) const {
        const int t = u.pn >> 2, pnl = u.pn & 3;
        bf16_t* ob = base + (size_t)t * ((size_t)S * DM);
        const bool rope = (t < 2) && (wc == 0);
        f32x4 cs[2][2];
#pragma unroll
        for (int bj = 0; bj < 2; ++bj)
#pragma unroll
            for (int n = 0; n < 2; ++n) cs[bj][n] = (f32x4){0.f, 0.f, 0.f, 0.f};
#pragma unroll
        for (int ai = 0; ai < 2; ++ai)
#pragma unroll
            for (int m = 0; m < 4; ++m) {
                const int row = u.pm * BM + ai * HALF + wr * 64 + m * 16 + fr;
                f32x4 cv = (f32x4){1.f, 1.f, 1.f, 1.f}, sv = (f32x4){0.f, 0.f, 0.f, 0.f};
                if (rope) { cv = *(const f32x4*)(cosT + (size_t)row * 16 + 4 * fq); sv = *(const f32x4*)(sinT + (size_t)row * 16 + 4 * fq); }
#pragma unroll
                for (int bj = 0; bj < 2; ++bj) {
                    f32x4 v0 = acc[ai][bj][m][0], v1 = acc[ai][bj][m][1];
                    if (rope) { const f32x4 n0 = v0 * cv - v1 * sv, n1 = v1 * cv + v0 * sv; v0 = n0; v1 = n1; }
                    cs[bj][0] = cs[bj][0] + v0; cs[bj][1] = cs[bj][1] + v1;
                    bf16_t* p = ob + (size_t)row * DM + pnl * 256 + bj * HALF + wc * 32 + 4 * fq;
                    u32x2 w0, w1; w0.x = cvt_pk_bf16(v0[0], v0[1]); w0.y = cvt_pk_bf16(v0[2], v0[3]); w1.x = cvt_pk_bf16(v1[0], v1[1]); w1.y = cvt_pk_bf16(v1[2], v1[3]);
                    *(u32x2*)p = w0; *(u32x2*)(p + 16) = w1;
                }
            }
        if (t == 1) {
#pragma unroll
            for (int bj = 0; bj < 2; ++bj)
#pragma unroll
                for (int n = 0; n < 2; ++n) { f32x4 s = cs[bj][n];
#pragma unroll
                    for (int o = 1; o < 16; o <<= 1) { s.x += __shfl_xor(s.x, o); s.y += __shfl_xor(s.y, o); s.z += __shfl_xor(s.z, o); s.w += __shfl_xor(s.w, o); }
                    if (fr == 0) *(f32x4*)(kpart + ((size_t)(u.pm * 2 + wr) * NH + 2 * pnl + bj) * HD + wc * 32 + 16 * n + 4 * fq) = s; } }
    }
};
template <int MODE> struct EpiGen {
    static constexpr bool PERM = true, AFTER_DRAIN = false;
    bf16_t* O; int ldc; int split_cols; size_t split_stride; const bf16_t* G2;
    __device__ __forceinline__ static void unpack8(const u32x4 w, float (&f)[8]) {
        f[0] = bflo(w.x); f[1] = bfhi(w.x); f[2] = bflo(w.y); f[3] = bfhi(w.y); f[4] = bflo(w.z); f[5] = bfhi(w.z); f[6] = bflo(w.w); f[7] = bfhi(w.w);
    }
    __device__ __forceinline__ void operator()(const f32x4 (&acc)[2][2][4][2], const Unit& u, int wr, int wc, int fr, int fq) const {
        const int row0 = u.pm * BM + wr * 64 + fr; int colt = u.pn * BM; bf16_t* base = O; const bf16_t* g2 = G2;
        if (split_cols) { const int t = colt / split_cols; base += (size_t)t * split_stride; colt -= t * split_cols; }
#pragma unroll
        for (int ai = 0; ai < 2; ++ai)
#pragma unroll
            for (int m = 0; m < 4; ++m) {
                const int row = row0 + ai * HALF + m * 16;
                if constexpr (MODE == 4) {
                    const f32x4 g0 = acc[ai][0][m][0], g1 = acc[ai][0][m][1], u0 = acc[ai][1][m][0], u1 = acc[ai][1][m][1];
                    float r[8];
#pragma unroll
                    for (int e = 0; e < 4; ++e) { r[e] = siluf_e(g0[e]) * u0[e]; r[4 + e] = siluf_e(g1[e]) * u1[e]; }
                    u32x4 w; w.x = cvt_pk_bf16(r[0], r[1]); w.y = cvt_pk_bf16(r[2], r[3]); w.z = cvt_pk_bf16(r[4], r[5]); w.w = cvt_pk_bf16(r[6], r[7]);
                    *(u32x4*)(base + (size_t)row * ldc + u.pn * HALF + wc * 32 + 8 * fq) = w;
                } else {
#pragma unroll
                    for (int bj = 0; bj < 2; ++bj) {
                        const f32x4 v0 = acc[ai][bj][m][0], v1 = acc[ai][bj][m][1];
                        float r[8] = {v0[0], v0[1], v0[2], v0[3], v1[0], v1[1], v1[2], v1[3]};
                        bf16_t* p = base + (size_t)row * ldc + colt + bj * HALF + wc * 32 + 8 * fq;
                        if constexpr (MODE == 1) {
#pragma unroll
                            for (int e = 0; e < 8; ++e) r[e] = sigmoidf_e(r[e]);
                        }
                        if constexpr (MODE == 2) { float g[8]; unpack8(*(const u32x4*)p, g);
#pragma unroll
                            for (int e = 0; e < 8; ++e) r[e] = r[e] * g[e]; }
                        if constexpr (MODE == 3) { float g[8], o[8]; unpack8(*(const u32x4*)(g2 + (size_t)row * ldc + colt + bj * HALF + wc * 32 + 8 * fq), g); unpack8(*(const u32x4*)p, o);
#pragma unroll
                            for (int e = 0; e < 8; ++e) r[e] = o[e] + r[e] * g[e]; }
                        u32x4 w; w.x = cvt_pk_bf16(r[0], r[1]); w.y = cvt_pk_bf16(r[2], r[3]); w.z = cvt_pk_bf16(r[4], r[5]); w.w = cvt_pk_bf16(r[6], r[7]);
                        *(u32x4*)p = w;
                        if constexpr (MODE == 5) {
                            if (m == 3 && fr >= 13 && u.pn * BM < 3 * 1024) *(u32x4*)((bf16_t*)G2 + ((size_t)(row >> 6) * 3 + (fr - 13)) * 3072 + u.pn * BM + bj * HALF + wc * 32 + 8 * fq) = w; }
                    }
                }
            }
    }
};
struct EpiF32 {
    static constexpr bool PERM = false, AFTER_DRAIN = false;
    float* C; int ldc;
    __device__ __forceinline__ void operator()(const f32x4 (&acc)[2][2][4][2], const Unit& u, int wr, int wc, int fr, int fq) const {
        const int row0 = u.pm * BM + wr * 64 + fr, col0 = u.pn * BM + wc * 32 + 4 * fq;
#pragma unroll
        for (int ai = 0; ai < 2; ++ai)
#pragma unroll
            for (int m = 0; m < 4; ++m) { float* rowp = C + (size_t)(row0 + ai * HALF + m * 16) * ldc + col0;
#pragma unroll
                for (int bj = 0; bj < 2; ++bj)
#pragma unroll
                    for (int n = 0; n < 2; ++n) *(f32x4*)(rowp + bj * HALF + n * 16) = acc[ai][bj][m][n]; }
    }
};
struct PairOrder {
    StaticOrder so; int nblk, nN1;
    __host__ __device__ void init(int M, int N1, int nblk_, int G_, int c_) { so.init(M, N1, G_, c_); nblk = nblk_; nN1 = N1 / BM; }
    __host__ __device__ bool next(int i, Unit& u) const { if (!so.next(i / nblk, u)) return false; u.pn += (i % nblk) * nN1; return true; }
    __device__ __forceinline__ void a_ready(const Unit&) const {}
    __device__ __forceinline__ void done(const Unit&) const {}
};
}

struct Args { const float* in[16]; float* out; unsigned char* ws; int ph_lo, ph_hi, pass, pad; };
struct Frame {
    LAS unsigned char* lds;
    volatile LAS unsigned* MISC;
    int tid, lane, wave, G, gw, NGW;
    float* out; unsigned char* ws;
};
#define WSP(T, off) ((T*)(F.ws + (off)))
#define WSPF(T, off) ((T*)(Fp.ws + (off)))

struct WtItem { const float* src; bf16* dst; int ldw, K; };
__device__ __forceinline__ void tr_load(const WtItem& I, int lane, f32x4 (&v)[8]) {
#pragma unroll
    for (int i = 0; i < 8; ++i) v[i] = *(const f32x4*)(I.src + (size_t)((lane >> 3) + 8 * i) * I.ldw + 4 * (lane & 7));
}
__device__ __forceinline__ void tr_put(const f32x4 (&v)[8], LAS float* scr, int lane) {
#pragma unroll
    for (int i = 0; i < 8; ++i) { LAS float* s = scr + ((lane >> 3) + 8 * i) * 33 + 4 * (lane & 7); s[0] = v[i].x; s[1] = v[i].y; s[2] = v[i].z; s[3] = v[i].w; }
    LDS_WAIT(); asm volatile("" ::: "memory");
}
__device__ __forceinline__ void tr_out(const WtItem& I, const LAS float* scr, int lane) {
    const int c = lane & 7;
#pragma unroll
    for (int j = 0; j < 4; ++j) { const int n = (lane >> 3) + 8 * j; const LAS float* s = scr + (8 * c) * 33 + n;
        v4u o; o.x = pk2(s[0 * 33], s[1 * 33]); o.y = pk2(s[2 * 33], s[3 * 33]); o.z = pk2(s[4 * 33], s[5 * 33]); o.w = pk2(s[6 * 33], s[7 * 33]);
        *(GAS v4u*)(I.dst + (size_t)n * I.K + 8 * c) = o; }
    LDS_WAIT(); asm volatile("" ::: "memory");
}
__device__ __forceinline__ void rms_row_bf16(const float* xrow, const float* w, bf16* orow, int lane, f32x4 (&hv)[4]) {
    const f32x4* xr = (const f32x4*)xrow + lane; const f32x4* wr = (const f32x4*)w + lane;
    float ss = 0.f;
#pragma unroll
    for (int j = 0; j < 4; ++j) { hv[j] = xr[64 * j]; ss += (hv[j].x * hv[j].x + hv[j].y * hv[j].y) + (hv[j].z * hv[j].z + hv[j].w * hv[j].w); }
    const float rs = rsq_(wave_sum(ss) * (1.f / DM) + EPS);
    unsigned long long* o8 = (unsigned long long*)orow + lane;
#pragma unroll
    for (int j = 0; j < 4; ++j) { const f32x4 wv = wr[64 * j]; hv[j] = hv[j] * rs * wv;
        o8[64 * j] = (unsigned long long)pk2(hv[j].x, hv[j].y) | ((unsigned long long)pk2(hv[j].z, hv[j].w) << 32); }
}
__device__ __forceinline__ WtItem wt_decode(const Args& A, unsigned char* ws, int it) {
    constexpr int I_A = 16 * 96, I_B = 16 * 128, I_G = 16 * 64, I_O = 16 * 32, I_GU = 16 * 88;
    const float* w_in = A.in[2];
    int r = it; const float* W; int ldw, scol, nbn, K = DM, dmode = 0; size_t dst;
    if (r < I_A) { W = w_in; ldw = INTOT; scol = 0; nbn = 96; dst = WS_WTA; }
    else if ((r -= I_A) < I_B) { W = w_in; ldw = INTOT; scol = 3072; nbn = 128; dst = WS_WTB; }
    else if ((r -= I_B) < I_G) { W = w_in; ldw = INTOT; scol = 7184; nbn = 64; dst = WS_WTG; }
    else if ((r -= I_G) < I_O) { W = A.in[7]; ldw = DM; scol = 0; nbn = 32; dst = WS_WTOA; }
    else if ((r -= I_O) < I_O) { W = A.in[8]; ldw = DM; scol = 0; nbn = 32; dst = WS_WTOD; }
    else if ((r -= I_O) < I_O) { W = A.in[9]; ldw = DM; scol = 0; nbn = 32; dst = WS_WTOUT; }
    else if ((r -= I_O) < I_GU) { W = A.in[12]; ldw = DFF; scol = 0; nbn = 88; dst = WS_WTGU; dmode = 1; }
    else if ((r -= I_GU) < I_GU) { W = A.in[13]; ldw = DFF; scol = 0; nbn = 88; dst = WS_WTGU; dmode = 2; }
    else { r -= I_GU; W = A.in[14]; ldw = DM; scol = 0; nbn = 32; dst = WS_WTDN; K = DFF; }
    const int kb = r / nbn, nb = r % nbn, n0 = 32 * nb;
    const int drow0 = (dmode == 0) ? n0 : 256 * (n0 / 128) + (n0 % 128) + (dmode == 2 ? 128 : 0);
    WtItem I; I.src = W + (size_t)(64 * kb) * ldw + scol + n0; I.dst = (bf16*)(ws + dst) + (size_t)drow0 * K + 64 * kb; I.ldw = ldw; I.K = K; return I;
}
__device__ __forceinline__ void p_wtrans(Frame& F, const Args& A, int it0, int it1, int gw0, int ngw) {
    LAS float* scr = (LAS float*)(F.lds + RING_OFF + F.wave * 16384);
    int it = it0 + gw0; if (it >= it1) return;
    WtItem cur = wt_decode(A, F.ws, it); f32x4 v[8]; tr_load(cur, F.lane, v);
    for (;;) {
        const int itn = it + ngw; const bool more = itn < it1;
        tr_put(v, scr, F.lane);
        WtItem nxt = cur; if (more) { nxt = wt_decode(A, F.ws, itn); tr_load(nxt, F.lane, v); }
        tr_out(cur, scr, F.lane);
        if (!more) break;
        cur = nxt; it = itn;
    }
}
constexpr int WT_A_ITEMS = 2560;
constexpr int WT_ITEMS_EARLY = 16 * 96 + 16 * 128, WT_ITEMS_ALL = 16 * 96 + 16 * 128 + 16 * 64 + 3 * 16 * 32 + 2 * 16 * 88 + 44 * 32;
__device__ __forceinline__ void p_prologue(Frame& F, const Args& A) {
    const float* w_in = A.in[2];
#if DN2_LATE_WT
    p_wtrans(F, A, 0, WT_ITEMS_EARLY, F.gw, F.NGW);
#else
    p_wtrans(F, A, 0, WT_ITEMS_ALL, F.gw, F.NGW);
#endif
    { float* cosT = WSP(float, WS_COS); float* sinT = WSP(float, WS_SIN);
      for (int i = F.gw * 64 + F.lane; i < S * 16; i += F.NGW * 64) { const int pos = i >> 4, k = i & 15;
          const float inv = (float)pow(500000.0, -(double)k / 16.0); const float ang = (float)pos * inv;
          cosT[i] = cosf(ang); sinT[i] = sinf(ang); } }
    { const float* x = A.in[0]; bf16* H = WSP(bf16, WS_H); float* BA = WSP(float, WS_BA);
      constexpr int WP = 2064;
      LAS unsigned char* wimg = F.lds; LAS unsigned char* hl = F.lds + 36864 + F.wave * (4 * WP + 192);
      __syncthreads();
      { const int k8 = F.tid >> 2, c4 = 4 * (F.tid & 3); f32x4 wv[8];
#pragma unroll
        for (int i = 0; i < 8; ++i) wv[i] = *(const f32x4*)(w_in + (size_t)(8 * k8 + i) * INTOT + 7168 + c4);
#pragma unroll
        for (int c = 0; c < 4; ++c) { u32x4 o; o.x = pk2(wv[0][c], wv[1][c]); o.y = pk2(wv[2][c], wv[3][c]); o.z = pk2(wv[4][c], wv[5][c]); o.w = pk2(wv[6][c], wv[7][c]);
            *(LAS u32x4*)(wimg + (c4 + c) * WP + 16 * k8) = o; } }
      __syncthreads();
      const int r16 = F.lane & 15, g = F.lane >> 4;
      const LAS unsigned char* wrd = wimg + r16 * WP + 16 * g; const LAS unsigned char* hrd = hl + (r16 & 3) * WP + 16 * g;
      f32x4 nw[4];
#pragma unroll
      for (int j = 0; j < 4; ++j) nw[j] = ((const f32x4*)A.in[1])[F.lane + 64 * j];
      for (int m0 = F.gw; m0 < S; m0 += 4 * F.NGW) {
          f32x4 xv[4][4];
#pragma unroll
          for (int k = 0; k < 4; ++k) { const int m = m0 + k * F.NGW; const f32x4* xr = (const f32x4*)(x + (size_t)(m < S ? m : m0) * DM) + F.lane;
#pragma unroll
              for (int j = 0; j < 4; ++j) xv[k][j] = xr[64 * j]; }
#pragma unroll
          for (int k = 0; k < 4; ++k) { const int m = m0 + k * F.NGW; float ss = 0.f;
#pragma unroll
              for (int j = 0; j < 4; ++j) ss += (xv[k][j].x * xv[k][j].x + xv[k][j].y * xv[k][j].y) + (xv[k][j].z * xv[k][j].z + xv[k][j].w * xv[k][j].w);
              const float rs = rsq_(wave_sum(ss) * (1.f / DM) + EPS);
              unsigned long long* o8 = (unsigned long long*)(H + (size_t)m * DM) + F.lane;
#pragma unroll
              for (int j = 0; j < 4; ++j) { const f32x4 hv = xv[k][j] * rs * nw[j]; u32x2 p; p.x = pk2(hv.x, hv.y); p.y = pk2(hv.z, hv.w);
                  if (m < S) o8[64 * j] = (unsigned long long)p.x | ((unsigned long long)p.y << 32);
                  *(LAS u32x2*)(hl + k * WP + 8 * (F.lane + 64 * j)) = p; } }
          asm volatile("s_waitcnt lgkmcnt(0)" ::: "memory");
          f32x4 acc = {0.f, 0.f, 0.f, 0.f};
#pragma unroll 8
          for (int s = 0; s < 32; ++s) { const bf16x8 wf = *(const LAS bf16x8*)(wrd + 64 * s), hf = *(const LAS bf16x8*)(hrd + 64 * s);
              acc = __builtin_amdgcn_mfma_f32_16x16x32_bf16(wf, hf, acc, 0, 0, 0); }
          { const int m = m0 + r16 * F.NGW; if (r16 < 4 && m < S) *(f32x4*)(BA + (size_t)m * 16 + 4 * g) = acc; }
          asm volatile("s_waitcnt lgkmcnt(0)" ::: "memory");
      }
      __syncthreads(); }
}
__device__ __forceinline__ void p_hrecompute_sub(Frame& F, const Args& A, bf16* H, int gw0, int ngw) {
    const float* x = A.in[0];
    for (int m = gw0; m < S; m += ngw) { f32x4 hv[4]; rms_row_bf16(x + (size_t)m * DM, A.in[1], H + (size_t)m * DM, F.lane, hv); }
}
__device__ __forceinline__ void p_hrecompute(Frame& F, const Args& A) {
    const float* x = A.in[0]; bf16* H = WSP(bf16, WS_H);
    for (int m = F.gw; m < S; m += F.NGW) { f32x4 hv[4]; rms_row_bf16(x + (size_t)m * DM, A.in[1], H + (size_t)m * DM, F.lane, hv); }
}

__device__ __forceinline__ void p_kmean(Frame& F, const Args& A) {
    const bf16* KA = WSP(bf16, WS_R1 + T32); float* KM = WSP(float, WS_KMEAN);
    for (int it = F.gw; it < NBLK * NH; it += F.NGW) { const int blk = it >> 3, h = it & 7;
        float s0 = 0.f, s1 = 0.f; const bf16* p = KA + (size_t)(blk * MBLK) * DM + h * HD + 2 * F.lane;
#pragma unroll 32
        for (int r = 0; r < MBLK; ++r) { const unsigned v = *(const unsigned*)(p + (size_t)r * DM); s0 += bflo(v); s1 += bfhi(v); }
        KM[(size_t)it * HD + 2 * F.lane] = s0 * (1.f / MBLK); KM[(size_t)it * HD + 2 * F.lane + 1] = s1 * (1.f / MBLK); }
}
__device__ __forceinline__ void p_topk(Frame& F, const Args& A) {
    const bf16* QA = WSP(bf16, WS_R1); const float* KM = WSP(float, WS_KMEAN); int* TOPI = WSP(int, WS_TOPI);
    for (int it = F.gw; it < S * NH; it += F.NGW) { const int q = it >> 3, h = it & 7, qblk = q >> 8;
        float g = -INFINITY;
        if (F.lane < qblk) { const bf16* qp = QA + (size_t)q * DM + h * HD; const float* kp = KM + ((size_t)F.lane * NH + h) * HD; float a = 0.f;
#pragma unroll
            for (int c = 0; c < 16; ++c) { const u32x4 qv = *(const u32x4*)(qp + 8 * c); const f32x4 k0 = *(const f32x4*)(kp + 8 * c), k1 = *(const f32x4*)(kp + 8 * c + 4);
                a += bflo(qv.x) * k0.x + bfhi(qv.x) * k0.y + bflo(qv.y) * k0.z + bfhi(qv.y) * k0.w + bflo(qv.z) * k1.x + bfhi(qv.z) * k1.y + bflo(qv.w) * k1.z + bfhi(qv.w) * k1.w; }
            g = a; }
        int res = -1;
#pragma unroll
        for (int r = 0; r < 3; ++r) { float v = g; int i = F.lane;
#pragma unroll
            for (int o = 1; o < 64; o <<= 1) { const float ov = __shfl_xor(v, o); const int oi = __shfl_xor(i, o); if (ov > v || (ov == v && oi < i)) { v = ov; i = oi; } }
            if (F.lane == r) res = (r < qblk) ? i : -1;
            if (F.lane == i) g = -INFINITY; }
        if (F.lane < 3) TOPI[(size_t)it * 3 + F.lane] = res; }
}
__device__ __forceinline__ void p_attn_naive(Frame& F, const Args& A) {
    const bf16* QA = WSP(bf16, WS_R1); const bf16* KA = WSP(bf16, WS_R1 + T32); const bf16* VA = WSP(bf16, WS_R1 + 2 * T32); const int* TOPI = WSP(int, WS_TOPI);
#ifdef DBG_ATTN
    bf16* YA = (bf16*)F.out;
#else
    bf16* YA = WSP(bf16, WS_YA);
#endif
    for (int it = F.gw; it < S * NH; it += F.NGW) { const int q = it >> 3, h = it & 7, qblk = q >> 8;
        const bf16* qp = QA + (size_t)q * DM + h * HD;
        float m = -INFINITY, l = 0.f, o0 = 0.f, o1 = 0.f;
        for (int slot = 0; slot < 4; ++slot) {
            int kb = qblk; if (slot < 3) { kb = TOPI[(size_t)it * 3 + slot]; if (kb < 0) continue; }
            const bf16* kp = KA + (size_t)(kb * MBLK) * DM + h * HD; const bf16* vp = VA + (size_t)(kb * MBLK) * DM + h * HD;
            float s[4] = {0.f, 0.f, 0.f, 0.f};
#pragma unroll 4
            for (int c = 0; c < 16; ++c) { const u32x4 qv = *(const u32x4*)(qp + 8 * c);
                const float q0 = bflo(qv.x), q1 = bfhi(qv.x), q2 = bflo(qv.y), q3 = bfhi(qv.y), q4 = bflo(qv.z), q5 = bfhi(qv.z), q6 = bflo(qv.w), q7 = bfhi(qv.w);
#pragma unroll
                for (int jj = 0; jj < 4; ++jj) { const u32x4 kv = *(const u32x4*)(kp + (size_t)(F.lane + 64 * jj) * DM + 8 * c);
                    s[jj] += q0 * bflo(kv.x) + q1 * bfhi(kv.x) + q2 * bflo(kv.y) + q3 * bfhi(kv.y) + q4 * bflo(kv.z) + q5 * bfhi(kv.z) + q6 * bflo(kv.w) + q7 * bfhi(kv.w); } }
            float mx = -INFINITY;
#pragma unroll
            for (int jj = 0; jj < 4; ++jj) { s[jj] *= 0.08838834764831845f; if (slot == 3 && (kb * MBLK + F.lane + 64 * jj) > q) s[jj] = -INFINITY; mx = fmaxf(mx, s[jj]); }
            mx = wave_max(mx);
            const float mn = fmaxf(m, mx), sc = __expf(m - mn);
            float p[4], ps = 0.f;
#pragma unroll
            for (int jj = 0; jj < 4; ++jj) { p[jj] = __expf(s[jj] - mn); ps += p[jj]; }
            l = l * sc + wave_sum(ps); o0 *= sc; o1 *= sc; m = mn;
#pragma unroll
            for (int jj = 0; jj < 4; ++jj)
                for (int ln = 0; ln < 64; ++ln) { const float pj = __shfl(p[jj], ln); const unsigned vv = *(const unsigned*)(vp + (size_t)(ln + 64 * jj) * DM + 2 * F.lane); o0 += pj * bflo(vv); o1 += pj * bfhi(vv); }
        }
        const float il = 1.f / l;
        *(unsigned*)(YA + (size_t)q * DM + h * HD + 2 * F.lane) = pk2(o0 * il, o1 * il); }
}


typedef float f32x16 __attribute__((ext_vector_type(16)));
typedef short s16x4 __attribute__((ext_vector_type(4)));
typedef float f32x2_t __attribute__((ext_vector_type(2)));
typedef __bf16 bf16x2_t __attribute__((ext_vector_type(2)));
constexpr size_t WS_BUCKET = 241 * MiB, WS_ML = 249 * MiB, WS_OP2 = WS_Z;
constexpr int BUCKET_PER_HEAD = 256 * 2016;
constexpr int CW_CNT = 16384;
static_assert(WS_BUCKET + (size_t)NH * BUCKET_PER_HEAD * 2 <= WS_ML && WS_ML + (size_t)3 * S * NH * 8 <= WS_END, "bucket map");
constexpr float SM_C = 0.08838834764831845f * 1.4426950408889634f;

__device__ __forceinline__ int bucket_off(int kb) { return 256 * (63 * kb - (kb * (kb - 1)) / 2); }
__device__ __forceinline__ unsigned attn_off(unsigned row, unsigned ch) { return 256u * row + 16u * (ch ^ (((row & 3u) << 2) | ((row >> 2) & 3u))); }
__device__ __forceinline__ unsigned cvtpk(float lo, float hi) { f32x2_t v = {lo, hi}; bf16x2_t b = __builtin_convertvector(v, bf16x2_t); return __builtin_bit_cast(unsigned, b); }
__device__ __forceinline__ s16x4 vtr16(const LAS unsigned char* p) { typedef short v4i16_t __attribute__((ext_vector_type(4))); return __builtin_bit_cast(s16x4, __builtin_amdgcn_ds_read_tr16_b64_v4i16((LAS v4i16_t*)p)); }

__device__ __forceinline__ void unpack8f(const bf16x8 v, float (&f)[8]) { const u32x4 w = __builtin_bit_cast(u32x4, v);
    f[0] = bflo(w.x); f[1] = bfhi(w.x); f[2] = bflo(w.y); f[3] = bfhi(w.y); f[4] = bflo(w.z); f[5] = bfhi(w.z); f[6] = bflo(w.w); f[7] = bfhi(w.w); }
__device__ __forceinline__ bf16x8 pack8f(const float (&f)[8]) { u32x4 w; w.x = cvtpk(f[0], f[1]); w.y = cvtpk(f[2], f[3]); w.z = cvtpk(f[4], f[5]); w.w = cvtpk(f[6], f[7]); return __builtin_bit_cast(bf16x8, w); }

__device__ __forceinline__ void attn_stage(const bf16* src, LAS unsigned char* img, int tid) {
#pragma unroll
    for (int i = 0; i < 8; ++i) { const int n = tid + 512 * i, row = n >> 4, ch = n & 15;
        const u32x4 v = *(const u32x4*)(src + (size_t)row * DM + 8 * ch); *(LAS u32x4*)(img + attn_off(row, ch)) = v; }
}
struct AttnState { float m, l; f32x16 o[4]; };
__device__ __forceinline__ float half_max(float v) { const auto t = __builtin_amdgcn_permlane32_swap(__builtin_bit_cast(unsigned, v), __builtin_bit_cast(unsigned, v), false, false); return fmaxf(__builtin_bit_cast(float, t[0]), __builtin_bit_cast(float, t[1])); }
__device__ __forceinline__ float half_sum(float v) { const auto t = __builtin_amdgcn_permlane32_swap(__builtin_bit_cast(unsigned, v), __builtin_bit_cast(unsigned, v), false, false); return __builtin_bit_cast(float, t[0]) + __builtin_bit_cast(float, t[1]); }
template <int NT> __device__ __forceinline__ void attn_wave(const bf16x8 (&qf)[8], const LAS unsigned char* Kimg, const LAS unsigned char* Vimg, int nt, int diag, int lane, AttnState& st) {
    const int r = lane & 31, hh = lane >> 5, blk = (lane >> 4) & 1, q4 = (lane & 15) >> 2, p4 = lane & 3;
    const LAS unsigned char* kad[8];
#pragma unroll
    for (int ks = 0; ks < 8; ++ks) kad[ks] = Kimg + attn_off(r, 2 * ks + hh);
    const LAS unsigned char* vb[2][4];
    { const unsigned rl0 = 4u * hh + q4, cb = 2u * blk + (p4 >> 1);
#pragma unroll
      for (int a = 0; a < 2; ++a)
#pragma unroll
          for (int c = 0; c < 4; ++c) vb[a][c] = Vimg + 256u * rl0 + 16u * (cb ^ (unsigned)hh ^ (2u * a)) + 8u * (p4 & 1) + 64u * ((unsigned)c ^ q4); }
    st.m = -INFINITY; st.l = 0.f;
#pragma unroll
    for (int c = 0; c < 4; ++c)
#pragma unroll
        for (int i = 0; i < 16; ++i) st.o[c][i] = 0.f;
    auto tile = [&](const int kt) __attribute__((always_inline)) {
        f32x16 s;
#pragma unroll
        for (int i = 0; i < 16; ++i) s[i] = 0.f;
#pragma unroll
        for (int ks = 0; ks < 8; ++ks) { const bf16x8 kf = *(const LAS bf16x8*)(kad[ks] + kt * 8192); s = __builtin_amdgcn_mfma_f32_32x32x16_bf16(kf, qf[ks], s, 0, 0, 0); }
        float tmax = -INFINITY;
#pragma unroll
        for (int i = 0; i < 16; ++i) { if (kt == diag && ((i & 3) + 8 * (i >> 2) + 4 * hh) > r) s[i] = -INFINITY; tmax = fmaxf(tmax, s[i]); }
        tmax = fmaxf(tmax, __shfl_xor(tmax, 32)) * SM_C;
        if (!(tmax - st.m <= 8.f)) { const float mn = fmaxf(st.m, tmax), alpha = __builtin_amdgcn_exp2f(st.m - mn); st.l *= alpha; st.m = mn;
#pragma unroll
            for (int c = 0; c < 4; ++c)
#pragma unroll
                for (int i = 0; i < 16; ++i) st.o[c][i] *= alpha; }
        float rs = 0.f; const float nm = -st.m;
#pragma unroll
        for (int i = 0; i < 16; ++i) { s[i] = __builtin_amdgcn_exp2f(__builtin_fmaf(s[i], SM_C, nm)); rs += s[i]; }
        st.l += rs + __shfl_xor(rs, 32);
#pragma unroll
        for (int sp = 0; sp < 2; ++sp) {
            u32x4 pw; pw.x = cvtpk(s[8 * sp], s[8 * sp + 1]); pw.y = cvtpk(s[8 * sp + 2], s[8 * sp + 3]); pw.z = cvtpk(s[8 * sp + 4], s[8 * sp + 5]); pw.w = cvtpk(s[8 * sp + 6], s[8 * sp + 7]);
            const bf16x8 pf = __builtin_bit_cast(bf16x8, pw);
#pragma unroll
            for (int c = 0; c < 4; ++c) {
                const s16x4 lo = vtr16(vb[0][c] + (4096 * sp + kt * 8192));
                const s16x4 hi = vtr16(vb[1][c] + (2048 + 4096 * sp + kt * 8192));
                const bf16x8 vf = __builtin_shufflevector(lo, hi, 0, 1, 2, 3, 4, 5, 6, 7);
                st.o[c] = __builtin_amdgcn_mfma_f32_32x32x16_bf16(vf, pf, st.o[c], 0, 0, 0);
            }
        }
    };
    if constexpr (NT > 0) {
#pragma unroll
        for (int kt = 0; kt < NT; ++kt) tile(kt);
    } else { for (int kt = 0; kt < nt; ++kt) tile(kt); }
}
__device__ __forceinline__ void p_topk_bucket(Frame& F, const Args& A) {
    const bf16* QA = WSP(bf16, WS_R1); const float* KM = WSP(float, WS_KMEAN); int* TOPI = WSP(int, WS_TOPI);
    unsigned* CNT = WSP(unsigned, WS_CTL) + CW_CNT; unsigned short* BUCKET = WSP(unsigned short, WS_BUCKET); f32x2_t* ML = WSP(f32x2_t, WS_ML);
    for (int it = F.gw; it < S * NH; it += F.NGW) { const int q = it >> 3, h = it & 7, qblk = q >> 8;
        float g = -INFINITY;
        if (F.lane < qblk) { const bf16* qp = QA + (size_t)q * DM + h * HD; const float* kp = KM + ((size_t)F.lane * NH + h) * HD; float a = 0.f;
#pragma unroll
            for (int c = 0; c < 16; ++c) { const u32x4 qv = *(const u32x4*)(qp + 8 * c); const f32x4 k0 = *(const f32x4*)(kp + 8 * c), k1 = *(const f32x4*)(kp + 8 * c + 4);
                a += bflo(qv.x) * k0.x + bfhi(qv.x) * k0.y + bflo(qv.y) * k0.z + bfhi(qv.y) * k0.w + bflo(qv.z) * k1.x + bfhi(qv.z) * k1.y + bflo(qv.w) * k1.z + bfhi(qv.w) * k1.w; }
            g = a; }
        int res = -1;
#pragma unroll
        for (int r = 0; r < 3; ++r) { float v = g; int i = F.lane;
#pragma unroll
            for (int o = 1; o < 64; o <<= 1) { const float ov = __shfl_xor(v, o); const int oi = __shfl_xor(i, o); if (ov > v || (ov == v && oi < i)) { v = ov; i = oi; } }
            if (F.lane == r) res = (r < qblk) ? i : -1;
            if (F.lane == i) g = -INFINITY; }
        if (F.lane < 3) { TOPI[(size_t)it * 3 + F.lane] = res;
            if (res >= 0) { const unsigned pos = __hip_atomic_fetch_add(CNT + h * NBLK + res, 1u, __ATOMIC_RELAXED, __HIP_MEMORY_SCOPE_AGENT);
                BUCKET[(size_t)h * BUCKET_PER_HEAD + bucket_off(res) + pos] = (unsigned short)((q << 2) | F.lane); }
            else ML[((size_t)F.lane * S + q) * NH + h] = (f32x2_t){-INFINITY, 0.f}; } }
}

__device__ __forceinline__ void p_topk2(Frame& F, const Args& A) {
    const bf16* QA = WSP(bf16, WS_R1); const float* KP = WSP(const float, WS_KMEAN);
    unsigned* CNT = WSP(unsigned, WS_CTL) + CW_CNT; unsigned short* BUCKET = WSP(unsigned short, WS_BUCKET); f32x2_t* ML = WSP(f32x2_t, WS_ML);
    LAS unsigned char* Kimg = F.lds;
    LAS int* lcnt = (LAS int*)(F.lds + 16384); LAS int* lbase = lcnt + 64;
    const int lane = F.lane, r = lane & 31, hh = lane >> 5;
    for (int u = blockIdx.x; u < NBLK * NH; u += F.G) { const int qblk = u >> 3, h = u & 7, q = qblk * MBLK + 32 * F.wave + r;
        __syncthreads();
        { const int n = F.tid >> 3, c = F.tid & 7; const float* p0 = KP + ((size_t)(n * 2) * NH + h) * HD + 16 * c; const float* p1 = p0 + (size_t)NH * HD;
#pragma unroll
          for (int half = 0; half < 2; ++half) { const f32x4 a0 = *(const f32x4*)(p0 + 8 * half), a1 = *(const f32x4*)(p0 + 8 * half + 4), c0 = *(const f32x4*)(p1 + 8 * half), c1 = *(const f32x4*)(p1 + 8 * half + 4);
              float f[8] = {(a0.x + c0.x) * (1.f / MBLK), (a0.y + c0.y) * (1.f / MBLK), (a0.z + c0.z) * (1.f / MBLK), (a0.w + c0.w) * (1.f / MBLK), (a1.x + c1.x) * (1.f / MBLK), (a1.y + c1.y) * (1.f / MBLK), (a1.z + c1.z) * (1.f / MBLK), (a1.w + c1.w) * (1.f / MBLK)};
              *(LAS bf16x8*)(Kimg + attn_off(n, 2 * c + half)) = pack8f(f); } }
        if (F.tid < 64) lcnt[F.tid] = 0;
        __syncthreads();
        float bv[3] = {-INFINITY, -INFINITY, -INFINITY}; int bi[3] = {0, 0, 0};
        if (qblk > 0) {
            bf16x8 qf[8];
#pragma unroll
            for (int ks = 0; ks < 8; ++ks) qf[ks] = *(const bf16x8*)(QA + (size_t)q * DM + h * HD + 16 * ks + 8 * hh);
            const int nt = (qblk > 32) ? 2 : 1;
            for (int tn = 0; tn < nt; ++tn) {
                f32x16 acc;
#pragma unroll
                for (int i = 0; i < 16; ++i) acc[i] = 0.f;
#pragma unroll
                for (int ks = 0; ks < 8; ++ks) { const bf16x8 kf = *(const LAS bf16x8*)(Kimg + attn_off(32 * tn + r, 2 * ks + hh)); acc = __builtin_amdgcn_mfma_f32_32x32x16_bf16(kf, qf[ks], acc, 0, 0, 0); }
#pragma unroll
                for (int i = 0; i < 16; ++i) { const int n = 32 * tn + (i & 3) + 8 * (i >> 2) + 4 * hh; const float v = (n < qblk) ? acc[i] : -INFINITY;
                    const bool g0 = v > bv[0], g1 = v > bv[1], g2 = v > bv[2];
                    bv[2] = g1 ? bv[1] : (g2 ? v : bv[2]); bi[2] = g1 ? bi[1] : (g2 ? n : bi[2]);
                    bv[1] = g0 ? bv[0] : (g1 ? v : bv[1]); bi[1] = g0 ? bi[0] : (g1 ? n : bi[1]);
                    bv[0] = g0 ? v : bv[0]; bi[0] = g0 ? n : bi[0]; }
            }
            float ov[3]; int oi[3];
#pragma unroll
            for (int k = 0; k < 3; ++k) { ov[k] = __shfl_xor(bv[k], 32); oi[k] = __shfl_xor(bi[k], 32); }
#pragma unroll
            for (int k = 0; k < 3; ++k) { const float v = ov[k]; const int n = oi[k];
#define TK_GT(v_, n_, w_, m_) ((v_) > (w_) || ((v_) == (w_) && (n_) < (m_)))
                const bool ok = v > -INFINITY, g0 = ok && TK_GT(v, n, bv[0], bi[0]), g1 = ok && TK_GT(v, n, bv[1], bi[1]), g2 = ok && TK_GT(v, n, bv[2], bi[2]);
                bv[2] = g1 ? bv[1] : (g2 ? v : bv[2]); bi[2] = g1 ? bi[1] : (g2 ? n : bi[2]);
                bv[1] = g0 ? bv[0] : (g1 ? v : bv[1]); bi[1] = g0 ? bi[0] : (g1 ? n : bi[1]);
                bv[0] = g0 ? v : bv[0]; bi[0] = g0 ? n : bi[0]; }
        }
        int rank[3] = {0, 0, 0}; bool valid[3];
#pragma unroll
        for (int k = 0; k < 3; ++k) { valid[k] = (hh == 0) && (k < qblk) && (bv[k] > -INFINITY);
            if (valid[k]) rank[k] = __hip_atomic_fetch_add(lcnt + bi[k], 1, __ATOMIC_RELAXED, __HIP_MEMORY_SCOPE_WORKGROUP);
            else if (hh == 0) ML[((size_t)k * S + q) * NH + h] = (f32x2_t){-INFINITY, 0.f}; }
        __syncthreads();
        if (F.tid < 64) { const int c = lcnt[F.tid]; if (c > 0) lbase[F.tid] = (int)__hip_atomic_fetch_add(CNT + h * NBLK + F.tid, (unsigned)c, __ATOMIC_RELAXED, __HIP_MEMORY_SCOPE_AGENT); }
        __syncthreads();
#pragma unroll
        for (int k = 0; k < 3; ++k) if (valid[k]) BUCKET[(size_t)h * BUCKET_PER_HEAD + bucket_off(bi[k]) + lbase[bi[k]] + rank[k]] = (unsigned short)((q << 2) | k);
    }
    __syncthreads();
}
__device__ __forceinline__ bf16* op_slot(Frame& F, int r) { return r < 2 ? (bf16*)F.out + (size_t)r * S * DM : WSP(bf16, WS_OP2); }
__device__ __forceinline__ void p_attn_sel(Frame& F, const Args& A) {
    const bf16* QA = WSP(bf16, WS_R1); const bf16* KA = WSP(bf16, WS_R1 + T32); const bf16* VA = WSP(bf16, WS_R1 + 2 * T32);
    const unsigned* CNT = WSP(const unsigned, WS_CTL) + CW_CNT; const unsigned short* BUCKET = WSP(const unsigned short, WS_BUCKET); f32x2_t* ML = WSP(f32x2_t, WS_ML);
    LAS unsigned char* Kimg = F.lds; LAS unsigned char* Vimg = F.lds + 65536; LAS int* pre = (LAS int*)(F.lds + LDSCTL_OFF + 1024);
    constexpr int AS_UW = 4, AS_SW = 3;
    LAS int* prew = (LAS int*)(F.lds + 131072);
    __syncthreads();
    { const int nb = (int)((CNT[F.tid] + 255u) >> 8), wb = nb ? AS_SW + AS_UW * nb : 0;
      int inc = nb, incw = wb;
#pragma unroll
      for (int o = 1; o < 64; o <<= 1) { const int v = __shfl_up(inc, o), vw = __shfl_up(incw, o); if (F.lane >= o) { inc += v; incw += vw; } }
      LAS int* wtot = pre + 520;
      if (F.lane == 63) { wtot[F.wave] = inc; wtot[8 + F.wave] = incw; }
      __syncthreads();
      int base = 0, basew = 0;
#pragma unroll
      for (int w = 0; w < NWAVES; ++w) { base += (w < F.wave) ? wtot[w] : 0; basew += (w < F.wave) ? wtot[8 + w] : 0; }
      pre[F.tid] = base + inc - nb; prew[F.tid] = basew + incw - wb;
      if (F.tid == NWAVES * 64 - 1) { pre[NH * NBLK] = base + inc; prew[NH * NBLK] = basew + incw; } }
    __syncthreads();
    const int totalw = prew[NH * NBLK];
    auto first_unit = [&](const int x) __attribute__((always_inline)) -> int {
        int lo = 0, hi = NH * NBLK - 1; while (lo < hi) { const int mid = (lo + hi + 1) >> 1; if (prew[mid] <= x) lo = mid; else hi = mid - 1; }
        const int nbl = pre[lo + 1] - pre[lo], d = x - prew[lo];
        int j = 0; if (d > 0) { j = (d - AS_SW + AS_UW - 1) / AS_UW; j = j < 1 ? 1 : j; j = j > nbl ? nbl : j; }
        return pre[lo] + j; };
#define AS_DECODE(u_, h_, kb_, b_, cnt_) do { int lo_ = 0, hi_ = NH * NBLK - 1; while (lo_ < hi_) { const int mid_ = (lo_ + hi_ + 1) >> 1; if (pre[mid_] <= (u_)) lo_ = mid_; else hi_ = mid_ - 1; } \
        h_ = lo_ >> 6; kb_ = lo_ & 63; b_ = (u_) - pre[lo_]; cnt_ = (int)CNT[lo_]; } while (0)
    const int hh = F.lane >> 5;
    bf16x8 qf[8];
    const int u1 = first_unit((int)(((long long)(blockIdx.x + 1) * totalw) / F.G)); int hs = -1, kbs = -1;
    int u = first_unit((int)(((long long)blockIdx.x * totalw) / F.G)), h = 0, kb = 0, b = 0, cnt = 0, q = 0, r = 0; bool valid = false;
    if (u < u1) { AS_DECODE(u, h, kb, b, cnt);
        const int e = 256 * b + 32 * F.wave + (F.lane & 31); valid = e < cnt;
        const unsigned ent = BUCKET[(size_t)h * BUCKET_PER_HEAD + bucket_off(kb) + (valid ? e : 256 * b)]; q = (int)(ent >> 2); r = (int)(ent & 3u);
#pragma unroll
        for (int ks = 0; ks < 8; ++ks) qf[ks] = *(const bf16x8*)(QA + (size_t)q * DM + h * HD + 16 * ks + 8 * hh); }
    while (u < u1) {
        if (h != hs || kb != kbs) {
            __syncthreads();
            attn_stage(KA + (size_t)(kb * MBLK) * DM + h * HD, Kimg, F.tid); attn_stage(VA + (size_t)(kb * MBLK) * DM + h * HD, Vimg, F.tid);
            __syncthreads(); hs = h; kbs = kb; }
        const int un = u + 1; int hn = 0, kbn = 0, bn = 0, cntn = 0; unsigned entn = 0u; bool validn = false;
        if (un < u1) { AS_DECODE(un, hn, kbn, bn, cntn);
            const int e = 256 * bn + 32 * F.wave + (F.lane & 31); validn = e < cntn;
            entn = BUCKET[(size_t)hn * BUCKET_PER_HEAD + bucket_off(kbn) + (validn ? e : 256 * bn)]; }
        AttnState st; if (__ballot(valid) != 0ull) attn_wave<8>(qf, Kimg, Vimg, 8, -1, F.lane, st);
        const int qc = q, rc = r, hc = h; const bool vc = valid;
        if (un < u1) { q = (int)(entn >> 2); r = (int)(entn & 3u); h = hn; kb = kbn; valid = validn;
#pragma unroll
            for (int ks = 0; ks < 8; ++ks) qf[ks] = *(const bf16x8*)(QA + (size_t)q * DM + h * HD + 16 * ks + 8 * hh); }
        if (vc) {
            bf16* op = op_slot(F, rc) + (size_t)qc * DM + hc * HD + 64 * hh;
#pragma unroll
            for (int c = 0; c < 4; ++c)
#pragma unroll
                for (int g2 = 0; g2 < 2; ++g2) { u32x4 w; w.x = cvtpk(st.o[c][8 * g2], st.o[c][8 * g2 + 1]); w.y = cvtpk(st.o[c][8 * g2 + 2], st.o[c][8 * g2 + 3]); w.z = cvtpk(st.o[c][8 * g2 + 4], st.o[c][8 * g2 + 5]); w.w = cvtpk(st.o[c][8 * g2 + 6], st.o[c][8 * g2 + 7]);
                    *(u32x4*)(op + 16 * c + 8 * g2) = w; }
            if (hh == 0) ML[((size_t)rc * S + qc) * NH + hc] = (f32x2_t){st.m, st.l}; }
        u = un;
    }
    __syncthreads();
}
__device__ __forceinline__ void p_attn_own(Frame& F, const Args& A) {
    const bf16* QA = WSP(bf16, WS_R1); const bf16* KA = WSP(bf16, WS_R1 + T32); const bf16* VA = WSP(bf16, WS_R1 + 2 * T32); const f32x2_t* ML = WSP(const f32x2_t, WS_ML); bf16* YA = WSP(bf16, WS_YA);
    LAS unsigned char* Kimg = F.lds; LAS unsigned char* Vimg = F.lds + 65536;
    for (int u = blockIdx.x; u < NH * NBLK; u += F.G) { const int h = u & 7, qb = u >> 3;
        __syncthreads();
        attn_stage(KA + (size_t)(qb * MBLK) * DM + h * HD, Kimg, F.tid); attn_stage(VA + (size_t)(qb * MBLK) * DM + h * HD, Vimg, F.tid);
        __syncthreads();
        const int q = qb * MBLK + 32 * F.wave + (F.lane & 31), hh = F.lane >> 5;
        bf16x8 qf[8];
#pragma unroll
        for (int ks = 0; ks < 8; ++ks) qf[ks] = *(const bf16x8*)(QA + (size_t)q * DM + h * HD + 16 * ks + 8 * hh);
        AttnState st; attn_wave<0>(qf, Kimg, Vimg, F.wave + 1, F.wave, F.lane, st);
        float mr[3], lr[3], M = st.m;
#pragma unroll
        for (int r = 0; r < 3; ++r) { const f32x2_t ml = ML[((size_t)r * S + q) * NH + h]; mr[r] = ml.x; lr[r] = ml.y; M = fmaxf(M, ml.x); }
        const float w0 = __builtin_amdgcn_exp2f(st.m - M); float L = st.l * w0; float wr[3];
#pragma unroll
        for (int r = 0; r < 3; ++r) { wr[r] = (lr[r] > 0.f) ? __builtin_amdgcn_exp2f(mr[r] - M) : 0.f; L += lr[r] * wr[r]; }
        const float iL = rcp_(L);
        const size_t pbase = (size_t)q * DM + h * HD + 64 * hh;
        const bf16* ps0 = op_slot(F, 0) + pbase; const bf16* ps1 = op_slot(F, 1) + pbase; const bf16* ps2 = op_slot(F, 2) + pbase;
#pragma unroll
        for (int half = 0; half < 2; ++half) {
            bf16x8 pl[4][3];
#pragma unroll
            for (int k = 0; k < 4; ++k) { pl[k][0] = *(const bf16x8*)(ps0 + 32 * half + 8 * k); pl[k][1] = *(const bf16x8*)(ps1 + 32 * half + 8 * k); pl[k][2] = *(const bf16x8*)(ps2 + 32 * half + 8 * k); }
            __builtin_amdgcn_sched_barrier(0);
#pragma unroll
            for (int k = 0; k < 4; ++k) { const int c = 2 * half + (k >> 1), g2 = k & 1;
                float v[8];
#pragma unroll
                for (int e = 0; e < 8; ++e) v[e] = st.o[c][8 * g2 + e] * w0;
#pragma unroll
                for (int r = 0; r < 3; ++r) { float pf[8]; unpack8f(pl[k][r], pf); const bool on = wr[r] != 0.f;
#pragma unroll
                    for (int e = 0; e < 8; ++e) v[e] += on ? wr[r] * pf[e] : 0.f; }
                u32x2 wa, wb; wa.x = cvtpk(v[0] * iL, v[1] * iL); wa.y = cvtpk(v[2] * iL, v[3] * iL); wb.x = cvtpk(v[4] * iL, v[5] * iL); wb.y = cvtpk(v[6] * iL, v[7] * iL);
                bf16* yp = YA + (size_t)q * DM + h * HD + 32 * c + 16 * g2 + 4 * hh; *(u32x2*)yp = wa; *(u32x2*)(yp + 8) = wb; }
        }
    }
    __syncthreads();
}
__device__ __forceinline__ void p_dn_conv(Frame& F, const Args& A) {
    const bf16* QB = WSP(bf16, WS_R1); const bf16* KB = WSP(bf16, WS_R1 + T32); const bf16* VB = WSP(bf16, WS_R1 + 2 * T32);
    bf16* QN = (bf16*)F.out; bf16* KN = (bf16*)F.out + (size_t)S * DM; bf16* VN = WSP(bf16, WS_VN);
    const float* cw = A.in[3]; const float* BA = WSP(const float, WS_BA); float* BETA = WSP(float, WS_BETA); float* G = WSP(float, WS_G);
    for (int it = F.gw; it < S * NH; it += F.NGW) { const int t = it >> 3, h = it & 7, c = h * HD + 2 * F.lane;
        float aq0 = 0.f, aq1 = 0.f, ak0 = 0.f, ak1 = 0.f, av0 = 0.f, av1 = 0.f;
#pragma unroll
        for (int j = 0; j < 4; ++j) { const int tt = t + j - 3; if (tt < 0) continue;
            const unsigned xq = *(const unsigned*)(QB + (size_t)tt * DM + c), xk = *(const unsigned*)(KB + (size_t)tt * DM + c), xv = *(const unsigned*)(VB + (size_t)tt * DM + c);
            const float* w = cw + (size_t)j * 3072;
            aq0 += w[c] * bflo(xq); aq1 += w[c + 1] * bfhi(xq); ak0 += w[1024 + c] * bflo(xk); ak1 += w[1024 + c + 1] * bfhi(xk); av0 += w[2048 + c] * bflo(xv); av1 += w[2048 + c + 1] * bfhi(xv); }
        aq0 = siluf_(aq0); aq1 = siluf_(aq1); ak0 = siluf_(ak0); ak1 = siluf_(ak1); av0 = siluf_(av0); av1 = siluf_(av1);
        const float rq = rsq_(wave_sum(aq0 * aq0 + aq1 * aq1) + EPS) * 0.08838834764831845f, rk = rsq_(wave_sum(ak0 * ak0 + ak1 * ak1) + EPS);
        *(unsigned*)(QN + (size_t)t * DM + c) = pk2(aq0 * rq, aq1 * rq); *(unsigned*)(KN + (size_t)t * DM + c) = pk2(ak0 * rk, ak1 * rk); *(unsigned*)(VN + (size_t)t * DM + c) = pk2(av0, av1);
        if (F.lane == 0) { const float b = BA[(size_t)t * 16 + h], a = BA[(size_t)t * 16 + 8 + h] + A.in[5][h];
            const float sp = (a > 20.f) ? a : log1pf(expf(a));
            BETA[(size_t)t * 8 + h] = 1.f / (1.f + expf(-b)); G[(size_t)t * 8 + h] = -expf(A.in[4][h]) * sp; } }
}
__device__ __forceinline__ void p_dn_chunk(Frame& F, const Args& A) {
    const bf16* QN = (const bf16*)F.out; const bf16* KN = (const bf16*)F.out + (size_t)S * DM; bf16* VU = WSP(bf16, WS_VN); bf16* Wb = WSP(bf16, WS_W); bf16* ATT = WSP(bf16, WS_ATT);
    const float* BETA = WSP(const float, WS_BETA); const float* G = WSP(const float, WS_G); float* GC = WSP(float, WS_GC);
    LAS float* Kc = (LAS float*)(F.lds); LAS float* Qc = Kc + 64 * 132; LAS float* Lm = Qc + 64 * 132; LAS float* Tm = Lm + 64 * 65; LAS float* gcs = Tm + 64 * 65; LAS float* bes = gcs + 64; LAS float* bge = bes + 64;
    const int tid = F.tid;
    for (int item = blockIdx.x; item < NCH * NH; item += F.G) { const int n = item >> 3, h = item & 7, t0 = n * CH;
        __syncthreads();
        if (tid < 64) { gcs[tid] = G[(size_t)(t0 + tid) * 8 + h]; bes[tid] = BETA[(size_t)(t0 + tid) * 8 + h]; }
        __syncthreads();
        if (tid == 0) { float a = 0.f; for (int i = 0; i < 64; ++i) { a += gcs[i]; gcs[i] = a; } }
#pragma unroll
        for (int r = 0; r < 2; ++r) { const int idx = tid + 512 * r, row = idx >> 4, c8 = idx & 15;
            const u32x4 kv = *(const u32x4*)(KN + (size_t)(t0 + row) * DM + h * HD + 8 * c8), qv = *(const u32x4*)(QN + (size_t)(t0 + row) * DM + h * HD + 8 * c8);
            LAS float* kd = Kc + row * 132 + 8 * c8; LAS float* qd = Qc + row * 132 + 8 * c8;
            kd[0] = bflo(kv.x); kd[1] = bfhi(kv.x); kd[2] = bflo(kv.y); kd[3] = bfhi(kv.y); kd[4] = bflo(kv.z); kd[5] = bfhi(kv.z); kd[6] = bflo(kv.w); kd[7] = bfhi(kv.w);
            qd[0] = bflo(qv.x); qd[1] = bfhi(qv.x); qd[2] = bflo(qv.y); qd[3] = bfhi(qv.y); qd[4] = bflo(qv.z); qd[5] = bfhi(qv.z); qd[6] = bflo(qv.w); qd[7] = bfhi(qv.w); }
        __syncthreads();
        if (tid < 64) { GC[(size_t)(t0 + tid) * 8 + h] = gcs[tid]; bge[tid] = bes[tid] * expf(gcs[tid]); }
        for (int r = 0; r < 8; ++r) { const int p = tid + 512 * r, i = p >> 6, j = p & 63;
            float dk = 0.f, dq = 0.f;
            if (j <= i) { const LAS float* ki = Kc + i * 132; const LAS float* kj = Kc + j * 132; const LAS float* qi = Qc + i * 132;
                for (int d = 0; d < HD; ++d) { dk += ki[d] * kj[d]; dq += qi[d] * kj[d]; } }
            const float dec = (j <= i) ? expf(gcs[i] - gcs[j]) : 0.f;
            Lm[i * 65 + j] = (j < i) ? bes[i] * dk * dec : 0.f;
            ATT[((size_t)(h * NCH + n) * 64 + i) * 64 + j] = (bf16)f2bf((j <= i) ? dq * dec : 0.f); }
        __syncthreads();
        if (tid < 64) { const int c = tid;
            for (int i = 0; i < 64; ++i) { float acc = (i == c) ? 1.f : 0.f; for (int j = 0; j < i; ++j) acc -= Lm[i * 65 + j] * Tm[j * 65 + c]; Tm[i * 65 + c] = acc; } }
        __syncthreads();
#pragma unroll
        for (int r = 0; r < 2; ++r) { const int idx = tid + 512 * r, row = idx >> 4, c8 = idx & 15;
            const u32x4 vv = *(const u32x4*)(VU + (size_t)(t0 + row) * DM + h * HD + 8 * c8); LAS float* vd = Qc + row * 132 + 8 * c8;
            vd[0] = bflo(vv.x); vd[1] = bfhi(vv.x); vd[2] = bflo(vv.y); vd[3] = bfhi(vv.y); vd[4] = bflo(vv.z); vd[5] = bfhi(vv.z); vd[6] = bflo(vv.w); vd[7] = bfhi(vv.w); }
        __syncthreads();
        { const int d = tid & 127, ig = tid >> 7;
          for (int ii = 0; ii < 16; ++ii) { const int i = ig * 16 + ii; float au = 0.f, aw = 0.f;
              for (int j = 0; j <= i; ++j) { const float t = Tm[i * 65 + j]; au += t * bes[j] * Qc[j * 132 + d]; aw += t * bge[j] * Kc[j * 132 + d]; }
              VU[(size_t)(t0 + i) * DM + h * HD + d] = (bf16)f2bf(au); Wb[(size_t)(t0 + i) * DM + h * HD + d] = (bf16)f2bf(aw); } }
    }
    __syncthreads();
}
__device__ __forceinline__ void p_dn_scan_naive(Frame& F, const Args& A) {
    if (blockIdx.x < 4) {
    const bf16* QN = (const bf16*)F.out; const bf16* KN = (const bf16*)F.out + (size_t)S * DM; const bf16* U = WSP(const bf16, WS_VN); const bf16* Wb = WSP(const bf16, WS_W); const bf16* ATT = WSP(const bf16, WS_ATT);
    const float* GC = WSP(const float, WS_GC); bf16* O = WSP(bf16, WS_O);
    LAS float* vn = (LAS float*)F.lds;
    const int tid = F.tid, wv = tid >> 6, h = blockIdx.x * 2 + (wv >> 2), e = (wv & 3) * 32 + (F.lane & 31), half = F.lane >> 5;
    float s[64];
#pragma unroll
    for (int d = 0; d < 64; ++d) s[d] = 0.f;
    for (int n = 0; n < NCH; ++n) { const int t0 = n * CH; const float gl = GC[(size_t)(t0 + 63) * 8 + h];
        for (int c = 0; c < 64; ++c) { const size_t ro = (size_t)(t0 + c) * DM + h * HD; const bf16* wp = Wb + ro + 64 * half; float a = 0.f;
#pragma unroll
            for (int d8 = 0; d8 < 8; ++d8) { if ((d8 & 1) == 0) asm volatile("" ::: "memory"); const u32x4 wv4 = *(const u32x4*)(wp + 8 * d8);
                a += bflo(wv4.x) * s[8 * d8] + bfhi(wv4.x) * s[8 * d8 + 1] + bflo(wv4.y) * s[8 * d8 + 2] + bfhi(wv4.y) * s[8 * d8 + 3] + bflo(wv4.z) * s[8 * d8 + 4] + bfhi(wv4.z) * s[8 * d8 + 5] + bflo(wv4.w) * s[8 * d8 + 6] + bfhi(wv4.w) * s[8 * d8 + 7]; }
            a += __shfl_xor(a, 32);
            vn[c * 512 + tid] = bf2f(U[ro + e]) - a; }
        for (int c = 0; c < 64; ++c) { const size_t ro = (size_t)(t0 + c) * DM + h * HD; const bf16* qp = QN + ro + 64 * half; float a = 0.f;
#pragma unroll
            for (int d8 = 0; d8 < 8; ++d8) { if ((d8 & 1) == 0) asm volatile("" ::: "memory"); const u32x4 wv4 = *(const u32x4*)(qp + 8 * d8);
                a += bflo(wv4.x) * s[8 * d8] + bfhi(wv4.x) * s[8 * d8 + 1] + bflo(wv4.y) * s[8 * d8 + 2] + bfhi(wv4.y) * s[8 * d8 + 3] + bflo(wv4.z) * s[8 * d8 + 4] + bfhi(wv4.z) * s[8 * d8 + 5] + bflo(wv4.w) * s[8 * d8 + 6] + bfhi(wv4.w) * s[8 * d8 + 7]; }
            a += __shfl_xor(a, 32);
            a *= expf(GC[(size_t)(t0 + c) * 8 + h]);
            const bf16* ap = ATT + ((size_t)(h * NCH + n) * 64 + c) * 64; float b = 0.f;
            for (int j = 0; j <= c; ++j) b += bf2f(ap[j]) * vn[j * 512 + tid];
            if (half == 0) O[ro + e] = (bf16)f2bf(a + b); }
        const float egl = expf(gl);
#pragma unroll
        for (int d = 0; d < 64; ++d) s[d] *= egl;
        for (int c = 0; c < 64; ++c) { const size_t ro = (size_t)(t0 + c) * DM + h * HD; const bf16* kp = KN + ro + 64 * half; const float f = vn[c * 512 + tid] * expf(gl - GC[(size_t)(t0 + c) * 8 + h]);
#pragma unroll
            for (int d8 = 0; d8 < 8; ++d8) { if ((d8 & 1) == 0) asm volatile("" ::: "memory"); const u32x4 wv4 = *(const u32x4*)(kp + 8 * d8);
                s[8 * d8] += f * bflo(wv4.x); s[8 * d8 + 1] += f * bfhi(wv4.x); s[8 * d8 + 2] += f * bflo(wv4.y); s[8 * d8 + 3] += f * bfhi(wv4.y); s[8 * d8 + 4] += f * bflo(wv4.z); s[8 * d8 + 5] += f * bfhi(wv4.z); s[8 * d8 + 6] += f * bflo(wv4.w); s[8 * d8 + 7] += f * bfhi(wv4.w); } }
    }
    }
}
__device__ __forceinline__ void p_dn_out(Frame& F, const Args& A) {
    const bf16* O = WSP(const bf16, WS_O); const bf16* Z = WSP(const bf16, WS_Z); bf16* YD = WSP(bf16, WS_YD); const float* ow = A.in[6];
    for (int it = F.gw; it < S * NH; it += F.NGW) { const int t = it >> 3, h = it & 7; const size_t off = (size_t)t * DM + h * HD + 2 * F.lane;
        const unsigned ov = *(const unsigned*)(O + off), zv = *(const unsigned*)(Z + off); const float o0 = bflo(ov), o1 = bfhi(ov);
        const float rs = rsq_(wave_sum(o0 * o0 + o1 * o1) * (1.f / HD) + EPS);
        *(unsigned*)(YD + off) = pk2(o0 * rs * ow[2 * F.lane] * siluf_(bflo(zv)), o1 * rs * ow[2 * F.lane + 1] * siluf_(bfhi(zv))); }
}


constexpr size_t WS_UT = WS_O;
constexpr size_t WS_KT = WS_VN;
constexpr size_t WS_EGL = WS_KMEAN;
typedef float f32x4_t __attribute__((ext_vector_type(4)));

__device__ __forceinline__ void p_dn_relayout1(Frame& F, const Args& A) {
    bf16* QN = (bf16*)F.out; bf16* Wb = WSP(bf16, WS_W); const bf16* U = WSP(const bf16, WS_VN); bf16* UT = WSP(bf16, WS_UT); const float* GC = WSP(const float, WS_GC); float* EGL = WSP(float, WS_EGL);
    LAS unsigned short* tile = (LAS unsigned short*)(F.lds + F.wave * 16640);
    for (int it = F.gw; it < NCH * NH; it += F.NGW) { const int n = it >> 3, h = it & 7, t0 = n * CH;
        if (F.lane == 0) EGL[h * NCH + n] = expf(GC[(size_t)(t0 + 63) * 8 + h]);
        for (int c = 0; c < 64; ++c) { const size_t off = (size_t)(t0 + c) * DM + h * HD + 2 * F.lane; const float eg = expf(GC[(size_t)(t0 + c) * 8 + h]);
            const unsigned qv = *(const unsigned*)(QN + off); *(unsigned*)(QN + off) = pk2(bflo(qv) * eg, bfhi(qv) * eg);
            const unsigned wv = *(const unsigned*)(Wb + off); *(unsigned*)(Wb + off) = wv ^ 0x80008000u;
            const unsigned uv = *(const unsigned*)(U + off); *(LAS unsigned*)(tile + c * 130 + 2 * F.lane) = uv; }
        asm volatile("s_waitcnt lgkmcnt(0)" ::: "memory");
        bf16* ut = UT + (size_t)(h * NCH + n) * (HD * CH);
        for (int e = 0; e < HD; ++e) ut[e * CH + F.lane] = tile[F.lane * 130 + e];
        asm volatile("s_waitcnt lgkmcnt(0)" ::: "memory");
    }
}
__device__ __forceinline__ void p_dn_relayout2(Frame& F, const Args& A) {
    const bf16* KN = (const bf16*)F.out + (size_t)S * DM; bf16* KT = WSP(bf16, WS_KT); const float* GC = WSP(const float, WS_GC);
    LAS unsigned short* tile = (LAS unsigned short*)(F.lds + F.wave * 16640);
    for (int it = F.gw; it < NCH * NH; it += F.NGW) { const int n = it >> 3, h = it & 7, t0 = n * CH;
        for (int c = 0; c < 64; ++c) { const size_t off = (size_t)(t0 + c) * DM + h * HD + 2 * F.lane; *(LAS unsigned*)(tile + c * 130 + 2 * F.lane) = *(const unsigned*)(KN + off); }
        asm volatile("s_waitcnt lgkmcnt(0)" ::: "memory");
        const float f = expf(GC[(size_t)(t0 + 63) * 8 + h] - GC[(size_t)(t0 + F.lane) * 8 + h]);
        bf16* kt = KT + (size_t)(h * NCH + n) * (HD * CH);
        for (int d = 0; d < HD; ++d) kt[d * CH + F.lane] = (bf16)f2bf(bf2f(tile[F.lane * 130 + d]) * f);
        asm volatile("s_waitcnt lgkmcnt(0)" ::: "memory");
    }
}

constexpr size_t WS2_QN = WS_R1, WS2_KN = WS_R1 + T32, WS2_WNEG = WS_R1 + 2 * T32, WS2_ATT = WS_H, WS2_YD = WS_R1 + 2 * T32, WS2_HALT = WS_R1 + T32;
__device__ __forceinline__ bf16* ws2_kt(Frame& F) { return (bf16*)F.out; }
__device__ __forceinline__ bf16* ws2_ut(Frame& F) { return (bf16*)F.out + (size_t)S * DM; }

struct ConvHalo { unsigned q[3], k[3], v[3]; };
constexpr size_t WS_HALO = 241 * MiB;
__device__ __forceinline__ void p_dn_conv2_halo(Frame& F, ConvHalo& H) {
    const bf16* HB = WSP(const bf16, WS_HALO);
    const int n = F.gw >> 3, h = F.gw & 7, col = h * HD + 2 * F.lane;
#pragma unroll
    for (int j = 0; j < 3; ++j) { H.q[j] = H.k[j] = H.v[j] = 0u;
        if (n > 0 && F.gw < NCH * NH) { const bf16* hp = HB + ((size_t)(n - 1) * 3 + j) * 3072 + col; H.q[j] = *(const unsigned*)hp; H.k[j] = *(const unsigned*)(hp + 1024); H.v[j] = *(const unsigned*)(hp + 2048); } }
}
struct ConvW { float w0[4], w1[4]; };
__device__ __forceinline__ void conv_w(const float* cw, int col, ConvW& W) {
#pragma unroll
    for (int j = 0; j < 4; ++j) { W.w0[j] = cw[(size_t)j * 3072 + col]; W.w1[j] = cw[(size_t)j * 3072 + col + 1]; }
}
__device__ __forceinline__ __amdgpu_buffer_rsrc_t mk_rsrc(const void* p) { return __builtin_amdgcn_make_buffer_rsrc((void*)p, 0, 0x7fffffff, 0x00020000); }
__device__ __forceinline__ void conv_load(const bf16* src, int t0, int col, unsigned (&xall)[CH]) {
    const __amdgpu_buffer_rsrc_t r = mk_rsrc(src + (size_t)t0 * DM);
#pragma unroll
    for (int c = 0; c < CH; ++c) xall[c] = __builtin_amdgcn_raw_buffer_load_b32(r, 2 * col, c * (DM * 2), 0);
}
template <bool NORM, bool DST, bool TILE> __device__ __forceinline__ void conv_pass(const unsigned (&xall)[CH], bf16* dst, LAS unsigned short* tile, const ConvW& W, const unsigned (&halo)[3], int t0, int col, int lane, float scale) {
    float a0 = bflo(halo[0]), a1 = bfhi(halo[0]), b0 = bflo(halo[1]), b1 = bfhi(halo[1]), c0 = bflo(halo[2]), c1 = bfhi(halo[2]);
    const __amdgpu_buffer_rsrc_t rd = mk_rsrc(DST ? dst + (size_t)t0 * DM : nullptr);
#pragma unroll
    for (int c = 0; c < CH; ++c) { const unsigned xv = xall[c]; const float d0 = bflo(xv), d1 = bfhi(xv);
        float y0 = siluf_(W.w0[0] * a0 + W.w0[1] * b0 + W.w0[2] * c0 + W.w0[3] * d0), y1 = siluf_(W.w1[0] * a1 + W.w1[1] * b1 + W.w1[2] * c1 + W.w1[3] * d1);
        if (NORM) { const float rs = scale * rsq_(wave_sum(y0 * y0 + y1 * y1) + EPS); y0 *= rs; y1 *= rs; }
        const unsigned o = pk2(y0, y1);
        if (DST) __builtin_amdgcn_raw_buffer_store_b32(o, rd, 2 * col, c * (DM * 2), 0);
        if (TILE) *(LAS unsigned*)(tile + c * 130 + 2 * lane) = o;
        a0 = b0; a1 = b1; b0 = c0; b1 = c1; c0 = d0; c1 = d1; }
}
__device__ __forceinline__ void conv_tile_out(const LAS unsigned short* tile, bf16* dstT, int lane) {
#pragma unroll 4
    for (int i = 0; i < 16; ++i) { const int d = 8 * i + (lane >> 3), ch = lane & 7; const LAS unsigned short* tp = tile + (8 * ch) * 130 + d;
        u32x4 w; w.x = (unsigned)tp[0] | ((unsigned)tp[130] << 16); w.y = (unsigned)tp[260] | ((unsigned)tp[390] << 16); w.z = (unsigned)tp[520] | ((unsigned)tp[650] << 16); w.w = (unsigned)tp[780] | ((unsigned)tp[910] << 16);
        *(u32x4*)(dstT + (size_t)d * CH + 8 * ch) = w; }
}
__device__ __forceinline__ void p_dn_conv2(Frame& F, const Args& A, const ConvHalo& H) {
    if (F.gw >= NCH * NH) return;
    bf16* QB = WSP(bf16, WS_R1); bf16* KB = WSP(bf16, WS_R1 + T32); const bf16* VB = WSP(bf16, WS_R1 + 2 * T32); const float* cw = A.in[3];
    LAS unsigned short* tile = (LAS unsigned short*)(F.lds + F.wave * 16640);
    const int n = F.gw >> 3, h = F.gw & 7, t0 = n * CH, col = h * HD + 2 * F.lane;
    bf16* ktr = ws2_kt(F) + (size_t)(h * NCH + n) * (HD * CH); bf16* vt = ws2_ut(F) + (size_t)(h * NCH + n) * (HD * CH);
    unsigned xa[CH]; ConvW W;
    conv_load(KB, t0, col, xa); conv_w(cw + 1024, col, W);
    conv_pass<true, true, true>(xa, KB, tile, W, H.k, t0, col, F.lane, 1.f);
    asm volatile("s_waitcnt lgkmcnt(0)" ::: "memory");
    conv_load(VB, t0, col, xa); conv_w(cw + 2048, col, W);
    __builtin_amdgcn_sched_barrier(0);
    conv_tile_out(tile, ktr, F.lane);
    asm volatile("s_waitcnt lgkmcnt(0)" ::: "memory");
    conv_pass<false, false, true>(xa, nullptr, tile, W, H.v, t0, col, F.lane, 1.f);
    asm volatile("s_waitcnt lgkmcnt(0)" ::: "memory");
    conv_load(QB, t0, col, xa); conv_w(cw, col, W);
    __builtin_amdgcn_sched_barrier(0);
    conv_tile_out(tile, vt, F.lane);
    asm volatile("s_waitcnt lgkmcnt(0)" ::: "memory");
    conv_pass<true, true, false>(xa, QB, tile, W, H.q, t0, col, F.lane, 0.08838834764831845f);
}

constexpr int CK_WAVE_LDS = 19200;
__device__ __forceinline__ void p_dn_chunk2(Frame& F, const Args& A) {
    if (F.gw >= NCH * NH) return;
    const int n = F.gw >> 3, h = F.gw & 7, t0 = n * CH, lane = F.lane, r = lane & 31, hh = lane >> 5;
    bf16* QN = WSP(bf16, WS2_QN); const bf16* KN = WSP(const bf16, WS2_KN); bf16* Wn = WSP(bf16, WS2_WNEG); bf16* ATT = WSP(bf16, WS2_ATT) + (size_t)(h * NCH + n) * (CH * CH);
    bf16* KT = ws2_kt(F) + (size_t)(h * NCH + n) * (HD * CH); bf16* UT = ws2_ut(F) + (size_t)(h * NCH + n) * (HD * CH);
    const float* BA = WSP(const float, WS_BA); float* EGL = WSP(float, WS_EGL);
    LAS unsigned char* wl = F.lds + F.wave * CK_WAVE_LDS; LAS float* Lw = (LAS float*)wl; LAS float* gcs = (LAS float*)(wl + 18432); LAS float* bes = gcs + 64; LAS float* fcs = bes + 64;
    float beta, gc, gl;
    { const int t = t0 + lane; const float b = BA[(size_t)t * 16 + h], a = BA[(size_t)t * 16 + 8 + h] + A.in[5][h];
      const float sp = (a > 20.f) ? a : log1pf(expf(a)); gc = -expf(A.in[4][h]) * sp; beta = 1.f / (1.f + expf(-b));
#pragma unroll
      for (int o = 1; o < 64; o <<= 1) { const float v = __shfl_up(gc, o); if (lane >= o) gc += v; }
      gl = __shfl(gc, 63);
      gcs[lane] = gc; bes[lane] = beta; fcs[lane] = expf(gl - gc);
      if (lane == 0) EGL[h * NCH + n] = expf(gl); }
    asm volatile("s_waitcnt lgkmcnt(0)" ::: "memory");
    {
        bf16x8 kf[2][8];
#pragma unroll
        for (int ti = 0; ti < 2; ++ti)
#pragma unroll
            for (int ks = 0; ks < 8; ++ks) kf[ti][ks] = *(const bf16x8*)(KN + (size_t)(t0 + 32 * ti + r) * DM + h * HD + 16 * ks + 8 * hh);
#pragma unroll
        for (int tt = 0; tt < 3; ++tt) { const int ti = (tt == 0) ? 0 : 1, tj = (tt == 2) ? 1 : 0;
            f32x16 acc;
#pragma unroll
            for (int i = 0; i < 16; ++i) acc[i] = 0.f;
#pragma unroll
            for (int ks = 0; ks < 8; ++ks) acc = __builtin_amdgcn_mfma_f32_32x32x16_bf16(kf[ti][ks], kf[tj][ks], acc, 0, 0, 0);
            const int j = 32 * tj + r; const float gcj = gcs[j];
#pragma unroll
            for (int g4 = 0; g4 < 4; ++g4) { const int i0 = 32 * ti + 8 * g4 + 4 * hh; const f32x4 gi = *(const LAS f32x4*)(gcs + i0), bi = *(const LAS f32x4*)(bes + i0);
#pragma unroll
                for (int e = 0; e < 4; ++e) { const int i = i0 + e; Lw[i * 68 + j] = (j < i) ? bi[e] * acc[4 * g4 + e] * __expf(gi[e] - gcj) : 0.f; } } }
        bf16x8 qf[2][8];
#pragma unroll
        for (int ti = 0; ti < 2; ++ti)
#pragma unroll
            for (int ks = 0; ks < 8; ++ks) qf[ti][ks] = *(const bf16x8*)(QN + (size_t)(t0 + 32 * ti + r) * DM + h * HD + 16 * ks + 8 * hh);
#pragma unroll
        for (int tt = 0; tt < 3; ++tt) { const int tj = (tt == 2) ? 1 : 0, ti = (tt == 0) ? 0 : 1;
            f32x16 acc;
#pragma unroll
            for (int i = 0; i < 16; ++i) acc[i] = 0.f;
#pragma unroll
            for (int ks = 0; ks < 8; ++ks) acc = __builtin_amdgcn_mfma_f32_32x32x16_bf16(kf[tj][ks], qf[ti][ks], acc, 0, 0, 0);
            const int i = 32 * ti + r; const float gci = gcs[i];
#pragma unroll
            for (int g4 = 0; g4 < 4; ++g4) { const int j0 = 32 * tj + 8 * g4 + 4 * hh; const f32x4 gj = *(const LAS f32x4*)(gcs + j0); float v[4];
#pragma unroll
                for (int e = 0; e < 4; ++e) v[e] = (j0 + e <= i) ? acc[4 * g4 + e] * __expf(gci - gj[e]) : 0.f;
                u32x2 w; w.x = cvtpk(v[0], v[1]); w.y = cvtpk(v[2], v[3]); *(u32x2*)(ATT + (size_t)i * CH + 32 * tj + 16 * (g4 & 1) + 8 * hh + 4 * (g4 >> 1)) = w; } }
        { const u32x4 z4 = {0u, 0u, 0u, 0u}; const int zi = lane >> 1, zj = 32 + 16 * (lane & 1); *(u32x4*)(ATT + (size_t)zi * CH + zj) = z4; *(u32x4*)(ATT + (size_t)zi * CH + zj + 8) = z4; }
#pragma unroll
        for (int ti = 0; ti < 2; ++ti) { const float eg = __expf(gcs[32 * ti + r]);
#pragma unroll
            for (int ks = 0; ks < 8; ++ks) { float f[8]; unpack8f(qf[ti][ks], f);
#pragma unroll
                for (int e = 0; e < 8; ++e) f[e] *= eg;
                const u32x4 pw = __builtin_bit_cast(u32x4, pack8f(f)); bf16* qd = QN + (size_t)(t0 + 32 * ti + r) * DM + h * HD + 32 * (ks >> 1) + 16 * hh + 4 * (ks & 1);
                u32x2 p0, p1; p0.x = pw.x; p0.y = pw.y; p1.x = pw.z; p1.y = pw.w; *(u32x2*)qd = p0; *(u32x2*)(qd + 8) = p1; } }
    }
    asm volatile("s_waitcnt lgkmcnt(0)" ::: "memory");
    float T[64];
#pragma unroll
    for (int i = 0; i < 64; ++i) { float acc = (lane == i) ? 1.f : 0.f;
#pragma unroll
        for (int j = 0; j < i; ++j) acc -= Lw[i * 68 + j] * T[j];
        T[i] = acc; }
    LAS unsigned short* Tb = (LAS unsigned short*)wl; LAS unsigned short* Tbg = Tb + 64 * 72;
    { const float eg = __expf(gc);
      asm volatile("s_waitcnt lgkmcnt(0)" ::: "memory");
#pragma unroll
      for (int i = 0; i < 64; ++i) { const float v = T[i] * beta; Tb[i * 72 + lane] = (unsigned short)f2bf(v); Tbg[i * 72 + lane] = (unsigned short)f2bf(v * eg); } }
    asm volatile("s_waitcnt lgkmcnt(0)" ::: "memory");
#ifdef DBG_CHK
    if (n < 128) { bf16* dump = WSP(bf16, 241 * MiB) + (size_t)(h * 128 + n) * 4096; for (int i = 0; i < 64; ++i) dump[i * 64 + lane] = Tbg[i * 72 + lane]; }
#endif
#ifdef DBG_CHK
    if (n < 32) { bf16* dk = WSP(bf16, 249 * MiB) + (size_t)(h * 32 + n) * 8192; for (int x = 0; x < 128; ++x) dk[x * 64 + lane] = KT[(size_t)x * CH + lane]; }
#endif
#ifdef DN2_VALU_UW
    for (int e = 0; e < HD; ++e) { float a = 0.f; for (int j2 = 0; j2 < 64; ++j2) a += bf2f(Tb[lane * 72 + j2]) * bf2f(UT[(size_t)e * CH + j2]); asm volatile("s_waitcnt vmcnt(0)" ::: "memory"); UT[(size_t)e * CH + lane] = (bf16)f2bf(a); asm volatile("s_waitcnt vmcnt(0)" ::: "memory"); }
    for (int d2 = 0; d2 < HD; ++d2) { float a = 0.f; for (int j2 = 0; j2 < 64; ++j2) a += bf2f(Tbg[lane * 72 + j2]) * bf2f(KT[(size_t)d2 * CH + j2]); Wn[(size_t)(t0 + lane) * DM + h * HD + d2] = (bf16)f2bf(-a); }
#else
#pragma unroll
    for (int te = 0; te < 4; ++te) { bf16x8 vfr[4];
#pragma unroll
        for (int ks2 = 0; ks2 < 4; ++ks2) vfr[ks2] = *(const bf16x8*)(UT + (size_t)(32 * te + r) * CH + 16 * ks2 + 8 * hh);
#pragma unroll
        for (int ti = 0; ti < 2; ++ti) { f32x16 acc;
#pragma unroll
            for (int i = 0; i < 16; ++i) acc[i] = 0.f;
#pragma unroll
            for (int ks2 = 0; ks2 < 4; ++ks2) if (ti == 1 || ks2 < 2) { const bf16x8 tb = *(const LAS bf16x8*)(Tb + (32 * ti + r) * 72 + 16 * ks2 + 8 * hh); acc = __builtin_amdgcn_mfma_f32_32x32x16_bf16(tb, vfr[ks2], acc, 0, 0, 0); }
#pragma unroll
            for (int g4 = 0; g4 < 4; ++g4) { u32x2 w; w.x = cvtpk(acc[4 * g4], acc[4 * g4 + 1]); w.y = cvtpk(acc[4 * g4 + 2], acc[4 * g4 + 3]); *(u32x2*)(UT + (size_t)(32 * te + r) * CH + 32 * ti + 8 * g4 + 4 * hh) = w; } } }
    f32x4 fsc[4][2];
#pragma unroll
    for (int ks2 = 0; ks2 < 4; ++ks2) { fsc[ks2][0] = *(const LAS f32x4*)(fcs + 16 * ks2 + 8 * hh); fsc[ks2][1] = *(const LAS f32x4*)(fcs + 16 * ks2 + 8 * hh + 4); }
#pragma unroll
    for (int td = 0; td < 4; ++td) { bf16x8 kfr[4];
#pragma unroll
        for (int ks2 = 0; ks2 < 4; ++ks2) kfr[ks2] = *(const bf16x8*)(KT + (size_t)(32 * td + r) * CH + 16 * ks2 + 8 * hh);
#pragma unroll
        for (int tc = 0; tc < 2; ++tc) { f32x16 acc;
#pragma unroll
            for (int i = 0; i < 16; ++i) acc[i] = 0.f;
#pragma unroll
            for (int ks2 = 0; ks2 < 4; ++ks2) if (tc == 1 || ks2 < 2) { const bf16x8 tg = *(const LAS bf16x8*)(Tbg + (32 * tc + r) * 72 + 16 * ks2 + 8 * hh); acc = __builtin_amdgcn_mfma_f32_32x32x16_bf16(kfr[ks2], tg, acc, 0, 0, 0); }
#pragma unroll
            for (int g4 = 0; g4 < 4; ++g4) { u32x2 w; w.x = cvtpk(-acc[4 * g4], -acc[4 * g4 + 1]); w.y = cvtpk(-acc[4 * g4 + 2], -acc[4 * g4 + 3]);
                *(u32x2*)(Wn + (size_t)(t0 + 32 * tc + r) * DM + h * HD + 32 * td + 16 * (g4 & 1) + 8 * hh + 4 * (g4 >> 1)) = w; } }
#pragma unroll
        for (int ks2 = 0; ks2 < 4; ++ks2) { float f[8]; unpack8f(kfr[ks2], f); const f32x4 f0 = fsc[ks2][0], f1 = fsc[ks2][1];
            f[0] *= f0[0]; f[1] *= f0[1]; f[2] *= f0[2]; f[3] *= f0[3]; f[4] *= f1[0]; f[5] *= f1[1]; f[6] *= f1[2]; f[7] *= f1[3];
            const u32x4 pw = __builtin_bit_cast(u32x4, pack8f(f)); const int ch = 2 * ks2 + hh; bf16* kd = KT + (size_t)(32 * td + r) * CH + 32 * (ch >> 2) + 16 * (ch & 1) + 4 * ((ch >> 1) & 1);
            u32x2 p0, p1; p0.x = pw.x; p0.y = pw.y; p1.x = pw.z; p1.y = pw.w; *(u32x2*)kd = p0; *(u32x2*)(kd + 8) = p1; } }
#endif
}

#ifndef DN2
#define DN2 1
#endif
#if DN2
#define SCAN_WNEG WS2_WNEG
#define SCAN_QP WSP(const bf16, WS2_QN)
#define SCAN_KT ws2_kt(F)
#define SCAN_UT ws2_ut(F)
#define SCAN_ATT WS2_ATT
#define SCAN_YD WS2_YD
#else
#define SCAN_WNEG WS_W
#define SCAN_QP ((const bf16*)F.out)
#define SCAN_KT WSP(bf16, WS_KT)
#define SCAN_UT WSP(bf16, WS_UT)
#define SCAN_ATT WS_ATT
#define SCAN_YD WS_YD
#endif
constexpr int SC_RW = 288, SC_RK = 160;
constexpr int SC_W = 0, SC_Q = 64 * SC_RW, SC_K = 2 * 64 * SC_RW, SC_A = SC_K + 128 * SC_RK, SC_BUF = SC_A + 64 * SC_RK;
__device__ __forceinline__ bf16x8 frag2(const LAS unsigned char* p) {
    const u32x2 a = *(const LAS u32x2*)p, b = *(const LAS u32x2*)(p + 32); u32x4 w; w.x = a.x; w.y = a.y; w.z = b.x; w.w = b.y; return __builtin_bit_cast(bf16x8, w);
}
__device__ __forceinline__ bf16x8 packb(const f32x4_t a, const f32x4_t b) { u32x4 w; w.x = cvtpk(a[0], a[1]); w.y = cvtpk(a[2], a[3]); w.z = cvtpk(b[0], b[1]); w.w = cvtpk(b[2], b[3]); return __builtin_bit_cast(bf16x8, w); }
constexpr int SCAN_WGS = 16;
__device__ __forceinline__ void p_dn_scan_fast(Frame& F, const Args& A) {
    if (blockIdx.x < SCAN_WGS) {
    const int h = blockIdx.x >> 1, hf = blockIdx.x & 1;
    const bf16* Wb = WSP(const bf16, SCAN_WNEG); const bf16* QP = SCAN_QP; const bf16* KT = SCAN_KT; const bf16* ATT = WSP(const bf16, SCAN_ATT); bf16* UT = SCAN_UT; const float* EGL = WSP(const float, WS_EGL);
    if (F.wave >= 4) {
        const int lt = F.tid - 256;
#if defined(SCAN_PROBE) && SCAN_PROBE == 2
        unsigned long long lp_sum = 0ull, lp_t0 = 0ull;
#define SCP_T0() (lp_t0 = __builtin_amdgcn_s_memrealtime())
#define SCP_T1() (lp_sum += __builtin_amdgcn_s_memrealtime() - lp_t0)
#else
#define SCP_T0() ((void)0)
#define SCP_T1() ((void)0)
#endif
        u32x4 rwA[4], rqA[4], rkA[4], raA[2], rwB[4], rqB[4], rkB[4], raB[2], rwC[4], rqC[4], rkC[4], raC[2];
#define SC_GLD(dst, voff, sbase) asm volatile("global_load_dwordx4 %0, %1, %2" : "=v"(dst) : "v"(voff), "s"(sbase) : "memory")
        const unsigned vo_w = (unsigned)((lt >> 4) * (DM * 2) + (lt & 15) * 16), vo_t = (unsigned)lt * 16u;
#define SC_ISSUE(n_, X) do { const bf16* bw_ = Wb + (size_t)((n_) * CH) * DM + h * HD; const bf16* bq_ = QP + (size_t)((n_) * CH) * DM + h * HD; \
            const bf16* bk_ = KT + (size_t)(h * NCH + (n_)) * (HD * CH); const bf16* ba_ = ATT + (size_t)(h * NCH + (n_)) * (CH * CH); \
            _Pragma("unroll") for (int i = 0; i < 4; ++i) { SC_GLD(rw##X[i], vo_w + (unsigned)i * (16u * DM * 2u), bw_); SC_GLD(rq##X[i], vo_w + (unsigned)i * (16u * DM * 2u), bq_); } \
            _Pragma("unroll") for (int i = 0; i < 4; ++i) { SC_GLD(rk##X[i], vo_t + (unsigned)i * 4096u, bk_); } \
            _Pragma("unroll") for (int i = 0; i < 2; ++i) { SC_GLD(ra##X[i], vo_t + (unsigned)i * 4096u, ba_); } } while (0)
#define SC_WAIT(N, X) asm volatile("s_waitcnt vmcnt(" #N ")" : "+v"(rw##X[0]), "+v"(rw##X[1]), "+v"(rw##X[2]), "+v"(rw##X[3]), "+v"(rq##X[0]), "+v"(rq##X[1]), "+v"(rq##X[2]), "+v"(rq##X[3]), \
            "+v"(rk##X[0]), "+v"(rk##X[1]), "+v"(rk##X[2]), "+v"(rk##X[3]), "+v"(ra##X[0]), "+v"(ra##X[1]) :: "memory")
#define SC_PUT(buf_, X) do { LAS unsigned char* b_ = F.lds + (buf_) * SC_BUF; \
            _Pragma("unroll") for (int i = 0; i < 4; ++i) { const int idx = lt + 256 * i, row = idx >> 4, ch = idx & 15; *(LAS u32x4*)(b_ + SC_W + row * SC_RW + 16 * ch) = rw##X[i]; *(LAS u32x4*)(b_ + SC_Q + row * SC_RW + 16 * ch) = rq##X[i]; } \
            _Pragma("unroll") for (int i = 0; i < 4; ++i) { const int idx = lt + 256 * i, row = idx >> 3, ch = idx & 7; *(LAS u32x4*)(b_ + SC_K + row * SC_RK + 16 * ch) = rk##X[i]; } \
            _Pragma("unroll") for (int i = 0; i < 2; ++i) { const int idx = lt + 256 * i, row = idx >> 3, ch = idx & 7; *(LAS u32x4*)(b_ + SC_A + row * SC_RK + 16 * ch) = ra##X[i]; } } while (0)
#define SC_STEP(n_, X) do { SCP_T0(); if ((n_) + 1 < NCH) { if ((n_) + 3 < NCH) SC_WAIT(28, X); else if ((n_) + 2 < NCH) SC_WAIT(14, X); else SC_WAIT(0, X); \
                SC_PUT(((n_) + 1) & 1, X); if ((n_) + 4 < NCH) SC_ISSUE((n_) + 4, X); } \
            asm volatile("s_waitcnt lgkmcnt(0)" ::: "memory"); SCP_T1(); __builtin_amdgcn_s_barrier(); } while (0)
        SC_ISSUE(0, A); SC_WAIT(0, A); SC_PUT(0, A);
        asm volatile("s_waitcnt lgkmcnt(0)" ::: "memory");
        __builtin_amdgcn_s_barrier();
        SC_ISSUE(1, A); SC_ISSUE(2, B); SC_ISSUE(3, C);
        for (int n = 0; n < NCH; n += 3) {
            SC_STEP(n, A);
            if (n + 1 < NCH) SC_STEP(n + 1, B);
            if (n + 2 < NCH) SC_STEP(n + 2, C);
        }
#if defined(SCAN_PROBE) && SCAN_PROBE == 2
        if (blockIdx.x == 0 && F.tid == 256) F.MISC[16] = (unsigned)lp_sum;
#endif
    } else {
        const int r = F.lane & 15, g = F.lane >> 4, e0 = (hf * 4 + F.wave) * 16;
        f32x4_t sacc[8];
#pragma unroll
        for (int i = 0; i < 8; ++i) sacc[i] = (f32x4_t){0.f, 0.f, 0.f, 0.f};
        bf16* utp = UT + (size_t)h * NCH * (HD * CH) + (size_t)(e0 + r) * CH + 4 * g;
        u32x2 un[4];
#pragma unroll
        for (int ct = 0; ct < 4; ++ct) un[ct] = *(const u32x2*)(utp + 16 * ct);
        float egl = EGL[h * NCH];
        __builtin_amdgcn_s_barrier();
#ifdef SCAN_PROBE
        unsigned long long sp_sum = 0ull;
#endif
        for (int n = 0; n < NCH; ++n) {
#ifdef SCAN_PROBE
            const unsigned long long sp_t0 = __builtin_amdgcn_s_memrealtime();
#endif
            const LAS unsigned char* b = F.lds + (n & 1) * SC_BUF; const LAS unsigned char* lw = b + SC_W + r * SC_RW + 16 * g; const LAS unsigned char* lq = b + SC_Q + r * SC_RW + 16 * g;
            const LAS unsigned char* lk = b + SC_K + r * SC_RK + 16 * g; const LAS unsigned char* la = b + SC_A + r * SC_RK + 16 * g;
            f32x4_t vacc[4], oacc[4]; bf16x8 sb[4], fa[16], fb[16];
#pragma unroll
            for (int ct = 0; ct < 4; ++ct)
#pragma unroll
                for (int kk = 0; kk < 4; ++kk) fa[4 * ct + kk] = *(const LAS bf16x8*)(lw + ct * 16 * SC_RW + kk * 64);
#pragma unroll
            for (int ct = 0; ct < 4; ++ct)
#pragma unroll
                for (int kk = 0; kk < 4; ++kk) fb[4 * ct + kk] = *(const LAS bf16x8*)(lq + ct * 16 * SC_RW + kk * 64);
            __builtin_amdgcn_sched_barrier(0);
#pragma unroll
            for (int kk = 0; kk < 4; ++kk) sb[kk] = packb(sacc[2 * kk], sacc[2 * kk + 1]);
#pragma unroll
            for (int ct = 0; ct < 4; ++ct) { vacc[ct] = (f32x4_t){bflo(un[ct].x), bfhi(un[ct].x), bflo(un[ct].y), bfhi(un[ct].y)}; oacc[ct] = (f32x4_t){0.f, 0.f, 0.f, 0.f}; }
            bf16* utc = utp + (size_t)n * (HD * CH);
            u32x2 unn[4]; float egln = 0.f;
            if (n + 1 < NCH) {
#pragma unroll
                for (int ct = 0; ct < 4; ++ct) unn[ct] = *(const u32x2*)(utc + HD * CH + 16 * ct);
                egln = EGL[h * NCH + n + 1]; }
#pragma unroll
            for (int kk = 0; kk < 4; ++kk)
#pragma unroll
                for (int ct = 0; ct < 4; ++ct) vacc[ct] = __builtin_amdgcn_mfma_f32_16x16x32_bf16(fa[4 * ct + kk], sb[kk], vacc[ct], 0, 0, 0);
            __builtin_amdgcn_sched_barrier(0);
#pragma unroll
            for (int mt = 0; mt < 8; ++mt)
#pragma unroll
                for (int k2 = 0; k2 < 2; ++k2) fa[2 * mt + k2] = *(const LAS bf16x8*)(lk + mt * 16 * SC_RK + k2 * 64);
            __builtin_amdgcn_sched_barrier(0);
#pragma unroll
            for (int kk = 0; kk < 4; ++kk)
#pragma unroll
                for (int ct = 0; ct < 4; ++ct) oacc[ct] = __builtin_amdgcn_mfma_f32_16x16x32_bf16(fb[4 * ct + kk], sb[kk], oacc[ct], 0, 0, 0);
            __builtin_amdgcn_sched_barrier(0);
#pragma unroll
            for (int ct = 0; ct < 4; ++ct)
#pragma unroll
                for (int k2 = 0; k2 < 2; ++k2) if (!(k2 == 1 && ct < 2)) fb[2 * ct + k2] = *(const LAS bf16x8*)(la + ct * 16 * SC_RK + k2 * 64);
            __builtin_amdgcn_sched_barrier(0);
            bf16x8 vb[2];
#pragma unroll
            for (int k2 = 0; k2 < 2; ++k2) vb[k2] = packb(vacc[2 * k2], vacc[2 * k2 + 1]);
#pragma unroll
            for (int mt = 0; mt < 8; ++mt) sacc[mt] = sacc[mt] * egl;
#pragma unroll
            for (int k2 = 0; k2 < 2; ++k2)
#pragma unroll
                for (int mt = 0; mt < 8; ++mt) sacc[mt] = __builtin_amdgcn_mfma_f32_16x16x32_bf16(fa[2 * mt + k2], vb[k2], sacc[mt], 0, 0, 0);
#pragma unroll
            for (int k2 = 0; k2 < 2; ++k2)
#pragma unroll
                for (int ct = 0; ct < 4; ++ct) if (!(k2 == 1 && ct < 2)) oacc[ct] = __builtin_amdgcn_mfma_f32_16x16x32_bf16(fb[2 * ct + k2], vb[k2], oacc[ct], 0, 0, 0);
#pragma unroll
            for (int ct = 0; ct < 4; ++ct) { u32x2 w; w.x = cvtpk(oacc[ct][0], oacc[ct][1]); w.y = cvtpk(oacc[ct][2], oacc[ct][3]); *(u32x2*)(utc + 16 * ct) = w; }
#pragma unroll
            for (int ct = 0; ct < 4; ++ct) un[ct] = unn[ct];
            egl = egln;
            asm volatile("s_waitcnt lgkmcnt(0)" ::: "memory");
#if defined(SCAN_PROBE) && SCAN_PROBE == 1
            asm volatile("s_waitcnt vmcnt(0)" ::: "memory"); sp_sum += __builtin_amdgcn_s_memrealtime() - sp_t0;
#endif
            __builtin_amdgcn_s_barrier();
        }
#if defined(SCAN_PROBE) && SCAN_PROBE == 1
        if (blockIdx.x == 0 && F.tid == 0) F.MISC[16] = (unsigned)sp_sum;
#endif
    }
    }
}

constexpr int SEG_G = 8, SEG_N = NCH / SEG_G;
constexpr size_t WS_SST = 241 * MiB;
constexpr size_t WS_MBB = 245 * MiB;
constexpr size_t WS_MBM = 249 * MiB;
static_assert(WS_MBM + (size_t)NH * (SEG_G - 1) * 128 * 128 * 4 <= WS_END, "segment scan buffers");

template <bool FINAL> __device__ __forceinline__ void scan_job(Frame& F, const Args& A, int h, int sg, int sub) {
    const bf16* Wb = WSP(const bf16, SCAN_WNEG); const bf16* QP = SCAN_QP; const bf16* KT = SCAN_KT; const bf16* ATT = WSP(const bf16, SCAN_ATT); bf16* UT = SCAN_UT; const float* EGL = WSP(const float, WS_EGL);
    const int n0 = sg * SEG_N, n1 = n0 + SEG_N;
    constexpr int NLD = FINAL ? 14 : 8;
    if (F.wave >= 4) {
        const int lt = F.tid - 256;
        u32x4 rwA[4], rqA[4], rkA[4], raA[2], rwB[4], rqB[4], rkB[4], raB[2], rwC[4], rqC[4], rkC[4], raC[2];
#define S2_GLD(dst, voff, sbase) asm volatile("global_load_dwordx4 %0, %1, %2" : "=v"(dst) : "v"(voff), "s"(sbase) : "memory")
        const unsigned vo_w = (unsigned)((lt >> 4) * (DM * 2) + (lt & 15) * 16), vo_t = (unsigned)lt * 16u;
#define S2_ISSUE(n_, X) do { const bf16* bw_ = Wb + (size_t)((n_) * CH) * DM + h * HD; const bf16* bk_ = KT + (size_t)(h * NCH + (n_)) * (HD * CH); \
            _Pragma("unroll") for (int i = 0; i < 4; ++i) { S2_GLD(rw##X[i], vo_w + (unsigned)i * (16u * DM * 2u), bw_); } \
            _Pragma("unroll") for (int i = 0; i < 4; ++i) { S2_GLD(rk##X[i], vo_t + (unsigned)i * 4096u, bk_); } \
            if constexpr (FINAL) { const bf16* bq_ = QP + (size_t)((n_) * CH) * DM + h * HD; const bf16* ba_ = ATT + (size_t)(h * NCH + (n_)) * (CH * CH); \
                _Pragma("unroll") for (int i = 0; i < 4; ++i) { S2_GLD(rq##X[i], vo_w + (unsigned)i * (16u * DM * 2u), bq_); } \
                _Pragma("unroll") for (int i = 0; i < 2; ++i) { S2_GLD(ra##X[i], vo_t + (unsigned)i * 4096u, ba_); } } } while (0)
#define S2_TIEF(X) "+v"(rw##X[0]), "+v"(rw##X[1]), "+v"(rw##X[2]), "+v"(rw##X[3]), "+v"(rq##X[0]), "+v"(rq##X[1]), "+v"(rq##X[2]), "+v"(rq##X[3]), "+v"(rk##X[0]), "+v"(rk##X[1]), "+v"(rk##X[2]), "+v"(rk##X[3]), "+v"(ra##X[0]), "+v"(ra##X[1])
#define S2_TIEA(X) "+v"(rw##X[0]), "+v"(rw##X[1]), "+v"(rw##X[2]), "+v"(rw##X[3]), "+v"(rk##X[0]), "+v"(rk##X[1]), "+v"(rk##X[2]), "+v"(rk##X[3])
#define S2_WAIT2(X) do { if constexpr (FINAL) asm volatile("s_waitcnt vmcnt(28)" : S2_TIEF(X) :: "memory"); else asm volatile("s_waitcnt vmcnt(16)" : S2_TIEA(X) :: "memory"); } while (0)
#define S2_WAIT0(X) do { if constexpr (FINAL) asm volatile("s_waitcnt vmcnt(0)" : S2_TIEF(X) :: "memory"); else asm volatile("s_waitcnt vmcnt(0)" : S2_TIEA(X) :: "memory"); } while (0)
#define S2_PUT(buf_, X) do { LAS unsigned char* b_ = F.lds + (buf_) * SC_BUF; \
            _Pragma("unroll") for (int i = 0; i < 4; ++i) { const int idx = lt + 256 * i, row = idx >> 4, ch = idx & 15; *(LAS u32x4*)(b_ + SC_W + row * SC_RW + 16 * ch) = rw##X[i]; \
                if constexpr (FINAL) *(LAS u32x4*)(b_ + SC_Q + row * SC_RW + 16 * ch) = rq##X[i]; } \
            _Pragma("unroll") for (int i = 0; i < 4; ++i) { const int idx = lt + 256 * i, row = idx >> 3, ch = idx & 7; *(LAS u32x4*)(b_ + SC_K + row * SC_RK + 16 * ch) = rk##X[i]; } \
            if constexpr (FINAL) { _Pragma("unroll") for (int i = 0; i < 2; ++i) { const int idx = lt + 256 * i, row = idx >> 3, ch = idx & 7; *(LAS u32x4*)(b_ + SC_A + row * SC_RK + 16 * ch) = ra##X[i]; } } } while (0)
#define S2_STEP(n_, X) do { S2_WAIT2(X); S2_PUT(((n_) + 1 - n0) & 1, X); { const int nn_ = ((n_) + 4 < n1) ? (n_) + 4 : n1 - 1; S2_ISSUE(nn_, X); } \
            asm volatile("s_waitcnt lgkmcnt(0)" ::: "memory"); __builtin_amdgcn_s_barrier(); } while (0)
        static_assert(SEG_N % 3 == 2, "loader tail below is written for SEG_N = 3k + 2");
        S2_ISSUE(n0, A); S2_WAIT0(A); S2_PUT(0, A);
        asm volatile("s_waitcnt lgkmcnt(0)" ::: "memory");
        __builtin_amdgcn_s_barrier();
        S2_ISSUE(n0 + 1, A); S2_ISSUE(n0 + 2, B); S2_ISSUE(n0 + 3, C);
        int n = n0;
        for (; n + 2 < n1; n += 3) { S2_STEP(n, A); S2_STEP(n + 1, B); S2_STEP(n + 2, C); }
        S2_STEP(n, A); S2_STEP(n + 1, B);
        asm volatile("s_waitcnt vmcnt(0)" ::: "memory");
    } else {
        const int r = F.lane & 15, g = F.lane >> 4;
        const int col = FINAL ? (sub * 4 + F.wave) * 16 + r : 64 * sub + 16 * F.wave + r;
        const bool real = FINAL || (col < 128);
        f32x4_t sacc[8];
        if constexpr (FINAL) { const float* sp = WSP(const float, WS_SST) + ((size_t)(h * SEG_G + sg) * 128 + col) * 128 + 4 * g;
#pragma unroll
            for (int mt = 0; mt < 8; ++mt) sacc[mt] = *(const f32x4_t*)(sp + 16 * mt); }
        else {
#pragma unroll
            for (int mt = 0; mt < 8; ++mt)
#pragma unroll
                for (int e = 0; e < 4; ++e) sacc[mt][e] = (!real && (16 * mt + 4 * g + e) == (col - 128)) ? 1.f : 0.f; }
        bf16* utp = UT + (size_t)h * NCH * (HD * CH) + (size_t)((FINAL ? col : (col & 127))) * CH + 4 * g;
        u32x2 un[4];
#pragma unroll
        for (int ct = 0; ct < 4; ++ct) { un[ct] = (u32x2){0u, 0u}; if (real) un[ct] = *(const u32x2*)(utp + (size_t)n0 * (HD * CH) + 16 * ct); }
        float egl = EGL[h * NCH + n0];
        __builtin_amdgcn_s_barrier();
        for (int n = n0; n < n1; ++n) {
            const LAS unsigned char* b = F.lds + ((n - n0) & 1) * SC_BUF; const LAS unsigned char* lw = b + SC_W + r * SC_RW + 16 * g; const LAS unsigned char* lq = b + SC_Q + r * SC_RW + 16 * g;
            const LAS unsigned char* lk = b + SC_K + r * SC_RK + 16 * g; const LAS unsigned char* la = b + SC_A + r * SC_RK + 16 * g;
            f32x4_t vacc[4], oacc[4]; bf16x8 sb[4], fa[16], fb[16];
#pragma unroll
            for (int ct = 0; ct < 4; ++ct)
#pragma unroll
                for (int kk = 0; kk < 4; ++kk) fa[4 * ct + kk] = *(const LAS bf16x8*)(lw + ct * 16 * SC_RW + kk * 64);
            if constexpr (FINAL) {
#pragma unroll
                for (int ct = 0; ct < 4; ++ct)
#pragma unroll
                    for (int kk = 0; kk < 4; ++kk) fb[4 * ct + kk] = *(const LAS bf16x8*)(lq + ct * 16 * SC_RW + kk * 64); }
            __builtin_amdgcn_sched_barrier(0);
#pragma unroll
            for (int kk = 0; kk < 4; ++kk) sb[kk] = packb(sacc[2 * kk], sacc[2 * kk + 1]);
#pragma unroll
            for (int ct = 0; ct < 4; ++ct) { vacc[ct] = (f32x4_t){bflo(un[ct].x), bfhi(un[ct].x), bflo(un[ct].y), bfhi(un[ct].y)}; oacc[ct] = (f32x4_t){0.f, 0.f, 0.f, 0.f}; }
            bf16* utc = utp + (size_t)n * (HD * CH);
            u32x2 unn[4]; float egln = 0.f;
#pragma unroll
            for (int ct = 0; ct < 4; ++ct) unn[ct] = (u32x2){0u, 0u};
            if (n + 1 < n1) { if (real) {
#pragma unroll
                    for (int ct = 0; ct < 4; ++ct) unn[ct] = *(const u32x2*)(utc + HD * CH + 16 * ct); }
                egln = EGL[h * NCH + n + 1]; }
#pragma unroll
            for (int kk = 0; kk < 4; ++kk)
#pragma unroll
                for (int ct = 0; ct < 4; ++ct) vacc[ct] = __builtin_amdgcn_mfma_f32_16x16x32_bf16(fa[4 * ct + kk], sb[kk], vacc[ct], 0, 0, 0);
            __builtin_amdgcn_sched_barrier(0);
#pragma unroll
            for (int mt = 0; mt < 8; ++mt)
#pragma unroll
                for (int k2 = 0; k2 < 2; ++k2) fa[2 * mt + k2] = *(const LAS bf16x8*)(lk + mt * 16 * SC_RK + k2 * 64);
            __builtin_amdgcn_sched_barrier(0);
            if constexpr (FINAL) {
#pragma unroll
                for (int kk = 0; kk < 4; ++kk)
#pragma unroll
                    for (int ct = 0; ct < 4; ++ct) oacc[ct] = __builtin_amdgcn_mfma_f32_16x16x32_bf16(fb[4 * ct + kk], sb[kk], oacc[ct], 0, 0, 0);
                __builtin_amdgcn_sched_barrier(0);
#pragma unroll
                for (int ct = 0; ct < 4; ++ct)
#pragma unroll
                    for (int k2 = 0; k2 < 2; ++k2) if (!(k2 == 1 && ct < 2)) fb[2 * ct + k2] = *(const LAS bf16x8*)(la + ct * 16 * SC_RK + k2 * 64);
                __builtin_amdgcn_sched_barrier(0); }
            bf16x8 vb[2];
#pragma unroll
            for (int k2 = 0; k2 < 2; ++k2) vb[k2] = packb(vacc[2 * k2], vacc[2 * k2 + 1]);
#pragma unroll
            for (int mt = 0; mt < 8; ++mt) sacc[mt] = sacc[mt] * egl;
#pragma unroll
            for (int k2 = 0; k2 < 2; ++k2)
#pragma unroll
                for (int mt = 0; mt < 8; ++mt) sacc[mt] = __builtin_amdgcn_mfma_f32_16x16x32_bf16(fa[2 * mt + k2], vb[k2], sacc[mt], 0, 0, 0);
            if constexpr (FINAL) {
#pragma unroll
                for (int k2 = 0; k2 < 2; ++k2)
#pragma unroll
                    for (int ct = 0; ct < 4; ++ct) if (!(k2 == 1 && ct < 2)) oacc[ct] = __builtin_amdgcn_mfma_f32_16x16x32_bf16(fb[2 * ct + k2], vb[k2], oacc[ct], 0, 0, 0);
#pragma unroll
                for (int ct = 0; ct < 4; ++ct) { u32x2 w; w.x = cvtpk(oacc[ct][0], oacc[ct][1]); w.y = cvtpk(oacc[ct][2], oacc[ct][3]); *(u32x2*)(utc + 16 * ct) = w; } }
#pragma unroll
            for (int ct = 0; ct < 4; ++ct) un[ct] = unn[ct];
            egl = egln;
            asm volatile("s_waitcnt lgkmcnt(0)" ::: "memory");
            __builtin_amdgcn_s_barrier();
        }
        if constexpr (!FINAL) {
            if (real) { float* bp = WSP(float, WS_MBB) + ((size_t)(h * (SEG_G - 1) + sg) * 128 + col) * 128 + 4 * g;
#pragma unroll
                for (int mt = 0; mt < 8; ++mt) *(f32x4_t*)(bp + 16 * mt) = sacc[mt]; }
            else { bf16* mp = WSP(bf16, WS_MBM) + (size_t)(h * (SEG_G - 1) + sg) * (128 * 128) + (col - 128);
#pragma unroll
                for (int mt = 0; mt < 8; ++mt)
#pragma unroll
                    for (int e = 0; e < 4; ++e) mp[(size_t)(16 * mt + 4 * g + e) * 128] = (bf16)f2bf(sacc[mt][e]); } }
    }
}
constexpr int MID_SPLIT = 8;
__device__ __forceinline__ void scan_mid(Frame& F, const Args& A, int h, int cg) {
    LAS float* Sl = (LAS float*)F.lds; LAS unsigned char* Mimg = F.lds + 16 * 132 * 4;
    float* SST = WSP(float, WS_SST) + (size_t)h * SEG_G * (128 * 128);
    const float* MBB = WSP(const float, WS_MBB) + (size_t)h * (SEG_G - 1) * (128 * 128); const bf16* MBM = WSP(const bf16, WS_MBM) + (size_t)h * (SEG_G - 1) * (128 * 128);
    const int r = F.lane & 15, g = F.lane >> 4, et = F.wave, col = 16 * cg + r;
    __syncthreads();
    for (int i = F.tid; i < 16 * 128; i += NWAVES * 64) { Sl[(i >> 7) * 132 + (i & 127)] = 0.f; SST[(size_t)(16 * cg + (i >> 7)) * 128 + (i & 127)] = 0.f; }
    u32x4 mreg[2][4]; f32x4_t accn[2];
#pragma unroll
    for (int p = 0; p < 2; ++p) {
#pragma unroll
        for (int i = 0; i < 4; ++i) mreg[p][i] = *(const u32x4*)(MBM + (size_t)p * (128 * 128) + (size_t)(F.tid + 512 * i) * 8);
        accn[p] = *(const f32x4_t*)(MBB + ((size_t)p * 128 + col) * 128 + 16 * et + 4 * g); }
#pragma unroll
    for (int sg = 0; sg < SEG_G - 1; ++sg) { const int p = sg & 1;
        __syncthreads();
#pragma unroll
        for (int i = 0; i < 4; ++i) { const int idx = F.tid + 512 * i, row = idx >> 4, ch = idx & 15; *(LAS u32x4*)(Mimg + row * 272 + 16 * ch) = mreg[p][i]; }
        if (sg + 2 < SEG_G - 1) {
#pragma unroll
            for (int i = 0; i < 4; ++i) mreg[p][i] = *(const u32x4*)(MBM + (size_t)(sg + 2) * (128 * 128) + (size_t)(F.tid + 512 * i) * 8); }
        f32x4_t acc = accn[p];
        if (sg + 2 < SEG_G - 1) accn[p] = *(const f32x4_t*)(MBB + ((size_t)(sg + 2) * 128 + col) * 128 + 16 * et + 4 * g);
        __syncthreads();
#pragma unroll
        for (int kk = 0; kk < 4; ++kk) {
            const LAS float* sp = Sl + r * 132 + 32 * kk + 8 * g; const f32x4 s0 = *(const LAS f32x4*)sp, s1 = *(const LAS f32x4*)(sp + 4);
            float sf[8] = {s0.x, s0.y, s0.z, s0.w, s1.x, s1.y, s1.z, s1.w}; const bf16x8 bfr = pack8f(sf);
            const bf16x8 afr = *(const LAS bf16x8*)(Mimg + (16 * et + r) * 272 + 64 * kk + 16 * g); acc = __builtin_amdgcn_mfma_f32_16x16x32_bf16(afr, bfr, acc, 0, 0, 0); }
        *(f32x4_t*)(SST + (size_t)(sg + 1) * (128 * 128) + (size_t)col * 128 + 16 * et + 4 * g) = acc;
        __syncthreads();
        *(LAS f32x4_t*)(Sl + r * 132 + 16 * et + 4 * g) = acc;
    }
    __syncthreads();
}
__device__ __forceinline__ void p_dn_scan2_A(Frame& F, const Args& A) { const int b = blockIdx.x; if (b < NH * (SEG_G - 1) * 4) { const int gid = 8 * (b >> 5) + (b & 7), sub = (b >> 3) & 3; scan_job<false>(F, A, gid / (SEG_G - 1), gid % (SEG_G - 1), sub); } }
__device__ __forceinline__ void p_dn_scan2_B(Frame& F, const Args& A) { if (blockIdx.x < NH * MID_SPLIT) scan_mid(F, A, blockIdx.x / MID_SPLIT, blockIdx.x % MID_SPLIT); }
__device__ __forceinline__ void p_dn_scan2_C(Frame& F, const Args& A) { const int b = blockIdx.x; if (b < NH * SEG_G * 2) { const int gid = 8 * (b >> 4) + (b & 7), sub = (b >> 3) & 1; scan_job<true>(F, A, gid / SEG_G, gid % SEG_G, sub); } }
__device__ __forceinline__ void p_dn_out_fast(Frame& F, const Args& A) {
    const bf16* OT = SCAN_UT; const bf16* Z = WSP(const bf16, WS_Z); bf16* YD = WSP(bf16, SCAN_YD); const float* ow = A.in[6];
    LAS unsigned short* tile = (LAS unsigned short*)(F.lds + F.wave * 16640);
    for (int it = F.gw; it < NCH * NH; it += F.NGW) { const int n = it >> 3, h = it & 7, t0 = n * CH;
        const bf16* ot = OT + (size_t)(h * NCH + n) * (HD * CH);
        u32x4 ov[16]; unsigned zall[CH];
#pragma unroll
        for (int i = 0; i < 16; ++i) { const int e = 8 * i + (F.lane >> 3), ch = F.lane & 7; ov[i] = *(const u32x4*)(ot + (size_t)e * CH + 8 * ch); }
#pragma unroll
        for (int c = 0; c < CH; ++c) zall[c] = *(const unsigned*)(Z + (size_t)(t0 + c) * DM + h * HD + 2 * F.lane);
        const float w0 = ow[2 * F.lane], w1 = ow[2 * F.lane + 1];
#pragma unroll
        for (int i = 0; i < 16; ++i) { const int e = 8 * i + (F.lane >> 3), ch = F.lane & 7; const u32x4 v = ov[i]; LAS unsigned short* tp = tile + e * 65 + 8 * ch;
            tp[0] = (unsigned short)v.x; tp[1] = (unsigned short)(v.x >> 16); tp[2] = (unsigned short)v.y; tp[3] = (unsigned short)(v.y >> 16); tp[4] = (unsigned short)v.z; tp[5] = (unsigned short)(v.z >> 16); tp[6] = (unsigned short)v.w; tp[7] = (unsigned short)(v.w >> 16); }
        asm volatile("s_waitcnt lgkmcnt(0)" ::: "memory");
#pragma unroll
        for (int c = 0; c < CH; ++c) { const float o0 = bf2f(tile[(2 * F.lane) * 65 + c]), o1 = bf2f(tile[(2 * F.lane + 1) * 65 + c]);
            const float rs = rsq_(wave_sum(o0 * o0 + o1 * o1) * (1.f / HD) + EPS);
            const size_t off = (size_t)(t0 + c) * DM + h * HD + 2 * F.lane; const unsigned zv = zall[c];
            *(unsigned*)(YD + off) = pk2(o0 * rs * w0 * siluf_(bflo(zv)), o1 * rs * w1 * siluf_(bfhi(zv))); }
        asm volatile("s_waitcnt lgkmcnt(0)" ::: "memory");
    }
}
#ifdef DBG_ATTN
constexpr int CW_DBG = 20000;
__device__ __forceinline__ void dbg_compare(Frame& F, const bf16* a, const bf16* b, size_t n) {
    float* acc = (float*)(WSP(unsigned, WS_CTL) + CW_DBG); float d2 = 0.f, r2 = 0.f;
    for (size_t i = (size_t)F.gw * 64 + F.lane; i < n; i += (size_t)F.NGW * 64) { const float x = bf2f(a[i]), y = bf2f(b[i]); d2 += (x - y) * (x - y); r2 += y * y; }
    d2 = wave_sum(d2); r2 = wave_sum(r2);
    if (F.lane == 0) { atomicAdd(acc, d2); atomicAdd(acc + 1, r2); }
}
#endif

#if defined(DBG_DET) || defined(DBG_L2L)
constexpr int CW_CS = 24000;
__device__ __forceinline__ void dbg_cksum(Frame& F, const void* p, size_t bytes, int slot) {
    const unsigned* w = (const unsigned*)p; unsigned acc = 0u; const size_t nw = bytes / 4;
#ifdef DBG_NANCNT
    for (size_t i = (size_t)F.gw * 64 + F.lane; i < nw; i += (size_t)F.NGW * 64) { const unsigned v = w[i]; acc += ((v & 0x7F80u) >= (141u << 7)) + ((v & 0x7F800000u) >= (141u << 23)); }
#else
    for (size_t i = (size_t)F.gw * 64 + F.lane; i < nw; i += (size_t)F.NGW * 64) { const unsigned v = w[i]; acc += v * 2654435761u + (unsigned)(i * 40503u) * (v >> 7); }
#endif
#pragma unroll
    for (int o = 1; o < 64; o <<= 1) acc += __shfl_xor(acc, o);
    if (F.lane == 0) atomicAdd(WSP(unsigned, WS_CTL) + CW_CS + slot, acc);
}
#endif

#ifdef DBG_SIG
constexpr int CW_SIG = 26000;
__device__ __forceinline__ void dbg_sig(Frame& F, const bf16* p, size_t n, int slot) {
    double acc = 0.0, acc2 = 0.0;
    for (size_t i = (size_t)F.gw * 64 + F.lane; i < n; i += (size_t)F.NGW * 64) { unsigned hsh = (unsigned)i * 2654435761u; hsh ^= hsh >> 15; hsh *= 2246822519u; hsh ^= hsh >> 13;
        const float wgt = (float)(hsh & 0xFFFFu) * (1.f / 32768.f) - 1.f; const float x = bf2f(p[i]); acc += (double)(x * wgt); acc2 += (double)(x * x); }
    long long q1 = (long long)(acc * 65536.0), q2 = (long long)(acc2 * 65536.0);
#pragma unroll
    for (int o = 1; o < 64; o <<= 1) { q1 += __shfl_xor(q1, o); q2 += __shfl_xor(q2, o); }
    if (F.lane == 0) { unsigned long long* a = (unsigned long long*)(WSP(unsigned, WS_CTL) + CW_SIG); atomicAdd(a + 2 * slot, (unsigned long long)q1); atomicAdd(a + 2 * slot + 1, (unsigned long long)q2); }
}
#endif

#ifdef DBG_CHK
constexpr int CW_CHK = 28000;
__device__ __forceinline__ float dbg_g(const float* BA, const Args& A, int t, int h) { const float a = BA[(size_t)t * 16 + 8 + h] + A.in[5][h]; const float sp = (a > 20.f) ? a : log1pf(expf(a)); return -expf(A.in[4][h]) * sp; }
__device__ __forceinline__ void dbg_chk_acc(Frame& F, int k, float err, float ref) {
    long long q1 = (long long)((double)err * (double)err * 1048576.0), q2 = (long long)((double)ref * (double)ref * 1048576.0);
    unsigned long long* a = (unsigned long long*)(WSP(unsigned, WS_CTL) + CW_CHK); atomicAdd(a + 2 * k, (unsigned long long)q1); atomicAdd(a + 2 * k + 1, (unsigned long long)q2);
}
__device__ __forceinline__ void dbg_chunk2_check(Frame& F, const Args& A) {
    const float* BA = WSP(const float, WS_BA); const bf16* KN = WSP(const bf16, WS2_KN); const bf16* QP = WSP(const bf16, WS2_QN); const bf16* Wn = WSP(const bf16, WS2_WNEG);
    const bf16* ATT = WSP(const bf16, WS2_ATT); const bf16* KT = ws2_kt(F); const float* EGL = WSP(const float, WS_EGL);
    const int s = F.gw * 64 + F.lane; if (s >= 8192) return;
    unsigned hsh = (unsigned)s * 2654435761u; hsh ^= hsh >> 15; hsh *= 2246822519u; hsh ^= hsh >> 13;
    const int n = hsh & 255, h = (hsh >> 8) & 7, i = (hsh >> 11) & 63, d = (hsh >> 17) & 127, t0 = n * CH;
    float gci = 0.f, gl = 0.f; { float a = 0.f; for (int j = 0; j < 64; ++j) { a += dbg_g(BA, A, t0 + j, h); if (j == i) gci = a; } gl = a; }
    const float beta_i = 1.f / (1.f + expf(-BA[(size_t)(t0 + i) * 16 + h]));
    const bf16* ki = KN + (size_t)(t0 + i) * DM + h * HD;
    dbg_chk_acc(F, 0, EGL[h * NCH + n] - expf(gl), expf(gl));
    { const float ref = bf2f(ki[d]) * expf(gl - gci); dbg_chk_acc(F, 1, bf2f(KT[(size_t)(h * NCH + n) * (HD * CH) + (size_t)d * CH + i]) - ref, ref); }
    { const float kt = bf2f(KT[(size_t)(h * NCH + n) * (HD * CH) + (size_t)d * CH + i]); dbg_chk_acc(F, 4, kt - bf2f(ki[d]), bf2f(ki[d])); }
    if (n < 128) { const int c = d & 63; const bf16* tg = WSP(const bf16, 241 * MiB) + (size_t)(h * 128 + n) * 4096; float lhs = bf2f(tg[i * 64 + c]); float gcj = 0.f, gcc = 0.f;
      for (int j = 0; j < 64; ++j) { gcj += dbg_g(BA, A, t0 + j, h); if (j == c) gcc = gcj;
          if (j < i) { const bf16* kj = KN + (size_t)(t0 + j) * DM + h * HD; float dot = 0.f; for (int x = 0; x < HD; ++x) dot += bf2f(ki[x]) * bf2f(kj[x]); lhs += beta_i * dot * expf(gci - gcj) * bf2f(tg[j * 64 + c]); } }
      const float beta_c = 1.f / (1.f + expf(-BA[(size_t)(t0 + c) * 16 + h])); const float ref = (i == c) ? beta_c * expf(gcc) : 0.f; dbg_chk_acc(F, 5, lhs - ref, (i == c) ? ref : 0.05f * beta_c * expf(gcc)); }
    if (n < 128) { const bf16* tg = WSP(const bf16, 241 * MiB) + (size_t)(h * 128 + n) * 4096; float ref = 0.f, mag = 0.f;
      for (int j = 0; j < 64; ++j) { const float t = bf2f(tg[i * 64 + j]) * bf2f(KN[(size_t)(t0 + j) * DM + h * HD + d]); ref += t; mag += fabsf(t); }
      dbg_chk_acc(F, 6, -bf2f(Wn[(size_t)(t0 + i) * DM + h * HD + d]) - ref, mag); }
    if (n < 128) { const bf16* tg = WSP(const bf16, 241 * MiB) + (size_t)(h * 128 + n) * 4096; float r7 = 0.f, r8 = 0.f, mag = 0.f, gcj = 0.f;
      for (int j = 0; j < 64; ++j) { gcj += dbg_g(BA, A, t0 + j, h); const float kk = bf2f(KN[(size_t)(t0 + j) * DM + h * HD + d]); const float t = bf2f(tg[i * 64 + j]) * kk;
          r7 += t * expf(gl - gcj); r8 += bf2f(tg[j * 64 + i]) * kk; mag += fabsf(t); }
      const float wv = -bf2f(Wn[(size_t)(t0 + i) * DM + h * HD + d]); dbg_chk_acc(F, 7, wv - r7, mag); dbg_chk_acc(F, 8, wv - r8, mag); }
    if (n < 32) { const bf16* dk = WSP(const bf16, 249 * MiB) + (size_t)(h * 32 + n) * 8192; dbg_chk_acc(F, 9, bf2f(dk[d * 64 + i]) - bf2f(ki[d]), bf2f(ki[d])); }
    if (n < 32) { const float ref = bf2f(ki[d]) * expf(gl - gci); dbg_chk_acc(F, 10, bf2f(KT[(size_t)(h * NCH + n) * (HD * CH) + (size_t)d * CH + i]) - ref, ref); }
    if (n < 128) { const bf16* tg = WSP(const bf16, 241 * MiB) + (size_t)(h * 128 + n) * 4096; float ref = 0.f, mag = 0.f;
      for (int j = 0; j < 64; ++j) { const float t = bf2f(tg[i * 64 + j]) * bf2f(KN[(size_t)(t0 + j) * DM + h * HD + d]); ref += t; mag += fabsf(t); }
      dbg_chk_acc(F, n >= 32 ? 11 : 12, -bf2f(Wn[(size_t)(t0 + i) * DM + h * HD + d]) - ref, mag); }
    { float lhs = -bf2f(Wn[(size_t)(t0 + i) * DM + h * HD + d]); float gcj = 0.f;
      for (int j = 0; j < i; ++j) { gcj += dbg_g(BA, A, t0 + j, h); const bf16* kj = KN + (size_t)(t0 + j) * DM + h * HD; float dot = 0.f; for (int x = 0; x < HD; ++x) dot += bf2f(ki[x]) * bf2f(kj[x]);
          lhs += beta_i * dot * expf(gci - gcj) * (-bf2f(Wn[(size_t)(t0 + j) * DM + h * HD + d])); }
      const float ref = beta_i * expf(gci) * bf2f(ki[d]); dbg_chk_acc(F, 2, lhs - ref, ref); }
    { const int j = d & 63; if (j <= i && gci > -20.f) { float gcj = 0.f; for (int x = 0; x <= j; ++x) gcj += dbg_g(BA, A, t0 + x, h);
          const bf16* kj = KN + (size_t)(t0 + j) * DM + h * HD; const bf16* qi = QP + (size_t)(t0 + i) * DM + h * HD; float dot = 0.f; for (int x = 0; x < HD; ++x) dot += bf2f(qi[x]) * bf2f(kj[x]);
          const float ref = dot * expf(-gcj); dbg_chk_acc(F, 3, bf2f(ATT[(size_t)(h * NCH + n) * (CH * CH) + (size_t)i * CH + j]) - ref, ref); }
      else if (j > i) dbg_chk_acc(F, 3, bf2f(ATT[(size_t)(h * NCH + n) * (CH * CH) + (size_t)i * CH + j]), 0.f); }
}
#endif

#ifdef DBG_TILE
constexpr int CW_TILE = 30000;
__device__ __forceinline__ void dbg_tile_check(Frame& F, const Args& A) {
    if (F.gw >= NCH * NH) return;
    const int n = F.gw >> 3, h = F.gw & 7, t0 = n * CH, lane = F.lane;
    const float* BA = WSP(const float, WS_BA); const bf16* KN = WSP(const bf16, WS2_KN); const bf16* KT = ws2_kt(F) + (size_t)(h * NCH + n) * (HD * CH);
    float gc = 0.f, gl = 0.f; { float a = 0.f; for (int j = 0; j < 64; ++j) { a += dbg_g(BA, A, t0 + j, h); if (j == lane) gc = a; } gl = a; }
    const float f = expf(gl - gc); int bad = 0;
    for (int d = 0; d < HD; ++d) { const float ref = bf2f(KN[(size_t)(t0 + lane) * DM + h * HD + d]) * f; const float got = bf2f(KT[(size_t)d * CH + lane]); if (!(fabsf(got - ref) <= 0.02f * fabsf(ref) + 1e-3f)) ++bad; }
    bad = (int)wave_sum((float)bad);
    if (lane == 0 && bad > 0) { unsigned* w = WSP(unsigned, WS_CTL) + CW_TILE; atomicAdd(w, 1u); atomicMin(w + 1, (unsigned)n); atomicOr(w + 2 + n, 1u << h); atomicAdd(w + 300, (unsigned)bad); atomicOr(w + 301, 1u << h); if (bad > 4096) atomicOr(w + 302, 1u << h); }
}
#endif
template <int R> __device__ __forceinline__ void post_rows(Frame& F, const Args& A, int m0, int stride) {
    const float* x = A.in[0]; const bf16* T = WSP(const bf16, WS_T); bf16* H2 = WSP(bf16, WS_H2);
    const f32x4* w1 = (const f32x4*)A.in[10] + F.lane; const f32x4* w2 = (const f32x4*)A.in[11] + F.lane;
    unsigned long long t8[R][4]; f32x4 xv[R][4];
#pragma unroll
    for (int k = 0; k < R; ++k) { const int m = m0 + k * stride; const unsigned long long* tr = (const unsigned long long*)(T + (size_t)m * DM) + F.lane; const f32x4* xr = (const f32x4*)(x + (size_t)m * DM) + F.lane;
#pragma unroll
        for (int j = 0; j < 4; ++j) { t8[k][j] = tr[64 * j]; xv[k][j] = xr[64 * j]; } }
#pragma unroll
    for (int k = 0; k < R; ++k) { const int m = m0 + k * stride; unsigned long long* x1row = (unsigned long long*)(WSP(bf16, WS_X1B) + (size_t)m * DM) + F.lane;
        f32x4 tv[4]; float ss = 0.f;
#pragma unroll
        for (int j = 0; j < 4; ++j) { const unsigned long long w8 = t8[k][j]; const unsigned lo = (unsigned)w8, hi = (unsigned)(w8 >> 32); tv[j] = (f32x4){bflo(lo), bfhi(lo), bflo(hi), bfhi(hi)}; ss += (tv[j].x * tv[j].x + tv[j].y * tv[j].y) + (tv[j].z * tv[j].z + tv[j].w * tv[j].w); }
        const float rs = rsq_(wave_sum(ss) * (1.f / DM) + EPS); float s2 = 0.f;
#pragma unroll
        for (int j = 0; j < 4; ++j) { tv[j] = xv[k][j] + tv[j] * rs * w1[64 * j]; x1row[64 * j] = (unsigned long long)pk2(tv[j].x, tv[j].y) | ((unsigned long long)pk2(tv[j].z, tv[j].w) << 32);
            s2 += (tv[j].x * tv[j].x + tv[j].y * tv[j].y) + (tv[j].z * tv[j].z + tv[j].w * tv[j].w); }
        const float r2 = rsq_(wave_sum(s2) * (1.f / DM) + EPS);
        unsigned long long* o8 = (unsigned long long*)(H2 + (size_t)m * DM) + F.lane;
#pragma unroll
        for (int j = 0; j < 4; ++j) { const f32x4 hv = tv[j] * r2 * w2[64 * j]; o8[64 * j] = (unsigned long long)pk2(hv.x, hv.y) | ((unsigned long long)pk2(hv.z, hv.w) << 32); } }
}
__device__ __forceinline__ void p_post_mix(Frame& F, const Args& A) {
    int m = F.gw;
    for (; m + F.NGW < S; m += 2 * F.NGW) post_rows<2>(F, A, m, F.NGW);
    if (m < S) post_rows<1>(F, A, m, F.NGW);
}
#if !defined(DBG_NAN) && !defined(DBG_DET) && !defined(DBG_ATTN)
template <int R> __device__ __forceinline__ void final_rows(Frame& F, const Args& A, int m0, int stride) {
    const bf16* Fd = WSP(const bf16, WS_F); const f32x4* w = (const f32x4*)A.in[15] + F.lane;
    unsigned long long f8[R][4], x8[R][4];
#pragma unroll
    for (int k = 0; k < R; ++k) { const int m = m0 + k * stride; const unsigned long long* fr = (const unsigned long long*)(Fd + (size_t)m * DM) + F.lane; const unsigned long long* xr = (const unsigned long long*)(WSP(const bf16, WS_X1B) + (size_t)m * DM) + F.lane;
#pragma unroll
        for (int j = 0; j < 4; ++j) { f8[k][j] = fr[64 * j]; x8[k][j] = xr[64 * j]; } }
#pragma unroll
    for (int k = 0; k < R; ++k) { const int m = m0 + k * stride; f32x4* orow = (f32x4*)(F.out + (size_t)m * DM) + F.lane;
        f32x4 fv[4]; float ss = 0.f;
#pragma unroll
        for (int j = 0; j < 4; ++j) { const unsigned long long w8 = f8[k][j]; const unsigned lo = (unsigned)w8, hi = (unsigned)(w8 >> 32); fv[j] = (f32x4){bflo(lo), bfhi(lo), bflo(hi), bfhi(hi)}; ss += (fv[j].x * fv[j].x + fv[j].y * fv[j].y) + (fv[j].z * fv[j].z + fv[j].w * fv[j].w); }
        const float rs = rsq_(wave_sum(ss) * (1.f / DM) + EPS);
#pragma unroll
        for (int j = 0; j < 4; ++j) { const unsigned lo = (unsigned)x8[k][j], hi = (unsigned)(x8[k][j] >> 32); const f32x4 xv = {bflo(lo), bfhi(lo), bflo(hi), bfhi(hi)}; orow[64 * j] = xv + fv[j] * rs * w[64 * j]; } }
}
__device__ __forceinline__ void p_final(Frame& F, const Args& A) {
    int m = F.gw;
    for (; m + F.NGW < S; m += 2 * F.NGW) final_rows<2>(F, A, m, F.NGW);
    if (m < S) final_rows<1>(F, A, m, F.NGW);
}
#else
__device__ __forceinline__ void p_final(Frame& F, const Args& A) {
    const bf16* Fd = WSP(const bf16, WS_F);
    for (int m = F.gw; m < S; m += F.NGW) {
        const unsigned long long* fr = (const unsigned long long*)(Fd + (size_t)m * DM) + F.lane; f32x4* orow = (f32x4*)(F.out + (size_t)m * DM) + F.lane; const f32x4* w = (const f32x4*)A.in[15] + F.lane;
        f32x4 fv[4]; float ss = 0.f;
#pragma unroll
        for (int j = 0; j < 4; ++j) { const unsigned long long w8 = fr[64 * j]; const unsigned lo = (unsigned)w8, hi = (unsigned)(w8 >> 32); fv[j] = (f32x4){bflo(lo), bfhi(lo), bflo(hi), bfhi(hi)}; ss += (fv[j].x * fv[j].x + fv[j].y * fv[j].y) + (fv[j].z * fv[j].z + fv[j].w * fv[j].w); }
        const float rs = rsq_(wave_sum(ss) * (1.f / DM) + EPS);
#pragma unroll
        for (int j = 0; j < 4; ++j) { f32x4 ov = orow[64 * j] + fv[j] * rs * w[64 * j];
#ifdef DBG_NAN
#pragma unroll
            for (int e = 0; e < 4; ++e) if (!(fabsf(ov[e]) < 1e30f)) ov[e] = 12345.f;
#endif
            orow[64 * j] = ov; }
#ifdef DBG_DET
        { const unsigned* cs = WSP(const unsigned, WS_CTL) + CW_CS; float pz = 0.f;
          for (int k = 12; k >= 0; --k) if (cs[k] != cs[16 + k]) pz = __builtin_ldexpf(1.f, 40 - 2 * k);
#pragma unroll
          for (int j = 0; j < 4; ++j) orow[64 * j] = orow[64 * j] + pz; }
#endif
#ifdef DBG_ATTN
        { const float* acc = (const float*)(WSP(unsigned, WS_CTL) + CW_DBG); const float rv = acc[0] / acc[1]; const float pz = !(rv < DBG_TOL) ? 1000.f : 0.f;
#pragma unroll
          for (int j = 0; j < 4; ++j) orow[64 * j] = orow[64 * j] + pz; }
#endif
    }
}

#endif
constexpr int NPHASE = 18;
#ifndef MK_N_LAUNCHES
#define MK_N_LAUNCHES 1
#endif
constexpr int N_LAUNCHES = MK_N_LAUNCHES;
__global__ void __launch_bounds__(NWAVES * 64, 2) fwd(Args args) {
    extern __shared__ __attribute__((aligned(16))) unsigned char lds[];
    Frame F;
    F.lds = (LAS unsigned char*)lds; F.MISC = (volatile LAS unsigned*)(F.lds + MISC_OFF);
    F.tid = threadIdx.x; F.lane = F.tid & 63; F.wave = __builtin_amdgcn_readfirstlane(F.tid >> 6);
    F.G = gridDim.x; F.gw = blockIdx.x * NWAVES + F.wave; F.NGW = F.G * NWAVES;
    F.out = args.out; F.ws = args.ws;
    for (int u = F.tid; u < (LDS_BYTES - LDSCTL_OFF) / 4; u += NWAVES * 64) ((LAS unsigned*)(F.lds + LDSCTL_OFF))[u] = 0u;
    __syncthreads();
    XcdBarrier bar; bar.bar = (unsigned*)(F.ws + WS_CTL) + CW_BAR; bar.x = 0; bar.st = nullptr;
    if (N_LAUNCHES == 1) bar = xcd_barrier_post((unsigned*)(F.ws + WS_CTL) + CW_BAR, F.MISC + 8);
#define GRID_BAR() do { if (N_LAUNCHES == 1) xcd_barrier(bar); } while (0)
    const int lo = args.ph_lo, hi = args.ph_hi;
#ifdef PROBE_LO
    unsigned long long pr_t0 = 0ull, pr_dt = 0ull;
#define PROBE_AT(k) do { if (blockIdx.x == 0 && F.tid == 0) { if ((k) == PROBE_LO) pr_t0 = __builtin_amdgcn_s_memrealtime(); if ((k) == PROBE_HI + 1) pr_dt = __builtin_amdgcn_s_memrealtime() - pr_t0; } } while (0)
#else
#define PROBE_AT(k) do {} while (0)
#endif
#ifdef DBG_L2L
#define CK(k, p, n) dbg_cksum(F, (p), (n), (k))
#define CKB() GRID_BAR()
#else
#define CK(k, p, n) do {} while (0)
#define CKB() do {} while (0)
#endif
#if defined(ONLY_PH)
#define PH_EN(k) ((k) == ONLY_PH)
#elif defined(PH_MASK)
#define PH_EN(k) (((PH_MASK) >> (k)) & 1)
#else
#define PH_EN(k) true
#endif
#define IN(k) (PH_EN(k) && lo <= (k) && (k) < hi)
#define BOTH(k) (IN(k) && IN((k) + 1))
#define GEMM(EPI, Aoff, Boff, N_, K_, ...) do { pg8::Gemm g{(const pg8::bf16_t*)(F.ws + (Aoff)), (const pg8::bf16_t*)(F.ws + (Boff)), S, (N_), (K_)}; pg8::StaticOrder So; So.init(S, (N_), F.G, (int)blockIdx.x); \
        EPI E{__VA_ARGS__}; pg8::gemm_phase<EPI, pg8::StaticOrder, true, true>(F.lds + RING_OFF, g, So, E); } while (0)

    PROBE_AT(0);
    if (IN(0)) { p_prologue(F, args); if (BOTH(0)) GRID_BAR(); }
    CK(0, F.ws + WS_H, T32); CK(0, F.ws + WS_BA, 1 * MiB); CK(0, F.ws + WS_WTA, 41 * MiB - 512 * 1024); CKB();
    PROBE_AT(1);
    if (IN(1)) { GEMM(pg8::EpiRope, WS_H, WS_WTA, 3072, DM, WSP(pg8::bf16_t, WS_R1), WSP(const float, WS_COS), WSP(const float, WS_SIN), WSP(float, WS_KMEAN)); if (BOTH(1)) GRID_BAR(); }
    CK(1, F.ws + WS_R1, 3 * T32); CKB();
    PROBE_AT(2);
#ifndef TOPK2
#define TOPK2 1
#endif
#if !TOPK2
    if (IN(2)) { p_kmean(F, args); if (BOTH(2)) GRID_BAR(); }
#endif
    CK(2, F.ws + WS_KMEAN, 256 * 1024); CKB();
#ifndef ATTN_FAST
#define ATTN_FAST 1
#endif
#if ATTN_FAST
    PROBE_AT(3);
#if TOPK2
    if (IN(3)) { p_topk2(F, args); if (BOTH(3)) GRID_BAR();
#ifdef BAR_PROBE
        for (int i_ = 0; i_ < 8; ++i_) GRID_BAR();
#endif
    }
#else
    if (IN(3)) { p_topk_bucket(F, args); if (BOTH(3)) GRID_BAR(); }
#endif
    CK(3, F.ws + WS_TOPI, (size_t)S * NH * 12); CKB();
    PROBE_AT(4);
#ifdef WGSTAT
#define WGSTAT_RUN(k, call) do { const unsigned long long t0_ = __builtin_amdgcn_s_memrealtime(); call; if (WGSTAT_PH == (k)) { __syncthreads(); if (F.tid == 0) { const unsigned dt_ = (unsigned)(__builtin_amdgcn_s_memrealtime() - t0_); \
        unsigned* w_ = WSP(unsigned, WS_CTL) + 30000; atomicMax(w_, dt_); atomicAdd(w_ + 1, dt_); atomicMin(w_ + 2, 0xFFFFFFFFu - dt_); } } } while (0)
#else
#define WGSTAT_RUN(k, call) call
#endif
    if (IN(4)) { PROBE_AT(40); WGSTAT_RUN(40, p_attn_sel(F, args)); GRID_BAR(); PROBE_AT(41); WGSTAT_RUN(41, p_attn_own(F, args)); PROBE_AT(42);
#ifdef DBG_ATTN
        GRID_BAR(); p_attn_naive(F, args); GRID_BAR(); dbg_compare(F, WSP(const bf16, WS_YA), (const bf16*)F.out, (size_t)S * DM);
#endif
        if (BOTH(4)) GRID_BAR(); }
    CK(4, F.ws + WS_YA, T32); CKB();
#else
    PROBE_AT(3);
    if (IN(3)) { p_topk(F, args); if (BOTH(3)) GRID_BAR(); }
    PROBE_AT(4);
    if (IN(4)) { p_attn_naive(F, args); if (BOTH(4)) GRID_BAR(); }
#endif
#ifdef DBG_CHK
    {   GEMM(pg8::EpiGen<0>, WS_H, WS_WTB, 4096, DM, WSP(pg8::bf16_t, WS_R1), DM, 1024, (size_t)S * DM, nullptr); GRID_BAR();
        { ConvHalo hl; p_dn_conv2_halo(F, hl); GRID_BAR(); p_dn_conv2(F, args, hl); GRID_BAR(); }
        p_dn_chunk2(F, args); GRID_BAR();
        dbg_chunk2_check(F, args); GRID_BAR();
#ifdef DBG_TILE
        if (blockIdx.x == 0 && F.tid == 0) WSP(unsigned, WS_CTL)[CW_TILE + 1] = 0xFFFFu; GRID_BAR(); dbg_tile_check(F, args); GRID_BAR();
#endif
        }
#elif defined(DBG_SIG)
    {
      { Frame Fp = F; asm volatile("" : "+s"(Fp.ws), "+s"(Fp.out), "+v"(Fp.lane), "+v"(Fp.tid));
        GEMM(pg8::EpiGen<0>, WS_H, WS_WTB, 4096, DM, WSP(pg8::bf16_t, WS_R1), DM, 1024, (size_t)S * DM, nullptr); GRID_BAR();
        p_dn_conv(Fp, args); GRID_BAR(); p_dn_chunk(Fp, args); GRID_BAR(); p_dn_relayout1(Fp, args); GRID_BAR(); p_dn_relayout2(Fp, args); GRID_BAR();
        dbg_sig(Fp, (const bf16*)Fp.out, (size_t)S * DM, 0); dbg_sig(Fp, WSPF(const bf16, WS_W), (size_t)S * DM, 1); dbg_sig(Fp, WSPF(const bf16, WS_KT), (size_t)S * DM, 2);
        dbg_sig(Fp, WSPF(const bf16, WS_UT), (size_t)S * DM, 3); dbg_sig(Fp, WSPF(const bf16, WS_ATT), (size_t)S * DM / 2, 4); GRID_BAR();
      }
      { Frame Fp = F; asm volatile("" : "+s"(Fp.ws), "+s"(Fp.out), "+v"(Fp.lane), "+v"(Fp.tid));
        p_hrecompute(Fp, args); GRID_BAR();
        GEMM(pg8::EpiGen<0>, WS_H, WS_WTB, 4096, DM, WSP(pg8::bf16_t, WS_R1), DM, 1024, (size_t)S * DM, nullptr); GRID_BAR();
        { ConvHalo hl; p_dn_conv2_halo(Fp, hl); GRID_BAR(); p_dn_conv2(Fp, args, hl); GRID_BAR(); }
        p_dn_chunk2(Fp, args); GRID_BAR();
        dbg_sig(Fp, WSPF(const bf16, WS2_QN), (size_t)S * DM, 8); dbg_sig(Fp, WSPF(const bf16, WS2_WNEG), (size_t)S * DM, 9); dbg_sig(Fp, ws2_kt(Fp), (size_t)S * DM, 10);
        dbg_sig(Fp, ws2_ut(Fp), (size_t)S * DM, 11); dbg_sig(Fp, WSPF(const bf16, WS2_ATT), (size_t)S * DM / 2, 12); GRID_BAR();
      }
    }
#elif defined(DBG_DET)
#define DET_PASS(P) { Frame Fp = F; asm volatile("" : "+s"(Fp.ws), "+s"(Fp.out), "+v"(Fp.lane), "+v"(Fp.tid)); \
    p_hrecompute(Fp, args); GRID_BAR(); \
    GEMM(pg8::EpiGen<0>, WS_H, WS_WTB, 4096, DM, WSP(pg8::bf16_t, WS_R1), DM, 1024, (size_t)S * DM, nullptr); GRID_BAR(); \
    dbg_cksum(Fp, Fp.ws + WS_R1, 4 * T32, (P) * 16 + 0); GRID_BAR(); \
    { ConvHalo hl; p_dn_conv2_halo(Fp, hl); GRID_BAR(); p_dn_conv2(Fp, args, hl); GRID_BAR(); } \
    dbg_cksum(Fp, Fp.ws + WS2_QN, T32, (P) * 16 + 1); dbg_cksum(Fp, Fp.ws + WS2_KN, T32, (P) * 16 + 2); dbg_cksum(Fp, ws2_kt(Fp), T32, (P) * 16 + 3); dbg_cksum(Fp, ws2_ut(Fp), T32, (P) * 16 + 4); GRID_BAR(); \
    p_dn_chunk2(Fp, args); GRID_BAR(); \
    dbg_cksum(Fp, Fp.ws + WS2_ATT, T32 / 2, (P) * 16 + 5); dbg_cksum(Fp, Fp.ws + WS2_QN, T32, (P) * 16 + 6); dbg_cksum(Fp, ws2_ut(Fp), T32, (P) * 16 + 7); dbg_cksum(Fp, Fp.ws + WS2_WNEG, T32, (P) * 16 + 8); \
    dbg_cksum(Fp, ws2_kt(Fp), T32, (P) * 16 + 9);  GRID_BAR(); \
    p_dn_scan_fast(Fp, args); GRID_BAR(); \
    dbg_cksum(Fp, ws2_ut(Fp), T32, (P) * 16 + 11); GRID_BAR(); \
    p_dn_out_fast(Fp, args); GRID_BAR(); \
    dbg_cksum(Fp, Fp.ws + WS2_YD, T32, (P) * 16 + 12); GRID_BAR(); }
    { DET_PASS(0) }
    { DET_PASS(1) }
    p_hrecompute(F, args); GRID_BAR();
#else
    PROBE_AT(5);
    if (IN(5)) { GEMM(pg8::EpiGen<5>, WS_H, WS_WTB, 4096, DM, WSP(pg8::bf16_t, WS_R1), DM, 1024, (size_t)S * DM, WSP(const pg8::bf16_t, WS_HALO)); if (BOTH(5)) GRID_BAR(); }
    CK(5, F.ws + WS_R1, 4 * T32); CKB();
#if DN2
    PROBE_AT(6);
    if (IN(6)) { ConvHalo hl; p_dn_conv2_halo(F, hl); if (N_LAUNCHES != 1) GRID_BAR(); p_dn_conv2(F, args, hl); if (BOTH(6)) GRID_BAR(); }
    CK(6, F.ws + WS2_QN, 2 * T32); CK(6, F.out, 2 * T32); CKB();
    PROBE_AT(7);
    if (IN(7)) { p_dn_chunk2(F, args); if (BOTH(7)) GRID_BAR(); }
    CK(7, F.ws + WS2_ATT, T32 / 2); CK(7, F.ws + WS2_QN, T32); CK(7, F.out, 2 * T32); CK(7, F.ws + WS2_WNEG, T32); CK(7, F.ws + WS_EGL, 8192); CKB();
#else
    PROBE_AT(6);
    if (IN(6)) { p_dn_conv(F, args); if (BOTH(6)) GRID_BAR(); }
    PROBE_AT(7);
    if (IN(7)) { p_dn_chunk(F, args); if (BOTH(7)) GRID_BAR(); }
#endif
#ifndef DN_FAST
#define DN_FAST 1
#endif
#if DN_FAST
#if DN2
    PROBE_AT(8);
#ifndef SCAN2
#define SCAN2 1
#endif
#if SCAN2
    if (IN(8)) { PROBE_AT(80); p_dn_scan2_A(F, args); GRID_BAR(); PROBE_AT(81); p_dn_scan2_B(F, args); GRID_BAR(); PROBE_AT(82); if (blockIdx.x < 128) p_dn_scan2_C(F, args); else { p_hrecompute_sub(F, args, WSP(bf16, WS2_HALT), ((int)blockIdx.x - 128) * NWAVES + F.wave, 128 * NWAVES);
#if DN2_LATE_WT
            p_wtrans(F, args, WT_ITEMS_EARLY, WT_ITEMS_ALL, ((int)blockIdx.x - 128) * NWAVES + F.wave, 128 * NWAVES);
#endif
        } if (BOTH(8)) GRID_BAR(); PROBE_AT(83); }
#else
    if (IN(8)) { p_dn_scan_fast(F, args); if (BOTH(8)) GRID_BAR(); }
#endif
    CK(8, ws2_ut(F), T32); CKB();
#else
    PROBE_AT(8);
    if (IN(8)) { p_dn_relayout1(F, args); GRID_BAR(); p_dn_relayout2(F, args); GRID_BAR(); p_dn_scan_fast(F, args); if (BOTH(8)) GRID_BAR(); }
#endif
    PROBE_AT(9);
#if DN2 && SCAN2
    if (IN(9)) { p_dn_out_fast(F, args); if (BOTH(9)) GRID_BAR(); }
#else
    if (IN(9)) { p_dn_out_fast(F, args); p_hrecompute(F, args); if (BOTH(9)) GRID_BAR(); }
#endif
    CK(9, F.ws + WS2_YD, T32); CK(9, F.ws + WS_H, T32); CKB();
#else
    PROBE_AT(8);
    if (IN(8)) { p_dn_scan_naive(F, args); if (BOTH(8)) GRID_BAR(); }
    PROBE_AT(9);
    if (IN(9)) { p_dn_out(F, args); p_hrecompute(F, args); if (BOTH(9)) GRID_BAR(); }
#endif
#endif
    PROBE_AT(10);
    if (IN(10)) { pg8::Gemm g{(const pg8::bf16_t*)(F.ws + WS2_HALT), (const pg8::bf16_t*)(F.ws + WS_WTG), S, 2048, DM}; pg8::PairOrder Po; Po.init(S, DM, 2, F.G, (int)blockIdx.x);
        pg8::EpiGen<1> E{(pg8::bf16_t*)F.out, DM, 1024, (size_t)S * DM, nullptr}; pg8::gemm_phase<pg8::EpiGen<1>, pg8::PairOrder, true, true>(F.lds + RING_OFF, g, Po, E); if (BOTH(10) && N_LAUNCHES != 1) GRID_BAR(); }
    CK(10, F.out, 2 * T32); CKB();
    PROBE_AT(11);
    if (IN(11)) { GEMM(pg8::EpiGen<2>, WS_YA, WS_WTOA, 1024, DM, (pg8::bf16_t*)F.out, DM, 0, 0, nullptr); if (BOTH(11) && N_LAUNCHES != 1) GRID_BAR(); }
    CK(11, F.out, T32); CKB();
    PROBE_AT(12);
    if (IN(12)) { GEMM(pg8::EpiGen<3>, SCAN_YD, WS_WTOD, 1024, DM, (pg8::bf16_t*)F.out, DM, 0, 0, (const pg8::bf16_t*)F.out + (size_t)S * DM); if (BOTH(12)) GRID_BAR(); }
    CK(12, F.out, T32); CKB();
    PROBE_AT(13);
    if (IN(13)) { pg8::Gemm g{(const pg8::bf16_t*)F.out, WSP(const pg8::bf16_t, WS_WTOUT), S, DM, DM}; pg8::StaticOrder So; So.init(S, DM, F.G, (int)blockIdx.x);
        pg8::EpiGen<0> E{WSP(pg8::bf16_t, WS_T), DM, 0, 0, nullptr}; pg8::gemm_phase<pg8::EpiGen<0>, pg8::StaticOrder, true, true>(F.lds + RING_OFF, g, So, E); if (BOTH(13)) GRID_BAR(); }
    CK(13, F.ws + WS_T, 2 * T32); CKB();
    PROBE_AT(14);
    if (IN(14)) { p_post_mix(F, args); if (BOTH(14)) GRID_BAR(); }
    CK(14, F.out, 2 * T32); CK(14, F.ws + WS_H2, T32); CKB();
    PROBE_AT(15);
    if (IN(15)) { GEMM(pg8::EpiGen<4>, WS_H2, WS_WTGU, 2 * DFF, DM, WSP(pg8::bf16_t, WS_ACT), DFF, 0, 0, nullptr); if (BOTH(15)) GRID_BAR(); }
    CK(15, F.ws + WS_ACT, ACT_BYTES); CKB();
    PROBE_AT(16);
    if (IN(16)) { pg8::Gemm g{WSP(const pg8::bf16_t, WS_ACT), WSP(const pg8::bf16_t, WS_WTDN), S, DM, DFF}; pg8::StaticOrder So; So.init(S, DM, F.G, (int)blockIdx.x);
        pg8::EpiGen<0> E{WSP(pg8::bf16_t, WS_F), DM, 0, 0, nullptr}; pg8::gemm_phase<pg8::EpiGen<0>, pg8::StaticOrder, true, true>(F.lds + RING_OFF, g, So, E); if (BOTH(16)) GRID_BAR(); }
    CK(16, F.ws + WS_F, 2 * T32); CKB();
#ifdef DBG_TILE
    PROBE_AT(17);
    if (IN(17)) { const unsigned* w = WSP(const unsigned, WS_CTL) + CW_TILE; const unsigned cnt = w[0], mn = w[1]; const unsigned hm = (mn < 256u) ? w[2 + mn] : 0u;
        const int sel = DBG_TILE; const unsigned val = (sel == 1) ? (cnt > 120u ? 120u : cnt) : (sel == 2) ? (mn > 255u ? 127u : (mn >> 1)) : (sel == 3 ? (mn & 1u) * 8u + 0u + (hm & 0xFu) * 0u + (hm & 0xFFu) / 4u : (hm & 3u));
        float pz = __builtin_ldexpf(1.f, (int)val + 4); if (sel == 6) pz = __builtin_ldexpf(1.f, (int)(w[301] & 15u) + 4); if (sel == 7) pz = __builtin_ldexpf(1.f, (int)(w[301] >> 4) + 4); if (sel == 8) pz = __builtin_ldexpf(1.f, (int)(w[302] & 15u) + 4); if (sel == 9) pz = __builtin_ldexpf(1.f, (int)(w[302] >> 4) + 4);
        if (sel == 5) { unsigned be = w[300], lg = 0; while (be > 1u) { be >>= 1; ++lg; } pz = __builtin_ldexpf(1.f, (int)lg + 4); }
        for (size_t i = (size_t)F.gw * 64 + F.lane; i < (size_t)S * DM; i += (size_t)F.NGW * 64) F.out[i] = args.in[0][i] + pz; }
#elif defined(DBG_CHK)
    PROBE_AT(17);
    if (IN(17)) { const long long* sg = (const long long*)(WSP(unsigned, WS_CTL) + CW_CHK); float pz = 0.f;
        for (int k = 12; k >= 9; --k) { const double e2 = (double)sg[2 * k], r2 = (double)sg[2 * k + 1]; if (!(e2 <= 1e-3 * r2 + 16.0)) pz += 1024.f * (float)(1 << (2 * (k - 9))); }
        for (size_t i = (size_t)F.gw * 64 + F.lane; i < (size_t)S * DM; i += (size_t)F.NGW * 64) F.out[i] = args.in[0][i] + pz; }
#elif defined(DBG_SIG)
    PROBE_AT(17);
    if (IN(17)) { const long long* sg = (const long long*)(WSP(unsigned, WS_CTL) + CW_SIG); float pz = 0.f;
        for (int k = 4; k >= 0; --k) { const float a0 = (float)((double)sg[2 * k] / 65536.0), a1 = (float)((double)sg[2 * (8 + k)] / 65536.0), n0 = (float)((double)sg[2 * k + 1] / 65536.0), n1 = (float)((double)sg[2 * (8 + k) + 1] / 65536.0);
            const bool bad = !(fabsf(a0 - a1) <= 0.02f * sqrtf(n0) + 1e-3f) || !(fabsf(n0 - n1) <= 0.02f * (n0 + n1)); if (bad) pz = __builtin_ldexpf(1.f, 40 - 2 * k); }
        for (size_t i = (size_t)F.gw * 64 + F.lane; i < (size_t)S * DM; i += (size_t)F.NGW * 64) F.out[i] = args.in[0][i] + pz; }
#elif defined(DBG_DET)
    PROBE_AT(17);
    if (IN(17)) { const unsigned* cs = WSP(const unsigned, WS_CTL) + CW_CS; float pz = 0.f;
#ifdef DBG_NANCNT
        for (int k = 12; k >= 0; --k) if (cs[k] != 0u) pz = __builtin_ldexpf(1.f, 40 - 2 * k);
#else
        for (int k = 12; k >= 0; --k) if (cs[k] != cs[16 + k]) pz = __builtin_ldexpf(1.f, 40 - 2 * k);
#endif
        for (size_t i = (size_t)F.gw * 64 + F.lane; i < (size_t)S * DM; i += (size_t)F.NGW * 64) F.out[i] = args.in[0][i] + pz; }
#else
    PROBE_AT(17);
    if (IN(17)) { p_final(F, args); }
#endif
#ifdef WGSTAT
    if (blockIdx.x == 0 && F.tid == 0) { const unsigned* w_ = WSP(const unsigned, WS_CTL) + 30000; const unsigned v0 = __hip_atomic_load(w_, __ATOMIC_RELAXED, __HIP_MEMORY_SCOPE_AGENT), v1 = __hip_atomic_load(w_ + 1, __ATOMIC_RELAXED, __HIP_MEMORY_SCOPE_AGENT), v2 = __hip_atomic_load(w_ + 2, __ATOMIC_RELAXED, __HIP_MEMORY_SCOPE_AGENT);
        const unsigned long long dd = 8ull * (unsigned long long)(WGSTAT == 1 ? v0 : (WGSTAT == 2 ? v1 / (unsigned)F.G : 0xFFFFFFFFu - v2));
        const unsigned long long ts = __builtin_amdgcn_s_memrealtime(); while (__builtin_amdgcn_s_memrealtime() - ts < dd) __builtin_amdgcn_s_sleep(8); }
#endif
#ifdef SCAN_PROBE
    __syncthreads();
    if (blockIdx.x == 0 && F.tid == 0) { const unsigned long long ts = __builtin_amdgcn_s_memrealtime(); const unsigned long long dd = 8ull * (unsigned long long)F.MISC[16]; while (__builtin_amdgcn_s_memrealtime() - ts < dd) __builtin_amdgcn_s_sleep(8); }
#endif
#ifdef PROBE_LO
    PROBE_AT(18);
    if (blockIdx.x == 0 && F.tid == 0) { const unsigned long long ts = __builtin_amdgcn_s_memrealtime(); while (__builtin_amdgcn_s_memrealtime() - ts < 8ull * pr_dt) __builtin_amdgcn_s_sleep(8); }
#endif
#ifdef DBG_L2L
    GRID_BAR(); CK(17, F.out, 2 * T32); GRID_BAR();
    { unsigned* cs = WSP(unsigned, WS_CTL) + CW_CS; unsigned* save = WSP(unsigned, 253 * MiB);
      if (args.pass == 0) { if (blockIdx.x == 0 && F.tid < 32) save[F.tid] = cs[F.tid]; }
      else { float pz = 0.f; for (int k = 17; k >= 0; --k) if (cs[k] != save[k]) pz = __builtin_ldexpf(1.f, 44 - 2 * k);
          if (pz != 0.f) for (size_t i = (size_t)F.gw * 64 + F.lane; i < (size_t)S * DM; i += (size_t)F.NGW * 64) F.out[i] += pz; } }
#endif
#undef IN
#undef BOTH
}

extern "C" void kernel_launch(void* const* d_in, const int* in_sizes, int n_in, void* d_out, int out_size, void* d_ws, size_t ws_size, hipStream_t stream) {
    static int grid = 0;
    if (grid == 0) {
        if (n_in != 16 || in_sizes[0] != S * DM || out_size != S * DM || ws_size < WS_END) { fprintf(stderr, "kernel_launch: unexpected shapes (n_in %d, in0 %d, out %d, ws %zu); nothing launched\n", n_in, n_in > 0 ? in_sizes[0] : -1, out_size, ws_size); grid = -1; return; }
        int dev = 0, cus = 0, per_cu = 0;
        if (hipGetDevice(&dev) != hipSuccess || hipDeviceGetAttribute(&cus, hipDeviceAttributeMultiprocessorCount, dev) != hipSuccess) { grid = -1; return; }
        if (hipFuncSetAttribute((const void*)fwd, hipFuncAttributeMaxDynamicSharedMemorySize, LDS_BYTES) != hipSuccess) { fprintf(stderr, "kernel_launch: hipFuncSetAttribute failed\n"); grid = -1; return; }
        if (hipOccupancyMaxActiveBlocksPerMultiprocessor(&per_cu, (const void*)fwd, NWAVES * 64, LDS_BYTES) != hipSuccess || per_cu < 1) fprintf(stderr, "kernel_launch: occupancy query says %d\n", per_cu);
        (void)hipGetLastError();
        grid = cus;
    }
    if (grid < 0) return;
    if (hipMemsetAsync((char*)d_ws + WS_CTL, 0, CTL_ZERO_BYTES, stream) != hipSuccess) return;
    Args a{};
    for (int i = 0; i < 16; ++i) a.in[i] = (const float*)d_in[i];
    a.out = (float*)d_out; a.ws = (unsigned char*)d_ws;
#ifdef DBG_L2L
    hipMemsetAsync((char*)d_ws + CTL_ZERO_BYTES, 0xA5, WS_END - CTL_ZERO_BYTES, stream); hipMemsetAsync(d_out, 0xA5, (size_t)S * DM * 4, stream);
    for (int li = 0; li < 2; ++li) {
        if (li == 1) hipMemsetAsync((char*)d_ws + WS_CTL, 0, CTL_ZERO_BYTES, stream);
        a.ph_lo = 0; a.ph_hi = NPHASE; a.pass = li;
#else
    for (int li = 0; li < N_LAUNCHES; ++li) {
        a.ph_lo = (N_LAUNCHES == 1) ? 0 : li; a.ph_hi = (N_LAUNCHES == 1) ? NPHASE : li + 1;
#endif
        hipLaunchKernelGGL(fwd, dim3(grid), dim3(NWAVES * 64), LDS_BYTES, stream, a);
        if (hipPeekAtLastError() != hipSuccess) { fprintf(stderr, "kernel_launch: launch %d failed\n", li); break; }
    }
}
```

```cpp
#include <hip/hip_runtime.h>
#include <cstdio>
#include <cstdint>
#include <cmath>
namespace pg8 {
#define PG8_LAS __attribute__((address_space(3)))
typedef unsigned short bf16_t;
typedef short bf16x8 __attribute__((ext_vector_type(8)));
typedef float f32x4 __attribute__((ext_vector_type(4)));
typedef unsigned u32x4 __attribute__((ext_vector_type(4)));
constexpr int BM = 256, BK = 64, HALF = 128, HTB = HALF * BK * 2  , STAGE_BYTES = 8 * HTB, NXCD = 8, WGM = 8;

__host__ __device__ __forceinline__ int lds_byte(int r, int c) { const int st = (r >> 4) * 2 + (c >> 5), rr = r & 15, cc = c & 31, ob = rr * 64 + cc * 2; return st * 1024 + (ob ^ (((ob >> 9) & 1) << 5)); }
__host__ __device__ __forceinline__ void stage_rc(int b, int& R, int& C) { const int st = b / 1024, sb = b % 1024, swz = sb ^ (((sb >> 9) & 1) << 5); R = (st >> 1) * 16 + swz / 64; C = (st & 1) * 32 + (swz % 64) / 2; }
__host__ __device__ __forceinline__ int perm32(int rho) { const int n = rho >> 4, i = rho & 15; return 8 * (i >> 2) + 4 * n + (i & 3); }

struct Unit { int pm, pn; };
struct Gemm { const bf16_t* A; const bf16_t* Bt; int M, N, K; };

struct StaticOrder {
    int nM, nN, nwg, G, c;
    __host__ __device__ void init(int M, int N, int G_, int c_) { nM = M / BM; nN = N / BM; nwg = nM * nN; G = G_; c = c_; }
    __host__ __device__ bool next(int i, Unit& u) const {
        const long L = (long)i * G + c; if (L >= nwg) return false;
        int wgid = (int)L; { const int q = nwg / NXCD, r = nwg % NXCD, xcd = wgid % NXCD, off = wgid / NXCD; wgid = (xcd < r ? xcd * (q + 1) : r * (q + 1) + (xcd - r) * q) + off; }
        const int nig = WGM * nN, gid = wgid / nig, fm = gid * WGM, gsz = (nM - fm) < WGM ? (nM - fm) : WGM;
        u.pm = fm + ((wgid % nig) % gsz); u.pn = (wgid % nig) / gsz; return true;
    }
    __device__ __forceinline__ void a_ready(const Unit&) const {}
    __device__ __forceinline__ void done(const Unit&) const {}
};

__device__ __forceinline__ unsigned cvt_pk_bf16(float lo, float hi) { typedef __bf16 b2 __attribute__((ext_vector_type(2))); typedef float f2 __attribute__((ext_vector_type(2))); const f2 v = {lo, hi}; return __builtin_bit_cast(unsigned, __builtin_convertvector(v, b2)); }
template <class Epi, class Sched, bool ALIGN_EPI = false, bool SP2 = false>
__device__ __forceinline__ void gemm_phase(PG8_LAS unsigned char* lds, const Gemm g, const Sched& S, const Epi& E) {
    const int tid = threadIdx.x, wid = __builtin_amdgcn_readfirstlane(tid >> 6), lane = tid & 63, wr = wid >> 2, wc = wid & 3, fr = lane & 15, fq = lane >> 4;
    const int K = g.K, nt = K / BK;
    unsigned voffA[2], voffB[2];
#pragma unroll
    for (int i = 0; i < 2; ++i) { int R, C; stage_rc(tid * 16 + i * 8192, R, C); const int Rb = Epi::PERM ? ((R & ~31) + perm32(R & 31)) : R;
        voffA[i] = (unsigned)(R * K + C) * 2u; voffB[i] = (unsigned)(Rb * K + C) * 2u; }
    const size_t kstep = (size_t)(BK * 2);
    const size_t hstep = (size_t)HALF * K * 2;
    const size_t tstep = 2 * hstep;
    const unsigned ldsw = (unsigned)wid * 1024u;
    const int aoff = lds_byte(wr * 64 + fr, fq * 8), boff = lds_byte(wc * 32 + fr, fq * 8);
#define PG8_SA(b, h) (((b) * 2 + (h)) * HTB)
#define PG8_SB(b, h) ((4 + (b) * 2 + (h)) * HTB)
#define PG8_STAGE(bufoff, gbase, voff) do { _Pragma("unroll") for (int _i = 0; _i < 2; ++_i) \
        __builtin_amdgcn_global_load_lds((const unsigned*)((const char*)(gbase) + (voff)[_i]), (PG8_LAS unsigned*)(lds + (bufoff) + ldsw + _i * 8192), 16, 0, 0); } while (0)
#define PG8_LDA(dst, b, h) do { _Pragma("unroll") for (int m = 0; m < 4; ++m) _Pragma("unroll") for (int k = 0; k < 2; ++k) dst[m][k] = *(const PG8_LAS bf16x8*)(lds + PG8_SA(b, h) + aoff + m * 2048 + k * 1024); } while (0)
#define PG8_LDB(dst, b, h) do { _Pragma("unroll") for (int n = 0; n < 2; ++n) _Pragma("unroll") for (int k = 0; k < 2; ++k) dst[n][k] = *(const PG8_LAS bf16x8*)(lds + PG8_SB(b, h) + boff + n * 2048 + k * 1024); } while (0)
#define PG8_MMA(ai, bj, At, Bt) do { __builtin_amdgcn_s_setprio(1); _Pragma("unroll") for (int m = 0; m < 4; ++m) _Pragma("unroll") for (int n = 0; n < 2; ++n) _Pragma("unroll") for (int k = 0; k < 2; ++k) \
        acc[ai][bj][m][n] = __builtin_amdgcn_mfma_f32_16x16x32_bf16(Bt[n][k], At[m][k], acc[ai][bj][m][n], 0, 0, 0); __builtin_amdgcn_s_setprio(0); } while (0)
#define PG8_WAIT_V(n) asm volatile("s_waitcnt vmcnt(" #n ")" ::: "memory")
#define PG8_WAIT_L(n) asm volatile("s_waitcnt lgkmcnt(" #n ")" ::: "memory")
#define PG8_BAR __builtin_amdgcn_s_barrier()
#define PG8_SCHED __builtin_amdgcn_sched_barrier(0)
    Unit cur, nxt; int ui = 0;
    if (!S.next(0, cur)) return;
    f32x4 acc[2][2][4][2];
#pragma unroll
    for (int a = 0; a < 2; ++a)
#pragma unroll
        for (int b = 0; b < 2; ++b)
#pragma unroll
            for (int m = 0; m < 4; ++m)
#pragma unroll
                for (int n = 0; n < 2; ++n) acc[a][b][m][n] = (f32x4){0.f, 0.f, 0.f, 0.f};
    bf16x8 At[4][2], B0[2][2], B1[2][2];
    const char* cA = (const char*)g.A + (size_t)cur.pm * tstep; const char* cB = (const char*)g.Bt + (size_t)cur.pn * tstep;
    S.a_ready(cur);
    if constexpr (SP2) {
        PG8_STAGE(PG8_SB(0, 0), cB, voffB); PG8_STAGE(PG8_SB(0, 1), cB + hstep, voffB); PG8_STAGE(PG8_SA(0, 0), cA, voffA); PG8_STAGE(PG8_SA(0, 1), cA + hstep, voffA);
        if (wr == 1) PG8_BAR;
        PG8_WAIT_V(2); PG8_BAR;
        PG8_STAGE(PG8_SB(1, 0), cB + kstep, voffB); PG8_STAGE(PG8_SA(1, 0), cA + kstep, voffA); PG8_STAGE(PG8_SB(1, 1), cB + hstep + kstep, voffB);
        PG8_WAIT_V(6); PG8_BAR;
    } else {
        PG8_STAGE(PG8_SB(0, 0), cB, voffB); PG8_STAGE(PG8_SA(0, 0), cA, voffA); PG8_STAGE(PG8_SB(0, 1), cB + hstep, voffB); PG8_STAGE(PG8_SA(0, 1), cA + hstep, voffA);
        if (wr == 1) PG8_BAR;
        PG8_WAIT_V(4); PG8_BAR;
        PG8_STAGE(PG8_SB(1, 0), cB + kstep, voffB); PG8_STAGE(PG8_SA(1, 0), cA + kstep, voffA); PG8_STAGE(PG8_SB(1, 1), cB + hstep + kstep, voffB);
        PG8_WAIT_V(6); PG8_BAR;
    }
    for (;;) {
        const bool has_next = S.next(ui + 1, nxt);
        const char* nA = has_next ? (const char*)g.A + (size_t)nxt.pm * tstep : cA; const char* nB = has_next ? (const char*)g.Bt + (size_t)nxt.pn * tstep : cB;
        for (int t = 0; t < nt; t += 2) {
            const bool last = (t == nt - 2);
            const char* a1 = cA + (size_t)(t + 1) * kstep;
            const char* a2 = last ? nA : cA + (size_t)(t + 2) * kstep; const char* b2 = last ? nB : cB + (size_t)(t + 2) * kstep;
            const char* a3 = a2 + kstep; const char* b3 = b2 + kstep;
            if (last && has_next) S.a_ready(nxt);
            if constexpr (SP2) {
            PG8_LDB(B0, 0, 0); PG8_LDB(B1, 0, 1); PG8_SCHED; PG8_LDA(At, 0, 0); PG8_STAGE(PG8_SA(1, 1), a1 + hstep, voffA);
            PG8_WAIT_V(8); PG8_WAIT_L(0); PG8_BAR; PG8_MMA(0, 0, At, B0); PG8_MMA(0, 1, At, B1); PG8_BAR; PG8_SCHED;
            PG8_LDA(At, 0, 1); PG8_STAGE(PG8_SB(0, 0), b2, voffB); PG8_STAGE(PG8_SB(0, 1), b2 + hstep, voffB); PG8_STAGE(PG8_SA(0, 0), a2, voffA);
            PG8_WAIT_V(8); PG8_WAIT_L(0); PG8_BAR; PG8_MMA(1, 0, At, B0); PG8_MMA(1, 1, At, B1); PG8_BAR; PG8_SCHED;
            PG8_LDB(B0, 1, 0); PG8_LDB(B1, 1, 1); PG8_SCHED; PG8_LDA(At, 1, 0); PG8_STAGE(PG8_SA(0, 1), a2 + hstep, voffA);
            PG8_WAIT_V(8); PG8_WAIT_L(0); PG8_BAR; PG8_MMA(0, 0, At, B0); PG8_MMA(0, 1, At, B1); PG8_BAR; PG8_SCHED;
            PG8_LDA(At, 1, 1); PG8_STAGE(PG8_SB(1, 0), b3, voffB); PG8_STAGE(PG8_SB(1, 1), b3 + hstep, voffB); PG8_STAGE(PG8_SA(1, 0), a3, voffA);
            PG8_WAIT_V(8); PG8_WAIT_L(0); PG8_BAR; PG8_MMA(1, 0, At, B0); PG8_MMA(1, 1, At, B1); PG8_BAR; PG8_SCHED;
            } else {
            PG8_LDB(B0, 0, 0); PG8_SCHED; PG8_LDA(At, 0, 0); PG8_STAGE(PG8_SA(1, 1), a1 + hstep, voffA);
            PG8_WAIT_L(8); PG8_BAR; PG8_WAIT_L(0); PG8_MMA(0, 0, At, B0); PG8_BAR; PG8_SCHED;
            PG8_LDB(B1, 0, 1); PG8_STAGE(PG8_SB(0, 0), b2, voffB);
            PG8_BAR; PG8_WAIT_L(0); PG8_MMA(0, 1, At, B1); PG8_BAR;
            PG8_LDA(At, 0, 1); PG8_STAGE(PG8_SA(0, 0), a2, voffA);
            PG8_BAR; PG8_WAIT_L(0); PG8_MMA(1, 0, At, B0); PG8_BAR; PG8_SCHED;
            PG8_STAGE(PG8_SB(0, 1), b2 + hstep, voffB);
            PG8_WAIT_V(6); PG8_BAR; PG8_MMA(1, 1, At, B1); PG8_BAR;
            PG8_LDB(B0, 1, 0); PG8_SCHED; PG8_LDA(At, 1, 0); PG8_STAGE(PG8_SA(0, 1), a2 + hstep, voffA);
            PG8_WAIT_L(8); PG8_BAR; PG8_WAIT_L(0); PG8_MMA(0, 0, At, B0); PG8_BAR; PG8_SCHED;
            PG8_LDB(B1, 1, 1); PG8_STAGE(PG8_SB(1, 0), b3, voffB);
            PG8_BAR; PG8_WAIT_L(0); PG8_MMA(0, 1, At, B1); PG8_BAR;
            PG8_LDA(At, 1, 1); PG8_STAGE(PG8_SA(1, 0), a3, voffA);
            PG8_BAR; PG8_WAIT_L(0); PG8_MMA(1, 0, At, B0); PG8_BAR; PG8_SCHED;
            PG8_STAGE(PG8_SB(1, 1), b3 + hstep, voffB);
            PG8_WAIT_V(6); PG8_BAR; PG8_MMA(1, 1, At, B1); PG8_BAR;
            }
        }
        if constexpr (ALIGN_EPI) { if (wr == 0) PG8_BAR; }
        if constexpr (!Epi::AFTER_DRAIN) { E(acc, cur, wr, wc, fr, fq); S.done(cur); }
        if (!has_next) break;
#pragma unroll
        for (int a = 0; a < 2; ++a)
#pragma unroll
            for (int b = 0; b < 2; ++b)
#pragma unroll
                for (int m = 0; m < 4; ++m)
#pragma unroll
                    for (int n = 0; n < 2; ++n) acc[a][b][m][n] = (f32x4){0.f, 0.f, 0.f, 0.f};
        cur = nxt; cA = nA; cB = nB; ++ui;
        if constexpr (ALIGN_EPI) { if (wr == 1) PG8_BAR; }
    }
    PG8_WAIT_V(0);
    if constexpr (!ALIGN_EPI) { if (wr == 0) PG8_BAR; }
    PG8_BAR;
    if constexpr (Epi::AFTER_DRAIN) { E.fused(acc, cur, wr, wc, fr, fq, lds, wid, lane); S.done(cur); }
#undef PG8_SA
#undef PG8_SB
#undef PG8_STAGE
#undef PG8_LDA
#undef PG8_LDB
#undef PG8_MMA
#undef PG8_WAIT_V
#undef PG8_WAIT_L
#undef PG8_BAR
#undef PG8_SCHED
}
}
#define GAS __attribute__((address_space(1)))
#define LAS __attribute__((address_space(3)))
typedef unsigned short bf16;
typedef unsigned v4u __attribute__((ext_vector_type(4)));
typedef float f32x4 __attribute__((ext_vector_type(4)));
typedef short bf16x8 __attribute__((ext_vector_type(8)));
typedef GAS unsigned gu32;
typedef GAS unsigned long long gu64;
#define RLX_AGENT __ATOMIC_RELAXED, __HIP_MEMORY_SCOPE_AGENT
#define LDS_WAIT() asm volatile("s_waitcnt lgkmcnt(0)" ::: "memory")
#define VM_WAIT() asm volatile("s_waitcnt vmcnt(0)" ::: "memory")
__device__ __forceinline__ unsigned long long rt() { return __builtin_amdgcn_s_memrealtime(); }
typedef __bf16 hbf2_t __attribute__((ext_vector_type(2)));
typedef float hf2_t __attribute__((ext_vector_type(2)));
__device__ __forceinline__ unsigned pk2(float lo, float hi) { const hf2_t v = {lo, hi}; return __builtin_bit_cast(unsigned, __builtin_convertvector(v, hbf2_t)); }
__device__ __forceinline__ unsigned f2bf(float f) { return pk2(f, 0.f) & 0xffffu; }

#define XB_TMO      128
#define XB_XCNT(j)  (256  + 64 * (j))
#define XB_XSUB(j)  (1280 + 64 * (j))
#define XB_XGEN(j)  (2304 + 64 * (j))
#define XB_TOP      3328
#define XB_TOPGEN   3392
#define XCD_BAR_WORDS 3456
#define XB_SPIN_CAP (1u << 22)

__device__ __forceinline__ unsigned xb_ld(unsigned* p)              { return __hip_atomic_load(p, __ATOMIC_RELAXED, __HIP_MEMORY_SCOPE_AGENT); }
__device__ __forceinline__ unsigned xb_add(unsigned* p, unsigned v) { return __hip_atomic_fetch_add(p, v, __ATOMIC_RELAXED, __HIP_MEMORY_SCOPE_AGENT); }
__device__ __forceinline__ unsigned xb_xcc_id() { return (unsigned)__builtin_amdgcn_s_getreg((3 << 11) | 20) & 0xFu; }
#define XB_SPIN(cond, bar) do { unsigned _sp = 0; while (cond) { __builtin_amdgcn_s_sleep(1); \
    if ((++_sp & 255u) == 0u) { if (xb_ld(&(bar)[XB_TMO])) break; if (_sp > XB_SPIN_CAP) { atomicAdd(&(bar)[XB_TMO], 1u); break; } } } } while (0)

struct XcdBarrier {
    unsigned* bar; unsigned x;
    volatile LAS unsigned* st;
};

__device__ __forceinline__ XcdBarrier xcd_barrier_post(unsigned* bar, volatile LAS unsigned* st) {
    XcdBarrier b; b.bar = bar; b.x = xb_xcc_id(); b.st = st;
    if (threadIdx.x == 0) (void)xb_add(&bar[XB_XCNT(b.x)], 1u);
    return b;
}
__device__ __forceinline__ void xcd_barrier_complete(unsigned* bar, unsigned x, unsigned& nloc, unsigned& nx) {
    const unsigned G = gridDim.x * gridDim.y * gridDim.z;
    unsigned sum, cnt, mine, sp = 0u;
    for (;;) {
        sum = 0u; cnt = 0u; mine = 0u;
#pragma unroll
        for (unsigned j = 0; j < 16; ++j) { const unsigned c = xb_ld(&bar[XB_XCNT(j)]); sum += c; cnt += (c > 0u) ? 1u : 0u; mine = (j == x) ? c : mine; }
        if (sum == G) break;
        __builtin_amdgcn_s_sleep(1);
        if ((++sp & 255u) == 0u) { if (xb_ld(&bar[XB_TMO])) break; if (sp > XB_SPIN_CAP) { atomicAdd(&bar[XB_TMO], 1u); break; } }
    }
    nloc = mine > 0u ? mine : 1u; nx = cnt > 0u ? cnt : 1u;
}

__device__ __forceinline__ void xcd_barrier(const XcdBarrier& b) {
    asm volatile("s_waitcnt vmcnt(0)" ::: "memory");
    __syncthreads();
    if (threadIdx.x == 0) {
        unsigned* bar = b.bar;
        __builtin_amdgcn_s_waitcnt(0);
        unsigned nloc = b.st[0], nx = b.st[1];
        if (nloc == 0u) { xcd_barrier_complete(bar, b.x, nloc, nx); b.st[0] = nloc; b.st[1] = nx; }
        const unsigned old = xb_add(&bar[XB_XSUB(b.x)], 1u);
        const unsigned gen = old / nloc;
        if (old + 1u == (gen + 1u) * nloc) {
            __builtin_amdgcn_fence(__ATOMIC_RELEASE, "agent");
            asm volatile("s_waitcnt vmcnt(0)" ::: "memory");
            const unsigned og = xb_add(&bar[XB_TOP], 1u);
            const unsigned tg = og / nx;
            if (og + 1u == (tg + 1u) * nx) xb_add(&bar[XB_TOPGEN], 1u);
            else XB_SPIN(xb_ld(&bar[XB_TOPGEN]) == tg, bar);
            __builtin_amdgcn_fence(__ATOMIC_ACQUIRE, "agent");
            xb_add(&bar[XB_XGEN(b.x)], 1u);
            asm volatile("s_waitcnt vmcnt(0)" ::: "memory");
        } else {
            XB_SPIN(xb_ld(&bar[XB_XGEN(b.x)]) == gen, bar);
            __builtin_amdgcn_fence(__ATOMIC_ACQUIRE, "agent");
            asm volatile("s_waitcnt vmcnt(0)" ::: "memory");
        }
    }
    __syncthreads();
}

constexpr int S = 16384, DM = 1024, NH = 8, HD = 128, MBLK = 256, NBLK = S / MBLK, DFF = 2816, INTOT = 9232;
constexpr int CH = 64, NCH = S / CH;
constexpr float EPS = 1e-6f;
constexpr int NWAVES = 8;
#ifndef DN2_LATE_WT
#define DN2_LATE_WT 1
#endif

constexpr size_t MiB = 1u << 20;
constexpr size_t WS_CTL = 0, CTL_ZERO_BYTES = 1 * MiB;
constexpr size_t WS_COS = 1 * MiB, WS_SIN = 2 * MiB;
constexpr size_t WS_BA = 3 * MiB;
constexpr size_t WS_KMEAN = 4 * MiB;
constexpr size_t WS_TOPI = 5 * MiB;
constexpr size_t WS_BETA = 6 * MiB + 512 * 1024, WS_G = 7 * MiB, WS_GC = 7 * MiB + 512 * 1024;
constexpr size_t WS_WTA = 8 * MiB, WS_WTB = 14 * MiB, WS_WTG = 22 * MiB, WS_WTOA = 26 * MiB, WS_WTOD = 28 * MiB, WS_WTOUT = 30 * MiB, WS_WTGU = 32 * MiB, WS_WTDN = 43 * MiB;
constexpr size_t WS_H = 49 * MiB;
constexpr size_t WS_R1 = 81 * MiB;
constexpr size_t WS_Z = 177 * MiB, WS_YA = 209 * MiB, WS_END = 256 * MiB;
constexpr size_t ACT_BYTES = (size_t)S * DFF * 2;
constexpr size_t T32 = (size_t)S * DM * 2;
static_assert(WS_WTDN + (size_t)DM * DFF * 2 <= WS_H && WS_YA + T32 <= WS_END && WS_R1 + 3 * T32 == WS_Z, "ws map");
constexpr size_t WS_VN = WS_H;
constexpr size_t WS_W = WS_R1, WS_ATT = WS_R1 + T32, WS_O = WS_R1 + T32 + 16 * MiB, WS_YD = WS_R1;
constexpr size_t WS_T = 113 * MiB, WS_H2 = WS_H, WS_ACT = 81 * MiB, WS_F = 169 * MiB, WS_X1B = 209 * MiB;
static_assert(WS_ACT + ACT_BYTES <= WS_F && WS_F + 2 * T32 <= WS_END && WS_O + T32 <= WS_Z && WS_T + 2 * T32 <= WS_Z, "overlay map");
constexpr int CW_BAR = 4096;

constexpr int RING_OFF = 0, RING_BYTES = 131072;
constexpr int LDS_BYTES = 163840;
constexpr int LDSCTL_OFF = LDS_BYTES - 4096, MISC_OFF = LDSCTL_OFF + 320;

typedef unsigned u32x4 __attribute__((ext_vector_type(4)));
typedef unsigned u32x2 __attribute__((ext_vector_type(2)));

__device__ __forceinline__ float bflo(unsigned u) { return __builtin_bit_cast(float, u << 16); }
__device__ __forceinline__ float bfhi(unsigned u) { return __builtin_bit_cast(float, u & 0xffff0000u); }
__device__ __forceinline__ float bf2f(bf16 b) { return __builtin_bit_cast(float, ((unsigned)b) << 16); }
__device__ __forceinline__ float wave_sum(float v) {
#define WS_DPP(ctrl) v += __builtin_bit_cast(float, __builtin_amdgcn_update_dpp(0, __builtin_bit_cast(int, v), (ctrl), 0xF, 0xF, true))
    WS_DPP(0xB1); WS_DPP(0x4E); WS_DPP(0x141); WS_DPP(0x140);
#undef WS_DPP
    const float s0 = __builtin_bit_cast(float, __builtin_amdgcn_readlane(__builtin_bit_cast(int, v), 0)), s1 = __builtin_bit_cast(float, __builtin_amdgcn_readlane(__builtin_bit_cast(int, v), 16));
    const float s2 = __builtin_bit_cast(float, __builtin_amdgcn_readlane(__builtin_bit_cast(int, v), 32)), s3 = __builtin_bit_cast(float, __builtin_amdgcn_readlane(__builtin_bit_cast(int, v), 48));
    return (s0 + s1) + (s2 + s3);
}
__device__ __forceinline__ float wave_max(float v) {
#pragma unroll
    for (int o = 1; o < 64; o <<= 1) v = fmaxf(v, __shfl_xor(v, o));
    return v;
}
__device__ __forceinline__ float rcp_(float x) { return __builtin_amdgcn_rcpf(x); }
__device__ __forceinline__ float rsq_(float x) { return __builtin_amdgcn_rsqf(x); }
__device__ __forceinline__ float sigmoidf_(float x) { return rcp_(1.f + __expf(-x)); }
__device__ __forceinline__ float siluf_(float x) { return x * rcp_(1.f + __expf(-x)); }
__device__ __forceinline__ float sigmoidf_e(float x) { return sigmoidf_(x); }
__device__ __forceinline__ float siluf_e(float x) { return siluf_(x); }

namespace pg8 {
struct EpiRope {
    static constexpr bool PERM = false, AFTER_DRAIN = false;
    bf16_t* base; const float* cosT; const float* sinT; float* kpart;
    __device__ __forceinline__ void operator()(const f32x4 (&acc)[2][2][4][2], const Unit& u, int wr, int wc, int fr, int fq) const {
        const int t = u.pn >> 2, pnl = u.pn & 3;
        bf16_t* ob = base + (size_t)t * ((size_t)S * DM);
        const bool rope = (t < 2) && (wc == 0);
        f32x4 cs[2][2];
#pragma unroll
        for (int bj = 0; bj < 2; ++bj)
#pragma unroll
            for (int n = 0; n < 2; ++n) cs[bj][n] = (f32x4){0.f, 0.f, 0.f, 0.f};
#pragma unroll
        for (int ai = 0; ai < 2; ++ai)
#pragma unroll
            for (int m = 0; m < 4; ++m) {
                const int row = u.pm * BM + ai * HALF + wr * 64 + m * 16 + fr;
                f32x4 cv = (f32x4){1.f, 1.f, 1.f, 1.f}, sv = (f32x4){0.f, 0.f, 0.f, 0.f};
                if (rope) { cv = *(const f32x4*)(cosT + (size_t)row * 16 + 4 * fq); sv = *(const f32x4*)(sinT + (size_t)row * 16 + 4 * fq); }
#pragma unroll
                for (int bj = 0; bj < 2; ++bj) {
                    f32x4 v0 = acc[ai][bj][m][0], v1 = acc[ai][bj][m][1];
                    if (rope) { const f32x4 n0 = v0 * cv - v1 * sv, n1 = v1 * cv + v0 * sv; v0 = n0; v1 = n1; }
                    cs[bj][0] = cs[bj][0] + v0; cs[bj][1] = cs[bj][1] + v1;
                    bf16_t* p = ob + (size_t)row * DM + pnl * 256 + bj * HALF + wc * 32 + 4 * fq;
                    u32x2 w0, w1; w0.x = cvt_pk_bf16(v0[0], v0[1]); w0.y = cvt_pk_bf16(v0[2], v0[3]); w1.x = cvt_pk_bf16(v1[0], v1[1]); w1.y = cvt_pk_bf16(v1[2], v1[3]);
                    *(u32x2*)p = w0; *(u32x2*)(p + 16) = w1;
                }
            }
        if (t == 1) {
#pragma unroll
            for (int bj = 0; bj < 2; ++bj)
#pragma unroll
                for (int n = 0; n < 2; ++n) { f32x4 s = cs[bj][n];
#pragma unroll
                    for (int o = 1; o < 16; o <<= 1) { s.x += __shfl_xor(s.x, o); s.y += __shfl_xor(s.y, o); s.z += __shfl_xor(s.z, o); s.w += __shfl_xor(s.w, o); }
                    if (fr == 0) *(f32x4*)(kpart + ((size_t)(u.pm * 2 + wr) * NH + 2 * pnl + bj) * HD + wc * 32 + 16 * n + 4 * fq) = s; } }
    }
};
template <int MODE> struct EpiGen {
    static constexpr bool PERM = true, AFTER_DRAIN = false;
    bf16_t* O; int ldc; int split_cols; size_t split_stride; const bf16_t* G2;
    __device__ __forceinline__ static void unpack8(const u32x4 w, float (&f)[8]) {
        f[0] = bflo(w.x); f[1] = bfhi(w.x); f[2] = bflo(w.y); f[3] = bfhi(w.y); f[4] = bflo(w.z); f[5] = bfhi(w.z); f[6] = bflo(w.w); f[7] = bfhi(w.w);
    }
    __device__ __forceinline__ void operator()(const f32x4 (&acc)[2][2][4][2], const Unit& u, int wr, int wc, int fr, int fq) const {
        const int row0 = u.pm * BM + wr * 64 + fr; int colt = u.pn * BM; bf16_t* base = O; const bf16_t* g2 = G2;
        if (split_cols) { const int t = colt / split_cols; base += (size_t)t * split_stride; colt -= t * split_cols; }
#pragma unroll
        for (int ai = 0; ai < 2; ++ai)
#pragma unroll
            for (int m = 0; m < 4; ++m) {
                const int row = row0 + ai * HALF + m * 16;
                if constexpr (MODE == 4) {
                    const f32x4 g0 = acc[ai][0][m][0], g1 = acc[ai][0][m][1], u0 = acc[ai][1][m][0], u1 = acc[ai][1][m][1];
                    float r[8];
#pragma unroll
                    for (int e = 0; e < 4; ++e) { r[e] = siluf_e(g0[e]) * u0[e]; r[4 + e] = siluf_e(g1[e]) * u1[e]; }
                    u32x4 w; w.x = cvt_pk_bf16(r[0], r[1]); w.y = cvt_pk_bf16(r[2], r[3]); w.z = cvt_pk_bf16(r[4], r[5]); w.w = cvt_pk_bf16(r[6], r[7]);
                    *(u32x4*)(base + (size_t)row * ldc + u.pn * HALF + wc * 32 + 8 * fq) = w;
                } else {
#pragma unroll
                    for (int bj = 0; bj < 2; ++bj) {
                        const f32x4 v0 = acc[ai][bj][m][0], v1 = acc[ai][bj][m][1];
                        float r[8] = {v0[0], v0[1], v0[2], v0[3], v1[0], v1[1], v1[2], v1[3]};
                        bf16_t* p = base + (size_t)row * ldc + colt + bj * HALF + wc * 32 + 8 * fq;
                        if constexpr (MODE == 1) {
#pragma unroll
                            for (int e = 0; e < 8; ++e) r[e] = sigmoidf_e(r[e]);
                        }
                        if constexpr (MODE == 2) { float g[8]; unpack8(*(const u32x4*)p, g);
#pragma unroll
                            for (int e = 0; e < 8; ++e) r[e] = r[e] * g[e]; }
                        if constexpr (MODE == 3) { float g[8], o[8]; unpack8(*(const u32x4*)(g2 + (size_t)row * ldc + colt + bj * HALF + wc * 32 + 8 * fq), g); unpack8(*(const u32x4*)p, o);
#pragma unroll
                            for (int e = 0; e < 8; ++e) r[e] = o[e] + r[e] * g[e]; }
                        u32x4 w; w.x = cvt_pk_bf16(r[0], r[1]); w.y = cvt_pk_bf16(r[2], r[3]); w.z = cvt_pk_bf16(r[4], r[5]); w.w = cvt_pk_bf16(r[6], r[7]);
                        *(u32x4*)p = w;
                        if constexpr (MODE == 5) {
                            if (m == 3 && fr >= 13 && u.pn * BM < 3 * 1024) *(u32x4*)((bf16_t*)G2 + ((size_t)(row >> 6) * 3 + (fr - 13)) * 3072 + u.pn * BM + bj * HALF + wc * 32 + 8 * fq) = w; }
                    }
                }
            }
    }
};
struct EpiF32 {
    static constexpr bool PERM = false, AFTER_DRAIN = false;
    float* C; int ldc;
    __device__ __forceinline__ void operator()(const f32x4 (&acc)[2][2][4][2], const Unit& u, int wr, int wc, int fr, int fq) const {
        const int row0 = u.pm * BM + wr * 64 + fr, col0 = u.pn * BM + wc * 32 + 4 * fq;
#pragma unroll
        for (int ai = 0; ai < 2; ++ai)
#pragma unroll
            for (int m = 0; m < 4; ++m) { float* rowp = C + (size_t)(row0 + ai * HALF + m * 16) * ldc + col0;
#pragma unroll
                for (int bj = 0; bj < 2; ++bj)
#pragma unroll
                    for (int n = 0; n < 2; ++n) *(f32x4*)(rowp + bj * HALF + n * 16) = acc[ai][bj][m][n]; }
    }
};
struct PairOrder {
    StaticOrder so; int nblk, nN1;
    __host__ __device__ void init(int M, int N1, int nblk_, int G_, int c_) { so.init(M, N1, G_, c_); nblk = nblk_; nN1 = N1 / BM; }
    __host__ __device__ bool next(int i, Unit& u) const { if (!so.next(i / nblk, u)) return false; u.pn += (i % nblk) * nN1; return true; }
    __device__ __forceinline__ void a_ready(const Unit&) const {}
    __device__ __forceinline__ void done(const Unit&) const {}
};
}

struct Args { const float* in[16]; float* out; unsigned char* ws; int ph_lo, ph_hi, pass, pad; };
struct Frame {
    LAS unsigned char* lds;
    volatile LAS unsigned* MISC;
    int tid, lane, wave, G, gw, NGW;
    float* out; unsigned char* ws;
};
#define WSP(T, off) ((T*)(F.ws + (off)))
#define WSPF(T, off) ((T*)(Fp.ws + (off)))

struct WtItem { const float* src; bf16* dst; int ldw, K; };
__device__ __forceinline__ void tr_load(const WtItem& I, int lane, f32x4 (&v)[8]) {
#pragma unroll
    for (int i = 0; i < 8; ++i) v[i] = *(const f32x4*)(I.src + (size_t)((lane >> 3) + 8 * i) * I.ldw + 4 * (lane & 7));
}
__device__ __forceinline__ void tr_put(const f32x4 (&v)[8], LAS float* scr, int lane) {
#pragma unroll
    for (int i = 0; i < 8; ++i) { LAS float* s = scr + ((lane >> 3) + 8 * i) * 33 + 4 * (lane & 7); s[0] = v[i].x; s[1] = v[i].y; s[2] = v[i].z; s[3] = v[i].w; }
    LDS_WAIT(); asm volatile("" ::: "memory");
}
__device__ __forceinline__ void tr_out(const WtItem& I, const LAS float* scr, int lane) {
    const int c = lane & 7;
#pragma unroll
    for (int j = 0; j < 4; ++j) { const int n = (lane >> 3) + 8 * j; const LAS float* s = scr + (8 * c) * 33 + n;
        v4u o; o.x = pk2(s[0 * 33], s[1 * 33]); o.y = pk2(s[2 * 33], s[3 * 33]); o.z = pk2(s[4 * 33], s[5 * 33]); o.w = pk2(s[6 * 33], s[7 * 33]);
        *(GAS v4u*)(I.dst + (size_t)n * I.K + 8 * c) = o; }
    LDS_WAIT(); asm volatile("" ::: "memory");
}
__device__ __forceinline__ void rms_row_bf16(const float* xrow, const float* w, bf16* orow, int lane, f32x4 (&hv)[4]) {
    const f32x4* xr = (const f32x4*)xrow + lane; const f32x4* wr = (const f32x4*)w + lane;
    float ss = 0.f;
#pragma unroll
    for (int j = 0; j < 4; ++j) { hv[j] = xr[64 * j]; ss += (hv[j].x * hv[j].x + hv[j].y * hv[j].y) + (hv[j].z * hv[j].z + hv[j].w * hv[j].w); }
    const float rs = rsq_(wave_sum(ss) * (1.f / DM) + EPS);
    unsigned long long* o8 = (unsigned long long*)orow + lane;
#pragma unroll
    for (int j = 0; j < 4; ++j) { const f32x4 wv = wr[64 * j]; hv[j] = hv[j] * rs * wv;
        o8[64 * j] = (unsigned long long)pk2(hv[j].x, hv[j].y) | ((unsigned long long)pk2(hv[j].z, hv[j].w) << 32); }
}
__device__ __forceinline__ WtItem wt_decode(const Args& A, unsigned char* ws, int it) {
    constexpr int I_A = 16 * 96, I_B = 16 * 128, I_G = 16 * 64, I_O = 16 * 32, I_GU = 16 * 88;
    const float* w_in = A.in[2];
    int r = it; const float* W; int ldw, scol, nbn, K = DM, dmode = 0; size_t dst;
    if (r < I_A) { W = w_in; ldw = INTOT; scol = 0; nbn = 96; dst = WS_WTA; }
    else if ((r -= I_A) < I_B) { W = w_in; ldw = INTOT; scol = 3072; nbn = 128; dst = WS_WTB; }
    else if ((r -= I_B) < I_G) { W = w_in; ldw = INTOT; scol = 7184; nbn = 64; dst = WS_WTG; }
    else if ((r -= I_G) < I_O) { W = A.in[7]; ldw = DM; scol = 0; nbn = 32; dst = WS_WTOA; }
    else if ((r -= I_O) < I_O) { W = A.in[8]; ldw = DM; scol = 0; nbn = 32; dst = WS_WTOD; }
    else if ((r -= I_O) < I_O) { W = A.in[9]; ldw = DM; scol = 0; nbn = 32; dst = WS_WTOUT; }
    else if ((r -= I_O) < I_GU) { W = A.in[12]; ldw = DFF; scol = 0; nbn = 88; dst = WS_WTGU; dmode = 1; }
    else if ((r -= I_GU) < I_GU) { W = A.in[13]; ldw = DFF; scol = 0; nbn = 88; dst = WS_WTGU; dmode = 2; }
    else { r -= I_GU; W = A.in[14]; ldw = DM; scol = 0; nbn = 32; dst = WS_WTDN; K = DFF; }
    const int kb = r / nbn, nb = r % nbn, n0 = 32 * nb;
    const int drow0 = (dmode == 0) ? n0 : 256 * (n0 / 128) + (n0 % 128) + (dmode == 2 ? 128 : 0);
    WtItem I; I.src = W + (size_t)(64 * kb) * ldw + scol + n0; I.dst = (bf16*)(ws + dst) + (size_t)drow0 * K + 64 * kb; I.ldw = ldw; I.K = K; return I;
}
__device__ __forceinline__ void p_wtrans(Frame& F, const Args& A, int it0, int it1, int gw0, int ngw) {
    LAS float* scr = (LAS float*)(F.lds + RING_OFF + F.wave * 16384);
    int it = it0 + gw0; if (it >= it1) return;
    WtItem cur = wt_decode(A, F.ws, it); f32x4 v[8]; tr_load(cur, F.lane, v);
    for (;;) {
        const int itn = it + ngw; const bool more = itn < it1;
        tr_put(v, scr, F.lane);
        WtItem nxt = cur; if (more) { nxt = wt_decode(A, F.ws, itn); tr_load(nxt, F.lane, v); }
        tr_out(cur, scr, F.lane);
        if (!more) break;
        cur = nxt; it = itn;
    }
}
constexpr int WT_A_ITEMS = 2560;
constexpr int WT_ITEMS_EARLY = 16 * 96 + 16 * 128, WT_ITEMS_ALL = 16 * 96 + 16 * 128 + 16 * 64 + 3 * 16 * 32 + 2 * 16 * 88 + 44 * 32;
__device__ __forceinline__ void p_prologue(Frame& F, const Args& A) {
    const float* w_in = A.in[2];
#if DN2_LATE_WT
    p_wtrans(F, A, 0, WT_ITEMS_EARLY, F.gw, F.NGW);
#else
    p_wtrans(F, A, 0, WT_ITEMS_ALL, F.gw, F.NGW);
#endif
    { float* cosT = WSP(float, WS_COS); float* sinT = WSP(float, WS_SIN);
      for (int i = F.gw * 64 + F.lane; i < S * 16; i += F.NGW * 64) { const int pos = i >> 4, k = i & 15;
          const float inv = (float)pow(500000.0, -(double)k / 16.0); const float ang = (float)pos * inv;
          cosT[i] = cosf(ang); sinT[i] = sinf(ang); } }
    { const float* x = A.in[0]; bf16* H = WSP(bf16, WS_H); float* BA = WSP(float, WS_BA);
      constexpr int WP = 2064;
      LAS unsigned char* wimg = F.lds; LAS unsigned char* hl = F.lds + 36864 + F.wave * (4 * WP + 192);
      __syncthreads();
      { const int k8 = F.tid >> 2, c4 = 4 * (F.tid & 3); f32x4 wv[8];
#pragma unroll
        for (int i = 0; i < 8; ++i) wv[i] = *(const f32x4*)(w_in + (size_t)(8 * k8 + i) * INTOT + 7168 + c4);
#pragma unroll
        for (int c = 0; c < 4; ++c) { u32x4 o; o.x = pk2(wv[0][c], wv[1][c]); o.y = pk2(wv[2][c], wv[3][c]); o.z = pk2(wv[4][c], wv[5][c]); o.w = pk2(wv[6][c], wv[7][c]);
            *(LAS u32x4*)(wimg + (c4 + c) * WP + 16 * k8) = o; } }
      __syncthreads();
      const int r16 = F.lane & 15, g = F.lane >> 4;
      const LAS unsigned char* wrd = wimg + r16 * WP + 16 * g; const LAS unsigned char* hrd = hl + (r16 & 3) * WP + 16 * g;
      f32x4 nw[4];
#pragma unroll
      for (int j = 0; j < 4; ++j) nw[j] = ((const f32x4*)A.in[1])[F.lane + 64 * j];
      for (int m0 = F.gw; m0 < S; m0 += 4 * F.NGW) {
          f32x4 xv[4][4];
#pragma unroll
          for (int k = 0; k < 4; ++k) { const int m = m0 + k * F.NGW; const f32x4* xr = (const f32x4*)(x + (size_t)(m < S ? m : m0) * DM) + F.lane;
#pragma unroll
              for (int j = 0; j < 4; ++j) xv[k][j] = xr[64 * j]; }
#pragma unroll
          for (int k = 0; k < 4; ++k) { const int m = m0 + k * F.NGW; float ss = 0.f;
#pragma unroll
              for (int j = 0; j < 4; ++j) ss += (xv[k][j].x * xv[k][j].x + xv[k][j].y * xv[k][j].y) + (xv[k][j].z * xv[k][j].z + xv[k][j].w * xv[k][j].w);
              const float rs = rsq_(wave_sum(ss) * (1.f / DM) + EPS);
              unsigned long long* o8 = (unsigned long long*)(H + (size_t)m * DM) + F.lane;
#pragma unroll
              for (int j = 0; j < 4; ++j) { const f32x4 hv = xv[k][j] * rs * nw[j]; u32x2 p; p.x = pk2(hv.x, hv.y); p.y = pk2(hv.z, hv.w);
                  if (m < S) o8[64 * j] = (unsigned long long)p.x | ((unsigned long long)p.y << 32);
                  *(LAS u32x2*)(hl + k * WP + 8 * (F.lane + 64 * j)) = p; } }
          asm volatile("s_waitcnt lgkmcnt(0)" ::: "memory");
          f32x4 acc = {0.f, 0.f, 0.f, 0.f};
#pragma unroll 8
          for (int s = 0; s < 32; ++s) { const bf16x8 wf = *(const LAS bf16x8*)(wrd + 64 * s), hf = *(const LAS bf16x8*)(hrd + 64 * s);
              acc = __builtin_amdgcn_mfma_f32_16x16x32_bf16(wf, hf, acc, 0, 0, 0); }
          { const int m = m0 + r16 * F.NGW; if (r16 < 4 && m < S) *(f32x4*)(BA + (size_t)m * 16 + 4 * g) = acc; }
          asm volatile("s_waitcnt lgkmcnt(0)" ::: "memory");
      }
      __syncthreads(); }
}
__device__ __forceinline__ void p_hrecompute_sub(Frame& F, const Args& A, bf16* H, int gw0, int ngw) {
    const float* x = A.in[0];
    for (int m = gw0; m < S; m += ngw) { f32x4 hv[4]; rms_row_bf16(x + (size_t)m * DM, A.in[1], H + (size_t)m * DM, F.lane, hv); }
}
__device__ __forceinline__ void p_hrecompute(Frame& F, const Args& A) {
    const float* x = A.in[0]; bf16* H = WSP(bf16, WS_H);
    for (int m = F.gw; m < S; m += F.NGW) { f32x4 hv[4]; rms_row_bf16(x + (size_t)m * DM, A.in[1], H + (size_t)m * DM, F.lane, hv); }
}

__device__ __forceinline__ void p_kmean(Frame& F, const Args& A) {
    const bf16* KA = WSP(bf16, WS_R1 + T32); float* KM = WSP(float, WS_KMEAN);
    for (int it = F.gw; it < NBLK * NH; it += F.NGW) { const int blk = it >> 3, h = it & 7;
        float s0 = 0.f, s1 = 0.f; const bf16* p = KA + (size_t)(blk * MBLK) * DM + h * HD + 2 * F.lane;
#pragma unroll 32
        for (int r = 0; r < MBLK; ++r) { const unsigned v = *(const unsigned*)(p + (size_t)r * DM); s0 += bflo(v); s1 += bfhi(v); }
        KM[(size_t)it * HD + 2 * F.lane] = s0 * (1.f / MBLK); KM[(size_t)it * HD + 2 * F.lane + 1] = s1 * (1.f / MBLK); }
}
__device__ __forceinline__ void p_topk(Frame& F, const Args& A) {
    const bf16* QA = WSP(bf16, WS_R1); const float* KM = WSP(float, WS_KMEAN); int* TOPI = WSP(int, WS_TOPI);
    for (int it = F.gw; it < S * NH; it += F.NGW) { const int q = it >> 3, h = it & 7, qblk = q >> 8;
        float g = -INFINITY;
        if (F.lane < qblk) { const bf16* qp = QA + (size_t)q * DM + h * HD; const float* kp = KM + ((size_t)F.lane * NH + h) * HD; float a = 0.f;
#pragma unroll
            for (int c = 0; c < 16; ++c) { const u32x4 qv = *(const u32x4*)(qp + 8 * c); const f32x4 k0 = *(const f32x4*)(kp + 8 * c), k1 = *(const f32x4*)(kp + 8 * c + 4);
                a += bflo(qv.x) * k0.x + bfhi(qv.x) * k0.y + bflo(qv.y) * k0.z + bfhi(qv.y) * k0.w + bflo(qv.z) * k1.x + bfhi(qv.z) * k1.y + bflo(qv.w) * k1.z + bfhi(qv.w) * k1.w; }
            g = a; }
        int res = -1;
#pragma unroll
        for (int r = 0; r < 3; ++r) { float v = g; int i = F.lane;
#pragma unroll
            for (int o = 1; o < 64; o <<= 1) { const float ov = __shfl_xor(v, o); const int oi = __shfl_xor(i, o); if (ov > v || (ov == v && oi < i)) { v = ov; i = oi; } }
            if (F.lane == r) res = (r < qblk) ? i : -1;
            if (F.lane == i) g = -INFINITY; }
        if (F.lane < 3) TOPI[(size_t)it * 3 + F.lane] = res; }
}
__device__ __forceinline__ void p_attn_naive(Frame& F, const Args& A) {
    const bf16* QA = WSP(bf16, WS_R1); const bf16* KA = WSP(bf16, WS_R1 + T32); const bf16* VA = WSP(bf16, WS_R1 + 2 * T32); const int* TOPI = WSP(int, WS_TOPI);
#ifdef DBG_ATTN
    bf16* YA = (bf16*)F.out;
#else
    bf16* YA = WSP(bf16, WS_YA);
#endif
    for (int it = F.gw; it < S * NH; it += F.NGW) { const int q = it >> 3, h = it & 7, qblk = q >> 8;
        const bf16* qp = QA + (size_t)q * DM + h * HD;
        float m = -INFINITY, l = 0.f, o0 = 0.f, o1 = 0.f;
        for (int slot = 0; slot < 4; ++slot) {
            int kb = qblk; if (slot < 3) { kb = TOPI[(size_t)it * 3 + slot]; if (kb < 0) continue; }
            const bf16* kp = KA + (size_t)(kb * MBLK) * DM + h * HD; const bf16* vp = VA + (size_t)(kb * MBLK) * DM + h * HD;
            float s[4] = {0.f, 0.f, 0.f, 0.f};
#pragma unroll 4
            for (int c = 0; c < 16; ++c) { const u32x4 qv = *(const u32x4*)(qp + 8 * c);
                const float q0 = bflo(qv.x), q1 = bfhi(qv.x), q2 = bflo(qv.y), q3 = bfhi(qv.y), q4 = bflo(qv.z), q5 = bfhi(qv.z), q6 = bflo(qv.w), q7 = bfhi(qv.w);
#pragma unroll
                for (int jj = 0; jj < 4; ++jj) { const u32x4 kv = *(const u32x4*)(kp + (size_t)(F.lane + 64 * jj) * DM + 8 * c);
                    s[jj] += q0 * bflo(kv.x) + q1 * bfhi(kv.x) + q2 * bflo(kv.y) + q3 * bfhi(kv.y) + q4 * bflo(kv.z) + q5 * bfhi(kv.z) + q6 * bflo(kv.w) + q7 * bfhi(kv.w); } }
            float mx = -INFINITY;
#pragma unroll
            for (int jj = 0; jj < 4; ++jj) { s[jj] *= 0.08838834764831845f; if (slot == 3 && (kb * MBLK + F.lane + 64 * jj) > q) s[jj] = -INFINITY; mx = fmaxf(mx, s[jj]); }
            mx = wave_max(mx);
            const float mn = fmaxf(m, mx), sc = __expf(m - mn);
            float p[4], ps = 0.f;
#pragma unroll
            for (int jj = 0; jj < 4; ++jj) { p[jj] = __expf(s[jj] - mn); ps += p[jj]; }
            l = l * sc + wave_sum(ps); o0 *= sc; o1 *= sc; m = mn;
#pragma unroll
            for (int jj = 0; jj < 4; ++jj)
                for (int ln = 0; ln < 64; ++ln) { const float pj = __shfl(p[jj], ln); const unsigned vv = *(const unsigned*)(vp + (size_t)(ln + 64 * jj) * DM + 2 * F.lane); o0 += pj * bflo(vv); o1 += pj * bfhi(vv); }
        }
        const float il = 1.f / l;
        *(unsigned*)(YA + (size_t)q * DM + h * HD + 2 * F.lane) = pk2(o0 * il, o1 * il); }
}


typedef float f32x16 __attribute__((ext_vector_type(16)));
typedef short s16x4 __attribute__((ext_vector_type(4)));
typedef float f32x2_t __attribute__((ext_vector_type(2)));
typedef __bf16 bf16x2_t __attribute__((ext_vector_type(2)));
constexpr size_t WS_BUCKET = 241 * MiB, WS_ML = 249 * MiB, WS_OP2 = WS_Z;
constexpr int BUCKET_PER_HEAD = 256 * 2016;
constexpr int CW_CNT = 16384;
static_assert(WS_BUCKET + (size_t)NH * BUCKET_PER_HEAD * 2 <= WS_ML && WS_ML + (size_t)3 * S * NH * 8 <= WS_END, "bucket map");
constexpr float SM_C = 0.08838834764831845f * 1.4426950408889634f;

__device__ __forceinline__ int bucket_off(int kb) { return 256 * (63 * kb - (kb * (kb - 1)) / 2); }
__device__ __forceinline__ unsigned attn_off(unsigned row, unsigned ch) { return 256u * row + 16u * (ch ^ (((row & 3u) << 2) | ((row >> 2) & 3u))); }
__device__ __forceinline__ unsigned cvtpk(float lo, float hi) { f32x2_t v = {lo, hi}; bf16x2_t b = __builtin_convertvector(v, bf16x2_t); return __builtin_bit_cast(unsigned, b); }
__device__ __forceinline__ s16x4 vtr16(const LAS unsigned char* p) { typedef short v4i16_t __attribute__((ext_vector_type(4))); return __builtin_bit_cast(s16x4, __builtin_amdgcn_ds_read_tr16_b64_v4i16((LAS v4i16_t*)p)); }

__device__ __forceinline__ void unpack8f(const bf16x8 v, float (&f)[8]) { const u32x4 w = __builtin_bit_cast(u32x4, v);
    f[0] = bflo(w.x); f[1] = bfhi(w.x); f[2] = bflo(w.y); f[3] = bfhi(w.y); f[4] = bflo(w.z); f[5] = bfhi(w.z); f[6] = bflo(w.w); f[7] = bfhi(w.w); }
__device__ __forceinline__ bf16x8 pack8f(const float (&f)[8]) { u32x4 w; w.x = cvtpk(f[0], f[1]); w.y = cvtpk(f[2], f[3]); w.z = cvtpk(f[4], f[5]); w.w = cvtpk(f[6], f[7]); return __builtin_bit_cast(bf16x8, w); }

__device__ __forceinline__ void attn_stage(const bf16* src, LAS unsigned char* img, int tid) {
#pragma unroll
    for (int i = 0; i < 8; ++i) { const int n = tid + 512 * i, row = n >> 4, ch = n & 15;
        const u32x4 v = *(const u32x4*)(src + (size_t)row * DM + 8 * ch); *(LAS u32x4*)(img + attn_off(row, ch)) = v; }
}
struct AttnState { float m, l; f32x16 o[4]; };
__device__ __forceinline__ float half_max(float v) { const auto t = __builtin_amdgcn_permlane32_swap(__builtin_bit_cast(unsigned, v), __builtin_bit_cast(unsigned, v), false, false); return fmaxf(__builtin_bit_cast(float, t[0]), __builtin_bit_cast(float, t[1])); }
__device__ __forceinline__ float half_sum(float v) { const auto t = __builtin_amdgcn_permlane32_swap(__builtin_bit_cast(unsigned, v), __builtin_bit_cast(unsigned, v), false, false); return __builtin_bit_cast(float, t[0]) + __builtin_bit_cast(float, t[1]); }
template <int NT> __device__ __forceinline__ void attn_wave(const bf16x8 (&qf)[8], const LAS unsigned char* Kimg, const LAS unsigned char* Vimg, int nt, int diag, int lane, AttnState& st) {
    const int r = lane & 31, hh = lane >> 5, blk = (lane >> 4) & 1, q4 = (lane & 15) >> 2, p4 = lane & 3;
    const LAS unsigned char* kad[8];
#pragma unroll
    for (int ks = 0; ks < 8; ++ks) kad[ks] = Kimg + attn_off(r, 2 * ks + hh);
    const LAS unsigned char* vb[2][4];
    { const unsigned rl0 = 4u * hh + q4, cb = 2u * blk + (p4 >> 1);
#pragma unroll
      for (int a = 0; a < 2; ++a)
#pragma unroll
          for (int c = 0; c < 4; ++c) vb[a][c] = Vimg + 256u * rl0 + 16u * (cb ^ (unsigned)hh ^ (2u * a)) + 8u * (p4 & 1) + 64u * ((unsigned)c ^ q4); }
    st.m = -INFINITY; st.l = 0.f;
#pragma unroll
    for (int c = 0; c < 4; ++c)
#pragma unroll
        for (int i = 0; i < 16; ++i) st.o[c][i] = 0.f;
    auto tile = [&](const int kt) __attribute__((always_inline)) {
        f32x16 s;
#pragma unroll
        for (int i = 0; i < 16; ++i) s[i] = 0.f;
#pragma unroll
        for (int ks = 0; ks < 8; ++ks) { const bf16x8 kf = *(const LAS bf16x8*)(kad[ks] + kt * 8192); s = __builtin_amdgcn_mfma_f32_32x32x16_bf16(kf, qf[ks], s, 0, 0, 0); }
        float tmax = -INFINITY;
#pragma unroll
        for (int i = 0; i < 16; ++i) { if (kt == diag && ((i & 3) + 8 * (i >> 2) + 4 * hh) > r) s[i] = -INFINITY; tmax = fmaxf(tmax, s[i]); }
        tmax = fmaxf(tmax, __shfl_xor(tmax, 32)) * SM_C;
        if (!(tmax - st.m <= 8.f)) { const float mn = fmaxf(st.m, tmax), alpha = __builtin_amdgcn_exp2f(st.m - mn); st.l *= alpha; st.m = mn;
#pragma unroll
            for (int c = 0; c < 4; ++c)
#pragma unroll
                for (int i = 0; i < 16; ++i) st.o[c][i] *= alpha; }
        float rs = 0.f; const float nm = -st.m;
#pragma unroll
        for (int i = 0; i < 16; ++i) { s[i] = __builtin_amdgcn_exp2f(__builtin_fmaf(s[i], SM_C, nm)); rs += s[i]; }
        st.l += rs + __shfl_xor(rs, 32);
#pragma unroll
        for (int sp = 0; sp < 2; ++sp) {
            u32x4 pw; pw.x = cvtpk(s[8 * sp], s[8 * sp + 1]); pw.y = cvtpk(s[8 * sp + 2], s[8 * sp + 3]); pw.z = cvtpk(s[8 * sp + 4], s[8 * sp + 5]); pw.w = cvtpk(s[8 * sp + 6], s[8 * sp + 7]);
            const bf16x8 pf = __builtin_bit_cast(bf16x8, pw);
#pragma unroll
            for (int c = 0; c < 4; ++c) {
                const s16x4 lo = vtr16(vb[0][c] + (4096 * sp + kt * 8192));
                const s16x4 hi = vtr16(vb[1][c] + (2048 + 4096 * sp + kt * 8192));
                const bf16x8 vf = __builtin_shufflevector(lo, hi, 0, 1, 2, 3, 4, 5, 6, 7);
                st.o[c] = __builtin_amdgcn_mfma_f32_32x32x16_bf16(vf, pf, st.o[c], 0, 0, 0);
            }
        }
    };
    if constexpr (NT > 0) {
#pragma unroll
        for (int kt = 0; kt < NT; ++kt) tile(kt);
    } else { for (int kt = 0; kt < nt; ++kt) tile(kt); }
}
__device__ __forceinline__ void p_topk_bucket(Frame& F, const Args& A) {
    const bf16* QA = WSP(bf16, WS_R1); const float* KM = WSP(float, WS_KMEAN); int* TOPI = WSP(int, WS_TOPI);
    unsigned* CNT = WSP(unsigned, WS_CTL) + CW_CNT; unsigned short* BUCKET = WSP(unsigned short, WS_BUCKET); f32x2_t* ML = WSP(f32x2_t, WS_ML);
    for (int it = F.gw; it < S * NH; it += F.NGW) { const int q = it >> 3, h = it & 7, qblk = q >> 8;
        float g = -INFINITY;
        if (F.lane < qblk) { const bf16* qp = QA + (size_t)q * DM + h * HD; const float* kp = KM + ((size_t)F.lane * NH + h) * HD; float a = 0.f;
#pragma unroll
            for (int c = 0; c < 16; ++c) { const u32x4 qv = *(const u32x4*)(qp + 8 * c); const f32x4 k0 = *(const f32x4*)(kp + 8 * c), k1 = *(const f32x4*)(kp + 8 * c + 4);
                a += bflo(qv.x) * k0.x + bfhi(qv.x) * k0.y + bflo(qv.y) * k0.z + bfhi(qv.y) * k0.w + bflo(qv.z) * k1.x + bfhi(qv.z) * k1.y + bflo(qv.w) * k1.z + bfhi(qv.w) * k1.w; }
            g = a; }
        int res = -1;
#pragma unroll
        for (int r = 0; r < 3; ++r) { float v = g; int i = F.lane;
#pragma unroll
            for (int o = 1; o < 64; o <<= 1) { const float ov = __shfl_xor(v, o); const int oi = __shfl_xor(i, o); if (ov > v || (ov == v && oi < i)) { v = ov; i = oi; } }
            if (F.lane == r) res = (r < qblk) ? i : -1;
            if (F.lane == i) g = -INFINITY; }
        if (F.lane < 3) { TOPI[(size_t)it * 3 + F.lane] = res;
            if (res >= 0) { const unsigned pos = __hip_atomic_fetch_add(CNT + h * NBLK + res, 1u, __ATOMIC_RELAXED, __HIP_MEMORY_SCOPE_AGENT);
                BUCKET[(size_t)h * BUCKET_PER_HEAD + bucket_off(res) + pos] = (unsigned short)((q << 2) | F.lane); }
            else ML[((size_t)F.lane * S + q) * NH + h] = (f32x2_t){-INFINITY, 0.f}; } }
}

__device__ __forceinline__ void p_topk2(Frame& F, const Args& A) {
    const bf16* QA = WSP(bf16, WS_R1); const float* KP = WSP(const float, WS_KMEAN);
    unsigned* CNT = WSP(unsigned, WS_CTL) + CW_CNT; unsigned short* BUCKET = WSP(unsigned short, WS_BUCKET); f32x2_t* ML = WSP(f32x2_t, WS_ML);
    LAS unsigned char* Kimg = F.lds;
    LAS int* lcnt = (LAS int*)(F.lds + 16384); LAS int* lbase = lcnt + 64;
    const int lane = F.lane, r = lane & 31, hh = lane >> 5;
    for (int u = blockIdx.x; u < NBLK * NH; u += F.G) { const int qblk = u >> 3, h = u & 7, q = qblk * MBLK + 32 * F.wave + r;
        __syncthreads();
        { const int n = F.tid >> 3, c = F.tid & 7; const float* p0 = KP + ((size_t)(n * 2) * NH + h) * HD + 16 * c; const float* p1 = p0 + (size_t)NH * HD;
#pragma unroll
          for (int half = 0; half < 2; ++half) { const f32x4 a0 = *(const f32x4*)(p0 + 8 * half), a1 = *(const f32x4*)(p0 + 8 * half + 4), c0 = *(const f32x4*)(p1 + 8 * half), c1 = *(const f32x4*)(p1 + 8 * half + 4);
              float f[8] = {(a0.x + c0.x) * (1.f / MBLK), (a0.y + c0.y) * (1.f / MBLK), (a0.z + c0.z) * (1.f / MBLK), (a0.w + c0.w) * (1.f / MBLK), (a1.x + c1.x) * (1.f / MBLK), (a1.y + c1.y) * (1.f / MBLK), (a1.z + c1.z) * (1.f / MBLK), (a1.w + c1.w) * (1.f / MBLK)};
              *(LAS bf16x8*)(Kimg + attn_off(n, 2 * c + half)) = pack8f(f); } }
        if (F.tid < 64) lcnt[F.tid] = 0;
        __syncthreads();
        float bv[3] = {-INFINITY, -INFINITY, -INFINITY}; int bi[3] = {0, 0, 0};
        if (qblk > 0) {
            bf16x8 qf[8];
#pragma unroll
            for (int ks = 0; ks < 8; ++ks) qf[ks] = *(const bf16x8*)(QA + (size_t)q * DM + h * HD + 16 * ks + 8 * hh);
            const int nt = (qblk > 32) ? 2 : 1;
            for (int tn = 0; tn < nt; ++tn) {
                f32x16 acc;
#pragma unroll
                for (int i = 0; i < 16; ++i) acc[i] = 0.f;
#pragma unroll
                for (int ks = 0; ks < 8; ++ks) { const bf16x8 kf = *(const LAS bf16x8*)(Kimg + attn_off(32 * tn + r, 2 * ks + hh)); acc = __builtin_amdgcn_mfma_f32_32x32x16_bf16(kf, qf[ks], acc, 0, 0, 0); }
#pragma unroll
                for (int i = 0; i < 16; ++i) { const int n = 32 * tn + (i & 3) + 8 * (i >> 2) + 4 * hh; const float v = (n < qblk) ? acc[i] : -INFINITY;
                    const bool g0 = v > bv[0], g1 = v > bv[1], g2 = v > bv[2];
                    bv[2] = g1 ? bv[1] : (g2 ? v : bv[2]); bi[2] = g1 ? bi[1] : (g2 ? n : bi[2]);
                    bv[1] = g0 ? bv[0] : (g1 ? v : bv[1]); bi[1] = g0 ? bi[0] : (g1 ? n : bi[1]);
                    bv[0] = g0 ? v : bv[0]; bi[0] = g0 ? n : bi[0]; }
            }
            float ov[3]; int oi[3];
#pragma unroll
            for (int k = 0; k < 3; ++k) { ov[k] = __shfl_xor(bv[k], 32); oi[k] = __shfl_xor(bi[k], 32); }
#pragma unroll
            for (int k = 0; k < 3; ++k) { const float v = ov[k]; const int n = oi[k];
#define TK_GT(v_, n_, w_, m_) ((v_) > (w_) || ((v_) == (w_) && (n_) < (m_)))
                const bool ok = v > -INFINITY, g0 = ok && TK_GT(v, n, bv[0], bi[0]), g1 = ok && TK_GT(v, n, bv[1], bi[1]), g2 = ok && TK_GT(v, n, bv[2], bi[2]);
                bv[2] = g1 ? bv[1] : (g2 ? v : bv[2]); bi[2] = g1 ? bi[1] : (g2 ? n : bi[2]);
                bv[1] = g0 ? bv[0] : (g1 ? v : bv[1]); bi[1] = g0 ? bi[0] : (g1 ? n : bi[1]);
                bv[0] = g0 ? v : bv[0]; bi[0] = g0 ? n : bi[0]; }
        }
        int rank[3] = {0, 0, 0}; bool valid[3];
#pragma unroll
        for (int k = 0; k < 3; ++k) { valid[k] = (hh == 0) && (k < qblk) && (bv[k] > -INFINITY);
            if (valid[k]) rank[k] = __hip_atomic_fetch_add(lcnt + bi[k], 1, __ATOMIC_RELAXED, __HIP_MEMORY_SCOPE_WORKGROUP);
            else if (hh == 0) ML[((size_t)k * S + q) * NH + h] = (f32x2_t){-INFINITY, 0.f}; }
        __syncthreads();
        if (F.tid < 64) { const int c = lcnt[F.tid]; if (c > 0) lbase[F.tid] = (int)__hip_atomic_fetch_add(CNT + h * NBLK + F.tid, (unsigned)c, __ATOMIC_RELAXED, __HIP_MEMORY_SCOPE_AGENT); }
        __syncthreads();
#pragma unroll
        for (int k = 0; k < 3; ++k) if (valid[k]) BUCKET[(size_t)h * BUCKET_PER_HEAD + bucket_off(bi[k]) + lbase[bi[k]] + rank[k]] = (unsigned short)((q << 2) | k);
    }
    __syncthreads();
}
__device__ __forceinline__ bf16* op_slot(Frame& F, int r) { return r < 2 ? (bf16*)F.out + (size_t)r * S * DM : WSP(bf16, WS_OP2); }
constexpr int AS_IU = 3, CW_TICKET = 20480;
__device__ __forceinline__ void p_attn_sel(Frame& F, const Args& A) {
    const bf16* QA = WSP(bf16, WS_R1); const bf16* KA = WSP(bf16, WS_R1 + T32); const bf16* VA = WSP(bf16, WS_R1 + 2 * T32);
    const unsigned* CNT = WSP(const unsigned, WS_CTL) + CW_CNT; const unsigned short* BUCKET = WSP(const unsigned short, WS_BUCKET); f32x2_t* ML = WSP(f32x2_t, WS_ML);
    unsigned* ticket = WSP(unsigned, WS_CTL) + CW_TICKET;
    LAS unsigned char* Kimg = F.lds; LAS unsigned char* Vimg = F.lds + 65536; LAS int* pit = (LAS int*)(F.lds + LDSCTL_OFF + 1024);
    LAS int* wtot = pit + 520; volatile LAS int* nxw = pit + 540;
    __syncthreads();
    { const int lo = (F.tid & 7) * NBLK + (F.tid >> 3); const int nb = (int)((CNT[lo] + 255u) >> 8), ni = (nb + AS_IU - 1) / AS_IU;
      int inc = ni;
#pragma unroll
      for (int o = 1; o < 64; o <<= 1) { const int v = __shfl_up(inc, o); if (F.lane >= o) inc += v; }
      if (F.lane == 63) wtot[F.wave] = inc;
      __syncthreads();
      int base = 0;
#pragma unroll
      for (int w = 0; w < NWAVES; ++w) base += (w < F.wave) ? wtot[w] : 0;
      pit[F.tid] = base + inc - ni;
      if (F.tid == NWAVES * 64 - 1) pit[NH * NBLK] = base + inc; }
    __syncthreads();
    const int NI = pit[NH * NBLK];
#define AS_ITEM(it_, h_, kb_, j_, je_, cnt_) do { int lo_ = 0, hi_ = NH * NBLK - 1; while (lo_ < hi_) { const int mid_ = (lo_ + hi_ + 1) >> 1; if (pit[mid_] <= (it_)) lo_ = mid_; else hi_ = mid_ - 1; } \
        h_ = lo_ & 7; kb_ = lo_ >> 3; cnt_ = (int)CNT[(h_) * NBLK + (kb_)]; j_ = ((it_) - pit[lo_]) * AS_IU; { const int nb_ = ((cnt_) + 255) >> 8; je_ = (j_) + AS_IU < nb_ ? (j_) + AS_IU : nb_; } } while (0)
#define AS_ENTRY(h_, kb_, j_, cnt_, valid_, ent_) do { const int e_ = 256 * (j_) + 32 * F.wave + (F.lane & 31); valid_ = e_ < (cnt_); \
        ent_ = BUCKET[(size_t)(h_) * BUCKET_PER_HEAD + bucket_off(kb_) + ((valid_) ? e_ : 256 * (j_))]; } while (0)
    const int hh = F.lane >> 5;
    bf16x8 qf[8];
    int it = (int)blockIdx.x, itn = NI;
    unsigned grab = 0u;
    int h = 0, kb = 0, j = 0, je = 0, cnt = 0, q = 0, r = 0; bool valid = false; int hs = -1, kbs = -1;
    if (it < NI) {
        if (F.tid == 0) grab = (unsigned)F.G + __hip_atomic_fetch_add(ticket, 1u, __ATOMIC_RELAXED, __HIP_MEMORY_SCOPE_AGENT);
        AS_ITEM(it, h, kb, j, je, cnt);
        unsigned ent; AS_ENTRY(h, kb, j, cnt, valid, ent); q = (int)(ent >> 2); r = (int)(ent & 3u);
#pragma unroll
        for (int ks = 0; ks < 8; ++ks) qf[ks] = *(const bf16x8*)(QA + (size_t)q * DM + h * HD + 16 * ks + 8 * hh);
    }
    bool fresh = true;
    while (it < NI) {
        if (fresh) {
            __syncthreads();
            if (F.tid == 0) { const int g_ = (int)grab; nxw[0] = g_ < NI ? g_ : NI; }
            if (h != hs || kb != kbs) { attn_stage(KA + (size_t)(kb * MBLK) * DM + h * HD, Kimg, F.tid); attn_stage(VA + (size_t)(kb * MBLK) * DM + h * HD, Vimg, F.tid); hs = h; kbs = kb; }
            __syncthreads();
            itn = nxw[0];
            if (F.tid == 0 && itn < NI) grab = (unsigned)F.G + __hip_atomic_fetch_add(ticket, 1u, __ATOMIC_RELAXED, __HIP_MEMORY_SCOPE_AGENT);
            fresh = false; }
        int hn = h, kbn = kb, jn = j + 1, jen = je, cntn = cnt; bool more = true, sw = false;
        if (jn >= je) { sw = true; if (itn < NI) { AS_ITEM(itn, hn, kbn, jn, jen, cntn); } else more = false; }
        unsigned entn = 0u; bool validn = false;
        if (more) AS_ENTRY(hn, kbn, jn, cntn, validn, entn);
        AttnState st; if (__ballot(valid) != 0ull) attn_wave<8>(qf, Kimg, Vimg, 8, -1, F.lane, st);
        const int qc = q, rc = r, hc = h; const bool vc = valid;
        if (more) { q = (int)(entn >> 2); r = (int)(entn & 3u);
#pragma unroll
            for (int ks = 0; ks < 8; ++ks) qf[ks] = *(const bf16x8*)(QA + (size_t)q * DM + hn * HD + 16 * ks + 8 * hh); }
        if (vc) {
            bf16* op = op_slot(F, rc) + (size_t)qc * DM + hc * HD + 64 * hh;
#pragma unroll
            for (int c = 0; c < 4; ++c)
#pragma unroll
                for (int g2 = 0; g2 < 2; ++g2) { u32x4 w; w.x = cvtpk(st.o[c][8 * g2], st.o[c][8 * g2 + 1]); w.y = cvtpk(st.o[c][8 * g2 + 2], st.o[c][8 * g2 + 3]); w.z = cvtpk(st.o[c][8 * g2 + 4], st.o[c][8 * g2 + 5]); w.w = cvtpk(st.o[c][8 * g2 + 6], st.o[c][8 * g2 + 7]);
                    *(u32x4*)(op + 16 * c + 8 * g2) = w; }
            if (hh == 0) ML[((size_t)rc * S + qc) * NH + hc] = (f32x2_t){st.m, st.l}; }
        if (!more) break;
        h = hn; kb = kbn; j = jn; je = jen; cnt = cntn; valid = validn;
        if (sw) { it = itn; fresh = true; }
    }
    __syncthreads();
}
__device__ __forceinline__ void p_attn_own(Frame& F, const Args& A) {
    const bf16* QA = WSP(bf16, WS_R1); const bf16* KA = WSP(bf16, WS_R1 + T32); const bf16* VA = WSP(bf16, WS_R1 + 2 * T32); const f32x2_t* ML = WSP(const f32x2_t, WS_ML); bf16* YA = WSP(bf16, WS_YA);
    LAS unsigned char* Kimg = F.lds; LAS unsigned char* Vimg = F.lds + 65536;
    for (int u = blockIdx.x; u < NH * NBLK; u += F.G) { const int h = u & 7, qb = u >> 3;
        __syncthreads();
        attn_stage(KA + (size_t)(qb * MBLK) * DM + h * HD, Kimg, F.tid); attn_stage(VA + (size_t)(qb * MBLK) * DM + h * HD, Vimg, F.tid);
        __syncthreads();
        const int q = qb * MBLK + 32 * F.wave + (F.lane & 31), hh = F.lane >> 5;
        bf16x8 qf[8];
#pragma unroll
        for (int ks = 0; ks < 8; ++ks) qf[ks] = *(const bf16x8*)(QA + (size_t)q * DM + h * HD + 16 * ks + 8 * hh);
        AttnState st; attn_wave<0>(qf, Kimg, Vimg, F.wave + 1, F.wave, F.lane, st);
        float mr[3], lr[3], M = st.m;
#pragma unroll
        for (int r = 0; r < 3; ++r) { const f32x2_t ml = ML[((size_t)r * S + q) * NH + h]; mr[r] = ml.x; lr[r] = ml.y; M = fmaxf(M, ml.x); }
        const float w0 = __builtin_amdgcn_exp2f(st.m - M); float L = st.l * w0; float wr[3];
#pragma unroll
        for (int r = 0; r < 3; ++r) { wr[r] = (lr[r] > 0.f) ? __builtin_amdgcn_exp2f(mr[r] - M) : 0.f; L += lr[r] * wr[r]; }
        const float iL = rcp_(L);
        const size_t pbase = (size_t)q * DM + h * HD + 64 * hh;
        const bf16* ps0 = op_slot(F, 0) + pbase; const bf16* ps1 = op_slot(F, 1) + pbase; const bf16* ps2 = op_slot(F, 2) + pbase;
#pragma unroll
        for (int half = 0; half < 2; ++half) {
            bf16x8 pl[4][3];
#pragma unroll
            for (int k = 0; k < 4; ++k) { pl[k][0] = *(const bf16x8*)(ps0 + 32 * half + 8 * k); pl[k][1] = *(const bf16x8*)(ps1 + 32 * half + 8 * k); pl[k][2] = *(const bf16x8*)(ps2 + 32 * half + 8 * k); }
            __builtin_amdgcn_sched_barrier(0);
#pragma unroll
            for (int k = 0; k < 4; ++k) { const int c = 2 * half + (k >> 1), g2 = k & 1;
                float v[8];
#pragma unroll
                for (int e = 0; e < 8; ++e) v[e] = st.o[c][8 * g2 + e] * w0;
#pragma unroll
                for (int r = 0; r < 3; ++r) { float pf[8]; unpack8f(pl[k][r], pf); const bool on = wr[r] != 0.f;
#pragma unroll
                    for (int e = 0; e < 8; ++e) v[e] += on ? wr[r] * pf[e] : 0.f; }
                u32x2 wa, wb; wa.x = cvtpk(v[0] * iL, v[1] * iL); wa.y = cvtpk(v[2] * iL, v[3] * iL); wb.x = cvtpk(v[4] * iL, v[5] * iL); wb.y = cvtpk(v[6] * iL, v[7] * iL);
                bf16* yp = YA + (size_t)q * DM + h * HD + 32 * c + 16 * g2 + 4 * hh; *(u32x2*)yp = wa; *(u32x2*)(yp + 8) = wb; }
        }
    }
    __syncthreads();
}
__device__ __forceinline__ void p_dn_conv(Frame& F, const Args& A) {
    const bf16* QB = WSP(bf16, WS_R1); const bf16* KB = WSP(bf16, WS_R1 + T32); const bf16* VB = WSP(bf16, WS_R1 + 2 * T32);
    bf16* QN = (bf16*)F.out; bf16* KN = (bf16*)F.out + (size_t)S * DM; bf16* VN = WSP(bf16, WS_VN);
    const float* cw = A.in[3]; const float* BA = WSP(const float, WS_BA); float* BETA = WSP(float, WS_BETA); float* G = WSP(float, WS_G);
    for (int it = F.gw; it < S * NH; it += F.NGW) { const int t = it >> 3, h = it & 7, c = h * HD + 2 * F.lane;
        float aq0 = 0.f, aq1 = 0.f, ak0 = 0.f, ak1 = 0.f, av0 = 0.f, av1 = 0.f;
#pragma unroll
        for (int j = 0; j < 4; ++j) { const int tt = t + j - 3; if (tt < 0) continue;
            const unsigned xq = *(const unsigned*)(QB + (size_t)tt * DM + c), xk = *(const unsigned*)(KB + (size_t)tt * DM + c), xv = *(const unsigned*)(VB + (size_t)tt * DM + c);
            const float* w = cw + (size_t)j * 3072;
            aq0 += w[c] * bflo(xq); aq1 += w[c + 1] * bfhi(xq); ak0 += w[1024 + c] * bflo(xk); ak1 += w[1024 + c + 1] * bfhi(xk); av0 += w[2048 + c] * bflo(xv); av1 += w[2048 + c + 1] * bfhi(xv); }
        aq0 = siluf_(aq0); aq1 = siluf_(aq1); ak0 = siluf_(ak0); ak1 = siluf_(ak1); av0 = siluf_(av0); av1 = siluf_(av1);
        const float rq = rsq_(wave_sum(aq0 * aq0 + aq1 * aq1) + EPS) * 0.08838834764831845f, rk = rsq_(wave_sum(ak0 * ak0 + ak1 * ak1) + EPS);
        *(unsigned*)(QN + (size_t)t * DM + c) = pk2(aq0 * rq, aq1 * rq); *(unsigned*)(KN + (size_t)t * DM + c) = pk2(ak0 * rk, ak1 * rk); *(unsigned*)(VN + (size_t)t * DM + c) = pk2(av0, av1);
        if (F.lane == 0) { const float b = BA[(size_t)t * 16 + h], a = BA[(size_t)t * 16 + 8 + h] + A.in[5][h];
            const float sp = (a > 20.f) ? a : log1pf(expf(a));
            BETA[(size_t)t * 8 + h] = 1.f / (1.f + expf(-b)); G[(size_t)t * 8 + h] = -expf(A.in[4][h]) * sp; } }
}
__device__ __forceinline__ void p_dn_chunk(Frame& F, const Args& A) {
    const bf16* QN = (const bf16*)F.out; const bf16* KN = (const bf16*)F.out + (size_t)S * DM; bf16* VU = WSP(bf16, WS_VN); bf16* Wb = WSP(bf16, WS_W); bf16* ATT = WSP(bf16, WS_ATT);
    const float* BETA = WSP(const float, WS_BETA); const float* G = WSP(const float, WS_G); float* GC = WSP(float, WS_GC);
    LAS float* Kc = (LAS float*)(F.lds); LAS float* Qc = Kc + 64 * 132; LAS float* Lm = Qc + 64 * 132; LAS float* Tm = Lm + 64 * 65; LAS float* gcs = Tm + 64 * 65; LAS float* bes = gcs + 64; LAS float* bge = bes + 64;
    const int tid = F.tid;
    for (int item = blockIdx.x; item < NCH * NH; item += F.G) { const int n = item >> 3, h = item & 7, t0 = n * CH;
        __syncthreads();
        if (tid < 64) { gcs[tid] = G[(size_t)(t0 + tid) * 8 + h]; bes[tid] = BETA[(size_t)(t0 + tid) * 8 + h]; }
        __syncthreads();
        if (tid == 0) { float a = 0.f; for (int i = 0; i < 64; ++i) { a += gcs[i]; gcs[i] = a; } }
#pragma unroll
        for (int r = 0; r < 2; ++r) { const int idx = tid + 512 * r, row = idx >> 4, c8 = idx & 15;
            const u32x4 kv = *(const u32x4*)(KN + (size_t)(t0 + row) * DM + h * HD + 8 * c8), qv = *(const u32x4*)(QN + (size_t)(t0 + row) * DM + h * HD + 8 * c8);
            LAS float* kd = Kc + row * 132 + 8 * c8; LAS float* qd = Qc + row * 132 + 8 * c8;
            kd[0] = bflo(kv.x); kd[1] = bfhi(kv.x); kd[2] = bflo(kv.y); kd[3] = bfhi(kv.y); kd[4] = bflo(kv.z); kd[5] = bfhi(kv.z); kd[6] = bflo(kv.w); kd[7] = bfhi(kv.w);
            qd[0] = bflo(qv.x); qd[1] = bfhi(qv.x); qd[2] = bflo(qv.y); qd[3] = bfhi(qv.y); qd[4] = bflo(qv.z); qd[5] = bfhi(qv.z); qd[6] = bflo(qv.w); qd[7] = bfhi(qv.w); }
        __syncthreads();
        if (tid < 64) { GC[(size_t)(t0 + tid) * 8 + h] = gcs[tid]; bge[tid] = bes[tid] * expf(gcs[tid]); }
        for (int r = 0; r < 8; ++r) { const int p = tid + 512 * r, i = p >> 6, j = p & 63;
            float dk = 0.f, dq = 0.f;
            if (j <= i) { const LAS float* ki = Kc + i * 132; const LAS float* kj = Kc + j * 132; const LAS float* qi = Qc + i * 132;
                for (int d = 0; d < HD; ++d) { dk += ki[d] * kj[d]; dq += qi[d] * kj[d]; } }
            const float dec = (j <= i) ? expf(gcs[i] - gcs[j]) : 0.f;
            Lm[i * 65 + j] = (j < i) ? bes[i] * dk * dec : 0.f;
            ATT[((size_t)(h * NCH + n) * 64 + i) * 64 + j] = (bf16)f2bf((j <= i) ? dq * dec : 0.f); }
        __syncthreads();
        if (tid < 64) { const int c = tid;
            for (int i = 0; i < 64; ++i) { float acc = (i == c) ? 1.f : 0.f; for (int j = 0; j < i; ++j) acc -= Lm[i * 65 + j] * Tm[j * 65 + c]; Tm[i * 65 + c] = acc; } }
        __syncthreads();
#pragma unroll
        for (int r = 0; r < 2; ++r) { const int idx = tid + 512 * r, row = idx >> 4, c8 = idx & 15;
            const u32x4 vv = *(const u32x4*)(VU + (size_t)(t0 + row) * DM + h * HD + 8 * c8); LAS float* vd = Qc + row * 132 + 8 * c8;
            vd[0] = bflo(vv.x); vd[1] = bfhi(vv.x); vd[2] = bflo(vv.y); vd[3] = bfhi(vv.y); vd[4] = bflo(vv.z); vd[5] = bfhi(vv.z); vd[6] = bflo(vv.w); vd[7] = bfhi(vv.w); }
        __syncthreads();
        { const int d = tid & 127, ig = tid >> 7;
          for (int ii = 0; ii < 16; ++ii) { const int i = ig * 16 + ii; float au = 0.f, aw = 0.f;
              for (int j = 0; j <= i; ++j) { const float t = Tm[i * 65 + j]; au += t * bes[j] * Qc[j * 132 + d]; aw += t * bge[j] * Kc[j * 132 + d]; }
              VU[(size_t)(t0 + i) * DM + h * HD + d] = (bf16)f2bf(au); Wb[(size_t)(t0 + i) * DM + h * HD + d] = (bf16)f2bf(aw); } }
    }
    __syncthreads();
}
__device__ __forceinline__ void p_dn_scan_naive(Frame& F, const Args& A) {
    if (blockIdx.x < 4) {
    const bf16* QN = (const bf16*)F.out; const bf16* KN = (const bf16*)F.out + (size_t)S * DM; const bf16* U = WSP(const bf16, WS_VN); const bf16* Wb = WSP(const bf16, WS_W); const bf16* ATT = WSP(const bf16, WS_ATT);
    const float* GC = WSP(const float, WS_GC); bf16* O = WSP(bf16, WS_O);
    LAS float* vn = (LAS float*)F.lds;
    const int tid = F.tid, wv = tid >> 6, h = blockIdx.x * 2 + (wv >> 2), e = (wv & 3) * 32 + (F.lane & 31), half = F.lane >> 5;
    float s[64];
#pragma unroll
    for (int d = 0; d < 64; ++d) s[d] = 0.f;
    for (int n = 0; n < NCH; ++n) { const int t0 = n * CH; const float gl = GC[(size_t)(t0 + 63) * 8 + h];
        for (int c = 0; c < 64; ++c) { const size_t ro = (size_t)(t0 + c) * DM + h * HD; const bf16* wp = Wb + ro + 64 * half; float a = 0.f;
#pragma unroll
            for (int d8 = 0; d8 < 8; ++d8) { if ((d8 & 1) == 0) asm volatile("" ::: "memory"); const u32x4 wv4 = *(const u32x4*)(wp + 8 * d8);
                a += bflo(wv4.x) * s[8 * d8] + bfhi(wv4.x) * s[8 * d8 + 1] + bflo(wv4.y) * s[8 * d8 + 2] + bfhi(wv4.y) * s[8 * d8 + 3] + bflo(wv4.z) * s[8 * d8 + 4] + bfhi(wv4.z) * s[8 * d8 + 5] + bflo(wv4.w) * s[8 * d8 + 6] + bfhi(wv4.w) * s[8 * d8 + 7]; }
            a += __shfl_xor(a, 32);
            vn[c * 512 + tid] = bf2f(U[ro + e]) - a; }
        for (int c = 0; c < 64; ++c) { const size_t ro = (size_t)(t0 + c) * DM + h * HD; const bf16* qp = QN + ro + 64 * half; float a = 0.f;
#pragma unroll
            for (int d8 = 0; d8 < 8; ++d8) { if ((d8 & 1) == 0) asm volatile("" ::: "memory"); const u32x4 wv4 = *(const u32x4*)(qp + 8 * d8);
                a += bflo(wv4.x) * s[8 * d8] + bfhi(wv4.x) * s[8 * d8 + 1] + bflo(wv4.y) * s[8 * d8 + 2] + bfhi(wv4.y) * s[8 * d8 + 3] + bflo(wv4.z) * s[8 * d8 + 4] + bfhi(wv4.z) * s[8 * d8 + 5] + bflo(wv4.w) * s[8 * d8 + 6] + bfhi(wv4.w) * s[8 * d8 + 7]; }
            a += __shfl_xor(a, 32);
            a *= expf(GC[(size_t)(t0 + c) * 8 + h]);
            const bf16* ap = ATT + ((size_t)(h * NCH + n) * 64 + c) * 64; float b = 0.f;
            for (int j = 0; j <= c; ++j) b += bf2f(ap[j]) * vn[j * 512 + tid];
            if (half == 0) O[ro + e] = (bf16)f2bf(a + b); }
        const float egl = expf(gl);
#pragma unroll
        for (int d = 0; d < 64; ++d) s[d] *= egl;
        for (int c = 0; c < 64; ++c) { const size_t ro = (size_t)(t0 + c) * DM + h * HD; const bf16* kp = KN + ro + 64 * half; const float f = vn[c * 512 + tid] * expf(gl - GC[(size_t)(t0 + c) * 8 + h]);
#pragma unroll
            for (int d8 = 0; d8 < 8; ++d8) { if ((d8 & 1) == 0) asm volatile("" ::: "memory"); const u32x4 wv4 = *(const u32x4*)(kp + 8 * d8);
                s[8 * d8] += f * bflo(wv4.x); s[8 * d8 + 1] += f * bfhi(wv4.x); s[8 * d8 + 2] += f * bflo(wv4.y); s[8 * d8 + 3] += f * bfhi(wv4.y); s[8 * d8 + 4] += f * bflo(wv4.z); s[8 * d8 + 5] += f * bfhi(wv4.z); s[8 * d8 + 6] += f * bflo(wv4.w); s[8 * d8 + 7] += f * bfhi(wv4.w); } }
    }
    }
}
__device__ __forceinline__ void p_dn_out(Frame& F, const Args& A) {
    const bf16* O = WSP(const bf16, WS_O); const bf16* Z = WSP(const bf16, WS_Z); bf16* YD = WSP(bf16, WS_YD); const float* ow = A.in[6];
    for (int it = F.gw; it < S * NH; it += F.NGW) { const int t = it >> 3, h = it & 7; const size_t off = (size_t)t * DM + h * HD + 2 * F.lane;
        const unsigned ov = *(const unsigned*)(O + off), zv = *(const unsigned*)(Z + off); const float o0 = bflo(ov), o1 = bfhi(ov);
        const float rs = rsq_(wave_sum(o0 * o0 + o1 * o1) * (1.f / HD) + EPS);
        *(unsigned*)(YD + off) = pk2(o0 * rs * ow[2 * F.lane] * siluf_(bflo(zv)), o1 * rs * ow[2 * F.lane + 1] * siluf_(bfhi(zv))); }
}


constexpr size_t WS_UT = WS_O;
constexpr size_t WS_KT = WS_VN;
constexpr size_t WS_EGL = WS_KMEAN;
typedef float f32x4_t __attribute__((ext_vector_type(4)));

__device__ __forceinline__ void p_dn_relayout1(Frame& F, const Args& A) {
    bf16* QN = (bf16*)F.out; bf16* Wb = WSP(bf16, WS_W); const bf16* U = WSP(const bf16, WS_VN); bf16* UT = WSP(bf16, WS_UT); const float* GC = WSP(const float, WS_GC); float* EGL = WSP(float, WS_EGL);
    LAS unsigned short* tile = (LAS unsigned short*)(F.lds + F.wave * 16640);
    for (int it = F.gw; it < NCH * NH; it += F.NGW) { const int n = it >> 3, h = it & 7, t0 = n * CH;
        if (F.lane == 0) EGL[h * NCH + n] = expf(GC[(size_t)(t0 + 63) * 8 + h]);
        for (int c = 0; c < 64; ++c) { const size_t off = (size_t)(t0 + c) * DM + h * HD + 2 * F.lane; const float eg = expf(GC[(size_t)(t0 + c) * 8 + h]);
            const unsigned qv = *(const unsigned*)(QN + off); *(unsigned*)(QN + off) = pk2(bflo(qv) * eg, bfhi(qv) * eg);
            const unsigned wv = *(const unsigned*)(Wb + off); *(unsigned*)(Wb + off) = wv ^ 0x80008000u;
            const unsigned uv = *(const unsigned*)(U + off); *(LAS unsigned*)(tile + c * 130 + 2 * F.lane) = uv; }
        asm volatile("s_waitcnt lgkmcnt(0)" ::: "memory");
        bf16* ut = UT + (size_t)(h * NCH + n) * (HD * CH);
        for (int e = 0; e < HD; ++e) ut[e * CH + F.lane] = tile[F.lane * 130 + e];
        asm volatile("s_waitcnt lgkmcnt(0)" ::: "memory");
    }
}
__device__ __forceinline__ void p_dn_relayout2(Frame& F, const Args& A) {
    const bf16* KN = (const bf16*)F.out + (size_t)S * DM; bf16* KT = WSP(bf16, WS_KT); const float* GC = WSP(const float, WS_GC);
    LAS unsigned short* tile = (LAS unsigned short*)(F.lds + F.wave * 16640);
    for (int it = F.gw; it < NCH * NH; it += F.NGW) { const int n = it >> 3, h = it & 7, t0 = n * CH;
        for (int c = 0; c < 64; ++c) { const size_t off = (size_t)(t0 + c) * DM + h * HD + 2 * F.lane; *(LAS unsigned*)(tile + c * 130 + 2 * F.lane) = *(const unsigned*)(KN + off); }
        asm volatile("s_waitcnt lgkmcnt(0)" ::: "memory");
        const float f = expf(GC[(size_t)(t0 + 63) * 8 + h] - GC[(size_t)(t0 + F.lane) * 8 + h]);
        bf16* kt = KT + (size_t)(h * NCH + n) * (HD * CH);
        for (int d = 0; d < HD; ++d) kt[d * CH + F.lane] = (bf16)f2bf(bf2f(tile[F.lane * 130 + d]) * f);
        asm volatile("s_waitcnt lgkmcnt(0)" ::: "memory");
    }
}

constexpr size_t WS2_QN = WS_R1, WS2_KN = WS_R1 + T32, WS2_WNEG = WS_R1 + 2 * T32, WS2_ATT = WS_H, WS2_YD = WS_R1 + 2 * T32, WS2_HALT = WS_R1 + T32;
__device__ __forceinline__ bf16* ws2_kt(Frame& F) { return (bf16*)F.out; }
__device__ __forceinline__ bf16* ws2_ut(Frame& F) { return (bf16*)F.out + (size_t)S * DM; }

struct ConvHalo { unsigned q[3], k[3], v[3]; };
constexpr size_t WS_HALO = 241 * MiB;
__device__ __forceinline__ void p_dn_conv2_halo(Frame& F, ConvHalo& H) {
    const bf16* HB = WSP(const bf16, WS_HALO);
    const int n = F.gw >> 3, h = F.gw & 7, col = h * HD + 2 * F.lane;
#pragma unroll
    for (int j = 0; j < 3; ++j) { H.q[j] = H.k[j] = H.v[j] = 0u;
        if (n > 0 && F.gw < NCH * NH) { const bf16* hp = HB + ((size_t)(n - 1) * 3 + j) * 3072 + col; H.q[j] = *(const unsigned*)hp; H.k[j] = *(const unsigned*)(hp + 1024); H.v[j] = *(const unsigned*)(hp + 2048); } }
}
struct ConvW { float w0[4], w1[4]; };
__device__ __forceinline__ void conv_w(const float* cw, int col, ConvW& W) {
#pragma unroll
    for (int j = 0; j < 4; ++j) { W.w0[j] = cw[(size_t)j * 3072 + col]; W.w1[j] = cw[(size_t)j * 3072 + col + 1]; }
}
__device__ __forceinline__ __amdgpu_buffer_rsrc_t mk_rsrc(const void* p) { return __builtin_amdgcn_make_buffer_rsrc((void*)p, 0, 0x7fffffff, 0x00020000); }
__device__ __forceinline__ void conv_load(const bf16* src, int t0, int col, unsigned (&xall)[CH]) {
    const __amdgpu_buffer_rsrc_t r = mk_rsrc(src + (size_t)t0 * DM);
#pragma unroll
    for (int c = 0; c < CH; ++c) xall[c] = __builtin_amdgcn_raw_buffer_load_b32(r, 2 * col, c * (DM * 2), 0);
}
template <bool NORM, bool DST, bool TILE> __device__ __forceinline__ void conv_pass(const unsigned (&xall)[CH], bf16* dst, LAS unsigned short* tile, const ConvW& W, const unsigned (&halo)[3], int t0, int col, int lane, float scale) {
    float a0 = bflo(halo[0]), a1 = bfhi(halo[0]), b0 = bflo(halo[1]), b1 = bfhi(halo[1]), c0 = bflo(halo[2]), c1 = bfhi(halo[2]);
    const __amdgpu_buffer_rsrc_t rd = mk_rsrc(DST ? dst + (size_t)t0 * DM : nullptr);
#pragma unroll
    for (int c = 0; c < CH; ++c) { const unsigned xv = xall[c]; const float d0 = bflo(xv), d1 = bfhi(xv);
        float y0 = siluf_(W.w0[0] * a0 + W.w0[1] * b0 + W.w0[2] * c0 + W.w0[3] * d0), y1 = siluf_(W.w1[0] * a1 + W.w1[1] * b1 + W.w1[2] * c1 + W.w1[3] * d1);
        if (NORM) { const float rs = scale * rsq_(wave_sum(y0 * y0 + y1 * y1) + EPS); y0 *= rs; y1 *= rs; }
        const unsigned o = pk2(y0, y1);
        if (DST) __builtin_amdgcn_raw_buffer_store_b32(o, rd, 2 * col, c * (DM * 2), 0);
        if (TILE) *(LAS unsigned*)(tile + c * 130 + 2 * lane) = o;
        a0 = b0; a1 = b1; b0 = c0; b1 = c1; c0 = d0; c1 = d1; }
}
__device__ __forceinline__ void conv_tile_out(const LAS unsigned short* tile, bf16* dstT, int lane) {
#pragma unroll 4
    for (int i = 0; i < 16; ++i) { const int d = 8 * i + (lane >> 3), ch = lane & 7; const LAS unsigned short* tp = tile + (8 * ch) * 130 + d;
        u32x4 w; w.x = (unsigned)tp[0] | ((unsigned)tp[130] << 16); w.y = (unsigned)tp[260] | ((unsigned)tp[390] << 16); w.z = (unsigned)tp[520] | ((unsigned)tp[650] << 16); w.w = (unsigned)tp[780] | ((unsigned)tp[910] << 16);
        *(u32x4*)(dstT + (size_t)d * CH + 8 * ch) = w; }
}
__device__ __forceinline__ void p_dn_conv2(Frame& F, const Args& A, const ConvHalo& H) {
    if (F.gw >= NCH * NH) return;
    bf16* QB = WSP(bf16, WS_R1); bf16* KB = WSP(bf16, WS_R1 + T32); const bf16* VB = WSP(bf16, WS_R1 + 2 * T32); const float* cw = A.in[3];
    LAS unsigned short* tile = (LAS unsigned short*)(F.lds + F.wave * 16640);
    const int n = F.gw >> 3, h = F.gw & 7, t0 = n * CH, col = h * HD + 2 * F.lane;
    bf16* ktr = ws2_kt(F) + (size_t)(h * NCH + n) * (HD * CH); bf16* vt = ws2_ut(F) + (size_t)(h * NCH + n) * (HD * CH);
    unsigned xa[CH]; ConvW W;
    conv_load(KB, t0, col, xa); conv_w(cw + 1024, col, W);
    conv_pass<true, true, true>(xa, KB, tile, W, H.k, t0, col, F.lane, 1.f);
    asm volatile("s_waitcnt lgkmcnt(0)" ::: "memory");
    conv_load(VB, t0, col, xa); conv_w(cw + 2048, col, W);
    __builtin_amdgcn_sched_barrier(0);
    conv_tile_out(tile, ktr, F.lane);
    asm volatile("s_waitcnt lgkmcnt(0)" ::: "memory");
    conv_pass<false, false, true>(xa, nullptr, tile, W, H.v, t0, col, F.lane, 1.f);
    asm volatile("s_waitcnt lgkmcnt(0)" ::: "memory");
    conv_load(QB, t0, col, xa); conv_w(cw, col, W);
    __builtin_amdgcn_sched_barrier(0);
    conv_tile_out(tile, vt, F.lane);
    asm volatile("s_waitcnt lgkmcnt(0)" ::: "memory");
    conv_pass<true, true, false>(xa, QB, tile, W, H.q, t0, col, F.lane, 0.08838834764831845f);
}

constexpr int CK_WAVE_LDS = 19200;
__device__ __forceinline__ void p_dn_chunk2(Frame& F, const Args& A) {
    if (F.gw >= NCH * NH) return;
    const int n = F.gw >> 3, h = F.gw & 7, t0 = n * CH, lane = F.lane, r = lane & 31, hh = lane >> 5;
    bf16* QN = WSP(bf16, WS2_QN); const bf16* KN = WSP(const bf16, WS2_KN); bf16* Wn = WSP(bf16, WS2_WNEG); bf16* ATT = WSP(bf16, WS2_ATT) + (size_t)(h * NCH + n) * (CH * CH);
    bf16* KT = ws2_kt(F) + (size_t)(h * NCH + n) * (HD * CH); bf16* UT = ws2_ut(F) + (size_t)(h * NCH + n) * (HD * CH);
    const float* BA = WSP(const float, WS_BA); float* EGL = WSP(float, WS_EGL);
    LAS unsigned char* wl = F.lds + F.wave * CK_WAVE_LDS; LAS float* Lw = (LAS float*)wl; LAS float* gcs = (LAS float*)(wl + 18432); LAS float* bes = gcs + 64; LAS float* fcs = bes + 64;
    float beta, gc, gl;
    { const int t = t0 + lane; const float b = BA[(size_t)t * 16 + h], a = BA[(size_t)t * 16 + 8 + h] + A.in[5][h];
      const float sp = (a > 20.f) ? a : log1pf(expf(a)); gc = -expf(A.in[4][h]) * sp; beta = 1.f / (1.f + expf(-b));
#pragma unroll
      for (int o = 1; o < 64; o <<= 1) { const float v = __shfl_up(gc, o); if (lane >= o) gc += v; }
      gl = __shfl(gc, 63);
      gcs[lane] = gc; bes[lane] = beta; fcs[lane] = expf(gl - gc);
      if (lane == 0) EGL[h * NCH + n] = expf(gl); }
    asm volatile("s_waitcnt lgkmcnt(0)" ::: "memory");
    {
        bf16x8 kf[2][8];
#pragma unroll
        for (int ti = 0; ti < 2; ++ti)
#pragma unroll
            for (int ks = 0; ks < 8; ++ks) kf[ti][ks] = *(const bf16x8*)(KN + (size_t)(t0 + 32 * ti + r) * DM + h * HD + 16 * ks + 8 * hh);
#pragma unroll
        for (int tt = 0; tt < 3; ++tt) { const int ti = (tt == 0) ? 0 : 1, tj = (tt == 2) ? 1 : 0;
            f32x16 acc;
#pragma unroll
            for (int i = 0; i < 16; ++i) acc[i] = 0.f;
#pragma unroll
            for (int ks = 0; ks < 8; ++ks) acc = __builtin_amdgcn_mfma_f32_32x32x16_bf16(kf[ti][ks], kf[tj][ks], acc, 0, 0, 0);
            const int j = 32 * tj + r; const float gcj = gcs[j];
#pragma unroll
            for (int g4 = 0; g4 < 4; ++g4) { const int i0 = 32 * ti + 8 * g4 + 4 * hh; const f32x4 gi = *(const LAS f32x4*)(gcs + i0), bi = *(const LAS f32x4*)(bes + i0);
#pragma unroll
                for (int e = 0; e < 4; ++e) { const int i = i0 + e; Lw[i * 68 + j] = (j < i) ? bi[e] * acc[4 * g4 + e] * __expf(gi[e] - gcj) : 0.f; } } }
        bf16x8 qf[2][8];
#pragma unroll
        for (int ti = 0; ti < 2; ++ti)
#pragma unroll
            for (int ks = 0; ks < 8; ++ks) qf[ti][ks] = *(const bf16x8*)(QN + (size_t)(t0 + 32 * ti + r) * DM + h * HD + 16 * ks + 8 * hh);
#pragma unroll
        for (int tt = 0; tt < 3; ++tt) { const int tj = (tt == 2) ? 1 : 0, ti = (tt == 0) ? 0 : 1;
            f32x16 acc;
#pragma unroll
            for (int i = 0; i < 16; ++i) acc[i] = 0.f;
#pragma unroll
            for (int ks = 0; ks < 8; ++ks) acc = __builtin_amdgcn_mfma_f32_32x32x16_bf16(kf[tj][ks], qf[ti][ks], acc, 0, 0, 0);
            const int i = 32 * ti + r; const float gci = gcs[i];
#pragma unroll
            for (int g4 = 0; g4 < 4; ++g4) { const int j0 = 32 * tj + 8 * g4 + 4 * hh; const f32x4 gj = *(const LAS f32x4*)(gcs + j0); float v[4];
#pragma unroll
                for (int e = 0; e < 4; ++e) v[e] = (j0 + e <= i) ? acc[4 * g4 + e] * __expf(gci - gj[e]) : 0.f;
                u32x2 w; w.x = cvtpk(v[0], v[1]); w.y = cvtpk(v[2], v[3]); *(u32x2*)(ATT + (size_t)i * CH + 32 * tj + 16 * (g4 & 1) + 8 * hh + 4 * (g4 >> 1)) = w; } }
        { const u32x4 z4 = {0u, 0u, 0u, 0u}; const int zi = lane >> 1, zj = 32 + 16 * (lane & 1); *(u32x4*)(ATT + (size_t)zi * CH + zj) = z4; *(u32x4*)(ATT + (size_t)zi * CH + zj + 8) = z4; }
#pragma unroll
        for (int ti = 0; ti < 2; ++ti) { const float eg = __expf(gcs[32 * ti + r]);
#pragma unroll
            for (int ks = 0; ks < 8; ++ks) { float f[8]; unpack8f(qf[ti][ks], f);
#pragma unroll
                for (int e = 0; e < 8; ++e) f[e] *= eg;
                const u32x4 pw = __builtin_bit_cast(u32x4, pack8f(f)); bf16* qd = QN + (size_t)(t0 + 32 * ti + r) * DM + h * HD + 32 * (ks >> 1) + 16 * hh + 4 * (ks & 1);
                u32x2 p0, p1; p0.x = pw.x; p0.y = pw.y; p1.x = pw.z; p1.y = pw.w; *(u32x2*)qd = p0; *(u32x2*)(qd + 8) = p1; } }
    }
    asm volatile("s_waitcnt lgkmcnt(0)" ::: "memory");
    float T[64];
#pragma unroll
    for (int i = 0; i < 64; ++i) { float acc = (lane == i) ? 1.f : 0.f;
#pragma unroll
        for (int j = 0; j < i; ++j) acc -= Lw[i * 68 + j] * T[j];
        T[i] = acc; }
    LAS unsigned short* Tb = (LAS unsigned short*)wl; LAS unsigned short* Tbg = Tb + 64 * 72;
    { const float eg = __expf(gc);
      asm volatile("s_waitcnt lgkmcnt(0)" ::: "memory");
#pragma unroll
      for (int i = 0; i < 64; ++i) { const float v = T[i] * beta; Tb[i * 72 + lane] = (unsigned short)f2bf(v); Tbg[i * 72 + lane] = (unsigned short)f2bf(v * eg); } }
    asm volatile("s_waitcnt lgkmcnt(0)" ::: "memory");
#ifdef DBG_CHK
    if (n < 128) { bf16* dump = WSP(bf16, 241 * MiB) + (size_t)(h * 128 + n) * 4096; for (int i = 0; i < 64; ++i) dump[i * 64 + lane] = Tbg[i * 72 + lane]; }
#endif
#ifdef DBG_CHK
    if (n < 32) { bf16* dk = WSP(bf16, 249 * MiB) + (size_t)(h * 32 + n) * 8192; for (int x = 0; x < 128; ++x) dk[x * 64 + lane] = KT[(size_t)x * CH + lane]; }
#endif
#ifdef DN2_VALU_UW
    for (int e = 0; e < HD; ++e) { float a = 0.f; for (int j2 = 0; j2 < 64; ++j2) a += bf2f(Tb[lane * 72 + j2]) * bf2f(UT[(size_t)e * CH + j2]); asm volatile("s_waitcnt vmcnt(0)" ::: "memory"); UT[(size_t)e * CH + lane] = (bf16)f2bf(a); asm volatile("s_waitcnt vmcnt(0)" ::: "memory"); }
    for (int d2 = 0; d2 < HD; ++d2) { float a = 0.f; for (int j2 = 0; j2 < 64; ++j2) a += bf2f(Tbg[lane * 72 + j2]) * bf2f(KT[(size_t)d2 * CH + j2]); Wn[(size_t)(t0 + lane) * DM + h * HD + d2] = (bf16)f2bf(-a); }
#else
#pragma unroll
    for (int te = 0; te < 4; ++te) { bf16x8 vfr[4];
#pragma unroll
        for (int ks2 = 0; ks2 < 4; ++ks2) vfr[ks2] = *(const bf16x8*)(UT + (size_t)(32 * te + r) * CH + 16 * ks2 + 8 * hh);
#pragma unroll
        for (int ti = 0; ti < 2; ++ti) { f32x16 acc;
#pragma unroll
            for (int i = 0; i < 16; ++i) acc[i] = 0.f;
#pragma unroll
            for (int ks2 = 0; ks2 < 4; ++ks2) if (ti == 1 || ks2 < 2) { const bf16x8 tb = *(const LAS bf16x8*)(Tb + (32 * ti + r) * 72 + 16 * ks2 + 8 * hh); acc = __builtin_amdgcn_mfma_f32_32x32x16_bf16(tb, vfr[ks2], acc, 0, 0, 0); }
#pragma unroll
            for (int g4 = 0; g4 < 4; ++g4) { u32x2 w; w.x = cvtpk(acc[4 * g4], acc[4 * g4 + 1]); w.y = cvtpk(acc[4 * g4 + 2], acc[4 * g4 + 3]); *(u32x2*)(UT + (size_t)(32 * te + r) * CH + 32 * ti + 8 * g4 + 4 * hh) = w; } } }
    f32x4 fsc[4][2];
#pragma unroll
    for (int ks2 = 0; ks2 < 4; ++ks2) { fsc[ks2][0] = *(const LAS f32x4*)(fcs + 16 * ks2 + 8 * hh); fsc[ks2][1] = *(const LAS f32x4*)(fcs + 16 * ks2 + 8 * hh + 4); }
#pragma unroll
    for (int td = 0; td < 4; ++td) { bf16x8 kfr[4];
#pragma unroll
        for (int ks2 = 0; ks2 < 4; ++ks2) kfr[ks2] = *(const bf16x8*)(KT + (size_t)(32 * td + r) * CH + 16 * ks2 + 8 * hh);
#pragma unroll
        for (int tc = 0; tc < 2; ++tc) { f32x16 acc;
#pragma unroll
            for (int i = 0; i < 16; ++i) acc[i] = 0.f;
#pragma unroll
            for (int ks2 = 0; ks2 < 4; ++ks2) if (tc == 1 || ks2 < 2) { const bf16x8 tg = *(const LAS bf16x8*)(Tbg + (32 * tc + r) * 72 + 16 * ks2 + 8 * hh); acc = __builtin_amdgcn_mfma_f32_32x32x16_bf16(kfr[ks2], tg, acc, 0, 0, 0); }
#pragma unroll
            for (int g4 = 0; g4 < 4; ++g4) { u32x2 w; w.x = cvtpk(-acc[4 * g4], -acc[4 * g4 + 1]); w.y = cvtpk(-acc[4 * g4 + 2], -acc[4 * g4 + 3]);
                *(u32x2*)(Wn + (size_t)(t0 + 32 * tc + r) * DM + h * HD + 32 * td + 16 * (g4 & 1) + 8 * hh + 4 * (g4 >> 1)) = w; } }
#pragma unroll
        for (int ks2 = 0; ks2 < 4; ++ks2) { float f[8]; unpack8f(kfr[ks2], f); const f32x4 f0 = fsc[ks2][0], f1 = fsc[ks2][1];
            f[0] *= f0[0]; f[1] *= f0[1]; f[2] *= f0[2]; f[3] *= f0[3]; f[4] *= f1[0]; f[5] *= f1[1]; f[6] *= f1[2]; f[7] *= f1[3];
            const u32x4 pw = __builtin_bit_cast(u32x4, pack8f(f)); const int ch = 2 * ks2 + hh; bf16* kd = KT + (size_t)(32 * td + r) * CH + 32 * (ch >> 2) + 16 * (ch & 1) + 4 * ((ch >> 1) & 1);
            u32x2 p0, p1; p0.x = pw.x; p0.y = pw.y; p1.x = pw.z; p1.y = pw.w; *(u32x2*)kd = p0; *(u32x2*)(kd + 8) = p1; } }
#endif
}

#ifndef DN2
#define DN2 1
#endif
#if DN2
#define SCAN_WNEG WS2_WNEG
#define SCAN_QP WSP(const bf16, WS2_QN)
#define SCAN_KT ws2_kt(F)
#define SCAN_UT ws2_ut(F)
#define SCAN_ATT WS2_ATT
#define SCAN_YD WS2_YD
#else
#define SCAN_WNEG WS_W
#define SCAN_QP ((const bf16*)F.out)
#define SCAN_KT WSP(bf16, WS_KT)
#define SCAN_UT WSP(bf16, WS_UT)
#define SCAN_ATT WS_ATT
#define SCAN_YD WS_YD
#endif
constexpr int SC_RW = 288, SC_RK = 160;
constexpr int SC_W = 0, SC_Q = 64 * SC_RW, SC_K = 2 * 64 * SC_RW, SC_A = SC_K + 128 * SC_RK, SC_BUF = SC_A + 64 * SC_RK;
__device__ __forceinline__ bf16x8 frag2(const LAS unsigned char* p) {
    const u32x2 a = *(const LAS u32x2*)p, b = *(const LAS u32x2*)(p + 32); u32x4 w; w.x = a.x; w.y = a.y; w.z = b.x; w.w = b.y; return __builtin_bit_cast(bf16x8, w);
}
__device__ __forceinline__ bf16x8 packb(const f32x4_t a, const f32x4_t b) { u32x4 w; w.x = cvtpk(a[0], a[1]); w.y = cvtpk(a[2], a[3]); w.z = cvtpk(b[0], b[1]); w.w = cvtpk(b[2], b[3]); return __builtin_bit_cast(bf16x8, w); }
constexpr int SCAN_WGS = 16;
__device__ __forceinline__ void p_dn_scan_fast(Frame& F, const Args& A) {
    if (blockIdx.x < SCAN_WGS) {
    const int h = blockIdx.x >> 1, hf = blockIdx.x & 1;
    const bf16* Wb = WSP(const bf16, SCAN_WNEG); const bf16* QP = SCAN_QP; const bf16* KT = SCAN_KT; const bf16* ATT = WSP(const bf16, SCAN_ATT); bf16* UT = SCAN_UT; const float* EGL = WSP(const float, WS_EGL);
    if (F.wave >= 4) {
        const int lt = F.tid - 256;
#if defined(SCAN_PROBE) && SCAN_PROBE == 2
        unsigned long long lp_sum = 0ull, lp_t0 = 0ull;
#define SCP_T0() (lp_t0 = __builtin_amdgcn_s_memrealtime())
#define SCP_T1() (lp_sum += __builtin_amdgcn_s_memrealtime() - lp_t0)
#else
#define SCP_T0() ((void)0)
#define SCP_T1() ((void)0)
#endif
        u32x4 rwA[4], rqA[4], rkA[4], raA[2], rwB[4], rqB[4], rkB[4], raB[2], rwC[4], rqC[4], rkC[4], raC[2];
#define SC_GLD(dst, voff, sbase) asm volatile("global_load_dwordx4 %0, %1, %2" : "=v"(dst) : "v"(voff), "s"(sbase) : "memory")
        const unsigned vo_w = (unsigned)((lt >> 4) * (DM * 2) + (lt & 15) * 16), vo_t = (unsigned)lt * 16u;
#define SC_ISSUE(n_, X) do { const bf16* bw_ = Wb + (size_t)((n_) * CH) * DM + h * HD; const bf16* bq_ = QP + (size_t)((n_) * CH) * DM + h * HD; \
            const bf16* bk_ = KT + (size_t)(h * NCH + (n_)) * (HD * CH); const bf16* ba_ = ATT + (size_t)(h * NCH + (n_)) * (CH * CH); \
            _Pragma("unroll") for (int i = 0; i < 4; ++i) { SC_GLD(rw##X[i], vo_w + (unsigned)i * (16u * DM * 2u), bw_); SC_GLD(rq##X[i], vo_w + (unsigned)i * (16u * DM * 2u), bq_); } \
            _Pragma("unroll") for (int i = 0; i < 4; ++i) { SC_GLD(rk##X[i], vo_t + (unsigned)i * 4096u, bk_); } \
            _Pragma("unroll") for (int i = 0; i < 2; ++i) { SC_GLD(ra##X[i], vo_t + (unsigned)i * 4096u, ba_); } } while (0)
#define SC_WAIT(N, X) asm volatile("s_waitcnt vmcnt(" #N ")" : "+v"(rw##X[0]), "+v"(rw##X[1]), "+v"(rw##X[2]), "+v"(rw##X[3]), "+v"(rq##X[0]), "+v"(rq##X[1]), "+v"(rq##X[2]), "+v"(rq##X[3]), \
            "+v"(rk##X[0]), "+v"(rk##X[1]), "+v"(rk##X[2]), "+v"(rk##X[3]), "+v"(ra##X[0]), "+v"(ra##X[1]) :: "memory")
#define SC_PUT(buf_, X) do { LAS unsigned char* b_ = F.lds + (buf_) * SC_BUF; \
            _Pragma("unroll") for (int i = 0; i < 4; ++i) { const int idx = lt + 256 * i, row = idx >> 4, ch = idx & 15; *(LAS u32x4*)(b_ + SC_W + row * SC_RW + 16 * ch) = rw##X[i]; *(LAS u32x4*)(b_ + SC_Q + row * SC_RW + 16 * ch) = rq##X[i]; } \
            _Pragma("unroll") for (int i = 0; i < 4; ++i) { const int idx = lt + 256 * i, row = idx >> 3, ch = idx & 7; *(LAS u32x4*)(b_ + SC_K + row * SC_RK + 16 * ch) = rk##X[i]; } \
            _Pragma("unroll") for (int i = 0; i < 2; ++i) { const int idx = lt + 256 * i, row = idx >> 3, ch = idx & 7; *(LAS u32x4*)(b_ + SC_A + row * SC_RK + 16 * ch) = ra##X[i]; } } while (0)
#define SC_STEP(n_, X) do { SCP_T0(); if ((n_) + 1 < NCH) { if ((n_) + 3 < NCH) SC_WAIT(28, X); else if ((n_) + 2 < NCH) SC_WAIT(14, X); else SC_WAIT(0, X); \
                SC_PUT(((n_) + 1) & 1, X); if ((n_) + 4 < NCH) SC_ISSUE((n_) + 4, X); } \
            asm volatile("s_waitcnt lgkmcnt(0)" ::: "memory"); SCP_T1(); __builtin_amdgcn_s_barrier(); } while (0)
        SC_ISSUE(0, A); SC_WAIT(0, A); SC_PUT(0, A);
        asm volatile("s_waitcnt lgkmcnt(0)" ::: "memory");
        __builtin_amdgcn_s_barrier();
        SC_ISSUE(1, A); SC_ISSUE(2, B); SC_ISSUE(3, C);
        for (int n = 0; n < NCH; n += 3) {
            SC_STEP(n, A);
            if (n + 1 < NCH) SC_STEP(n + 1, B);
            if (n + 2 < NCH) SC_STEP(n + 2, C);
        }
#if defined(SCAN_PROBE) && SCAN_PROBE == 2
        if (blockIdx.x == 0 && F.tid == 256) F.MISC[16] = (unsigned)lp_sum;
#endif
    } else {
        const int r = F.lane & 15, g = F.lane >> 4, e0 = (hf * 4 + F.wave) * 16;
        f32x4_t sacc[8];
#pragma unroll
        for (int i = 0; i < 8; ++i) sacc[i] = (f32x4_t){0.f, 0.f, 0.f, 0.f};
        bf16* utp = UT + (size_t)h * NCH * (HD * CH) + (size_t)(e0 + r) * CH + 4 * g;
        u32x2 un[4];
#pragma unroll
        for (int ct = 0; ct < 4; ++ct) un[ct] = *(const u32x2*)(utp + 16 * ct);
        float egl = EGL[h * NCH];
        __builtin_amdgcn_s_barrier();
#ifdef SCAN_PROBE
        unsigned long long sp_sum = 0ull;
#endif
        for (int n = 0; n < NCH; ++n) {
#ifdef SCAN_PROBE
            const unsigned long long sp_t0 = __builtin_amdgcn_s_memrealtime();
#endif
            const LAS unsigned char* b = F.lds + (n & 1) * SC_BUF; const LAS unsigned char* lw = b + SC_W + r * SC_RW + 16 * g; const LAS unsigned char* lq = b + SC_Q + r * SC_RW + 16 * g;
            const LAS unsigned char* lk = b + SC_K + r * SC_RK + 16 * g; const LAS unsigned char* la = b + SC_A + r * SC_RK + 16 * g;
            f32x4_t vacc[4], oacc[4]; bf16x8 sb[4], fa[16], fb[16];
#pragma unroll
            for (int ct = 0; ct < 4; ++ct)
#pragma unroll
                for (int kk = 0; kk < 4; ++kk) fa[4 * ct + kk] = *(const LAS bf16x8*)(lw + ct * 16 * SC_RW + kk * 64);
#pragma unroll
            for (int ct = 0; ct < 4; ++ct)
#pragma unroll
                for (int kk = 0; kk < 4; ++kk) fb[4 * ct + kk] = *(const LAS bf16x8*)(lq + ct * 16 * SC_RW + kk * 64);
            __builtin_amdgcn_sched_barrier(0);
#pragma unroll
            for (int kk = 0; kk < 4; ++kk) sb[kk] = packb(sacc[2 * kk], sacc[2 * kk + 1]);
#pragma unroll
            for (int ct = 0; ct < 4; ++ct) { vacc[ct] = (f32x4_t){bflo(un[ct].x), bfhi(un[ct].x), bflo(un[ct].y), bfhi(un[ct].y)}; oacc[ct] = (f32x4_t){0.f, 0.f, 0.f, 0.f}; }
            bf16* utc = utp + (size_t)n * (HD * CH);
            u32x2 unn[4]; float egln = 0.f;
            if (n + 1 < NCH) {
#pragma unroll
                for (int ct = 0; ct < 4; ++ct) unn[ct] = *(const u32x2*)(utc + HD * CH + 16 * ct);
                egln = EGL[h * NCH + n + 1]; }
#pragma unroll
            for (int kk = 0; kk < 4; ++kk)
#pragma unroll
                for (int ct = 0; ct < 4; ++ct) vacc[ct] = __builtin_amdgcn_mfma_f32_16x16x32_bf16(fa[4 * ct + kk], sb[kk], vacc[ct], 0, 0, 0);
            __builtin_amdgcn_sched_barrier(0);
#pragma unroll
            for (int mt = 0; mt < 8; ++mt)
#pragma unroll
                for (int k2 = 0; k2 < 2; ++k2) fa[2 * mt + k2] = *(const LAS bf16x8*)(lk + mt * 16 * SC_RK + k2 * 64);
            __builtin_amdgcn_sched_barrier(0);
#pragma unroll
            for (int kk = 0; kk < 4; ++kk)
#pragma unroll
                for (int ct = 0; ct < 4; ++ct) oacc[ct] = __builtin_amdgcn_mfma_f32_16x16x32_bf16(fb[4 * ct + kk], sb[kk], oacc[ct], 0, 0, 0);
            __builtin_amdgcn_sched_barrier(0);
#pragma unroll
            for (int ct = 0; ct < 4; ++ct)
#pragma unroll
                for (int k2 = 0; k2 < 2; ++k2) if (!(k2 == 1 && ct < 2)) fb[2 * ct + k2] = *(const LAS bf16x8*)(la + ct * 16 * SC_RK + k2 * 64);
            __builtin_amdgcn_sched_barrier(0);
            bf16x8 vb[2];
#pragma unroll
            for (int k2 = 0; k2 < 2; ++k2) vb[k2] = packb(vacc[2 * k2], vacc[2 * k2 + 1]);
#pragma unroll
            for (int mt = 0; mt < 8; ++mt) sacc[mt] = sacc[mt] * egl;
#pragma unroll
            for (int k2 = 0; k2 < 2; ++k2)
#pragma unroll
                for (int mt = 0; mt < 8; ++mt) sacc[mt] = __builtin_amdgcn_mfma_f32_16x16x32_bf16(fa[2 * mt + k2], vb[k2], sacc[mt], 0, 0, 0);
#pragma unroll
            for (int k2 = 0; k2 < 2; ++k2)
#pragma unroll
                for (int ct = 0; ct < 4; ++ct) if (!(k2 == 1 && ct < 2)) oacc[ct] = __builtin_amdgcn_mfma_f32_16x16x32_bf16(fb[2 * ct + k2], vb[k2], oacc[ct], 0, 0, 0);
#pragma unroll
            for (int ct = 0; ct < 4; ++ct) { u32x2 w; w.x = cvtpk(oacc[ct][0], oacc[ct][1]); w.y = cvtpk(oacc[ct][2], oacc[ct][3]); *(u32x2*)(utc + 16 * ct) = w; }
#pragma unroll
            for (int ct = 0; ct < 4; ++ct) un[ct] = unn[ct];
            egl = egln;
            asm volatile("s_waitcnt lgkmcnt(0)" ::: "memory");
#if defined(SCAN_PROBE) && SCAN_PROBE == 1
            asm volatile("s_waitcnt vmcnt(0)" ::: "memory"); sp_sum += __builtin_amdgcn_s_memrealtime() - sp_t0;
#endif
            __builtin_amdgcn_s_barrier();
        }
#if defined(SCAN_PROBE) && SCAN_PROBE == 1
        if (blockIdx.x == 0 && F.tid == 0) F.MISC[16] = (unsigned)sp_sum;
#endif
    }
    }
}

constexpr int SEG_G = 8, SEG_N = NCH / SEG_G;
constexpr size_t WS_SST = 241 * MiB;
constexpr size_t WS_MBB = 245 * MiB;
constexpr size_t WS_MBM = 249 * MiB;
static_assert(WS_MBM + (size_t)NH * (SEG_G - 1) * 128 * 128 * 4 <= WS_END, "segment scan buffers");

template <bool FINAL> __device__ __forceinline__ void scan_job(Frame& F, const Args& A, int h, int sg, int sub) {
    const bf16* Wb = WSP(const bf16, SCAN_WNEG); const bf16* QP = SCAN_QP; const bf16* KT = SCAN_KT; const bf16* ATT = WSP(const bf16, SCAN_ATT); bf16* UT = SCAN_UT; const float* EGL = WSP(const float, WS_EGL);
    const int n0 = sg * SEG_N, n1 = n0 + SEG_N;
    constexpr int NLD = FINAL ? 14 : 8;
    if (F.wave >= 4) {
        const int lt = F.tid - 256;
        u32x4 rwA[4], rqA[4], rkA[4], raA[2], rwB[4], rqB[4], rkB[4], raB[2], rwC[4], rqC[4], rkC[4], raC[2];
#define S2_GLD(dst, voff, sbase) asm volatile("global_load_dwordx4 %0, %1, %2" : "=v"(dst) : "v"(voff), "s"(sbase) : "memory")
        const unsigned vo_w = (unsigned)((lt >> 4) * (DM * 2) + (lt & 15) * 16), vo_t = (unsigned)lt * 16u;
#define S2_ISSUE(n_, X) do { const bf16* bw_ = Wb + (size_t)((n_) * CH) * DM + h * HD; const bf16* bk_ = KT + (size_t)(h * NCH + (n_)) * (HD * CH); \
            _Pragma("unroll") for (int i = 0; i < 4; ++i) { S2_GLD(rw##X[i], vo_w + (unsigned)i * (16u * DM * 2u), bw_); } \
            _Pragma("unroll") for (int i = 0; i < 4; ++i) { S2_GLD(rk##X[i], vo_t + (unsigned)i * 4096u, bk_); } \
            if constexpr (FINAL) { const bf16* bq_ = QP + (size_t)((n_) * CH) * DM + h * HD; const bf16* ba_ = ATT + (size_t)(h * NCH + (n_)) * (CH * CH); \
                _Pragma("unroll") for (int i = 0; i < 4; ++i) { S2_GLD(rq##X[i], vo_w + (unsigned)i * (16u * DM * 2u), bq_); } \
                _Pragma("unroll") for (int i = 0; i < 2; ++i) { S2_GLD(ra##X[i], vo_t + (unsigned)i * 4096u, ba_); } } } while (0)
#define S2_TIEF(X) "+v"(rw##X[0]), "+v"(rw##X[1]), "+v"(rw##X[2]), "+v"(rw##X[3]), "+v"(rq##X[0]), "+v"(rq##X[1]), "+v"(rq##X[2]), "+v"(rq##X[3]), "+v"(rk##X[0]), "+v"(rk##X[1]), "+v"(rk##X[2]), "+v"(rk##X[3]), "+v"(ra##X[0]), "+v"(ra##X[1])
#define S2_TIEA(X) "+v"(rw##X[0]), "+v"(rw##X[1]), "+v"(rw##X[2]), "+v"(rw##X[3]), "+v"(rk##X[0]), "+v"(rk##X[1]), "+v"(rk##X[2]), "+v"(rk##X[3])
#define S2_WAIT2(X) do { if constexpr (FINAL) asm volatile("s_waitcnt vmcnt(28)" : S2_TIEF(X) :: "memory"); else asm volatile("s_waitcnt vmcnt(16)" : S2_TIEA(X) :: "memory"); } while (0)
#define S2_WAIT0(X) do { if constexpr (FINAL) asm volatile("s_waitcnt vmcnt(0)" : S2_TIEF(X) :: "memory"); else asm volatile("s_waitcnt vmcnt(0)" : S2_TIEA(X) :: "memory"); } while (0)
#define S2_PUT(buf_, X) do { LAS unsigned char* b_ = F.lds + (buf_) * SC_BUF; \
            _Pragma("unroll") for (int i = 0; i < 4; ++i) { const int idx = lt + 256 * i, row = idx >> 4, ch = idx & 15; *(LAS u32x4*)(b_ + SC_W + row * SC_RW + 16 * ch) = rw##X[i]; \
                if constexpr (FINAL) *(LAS u32x4*)(b_ + SC_Q + row * SC_RW + 16 * ch) = rq##X[i]; } \
            _Pragma("unroll") for (int i = 0; i < 4; ++i) { const int idx = lt + 256 * i, row = idx >> 3, ch = idx & 7; *(LAS u32x4*)(b_ + SC_K + row * SC_RK + 16 * ch) = rk##X[i]; } \
            if constexpr (FINAL) { _Pragma("unroll") for (int i = 0; i < 2; ++i) { const int idx = lt + 256 * i, row = idx >> 3, ch = idx & 7; *(LAS u32x4*)(b_ + SC_A + row * SC_RK + 16 * ch) = ra##X[i]; } } } while (0)
#define S2_STEP(n_, X) do { S2_WAIT2(X); S2_PUT(((n_) + 1 - n0) & 1, X); { const int nn_ = ((n_) + 4 < n1) ? (n_) + 4 : n1 - 1; S2_ISSUE(nn_, X); } \
            asm volatile("s_waitcnt lgkmcnt(0)" ::: "memory"); __builtin_amdgcn_s_barrier(); } while (0)
        static_assert(SEG_N % 3 == 2, "loader tail below is written for SEG_N = 3k + 2");
        S2_ISSUE(n0, A); S2_WAIT0(A); S2_PUT(0, A);
        asm volatile("s_waitcnt lgkmcnt(0)" ::: "memory");
        __builtin_amdgcn_s_barrier();
        S2_ISSUE(n0 + 1, A); S2_ISSUE(n0 + 2, B); S2_ISSUE(n0 + 3, C);
        int n = n0;
        for (; n + 2 < n1; n += 3) { S2_STEP(n, A); S2_STEP(n + 1, B); S2_STEP(n + 2, C); }
        S2_STEP(n, A); S2_STEP(n + 1, B);
        asm volatile("s_waitcnt vmcnt(0)" ::: "memory");
    } else {
        const int r = F.lane & 15, g = F.lane >> 4;
        const int col = FINAL ? (sub * 4 + F.wave) * 16 + r : 64 * sub + 16 * F.wave + r;
        const bool real = FINAL || (col < 128);
        f32x4_t sacc[8];
        if constexpr (FINAL) { const float* sp = WSP(const float, WS_SST) + ((size_t)(h * SEG_G + sg) * 128 + col) * 128 + 4 * g;
#pragma unroll
            for (int mt = 0; mt < 8; ++mt) sacc[mt] = *(const f32x4_t*)(sp + 16 * mt); }
        else {
#pragma unroll
            for (int mt = 0; mt < 8; ++mt)
#pragma unroll
                for (int e = 0; e < 4; ++e) sacc[mt][e] = (!real && (16 * mt + 4 * g + e) == (col - 128)) ? 1.f : 0.f; }
        bf16* utp = UT + (size_t)h * NCH * (HD * CH) + (size_t)((FINAL ? col : (col & 127))) * CH + 4 * g;
        u32x2 un[4];
#pragma unroll
        for (int ct = 0; ct < 4; ++ct) { un[ct] = (u32x2){0u, 0u}; if (real) un[ct] = *(const u32x2*)(utp + (size_t)n0 * (HD * CH) + 16 * ct); }
        float egl = EGL[h * NCH + n0];
        __builtin_amdgcn_s_barrier();
        for (int n = n0; n < n1; ++n) {
            const LAS unsigned char* b = F.lds + ((n - n0) & 1) * SC_BUF; const LAS unsigned char* lw = b + SC_W + r * SC_RW + 16 * g; const LAS unsigned char* lq = b + SC_Q + r * SC_RW + 16 * g;
            const LAS unsigned char* lk = b + SC_K + r * SC_RK + 16 * g; const LAS unsigned char* la = b + SC_A + r * SC_RK + 16 * g;
            f32x4_t vacc[4], oacc[4]; bf16x8 sb[4], fa[16], fb[16];
#pragma unroll
            for (int ct = 0; ct < 4; ++ct)
#pragma unroll
                for (int kk = 0; kk < 4; ++kk) fa[4 * ct + kk] = *(const LAS bf16x8*)(lw + ct * 16 * SC_RW + kk * 64);
            if constexpr (FINAL) {
#pragma unroll
                for (int ct = 0; ct < 4; ++ct)
#pragma unroll
                    for (int kk = 0; kk < 4; ++kk) fb[4 * ct + kk] = *(const LAS bf16x8*)(lq + ct * 16 * SC_RW + kk * 64); }
            __builtin_amdgcn_sched_barrier(0);
#pragma unroll
            for (int kk = 0; kk < 4; ++kk) sb[kk] = packb(sacc[2 * kk], sacc[2 * kk + 1]);
#pragma unroll
            for (int ct = 0; ct < 4; ++ct) { vacc[ct] = (f32x4_t){bflo(un[ct].x), bfhi(un[ct].x), bflo(un[ct].y), bfhi(un[ct].y)}; oacc[ct] = (f32x4_t){0.f, 0.f, 0.f, 0.f}; }
            bf16* utc = utp + (size_t)n * (HD * CH);
            u32x2 unn[4]; float egln = 0.f;
#pragma unroll
            for (int ct = 0; ct < 4; ++ct) unn[ct] = (u32x2){0u, 0u};
            if (n + 1 < n1) { if (real) {
#pragma unroll
                    for (int ct = 0; ct < 4; ++ct) unn[ct] = *(const u32x2*)(utc + HD * CH + 16 * ct); }
                egln = EGL[h * NCH + n + 1]; }
#pragma unroll
            for (int kk = 0; kk < 4; ++kk)
#pragma unroll
                for (int ct = 0; ct < 4; ++ct) vacc[ct] = __builtin_amdgcn_mfma_f32_16x16x32_bf16(fa[4 * ct + kk], sb[kk], vacc[ct], 0, 0, 0);
            __builtin_amdgcn_sched_barrier(0);
#pragma unroll
            for (int mt = 0; mt < 8; ++mt)
#pragma unroll
                for (int k2 = 0; k2 < 2; ++k2) fa[2 * mt + k2] = *(const LAS bf16x8*)(lk + mt * 16 * SC_RK + k2 * 64);
            __builtin_amdgcn_sched_barrier(0);
            if constexpr (FINAL) {
#pragma unroll
                for (int kk = 0; kk < 4; ++kk)
#pragma unroll
                    for (int ct = 0; ct < 4; ++ct) oacc[ct] = __builtin_amdgcn_mfma_f32_16x16x32_bf16(fb[4 * ct + kk], sb[kk], oacc[ct], 0, 0, 0);
                __builtin_amdgcn_sched_barrier(0);
#pragma unroll
                for (int ct = 0; ct < 4; ++ct)
#pragma unroll
                    for (int k2 = 0; k2 < 2; ++k2) if (!(k2 == 1 && ct < 2)) fb[2 * ct + k2] = *(const LAS bf16x8*)(la + ct * 16 * SC_RK + k2 * 64);
                __builtin_amdgcn_sched_barrier(0); }
            bf16x8 vb[2];
#pragma unroll
            for (int k2 = 0; k2 < 2; ++k2) vb[k2] = packb(vacc[2 * k2], vacc[2 * k2 + 1]);
#pragma unroll
            for (int mt = 0; mt < 8; ++mt) sacc[mt] = sacc[mt] * egl;
#pragma unroll
            for (int k2 = 0; k2 < 2; ++k2)
#pragma unroll
                for (int mt = 0; mt < 8; ++mt) sacc[mt] = __builtin_amdgcn_mfma_f32_16x16x32_bf16(fa[2 * mt + k2], vb[k2], sacc[mt], 0, 0, 0);
            if constexpr (FINAL) {
#pragma unroll
                for (int k2 = 0; k2 < 2; ++k2)
#pragma unroll
                    for (int ct = 0; ct < 4; ++ct) if (!(k2 == 1 && ct < 2)) oacc[ct] = __builtin_amdgcn_mfma_f32_16x16x32_bf16(fb[2 * ct + k2], vb[k2], oacc[ct], 0, 0, 0);
#pragma unroll
                for (int ct = 0; ct < 4; ++ct) { u32x2 w; w.x = cvtpk(oacc[ct][0], oacc[ct][1]); w.y = cvtpk(oacc[ct][2], oacc[ct][3]); *(u32x2*)(utc + 16 * ct) = w; } }
#pragma unroll
            for (int ct = 0; ct < 4; ++ct) un[ct] = unn[ct];
            egl = egln;
            asm volatile("s_waitcnt lgkmcnt(0)" ::: "memory");
            __builtin_amdgcn_s_barrier();
        }
        if constexpr (!FINAL) {
            if (real) { float* bp = WSP(float, WS_MBB) + ((size_t)(h * (SEG_G - 1) + sg) * 128 + col) * 128 + 4 * g;
#pragma unroll
                for (int mt = 0; mt < 8; ++mt) *(f32x4_t*)(bp + 16 * mt) = sacc[mt]; }
            else { bf16* mp = WSP(bf16, WS_MBM) + (size_t)(h * (SEG_G - 1) + sg) * (128 * 128) + (col - 128);
#pragma unroll
                for (int mt = 0; mt < 8; ++mt)
#pragma unroll
                    for (int e = 0; e < 4; ++e) mp[(size_t)(16 * mt + 4 * g + e) * 128] = (bf16)f2bf(sacc[mt][e]); } }
    }
}
constexpr int MID_SPLIT = 8;
__device__ __forceinline__ void scan_mid(Frame& F, const Args& A, int h, int cg) {
    LAS float* Sl = (LAS float*)F.lds; LAS unsigned char* Mimg = F.lds + 16 * 132 * 4;
    float* SST = WSP(float, WS_SST) + (size_t)h * SEG_G * (128 * 128);
    const float* MBB = WSP(const float, WS_MBB) + (size_t)h * (SEG_G - 1) * (128 * 128); const bf16* MBM = WSP(const bf16, WS_MBM) + (size_t)h * (SEG_G - 1) * (128 * 128);
    const int r = F.lane & 15, g = F.lane >> 4, et = F.wave, col = 16 * cg + r;
    __syncthreads();
    for (int i = F.tid; i < 16 * 128; i += NWAVES * 64) { Sl[(i >> 7) * 132 + (i & 127)] = 0.f; SST[(size_t)(16 * cg + (i >> 7)) * 128 + (i & 127)] = 0.f; }
    u32x4 mreg[2][4]; f32x4_t accn[2];
#pragma unroll
    for (int p = 0; p < 2; ++p) {
#pragma unroll
        for (int i = 0; i < 4; ++i) mreg[p][i] = *(const u32x4*)(MBM + (size_t)p * (128 * 128) + (size_t)(F.tid + 512 * i) * 8);
        accn[p] = *(const f32x4_t*)(MBB + ((size_t)p * 128 + col) * 128 + 16 * et + 4 * g); }
#pragma unroll
    for (int sg = 0; sg < SEG_G - 1; ++sg) { const int p = sg & 1;
        __syncthreads();
#pragma unroll
        for (int i = 0; i < 4; ++i) { const int idx = F.tid + 512 * i, row = idx >> 4, ch = idx & 15; *(LAS u32x4*)(Mimg + row * 272 + 16 * ch) = mreg[p][i]; }
        if (sg + 2 < SEG_G - 1) {
#pragma unroll
            for (int i = 0; i < 4; ++i) mreg[p][i] = *(const u32x4*)(MBM + (size_t)(sg + 2) * (128 * 128) + (size_t)(F.tid + 512 * i) * 8); }
        f32x4_t acc = accn[p];
        if (sg + 2 < SEG_G - 1) accn[p] = *(const f32x4_t*)(MBB + ((size_t)(sg + 2) * 128 + col) * 128 + 16 * et + 4 * g);
        __syncthreads();
#pragma unroll
        for (int kk = 0; kk < 4; ++kk) {
            const LAS float* sp = Sl + r * 132 + 32 * kk + 8 * g; const f32x4 s0 = *(const LAS f32x4*)sp, s1 = *(const LAS f32x4*)(sp + 4);
            float sf[8] = {s0.x, s0.y, s0.z, s0.w, s1.x, s1.y, s1.z, s1.w}; const bf16x8 bfr = pack8f(sf);
            const bf16x8 afr = *(const LAS bf16x8*)(Mimg + (16 * et + r) * 272 + 64 * kk + 16 * g); acc = __builtin_amdgcn_mfma_f32_16x16x32_bf16(afr, bfr, acc, 0, 0, 0); }
        *(f32x4_t*)(SST + (size_t)(sg + 1) * (128 * 128) + (size_t)col * 128 + 16 * et + 4 * g) = acc;
        __syncthreads();
        *(LAS f32x4_t*)(Sl + r * 132 + 16 * et + 4 * g) = acc;
    }
    __syncthreads();
}
__device__ __forceinline__ void p_dn_scan2_A(Frame& F, const Args& A) { const int b = blockIdx.x; if (b < NH * (SEG_G - 1) * 4) { const int gid = 8 * (b >> 5) + (b & 7), sub = (b >> 3) & 3; scan_job<false>(F, A, gid / (SEG_G - 1), gid % (SEG_G - 1), sub); } }
__device__ __forceinline__ void p_dn_scan2_B(Frame& F, const Args& A) { if (blockIdx.x < NH * MID_SPLIT) scan_mid(F, A, blockIdx.x / MID_SPLIT, blockIdx.x % MID_SPLIT); }
__device__ __forceinline__ void p_dn_scan2_C(Frame& F, const Args& A) { const int b = blockIdx.x; if (b < NH * SEG_G * 2) { const int gid = 8 * (b >> 4) + (b & 7), sub = (b >> 3) & 1; scan_job<true>(F, A, gid / SEG_G, gid % SEG_G, sub); } }
__device__ __forceinline__ void p_dn_out_fast(Frame& F, const Args& A) {
    const bf16* OT = SCAN_UT; const bf16* Z = WSP(const bf16, WS_Z); bf16* YD = WSP(bf16, SCAN_YD); const float* ow = A.in[6];
    LAS unsigned short* tile = (LAS unsigned short*)(F.lds + F.wave * 16640);
    for (int it = F.gw; it < NCH * NH; it += F.NGW) { const int n = it >> 3, h = it & 7, t0 = n * CH;
        const bf16* ot = OT + (size_t)(h * NCH + n) * (HD * CH);
        u32x4 ov[16]; unsigned zall[CH];
#pragma unroll
        for (int i = 0; i < 16; ++i) { const int e = 8 * i + (F.lane >> 3), ch = F.lane & 7; ov[i] = *(const u32x4*)(ot + (size_t)e * CH + 8 * ch); }
#pragma unroll
        for (int c = 0; c < CH; ++c) zall[c] = *(const unsigned*)(Z + (size_t)(t0 + c) * DM + h * HD + 2 * F.lane);
        const float w0 = ow[2 * F.lane], w1 = ow[2 * F.lane + 1];
#pragma unroll
        for (int i = 0; i < 16; ++i) { const int e = 8 * i + (F.lane >> 3), ch = F.lane & 7; const u32x4 v = ov[i]; LAS unsigned short* tp = tile + e * 65 + 8 * ch;
            tp[0] = (unsigned short)v.x; tp[1] = (unsigned short)(v.x >> 16); tp[2] = (unsigned short)v.y; tp[3] = (unsigned short)(v.y >> 16); tp[4] = (unsigned short)v.z; tp[5] = (unsigned short)(v.z >> 16); tp[6] = (unsigned short)v.w; tp[7] = (unsigned short)(v.w >> 16); }
        asm volatile("s_waitcnt lgkmcnt(0)" ::: "memory");
#pragma unroll
        for (int c = 0; c < CH; ++c) { const float o0 = bf2f(tile[(2 * F.lane) * 65 + c]), o1 = bf2f(tile[(2 * F.lane + 1) * 65 + c]);
            const float rs = rsq_(wave_sum(o0 * o0 + o1 * o1) * (1.f / HD) + EPS);
            const size_t off = (size_t)(t0 + c) * DM + h * HD + 2 * F.lane; const unsigned zv = zall[c];
            *(unsigned*)(YD + off) = pk2(o0 * rs * w0 * siluf_(bflo(zv)), o1 * rs * w1 * siluf_(bfhi(zv))); }
        asm volatile("s_waitcnt lgkmcnt(0)" ::: "memory");
    }
}
#ifdef DBG_ATTN
constexpr int CW_DBG = 20000;
__device__ __forceinline__ void dbg_compare(Frame& F, const bf16* a, const bf16* b, size_t n) {
    float* acc = (float*)(WSP(unsigned, WS_CTL) + CW_DBG); float d2 = 0.f, r2 = 0.f;
    for (size_t i = (size_t)F.gw * 64 + F.lane; i < n; i += (size_t)F.NGW * 64) { const float x = bf2f(a[i]), y = bf2f(b[i]); d2 += (x - y) * (x - y); r2 += y * y; }
    d2 = wave_sum(d2); r2 = wave_sum(r2);
    if (F.lane == 0) { atomicAdd(acc, d2); atomicAdd(acc + 1, r2); }
}
#endif

#if defined(DBG_DET) || defined(DBG_L2L)
constexpr int CW_CS = 24000;
__device__ __forceinline__ void dbg_cksum(Frame& F, const void* p, size_t bytes, int slot) {
    const unsigned* w = (const unsigned*)p; unsigned acc = 0u; const size_t nw = bytes / 4;
#ifdef DBG_NANCNT
    for (size_t i = (size_t)F.gw * 64 + F.lane; i < nw; i += (size_t)F.NGW * 64) { const unsigned v = w[i]; acc += ((v & 0x7F80u) >= (141u << 7)) + ((v & 0x7F800000u) >= (141u << 23)); }
#else
    for (size_t i = (size_t)F.gw * 64 + F.lane; i < nw; i += (size_t)F.NGW * 64) { const unsigned v = w[i]; acc += v * 2654435761u + (unsigned)(i * 40503u) * (v >> 7); }
#endif
#pragma unroll
    for (int o = 1; o < 64; o <<= 1) acc += __shfl_xor(acc, o);
    if (F.lane == 0) atomicAdd(WSP(unsigned, WS_CTL) + CW_CS + slot, acc);
}
#endif

#ifdef DBG_SIG
constexpr int CW_SIG = 26000;
__device__ __forceinline__ void dbg_sig(Frame& F, const bf16* p, size_t n, int slot) {
    double acc = 0.0, acc2 = 0.0;
    for (size_t i = (size_t)F.gw * 64 + F.lane; i < n; i += (size_t)F.NGW * 64) { unsigned hsh = (unsigned)i * 2654435761u; hsh ^= hsh >> 15; hsh *= 2246822519u; hsh ^= hsh >> 13;
        const float wgt = (float)(hsh & 0xFFFFu) * (1.f / 32768.f) - 1.f; const float x = bf2f(p[i]); acc += (double)(x * wgt); acc2 += (double)(x * x); }
    long long q1 = (long long)(acc * 65536.0), q2 = (long long)(acc2 * 65536.0);
#pragma unroll
    for (int o = 1; o < 64; o <<= 1) { q1 += __shfl_xor(q1, o); q2 += __shfl_xor(q2, o); }
    if (F.lane == 0) { unsigned long long* a = (unsigned long long*)(WSP(unsigned, WS_CTL) + CW_SIG); atomicAdd(a + 2 * slot, (unsigned long long)q1); atomicAdd(a + 2 * slot + 1, (unsigned long long)q2); }
}
#endif

#ifdef DBG_CHK
constexpr int CW_CHK = 28000;
__device__ __forceinline__ float dbg_g(const float* BA, const Args& A, int t, int h) { const float a = BA[(size_t)t * 16 + 8 + h] + A.in[5][h]; const float sp = (a > 20.f) ? a : log1pf(expf(a)); return -expf(A.in[4][h]) * sp; }
__device__ __forceinline__ void dbg_chk_acc(Frame& F, int k, float err, float ref) {
    long long q1 = (long long)((double)err * (double)err * 1048576.0), q2 = (long long)((double)ref * (double)ref * 1048576.0);
    unsigned long long* a = (unsigned long long*)(WSP(unsigned, WS_CTL) + CW_CHK); atomicAdd(a + 2 * k, (unsigned long long)q1); atomicAdd(a + 2 * k + 1, (unsigned long long)q2);
}
__device__ __forceinline__ void dbg_chunk2_check(Frame& F, const Args& A) {
    const float* BA = WSP(const float, WS_BA); const bf16* KN = WSP(const bf16, WS2_KN); const bf16* QP = WSP(const bf16, WS2_QN); const bf16* Wn = WSP(const bf16, WS2_WNEG);
    const bf16* ATT = WSP(const bf16, WS2_ATT); const bf16* KT = ws2_kt(F); const float* EGL = WSP(const float, WS_EGL);
    const int s = F.gw * 64 + F.lane; if (s >= 8192) return;
    unsigned hsh = (unsigned)s * 2654435761u; hsh ^= hsh >> 15; hsh *= 2246822519u; hsh ^= hsh >> 13;
    const int n = hsh & 255, h = (hsh >> 8) & 7, i = (hsh >> 11) & 63, d = (hsh >> 17) & 127, t0 = n * CH;
    float gci = 0.f, gl = 0.f; { float a = 0.f; for (int j = 0; j < 64; ++j) { a += dbg_g(BA, A, t0 + j, h); if (j == i) gci = a; } gl = a; }
    const float beta_i = 1.f / (1.f + expf(-BA[(size_t)(t0 + i) * 16 + h]));
    const bf16* ki = KN + (size_t)(t0 + i) * DM + h * HD;
    dbg_chk_acc(F, 0, EGL[h * NCH + n] - expf(gl), expf(gl));
    { const float ref = bf2f(ki[d]) * expf(gl - gci); dbg_chk_acc(F, 1, bf2f(KT[(size_t)(h * NCH + n) * (HD * CH) + (size_t)d * CH + i]) - ref, ref); }
    { const float kt = bf2f(KT[(size_t)(h * NCH + n) * (HD * CH) + (size_t)d * CH + i]); dbg_chk_acc(F, 4, kt - bf2f(ki[d]), bf2f(ki[d])); }
    if (n < 128) { const int c = d & 63; const bf16* tg = WSP(const bf16, 241 * MiB) + (size_t)(h * 128 + n) * 4096; float lhs = bf2f(tg[i * 64 + c]); float gcj = 0.f, gcc = 0.f;
      for (int j = 0; j < 64; ++j) { gcj += dbg_g(BA, A, t0 + j, h); if (j == c) gcc = gcj;
          if (j < i) { const bf16* kj = KN + (size_t)(t0 + j) * DM + h * HD; float dot = 0.f; for (int x = 0; x < HD; ++x) dot += bf2f(ki[x]) * bf2f(kj[x]); lhs += beta_i * dot * expf(gci - gcj) * bf2f(tg[j * 64 + c]); } }
      const float beta_c = 1.f / (1.f + expf(-BA[(size_t)(t0 + c) * 16 + h])); const float ref = (i == c) ? beta_c * expf(gcc) : 0.f; dbg_chk_acc(F, 5, lhs - ref, (i == c) ? ref : 0.05f * beta_c * expf(gcc)); }
    if (n < 128) { const bf16* tg = WSP(const bf16, 241 * MiB) + (size_t)(h * 128 + n) * 4096; float ref = 0.f, mag = 0.f;
      for (int j = 0; j < 64; ++j) { const float t = bf2f(tg[i * 64 + j]) * bf2f(KN[(size_t)(t0 + j) * DM + h * HD + d]); ref += t; mag += fabsf(t); }
      dbg_chk_acc(F, 6, -bf2f(Wn[(size_t)(t0 + i) * DM + h * HD + d]) - ref, mag); }
    if (n < 128) { const bf16* tg = WSP(const bf16, 241 * MiB) + (size_t)(h * 128 + n) * 4096; float r7 = 0.f, r8 = 0.f, mag = 0.f, gcj = 0.f;
      for (int j = 0; j < 64; ++j) { gcj += dbg_g(BA, A, t0 + j, h); const float kk = bf2f(KN[(size_t)(t0 + j) * DM + h * HD + d]); const float t = bf2f(tg[i * 64 + j]) * kk;
          r7 += t * expf(gl - gcj); r8 += bf2f(tg[j * 64 + i]) * kk; mag += fabsf(t); }
      const float wv = -bf2f(Wn[(size_t)(t0 + i) * DM + h * HD + d]); dbg_chk_acc(F, 7, wv - r7, mag); dbg_chk_acc(F, 8, wv - r8, mag); }
    if (n < 32) { const bf16* dk = WSP(const bf16, 249 * MiB) + (size_t)(h * 32 + n) * 8192; dbg_chk_acc(F, 9, bf2f(dk[d * 64 + i]) - bf2f(ki[d]), bf2f(ki[d])); }
    if (n < 32) { const float ref = bf2f(ki[d]) * expf(gl - gci); dbg_chk_acc(F, 10, bf2f(KT[(size_t)(h * NCH + n) * (HD * CH) + (size_t)d * CH + i]) - ref, ref); }
    if (n < 128) { const bf16* tg = WSP(const bf16, 241 * MiB) + (size_t)(h * 128 + n) * 4096; float ref = 0.f, mag = 0.f;
      for (int j = 0; j < 64; ++j) { const float t = bf2f(tg[i * 64 + j]) * bf2f(KN[(size_t)(t0 + j) * DM + h * HD + d]); ref += t; mag += fabsf(t); }
      dbg_chk_acc(F, n >= 32 ? 11 : 12, -bf2f(Wn[(size_t)(t0 + i) * DM + h * HD + d]) - ref, mag); }
    { float lhs = -bf2f(Wn[(size_t)(t0 + i) * DM + h * HD + d]); float gcj = 0.f;
      for (int j = 0; j < i; ++j) { gcj += dbg_g(BA, A, t0 + j, h); const bf16* kj = KN + (size_t)(t0 + j) * DM + h * HD; float dot = 0.f; for (int x = 0; x < HD; ++x) dot += bf2f(ki[x]) * bf2f(kj[x]);
          lhs += beta_i * dot * expf(gci - gcj) * (-bf2f(Wn[(size_t)(t0 + j) * DM + h * HD + d])); }
      const float ref = beta_i * expf(gci) * bf2f(ki[d]); dbg_chk_acc(F, 2, lhs - ref, ref); }
    { const int j = d & 63; if (j <= i && gci > -20.f) { float gcj = 0.f; for (int x = 0; x <= j; ++x) gcj += dbg_g(BA, A, t0 + x, h);
          const bf16* kj = KN + (size_t)(t0 + j) * DM + h * HD; const bf16* qi = QP + (size_t)(t0 + i) * DM + h * HD; float dot = 0.f; for (int x = 0; x < HD; ++x) dot += bf2f(qi[x]) * bf2f(kj[x]);
          const float ref = dot * expf(-gcj); dbg_chk_acc(F, 3, bf2f(ATT[(size_t)(h * NCH + n) * (CH * CH) + (size_t)i * CH + j]) - ref, ref); }
      else if (j > i) dbg_chk_acc(F, 3, bf2f(ATT[(size_t)(h * NCH + n) * (CH * CH) + (size_t)i * CH + j]), 0.f); }
}
#endif

#ifdef DBG_TILE
constexpr int CW_TILE = 30000;
__device__ __forceinline__ void dbg_tile_check(Frame& F, const Args& A) {
    if (F.gw >= NCH * NH) return;
    const int n = F.gw >> 3, h = F.gw & 7, t0 = n * CH, lane = F.lane;
    const float* BA = WSP(const float, WS_BA); const bf16* KN = WSP(const bf16, WS2_KN); const bf16* KT = ws2_kt(F) + (size_t)(h * NCH + n) * (HD * CH);
    float gc = 0.f, gl = 0.f; { float a = 0.f; for (int j = 0; j < 64; ++j) { a += dbg_g(BA, A, t0 + j, h); if (j == lane) gc = a; } gl = a; }
    const float f = expf(gl - gc); int bad = 0;
    for (int d = 0; d < HD; ++d) { const float ref = bf2f(KN[(size_t)(t0 + lane) * DM + h * HD + d]) * f; const float got = bf2f(KT[(size_t)d * CH + lane]); if (!(fabsf(got - ref) <= 0.02f * fabsf(ref) + 1e-3f)) ++bad; }
    bad = (int)wave_sum((float)bad);
    if (lane == 0 && bad > 0) { unsigned* w = WSP(unsigned, WS_CTL) + CW_TILE; atomicAdd(w, 1u); atomicMin(w + 1, (unsigned)n); atomicOr(w + 2 + n, 1u << h); atomicAdd(w + 300, (unsigned)bad); atomicOr(w + 301, 1u << h); if (bad > 4096) atomicOr(w + 302, 1u << h); }
}
#endif
template <int R> __device__ __forceinline__ void post_rows(Frame& F, const Args& A, int m0, int stride) {
    const float* x = A.in[0]; const bf16* T = WSP(const bf16, WS_T); bf16* H2 = WSP(bf16, WS_H2);
    const f32x4* w1 = (const f32x4*)A.in[10] + F.lane; const f32x4* w2 = (const f32x4*)A.in[11] + F.lane;
    unsigned long long t8[R][4]; f32x4 xv[R][4];
#pragma unroll
    for (int k = 0; k < R; ++k) { const int m = m0 + k * stride; const unsigned long long* tr = (const unsigned long long*)(T + (size_t)m * DM) + F.lane; const f32x4* xr = (const f32x4*)(x + (size_t)m * DM) + F.lane;
#pragma unroll
        for (int j = 0; j < 4; ++j) { t8[k][j] = tr[64 * j]; xv[k][j] = xr[64 * j]; } }
#pragma unroll
    for (int k = 0; k < R; ++k) { const int m = m0 + k * stride; unsigned long long* x1row = (unsigned long long*)(WSP(bf16, WS_X1B) + (size_t)m * DM) + F.lane;
        f32x4 tv[4]; float ss = 0.f;
#pragma unroll
        for (int j = 0; j < 4; ++j) { const unsigned long long w8 = t8[k][j]; const unsigned lo = (unsigned)w8, hi = (unsigned)(w8 >> 32); tv[j] = (f32x4){bflo(lo), bfhi(lo), bflo(hi), bfhi(hi)}; ss += (tv[j].x * tv[j].x + tv[j].y * tv[j].y) + (tv[j].z * tv[j].z + tv[j].w * tv[j].w); }
        const float rs = rsq_(wave_sum(ss) * (1.f / DM) + EPS); float s2 = 0.f;
#pragma unroll
        for (int j = 0; j < 4; ++j) { tv[j] = xv[k][j] + tv[j] * rs * w1[64 * j]; x1row[64 * j] = (unsigned long long)pk2(tv[j].x, tv[j].y) | ((unsigned long long)pk2(tv[j].z, tv[j].w) << 32);
            s2 += (tv[j].x * tv[j].x + tv[j].y * tv[j].y) + (tv[j].z * tv[j].z + tv[j].w * tv[j].w); }
        const float r2 = rsq_(wave_sum(s2) * (1.f / DM) + EPS);
        unsigned long long* o8 = (unsigned long long*)(H2 + (size_t)m * DM) + F.lane;
#pragma unroll
        for (int j = 0; j < 4; ++j) { const f32x4 hv = tv[j] * r2 * w2[64 * j]; o8[64 * j] = (unsigned long long)pk2(hv.x, hv.y) | ((unsigned long long)pk2(hv.z, hv.w) << 32); } }
}
__device__ __forceinline__ void p_post_mix(Frame& F, const Args& A) {
    int m = F.gw;
    for (; m + F.NGW < S; m += 2 * F.NGW) post_rows<2>(F, A, m, F.NGW);
    if (m < S) post_rows<1>(F, A, m, F.NGW);
}
#if !defined(DBG_NAN) && !defined(DBG_DET) && !defined(DBG_ATTN)
template <int R> __device__ __forceinline__ void final_rows(Frame& F, const Args& A, int m0, int stride) {
    const bf16* Fd = WSP(const bf16, WS_F); const f32x4* w = (const f32x4*)A.in[15] + F.lane;
    unsigned long long f8[R][4], x8[R][4];
#pragma unroll
    for (int k = 0; k < R; ++k) { const int m = m0 + k * stride; const unsigned long long* fr = (const unsigned long long*)(Fd + (size_t)m * DM) + F.lane; const unsigned long long* xr = (const unsigned long long*)(WSP(const bf16, WS_X1B) + (size_t)m * DM) + F.lane;
#pragma unroll
        for (int j = 0; j < 4; ++j) { f8[k][j] = fr[64 * j]; x8[k][j] = xr[64 * j]; } }
#pragma unroll
    for (int k = 0; k < R; ++k) { const int m = m0 + k * stride; f32x4* orow = (f32x4*)(F.out + (size_t)m * DM) + F.lane;
        f32x4 fv[4]; float ss = 0.f;
#pragma unroll
        for (int j = 0; j < 4; ++j) { const unsigned long long w8 = f8[k][j]; const unsigned lo = (unsigned)w8, hi = (unsigned)(w8 >> 32); fv[j] = (f32x4){bflo(lo), bfhi(lo), bflo(hi), bfhi(hi)}; ss += (fv[j].x * fv[j].x + fv[j].y * fv[j].y) + (fv[j].z * fv[j].z + fv[j].w * fv[j].w); }
        const float rs = rsq_(wave_sum(ss) * (1.f / DM) + EPS);
#pragma unroll
        for (int j = 0; j < 4; ++j) { const unsigned lo = (unsigned)x8[k][j], hi = (unsigned)(x8[k][j] >> 32); const f32x4 xv = {bflo(lo), bfhi(lo), bflo(hi), bfhi(hi)}; orow[64 * j] = xv + fv[j] * rs * w[64 * j]; } }
}
__device__ __forceinline__ void p_final(Frame& F, const Args& A) {
    int m = F.gw;
    for (; m + F.NGW < S; m += 2 * F.NGW) final_rows<2>(F, A, m, F.NGW);
    if (m < S) final_rows<1>(F, A, m, F.NGW);
}
#else
__device__ __forceinline__ void p_final(Frame& F, const Args& A) {
    const bf16* Fd = WSP(const bf16, WS_F);
    for (int m = F.gw; m < S; m += F.NGW) {
        const unsigned long long* fr = (const unsigned long long*)(Fd + (size_t)m * DM) + F.lane; f32x4* orow = (f32x4*)(F.out + (size_t)m * DM) + F.lane; const f32x4* w = (const f32x4*)A.in[15] + F.lane;
        f32x4 fv[4]; float ss = 0.f;
#pragma unroll
        for (int j = 0; j < 4; ++j) { const unsigned long long w8 = fr[64 * j]; const unsigned lo = (unsigned)w8, hi = (unsigned)(w8 >> 32); fv[j] = (f32x4){bflo(lo), bfhi(lo), bflo(hi), bfhi(hi)}; ss += (fv[j].x * fv[j].x + fv[j].y * fv[j].y) + (fv[j].z * fv[j].z + fv[j].w * fv[j].w); }
        const float rs = rsq_(wave_sum(ss) * (1.f / DM) + EPS);
#pragma unroll
        for (int j = 0; j < 4; ++j) { f32x4 ov = orow[64 * j] + fv[j] * rs * w[64 * j];
#ifdef DBG_NAN
#pragma unroll
            for (int e = 0; e < 4; ++e) if (!(fabsf(ov[e]) < 1e30f)) ov[e] = 12345.f;
#endif
            orow[64 * j] = ov; }
#ifdef DBG_DET
        { const unsigned* cs = WSP(const unsigned, WS_CTL) + CW_CS; float pz = 0.f;
          for (int k = 12; k >= 0; --k) if (cs[k] != cs[16 + k]) pz = __builtin_ldexpf(1.f, 40 - 2 * k);
#pragma unroll
          for (int j = 0; j < 4; ++j) orow[64 * j] = orow[64 * j] + pz; }
#endif
#ifdef DBG_ATTN
        { const float* acc = (const float*)(WSP(unsigned, WS_CTL) + CW_DBG); const float rv = acc[0] / acc[1]; const float pz = !(rv < DBG_TOL) ? 1000.f : 0.f;
#pragma unroll
          for (int j = 0; j < 4; ++j) orow[64 * j] = orow[64 * j] + pz; }
#endif
    }
}

#endif
constexpr int NPHASE = 18;
#ifndef MK_N_LAUNCHES
#define MK_N_LAUNCHES 1
#endif
constexpr int N_LAUNCHES = MK_N_LAUNCHES;
__global__ void __launch_bounds__(NWAVES * 64, 2) fwd(Args args) {
    extern __shared__ __attribute__((aligned(16))) unsigned char lds[];
    Frame F;
    F.lds = (LAS unsigned char*)lds; F.MISC = (volatile LAS unsigned*)(F.lds + MISC_OFF);
    F.tid = threadIdx.x; F.lane = F.tid & 63; F.wave = __builtin_amdgcn_readfirstlane(F.tid >> 6);
    F.G = gridDim.x; F.gw = blockIdx.x * NWAVES + F.wave; F.NGW = F.G * NWAVES;
    F.out = args.out; F.ws = args.ws;
    for (int u = F.tid; u < (LDS_BYTES - LDSCTL_OFF) / 4; u += NWAVES * 64) ((LAS unsigned*)(F.lds + LDSCTL_OFF))[u] = 0u;
    __syncthreads();
    XcdBarrier bar; bar.bar = (unsigned*)(F.ws + WS_CTL) + CW_BAR; bar.x = 0; bar.st = nullptr;
    if (N_LAUNCHES == 1) bar = xcd_barrier_post((unsigned*)(F.ws + WS_CTL) + CW_BAR, F.MISC + 8);
#define GRID_BAR() do { if (N_LAUNCHES == 1) xcd_barrier(bar); } while (0)
    const int lo = args.ph_lo, hi = args.ph_hi;
#ifdef PROBE_LO
    unsigned long long pr_t0 = 0ull, pr_dt = 0ull;
#define PROBE_AT(k) do { if (blockIdx.x == 0 && F.tid == 0) { if ((k) == PROBE_LO) pr_t0 = __builtin_amdgcn_s_memrealtime(); if ((k) == PROBE_HI + 1) pr_dt = __builtin_amdgcn_s_memrealtime() - pr_t0; } } while (0)
#else
#define PROBE_AT(k) do {} while (0)
#endif
#ifdef DBG_L2L
#define CK(k, p, n) dbg_cksum(F, (p), (n), (k))
#define CKB() GRID_BAR()
#else
#define CK(k, p, n) do {} while (0)
#define CKB() do {} while (0)
#endif
#if defined(ONLY_PH)
#define PH_EN(k) ((k) == ONLY_PH)
#elif defined(PH_MASK)
#define PH_EN(k) (((PH_MASK) >> (k)) & 1)
#else
#define PH_EN(k) true
#endif
#define IN(k) (PH_EN(k) && lo <= (k) && (k) < hi)
#define BOTH(k) (IN(k) && IN((k) + 1))
#define GEMM(EPI, Aoff, Boff, N_, K_, ...) do { pg8::Gemm g{(const pg8::bf16_t*)(F.ws + (Aoff)), (const pg8::bf16_t*)(F.ws + (Boff)), S, (N_), (K_)}; pg8::StaticOrder So; So.init(S, (N_), F.G, (int)blockIdx.x); \
        EPI E{__VA_ARGS__}; pg8::gemm_phase<EPI, pg8::StaticOrder, true, true>(F.lds + RING_OFF, g, So, E); } while (0)

    PROBE_AT(0);
    if (IN(0)) { p_prologue(F, args); if (BOTH(0)) GRID_BAR(); }
    CK(0, F.ws + WS_H, T32); CK(0, F.ws + WS_BA, 1 * MiB); CK(0, F.ws + WS_WTA, 41 * MiB - 512 * 1024); CKB();
    PROBE_AT(1);
    if (IN(1)) { GEMM(pg8::EpiRope, WS_H, WS_WTA, 3072, DM, WSP(pg8::bf16_t, WS_R1), WSP(const float, WS_COS), WSP(const float, WS_SIN), WSP(float, WS_KMEAN)); if (BOTH(1)) GRID_BAR(); }
    CK(1, F.ws + WS_R1, 3 * T32); CKB();
    PROBE_AT(2);
#ifndef TOPK2
#define TOPK2 1
#endif
#if !TOPK2
    if (IN(2)) { p_kmean(F, args); if (BOTH(2)) GRID_BAR(); }
#endif
    CK(2, F.ws + WS_KMEAN, 256 * 1024); CKB();
#ifndef ATTN_FAST
#define ATTN_FAST 1
#endif
#if ATTN_FAST
    PROBE_AT(3);
#if TOPK2
    if (IN(3)) { p_topk2(F, args); if (BOTH(3)) GRID_BAR();
#ifdef BAR_PROBE
        for (int i_ = 0; i_ < 8; ++i_) GRID_BAR();
#endif
    }
#else
    if (IN(3)) { p_topk_bucket(F, args); if (BOTH(3)) GRID_BAR(); }
#endif
    CK(3, F.ws + WS_TOPI, (size_t)S * NH * 12); CKB();
    PROBE_AT(4);
#ifdef WGSTAT
#define WGSTAT_RUN(k, call) do { const unsigned long long t0_ = __builtin_amdgcn_s_memrealtime(); call; if (WGSTAT_PH == (k)) { __syncthreads(); if (F.tid == 0) { const unsigned dt_ = (unsigned)(__builtin_amdgcn_s_memrealtime() - t0_); \
        unsigned* w_ = WSP(unsigned, WS_CTL) + 30000; atomicMax(w_, dt_); atomicAdd(w_ + 1, dt_); atomicMax(w_ + 2, (dt_ << 12) | (unsigned)blockIdx.x); atomicMax(w_ + 3, ((0xFFFFFu - dt_) << 12) | (unsigned)blockIdx.x); } } } while (0)
#else
#define WGSTAT_RUN(k, call) call
#endif
    if (IN(4)) { PROBE_AT(40); WGSTAT_RUN(40, p_attn_sel(F, args)); GRID_BAR(); PROBE_AT(41); WGSTAT_RUN(41, p_attn_own(F, args)); PROBE_AT(42);
#ifdef DBG_ATTN
        GRID_BAR(); p_attn_naive(F, args); GRID_BAR(); dbg_compare(F, WSP(const bf16, WS_YA), (const bf16*)F.out, (size_t)S * DM);
#endif
        if (BOTH(4)) GRID_BAR(); }
    CK(4, F.ws + WS_YA, T32); CKB();
#else
    PROBE_AT(3);
    if (IN(3)) { p_topk(F, args); if (BOTH(3)) GRID_BAR(); }
    PROBE_AT(4);
    if (IN(4)) { p_attn_naive(F, args); if (BOTH(4)) GRID_BAR(); }
#endif
#ifdef DBG_CHK
    {   GEMM(pg8::EpiGen<0>, WS_H, WS_WTB, 4096, DM, WSP(pg8::bf16_t, WS_R1), DM, 1024, (size_t)S * DM, nullptr); GRID_BAR();
        { ConvHalo hl; p_dn_conv2_halo(F, hl); GRID_BAR(); p_dn_conv2(F, args, hl); GRID_BAR(); }
        p_dn_chunk2(F, args); GRID_BAR();
        dbg_chunk2_check(F, args); GRID_BAR();
#ifdef DBG_TILE
        if (blockIdx.x == 0 && F.tid == 0) WSP(unsigned, WS_CTL)[CW_TILE + 1] = 0xFFFFu; GRID_BAR(); dbg_tile_check(F, args); GRID_BAR();
#endif
        }
#elif defined(DBG_SIG)
    {
      { Frame Fp = F; asm volatile("" : "+s"(Fp.ws), "+s"(Fp.out), "+v"(Fp.lane), "+v"(Fp.tid));
        GEMM(pg8::EpiGen<0>, WS_H, WS_WTB, 4096, DM, WSP(pg8::bf16_t, WS_R1), DM, 1024, (size_t)S * DM, nullptr); GRID_BAR();
        p_dn_conv(Fp, args); GRID_BAR(); p_dn_chunk(Fp, args); GRID_BAR(); p_dn_relayout1(Fp, args); GRID_BAR(); p_dn_relayout2(Fp, args); GRID_BAR();
        dbg_sig(Fp, (const bf16*)Fp.out, (size_t)S * DM, 0); dbg_sig(Fp, WSPF(const bf16, WS_W), (size_t)S * DM, 1); dbg_sig(Fp, WSPF(const bf16, WS_KT), (size_t)S * DM, 2);
        dbg_sig(Fp, WSPF(const bf16, WS_UT), (size_t)S * DM, 3); dbg_sig(Fp, WSPF(const bf16, WS_ATT), (size_t)S * DM / 2, 4); GRID_BAR();
      }
      { Frame Fp = F; asm volatile("" : "+s"(Fp.ws), "+s"(Fp.out), "+v"(Fp.lane), "+v"(Fp.tid));
        p_hrecompute(Fp, args); GRID_BAR();
        GEMM(pg8::EpiGen<0>, WS_H, WS_WTB, 4096, DM, WSP(pg8::bf16_t, WS_R1), DM, 1024, (size_t)S * DM, nullptr); GRID_BAR();
        { ConvHalo hl; p_dn_conv2_halo(Fp, hl); GRID_BAR(); p_dn_conv2(Fp, args, hl); GRID_BAR(); }
        p_dn_chunk2(Fp, args); GRID_BAR();
        dbg_sig(Fp, WSPF(const bf16, WS2_QN), (size_t)S * DM, 8); dbg_sig(Fp, WSPF(const bf16, WS2_WNEG), (size_t)S * DM, 9); dbg_sig(Fp, ws2_kt(Fp), (size_t)S * DM, 10);
        dbg_sig(Fp, ws2_ut(Fp), (size_t)S * DM, 11); dbg_sig(Fp, WSPF(const bf16, WS2_ATT), (size_t)S * DM / 2, 12); GRID_BAR();
      }
    }
#elif defined(DBG_DET)
#define DET_PASS(P) { Frame Fp = F; asm volatile("" : "+s"(Fp.ws), "+s"(Fp.out), "+v"(Fp.lane), "+v"(Fp.tid)); \
    p_hrecompute(Fp, args); GRID_BAR(); \
    GEMM(pg8::EpiGen<0>, WS_H, WS_WTB, 4096, DM, WSP(pg8::bf16_t, WS_R1), DM, 1024, (size_t)S * DM, nullptr); GRID_BAR(); \
    dbg_cksum(Fp, Fp.ws + WS_R1, 4 * T32, (P) * 16 + 0); GRID_BAR(); \
    { ConvHalo hl; p_dn_conv2_halo(Fp, hl); GRID_BAR(); p_dn_conv2(Fp, args, hl); GRID_BAR(); } \
    dbg_cksum(Fp, Fp.ws + WS2_QN, T32, (P) * 16 + 1); dbg_cksum(Fp, Fp.ws + WS2_KN, T32, (P) * 16 + 2); dbg_cksum(Fp, ws2_kt(Fp), T32, (P) * 16 + 3); dbg_cksum(Fp, ws2_ut(Fp), T32, (P) * 16 + 4); GRID_BAR(); \
    p_dn_chunk2(Fp, args); GRID_BAR(); \
    dbg_cksum(Fp, Fp.ws + WS2_ATT, T32 / 2, (P) * 16 + 5); dbg_cksum(Fp, Fp.ws + WS2_QN, T32, (P) * 16 + 6); dbg_cksum(Fp, ws2_ut(Fp), T32, (P) * 16 + 7); dbg_cksum(Fp, Fp.ws + WS2_WNEG, T32, (P) * 16 + 8); \
    dbg_cksum(Fp, ws2_kt(Fp), T32, (P) * 16 + 9);  GRID_BAR(); \
    p_dn_scan_fast(Fp, args); GRID_BAR(); \
    dbg_cksum(Fp, ws2_ut(Fp), T32, (P) * 16 + 11); GRID_BAR(); \
    p_dn_out_fast(Fp, args); GRID_BAR(); \
    dbg_cksum(Fp, Fp.ws + WS2_YD, T32, (P) * 16 + 12); GRID_BAR(); }
    { DET_PASS(0) }
    { DET_PASS(1) }
    p_hrecompute(F, args); GRID_BAR();
#else
    PROBE_AT(5);
    if (IN(5)) { GEMM(pg8::EpiGen<5>, WS_H, WS_WTB, 4096, DM, WSP(pg8::bf16_t, WS_R1), DM, 1024, (size_t)S * DM, WSP(const pg8::bf16_t, WS_HALO)); if (BOTH(5)) GRID_BAR(); }
    CK(5, F.ws + WS_R1, 4 * T32); CKB();
#if DN2
    PROBE_AT(6);
    if (IN(6)) { ConvHalo hl; p_dn_conv2_halo(F, hl); if (N_LAUNCHES != 1) GRID_BAR(); p_dn_conv2(F, args, hl); if (BOTH(6)) GRID_BAR(); }
    CK(6, F.ws + WS2_QN, 2 * T32); CK(6, F.out, 2 * T32); CKB();
    PROBE_AT(7);
    if (IN(7)) { p_dn_chunk2(F, args); if (BOTH(7)) GRID_BAR(); }
    CK(7, F.ws + WS2_ATT, T32 / 2); CK(7, F.ws + WS2_QN, T32); CK(7, F.out, 2 * T32); CK(7, F.ws + WS2_WNEG, T32); CK(7, F.ws + WS_EGL, 8192); CKB();
#else
    PROBE_AT(6);
    if (IN(6)) { p_dn_conv(F, args); if (BOTH(6)) GRID_BAR(); }
    PROBE_AT(7);
    if (IN(7)) { p_dn_chunk(F, args); if (BOTH(7)) GRID_BAR(); }
#endif
#ifndef DN_FAST
#define DN_FAST 1
#endif
#if DN_FAST
#if DN2
    PROBE_AT(8);
#ifndef SCAN2
#define SCAN2 1
#endif
#if SCAN2
    if (IN(8)) { PROBE_AT(80); p_dn_scan2_A(F, args); GRID_BAR(); PROBE_AT(81); p_dn_scan2_B(F, args); GRID_BAR(); PROBE_AT(82); if (blockIdx.x < 128) p_dn_scan2_C(F, args); else { p_hrecompute_sub(F, args, WSP(bf16, WS2_HALT), ((int)blockIdx.x - 128) * NWAVES + F.wave, 128 * NWAVES);
#if DN2_LATE_WT
            p_wtrans(F, args, WT_ITEMS_EARLY, WT_ITEMS_ALL, ((int)blockIdx.x - 128) * NWAVES + F.wave, 128 * NWAVES);
#endif
        } if (BOTH(8)) GRID_BAR(); PROBE_AT(83); }
#else
    if (IN(8)) { p_dn_scan_fast(F, args); if (BOTH(8)) GRID_BAR(); }
#endif
    CK(8, ws2_ut(F), T32); CKB();
#else
    PROBE_AT(8);
    if (IN(8)) { p_dn_relayout1(F, args); GRID_BAR(); p_dn_relayout2(F, args); GRID_BAR(); p_dn_scan_fast(F, args); if (BOTH(8)) GRID_BAR(); }
#endif
    PROBE_AT(9);
#if DN2 && SCAN2
    if (IN(9)) { p_dn_out_fast(F, args); if (BOTH(9)) GRID_BAR(); }
#else
    if (IN(9)) { p_dn_out_fast(F, args); p_hrecompute(F, args); if (BOTH(9)) GRID_BAR(); }
#endif
    CK(9, F.ws + WS2_YD, T32); CK(9, F.ws + WS_H, T32); CKB();
#else
    PROBE_AT(8);
    if (IN(8)) { p_dn_scan_naive(F, args); if (BOTH(8)) GRID_BAR(); }
    PROBE_AT(9);
    if (IN(9)) { p_dn_out(F, args); p_hrecompute(F, args); if (BOTH(9)) GRID_BAR(); }
#endif
#endif
    PROBE_AT(10);
    if (IN(10)) { pg8::Gemm g{(const pg8::bf16_t*)(F.ws + WS2_HALT), (const pg8::bf16_t*)(F.ws + WS_WTG), S, 2048, DM}; pg8::PairOrder Po; Po.init(S, DM, 2, F.G, (int)blockIdx.x);
        pg8::EpiGen<1> E{(pg8::bf16_t*)F.out, DM, 1024, (size_t)S * DM, nullptr}; pg8::gemm_phase<pg8::EpiGen<1>, pg8::PairOrder, true, true>(F.lds + RING_OFF, g, Po, E); if (BOTH(10) && N_LAUNCHES != 1) GRID_BAR(); }
    CK(10, F.out, 2 * T32); CKB();
    PROBE_AT(11);
    if (IN(11)) { GEMM(pg8::EpiGen<2>, WS_YA, WS_WTOA, 1024, DM, (pg8::bf16_t*)F.out, DM, 0, 0, nullptr); if (BOTH(11) && N_LAUNCHES != 1) GRID_BAR(); }
    CK(11, F.out, T32); CKB();
    PROBE_AT(12);
    if (IN(12)) { GEMM(pg8::EpiGen<3>, SCAN_YD, WS_WTOD, 1024, DM, (pg8::bf16_t*)F.out, DM, 0, 0, (const pg8::bf16_t*)F.out + (size_t)S * DM); if (BOTH(12)) GRID_BAR(); }
    CK(12, F.out, T32); CKB();
    PROBE_AT(13);
    if (IN(13)) { pg8::Gemm g{(const pg8::bf16_t*)F.out, WSP(const pg8::bf16_t, WS_WTOUT), S, DM, DM}; pg8::StaticOrder So; So.init(S, DM, F.G, (int)blockIdx.x);
        pg8::EpiGen<0> E{WSP(pg8::bf16_t, WS_T), DM, 0, 0, nullptr}; pg8::gemm_phase<pg8::EpiGen<0>, pg8::StaticOrder, true, true>(F.lds + RING_OFF, g, So, E); if (BOTH(13)) GRID_BAR(); }
    CK(13, F.ws + WS_T, 2 * T32); CKB();
    PROBE_AT(14);
    if (IN(14)) { p_post_mix(F, args); if (BOTH(14)) GRID_BAR(); }
    CK(14, F.out, 2 * T32); CK(14, F.ws + WS_H2, T32); CKB();
    PROBE_AT(15);
    if (IN(15)) { GEMM(pg8::EpiGen<4>, WS_H2, WS_WTGU, 2 * DFF, DM, WSP(pg8::bf16_t, WS_ACT), DFF, 0, 0, nullptr); if (BOTH(15)) GRID_BAR(); }
    CK(15, F.ws + WS_ACT, ACT_BYTES); CKB();
    PROBE_AT(16);
    if (IN(16)) { pg8::Gemm g{WSP(const pg8::bf16_t, WS_ACT), WSP(const pg8::bf16_t, WS_WTDN), S, DM, DFF}; pg8::StaticOrder So; So.init(S, DM, F.G, (int)blockIdx.x);
        pg8::EpiGen<0> E{WSP(pg8::bf16_t, WS_F), DM, 0, 0, nullptr}; pg8::gemm_phase<pg8::EpiGen<0>, pg8::StaticOrder, true, true>(F.lds + RING_OFF, g, So, E); if (BOTH(16)) GRID_BAR(); }
    CK(16, F.ws + WS_F, 2 * T32); CKB();
#ifdef DBG_TILE
    PROBE_AT(17);
    if (IN(17)) { const unsigned* w = WSP(const unsigned, WS_CTL) + CW_TILE; const unsigned cnt = w[0], mn = w[1]; const unsigned hm = (mn < 256u) ? w[2 + mn] : 0u;
        const int sel = DBG_TILE; const unsigned val = (sel == 1) ? (cnt > 120u ? 120u : cnt) : (sel == 2) ? (mn > 255u ? 127u : (mn >> 1)) : (sel == 3 ? (mn & 1u) * 8u + 0u + (hm & 0xFu) * 0u + (hm & 0xFFu) / 4u : (hm & 3u));
        float pz = __builtin_ldexpf(1.f, (int)val + 4); if (sel == 6) pz = __builtin_ldexpf(1.f, (int)(w[301] & 15u) + 4); if (sel == 7) pz = __builtin_ldexpf(1.f, (int)(w[301] >> 4) + 4); if (sel == 8) pz = __builtin_ldexpf(1.f, (int)(w[302] & 15u) + 4); if (sel == 9) pz = __builtin_ldexpf(1.f, (int)(w[302] >> 4) + 4);
        if (sel == 5) { unsigned be = w[300], lg = 0; while (be > 1u) { be >>= 1; ++lg; } pz = __builtin_ldexpf(1.f, (int)lg + 4); }
        for (size_t i = (size_t)F.gw * 64 + F.lane; i < (size_t)S * DM; i += (size_t)F.NGW * 64) F.out[i] = args.in[0][i] + pz; }
#elif defined(DBG_CHK)
    PROBE_AT(17);
    if (IN(17)) { const long long* sg = (const long long*)(WSP(unsigned, WS_CTL) + CW_CHK); float pz = 0.f;
        for (int k = 12; k >= 9; --k) { const double e2 = (double)sg[2 * k], r2 = (double)sg[2 * k + 1]; if (!(e2 <= 1e-3 * r2 + 16.0)) pz += 1024.f * (float)(1 << (2 * (k - 9))); }
        for (size_t i = (size_t)F.gw * 64 + F.lane; i < (size_t)S * DM; i += (size_t)F.NGW * 64) F.out[i] = args.in[0][i] + pz; }
#elif defined(DBG_SIG)
    PROBE_AT(17);
    if (IN(17)) { const long long* sg = (const long long*)(WSP(unsigned, WS_CTL) + CW_SIG); float pz = 0.f;
        for (int k = 4; k >= 0; --k) { const float a0 = (float)((double)sg[2 * k] / 65536.0), a1 = (float)((double)sg[2 * (8 + k)] / 65536.0), n0 = (float)((double)sg[2 * k + 1] / 65536.0), n1 = (float)((double)sg[2 * (8 + k) + 1] / 65536.0);
            const bool bad = !(fabsf(a0 - a1) <= 0.02f * sqrtf(n0) + 1e-3f) || !(fabsf(n0 - n1) <= 0.02f * (n0 + n1)); if (bad) pz = __builtin_ldexpf(1.f, 40 - 2 * k); }
        for (size_t i = (size_t)F.gw * 64 + F.lane; i < (size_t)S * DM; i += (size_t)F.NGW * 64) F.out[i] = args.in[0][i] + pz; }
#elif defined(DBG_DET)
    PROBE_AT(17);
    if (IN(17)) { const unsigned* cs = WSP(const unsigned, WS_CTL) + CW_CS; float pz = 0.f;
#ifdef DBG_NANCNT
        for (int k = 12; k >= 0; --k) if (cs[k] != 0u) pz = __builtin_ldexpf(1.f, 40 - 2 * k);
#else
        for (int k = 12; k >= 0; --k) if (cs[k] != cs[16 + k]) pz = __builtin_ldexpf(1.f, 40 - 2 * k);
#endif
        for (size_t i = (size_t)F.gw * 64 + F.lane; i < (size_t)S * DM; i += (size_t)F.NGW * 64) F.out[i] = args.in[0][i] + pz; }
#else
    PROBE_AT(17);
    if (IN(17)) { p_final(F, args); }
#endif
#ifdef WGSTAT
    if (blockIdx.x == 0 && F.tid == 0) { const unsigned* w_ = WSP(const unsigned, WS_CTL) + 30000; const unsigned v0 = __hip_atomic_load(w_, __ATOMIC_RELAXED, __HIP_MEMORY_SCOPE_AGENT), v1 = __hip_atomic_load(w_ + 1, __ATOMIC_RELAXED, __HIP_MEMORY_SCOPE_AGENT), v2 = __hip_atomic_load(w_ + 2, __ATOMIC_RELAXED, __HIP_MEMORY_SCOPE_AGENT);
        const unsigned v3 = __hip_atomic_load(w_ + 3, __ATOMIC_RELAXED, __HIP_MEMORY_SCOPE_AGENT);
        const unsigned long long dd = 8ull * (unsigned long long)(WGSTAT == 1 ? v0 : (WGSTAT == 2 ? v1 / (unsigned)F.G : (WGSTAT == 3 ? (v2 & 0xFFFu) * 100u : (WGSTAT == 4 ? (v3 & 0xFFFu) * 100u : 0xFFFFFu - (v3 >> 12)))));
        const unsigned long long ts = __builtin_amdgcn_s_memrealtime(); while (__builtin_amdgcn_s_memrealtime() - ts < dd) __builtin_amdgcn_s_sleep(8); }
#endif
#ifdef SCAN_PROBE
    __syncthreads();
    if (blockIdx.x == 0 && F.tid == 0) { const unsigned long long ts = __builtin_amdgcn_s_memrealtime(); const unsigned long long dd = 8ull * (unsigned long long)F.MISC[16]; while (__builtin_amdgcn_s_memrealtime() - ts < dd) __builtin_amdgcn_s_sleep(8); }
#endif
#ifdef PROBE_LO
    PROBE_AT(18);
    if (blockIdx.x == 0 && F.tid == 0) { const unsigned long long ts = __builtin_amdgcn_s_memrealtime(); while (__builtin_amdgcn_s_memrealtime() - ts < 8ull * pr_dt) __builtin_amdgcn_s_sleep(8); }
#endif
#ifdef DBG_L2L
    GRID_BAR(); CK(17, F.out, 2 * T32); GRID_BAR();
    { unsigned* cs = WSP(unsigned, WS_CTL) + CW_CS; unsigned* save = WSP(unsigned, 253 * MiB);
      if (args.pass == 0) { if (blockIdx.x == 0 && F.tid < 32) save[F.tid] = cs[F.tid]; }
      else { float pz = 0.f; for (int k = 17; k >= 0; --k) if (cs[k] != save[k]) pz = __builtin_ldexpf(1.f, 44 - 2 * k);
          if (pz != 0.f) for (size_t i = (size_t)F.gw * 64 + F.lane; i < (size_t)S * DM; i += (size_t)F.NGW * 64) F.out[i] += pz; } }
#endif
#undef IN
#undef BOTH
}

extern "C" void kernel_launch(void* const* d_in, const int* in_sizes, int n_in, void* d_out, int out_size, void* d_ws, size_t ws_size, hipStream_t stream) {
    static int grid = 0;
    if (grid == 0) {
        if (n_in != 16 || in_sizes[0] != S * DM || out_size != S * DM || ws_size < WS_END) { fprintf(stderr, "kernel_launch: unexpected shapes (n_in %d, in0 %d, out %d, ws %zu); nothing launched\n", n_in, n_in > 0 ? in_sizes[0] : -1, out_size, ws_size); grid = -1; return; }
        int dev = 0, cus = 0, per_cu = 0;
        if (hipGetDevice(&dev) != hipSuccess || hipDeviceGetAttribute(&cus, hipDeviceAttributeMultiprocessorCount, dev) != hipSuccess) { grid = -1; return; }
        if (hipFuncSetAttribute((const void*)fwd, hipFuncAttributeMaxDynamicSharedMemorySize, LDS_BYTES) != hipSuccess) { fprintf(stderr, "kernel_launch: hipFuncSetAttribute failed\n"); grid = -1; return; }
        if (hipOccupancyMaxActiveBlocksPerMultiprocessor(&per_cu, (const void*)fwd, NWAVES * 64, LDS_BYTES) != hipSuccess || per_cu < 1) fprintf(stderr, "kernel_launch: occupancy query says %d\n", per_cu);
        (void)hipGetLastError();
        grid = cus;
    }
    if (grid < 0) return;
    if (hipMemsetAsync((char*)d_ws + WS_CTL, 0, CTL_ZERO_BYTES, stream) != hipSuccess) return;
    Args a{};
    for (int i = 0; i < 16; ++i) a.in[i] = (const float*)d_in[i];
    a.out = (float*)d_out; a.ws = (unsigned char*)d_ws;
#ifdef DBG_L2L
    hipMemsetAsync((char*)d_ws + CTL_ZERO_BYTES, 0xA5, WS_END - CTL_ZERO_BYTES, stream); hipMemsetAsync(d_out, 0xA5, (size_t)S * DM * 4, stream);
    for (int li = 0; li < 2; ++li) {
        if (li == 1) hipMemsetAsync((char*)d_ws + WS_CTL, 0, CTL_ZERO_BYTES, stream);
        a.ph_lo = 0; a.ph_hi = NPHASE; a.pass = li;
#else
    for (int li = 0; li < N_LAUNCHES; ++li) {
        a.ph_lo = (N_LAUNCHES == 1) ? 0 : li; a.ph_hi = (N_LAUNCHES == 1) ? NPHASE : li + 1;
#endif
        hipLaunchKernelGGL(fwd, dim3(grid), dim3(NWAVES * 64), LDS_BYTES, stream, a);
        if (hipPeekAtLastError() != hipSuccess) { fprintf(stderr, "kernel_launch: launch %d failed\n", li); break; }
    }
}
```
